# Optimizing an MI355X kernel written in HIP

```python
import math
import jax, jax.numpy as jnp
from jax import lax
import numpy as np

D_MODEL = 2048
BATCH = 8
SEQ = 2048
DEPTH = 4

RET_HEADS = 8
RET_DK = 128
RET_DV = 128
RET_CHUNK = 128
GN_EPS = 1e-5
ML_HEADS = 8
ML_DK = 64
ML_DV = 128
ML_CHUNK = 128
GATE_SOFTCAP = 15.0
MB_HEADS = 8
MB_DH = 128
MB_BLOCK = 256
MB_TOPK = 3
MB_QCHUNK = 32
ROPE_THETA = 10000.0
D_FF = 5632
FFN_CONV = 3
EPS = 1e-6

RET_W = RET_HEADS * RET_DV
ML_W = ML_HEADS * ML_DV
MB_W = MB_HEADS * MB_DH
SPLIT_SIZES = (
    RET_HEADS * RET_DK, RET_HEADS * RET_DK, RET_W, RET_W,
    ML_HEADS * ML_DK, ML_HEADS * ML_DK, ML_W, ML_W, ML_HEADS, ML_HEADS,
    MB_W, MB_W, MB_W,
    D_MODEL, D_MODEL, D_MODEL,
)
N_IN = sum(SPLIT_SIZES)
SPLIT_IDX = tuple(int(s) for s in np.cumsum(SPLIT_SIZES)[:-1])

kernel_name = 'hybrid_retention_mlstm_moba_convglu'


def rms_norm(x, g):
    xf = x.astype(jnp.float32)
    y = xf * lax.rsqrt(jnp.mean(xf * xf, axis=-1, keepdims=True) + EPS)
    return (y * g.astype(jnp.float32)).astype(x.dtype)


def retnet_inv_freq():
    return 1.0 / (ROPE_THETA ** jnp.linspace(0.0, 1.0, RET_DK // 2, dtype=jnp.float32))


def rope_inv_freq():
    return 1.0 / (ROPE_THETA ** (jnp.arange(0, MB_DH, 2, dtype=jnp.float32) / MB_DH))


def rotary(x, inv_freq):
    S = x.shape[1]
    ang = jnp.arange(S, dtype=jnp.float32)[:, None] * inv_freq[None, :]
    cos = jnp.cos(ang)[None, :, None, :]
    sin = jnp.sin(ang)[None, :, None, :]
    x1, x2 = jnp.split(x.astype(jnp.float32), 2, axis=-1)
    return jnp.concatenate([x1 * cos - x2 * sin, x1 * sin + x2 * cos], axis=-1).astype(x.dtype)


def retention(q, k, v, g, gn_w):
    B, S = q.shape[0], q.shape[1]
    H, C, N = RET_HEADS, RET_CHUNK, S // RET_CHUNK
    f32 = jnp.float32
    qc = q.astype(f32).reshape(B, N, C, H, RET_DK)
    kc = (k.astype(f32) * RET_DK ** -0.5).reshape(B, N, C, H, RET_DK)
    vc = v.astype(f32).reshape(B, N, C, H, RET_DV)
    log_gamma = jnp.log1p(-jnp.exp2(-5.0 - jnp.arange(H, dtype=f32)))
    pos = jnp.arange(C, dtype=f32)
    diff = pos[:, None] - pos[None, :]
    decay = jnp.where(diff >= 0, jnp.exp(log_gamma[:, None, None] * jnp.maximum(diff, 0.0)), 0.0)
    scores = jnp.einsum('bnihd,bnjhd->bnhij', qc, kc) * decay
    intra = jnp.einsum('bnhij,bnjhe->bnihe', scores, vc)
    k_w = kc * jnp.exp((C - 1.0 - pos)[:, None] * log_gamma[None, :])[None, None, :, :, None]
    kv = jnp.einsum('bnjhd,bnjhe->bnhde', k_w, vc)
    chunk_decay = jnp.exp(C * log_gamma)[None, :, None, None]

    def step(state, kv_n):
        return state * chunk_decay + kv_n, state

    _, prev = lax.scan(step, jnp.zeros((B, H, RET_DK, RET_DV), f32), jnp.moveaxis(kv, 1, 0))
    prev = jnp.moveaxis(prev, 0, 1)
    q_w = qc * jnp.exp((pos + 1.0)[:, None] * log_gamma[None, :])[None, None, :, :, None]
    inter = jnp.einsum('bnihd,bnhde->bnihe', q_w, prev)
    o = (intra + inter).reshape(B, S, H, RET_DV)
    o = o - o.mean(axis=-1, keepdims=True)
    o = o * lax.rsqrt(jnp.mean(o * o, axis=-1, keepdims=True) + GN_EPS)
    o = o.reshape(B, S, H * RET_DV) * gn_w.astype(f32)
    return (jax.nn.silu(g.astype(f32)) * o).astype(q.dtype)


def softcap(x):
    return GATE_SOFTCAP * jnp.tanh(x / GATE_SOFTCAP)


def mlstm(q, k, v, o_pre, i_pre, f_pre, norm_w):
    B, S = q.shape[0], q.shape[1]
    H, C, N = ML_HEADS, ML_CHUNK, S // ML_CHUNK
    f32 = jnp.float32
    qc = q.astype(f32).reshape(B, N, C, H, ML_DK)
    kc = (k.astype(f32) * ML_DK ** -0.5).reshape(B, N, C, H, ML_DK)
    vc = v.astype(f32).reshape(B, N, C, H, ML_DV)
    i_log = softcap(i_pre.astype(f32)).reshape(B, N, C, H).transpose(0, 1, 3, 2)
    f_log = jax.nn.log_sigmoid(softcap(f_pre.astype(f32))).reshape(B, N, C, H).transpose(0, 1, 3, 2)
    a = jnp.cumsum(f_log, axis=-1)
    a_last = a[..., -1]
    causal = jnp.tril(jnp.ones((C, C), dtype=bool))
    d_log = jnp.where(causal, a[..., :, None] - a[..., None, :] + i_log[..., None, :], -jnp.inf)
    w_end = a_last[..., None] - a + i_log
    g_loc = jnp.max(w_end, axis=-1)
    w_exp = jnp.exp(w_end - g_loc[..., None])
    kv_loc = jnp.einsum('bnhj,bnjhd,bnjhe->bnhde', w_exp, kc, vc)
    n_loc = jnp.einsum('bnhj,bnjhd->bnhd', w_exp, kc)

    def step(carry, xs):
        c_st, n_st, m_st = carry
        kv_n, nn_n, g_n, a_n = xs
        m_new = jnp.maximum(a_n + m_st, g_n)
        s_old = jnp.exp(a_n + m_st - m_new)
        s_new = jnp.exp(g_n - m_new)
        c_new = s_old[..., None, None] * c_st + s_new[..., None, None] * kv_n
        n_new = s_old[..., None] * n_st + s_new[..., None] * nn_n
        return (c_new, n_new, m_new), (c_st, n_st, m_st)

    init = (jnp.zeros((B, H, ML_DK, ML_DV), f32), jnp.zeros((B, H, ML_DK), f32), jnp.zeros((B, H), f32))
    xs = (jnp.moveaxis(kv_loc, 1, 0), jnp.moveaxis(n_loc, 1, 0), jnp.moveaxis(g_loc, 1, 0), jnp.moveaxis(a_last, 1, 0))
    _, (c_prev, n_prev, m_prev) = lax.scan(step, init, xs)
    c_prev = jnp.moveaxis(c_prev, 0, 1)
    n_prev = jnp.moveaxis(n_prev, 0, 1)
    m_prev = jnp.moveaxis(m_prev, 0, 1)
    inter_log = a + m_prev[..., None]
    m_row = jnp.maximum(jnp.max(d_log, axis=-1), inter_log)
    qk = jnp.einsum('bnihd,bnjhd->bnhij', qc, kc) * jnp.exp(d_log - m_row[..., None])
    s_inter = jnp.exp(inter_log - m_row)
    num = jnp.einsum('bnhij,bnjhe->bnihe', qk, vc) + jnp.einsum('bnihd,bnhde->bnihe', qc, c_prev) * jnp.swapaxes(s_inter, 2, 3)[..., None]
    den = qk.sum(axis=-1) + jnp.einsum('bnihd,bnhd->bnhi', qc, n_prev) * s_inter
    den = jnp.maximum(jnp.abs(den), jnp.exp(-m_row))
    h = (num / jnp.swapaxes(den, 2, 3)[..., None]).reshape(B, S, H, ML_DV)
    h = h * lax.rsqrt(jnp.mean(h * h, axis=-1, keepdims=True) + EPS) * norm_w.astype(f32).reshape(H, ML_DV)
    return (jax.nn.sigmoid(o_pre.astype(f32)) * h.reshape(B, S, H * ML_DV)).astype(q.dtype)


def moba(q, k, v):
    B, S, H, D = q.shape
    nb = -(-S // MB_BLOCK)
    s_pad = nb * MB_BLOCK
    pad = ((0, 0), (0, s_pad - S), (0, 0), (0, 0))
    qh = jnp.pad(q, pad).transpose(0, 2, 1, 3)
    kb = jnp.pad(k, pad).transpose(0, 2, 1, 3).reshape(B, H, nb, MB_BLOCK, D)
    vb = jnp.pad(v, pad).transpose(0, 2, 1, 3).reshape(B, H, nb, MB_BLOCK, D)
    k_mean = kb.astype(jnp.float32).mean(axis=3)
    gate = jnp.einsum('bhsd,bhnd->bhsn', qh.astype(jnp.float32), k_mean)
    q_blk = jnp.arange(s_pad) // MB_BLOCK
    gate = jnp.where(jnp.arange(nb)[None, :] < q_blk[:, None], gate, -jnp.inf)
    topk = min(MB_TOPK, nb)
    _, idx = lax.top_k(gate, topk)
    valid = jnp.arange(topk)[None, :] < q_blk[:, None]
    n_qc = s_pad // MB_QCHUNK
    scale = D ** -0.5
    q_x = qh.reshape(B, H, n_qc, MB_QCHUNK, D).transpose(2, 0, 1, 3, 4)
    idx_x = idx.reshape(B, H, n_qc, MB_QCHUNK, topk).transpose(2, 0, 1, 3, 4)
    valid_x = valid.reshape(n_qc, MB_QCHUNK, topk)
    bi = jnp.arange(B)[:, None, None]
    hi = jnp.arange(H)[None, :, None]

    def attend(xs):
        ci, qc, ic, vm = xs
        blk = (ci * MB_QCHUNK) // MB_BLOCK
        qpos = ci * MB_QCHUNK + jnp.arange(MB_QCHUNK)
        kpos = blk * MB_BLOCK + jnp.arange(MB_BLOCK)
        k_own = lax.dynamic_index_in_dim(kb, blk, axis=2, keepdims=False)
        v_own = lax.dynamic_index_in_dim(vb, blk, axis=2, keepdims=False)
        s = jnp.einsum('bhqd,bhkd->bhqk', qc, k_own, preferred_element_type=jnp.float32) * scale
        s = jnp.where(kpos[None, :] <= qpos[:, None], s, -jnp.inf)
        m = jnp.max(s, axis=-1)
        p = jnp.exp(s - m[..., None])
        l = p.sum(axis=-1)
        acc = jnp.einsum('bhqk,bhkd->bhqd', p, v_own.astype(jnp.float32))
        for slot in range(topk):
            sel = ic[..., slot]
            k_s = kb[bi, hi, sel]
            v_s = vb[bi, hi, sel]
            sc = jnp.einsum('bhqd,bhqkd->bhqk', qc, k_s, preferred_element_type=jnp.float32) * scale
            sc = jnp.where(vm[:, slot][None, None, :, None], sc, -jnp.inf)
            m_new = jnp.maximum(m, jnp.max(sc, axis=-1))
            alpha = jnp.exp(m - m_new)
            p = jnp.exp(sc - m_new[..., None])
            l = alpha * l + p.sum(axis=-1)
            acc = alpha[..., None] * acc + jnp.einsum('bhqk,bhqkd->bhqd', p, v_s.astype(jnp.float32))
            m = m_new
        return (acc / l[..., None]).astype(q.dtype)

    out = lax.map(attend, (jnp.arange(n_qc), q_x, idx_x, valid_x))
    out = out.transpose(1, 0, 3, 2, 4).reshape(B, s_pad, H, D)
    return out[:, :S]


def conv_glu_ffn(h, w_up, conv_w, conv_b, w_down):
    S = h.shape[1]
    u = h @ w_up
    up = jnp.pad(u, ((0, 0), (FFN_CONV - 1, 0), (0, 0)))
    u = conv_b + sum(up[:, j:j + S] * conv_w[j] for j in range(FFN_CONV))
    a, b = jnp.split(u, 2, axis=-1)
    return (jax.nn.silu(a) * b) @ w_down


def setup_inputs(seed: int = 0) -> dict:
    key = jax.random.key(seed)
    ks = jax.random.split(key, 20)
    f32 = jnp.float32

    def nrm(k, shape, scale):
        return jax.random.normal(k, shape, f32) * scale

    return {
        'x': nrm(ks[0], (BATCH, SEQ, D_MODEL), 1.0),
        'w_in': nrm(ks[1], (DEPTH, D_MODEL, N_IN), D_MODEL ** -0.5),
        'b_ig': nrm(ks[2], (DEPTH, ML_HEADS), 0.1),
        'b_fg': jnp.linspace(3.0, 6.0, ML_HEADS, dtype=f32)[None, :] + nrm(ks[3], (DEPTH, ML_HEADS), 0.1),
        'norm_mix': 1.0 + nrm(ks[4], (DEPTH, D_MODEL), 0.1),
        'ret_gn': 1.0 + nrm(ks[5], (DEPTH, RET_W), 0.1),
        'ml_norm': 1.0 + nrm(ks[6], (DEPTH, ML_W), 0.1),
        'q_norm': 1.0 + nrm(ks[7], (DEPTH, MB_DH), 0.1),
        'k_norm': 1.0 + nrm(ks[8], (DEPTH, MB_DH), 0.1),
        'w_pa': nrm(ks[9], (DEPTH, RET_W, D_MODEL), RET_W ** -0.5),
        'w_pb': nrm(ks[10], (DEPTH, ML_W, D_MODEL), ML_W ** -0.5),
        'w_pc': nrm(ks[11], (DEPTH, MB_W, D_MODEL), MB_W ** -0.5),
        'w_out': nrm(ks[12], (DEPTH, D_MODEL, D_MODEL), D_MODEL ** -0.5),
        'norm_ffn': 1.0 + nrm(ks[13], (DEPTH, D_MODEL), 0.1),
        'w_up': nrm(ks[14], (DEPTH, D_MODEL, 2 * D_FF), D_MODEL ** -0.5),
        'conv_w': nrm(ks[15], (DEPTH, FFN_CONV, 2 * D_FF), FFN_CONV ** -0.5),
        'conv_b': nrm(ks[16], (DEPTH, 2 * D_FF), 0.01),
        'w_down': nrm(ks[17], (DEPTH, D_FF, D_MODEL), D_FF ** -0.5),
    }


def reference(x, w_in, b_ig, b_fg, norm_mix, ret_gn, ml_norm, q_norm, k_norm, w_pa, w_pb, w_pc, w_out, norm_ffn, w_up, conv_w, conv_b, w_down):
    B, S = x.shape[0], x.shape[1]
    ret_freq = retnet_inv_freq()
    rope_freq = rope_inv_freq()
    for l in range(DEPTH):
        h = rms_norm(x, norm_mix[l])
        z = h @ w_in[l]
        (rq, rk, rv, rg, mq, mk, mv, mo, mi, mf, aq, ak, av, ga, gb, gc) = jnp.split(z, SPLIT_IDX, axis=-1)
        rq = rotary(rq.reshape(B, S, RET_HEADS, RET_DK), ret_freq)
        rk = rotary(rk.reshape(B, S, RET_HEADS, RET_DK), ret_freq)
        y_a = retention(rq, rk, rv.reshape(B, S, RET_HEADS, RET_DV), rg, ret_gn[l])
        y_b = mlstm(mq.reshape(B, S, ML_HEADS, ML_DK), mk.reshape(B, S, ML_HEADS, ML_DK),
                    mv.reshape(B, S, ML_HEADS, ML_DV), mo, mi + b_ig[l], mf + b_fg[l], ml_norm[l])
        aq = rotary(rms_norm(aq.reshape(B, S, MB_HEADS, MB_DH), q_norm[l]), rope_freq)
        ak = rotary(rms_norm(ak.reshape(B, S, MB_HEADS, MB_DH), k_norm[l]), rope_freq)
        y_c = moba(aq, ak, av.reshape(B, S, MB_HEADS, MB_DH)).reshape(B, S, MB_W)
        merged = (jax.nn.sigmoid(ga) * (y_a @ w_pa[l]) + jax.nn.sigmoid(gb) * (y_b @ w_pb[l])
                  + jax.nn.sigmoid(gc) * (y_c @ w_pc[l]))
        x = x + merged @ w_out[l]
        x = x + conv_glu_ffn(rms_norm(x, norm_ffn[l]), w_up[l], conv_w[l], conv_b[l], w_down[l])
    return x
```

```cpp
#include <hip/hip_runtime.h>
#include <cstdio>
#include <cstdint>
namespace pg8 {
#define PG8_LAS __attribute__((address_space(3)))
typedef unsigned short bf16_t;
typedef short bf16x8 __attribute__((ext_vector_type(8)));
typedef float f32x4 __attribute__((ext_vector_type(4)));
typedef unsigned u32x4 __attribute__((ext_vector_type(4)));
constexpr int BM = 256, BK = 64, HALF = 128, HTB = HALF * BK * 2  , STAGE_BYTES = 8 * HTB, NXCD = 8, WGM = 8;

__host__ __device__ __forceinline__ int lds_byte(int r, int c) { const int st = (r >> 4) * 2 + (c >> 5), rr = r & 15, cc = c & 31, ob = rr * 64 + cc * 2; return st * 1024 + (ob ^ (((ob >> 9) & 1) << 5)); }
__host__ __device__ __forceinline__ void stage_rc(int b, int& R, int& C) { const int st = b / 1024, sb = b % 1024, swz = sb ^ (((sb >> 9) & 1) << 5); R = (st >> 1) * 16 + swz / 64; C = (st & 1) * 32 + (swz % 64) / 2; }
__host__ __device__ __forceinline__ int perm32(int rho) { const int n = rho >> 4, i = rho & 15; return 8 * (i >> 2) + 4 * n + (i & 3); }

struct Unit { int pm, pn; };
struct Gemm { const bf16_t* A; const bf16_t* Bt; int M, N, K; };

struct StaticOrder {
    int nM, nN, nwg, G, c;
    __host__ __device__ void init(int M, int N, int G_, int c_) { nM = M / BM; nN = N / BM; nwg = nM * nN; G = G_; c = c_; }
    __host__ __device__ bool next(int i, Unit& u) const {
        const long L = (long)i * G + c; if (L >= nwg) return false;
        int wgid = (int)L; { const int q = nwg / NXCD, r = nwg % NXCD, xcd = wgid % NXCD, off = wgid / NXCD; wgid = (xcd < r ? xcd * (q + 1) : r * (q + 1) + (xcd - r) * q) + off; }
        const int nig = WGM * nN, gid = wgid / nig, fm = gid * WGM, gsz = (nM - fm) < WGM ? (nM - fm) : WGM;
        u.pm = fm + ((wgid % nig) % gsz); u.pn = (wgid % nig) / gsz; return true;
    }
    __device__ __forceinline__ void a_ready(const Unit&) const {}
    __device__ __forceinline__ void done(const Unit&) const {}
};

__device__ __forceinline__ unsigned cvt_pk_bf16(float lo, float hi) { unsigned r; asm volatile("v_cvt_pk_bf16_f32 %0, %1, %2" : "=v"(r) : "v"(lo), "v"(hi)); return r; }
struct EpiBf16 {
    static constexpr bool PERM = true, AFTER_DRAIN = false;
    bf16_t* O; int ldc;
    __device__ __forceinline__ void operator()(const f32x4 (&acc)[2][2][4][2], const Unit& u, int wr, int wc, int fr, int fq) const {
        const int row0 = u.pm * BM + wr * 64 + fr; const int col0 = u.pn * BM + wc * 32 + 8 * fq;
#pragma unroll
        for (int ai = 0; ai < 2; ++ai)
#pragma unroll
            for (int m = 0; m < 4; ++m) { bf16_t* rowp = O + (size_t)(row0 + ai * HALF + m * 16) * ldc + col0;
#pragma unroll
                for (int bj = 0; bj < 2; ++bj) { const f32x4 v0 = acc[ai][bj][m][0], v1 = acc[ai][bj][m][1];
                    u32x4 w; w.x = cvt_pk_bf16(v0[0], v0[1]); w.y = cvt_pk_bf16(v0[2], v0[3]); w.z = cvt_pk_bf16(v1[0], v1[1]); w.w = cvt_pk_bf16(v1[2], v1[3]);
                    *(u32x4*)(rowp + bj * HALF) = w; } }
    }
};
__device__ __forceinline__ float bf_lo(unsigned w) { return __uint_as_float(w << 16); }
__device__ __forceinline__ float bf_hi(unsigned w) { return __uint_as_float(w & 0xffff0000u); }
__device__ __forceinline__ float sigmoid_f(float x) { return __builtin_amdgcn_rcpf(1.0f + __expf(-x)); }
template <bool FIRST> struct EpiGateAcc {
    static constexpr bool PERM = true, AFTER_DRAIN = false;
    bf16_t* O; int ldc; const bf16_t* G; int ldg;
    __device__ __forceinline__ void operator()(const f32x4 (&acc)[2][2][4][2], const Unit& u, int wr, int wc, int fr, int fq) const {
        const int row0 = u.pm * BM + wr * 64 + fr; const int col0 = u.pn * BM + wc * 32 + 8 * fq;
#pragma unroll
        for (int ai = 0; ai < 2; ++ai)
#pragma unroll
            for (int m = 0; m < 4; ++m) { const size_t row = (size_t)(row0 + ai * HALF + m * 16);
#pragma unroll
                for (int bj = 0; bj < 2; ++bj) { const f32x4 v0 = acc[ai][bj][m][0], v1 = acc[ai][bj][m][1];
                    const u32x4 g = *(const u32x4*)(G + row * ldg + col0 + bj * HALF);
                    u32x4 p = (u32x4){0u, 0u, 0u, 0u};
                    if (!FIRST) p = *(const u32x4*)(O + row * ldc + col0 + bj * HALF);
                    float o[8];
                    o[0] = bf_lo(p.x) + sigmoid_f(bf_lo(g.x)) * v0[0]; o[1] = bf_hi(p.x) + sigmoid_f(bf_hi(g.x)) * v0[1];
                    o[2] = bf_lo(p.y) + sigmoid_f(bf_lo(g.y)) * v0[2]; o[3] = bf_hi(p.y) + sigmoid_f(bf_hi(g.y)) * v0[3];
                    o[4] = bf_lo(p.z) + sigmoid_f(bf_lo(g.z)) * v1[0]; o[5] = bf_hi(p.z) + sigmoid_f(bf_hi(g.z)) * v1[1];
                    o[6] = bf_lo(p.w) + sigmoid_f(bf_lo(g.w)) * v1[2]; o[7] = bf_hi(p.w) + sigmoid_f(bf_hi(g.w)) * v1[3];
                    u32x4 w; w.x = cvt_pk_bf16(o[0], o[1]); w.y = cvt_pk_bf16(o[2], o[3]); w.z = cvt_pk_bf16(o[4], o[5]); w.w = cvt_pk_bf16(o[6], o[7]);
                    *(u32x4*)(O + row * ldc + col0 + bj * HALF) = w; } }
    }
};
struct EpiResF32 {
    static constexpr bool PERM = false, AFTER_DRAIN = false;
    const float* base; float* out; int ldc;
    __device__ __forceinline__ void operator()(const f32x4 (&acc)[2][2][4][2], const Unit& u, int wr, int wc, int fr, int fq) const {
        const int col0 = u.pn * BM + wc * 32 + 4 * fq;
#pragma unroll
        for (int ai = 0; ai < 2; ++ai)
#pragma unroll
            for (int m = 0; m < 4; ++m) { const size_t off = (size_t)(u.pm * BM + ai * HALF + wr * 64 + m * 16 + fr) * ldc + col0;
#pragma unroll
                for (int bj = 0; bj < 2; ++bj)
#pragma unroll
                    for (int n = 0; n < 2; ++n) { const f32x4 bs = *(const f32x4*)(base + off + bj * HALF + n * 16); *(f32x4*)(out + off + bj * HALF + n * 16) = bs + acc[ai][bj][m][n]; } }
    }
};

template <class Epi, class Sched, bool ALIGN_EPI = false, bool SP2 = false>
__device__ __forceinline__ void gemm_phase(PG8_LAS unsigned char* lds, const Gemm g, const Sched& S, const Epi& E) {
    int tid_ = threadIdx.x; asm volatile("" : "+v"(tid_));
    const int tid = tid_, wid = __builtin_amdgcn_readfirstlane(tid >> 6), lane = tid & 63, wr = wid >> 2, wc = wid & 3, fr = lane & 15, fq = lane >> 4;
    const int K = g.K, nt = K / BK;
    unsigned voffA[2], voffB[2];
#pragma unroll
    for (int i = 0; i < 2; ++i) { int R, C; stage_rc(tid * 16 + i * 8192, R, C); const int Rb = Epi::PERM ? ((R & ~31) + perm32(R & 31)) : R;
        voffA[i] = (unsigned)(R * K + C) * 2u; voffB[i] = (unsigned)(Rb * K + C) * 2u; }
    const size_t kstep = (size_t)(BK * 2);
    const size_t hstep = (size_t)HALF * K * 2;
    const size_t tstep = 2 * hstep;
    const unsigned ldsw = (unsigned)wid * 1024u;
    const int aoff = lds_byte(wr * 64 + fr, fq * 8), boff = lds_byte(wc * 32 + fr, fq * 8);
#define PG8_SA(b, h) (((b) * 2 + (h)) * HTB)
#define PG8_SB(b, h) ((4 + (b) * 2 + (h)) * HTB)
#define PG8_STAGE(bufoff, gbase, voff) do { _Pragma("unroll") for (int _i = 0; _i < 2; ++_i) \
        __builtin_amdgcn_global_load_lds((const unsigned*)((const char*)(gbase) + (voff)[_i]), (PG8_LAS unsigned*)(lds + (bufoff) + ldsw + _i * 8192), 16, 0, 0); } while (0)
#define PG8_LDA(dst, b, h) do { _Pragma("unroll") for (int m = 0; m < 4; ++m) _Pragma("unroll") for (int k = 0; k < 2; ++k) dst[m][k] = *(const PG8_LAS bf16x8*)(lds + PG8_SA(b, h) + aoff + m * 2048 + k * 1024); } while (0)
#define PG8_LDB(dst, b, h) do { _Pragma("unroll") for (int n = 0; n < 2; ++n) _Pragma("unroll") for (int k = 0; k < 2; ++k) dst[n][k] = *(const PG8_LAS bf16x8*)(lds + PG8_SB(b, h) + boff + n * 2048 + k * 1024); } while (0)
#define PG8_MMA(ai, bj, At, Bt) do { __builtin_amdgcn_s_setprio(1); _Pragma("unroll") for (int m = 0; m < 4; ++m) _Pragma("unroll") for (int n = 0; n < 2; ++n) _Pragma("unroll") for (int k = 0; k < 2; ++k) \
        acc[ai][bj][m][n] = __builtin_amdgcn_mfma_f32_16x16x32_bf16(Bt[n][k], At[m][k], acc[ai][bj][m][n], 0, 0, 0); __builtin_amdgcn_s_setprio(0); } while (0)
#define PG8_WAIT_V(n) asm volatile("s_waitcnt vmcnt(" #n ")" ::: "memory")
#define PG8_WAIT_L(n) asm volatile("s_waitcnt lgkmcnt(" #n ")" ::: "memory")
#define PG8_BAR __builtin_amdgcn_s_barrier()
#define PG8_SCHED __builtin_amdgcn_sched_barrier(0)
    Unit cur, nxt; int ui = 0;
    if (!S.next(0, cur)) return;
    f32x4 acc[2][2][4][2];
#pragma unroll
    for (int a = 0; a < 2; ++a)
#pragma unroll
        for (int b = 0; b < 2; ++b)
#pragma unroll
            for (int m = 0; m < 4; ++m)
#pragma unroll
                for (int n = 0; n < 2; ++n) acc[a][b][m][n] = (f32x4){0.f, 0.f, 0.f, 0.f};
    bf16x8 At[4][2], B0[2][2], B1[2][2];
    const char* cA = (const char*)g.A + (size_t)cur.pm * tstep; const char* cB = (const char*)g.Bt + (size_t)cur.pn * tstep;
    S.a_ready(cur);
    if constexpr (SP2) {
        PG8_STAGE(PG8_SB(0, 0), cB, voffB); PG8_STAGE(PG8_SB(0, 1), cB + hstep, voffB); PG8_STAGE(PG8_SA(0, 0), cA, voffA); PG8_STAGE(PG8_SA(0, 1), cA + hstep, voffA);
        if (wr == 1) PG8_BAR;
        PG8_WAIT_V(2); PG8_BAR;
        PG8_STAGE(PG8_SB(1, 0), cB + kstep, voffB); PG8_STAGE(PG8_SA(1, 0), cA + kstep, voffA); PG8_STAGE(PG8_SB(1, 1), cB + hstep + kstep, voffB);
        PG8_WAIT_V(6); PG8_BAR;
    } else {
        PG8_STAGE(PG8_SB(0, 0), cB, voffB); PG8_STAGE(PG8_SA(0, 0), cA, voffA); PG8_STAGE(PG8_SB(0, 1), cB + hstep, voffB); PG8_STAGE(PG8_SA(0, 1), cA + hstep, voffA);
        if (wr == 1) PG8_BAR;
        PG8_WAIT_V(4); PG8_BAR;
        PG8_STAGE(PG8_SB(1, 0), cB + kstep, voffB); PG8_STAGE(PG8_SA(1, 0), cA + kstep, voffA); PG8_STAGE(PG8_SB(1, 1), cB + hstep + kstep, voffB);
        PG8_WAIT_V(6); PG8_BAR;
    }
    for (;;) {
        const bool has_next = S.next(ui + 1, nxt);
        const char* nA = has_next ? (const char*)g.A + (size_t)nxt.pm * tstep : cA; const char* nB = has_next ? (const char*)g.Bt + (size_t)nxt.pn * tstep : cB;
        for (int t = 0; t < nt; t += 2) {
            const bool last = (t == nt - 2);
            const char* a1 = cA + (size_t)(t + 1) * kstep;
            const char* a2 = last ? nA : cA + (size_t)(t + 2) * kstep; const char* b2 = last ? nB : cB + (size_t)(t + 2) * kstep;
            const char* a3 = a2 + kstep; const char* b3 = b2 + kstep;
            if (last && has_next) S.a_ready(nxt);
            if constexpr (SP2) {
            PG8_LDB(B0, 0, 0); PG8_LDB(B1, 0, 1); PG8_SCHED; PG8_LDA(At, 0, 0); PG8_STAGE(PG8_SA(1, 1), a1 + hstep, voffA);
            PG8_WAIT_V(8); PG8_WAIT_L(0); PG8_BAR; PG8_MMA(0, 0, At, B0); PG8_MMA(0, 1, At, B1); PG8_BAR; PG8_SCHED;
            PG8_LDA(At, 0, 1); PG8_STAGE(PG8_SB(0, 0), b2, voffB); PG8_STAGE(PG8_SB(0, 1), b2 + hstep, voffB); PG8_STAGE(PG8_SA(0, 0), a2, voffA);
            PG8_WAIT_V(8); PG8_WAIT_L(0); PG8_BAR; PG8_MMA(1, 0, At, B0); PG8_MMA(1, 1, At, B1); PG8_BAR; PG8_SCHED;
            PG8_LDB(B0, 1, 0); PG8_LDB(B1, 1, 1); PG8_SCHED; PG8_LDA(At, 1, 0); PG8_STAGE(PG8_SA(0, 1), a2 + hstep, voffA);
            PG8_WAIT_V(8); PG8_WAIT_L(0); PG8_BAR; PG8_MMA(0, 0, At, B0); PG8_MMA(0, 1, At, B1); PG8_BAR; PG8_SCHED;
            PG8_LDA(At, 1, 1); PG8_STAGE(PG8_SB(1, 0), b3, voffB); PG8_STAGE(PG8_SB(1, 1), b3 + hstep, voffB); PG8_STAGE(PG8_SA(1, 0), a3, voffA);
            PG8_WAIT_V(8); PG8_WAIT_L(0); PG8_BAR; PG8_MMA(1, 0, At, B0); PG8_MMA(1, 1, At, B1); PG8_BAR; PG8_SCHED;
            } else {
            PG8_LDB(B0, 0, 0); PG8_SCHED; PG8_LDA(At, 0, 0); PG8_STAGE(PG8_SA(1, 1), a1 + hstep, voffA);
            PG8_WAIT_L(8); PG8_BAR; PG8_WAIT_L(0); PG8_MMA(0, 0, At, B0); PG8_BAR; PG8_SCHED;
            PG8_LDB(B1, 0, 1); PG8_STAGE(PG8_SB(0, 0), b2, voffB);
            PG8_BAR; PG8_WAIT_L(0); PG8_MMA(0, 1, At, B1); PG8_BAR;
            PG8_LDA(At, 0, 1); PG8_STAGE(PG8_SA(0, 0), a2, voffA);
            PG8_BAR; PG8_WAIT_L(0); PG8_MMA(1, 0, At, B0); PG8_BAR; PG8_SCHED;
            PG8_STAGE(PG8_SB(0, 1), b2 + hstep, voffB);
            PG8_WAIT_V(6); PG8_BAR; PG8_MMA(1, 1, At, B1); PG8_BAR;
            PG8_LDB(B0, 1, 0); PG8_SCHED; PG8_LDA(At, 1, 0); PG8_STAGE(PG8_SA(0, 1), a2 + hstep, voffA);
            PG8_WAIT_L(8); PG8_BAR; PG8_WAIT_L(0); PG8_MMA(0, 0, At, B0); PG8_BAR; PG8_SCHED;
            PG8_LDB(B1, 1, 1); PG8_STAGE(PG8_SB(1, 0), b3, voffB);
            PG8_BAR; PG8_WAIT_L(0); PG8_MMA(0, 1, At, B1); PG8_BAR;
            PG8_LDA(At, 1, 1); PG8_STAGE(PG8_SA(1, 0), a3, voffA);
            PG8_BAR; PG8_WAIT_L(0); PG8_MMA(1, 0, At, B0); PG8_BAR; PG8_SCHED;
            PG8_STAGE(PG8_SB(1, 1), b3 + hstep, voffB);
            PG8_WAIT_V(6); PG8_BAR; PG8_MMA(1, 1, At, B1); PG8_BAR;
            }
        }
        if constexpr (ALIGN_EPI) { if (wr == 0) PG8_BAR; }
        if constexpr (!Epi::AFTER_DRAIN) { E(acc, cur, wr, wc, fr, fq); S.done(cur); }
        if (!has_next) break;
#pragma unroll
        for (int a = 0; a < 2; ++a)
#pragma unroll
            for (int b = 0; b < 2; ++b)
#pragma unroll
                for (int m = 0; m < 4; ++m)
#pragma unroll
                    for (int n = 0; n < 2; ++n) acc[a][b][m][n] = (f32x4){0.f, 0.f, 0.f, 0.f};
        cur = nxt; cA = nA; cB = nB; ++ui;
        if constexpr (ALIGN_EPI) { if (wr == 1) PG8_BAR; }
    }
    PG8_WAIT_V(0);
    if constexpr (!ALIGN_EPI) { if (wr == 0) PG8_BAR; }
    PG8_BAR;
    if constexpr (Epi::AFTER_DRAIN) { E.fused(acc, cur, wr, wc, fr, fq, lds, wid, lane); S.done(cur); }
#undef PG8_SA
#undef PG8_SB
#undef PG8_STAGE
#undef PG8_LDA
#undef PG8_LDB
#undef PG8_MMA
#undef PG8_WAIT_V
#undef PG8_WAIT_L
#undef PG8_BAR
#undef PG8_SCHED
}
}

constexpr int NWAVES = 8;
constexpr int BATCH = 8, SEQ = 2048, DM = 2048, DEPTH = 4, M = BATCH * SEQ, NH = 8;
constexpr int NIN = 16400, NZ = 16384, DFF = 5632, NUP = 2 * DFF, NY = 3072;
constexpr int Z_RQ = 0, Z_RK = 1024, Z_RV = 2048, Z_RG = 3072, Z_MQ = 4096, Z_MK = 4608, Z_MV = 5120, Z_MO = 6144, Z_AQ = 7168, Z_AK = 8192, Z_AV = 9216, Z_GA = 10240, Z_GB = 12288, Z_GC = 14336;
constexpr int W_GATE_COL = 7168;
constexpr size_t MiB = 1u << 20;
constexpr size_t WS_CTL = 0, CTL_ZERO_BYTES = 1 * MiB;
constexpr size_t WS_TAB = 2 * MiB;
constexpr size_t WS_W16T = 4 * MiB;
constexpr size_t WS_KMEAN = 5 * MiB;
constexpr size_t WS_GIF = 6 * MiB;
constexpr size_t WS_WIN = 8 * MiB;
constexpr size_t WS_WP = 264 * MiB;
constexpr size_t WS_WOUT = 312 * MiB;
constexpr size_t WS_WUP = 344 * MiB;
constexpr size_t WS_WDN = 520 * MiB;
constexpr size_t WS_H = 608 * MiB;
constexpr size_t WS_Z = 672 * MiB;
constexpr size_t WS_Y = 1184 * MiB;
constexpr size_t WS_MG = 1280 * MiB;
constexpr size_t WS_ACT = 1344 * MiB;
constexpr size_t WS_END = 1520 * MiB;
constexpr int CW_TMO = 0, CW_CODE = 1;
constexpr int CW_BAR = 4096;
constexpr int RING_OFF = 0, RING_BYTES = 131072;
constexpr int LDSCTL_OFF = RING_BYTES, MISC_OFF = LDSCTL_OFF + 320;
constexpr int LDS_BYTES = 147456;
static_assert(MISC_OFF + 128 <= LDS_BYTES, "LDS map");

#define GAS __attribute__((address_space(1)))
#define LAS __attribute__((address_space(3)))
typedef unsigned short bf16;
typedef unsigned v4u __attribute__((ext_vector_type(4)));
typedef unsigned v2u __attribute__((ext_vector_type(2)));
typedef float f32x4 __attribute__((ext_vector_type(4)));
typedef float f32x2 __attribute__((ext_vector_type(2)));
typedef GAS unsigned gu32;
#define RLX_AGENT __ATOMIC_RELAXED, __HIP_MEMORY_SCOPE_AGENT
#define LDS_WAIT() asm volatile("s_waitcnt lgkmcnt(0)" ::: "memory")
#define VM_WAIT() asm volatile("s_waitcnt vmcnt(0)" ::: "memory")
__device__ __forceinline__ unsigned f2bf(float f) { unsigned u = __builtin_bit_cast(unsigned, f); return (u + 0x7fffu + ((u >> 16) & 1u)) >> 16; }
__device__ __forceinline__ unsigned pk2(float lo, float hi) { return f2bf(lo) | (f2bf(hi) << 16); }
__device__ __forceinline__ float bflo(unsigned w) { return __uint_as_float(w << 16); }
__device__ __forceinline__ float bfhi(unsigned w) { return __uint_as_float(w & 0xffff0000u); }
__device__ __forceinline__ float bf1(bf16 v) { return __uint_as_float((unsigned)v << 16); }
__device__ __forceinline__ float sigm(float x) { return 1.0f / (1.0f + __expf(-x)); }

#define XB_TMO      128
#define XB_XCNT(j)  (256  + 64 * (j))
#define XB_XSUB(j)  (1280 + 64 * (j))
#define XB_XGEN(j)  (2304 + 64 * (j))
#define XB_TOP      3328
#define XB_TOPGEN   3392
#define XCD_BAR_WORDS 3456
#define XB_SPIN_CAP (1u << 18)

__device__ __forceinline__ unsigned xb_ld(unsigned* p)              { return __hip_atomic_load(p, __ATOMIC_RELAXED, __HIP_MEMORY_SCOPE_AGENT); }
__device__ __forceinline__ unsigned xb_add(unsigned* p, unsigned v) { return __hip_atomic_fetch_add(p, v, __ATOMIC_RELAXED, __HIP_MEMORY_SCOPE_AGENT); }
__device__ __forceinline__ unsigned xb_xcc_id() { return (unsigned)__builtin_amdgcn_s_getreg((3 << 11) | 20) & 0xFu; }
#define XB_SPIN(cond, bar) do { unsigned _sp = 0; while (cond) { __builtin_amdgcn_s_sleep(1); \
    if ((++_sp & 255u) == 0u) { if (xb_ld(&(bar)[XB_TMO])) break; if (_sp > XB_SPIN_CAP) { atomicAdd(&(bar)[XB_TMO], 1u); break; } } } } while (0)

struct XcdBarrier {
    unsigned* bar; unsigned x;
    volatile LAS unsigned* st;
};

__device__ __forceinline__ XcdBarrier xcd_barrier_post(unsigned* bar, volatile LAS unsigned* st) {
    XcdBarrier b; b.bar = bar; b.x = xb_xcc_id(); b.st = st;
    if (threadIdx.x == 0) (void)xb_add(&bar[XB_XCNT(b.x)], 1u);
    return b;
}
__device__ __forceinline__ void xcd_barrier_complete(unsigned* bar, unsigned x, unsigned& nloc, unsigned& nx) {
    const unsigned G = gridDim.x * gridDim.y * gridDim.z;
    unsigned sum, cnt, mine, sp = 0u;
    for (;;) {
        sum = 0u; cnt = 0u; mine = 0u;
#pragma unroll
        for (unsigned j = 0; j < 16; ++j) { const unsigned c = xb_ld(&bar[XB_XCNT(j)]); sum += c; cnt += (c > 0u) ? 1u : 0u; mine = (j == x) ? c : mine; }
        if (sum == G) break;
        __builtin_amdgcn_s_sleep(1);
        if ((++sp & 255u) == 0u) { if (xb_ld(&bar[XB_TMO])) break; if (sp > XB_SPIN_CAP) { atomicAdd(&bar[XB_TMO], 1u); break; } }
    }
    nloc = mine > 0u ? mine : 1u; nx = cnt > 0u ? cnt : 1u;
}

__device__ __forceinline__ void xcd_barrier(const XcdBarrier& b) {
    asm volatile("s_waitcnt vmcnt(0)" ::: "memory");
    __syncthreads();
    if (threadIdx.x == 0) {
        unsigned* bar = b.bar;
        __builtin_amdgcn_s_waitcnt(0);
        unsigned nloc = b.st[0], nx = b.st[1];
        if (nloc == 0u) { xcd_barrier_complete(bar, b.x, nloc, nx); b.st[0] = nloc; b.st[1] = nx; }
        const unsigned old = xb_add(&bar[XB_XSUB(b.x)], 1u);
        const unsigned gen = old / nloc;
        if (old + 1u == (gen + 1u) * nloc) {
            __builtin_amdgcn_fence(__ATOMIC_RELEASE, "agent");
            asm volatile("s_waitcnt vmcnt(0)" ::: "memory");
            const unsigned og = xb_add(&bar[XB_TOP], 1u);
            const unsigned tg = og / nx;
            if (og + 1u == (tg + 1u) * nx) xb_add(&bar[XB_TOPGEN], 1u);
            else XB_SPIN(xb_ld(&bar[XB_TOPGEN]) == tg, bar);
            __builtin_amdgcn_fence(__ATOMIC_ACQUIRE, "agent");
            xb_add(&bar[XB_XGEN(b.x)], 1u);
            asm volatile("s_waitcnt vmcnt(0)" ::: "memory");
        } else {
            XB_SPIN(xb_ld(&bar[XB_XGEN(b.x)]) == gen, bar);
            __builtin_amdgcn_fence(__ATOMIC_ACQUIRE, "agent");
            asm volatile("s_waitcnt vmcnt(0)" ::: "memory");
        }
    }
    __syncthreads();
}

struct Args { const float* in[18]; float* out; unsigned char* ws; int ph_lo, ph_hi, li, pad; };
enum { I_X = 0, I_WIN, I_BIG, I_BFG, I_NMIX, I_RGN, I_MLN, I_QN, I_KN, I_WPA, I_WPB, I_WPC, I_WOUT, I_NFFN, I_WUP, I_CW, I_CB, I_WDN };
struct Frame {
    LAS unsigned char* lds;
    volatile LAS unsigned* MISC;
    unsigned char* ws;
    int tid, lane, wave, G;
};
#define WSP(T, off) ((T*)(F.ws + (off)))
__device__ __forceinline__ float wave_sum(float v) {
#pragma unroll
    for (int o = 1; o < 64; o <<= 1) v += __shfl_xor(v, o);
    return v;
}
__device__ __forceinline__ float wave_max(float v) {
#pragma unroll
    for (int o = 1; o < 64; o <<= 1) v = fmaxf(v, __shfl_xor(v, o));
    return v;
}
__device__ __forceinline__ void p0_transpose_item(const float* W, int ldw, int K, int nblk, bf16* WT, LAS float* scr, int item, int lane) {
    const int kb = item / nblk, nb = item % nblk, k0 = 64 * kb, n0 = 32 * nb;
#pragma unroll 8
    for (int i = 0; i < 32; ++i) { const int kk = 2 * i + (lane >> 5); scr[kk * 33 + (lane & 31)] = W[(size_t)(k0 + kk) * ldw + n0 + (lane & 31)]; }
    LDS_WAIT(); asm volatile("" ::: "memory");
    const int c = lane & 7;
#pragma unroll
    for (int j = 0; j < 4; ++j) { const int n = (lane >> 3) + 8 * j; const LAS float* s = scr + (8 * c) * 33 + n;
        v4u o; o.x = pk2(s[0 * 33], s[1 * 33]); o.y = pk2(s[2 * 33], s[3 * 33]); o.z = pk2(s[4 * 33], s[5 * 33]); o.w = pk2(s[6 * 33], s[7 * 33]);
        *(GAS v4u*)(WT + (size_t)(n0 + n) * K + k0 + 8 * c) = o; }
    LDS_WAIT(); asm volatile("" ::: "memory");
}
__device__ __forceinline__ void p0_prologue(Frame& F, const Args& args) {
    LAS float* scr = (LAS float*)(F.lds + RING_OFF + F.wave * 16384);
    const int gw = blockIdx.x * NWAVES + F.wave, NGW = F.G * NWAVES;
    constexpr int I_INA = 32 * 224, I_INB = 32 * 288, I_P = 16 * 64, I_OUT = 32 * 64, I_UP = 32 * 352, I_DN = 88 * 64;
    constexpr int I_LAYER = I_INA + I_INB + 3 * I_P + I_OUT + I_UP + I_DN;
    for (int it = gw; it < DEPTH * I_LAYER; it += NGW) {
        const int l = it / I_LAYER; int r = it % I_LAYER;
        const float* win = args.in[I_WIN] + (size_t)l * DM * NIN; bf16* wint = WSP(bf16, WS_WIN) + (size_t)l * NZ * DM;
        if (r < I_INA) { p0_transpose_item(win, NIN, DM, 224, wint, scr, r, F.lane); continue; } r -= I_INA;
        if (r < I_INB) { p0_transpose_item(win + 7184, NIN, DM, 288, wint + (size_t)7168 * DM, scr, r, F.lane); continue; } r -= I_INB;
        if (r < I_P) { p0_transpose_item(args.in[I_WPA] + (size_t)l * 1024 * DM, DM, 1024, 64, WSP(bf16, WS_WP) + ((size_t)l * 3 + 0) * DM * 1024, scr, r, F.lane); continue; } r -= I_P;
        if (r < I_P) { p0_transpose_item(args.in[I_WPB] + (size_t)l * 1024 * DM, DM, 1024, 64, WSP(bf16, WS_WP) + ((size_t)l * 3 + 1) * DM * 1024, scr, r, F.lane); continue; } r -= I_P;
        if (r < I_P) { p0_transpose_item(args.in[I_WPC] + (size_t)l * 1024 * DM, DM, 1024, 64, WSP(bf16, WS_WP) + ((size_t)l * 3 + 2) * DM * 1024, scr, r, F.lane); continue; } r -= I_P;
        if (r < I_OUT) { p0_transpose_item(args.in[I_WOUT] + (size_t)l * DM * DM, DM, DM, 64, WSP(bf16, WS_WOUT) + (size_t)l * DM * DM, scr, r, F.lane); continue; } r -= I_OUT;
        if (r < I_UP) { p0_transpose_item(args.in[I_WUP] + (size_t)l * DM * NUP, NUP, DM, 352, WSP(bf16, WS_WUP) + (size_t)l * NUP * DM, scr, r, F.lane); continue; } r -= I_UP;
        p0_transpose_item(args.in[I_WDN] + (size_t)l * DFF * DM, DM, DFF, 64, WSP(bf16, WS_WDN) + (size_t)l * DM * DFF, scr, r, F.lane);
    }
    const int gt = blockIdx.x * (NWAVES * 64) + F.tid, NGT = F.G * NWAVES * 64;
    for (int i = gt; i < DEPTH * 16 * DM; i += NGT) { const int l = i / (16 * DM), c = (i / DM) % 16, k = i % DM; WSP(float, WS_W16T)[i] = args.in[I_WIN][((size_t)l * DM + k) * NIN + W_GATE_COL + c]; }
    for (int i = gt; i < 2 * SEQ * 64; i += NGT) { const int which = i / (SEQ * 64), pos = (i / 64) % SEQ, d = i % 64;
        const float ex = which == 0 ? (float)d / 63.0f : (float)(2 * d) / 128.0f;
        const float inv = 1.0f / powf(10000.0f, ex); const float ang = (float)pos * inv; float s, c; sincosf(ang, &s, &c); WSP(f32x2, WS_TAB)[i] = (f32x2){c, s}; }
}
template <bool GATES> __device__ __forceinline__ void norm_phase(Frame& F, const float* x, const float* g, const float* w16t, const float* big, const float* bfg) {
    LAS float* wl = (LAS float*)(F.lds + RING_OFF);
    if (GATES) { for (int i = F.tid; i < 16 * DM / 4; i += NWAVES * 64) ((LAS f32x4*)wl)[i] = ((const f32x4*)w16t)[i]; __syncthreads(); }
    const int gw = blockIdx.x * NWAVES + F.wave, NGW = F.G * NWAVES, lane = F.lane;
    f32x4 gv[8];
#pragma unroll
    for (int j = 0; j < 8; ++j) gv[j] = ((const f32x4*)g)[64 * j + lane];
    for (int m = gw; m < M; m += NGW) {
        const f32x4* xr = (const f32x4*)(x + (size_t)m * DM) + lane;
        f32x4 v[8]; float s = 0.f;
#pragma unroll
        for (int j = 0; j < 8; ++j) { v[j] = xr[64 * j]; s += (v[j].x * v[j].x + v[j].y * v[j].y) + (v[j].z * v[j].z + v[j].w * v[j].w); }
        const float rstd = rsqrtf(wave_sum(s) * (1.f / DM) + 1e-6f);
        v2u* o8 = (v2u*)(WSP(bf16, WS_H) + (size_t)m * DM) + lane;
#pragma unroll
        for (int j = 0; j < 8; ++j) { v[j] = v[j] * rstd * gv[j]; v2u w; w.x = pk2(v[j].x, v[j].y); w.y = pk2(v[j].z, v[j].w); o8[64 * j] = w; }
        if (GATES) {
            float mine = 0.f;
#pragma unroll 1
            for (int c = 0; c < 16; ++c) { float p = 0.f;
#pragma unroll
                for (int j = 0; j < 8; ++j) { const f32x4 w = ((const LAS f32x4*)(wl + c * DM))[64 * j + lane]; p += (v[j].x * w.x + v[j].y * w.y) + (v[j].z * w.z + v[j].w * w.w); }
                p = wave_sum(p); if (lane == c) mine = p; }
            if (lane < 16) { const int hh = lane & 7; float pre = mine + (lane < 8 ? big[hh] : bfg[hh]);
                const float sc = 15.0f * tanhf(pre * (1.0f / 15.0f));
                float o = sc;
                if (lane >= 8) o = sc > 0.f ? -log1pf(__expf(-sc)) : sc - log1pf(__expf(sc));
                WSP(float, WS_GIF)[(size_t)m * 16 + lane] = o; }
        }
    }
}
__device__ __forceinline__ void prep_phase(Frame& F, const float* qn, const float* kn) {
    const int gw = blockIdx.x * NWAVES + F.wave, NGW = F.G * NWAVES, lane = F.lane;
    const f32x2* tret = WSP(f32x2, WS_TAB); const f32x2* trope = WSP(f32x2, WS_TAB) + SEQ * 64;
    const float qn1 = qn[lane], qn2 = qn[lane + 64], kn1 = kn[lane], kn2 = kn[lane + 64];
    for (int m = gw; m < M; m += NGW) {
        const int pos = m & (SEQ - 1); bf16* zr = WSP(bf16, WS_Z) + (size_t)m * NZ;
        const f32x2 cr = tret[pos * 64 + lane], cp = trope[pos * 64 + lane];
        for (int hh = 0; hh < NH; ++hh) {
            { bf16* p = zr + Z_RQ + hh * 128 + lane; const float a = bf1(p[0]), b = bf1(p[64]); p[0] = (bf16)f2bf(a * cr.x - b * cr.y); p[64] = (bf16)f2bf(a * cr.y + b * cr.x); }
            { bf16* p = zr + Z_RK + hh * 128 + lane; const float a = bf1(p[0]) * 0.08838834764831845f, b = bf1(p[64]) * 0.08838834764831845f; p[0] = (bf16)f2bf(a * cr.x - b * cr.y); p[64] = (bf16)f2bf(a * cr.y + b * cr.x); }
            { bf16* p = zr + Z_AQ + hh * 128 + lane; float a = bf1(p[0]), b = bf1(p[64]); const float r = rsqrtf(wave_sum(a * a + b * b) * (1.f / 128.f) + 1e-6f); a *= r * qn1; b *= r * qn2;
              p[0] = (bf16)f2bf(a * cp.x - b * cp.y); p[64] = (bf16)f2bf(a * cp.y + b * cp.x); }
        }
    }
    for (int it = gw; it < BATCH * 8 * NH; it += NGW) {
        const int b = it >> 6, blk = (it >> 3) & 7, hh = it & 7; float s1 = 0.f, s2 = 0.f;
        for (int t = 0; t < 256; ++t) { const int pos = blk * 256 + t; bf16* p = WSP(bf16, WS_Z) + (size_t)(b * SEQ + pos) * NZ + Z_AK + hh * 128 + lane; const f32x2 cp = trope[pos * 64 + lane];
            float a = bf1(p[0]), c = bf1(p[64]); const float r = rsqrtf(wave_sum(a * a + c * c) * (1.f / 128.f) + 1e-6f); a *= r * kn1; c *= r * kn2;
            const float o1 = a * cp.x - c * cp.y, o2 = a * cp.y + c * cp.x; s1 += o1; s2 += o2; p[0] = (bf16)f2bf(o1); p[64] = (bf16)f2bf(o2); }
        float* km = WSP(float, WS_KMEAN) + (size_t)((b * NH + hh) * 8 + blk) * 128; km[lane] = s1 * (1.f / 256.f); km[lane + 64] = s2 * (1.f / 256.f);
    }
}
__device__ __forceinline__ void ret_unit_scalar(Frame& F, const float* gn, int b, int h) {
    LAS float* qs = (LAS float*)(F.lds + RING_OFF); LAS float* ks = qs + 2048; LAS float* vs = ks + 2048; LAS float* part = vs + 2048;
    const int tid = F.tid, lane = F.lane, e = tid & 127, dq = tid >> 7;
    float S[32];
#pragma unroll
    for (int i = 0; i < 32; ++i) S[i] = 0.f;
    const float gamma = 1.0f - exp2f(-5.0f - (float)h);
    const bf16* zb = WSP(bf16, WS_Z) + (size_t)(b * SEQ) * NZ;
    const float gn1 = gn[h * 128 + lane], gn2 = gn[h * 128 + 64 + lane];
    for (int t0 = 0; t0 < SEQ; t0 += 16) {
        { const int tt = tid >> 5, d4 = (tid & 31) * 4; const bf16* zr = zb + (size_t)(t0 + tt) * NZ + h * 128 + d4;
          const v2u qv = *(const v2u*)(zr + Z_RQ), kv = *(const v2u*)(zr + Z_RK), vv = *(const v2u*)(zr + Z_RV);
          *(LAS f32x4*)(qs + tt * 128 + d4) = (f32x4){bflo(qv.x), bfhi(qv.x), bflo(qv.y), bfhi(qv.y)};
          *(LAS f32x4*)(ks + tt * 128 + d4) = (f32x4){bflo(kv.x), bfhi(kv.x), bflo(kv.y), bfhi(kv.y)};
          *(LAS f32x4*)(vs + tt * 128 + d4) = (f32x4){bflo(vv.x), bfhi(vv.x), bflo(vv.y), bfhi(vv.y)}; }
        __syncthreads();
        for (int tt = 0; tt < 16; ++tt) {
            const float v = vs[tt * 128 + e]; float acc = 0.f;
#pragma unroll
            for (int i = 0; i < 32; ++i) { const float kd = ks[tt * 128 + dq * 32 + i], qd = qs[tt * 128 + dq * 32 + i]; S[i] = gamma * S[i] + kd * v; acc += qd * S[i]; }
            part[(tt * 4 + dq) * 128 + e] = acc;
        }
        __syncthreads();
#pragma unroll
        for (int t2 = 0; t2 < 2; ++t2) { const int tt = 2 * F.wave + t2; const size_t m = (size_t)b * SEQ + t0 + tt;
            float o1 = 0.f, o2 = 0.f;
#pragma unroll
            for (int q = 0; q < 4; ++q) { o1 += part[(tt * 4 + q) * 128 + lane]; o2 += part[(tt * 4 + q) * 128 + 64 + lane]; }
            const float mean = wave_sum(o1 + o2) * (1.f / 128.f); const float d1 = o1 - mean, d2 = o2 - mean;
            const float r = rsqrtf(wave_sum(d1 * d1 + d2 * d2) * (1.f / 128.f) + 1e-5f);
            const float g1 = bf1(WSP(bf16, WS_Z)[m * NZ + Z_RG + h * 128 + lane]), g2 = bf1(WSP(bf16, WS_Z)[m * NZ + Z_RG + h * 128 + 64 + lane]);
            WSP(bf16, WS_Y)[m * 1024 + h * 128 + lane] = (bf16)f2bf(d1 * r * gn1 * g1 * sigm(g1)); WSP(bf16, WS_Y)[m * 1024 + h * 128 + 64 + lane] = (bf16)f2bf(d2 * r * gn2 * g2 * sigm(g2)); }
        __syncthreads();
    }
}
__device__ __forceinline__ void mlstm_unit_scalar(Frame& F, const float* nw, int b, int h) {
    LAS float* qs = (LAS float*)(F.lds + RING_OFF); LAS float* ks = qs + 1024; LAS float* vs = ks + 1024; LAS float* part = vs + 2048; LAS float* pden = part + 8192; LAS float* gi = pden + 64; LAS float* gf = gi + 16;
    const int tid = F.tid, lane = F.lane, e = tid & 127, dq = tid >> 7;
    float C[16], nn[16];
#pragma unroll
    for (int i = 0; i < 16; ++i) { C[i] = 0.f; nn[i] = 0.f; }
    const bf16* zb = WSP(bf16, WS_Z) + (size_t)(b * SEQ) * NZ;
    const float nw1 = nw[h * 128 + lane], nw2 = nw[h * 128 + 64 + lane];
    for (int t0 = 0; t0 < SEQ; t0 += 16) {
        { const int tt = tid >> 5, d4 = (tid & 31) * 4; const bf16* zr = zb + (size_t)(t0 + tt) * NZ;
          const v2u vv = *(const v2u*)(zr + Z_MV + h * 128 + d4);
          *(LAS f32x4*)(vs + tt * 128 + d4) = (f32x4){bflo(vv.x), bfhi(vv.x), bflo(vv.y), bfhi(vv.y)};
          if (d4 < 64) { const v2u qv = *(const v2u*)(zr + Z_MQ + h * 64 + d4), kv = *(const v2u*)(zr + Z_MK + h * 64 + d4);
              *(LAS f32x4*)(qs + tt * 64 + d4) = (f32x4){bflo(qv.x), bfhi(qv.x), bflo(qv.y), bfhi(qv.y)};
              *(LAS f32x4*)(ks + tt * 64 + d4) = (f32x4){bflo(kv.x), bfhi(kv.x), bflo(kv.y), bfhi(kv.y)} * 0.125f; }
          if (tid < 16) { const size_t m = (size_t)b * SEQ + t0 + tid; gi[tid] = __expf(WSP(float, WS_GIF)[m * 16 + h]); gf[tid] = __expf(WSP(float, WS_GIF)[m * 16 + 8 + h]); } }
        __syncthreads();
        for (int tt = 0; tt < 16; ++tt) {
            const float v = vs[tt * 128 + e], ig = gi[tt], fg = gf[tt]; float num = 0.f, den = 0.f;
#pragma unroll
            for (int i = 0; i < 16; ++i) { const float kd = ks[tt * 64 + dq * 16 + i] * ig, qd = qs[tt * 64 + dq * 16 + i]; C[i] = fg * C[i] + kd * v; nn[i] = fg * nn[i] + kd; num += qd * C[i]; den += qd * nn[i]; }
            part[(tt * 4 + dq) * 128 + e] = num; if (e == 0) pden[tt * 4 + dq] = den;
        }
        __syncthreads();
#pragma unroll
        for (int t2 = 0; t2 < 2; ++t2) { const int tt = 2 * F.wave + t2; const size_t m = (size_t)b * SEQ + t0 + tt;
            float o1 = 0.f, o2 = 0.f, dn = 0.f;
#pragma unroll
            for (int q = 0; q < 4; ++q) { o1 += part[(tt * 4 + q) * 128 + lane]; o2 += part[(tt * 4 + q) * 128 + 64 + lane]; dn += pden[tt * 4 + q]; }
            const float dd = 1.0f / fmaxf(fabsf(dn), 1.0f); o1 *= dd; o2 *= dd;
            const float r = rsqrtf(wave_sum(o1 * o1 + o2 * o2) * (1.f / 128.f) + 1e-6f);
            const float g1 = bf1(WSP(bf16, WS_Z)[m * NZ + Z_MO + h * 128 + lane]), g2 = bf1(WSP(bf16, WS_Z)[m * NZ + Z_MO + h * 128 + 64 + lane]);
            WSP(bf16, WS_Y)[(size_t)M * 1024 + m * 1024 + h * 128 + lane] = (bf16)f2bf(o1 * r * nw1 * sigm(g1)); WSP(bf16, WS_Y)[(size_t)M * 1024 + m * 1024 + h * 128 + 64 + lane] = (bf16)f2bf(o2 * r * nw2 * sigm(g2)); }
        __syncthreads();
    }
}
__device__ __forceinline__ void moba_item_scalar(Frame& F, int b, int h, int t, LAS float* qL, LAS float* pL) {
    const int lane = F.lane, blk = t >> 8; const size_t m = (size_t)b * SEQ + t;
    const bf16* zb = WSP(bf16, WS_Z) + (size_t)(b * SEQ) * NZ;
    const unsigned qw = *(const unsigned*)(zb + (size_t)t * NZ + Z_AQ + h * 128 + 2 * lane);
    const float q0 = bflo(qw), q1 = bfhi(qw);
    qL[2 * lane] = q0; qL[2 * lane + 1] = q1;
    float gate[8];
#pragma unroll
    for (int n = 0; n < 8; ++n) { gate[n] = -INFINITY;
        if (n < blk) { const f32x2 km = *(const f32x2*)(WSP(float, WS_KMEAN) + (size_t)((b * NH + h) * 8 + n) * 128 + 2 * lane); gate[n] = wave_sum(q0 * km.x + q1 * km.y); } }
    int sel[4]; sel[0] = blk; unsigned used = 0u;
#pragma unroll
    for (int s = 1; s < 4; ++s) { float bv = -INFINITY; int best = -1;
#pragma unroll
        for (int n = 0; n < 8; ++n) { const bool c = !((used >> n) & 1u) && gate[n] > bv; bv = c ? gate[n] : bv; best = c ? n : best; }
        if (best >= 0) used |= 1u << best; sel[s] = best; }
    LDS_WAIT();
    float sc[4][4]; float mx = -INFINITY;
#pragma unroll
    for (int s = 0; s < 4; ++s) {
#pragma unroll
        for (int c = 0; c < 4; ++c) sc[s][c] = -INFINITY;
        const int kb = __builtin_amdgcn_readfirstlane(sel[s]);
        if (kb >= 0) {
#pragma unroll
            for (int c = 0; c < 4; ++c) { const int kpos = kb * 256 + c * 64 + lane; const bf16* kr = zb + (size_t)kpos * NZ + Z_AK + h * 128; float d = 0.f;
#pragma unroll 4
                for (int i = 0; i < 16; ++i) { const v4u kw = *(const v4u*)(kr + 8 * i); const f32x4 qa = *(const LAS f32x4*)(qL + 8 * i), qb = *(const LAS f32x4*)(qL + 8 * i + 4);
                    d += (bflo(kw.x) * qa.x + bfhi(kw.x) * qa.y) + (bflo(kw.y) * qa.z + bfhi(kw.y) * qa.w) + (bflo(kw.z) * qb.x + bfhi(kw.z) * qb.y) + (bflo(kw.w) * qb.z + bfhi(kw.w) * qb.w); }
                const bool valid = (s > 0) || (kpos <= t); sc[s][c] = valid ? d * 0.08838834764831845f : -INFINITY; mx = fmaxf(mx, sc[s][c]); } }
    }
    mx = wave_max(mx); float ls = 0.f;
#pragma unroll
    for (int s = 0; s < 4; ++s)
#pragma unroll
        for (int c = 0; c < 4; ++c) { const float p = __expf(sc[s][c] - mx); ls += p; pL[s * 256 + c * 64 + lane] = p; }
    ls = wave_sum(ls);
    LDS_WAIT();
    float a0 = 0.f, a1 = 0.f;
#pragma unroll
    for (int s = 0; s < 4; ++s) { const int kb = __builtin_amdgcn_readfirstlane(sel[s]);
        if (kb >= 0) { const int nk = (s == 0) ? (t - blk * 256 + 1) : 256; const bf16* vr = zb + (size_t)(kb * 256) * NZ + Z_AV + h * 128 + 2 * lane;
            for (int j = 0; j < nk; ++j) { const float p = pL[s * 256 + j]; const unsigned vw = *(const unsigned*)(vr + (size_t)j * NZ); a0 += p * bflo(vw); a1 += p * bfhi(vw); } } }
    const float inv = 1.0f / ls;
    *(unsigned*)(WSP(bf16, WS_Y) + (size_t)2 * M * 1024 + m * 1024 + h * 128 + 2 * lane) = pk2(a0 * inv, a1 * inv);
    LDS_WAIT();
}
__device__ __forceinline__ void mix_phase_scalar(Frame& F, const float* rgn, const float* mln) {
    const int bx = blockIdx.x;
    if (F.G >= 256) {
        if (bx < 64) ret_unit_scalar(F, rgn, bx >> 3, bx & 7);
        else if (bx < 128) mlstm_unit_scalar(F, mln, (bx - 64) >> 3, bx & 7);
        else { const int nw = (F.G - 128) * NWAVES, w = (bx - 128) * NWAVES + F.wave;
            LAS float* qL = (LAS float*)(F.lds + RING_OFF) + F.wave * 1280; LAS float* pL = qL + 128;
            const int per = (BATCH * NH * SEQ + nw - 1) / nw;
            for (int i = 0; i < per; ++i) { const int it = w * per + i; if (it < BATCH * NH * SEQ) moba_item_scalar(F, it >> 14, (it >> 11) & 7, it & (SEQ - 1), qL, pL); } }
    }
}
__device__ __forceinline__ void glu_phase(Frame& F, const float* cw, const float* cb) {
    const int gt = blockIdx.x * (NWAVES * 64) + F.tid, NGT = F.G * NWAVES * 64;
    for (int idx = gt; idx < M * (DFF / 8); idx += NGT) {
        const int m = idx / (DFF / 8), c8 = (idx % (DFF / 8)) * 8, pos = m & (SEQ - 1);
        float r[2][8];
#pragma unroll
        for (int hf = 0; hf < 2; ++hf) { const int col = hf * DFF + c8;
            const f32x4 b0 = *(const f32x4*)(cb + col), b1 = *(const f32x4*)(cb + col + 4);
            float a[8] = {b0.x, b0.y, b0.z, b0.w, b1.x, b1.y, b1.z, b1.w};
#pragma unroll
            for (int j = 0; j < 3; ++j) { const int dt = 2 - j; if (pos >= dt) {
                const v4u uw = *(const v4u*)(WSP(bf16, WS_Z) + (size_t)(m - dt) * NUP + col); const f32x4 w0 = *(const f32x4*)(cw + (size_t)j * NUP + col), w1 = *(const f32x4*)(cw + (size_t)j * NUP + col + 4);
                a[0] += bflo(uw.x) * w0.x; a[1] += bfhi(uw.x) * w0.y; a[2] += bflo(uw.y) * w0.z; a[3] += bfhi(uw.y) * w0.w; a[4] += bflo(uw.z) * w1.x; a[5] += bfhi(uw.z) * w1.y; a[6] += bflo(uw.w) * w1.z; a[7] += bfhi(uw.w) * w1.w; } }
#pragma unroll
            for (int i = 0; i < 8; ++i) r[hf][i] = a[i]; }
        v4u o;
        o.x = pk2(r[0][0] * sigm(r[0][0]) * r[1][0], r[0][1] * sigm(r[0][1]) * r[1][1]); o.y = pk2(r[0][2] * sigm(r[0][2]) * r[1][2], r[0][3] * sigm(r[0][3]) * r[1][3]);
        o.z = pk2(r[0][4] * sigm(r[0][4]) * r[1][4], r[0][5] * sigm(r[0][5]) * r[1][5]); o.w = pk2(r[0][6] * sigm(r[0][6]) * r[1][6], r[0][7] * sigm(r[0][7]) * r[1][7]);
        *(v4u*)(WSP(bf16, WS_ACT) + (size_t)m * DFF + c8) = o;
    }
}
constexpr int N_PHASES = 1 + 10 * DEPTH;
__global__ void __launch_bounds__(NWAVES * 64, 2) fwd(Args args) {
    extern __shared__ __attribute__((aligned(16))) unsigned char lds[];
    Frame F;
    F.lds = (LAS unsigned char*)lds;
    F.MISC = (volatile LAS unsigned*)(F.lds + MISC_OFF);
    F.tid = threadIdx.x; F.lane = F.tid & 63; F.wave = __builtin_amdgcn_readfirstlane(F.tid >> 6); F.G = gridDim.x;
    F.ws = args.ws;
    for (int u = F.tid; u < (LDS_BYTES - LDSCTL_OFF) / 4; u += NWAVES * 64) ((LAS unsigned*)(F.lds + LDSCTL_OFF))[u] = 0u;
    __syncthreads();
    XcdBarrier bar = xcd_barrier_post((unsigned*)(F.ws + WS_CTL) + CW_BAR + args.li * XCD_BAR_WORDS, F.MISC + 8);
    const int lo = args.ph_lo, hi = args.ph_hi;
#define RUN(p) (lo <= (p) && (p) < hi)
#define SEAM(p) do { if ((p) + 1 < hi) xcd_barrier(bar); } while (0)
    if (RUN(0)) { p0_prologue(F, args); SEAM(0); }
    for (int l = 0; l < DEPTH; ++l) {
        const int p0 = 1 + 10 * l;
        { int t_ = threadIdx.x; asm volatile("" : "+v"(t_)); F.tid = t_; F.lane = t_ & 63; F.wave = __builtin_amdgcn_readfirstlane(t_ >> 6); }
        const float* xcur = (l == 0) ? args.in[I_X] : args.out;
        if (RUN(p0 + 0)) { norm_phase<true>(F, xcur, args.in[I_NMIX] + l * DM, WSP(float, WS_W16T) + (size_t)l * 16 * DM, args.in[I_BIG] + l * 8, args.in[I_BFG] + l * 8); SEAM(p0 + 0); }
        if (RUN(p0 + 1)) {
            pg8::Gemm g{WSP(bf16, WS_H), WSP(bf16, WS_WIN) + (size_t)l * NZ * DM, M, NZ, DM}; pg8::StaticOrder S; S.init(M, NZ, F.G, (int)blockIdx.x);
            pg8::EpiBf16 E{WSP(bf16, WS_Z), NZ};
            pg8::gemm_phase<pg8::EpiBf16, pg8::StaticOrder, true, true>(F.lds + RING_OFF, g, S, E);
            SEAM(p0 + 1); }
        if (RUN(p0 + 2)) { prep_phase(F, args.in[I_QN] + l * 128, args.in[I_KN] + l * 128); SEAM(p0 + 2); }
        if (RUN(p0 + 3)) { mix_phase_scalar(F, args.in[I_RGN] + l * 1024, args.in[I_MLN] + l * 1024); SEAM(p0 + 3); }
        if (RUN(p0 + 4)) {
            pg8::StaticOrder S; S.init(M, DM, F.G, (int)blockIdx.x);
            { pg8::Gemm g{WSP(bf16, WS_Y), WSP(bf16, WS_WP) + ((size_t)l * 3 + 0) * DM * 1024, M, DM, 1024}; pg8::EpiGateAcc<true> E{WSP(bf16, WS_MG), DM, WSP(bf16, WS_Z) + Z_GA, NZ};
              pg8::gemm_phase<pg8::EpiGateAcc<true>, pg8::StaticOrder, true, true>(F.lds + RING_OFF, g, S, E); }
            for (int br = 1; br < 3; ++br) { __syncthreads();
              pg8::Gemm g{WSP(bf16, WS_Y) + (size_t)br * M * 1024, WSP(bf16, WS_WP) + ((size_t)l * 3 + br) * DM * 1024, M, DM, 1024}; pg8::EpiGateAcc<false> E{WSP(bf16, WS_MG), DM, WSP(bf16, WS_Z) + Z_GA + br * DM, NZ};
              pg8::gemm_phase<pg8::EpiGateAcc<false>, pg8::StaticOrder, true, true>(F.lds + RING_OFF, g, S, E); }
            SEAM(p0 + 4); }
        if (RUN(p0 + 5)) {
            pg8::Gemm g{WSP(bf16, WS_MG), WSP(bf16, WS_WOUT) + (size_t)l * DM * DM, M, DM, DM}; pg8::StaticOrder S; S.init(M, DM, F.G, (int)blockIdx.x);
            pg8::EpiResF32 E{xcur, args.out, DM};
            pg8::gemm_phase<pg8::EpiResF32, pg8::StaticOrder, true, true>(F.lds + RING_OFF, g, S, E);
            SEAM(p0 + 5); }
        if (RUN(p0 + 6)) { norm_phase<false>(F, args.out, args.in[I_NFFN] + l * DM, nullptr, nullptr, nullptr); SEAM(p0 + 6); }
        if (RUN(p0 + 7)) {
            pg8::Gemm g{WSP(bf16, WS_H), WSP(bf16, WS_WUP) + (size_t)l * NUP * DM, M, NUP, DM}; pg8::StaticOrder S; S.init(M, NUP, F.G, (int)blockIdx.x);
            pg8::EpiBf16 E{WSP(bf16, WS_Z), NUP};
            pg8::gemm_phase<pg8::EpiBf16, pg8::StaticOrder, true, true>(F.lds + RING_OFF, g, S, E);
            SEAM(p0 + 7); }
        if (RUN(p0 + 8)) { glu_phase(F, args.in[I_CW] + (size_t)l * 3 * NUP, args.in[I_CB] + (size_t)l * NUP); SEAM(p0 + 8); }
        if (RUN(p0 + 9)) {
            pg8::Gemm g{WSP(bf16, WS_ACT), WSP(bf16, WS_WDN) + (size_t)l * DM * DFF, M, DM, DFF}; pg8::StaticOrder S; S.init(M, DM, F.G, (int)blockIdx.x);
            pg8::EpiResF32 E{args.out, args.out, DM};
            pg8::gemm_phase<pg8::EpiResF32, pg8::StaticOrder, true, true>(F.lds + RING_OFF, g, S, E);
            SEAM(p0 + 9); }
    }
#undef RUN
#undef SEAM
}

#ifndef MK_N_LAUNCHES
#define MK_N_LAUNCHES 1
#endif
extern "C" void kernel_launch(void* const* d_in, const int* in_sizes, int n_in, void* d_out, int out_size, void* d_ws, size_t ws_size, hipStream_t stream) {
    static int grid = 0;
    if (grid == 0) {
        if (n_in != 18 || in_sizes[0] != M * DM || out_size != M * DM || ws_size < WS_END) { fprintf(stderr, "kernel_launch: unexpected shapes (n_in %d, in0 %d, out %d, ws %zu)\n", n_in, n_in > 0 ? in_sizes[0] : -1, out_size, ws_size); grid = -1; return; }
        int dev = 0, cus = 0, per_cu = 0;
        if (hipGetDevice(&dev) != hipSuccess || hipDeviceGetAttribute(&cus, hipDeviceAttributeMultiprocessorCount, dev) != hipSuccess) { grid = -1; return; }
        if (hipFuncSetAttribute((const void*)fwd, hipFuncAttributeMaxDynamicSharedMemorySize, LDS_BYTES) != hipSuccess) { fprintf(stderr, "kernel_launch: hipFuncSetAttribute failed\n"); grid = -1; return; }
        if (hipOccupancyMaxActiveBlocksPerMultiprocessor(&per_cu, (const void*)fwd, NWAVES * 64, LDS_BYTES) != hipSuccess || per_cu < 1) fprintf(stderr, "kernel_launch: occupancy query reports %d\n", per_cu);
        (void)hipGetLastError();
        grid = cus;
    }
    if (grid < 0) return;
    if (hipMemsetAsync((char*)d_ws + WS_CTL, 0, CTL_ZERO_BYTES, stream) != hipSuccess) return;
    Args a{};
    for (int i = 0; i < 18; ++i) a.in[i] = (const float*)d_in[i];
    a.out = (float*)d_out; a.ws = (unsigned char*)d_ws; a.pad = 0;
    constexpr int NL = MK_N_LAUNCHES;
    for (int li = 0; li < NL; ++li) {
        a.ph_lo = (NL == 1) ? 0 : li; a.ph_hi = (NL == 1) ? N_PHASES : li + 1; a.li = (NL == 1) ? 0 : 0;
        hipLaunchKernelGGL(fwd, dim3(grid), dim3(NWAVES * 64), LDS_BYTES, stream, a);
    }
}
```

```cpp
#include <hip/hip_runtime.h>
#include <cstdio>
#include <cstdint>
namespace pg8 {
#define PG8_LAS __attribute__((address_space(3)))
typedef unsigned short bf16_t;
typedef short bf16x8 __attribute__((ext_vector_type(8)));
typedef float f32x4 __attribute__((ext_vector_type(4)));
typedef unsigned u32x4 __attribute__((ext_vector_type(4)));
constexpr int BM = 256, BK = 64, HALF = 128, HTB = HALF * BK * 2  , STAGE_BYTES = 8 * HTB, NXCD = 8, WGM = 8;

__host__ __device__ __forceinline__ int lds_byte(int r, int c) { const int st = (r >> 4) * 2 + (c >> 5), rr = r & 15, cc = c & 31, ob = rr * 64 + cc * 2; return st * 1024 + (ob ^ (((ob >> 9) & 1) << 5)); }
__host__ __device__ __forceinline__ void stage_rc(int b, int& R, int& C) { const int st = b / 1024, sb = b % 1024, swz = sb ^ (((sb >> 9) & 1) << 5); R = (st >> 1) * 16 + swz / 64; C = (st & 1) * 32 + (swz % 64) / 2; }
__host__ __device__ __forceinline__ int perm32(int rho) { const int n = rho >> 4, i = rho & 15; return 8 * (i >> 2) + 4 * n + (i & 3); }

struct Unit { int pm, pn; };
struct Gemm { const bf16_t* A; const bf16_t* Bt; int M, N, K; };

struct StaticOrder {
    int nM, nN, nwg, G, c;
    __host__ __device__ void init(int M, int N, int G_, int c_) { nM = M / BM; nN = N / BM; nwg = nM * nN; G = G_; c = c_; }
    __host__ __device__ bool next(int i, Unit& u) const {
        const long L = (long)i * G + c; if (L >= nwg) return false;
        int wgid = (int)L; { const int q = nwg / NXCD, r = nwg % NXCD, xcd = wgid % NXCD, off = wgid / NXCD; wgid = (xcd < r ? xcd * (q + 1) : r * (q + 1) + (xcd - r) * q) + off; }
        const int nig = WGM * nN, gid = wgid / nig, fm = gid * WGM, gsz = (nM - fm) < WGM ? (nM - fm) : WGM;
        u.pm = fm + ((wgid % nig) % gsz); u.pn = (wgid % nig) / gsz; return true;
    }
    __device__ __forceinline__ void a_ready(const Unit&) const {}
    __device__ __forceinline__ void done(const Unit&) const {}
};

__device__ __forceinline__ unsigned cvt_pk_bf16(float lo, float hi) { unsigned r; asm volatile("v_cvt_pk_bf16_f32 %0, %1, %2" : "=v"(r) : "v"(lo), "v"(hi)); return r; }
struct EpiBf16 {
    static constexpr bool PERM = true, AFTER_DRAIN = false;
    bf16_t* O; int ldc;
    __device__ __forceinline__ void operator()(const f32x4 (&acc)[2][2][4][2], const Unit& u, int wr, int wc, int fr, int fq) const {
        const int row0 = u.pm * BM + wr * 64 + fr; const int col0 = u.pn * BM + wc * 32 + 8 * fq;
#pragma unroll
        for (int ai = 0; ai < 2; ++ai)
#pragma unroll
            for (int m = 0; m < 4; ++m) { bf16_t* rowp = O + (size_t)(row0 + ai * HALF + m * 16) * ldc + col0;
#pragma unroll
                for (int bj = 0; bj < 2; ++bj) { const f32x4 v0 = acc[ai][bj][m][0], v1 = acc[ai][bj][m][1];
                    u32x4 w; w.x = cvt_pk_bf16(v0[0], v0[1]); w.y = cvt_pk_bf16(v0[2], v0[3]); w.z = cvt_pk_bf16(v1[0], v1[1]); w.w = cvt_pk_bf16(v1[2], v1[3]);
                    *(u32x4*)(rowp + bj * HALF) = w; } }
    }
};
__device__ __forceinline__ float bf_lo(unsigned w) { return __uint_as_float(w << 16); }
__device__ __forceinline__ float bf_hi(unsigned w) { return __uint_as_float(w & 0xffff0000u); }
__device__ __forceinline__ float sigmoid_f(float x) { return __builtin_amdgcn_rcpf(1.0f + __expf(-x)); }
template <bool FIRST> struct EpiGateAcc {
    static constexpr bool PERM = true, AFTER_DRAIN = false;
    bf16_t* O; int ldc; const bf16_t* G; int ldg;
    __device__ __forceinline__ void operator()(const f32x4 (&acc)[2][2][4][2], const Unit& u, int wr, int wc, int fr, int fq) const {
        const int row0 = u.pm * BM + wr * 64 + fr; const int col0 = u.pn * BM + wc * 32 + 8 * fq;
#pragma unroll
        for (int ai = 0; ai < 2; ++ai)
#pragma unroll
            for (int m = 0; m < 4; ++m) { const size_t row = (size_t)(row0 + ai * HALF + m * 16);
#pragma unroll
                for (int bj = 0; bj < 2; ++bj) { const f32x4 v0 = acc[ai][bj][m][0], v1 = acc[ai][bj][m][1];
                    const u32x4 g = *(const u32x4*)(G + row * ldg + col0 + bj * HALF);
                    u32x4 p = (u32x4){0u, 0u, 0u, 0u};
                    if (!FIRST) p = *(const u32x4*)(O + row * ldc + col0 + bj * HALF);
                    float o[8];
                    o[0] = bf_lo(p.x) + sigmoid_f(bf_lo(g.x)) * v0[0]; o[1] = bf_hi(p.x) + sigmoid_f(bf_hi(g.x)) * v0[1];
                    o[2] = bf_lo(p.y) + sigmoid_f(bf_lo(g.y)) * v0[2]; o[3] = bf_hi(p.y) + sigmoid_f(bf_hi(g.y)) * v0[3];
                    o[4] = bf_lo(p.z) + sigmoid_f(bf_lo(g.z)) * v1[0]; o[5] = bf_hi(p.z) + sigmoid_f(bf_hi(g.z)) * v1[1];
                    o[6] = bf_lo(p.w) + sigmoid_f(bf_lo(g.w)) * v1[2]; o[7] = bf_hi(p.w) + sigmoid_f(bf_hi(g.w)) * v1[3];
                    u32x4 w; w.x = cvt_pk_bf16(o[0], o[1]); w.y = cvt_pk_bf16(o[2], o[3]); w.z = cvt_pk_bf16(o[4], o[5]); w.w = cvt_pk_bf16(o[6], o[7]);
                    *(u32x4*)(O + row * ldc + col0 + bj * HALF) = w; } }
    }
};
struct EpiResF32 {
    static constexpr bool PERM = false, AFTER_DRAIN = false;
    const float* base; float* out; int ldc;
    __device__ __forceinline__ void operator()(const f32x4 (&acc)[2][2][4][2], const Unit& u, int wr, int wc, int fr, int fq) const {
        const int col0 = u.pn * BM + wc * 32 + 4 * fq;
#pragma unroll
        for (int ai = 0; ai < 2; ++ai)
#pragma unroll
            for (int m = 0; m < 4; ++m) { const size_t off = (size_t)(u.pm * BM + ai * HALF + wr * 64 + m * 16 + fr) * ldc + col0;
#pragma unroll
                for (int bj = 0; bj < 2; ++bj)
#pragma unroll
                    for (int n = 0; n < 2; ++n) { const f32x4 bs = *(const f32x4*)(base + off + bj * HALF + n * 16); *(f32x4*)(out + off + bj * HALF + n * 16) = bs + acc[ai][bj][m][n]; } }
    }
};

template <class Epi, class Sched, bool ALIGN_EPI = false, bool SP2 = false>
__device__ __forceinline__ void gemm_phase(PG8_LAS unsigned char* lds, const Gemm g, const Sched& S, const Epi& E) {
    int tid_ = threadIdx.x; asm volatile("" : "+v"(tid_));
    const int tid = tid_, wid = __builtin_amdgcn_readfirstlane(tid >> 6), lane = tid & 63, wr = wid >> 2, wc = wid & 3, fr = lane & 15, fq = lane >> 4;
    const int K = g.K, nt = K / BK;
    unsigned voffA[2], voffB[2];
#pragma unroll
    for (int i = 0; i < 2; ++i) { int R, C; stage_rc(tid * 16 + i * 8192, R, C); const int Rb = Epi::PERM ? ((R & ~31) + perm32(R & 31)) : R;
        voffA[i] = (unsigned)(R * K + C) * 2u; voffB[i] = (unsigned)(Rb * K + C) * 2u; }
    const size_t kstep = (size_t)(BK * 2);
    const size_t hstep = (size_t)HALF * K * 2;
    const size_t tstep = 2 * hstep;
    const unsigned ldsw = (unsigned)wid * 1024u;
    const int aoff = lds_byte(wr * 64 + fr, fq * 8), boff = lds_byte(wc * 32 + fr, fq * 8);
#define PG8_SA(b, h) (((b) * 2 + (h)) * HTB)
#define PG8_SB(b, h) ((4 + (b) * 2 + (h)) * HTB)
#define PG8_STAGE(bufoff, gbase, voff) do { _Pragma("unroll") for (int _i = 0; _i < 2; ++_i) \
        __builtin_amdgcn_global_load_lds((const unsigned*)((const char*)(gbase) + (voff)[_i]), (PG8_LAS unsigned*)(lds + (bufoff) + ldsw + _i * 8192), 16, 0, 0); } while (0)
#define PG8_LDA(dst, b, h) do { _Pragma("unroll") for (int m = 0; m < 4; ++m) _Pragma("unroll") for (int k = 0; k < 2; ++k) dst[m][k] = *(const PG8_LAS bf16x8*)(lds + PG8_SA(b, h) + aoff + m * 2048 + k * 1024); } while (0)
#define PG8_LDB(dst, b, h) do { _Pragma("unroll") for (int n = 0; n < 2; ++n) _Pragma("unroll") for (int k = 0; k < 2; ++k) dst[n][k] = *(const PG8_LAS bf16x8*)(lds + PG8_SB(b, h) + boff + n * 2048 + k * 1024); } while (0)
#define PG8_MMA(ai, bj, At, Bt) do { __builtin_amdgcn_s_setprio(1); _Pragma("unroll") for (int m = 0; m < 4; ++m) _Pragma("unroll") for (int n = 0; n < 2; ++n) _Pragma("unroll") for (int k = 0; k < 2; ++k) \
        acc[ai][bj][m][n] = __builtin_amdgcn_mfma_f32_16x16x32_bf16(Bt[n][k], At[m][k], acc[ai][bj][m][n], 0, 0, 0); __builtin_amdgcn_s_setprio(0); } while (0)
#define PG8_WAIT_V(n) asm volatile("s_waitcnt vmcnt(" #n ")" ::: "memory")
#define PG8_WAIT_L(n) asm volatile("s_waitcnt lgkmcnt(" #n ")" ::: "memory")
#define PG8_BAR __builtin_amdgcn_s_barrier()
#define PG8_SCHED __builtin_amdgcn_sched_barrier(0)
    Unit cur, nxt; int ui = 0;
    if (!S.next(0, cur)) return;
    f32x4 acc[2][2][4][2];
#pragma unroll
    for (int a = 0; a < 2; ++a)
#pragma unroll
        for (int b = 0; b < 2; ++b)
#pragma unroll
            for (int m = 0; m < 4; ++m)
#pragma unroll
                for (int n = 0; n < 2; ++n) acc[a][b][m][n] = (f32x4){0.f, 0.f, 0.f, 0.f};
    bf16x8 At[4][2], B0[2][2], B1[2][2];
    const char* cA = (const char*)g.A + (size_t)cur.pm * tstep; const char* cB = (const char*)g.Bt + (size_t)cur.pn * tstep;
    S.a_ready(cur);
    if constexpr (SP2) {
        PG8_STAGE(PG8_SB(0, 0), cB, voffB); PG8_STAGE(PG8_SB(0, 1), cB + hstep, voffB); PG8_STAGE(PG8_SA(0, 0), cA, voffA); PG8_STAGE(PG8_SA(0, 1), cA + hstep, voffA);
        if (wr == 1) PG8_BAR;
        PG8_WAIT_V(2); PG8_BAR;
        PG8_STAGE(PG8_SB(1, 0), cB + kstep, voffB); PG8_STAGE(PG8_SA(1, 0), cA + kstep, voffA); PG8_STAGE(PG8_SB(1, 1), cB + hstep + kstep, voffB);
        PG8_WAIT_V(6); PG8_BAR;
    } else {
        PG8_STAGE(PG8_SB(0, 0), cB, voffB); PG8_STAGE(PG8_SA(0, 0), cA, voffA); PG8_STAGE(PG8_SB(0, 1), cB + hstep, voffB); PG8_STAGE(PG8_SA(0, 1), cA + hstep, voffA);
        if (wr == 1) PG8_BAR;
        PG8_WAIT_V(4); PG8_BAR;
        PG8_STAGE(PG8_SB(1, 0), cB + kstep, voffB); PG8_STAGE(PG8_SA(1, 0), cA + kstep, voffA); PG8_STAGE(PG8_SB(1, 1), cB + hstep + kstep, voffB);
        PG8_WAIT_V(6); PG8_BAR;
    }
    for (;;) {
        const bool has_next = S.next(ui + 1, nxt);
        const char* nA = has_next ? (const char*)g.A + (size_t)nxt.pm * tstep : cA; const char* nB = has_next ? (const char*)g.Bt + (size_t)nxt.pn * tstep : cB;
        for (int t = 0; t < nt; t += 2) {
            const bool last = (t == nt - 2);
            const char* a1 = cA + (size_t)(t + 1) * kstep;
            const char* a2 = last ? nA : cA + (size_t)(t + 2) * kstep; const char* b2 = last ? nB : cB + (size_t)(t + 2) * kstep;
            const char* a3 = a2 + kstep; const char* b3 = b2 + kstep;
            if (last && has_next) S.a_ready(nxt);
            if constexpr (SP2) {
            PG8_LDB(B0, 0, 0); PG8_LDB(B1, 0, 1); PG8_SCHED; PG8_LDA(At, 0, 0); PG8_STAGE(PG8_SA(1, 1), a1 + hstep, voffA);
            PG8_WAIT_V(8); PG8_WAIT_L(0); PG8_BAR; PG8_MMA(0, 0, At, B0); PG8_MMA(0, 1, At, B1); PG8_BAR; PG8_SCHED;
            PG8_LDA(At, 0, 1); PG8_STAGE(PG8_SB(0, 0), b2, voffB); PG8_STAGE(PG8_SB(0, 1), b2 + hstep, voffB); PG8_STAGE(PG8_SA(0, 0), a2, voffA);
            PG8_WAIT_V(8); PG8_WAIT_L(0); PG8_BAR; PG8_MMA(1, 0, At, B0); PG8_MMA(1, 1, At, B1); PG8_BAR; PG8_SCHED;
            PG8_LDB(B0, 1, 0); PG8_LDB(B1, 1, 1); PG8_SCHED; PG8_LDA(At, 1, 0); PG8_STAGE(PG8_SA(0, 1), a2 + hstep, voffA);
            PG8_WAIT_V(8); PG8_WAIT_L(0); PG8_BAR; PG8_MMA(0, 0, At, B0); PG8_MMA(0, 1, At, B1); PG8_BAR; PG8_SCHED;
            PG8_LDA(At, 1, 1); PG8_STAGE(PG8_SB(1, 0), b3, voffB); PG8_STAGE(PG8_SB(1, 1), b3 + hstep, voffB); PG8_STAGE(PG8_SA(1, 0), a3, voffA);
            PG8_WAIT_V(8); PG8_WAIT_L(0); PG8_BAR; PG8_MMA(1, 0, At, B0); PG8_MMA(1, 1, At, B1); PG8_BAR; PG8_SCHED;
            } else {
            PG8_LDB(B0, 0, 0); PG8_SCHED; PG8_LDA(At, 0, 0); PG8_STAGE(PG8_SA(1, 1), a1 + hstep, voffA);
            PG8_WAIT_L(8); PG8_BAR; PG8_WAIT_L(0); PG8_MMA(0, 0, At, B0); PG8_BAR; PG8_SCHED;
            PG8_LDB(B1, 0, 1); PG8_STAGE(PG8_SB(0, 0), b2, voffB);
            PG8_BAR; PG8_WAIT_L(0); PG8_MMA(0, 1, At, B1); PG8_BAR;
            PG8_LDA(At, 0, 1); PG8_STAGE(PG8_SA(0, 0), a2, voffA);
            PG8_BAR; PG8_WAIT_L(0); PG8_MMA(1, 0, At, B0); PG8_BAR; PG8_SCHED;
            PG8_STAGE(PG8_SB(0, 1), b2 + hstep, voffB);
            PG8_WAIT_V(6); PG8_BAR; PG8_MMA(1, 1, At, B1); PG8_BAR;
            PG8_LDB(B0, 1, 0); PG8_SCHED; PG8_LDA(At, 1, 0); PG8_STAGE(PG8_SA(0, 1), a2 + hstep, voffA);
            PG8_WAIT_L(8); PG8_BAR; PG8_WAIT_L(0); PG8_MMA(0, 0, At, B0); PG8_BAR; PG8_SCHED;
            PG8_LDB(B1, 1, 1); PG8_STAGE(PG8_SB(1, 0), b3, voffB);
            PG8_BAR; PG8_WAIT_L(0); PG8_MMA(0, 1, At, B1); PG8_BAR;
            PG8_LDA(At, 1, 1); PG8_STAGE(PG8_SA(1, 0), a3, voffA);
            PG8_BAR; PG8_WAIT_L(0); PG8_MMA(1, 0, At, B0); PG8_BAR; PG8_SCHED;
            PG8_STAGE(PG8_SB(1, 1), b3 + hstep, voffB);
            PG8_WAIT_V(6); PG8_BAR; PG8_MMA(1, 1, At, B1); PG8_BAR;
            }
        }
        if constexpr (ALIGN_EPI) { if (wr == 0) PG8_BAR; }
        if constexpr (!Epi::AFTER_DRAIN) { E(acc, cur, wr, wc, fr, fq); S.done(cur); }
        if (!has_next) break;
#pragma unroll
        for (int a = 0; a < 2; ++a)
#pragma unroll
            for (int b = 0; b < 2; ++b)
#pragma unroll
                for (int m = 0; m < 4; ++m)
#pragma unroll
                    for (int n = 0; n < 2; ++n) acc[a][b][m][n] = (f32x4){0.f, 0.f, 0.f, 0.f};
        cur = nxt; cA = nA; cB = nB; ++ui;
        if constexpr (ALIGN_EPI) { if (wr == 1) PG8_BAR; }
    }
    PG8_WAIT_V(0);
    if constexpr (!ALIGN_EPI) { if (wr == 0) PG8_BAR; }
    PG8_BAR;
    if constexpr (Epi::AFTER_DRAIN) { E.fused(acc, cur, wr, wc, fr, fq, lds, wid, lane); S.done(cur); }
#undef PG8_SA
#undef PG8_SB
#undef PG8_STAGE
#undef PG8_LDA
#undef PG8_LDB
#undef PG8_MMA
#undef PG8_WAIT_V
#undef PG8_WAIT_L
#undef PG8_BAR
#undef PG8_SCHED
}
}

constexpr int NWAVES = 8;
constexpr int BATCH = 8, SEQ = 2048, DM = 2048, DEPTH = 4, M = BATCH * SEQ, NH = 8;
constexpr int NIN = 16400, NZ = 16384, DFF = 5632, NUP = 2 * DFF, NY = 3072;
constexpr int Z_RQ = 0, Z_RK = 1024, Z_RV = 2048, Z_RG = 3072, Z_MQ = 4096, Z_MK = 4608, Z_MV = 5120, Z_MO = 6144, Z_AQ = 7168, Z_AK = 8192, Z_AV = 9216, Z_GA = 10240, Z_GB = 12288, Z_GC = 14336;
constexpr int W_GATE_COL = 7168;
constexpr size_t MiB = 1u << 20;
constexpr size_t WS_CTL = 0, CTL_ZERO_BYTES = 1 * MiB;
constexpr size_t WS_TAB = 2 * MiB;
constexpr size_t WS_W16T = 4 * MiB;
constexpr size_t WS_KMEAN = 5 * MiB;
constexpr size_t WS_GIF = 6 * MiB;
constexpr size_t WS_WIN = 8 * MiB;
constexpr size_t WS_WP = 264 * MiB;
constexpr size_t WS_WOUT = 312 * MiB;
constexpr size_t WS_WUP = 344 * MiB;
constexpr size_t WS_WDN = 520 * MiB;
constexpr size_t WS_H = 608 * MiB;
constexpr size_t WS_Z = 672 * MiB;
constexpr size_t WS_Y = 1184 * MiB;
constexpr size_t WS_MG = 1280 * MiB;
constexpr size_t WS_ACT = 1344 * MiB;
constexpr size_t WS_END = 1520 * MiB;
constexpr int CW_TMO = 0, CW_CODE = 1;
constexpr int CW_BAR = 4096;
constexpr int RING_OFF = 0, RING_BYTES = 131072;
constexpr int LDS_BYTES = 163840;
constexpr int LDSCTL_OFF = LDS_BYTES - 512, MISC_OFF = LDSCTL_OFF + 320;
static_assert(MISC_OFF + 128 <= LDS_BYTES, "LDS map");

#define GAS __attribute__((address_space(1)))
#define LAS __attribute__((address_space(3)))
typedef unsigned short bf16;
typedef unsigned v4u __attribute__((ext_vector_type(4)));
typedef unsigned v2u __attribute__((ext_vector_type(2)));
typedef float f32x4 __attribute__((ext_vector_type(4)));
typedef float f32x2 __attribute__((ext_vector_type(2)));
typedef GAS unsigned gu32;
#define RLX_AGENT __ATOMIC_RELAXED, __HIP_MEMORY_SCOPE_AGENT
#define LDS_WAIT() asm volatile("s_waitcnt lgkmcnt(0)" ::: "memory")
#define VM_WAIT() asm volatile("s_waitcnt vmcnt(0)" ::: "memory")
__device__ __forceinline__ unsigned f2bf(float f) { unsigned u = __builtin_bit_cast(unsigned, f); return (u + 0x7fffu + ((u >> 16) & 1u)) >> 16; }
__device__ __forceinline__ unsigned pk2(float lo, float hi) { return f2bf(lo) | (f2bf(hi) << 16); }
__device__ __forceinline__ float bflo(unsigned w) { return __uint_as_float(w << 16); }
__device__ __forceinline__ float bfhi(unsigned w) { return __uint_as_float(w & 0xffff0000u); }
__device__ __forceinline__ float bf1(bf16 v) { return __uint_as_float((unsigned)v << 16); }
__device__ __forceinline__ float sigm(float x) { return 1.0f / (1.0f + __expf(-x)); }

#define MX_RET 1
#define MX_ML 1
#define MX_MOBA 1
#define XB_TMO      128
#define XB_XCNT(j)  (256  + 64 * (j))
#define XB_XSUB(j)  (1280 + 64 * (j))
#define XB_XGEN(j)  (2304 + 64 * (j))
#define XB_TOP      3328
#define XB_TOPGEN   3392
#define XCD_BAR_WORDS 3456
#define XB_SPIN_CAP (1u << 18)

__device__ __forceinline__ unsigned xb_ld(unsigned* p)              { return __hip_atomic_load(p, __ATOMIC_RELAXED, __HIP_MEMORY_SCOPE_AGENT); }
__device__ __forceinline__ unsigned xb_add(unsigned* p, unsigned v) { return __hip_atomic_fetch_add(p, v, __ATOMIC_RELAXED, __HIP_MEMORY_SCOPE_AGENT); }
__device__ __forceinline__ unsigned xb_xcc_id() { return (unsigned)__builtin_amdgcn_s_getreg((3 << 11) | 20) & 0xFu; }
#define XB_SPIN(cond, bar) do { unsigned _sp = 0; while (cond) { __builtin_amdgcn_s_sleep(1); \
    if ((++_sp & 255u) == 0u) { if (xb_ld(&(bar)[XB_TMO])) break; if (_sp > XB_SPIN_CAP) { atomicAdd(&(bar)[XB_TMO], 1u); break; } } } } while (0)

struct XcdBarrier {
    unsigned* bar; unsigned x;
    volatile LAS unsigned* st;
};

__device__ __forceinline__ XcdBarrier xcd_barrier_post(unsigned* bar, volatile LAS unsigned* st) {
    XcdBarrier b; b.bar = bar; b.x = xb_xcc_id(); b.st = st;
    if (threadIdx.x == 0) (void)xb_add(&bar[XB_XCNT(b.x)], 1u);
    return b;
}
__device__ __forceinline__ void xcd_barrier_complete(unsigned* bar, unsigned x, unsigned& nloc, unsigned& nx) {
    const unsigned G = gridDim.x * gridDim.y * gridDim.z;
    unsigned sum, cnt, mine, sp = 0u;
    for (;;) {
        sum = 0u; cnt = 0u; mine = 0u;
#pragma unroll
        for (unsigned j = 0; j < 16; ++j) { const unsigned c = xb_ld(&bar[XB_XCNT(j)]); sum += c; cnt += (c > 0u) ? 1u : 0u; mine = (j == x) ? c : mine; }
        if (sum == G) break;
        __builtin_amdgcn_s_sleep(1);
        if ((++sp & 255u) == 0u) { if (xb_ld(&bar[XB_TMO])) break; if (sp > XB_SPIN_CAP) { atomicAdd(&bar[XB_TMO], 1u); break; } }
    }
    nloc = mine > 0u ? mine : 1u; nx = cnt > 0u ? cnt : 1u;
}

__device__ __forceinline__ void xcd_barrier(const XcdBarrier& b) {
    asm volatile("s_waitcnt vmcnt(0)" ::: "memory");
    __syncthreads();
    if (threadIdx.x == 0) {
        unsigned* bar = b.bar;
        __builtin_amdgcn_s_waitcnt(0);
        unsigned nloc = b.st[0], nx = b.st[1];
        if (nloc == 0u) { xcd_barrier_complete(bar, b.x, nloc, nx); b.st[0] = nloc; b.st[1] = nx; }
        const unsigned old = xb_add(&bar[XB_XSUB(b.x)], 1u);
        const unsigned gen = old / nloc;
        if (old + 1u == (gen + 1u) * nloc) {
            __builtin_amdgcn_fence(__ATOMIC_RELEASE, "agent");
            asm volatile("s_waitcnt vmcnt(0)" ::: "memory");
            const unsigned og = xb_add(&bar[XB_TOP], 1u);
            const unsigned tg = og / nx;
            if (og + 1u == (tg + 1u) * nx) xb_add(&bar[XB_TOPGEN], 1u);
            else XB_SPIN(xb_ld(&bar[XB_TOPGEN]) == tg, bar);
            __builtin_amdgcn_fence(__ATOMIC_ACQUIRE, "agent");
            xb_add(&bar[XB_XGEN(b.x)], 1u);
            asm volatile("s_waitcnt vmcnt(0)" ::: "memory");
        } else {
            XB_SPIN(xb_ld(&bar[XB_XGEN(b.x)]) == gen, bar);
            __builtin_amdgcn_fence(__ATOMIC_ACQUIRE, "agent");
            asm volatile("s_waitcnt vmcnt(0)" ::: "memory");
        }
    }
    __syncthreads();
}

struct Args { const float* in[18]; float* out; unsigned char* ws; int ph_lo, ph_hi, li, pad; };
enum { I_X = 0, I_WIN, I_BIG, I_BFG, I_NMIX, I_RGN, I_MLN, I_QN, I_KN, I_WPA, I_WPB, I_WPC, I_WOUT, I_NFFN, I_WUP, I_CW, I_CB, I_WDN };
struct Frame {
    LAS unsigned char* lds;
    volatile LAS unsigned* MISC;
    unsigned char* ws;
    int tid, lane, wave, G, bx;
};
#define WSP(T, off) ((T*)(F.ws + (off)))
__device__ __forceinline__ float wave_sum(float v) {
#pragma unroll
    for (int o = 1; o < 64; o <<= 1) v += __shfl_xor(v, o);
    return v;
}
__device__ __forceinline__ float wave_max(float v) {
#pragma unroll
    for (int o = 1; o < 64; o <<= 1) v = fmaxf(v, __shfl_xor(v, o));
    return v;
}
__device__ __forceinline__ void p0_transpose_item(const float* W, int ldw, int K, int nblk, bf16* WT, LAS float* scr, int item, int lane) {
    const int kb = item / nblk, nb = item % nblk, k0 = 64 * kb, n0 = 32 * nb;
#pragma unroll 8
    for (int i = 0; i < 32; ++i) { const int kk = 2 * i + (lane >> 5); scr[kk * 33 + (lane & 31)] = W[(size_t)(k0 + kk) * ldw + n0 + (lane & 31)]; }
    LDS_WAIT(); asm volatile("" ::: "memory");
    const int c = lane & 7;
#pragma unroll
    for (int j = 0; j < 4; ++j) { const int n = (lane >> 3) + 8 * j; const LAS float* s = scr + (8 * c) * 33 + n;
        v4u o; o.x = pk2(s[0 * 33], s[1 * 33]); o.y = pk2(s[2 * 33], s[3 * 33]); o.z = pk2(s[4 * 33], s[5 * 33]); o.w = pk2(s[6 * 33], s[7 * 33]);
        *(GAS v4u*)(WT + (size_t)(n0 + n) * K + k0 + 8 * c) = o; }
    LDS_WAIT(); asm volatile("" ::: "memory");
}
__device__ __forceinline__ void p0_prologue(Frame& F, const Args& args) {
    LAS float* scr = (LAS float*)(F.lds + RING_OFF + F.wave * 16384);
    const int gw = F.bx * NWAVES + F.wave, NGW = F.G * NWAVES;
    constexpr int I_INA = 32 * 224, I_INB = 32 * 288, I_P = 16 * 64, I_OUT = 32 * 64, I_UP = 32 * 352, I_DN = 88 * 64;
    constexpr int I_LAYER = I_INA + I_INB + 3 * I_P + I_OUT + I_UP + I_DN;
    for (int it = gw; it < DEPTH * I_LAYER; it += NGW) {
        const int l = it / I_LAYER; int r = it % I_LAYER;
        const float* win = args.in[I_WIN] + (size_t)l * DM * NIN; bf16* wint = WSP(bf16, WS_WIN) + (size_t)l * NZ * DM;
        if (r < I_INA) { p0_transpose_item(win, NIN, DM, 224, wint, scr, r, F.lane); continue; } r -= I_INA;
        if (r < I_INB) { p0_transpose_item(win + 7184, NIN, DM, 288, wint + (size_t)7168 * DM, scr, r, F.lane); continue; } r -= I_INB;
        if (r < I_P) { p0_transpose_item(args.in[I_WPA] + (size_t)l * 1024 * DM, DM, 1024, 64, WSP(bf16, WS_WP) + ((size_t)l * 3 + 0) * DM * 1024, scr, r, F.lane); continue; } r -= I_P;
        if (r < I_P) { p0_transpose_item(args.in[I_WPB] + (size_t)l * 1024 * DM, DM, 1024, 64, WSP(bf16, WS_WP) + ((size_t)l * 3 + 1) * DM * 1024, scr, r, F.lane); continue; } r -= I_P;
        if (r < I_P) { p0_transpose_item(args.in[I_WPC] + (size_t)l * 1024 * DM, DM, 1024, 64, WSP(bf16, WS_WP) + ((size_t)l * 3 + 2) * DM * 1024, scr, r, F.lane); continue; } r -= I_P;
        if (r < I_OUT) { p0_transpose_item(args.in[I_WOUT] + (size_t)l * DM * DM, DM, DM, 64, WSP(bf16, WS_WOUT) + (size_t)l * DM * DM, scr, r, F.lane); continue; } r -= I_OUT;
        if (r < I_UP) { p0_transpose_item(args.in[I_WUP] + (size_t)l * DM * NUP, NUP, DM, 352, WSP(bf16, WS_WUP) + (size_t)l * NUP * DM, scr, r, F.lane); continue; } r -= I_UP;
        p0_transpose_item(args.in[I_WDN] + (size_t)l * DFF * DM, DM, DFF, 64, WSP(bf16, WS_WDN) + (size_t)l * DM * DFF, scr, r, F.lane);
    }
    const int gt = F.bx * (NWAVES * 64) + F.tid, NGT = F.G * NWAVES * 64;
    for (int i = gt; i < DEPTH * 16 * DM; i += NGT) { const int l = i / (16 * DM), c = (i / DM) % 16, k = i % DM; WSP(float, WS_W16T)[i] = args.in[I_WIN][((size_t)l * DM + k) * NIN + W_GATE_COL + c]; }
    for (int i = gt; i < 2 * SEQ * 64; i += NGT) { const int which = i / (SEQ * 64), pos = (i / 64) % SEQ, d = i % 64;
        const float ex = which == 0 ? (float)d / 63.0f : (float)(2 * d) / 128.0f;
        const float inv = 1.0f / powf(10000.0f, ex); const float ang = (float)pos * inv; float s, c; sincosf(ang, &s, &c); WSP(f32x2, WS_TAB)[i] = (f32x2){c, s}; }
}
template <bool GATES> __device__ __forceinline__ void norm_phase(Frame& F, const float* x, const float* g, const float* w16t, const float* big, const float* bfg) {
    LAS float* wl = (LAS float*)(F.lds + RING_OFF);
    if (GATES) { for (int i = F.tid; i < 16 * DM / 4; i += NWAVES * 64) ((LAS f32x4*)wl)[i] = ((const f32x4*)w16t)[i]; __syncthreads(); }
    const int gw = F.bx * NWAVES + F.wave, NGW = F.G * NWAVES, lane = F.lane;
    f32x4 gv[8];
#pragma unroll
    for (int j = 0; j < 8; ++j) gv[j] = ((const f32x4*)g)[64 * j + lane];
    for (int m = gw; m < M; m += NGW) {
        const f32x4* xr = (const f32x4*)(x + (size_t)m * DM) + lane;
        f32x4 v[8]; float s = 0.f;
#pragma unroll
        for (int j = 0; j < 8; ++j) { v[j] = xr[64 * j]; s += (v[j].x * v[j].x + v[j].y * v[j].y) + (v[j].z * v[j].z + v[j].w * v[j].w); }
        const float rstd = rsqrtf(wave_sum(s) * (1.f / DM) + 1e-6f);
        v2u* o8 = (v2u*)(WSP(bf16, WS_H) + (size_t)m * DM) + lane;
#pragma unroll
        for (int j = 0; j < 8; ++j) { v[j] = v[j] * rstd * gv[j]; v2u w; w.x = pk2(v[j].x, v[j].y); w.y = pk2(v[j].z, v[j].w); o8[64 * j] = w; }
        if (GATES) {
            float mine = 0.f;
#pragma unroll 1
            for (int c = 0; c < 16; ++c) { float p = 0.f;
#pragma unroll
                for (int j = 0; j < 8; ++j) { const f32x4 w = ((const LAS f32x4*)(wl + c * DM))[64 * j + lane]; p += (v[j].x * w.x + v[j].y * w.y) + (v[j].z * w.z + v[j].w * w.w); }
                p = wave_sum(p); if (lane == c) mine = p; }
            if (lane < 16) { const int hh = lane & 7; float pre = mine + (lane < 8 ? big[hh] : bfg[hh]);
                const float sc = 15.0f * tanhf(pre * (1.0f / 15.0f));
                float o = sc;
                if (lane >= 8) o = sc > 0.f ? -log1pf(__expf(-sc)) : sc - log1pf(__expf(sc));
                WSP(float, WS_GIF)[(size_t)m * 16 + lane] = o; }
        }
    }
}
__device__ __forceinline__ void prep_phase(Frame& F, const float* qn, const float* kn) {
    const int gw = F.bx * NWAVES + F.wave, NGW = F.G * NWAVES, lane = F.lane;
    const f32x2* tret = WSP(f32x2, WS_TAB); const f32x2* trope = WSP(f32x2, WS_TAB) + SEQ * 64;
    const float qn1 = qn[lane], qn2 = qn[lane + 64], kn1 = kn[lane], kn2 = kn[lane + 64];
    for (int m = gw; m < M; m += NGW) {
        const int pos = m & (SEQ - 1); bf16* zr = WSP(bf16, WS_Z) + (size_t)m * NZ;
        const f32x2 cr = tret[pos * 64 + lane], cp = trope[pos * 64 + lane];
        for (int hh = 0; hh < NH; ++hh) {
            if (!MX_RET) {
            { bf16* p = zr + Z_RQ + hh * 128 + lane; const float a = bf1(p[0]), b = bf1(p[64]); p[0] = (bf16)f2bf(a * cr.x - b * cr.y); p[64] = (bf16)f2bf(a * cr.y + b * cr.x); }
            { bf16* p = zr + Z_RK + hh * 128 + lane; const float a = bf1(p[0]) * 0.08838834764831845f, b = bf1(p[64]) * 0.08838834764831845f; p[0] = (bf16)f2bf(a * cr.x - b * cr.y); p[64] = (bf16)f2bf(a * cr.y + b * cr.x); }
            }
            { bf16* p = zr + Z_AQ + hh * 128 + lane; float a = bf1(p[0]), b = bf1(p[64]); const float r = rsqrtf(wave_sum(a * a + b * b) * (1.f / 128.f) + 1e-6f); a *= r * qn1; b *= r * qn2;
              p[0] = (bf16)f2bf(a * cp.x - b * cp.y); p[64] = (bf16)f2bf(a * cp.y + b * cp.x); }
        }
    }
    for (int it = gw; it < BATCH * 8 * NH; it += NGW) {
        const int b = it >> 6, blk = (it >> 3) & 7, hh = it & 7; float s1 = 0.f, s2 = 0.f;
        for (int t = 0; t < 256; ++t) { const int pos = blk * 256 + t; bf16* p = WSP(bf16, WS_Z) + (size_t)(b * SEQ + pos) * NZ + Z_AK + hh * 128 + lane; const f32x2 cp = trope[pos * 64 + lane];
            float a = bf1(p[0]), c = bf1(p[64]); const float r = rsqrtf(wave_sum(a * a + c * c) * (1.f / 128.f) + 1e-6f); a *= r * kn1; c *= r * kn2;
            const float o1 = a * cp.x - c * cp.y, o2 = a * cp.y + c * cp.x; s1 += o1; s2 += o2; p[0] = (bf16)f2bf(o1); p[64] = (bf16)f2bf(o2); }
        float* km = WSP(float, WS_KMEAN) + (size_t)((b * NH + hh) * 8 + blk) * 128; km[lane] = s1 * (1.f / 256.f); km[lane + 64] = s2 * (1.f / 256.f);
    }
}
__device__ __forceinline__ void ret_unit_scalar(Frame& F, const float* gn, int b, int h) {
    LAS float* qs = (LAS float*)(F.lds + RING_OFF); LAS float* ks = qs + 2048; LAS float* vs = ks + 2048; LAS float* part = vs + 2048;
    const int tid = F.tid, lane = F.lane, e = tid & 127, dq = tid >> 7;
    float S[32];
#pragma unroll
    for (int i = 0; i < 32; ++i) S[i] = 0.f;
    const float gamma = 1.0f - exp2f(-5.0f - (float)h);
    const bf16* zb = WSP(bf16, WS_Z) + (size_t)(b * SEQ) * NZ;
    const float gn1 = gn[h * 128 + lane], gn2 = gn[h * 128 + 64 + lane];
    for (int t0 = 0; t0 < SEQ; t0 += 16) {
        { const int tt = tid >> 5, d4 = (tid & 31) * 4; const bf16* zr = zb + (size_t)(t0 + tt) * NZ + h * 128 + d4;
          const v2u qv = *(const v2u*)(zr + Z_RQ), kv = *(const v2u*)(zr + Z_RK), vv = *(const v2u*)(zr + Z_RV);
          *(LAS f32x4*)(qs + tt * 128 + d4) = (f32x4){bflo(qv.x), bfhi(qv.x), bflo(qv.y), bfhi(qv.y)};
          *(LAS f32x4*)(ks + tt * 128 + d4) = (f32x4){bflo(kv.x), bfhi(kv.x), bflo(kv.y), bfhi(kv.y)};
          *(LAS f32x4*)(vs + tt * 128 + d4) = (f32x4){bflo(vv.x), bfhi(vv.x), bflo(vv.y), bfhi(vv.y)}; }
        __syncthreads();
        for (int tt = 0; tt < 16; ++tt) {
            const float v = vs[tt * 128 + e]; float acc = 0.f;
#pragma unroll
            for (int i = 0; i < 32; ++i) { const float kd = ks[tt * 128 + dq * 32 + i], qd = qs[tt * 128 + dq * 32 + i]; S[i] = gamma * S[i] + kd * v; acc += qd * S[i]; }
            part[(tt * 4 + dq) * 128 + e] = acc;
        }
        __syncthreads();
#pragma unroll
        for (int t2 = 0; t2 < 2; ++t2) { const int tt = 2 * F.wave + t2; const size_t m = (size_t)b * SEQ + t0 + tt;
            float o1 = 0.f, o2 = 0.f;
#pragma unroll
            for (int q = 0; q < 4; ++q) { o1 += part[(tt * 4 + q) * 128 + lane]; o2 += part[(tt * 4 + q) * 128 + 64 + lane]; }
            const float mean = wave_sum(o1 + o2) * (1.f / 128.f); const float d1 = o1 - mean, d2 = o2 - mean;
            const float r = rsqrtf(wave_sum(d1 * d1 + d2 * d2) * (1.f / 128.f) + 1e-5f);
            const float g1 = bf1(WSP(bf16, WS_Z)[m * NZ + Z_RG + h * 128 + lane]), g2 = bf1(WSP(bf16, WS_Z)[m * NZ + Z_RG + h * 128 + 64 + lane]);
            WSP(bf16, WS_Y)[m * 1024 + h * 128 + lane] = (bf16)f2bf(d1 * r * gn1 * g1 * sigm(g1)); WSP(bf16, WS_Y)[m * 1024 + h * 128 + 64 + lane] = (bf16)f2bf(d2 * r * gn2 * g2 * sigm(g2)); }
        __syncthreads();
    }
}
__device__ __forceinline__ void mlstm_unit_scalar(Frame& F, const float* nw, int b, int h) {
    LAS float* qs = (LAS float*)(F.lds + RING_OFF); LAS float* ks = qs + 1024; LAS float* vs = ks + 1024; LAS float* part = vs + 2048; LAS float* pden = part + 8192; LAS float* gi = pden + 64; LAS float* gf = gi + 16;
    const int tid = F.tid, lane = F.lane, e = tid & 127, dq = tid >> 7;
    float C[16], nn[16];
#pragma unroll
    for (int i = 0; i < 16; ++i) { C[i] = 0.f; nn[i] = 0.f; }
    const bf16* zb = WSP(bf16, WS_Z) + (size_t)(b * SEQ) * NZ;
    const float nw1 = nw[h * 128 + lane], nw2 = nw[h * 128 + 64 + lane];
    for (int t0 = 0; t0 < SEQ; t0 += 16) {
        { const int tt = tid >> 5, d4 = (tid & 31) * 4; const bf16* zr = zb + (size_t)(t0 + tt) * NZ;
          const v2u vv = *(const v2u*)(zr + Z_MV + h * 128 + d4);
          *(LAS f32x4*)(vs + tt * 128 + d4) = (f32x4){bflo(vv.x), bfhi(vv.x), bflo(vv.y), bfhi(vv.y)};
          if (d4 < 64) { const v2u qv = *(const v2u*)(zr + Z_MQ + h * 64 + d4), kv = *(const v2u*)(zr + Z_MK + h * 64 + d4);
              *(LAS f32x4*)(qs + tt * 64 + d4) = (f32x4){bflo(qv.x), bfhi(qv.x), bflo(qv.y), bfhi(qv.y)};
              *(LAS f32x4*)(ks + tt * 64 + d4) = (f32x4){bflo(kv.x), bfhi(kv.x), bflo(kv.y), bfhi(kv.y)} * 0.125f; }
          if (tid < 16) { const size_t m = (size_t)b * SEQ + t0 + tid; gi[tid] = __expf(WSP(float, WS_GIF)[m * 16 + h]); gf[tid] = __expf(WSP(float, WS_GIF)[m * 16 + 8 + h]); } }
        __syncthreads();
        for (int tt = 0; tt < 16; ++tt) {
            const float v = vs[tt * 128 + e], ig = gi[tt], fg = gf[tt]; float num = 0.f, den = 0.f;
#pragma unroll
            for (int i = 0; i < 16; ++i) { const float kd = ks[tt * 64 + dq * 16 + i] * ig, qd = qs[tt * 64 + dq * 16 + i]; C[i] = fg * C[i] + kd * v; nn[i] = fg * nn[i] + kd; num += qd * C[i]; den += qd * nn[i]; }
            part[(tt * 4 + dq) * 128 + e] = num; if (e == 0) pden[tt * 4 + dq] = den;
        }
        __syncthreads();
#pragma unroll
        for (int t2 = 0; t2 < 2; ++t2) { const int tt = 2 * F.wave + t2; const size_t m = (size_t)b * SEQ + t0 + tt;
            float o1 = 0.f, o2 = 0.f, dn = 0.f;
#pragma unroll
            for (int q = 0; q < 4; ++q) { o1 += part[(tt * 4 + q) * 128 + lane]; o2 += part[(tt * 4 + q) * 128 + 64 + lane]; dn += pden[tt * 4 + q]; }
            const float dd = 1.0f / fmaxf(fabsf(dn), 1.0f); o1 *= dd; o2 *= dd;
            const float r = rsqrtf(wave_sum(o1 * o1 + o2 * o2) * (1.f / 128.f) + 1e-6f);
            const float g1 = bf1(WSP(bf16, WS_Z)[m * NZ + Z_MO + h * 128 + lane]), g2 = bf1(WSP(bf16, WS_Z)[m * NZ + Z_MO + h * 128 + 64 + lane]);
            WSP(bf16, WS_Y)[(size_t)M * 1024 + m * 1024 + h * 128 + lane] = (bf16)f2bf(o1 * r * nw1 * sigm(g1)); WSP(bf16, WS_Y)[(size_t)M * 1024 + m * 1024 + h * 128 + 64 + lane] = (bf16)f2bf(o2 * r * nw2 * sigm(g2)); }
        __syncthreads();
    }
}
__device__ __forceinline__ void moba_item_scalar(Frame& F, int b, int h, int t, LAS float* qL, LAS float* pL) {
    const int lane = F.lane, blk = t >> 8; const size_t m = (size_t)b * SEQ + t;
    const bf16* zb = WSP(bf16, WS_Z) + (size_t)(b * SEQ) * NZ;
    const unsigned qw = *(const unsigned*)(zb + (size_t)t * NZ + Z_AQ + h * 128 + 2 * lane);
    const float q0 = bflo(qw), q1 = bfhi(qw);
    qL[2 * lane] = q0; qL[2 * lane + 1] = q1;
    float gate[8];
#pragma unroll
    for (int n = 0; n < 8; ++n) { gate[n] = -INFINITY;
        if (n < blk) { const f32x2 km = *(const f32x2*)(WSP(float, WS_KMEAN) + (size_t)((b * NH + h) * 8 + n) * 128 + 2 * lane); gate[n] = wave_sum(q0 * km.x + q1 * km.y); } }
    int sel[4]; sel[0] = blk; unsigned used = 0u;
#pragma unroll
    for (int s = 1; s < 4; ++s) { float bv = -INFINITY; int best = -1;
#pragma unroll
        for (int n = 0; n < 8; ++n) { const bool c = !((used >> n) & 1u) && gate[n] > bv; bv = c ? gate[n] : bv; best = c ? n : best; }
        if (best >= 0) used |= 1u << best; sel[s] = best; }
    LDS_WAIT();
    float sc[4][4]; float mx = -INFINITY;
#pragma unroll
    for (int s = 0; s < 4; ++s) {
#pragma unroll
        for (int c = 0; c < 4; ++c) sc[s][c] = -INFINITY;
        const int kb = __builtin_amdgcn_readfirstlane(sel[s]);
        if (kb >= 0) {
#pragma unroll
            for (int c = 0; c < 4; ++c) { const int kpos = kb * 256 + c * 64 + lane; const bf16* kr = zb + (size_t)kpos * NZ + Z_AK + h * 128; float d = 0.f;
#pragma unroll 4
                for (int i = 0; i < 16; ++i) { const v4u kw = *(const v4u*)(kr + 8 * i); const f32x4 qa = *(const LAS f32x4*)(qL + 8 * i), qb = *(const LAS f32x4*)(qL + 8 * i + 4);
                    d += (bflo(kw.x) * qa.x + bfhi(kw.x) * qa.y) + (bflo(kw.y) * qa.z + bfhi(kw.y) * qa.w) + (bflo(kw.z) * qb.x + bfhi(kw.z) * qb.y) + (bflo(kw.w) * qb.z + bfhi(kw.w) * qb.w); }
                const bool valid = (s > 0) || (kpos <= t); sc[s][c] = valid ? d * 0.08838834764831845f : -INFINITY; mx = fmaxf(mx, sc[s][c]); } }
    }
    mx = wave_max(mx); float ls = 0.f;
#pragma unroll
    for (int s = 0; s < 4; ++s)
#pragma unroll
        for (int c = 0; c < 4; ++c) { const float p = __expf(sc[s][c] - mx); ls += p; pL[s * 256 + c * 64 + lane] = p; }
    ls = wave_sum(ls);
    LDS_WAIT();
    float a0 = 0.f, a1 = 0.f;
#pragma unroll
    for (int s = 0; s < 4; ++s) { const int kb = __builtin_amdgcn_readfirstlane(sel[s]);
        if (kb >= 0) { const int nk = (s == 0) ? (t - blk * 256 + 1) : 256; const bf16* vr = zb + (size_t)(kb * 256) * NZ + Z_AV + h * 128 + 2 * lane;
            for (int j = 0; j < nk; ++j) { const float p = pL[s * 256 + j]; const unsigned vw = *(const unsigned*)(vr + (size_t)j * NZ); a0 += p * bflo(vw); a1 += p * bfhi(vw); } } }
    const float inv = 1.0f / ls;
    *(unsigned*)(WSP(bf16, WS_Y) + (size_t)2 * M * 1024 + m * 1024 + h * 128 + 2 * lane) = pk2(a0 * inv, a1 * inv);
    LDS_WAIT();
}
__device__ __forceinline__ void mix_phase_scalar(Frame& F, const float* rgn, const float* mln) {
    const int bx = F.bx;
    if (F.G >= 256) {
        if (bx < 64) ret_unit_scalar(F, rgn, bx >> 3, bx & 7);
        else if (bx < 128) mlstm_unit_scalar(F, mln, (bx - 64) >> 3, bx & 7);
        else { const int nw = (F.G - 128) * NWAVES, w = (bx - 128) * NWAVES + F.wave;
            LAS float* qL = (LAS float*)(F.lds + RING_OFF) + F.wave * 1280; LAS float* pL = qL + 128;
            const int per = (BATCH * NH * SEQ + nw - 1) / nw;
            for (int i = 0; i < per; ++i) { const int it = w * per + i; if (it < BATCH * NH * SEQ) moba_item_scalar(F, it >> 14, (it >> 11) & 7, it & (SEQ - 1), qL, pL); } }
    }
}
__device__ __forceinline__ void glu_phase(Frame& F, const float* cw, const float* cb) {
    const int gt = F.bx * (NWAVES * 64) + F.tid, NGT = F.G * NWAVES * 64;
    for (int idx = gt; idx < M * (DFF / 8); idx += NGT) {
        const int m = idx / (DFF / 8), c8 = (idx % (DFF / 8)) * 8, pos = m & (SEQ - 1);
        float r[2][8];
#pragma unroll
        for (int hf = 0; hf < 2; ++hf) { const int col = hf * DFF + c8;
            const f32x4 b0 = *(const f32x4*)(cb + col), b1 = *(const f32x4*)(cb + col + 4);
            float a[8] = {b0.x, b0.y, b0.z, b0.w, b1.x, b1.y, b1.z, b1.w};
#pragma unroll
            for (int j = 0; j < 3; ++j) { const int dt = 2 - j; if (pos >= dt) {
                const v4u uw = *(const v4u*)(WSP(bf16, WS_Z) + (size_t)(m - dt) * NUP + col); const f32x4 w0 = *(const f32x4*)(cw + (size_t)j * NUP + col), w1 = *(const f32x4*)(cw + (size_t)j * NUP + col + 4);
                a[0] += bflo(uw.x) * w0.x; a[1] += bfhi(uw.x) * w0.y; a[2] += bflo(uw.y) * w0.z; a[3] += bfhi(uw.y) * w0.w; a[4] += bflo(uw.z) * w1.x; a[5] += bfhi(uw.z) * w1.y; a[6] += bflo(uw.w) * w1.z; a[7] += bfhi(uw.w) * w1.w; } }
#pragma unroll
            for (int i = 0; i < 8; ++i) r[hf][i] = a[i]; }
        v4u o;
        o.x = pk2(r[0][0] * sigm(r[0][0]) * r[1][0], r[0][1] * sigm(r[0][1]) * r[1][1]); o.y = pk2(r[0][2] * sigm(r[0][2]) * r[1][2], r[0][3] * sigm(r[0][3]) * r[1][3]);
        o.z = pk2(r[0][4] * sigm(r[0][4]) * r[1][4], r[0][5] * sigm(r[0][5]) * r[1][5]); o.w = pk2(r[0][6] * sigm(r[0][6]) * r[1][6], r[0][7] * sigm(r[0][7]) * r[1][7]);
        *(v4u*)(WSP(bf16, WS_ACT) + (size_t)m * DFF + c8) = o;
    }
}
namespace mx {
typedef short bf16x8 __attribute__((ext_vector_type(8)));
typedef short s16x4 __attribute__((ext_vector_type(4)));
#define MFMA16(a, b, c) __builtin_amdgcn_mfma_f32_16x16x32_bf16((a), (b), (c), 0, 0, 0)
#define LDS_FENCE() asm volatile("s_waitcnt lgkmcnt(0)" ::: "memory")
__device__ __forceinline__ bf16x8 frag_row(const LAS bf16* X, int ld, int r0, int c0, int lane) {
    return *(const LAS bf16x8*)(X + (r0 + (lane & 15)) * ld + c0 + 8 * (lane >> 4)); }
__device__ __forceinline__ bf16x8 frag_tr(const LAS bf16* X, int ld, int k0, int c0, int lane) {
    const int g = lane >> 4, q = (lane & 15) >> 2, p = lane & 3;
    const LAS bf16* a = X + (k0 + 8 * g + q) * ld + c0 + 4 * p;
    const s16x4 lo = __builtin_amdgcn_ds_read_tr16_b64_v4i16((LAS s16x4*)a);
    const s16x4 hi = __builtin_amdgcn_ds_read_tr16_b64_v4i16((LAS s16x4*)(a + 4 * ld));
    return __builtin_shufflevector(lo, hi, 0, 1, 2, 3, 4, 5, 6, 7);
}
__device__ __forceinline__ float red16_sum(float v) { v += __shfl_xor(v, 1); v += __shfl_xor(v, 2); v += __shfl_xor(v, 4); v += __shfl_xor(v, 8); return v; }
__device__ __forceinline__ float red16_max(float v) { v = fmaxf(v, __shfl_xor(v, 1)); v = fmaxf(v, __shfl_xor(v, 2)); v = fmaxf(v, __shfl_xor(v, 4)); v = fmaxf(v, __shfl_xor(v, 8)); return v; }
__device__ __forceinline__ void rot8(const v4u lo, const v4u hi, const f32x2* tb, float sc, v4u& olo, v4u& ohi) {
    float a[8] = {bflo(lo.x), bfhi(lo.x), bflo(lo.y), bfhi(lo.y), bflo(lo.z), bfhi(lo.z), bflo(lo.w), bfhi(lo.w)};
    float c[8] = {bflo(hi.x), bfhi(hi.x), bflo(hi.y), bfhi(hi.y), bflo(hi.z), bfhi(hi.z), bflo(hi.w), bfhi(hi.w)};
    float o1[8], o2[8];
#pragma unroll
    for (int e = 0; e < 8; ++e) { const f32x2 cs = tb[e]; o1[e] = (a[e] * cs.x - c[e] * cs.y) * sc; o2[e] = (a[e] * cs.y + c[e] * cs.x) * sc; }
    olo = (v4u){pk2(o1[0], o1[1]), pk2(o1[2], o1[3]), pk2(o1[4], o1[5]), pk2(o1[6], o1[7])};
    ohi = (v4u){pk2(o2[0], o2[1]), pk2(o2[2], o2[3]), pk2(o2[4], o2[5]), pk2(o2[6], o2[7])};
}
constexpr int LQ = 136;
__device__ __forceinline__ void ret_unit(Frame& F, const float* gn, int b, int h) {
    LAS bf16* Qs = (LAS bf16*)(F.lds); LAS bf16* Ks = Qs + 128 * LQ; LAS bf16* Vs = Ks + 128 * LQ; LAS bf16* Ts = Vs + 128 * LQ;
    const int tid = F.tid, lane = F.lane, w = tid >> 6, i16 = lane & 15, g = lane >> 4;
    const float gamma = 1.0f - exp2f(-5.0f - (float)h), lg = log2f(gamma);
    const float gC = exp2f(lg * 128.0f), gC1 = exp2f(lg * 127.0f);
    f32x4 accT[8];
#pragma unroll
    for (int n = 0; n < 8; ++n) accT[n] = (f32x4){0.f, 0.f, 0.f, 0.f};
    for (int i = tid; i < 128 * LQ / 8; i += NWAVES * 64) ((LAS v4u*)Ts)[i] = (v4u){0u, 0u, 0u, 0u};
    const bf16* zb = WSP(bf16, WS_Z) + (size_t)(b * SEQ) * NZ + h * 128;
    const f32x2* tret = WSP(f32x2, WS_TAB);
    bf16* yb = WSP(bf16, WS_Y) + (size_t)(b * SEQ) * 1024 + h * 128;
    for (int c = 0; c < SEQ / 128; ++c) {
        const int t0 = c * 128;
        {
            const int r = tid >> 2, dg = tid & 3, pos = t0 + r; const bf16* zr = zb + (size_t)pos * NZ;
            const float sq = exp2f(lg * (float)r), sk = exp2f(-lg * (float)r) * 0.08838834764831845f;
            const f32x2* tb = tret + pos * 64 + 16 * dg;
#pragma unroll
            for (int hh = 0; hh < 2; ++hh) {
                const v4u ql = *(const v4u*)(zr + Z_RQ + 16 * dg + 8 * hh), qh = *(const v4u*)(zr + Z_RQ + 64 + 16 * dg + 8 * hh);
                const v4u kl = *(const v4u*)(zr + Z_RK + 16 * dg + 8 * hh), kh = *(const v4u*)(zr + Z_RK + 64 + 16 * dg + 8 * hh);
                v4u o1, o2; rot8(ql, qh, tb + 8 * hh, sq, o1, o2);
                *(LAS v4u*)(Qs + r * LQ + 16 * dg + 8 * hh) = o1; *(LAS v4u*)(Qs + r * LQ + 64 + 16 * dg + 8 * hh) = o2;
                rot8(kl, kh, tb + 8 * hh, sk, o1, o2);
                *(LAS v4u*)(Ks + r * LQ + 16 * dg + 8 * hh) = o1; *(LAS v4u*)(Ks + r * LQ + 64 + 16 * dg + 8 * hh) = o2;
            }
#pragma unroll
            for (int q = 0; q < 4; ++q) *(LAS v4u*)(Vs + r * LQ + 32 * dg + 8 * q) = *(const v4u*)(zr + Z_RV + 32 * dg + 8 * q);
        }
        __syncthreads();
        bf16x8 aq[4];
#pragma unroll
        for (int s = 0; s < 4; ++s) aq[s] = frag_row(Qs, LQ, 16 * w, 32 * s, lane);
        f32x4 acco[8];
#pragma unroll
        for (int n = 0; n < 8; ++n) { acco[n] = (f32x4){0.f, 0.f, 0.f, 0.f};
#pragma unroll
            for (int s = 0; s < 4; ++s) acco[n] = MFMA16(aq[s], frag_tr(Ts, LQ, 32 * s, 16 * n, lane), acco[n]); }
        LDS_FENCE();
#pragma unroll
        for (int n = 0; n < 8; ++n) {
            if (n <= w) { f32x4 sa = (f32x4){0.f, 0.f, 0.f, 0.f};
#pragma unroll
                for (int s = 0; s < 4; ++s) sa = MFMA16(aq[s], frag_row(Ks, LQ, 16 * n, 32 * s, lane), sa);
#pragma unroll
                for (int r = 0; r < 4; ++r) { const int i = 16 * w + 4 * g + r, j = 16 * n + i16; Qs[i * LQ + j] = (bf16)f2bf(j <= i ? sa[r] : 0.f); } }
            else if (n == w + 1) {
#pragma unroll
                for (int r = 0; r < 4; ++r) Qs[(16 * w + 4 * g + r) * LQ + 16 * n + i16] = (bf16)0; }
        }
        LDS_FENCE();
#pragma unroll
        for (int s = 0; s < 4; ++s) if (s <= (w >> 1)) { const bf16x8 as = frag_row(Qs, LQ, 16 * w, 32 * s, lane);
#pragma unroll
            for (int n = 0; n < 8; ++n) acco[n] = MFMA16(as, frag_tr(Vs, LQ, 32 * s, 16 * n, lane), acco[n]); }
        f32x4 kv[8];
#pragma unroll
        for (int n = 0; n < 8; ++n) kv[n] = (f32x4){0.f, 0.f, 0.f, 0.f};
#pragma unroll
        for (int s = 0; s < 4; ++s) { const bf16x8 ak = frag_tr(Ks, LQ, 32 * s, 16 * w, lane);
#pragma unroll
            for (int n = 0; n < 8; ++n) kv[n] = MFMA16(ak, frag_tr(Vs, LQ, 32 * s, 16 * n, lane), kv[n]); }
#pragma unroll
        for (int n = 0; n < 8; ++n) accT[n] = accT[n] * gC + kv[n] * gC1;
        LDS_FENCE();
        __syncthreads();
#pragma unroll
        for (int n = 0; n < 8; ++n)
#pragma unroll
            for (int r = 0; r < 4; ++r) Ts[(16 * w + 4 * g + r) * LQ + 16 * n + i16] = (bf16)f2bf(gamma * accT[n][r]);
#pragma unroll
        for (int r = 0; r < 4; ++r) {
            float s = 0.f;
#pragma unroll
            for (int n = 0; n < 8; ++n) s += acco[n][r];
            const float mean = red16_sum(s) * (1.f / 128.f); float q = 0.f;
#pragma unroll
            for (int n = 0; n < 8; ++n) { const float d = acco[n][r] - mean; q += d * d; }
            const float rstd = rsqrtf(red16_sum(q) * (1.f / 128.f) + 1e-5f);
            const int pos = t0 + 16 * w + 4 * g + r; const bf16* gr = zb + (size_t)pos * NZ + Z_RG; bf16* yr = yb + (size_t)pos * 1024;
#pragma unroll
            for (int n = 0; n < 8; ++n) { const int e = 16 * n + i16; const float gv = bf1(gr[e]); yr[e] = (bf16)f2bf((acco[n][r] - mean) * rstd * gn[h * 128 + e] * gv * sigm(gv)); }
        }
    }
    __syncthreads();
}
constexpr int LK = 72, LV = 168;
__device__ __forceinline__ float scan64_sum(float x, int lane) {
#pragma unroll
    for (int o = 1; o < 64; o <<= 1) { const float y = __shfl_up(x, o); if (lane >= o) x += y; }
    return x; }
__device__ __forceinline__ float scan64_max(float x, int lane) {
#pragma unroll
    for (int o = 1; o < 64; o <<= 1) { const float y = __shfl_up(x, o); if (lane >= o) x = fmaxf(x, y); }
    return x; }
__device__ __forceinline__ void mlstm_unit(Frame& F, const float* nw, int b, int h) {
    LAS bf16* Qm = (LAS bf16*)(F.lds); LAS bf16* Km = Qm + 128 * LK; LAS bf16* Kw = Km + 128 * LK; LAS bf16* Vm = Kw + 128 * LK; LAS bf16* Pm = Vm + 128 * LV; LAS bf16* Cm = Pm + 128 * LQ;
    const int tid = F.tid, lane = F.lane, w = tid >> 6, i16 = lane & 15, g = lane >> 4;
    const int dt = w & 3, eh = w >> 2;
    f32x4 accC[5];
#pragma unroll
    for (int k = 0; k < 5; ++k) accC[k] = (f32x4){0.f, 0.f, 0.f, 0.f};
    for (int i = tid; i < 64 * LV / 8; i += NWAVES * 64) ((LAS v4u*)Cm)[i] = (v4u){0u, 0u, 0u, 0u};
    float m_prev = 0.f;
    const bf16* zb = WSP(bf16, WS_Z) + (size_t)(b * SEQ) * NZ;
    const float* gif = WSP(float, WS_GIF) + (size_t)(b * SEQ) * 16;
    bf16* yb = WSP(bf16, WS_Y) + (size_t)M * 1024 + (size_t)(b * SEQ) * 1024 + h * 128;
    for (int c = 0; c < SEQ / 128; ++c) {
        const int t0 = c * 128;
        const float fl0 = gif[(size_t)(t0 + lane) * 16 + 8 + h], fl1 = gif[(size_t)(t0 + 64 + lane) * 16 + 8 + h];
        const float il0 = gif[(size_t)(t0 + lane) * 16 + h], il1 = gif[(size_t)(t0 + 64 + lane) * 16 + h];
        const float a0 = scan64_sum(fl0, lane); const float a1 = scan64_sum(fl1, lane) + __shfl(a0, 63);
        const float b0 = il0 - a0, b1 = il1 - a1;
        const float pm0 = scan64_max(b0, lane); const float pm1 = fmaxf(scan64_max(b1, lane), __shfl(pm0, 63));
        const float a_last = __shfl(a1, 63), bmax = __shfl(pm1, 63);
        {
            const int r = tid >> 2, dg = tid & 3; const bf16* zr = zb + (size_t)(t0 + r) * NZ;
            const float br = (r < 64) ? __shfl(b0, r & 63) : __shfl(b1, r & 63);
            const float wk = __expf(br - bmax) * 0.125f;
#pragma unroll
            for (int hh = 0; hh < 2; ++hh) {
                *(LAS v4u*)(Qm + r * LK + 16 * dg + 8 * hh) = *(const v4u*)(zr + Z_MQ + h * 64 + 16 * dg + 8 * hh);
                const v4u kk = *(const v4u*)(zr + Z_MK + h * 64 + 16 * dg + 8 * hh);
                float kf[8] = {bflo(kk.x), bfhi(kk.x), bflo(kk.y), bfhi(kk.y), bflo(kk.z), bfhi(kk.z), bflo(kk.w), bfhi(kk.w)};
                *(LAS v4u*)(Km + r * LK + 16 * dg + 8 * hh) = (v4u){pk2(kf[0] * 0.125f, kf[1] * 0.125f), pk2(kf[2] * 0.125f, kf[3] * 0.125f), pk2(kf[4] * 0.125f, kf[5] * 0.125f), pk2(kf[6] * 0.125f, kf[7] * 0.125f)};
                *(LAS v4u*)(Kw + r * LK + 16 * dg + 8 * hh) = (v4u){pk2(kf[0] * wk, kf[1] * wk), pk2(kf[2] * wk, kf[3] * wk), pk2(kf[4] * wk, kf[5] * wk), pk2(kf[6] * wk, kf[7] * wk)};
            }
#pragma unroll
            for (int q = 0; q < 4; ++q) *(LAS v4u*)(Vm + r * LV + 32 * dg + 8 * q) = *(const v4u*)(zr + Z_MV + h * 128 + 32 * dg + 8 * q);
            *(LAS v4u*)(Vm + r * LV + 128 + 8 * dg) = (v4u){dg == 0 ? 0x00003f80u : 0u, 0u, 0u, 0u};
        }
        __syncthreads();
        float Mi[4], ai[4];
#pragma unroll
        for (int r = 0; r < 4; ++r) { const int i = 16 * w + 4 * g + r; const float pmi = (w < 4) ? __shfl(pm0, i & 63) : __shfl(pm1, i & 63); ai[r] = (w < 4) ? __shfl(a0, i & 63) : __shfl(a1, i & 63); Mi[r] = fmaxf(pmi, m_prev); }
        bf16x8 aq[2];
#pragma unroll
        for (int s = 0; s < 2; ++s) aq[s] = frag_row(Qm, LK, 16 * w, 32 * s, lane);
        f32x4 acco[9];
#pragma unroll
        for (int n = 0; n < 9; ++n) { acco[n] = (f32x4){0.f, 0.f, 0.f, 0.f};
#pragma unroll
            for (int s = 0; s < 2; ++s) acco[n] = MFMA16(aq[s], frag_tr(Cm, LV, 32 * s, 16 * n, lane), acco[n]);
#pragma unroll
            for (int r = 0; r < 4; ++r) acco[n][r] *= __expf(m_prev - Mi[r]); }
        LDS_FENCE();
#pragma unroll
        for (int n = 0; n < 8; ++n) {
            if (n <= w) { f32x4 sa = (f32x4){0.f, 0.f, 0.f, 0.f};
#pragma unroll
                for (int s = 0; s < 2; ++s) sa = MFMA16(aq[s], frag_row(Km, LK, 16 * n, 32 * s, lane), sa);
                const int j = 16 * n + i16; const float bj = (n < 4) ? __shfl(b0, j & 63) : __shfl(b1, j & 63);
#pragma unroll
                for (int r = 0; r < 4; ++r) { const int i = 16 * w + 4 * g + r; Pm[i * LQ + j] = (bf16)f2bf(j <= i ? sa[r] * __expf(bj - Mi[r]) : 0.f); } }
            else if (n == w + 1) {
#pragma unroll
                for (int r = 0; r < 4; ++r) Pm[(16 * w + 4 * g + r) * LQ + 16 * n + i16] = (bf16)0; }
        }
        LDS_FENCE();
#pragma unroll
        for (int s = 0; s < 4; ++s) if (s <= (w >> 1)) { const bf16x8 ap = frag_row(Pm, LQ, 16 * w, 32 * s, lane);
#pragma unroll
            for (int n = 0; n < 9; ++n) acco[n] = MFMA16(ap, frag_tr(Vm, LV, 32 * s, 16 * n, lane), acco[n]); }
        f32x4 kv[5];
#pragma unroll
        for (int k = 0; k < 5; ++k) kv[k] = (f32x4){0.f, 0.f, 0.f, 0.f};
#pragma unroll
        for (int s = 0; s < 4; ++s) { const bf16x8 ak = frag_tr(Kw, LK, 32 * s, 16 * dt, lane);
#pragma unroll
            for (int k = 0; k < 5; ++k) kv[k] = MFMA16(ak, frag_tr(Vm, LV, 32 * s, 16 * (5 * eh + k), lane), kv[k]); }
        const float g_n = a_last + bmax, m_new = fmaxf(a_last + m_prev, g_n), s_old = __expf(a_last + m_prev - m_new), s_new = __expf(g_n - m_new);
#pragma unroll
        for (int k = 0; k < 5; ++k) accC[k] = accC[k] * s_old + kv[k] * s_new;
        LDS_FENCE();
        __syncthreads();
#pragma unroll
        for (int k = 0; k < 5; ++k)
#pragma unroll
            for (int r = 0; r < 4; ++r) Cm[(16 * dt + 4 * g + r) * LV + 16 * (5 * eh + k) + i16] = (bf16)f2bf(accC[k][r]);
#pragma unroll
        for (int r = 0; r < 4; ++r) {
            const float den = __shfl(acco[8][r], lane & 48);
            const float dd = 1.0f / fmaxf(fabsf(den), __expf(-(ai[r] + Mi[r])));
            float q = 0.f;
#pragma unroll
            for (int n = 0; n < 8; ++n) { acco[n][r] *= dd; q += acco[n][r] * acco[n][r]; }
            const float rstd = rsqrtf(red16_sum(q) * (1.f / 128.f) + 1e-6f);
            const int pos = t0 + 16 * w + 4 * g + r; const bf16* gr = zb + (size_t)pos * NZ + Z_MO + h * 128; bf16* yr = yb + (size_t)pos * 1024;
#pragma unroll
            for (int n = 0; n < 8; ++n) { const int e = 16 * n + i16; yr[e] = (bf16)f2bf(acco[n][r] * rstd * nw[h * 128 + e] * sigm(bf1(gr[e]))); }
        }
        m_prev = m_new;
    }
    __syncthreads();
}
__device__ __forceinline__ void moba_unit(Frame& F, int b, int h, int qi) {
    LAS bf16* Kt = (LAS bf16*)(F.lds); LAS bf16* Vt = Kt + 128 * LQ; LAS bf16* Pm = Vt + 128 * LQ;
    const int tid = F.tid, lane = F.lane, w = tid >> 6, i16 = lane & 15, g = lane >> 4;
    const int blk = qi >> 1, qt = qi & 1, q0 = qi * 128;
    const bf16* zb = WSP(bf16, WS_Z) + (size_t)(b * SEQ) * NZ + h * 128;
    bf16x8 aq[4];
    { const bf16* qr = zb + (size_t)(q0 + 16 * w + i16) * NZ + Z_AQ + 8 * g;
#pragma unroll
      for (int s = 0; s < 4; ++s) aq[s] = *(const bf16x8*)(qr + 32 * s); }
    unsigned sel = 0u;
    {
        float gate[8];
        const float* km = WSP(float, WS_KMEAN) + (size_t)((b * NH + h) * 8) * 128 + 8 * g;
#pragma unroll
        for (int n = 0; n < 8; ++n) { gate[n] = -INFINITY;
            if (n < blk) { float p = 0.f;
#pragma unroll
                for (int s = 0; s < 4; ++s) { const f32x4 k0 = *(const f32x4*)(km + n * 128 + 32 * s), k1 = *(const f32x4*)(km + n * 128 + 32 * s + 4);
                    p += bf1((bf16)aq[s][0]) * k0.x + bf1((bf16)aq[s][1]) * k0.y + bf1((bf16)aq[s][2]) * k0.z + bf1((bf16)aq[s][3]) * k0.w
                       + bf1((bf16)aq[s][4]) * k1.x + bf1((bf16)aq[s][5]) * k1.y + bf1((bf16)aq[s][6]) * k1.z + bf1((bf16)aq[s][7]) * k1.w; }
                p += __shfl_xor(p, 16); p += __shfl_xor(p, 32); gate[n] = p; } }
#pragma unroll
        for (int s = 0; s < 3; ++s) { float bv = -INFINITY; int best = -1;
#pragma unroll
            for (int n = 0; n < 8; ++n) { const bool c = !((sel >> n) & 1u) && gate[n] > bv; bv = c ? gate[n] : bv; best = c ? n : best; }
            if (best >= 0) sel |= 1u << best; }
    }
    unsigned rsel[4];
#pragma unroll
    for (int r = 0; r < 4; ++r) rsel[r] = (unsigned)__shfl((int)sel, 4 * g + r);
    f32x4 acco[8];
#pragma unroll
    for (int n = 0; n < 8; ++n) acco[n] = (f32x4){0.f, 0.f, 0.f, 0.f};
    float mrow[4], lrow[4];
#pragma unroll
    for (int r = 0; r < 4; ++r) { mrow[r] = -1e30f; lrow[r] = 0.f; }
    const int ntiles = 2 * blk + qt + 1;
    for (int kt = 0; kt < ntiles; ++kt) {
        const int k0 = kt * 128, kb = kt >> 1; const bool own = (kb == blk), diag = (kt == 2 * blk + qt);
        __syncthreads();
        { const int r = tid >> 2, dg = tid & 3; const bf16* zr = zb + (size_t)(k0 + r) * NZ;
#pragma unroll
          for (int q = 0; q < 4; ++q) { *(LAS v4u*)(Kt + r * LQ + 32 * dg + 8 * q) = *(const v4u*)(zr + Z_AK + 32 * dg + 8 * q); *(LAS v4u*)(Vt + r * LQ + 32 * dg + 8 * q) = *(const v4u*)(zr + Z_AV + 32 * dg + 8 * q); } }
        __syncthreads();
        f32x4 sc[8];
#pragma unroll
        for (int n = 0; n < 8; ++n) { sc[n] = (f32x4){0.f, 0.f, 0.f, 0.f};
#pragma unroll
            for (int s = 0; s < 4; ++s) sc[n] = MFMA16(aq[s], frag_row(Kt, LQ, 16 * n, 32 * s, lane), sc[n]); }
#pragma unroll
        for (int r = 0; r < 4; ++r) {
            const int qpos = q0 + 16 * w + 4 * g + r; const bool rowsel = own || ((rsel[r] >> kb) & 1u);
            float mx = -1e30f; bool vld[8];
#pragma unroll
            for (int n = 0; n < 8; ++n) { vld[n] = rowsel && (!diag || (k0 + 16 * n + i16 <= qpos)); sc[n][r] = vld[n] ? sc[n][r] * 0.08838834764831845f : -1e30f; mx = fmaxf(mx, sc[n][r]); }
            mx = red16_max(mx);
            const float mnew = fmaxf(mrow[r], mx), alpha = __expf(mrow[r] - mnew); mrow[r] = mnew;
            float ps = 0.f;
#pragma unroll
            for (int n = 0; n < 8; ++n) { const float p = vld[n] ? __expf(sc[n][r] - mnew) : 0.f; ps += p; Pm[(16 * w + 4 * g + r) * LQ + 16 * n + i16] = (bf16)f2bf(p); }
            lrow[r] = lrow[r] * alpha + ps;
#pragma unroll
            for (int n = 0; n < 8; ++n) acco[n][r] *= alpha;
        }
        LDS_FENCE();
#pragma unroll
        for (int s = 0; s < 4; ++s) { const bf16x8 ap = frag_row(Pm, LQ, 16 * w, 32 * s, lane);
#pragma unroll
            for (int n = 0; n < 8; ++n) acco[n] = MFMA16(ap, frag_tr(Vt, LQ, 32 * s, 16 * n, lane), acco[n]); }
        LDS_FENCE();
    }
    bf16* yb = WSP(bf16, WS_Y) + (size_t)2 * M * 1024 + (size_t)(b * SEQ + q0) * 1024 + h * 128;
#pragma unroll
    for (int r = 0; r < 4; ++r) { const float inv = 1.0f / red16_sum(lrow[r]); bf16* yr = yb + (size_t)(16 * w + 4 * g + r) * 1024;
#pragma unroll
        for (int n = 0; n < 8; ++n) yr[16 * n + i16] = (bf16)f2bf(acco[n][r] * inv); }
}
__device__ __forceinline__ void mix_phase(Frame& F, const float* rgn, const float* mln) {
    const int bx = F.bx;
    if (F.G < 256) return;
    if (bx < 64) { if (MX_RET) ret_unit(F, rgn, bx >> 3, bx & 7); else ret_unit_scalar(F, rgn, bx >> 3, bx & 7); }
    else if (bx < 128) { if (MX_ML) mlstm_unit(F, mln, (bx - 64) >> 3, bx & 7); else mlstm_unit_scalar(F, mln, (bx - 64) >> 3, bx & 7); }
    else if (MX_MOBA) { const int v = bx - 128, bh = v >> 1, x = v & 1;
#pragma unroll 1
        for (int u = 0; u < 8; ++u) { const int pr = u >> 1; const int qi = (u & 1) ? (2 * pr + x) : (15 - 2 * pr - x); moba_unit(F, bh >> 3, bh & 7, qi); __syncthreads(); } }
    else { const int nw = (F.G - 128) * NWAVES, wv = (bx - 128) * NWAVES + F.wave;
        LAS float* qL = (LAS float*)(F.lds + RING_OFF) + F.wave * 1280; LAS float* pL = qL + 128;
        const int per = (BATCH * NH * SEQ + nw - 1) / nw;
        for (int i = 0; i < per; ++i) { const int it = wv * per + i; if (it < BATCH * NH * SEQ) moba_item_scalar(F, it >> 14, (it >> 11) & 7, it & (SEQ - 1), qL, pL); } }
}
}
constexpr int N_PHASES = 1 + 10 * DEPTH;
__global__ void __launch_bounds__(NWAVES * 64, 2) fwd(Args args) {
    extern __shared__ __attribute__((aligned(16))) unsigned char lds[];
    Frame F;
    F.lds = (LAS unsigned char*)lds;
    F.MISC = (volatile LAS unsigned*)(F.lds + MISC_OFF);
    F.tid = threadIdx.x; F.lane = F.tid & 63; F.wave = __builtin_amdgcn_readfirstlane(F.tid >> 6); F.G = gridDim.x; F.bx = blockIdx.x;
    F.ws = args.ws;
    for (int u = F.tid; u < (LDS_BYTES - LDSCTL_OFF) / 4; u += NWAVES * 64) ((LAS unsigned*)(F.lds + LDSCTL_OFF))[u] = 0u;
    __syncthreads();
    XcdBarrier bar = xcd_barrier_post((unsigned*)(F.ws + WS_CTL) + CW_BAR + args.li * XCD_BAR_WORDS, F.MISC + 8);
    const int lo = args.ph_lo, hi = args.ph_hi;
#define RUN(p) (lo <= (p) && (p) < hi)
#define SEAM(p) do { if ((p) + 1 < hi) xcd_barrier(bar); } while (0)
    if (RUN(0)) { p0_prologue(F, args); SEAM(0); }
    for (int l = 0; l < DEPTH; ++l) {
        const int p0 = 1 + 10 * l;
        { int t_ = threadIdx.x; asm volatile("" : "+v"(t_)); F.tid = t_; F.lane = t_ & 63; F.wave = __builtin_amdgcn_readfirstlane(t_ >> 6); int b_ = blockIdx.x; asm volatile("" : "+s"(b_)); F.bx = b_; }
        const float* xcur = (l == 0) ? args.in[I_X] : args.out;
        if (RUN(p0 + 0)) { norm_phase<true>(F, xcur, args.in[I_NMIX] + l * DM, WSP(float, WS_W16T) + (size_t)l * 16 * DM, args.in[I_BIG] + l * 8, args.in[I_BFG] + l * 8); SEAM(p0 + 0); }
        if (RUN(p0 + 1)) {
            pg8::Gemm g{WSP(bf16, WS_H), WSP(bf16, WS_WIN) + (size_t)l * NZ * DM, M, NZ, DM}; pg8::StaticOrder S; S.init(M, NZ, F.G, F.bx);
            pg8::EpiBf16 E{WSP(bf16, WS_Z), NZ};
            pg8::gemm_phase<pg8::EpiBf16, pg8::StaticOrder, true, true>(F.lds + RING_OFF, g, S, E);
            SEAM(p0 + 1); }
        if (RUN(p0 + 2)) { prep_phase(F, args.in[I_QN] + l * 128, args.in[I_KN] + l * 128); SEAM(p0 + 2); }
        if (RUN(p0 + 3)) { mx::mix_phase(F, args.in[I_RGN] + l * 1024, args.in[I_MLN] + l * 1024); SEAM(p0 + 3); }
        if (RUN(p0 + 4)) {
            pg8::StaticOrder S; S.init(M, DM, F.G, F.bx);
            { pg8::Gemm g{WSP(bf16, WS_Y), WSP(bf16, WS_WP) + ((size_t)l * 3 + 0) * DM * 1024, M, DM, 1024}; pg8::EpiGateAcc<true> E{WSP(bf16, WS_MG), DM, WSP(bf16, WS_Z) + Z_GA, NZ};
              pg8::gemm_phase<pg8::EpiGateAcc<true>, pg8::StaticOrder, true, true>(F.lds + RING_OFF, g, S, E); }
            for (int br = 1; br < 3; ++br) { __syncthreads();
              pg8::Gemm g{WSP(bf16, WS_Y) + (size_t)br * M * 1024, WSP(bf16, WS_WP) + ((size_t)l * 3 + br) * DM * 1024, M, DM, 1024}; pg8::EpiGateAcc<false> E{WSP(bf16, WS_MG), DM, WSP(bf16, WS_Z) + Z_GA + br * DM, NZ};
              pg8::gemm_phase<pg8::EpiGateAcc<false>, pg8::StaticOrder, true, true>(F.lds + RING_OFF, g, S, E); }
            SEAM(p0 + 4); }
        if (RUN(p0 + 5)) {
            pg8::Gemm g{WSP(bf16, WS_MG), WSP(bf16, WS_WOUT) + (size_t)l * DM * DM, M, DM, DM}; pg8::StaticOrder S; S.init(M, DM, F.G, F.bx);
            pg8::EpiResF32 E{xcur, args.out, DM};
            pg8::gemm_phase<pg8::EpiResF32, pg8::StaticOrder, true, true>(F.lds + RING_OFF, g, S, E);
            SEAM(p0 + 5); }
        if (RUN(p0 + 6)) { norm_phase<false>(F, args.out, args.in[I_NFFN] + l * DM, nullptr, nullptr, nullptr); SEAM(p0 + 6); }
        if (RUN(p0 + 7)) {
            pg8::Gemm g{WSP(bf16, WS_H), WSP(bf16, WS_WUP) + (size_t)l * NUP * DM, M, NUP, DM}; pg8::StaticOrder S; S.init(M, NUP, F.G, F.bx);
            pg8::EpiBf16 E{WSP(bf16, WS_Z), NUP};
            pg8::gemm_phase<pg8::EpiBf16, pg8::StaticOrder, true, true>(F.lds + RING_OFF, g, S, E);
            SEAM(p0 + 7); }
        if (RUN(p0 + 8)) { glu_phase(F, args.in[I_CW] + (size_t)l * 3 * NUP, args.in[I_CB] + (size_t)l * NUP); SEAM(p0 + 8); }
        if (RUN(p0 + 9)) {
            pg8::Gemm g{WSP(bf16, WS_ACT), WSP(bf16, WS_WDN) + (size_t)l * DM * DFF, M, DM, DFF}; pg8::StaticOrder S; S.init(M, DM, F.G, F.bx);
            pg8::EpiResF32 E{args.out, args.out, DM};
            pg8::gemm_phase<pg8::EpiResF32, pg8::StaticOrder, true, true>(F.lds + RING_OFF, g, S, E);
            SEAM(p0 + 9); }
    }
#undef RUN
#undef SEAM
}

#ifndef MK_N_LAUNCHES
#define MK_N_LAUNCHES 1
#endif
extern "C" void kernel_launch(void* const* d_in, const int* in_sizes, int n_in, void* d_out, int out_size, void* d_ws, size_t ws_size, hipStream_t stream) {
    static int grid = 0;
    if (grid == 0) {
        if (n_in != 18 || in_sizes[0] != M * DM || out_size != M * DM || ws_size < WS_END) { fprintf(stderr, "kernel_launch: unexpected shapes (n_in %d, in0 %d, out %d, ws %zu)\n", n_in, n_in > 0 ? in_sizes[0] : -1, out_size, ws_size); grid = -1; return; }
        int dev = 0, cus = 0, per_cu = 0;
        if (hipGetDevice(&dev) != hipSuccess || hipDeviceGetAttribute(&cus, hipDeviceAttributeMultiprocessorCount, dev) != hipSuccess) { grid = -1; return; }
        if (hipFuncSetAttribute((const void*)fwd, hipFuncAttributeMaxDynamicSharedMemorySize, LDS_BYTES) != hipSuccess) { fprintf(stderr, "kernel_launch: hipFuncSetAttribute failed\n"); grid = -1; return; }
        if (hipOccupancyMaxActiveBlocksPerMultiprocessor(&per_cu, (const void*)fwd, NWAVES * 64, LDS_BYTES) != hipSuccess || per_cu < 1) fprintf(stderr, "kernel_launch: occupancy query reports %d\n", per_cu);
        (void)hipGetLastError();
        grid = cus;
    }
    if (grid < 0) return;
    if (hipMemsetAsync((char*)d_ws + WS_CTL, 0, CTL_ZERO_BYTES, stream) != hipSuccess) return;
    Args a{};
    for (int i = 0; i < 18; ++i) a.in[i] = (const float*)d_in[i];
    a.out = (float*)d_out; a.ws = (unsigned char*)d_ws; a.pad = 0;
    constexpr int NL = MK_N_LAUNCHES;
    for (int li = 0; li < NL; ++li) {
        a.ph_lo = (NL == 1) ? 0 : li; a.ph_hi = (NL == 1) ? N_PHASES : li + 1; a.li = (NL == 1) ? 0 : 0;
        hipLaunchKernelGGL(fwd, dim3(grid), dim3(NWAVES * 64), LDS_BYTES, stream, a);
    }
}
```

```cpp
#include <hip/hip_runtime.h>
#include <cstdio>
#include <cstdint>
namespace pg8 {
#define PG8_LAS __attribute__((address_space(3)))
typedef unsigned short bf16_t;
typedef short bf16x8 __attribute__((ext_vector_type(8)));
typedef float f32x4 __attribute__((ext_vector_type(4)));
typedef unsigned u32x4 __attribute__((ext_vector_type(4)));
constexpr int BM = 256, BK = 64, HALF = 128, HTB = HALF * BK * 2  , STAGE_BYTES = 8 * HTB, NXCD = 8, WGM = 8;

__host__ __device__ __forceinline__ int lds_byte(int r, int c) { const int st = (r >> 4) * 2 + (c >> 5), rr = r & 15, cc = c & 31, ob = rr * 64 + cc * 2; return st * 1024 + (ob ^ (((ob >> 9) & 1) << 5)); }
__host__ __device__ __forceinline__ void stage_rc(int b, int& R, int& C) { const int st = b / 1024, sb = b % 1024, swz = sb ^ (((sb >> 9) & 1) << 5); R = (st >> 1) * 16 + swz / 64; C = (st & 1) * 32 + (swz % 64) / 2; }
__host__ __device__ __forceinline__ int perm32(int rho) { const int n = rho >> 4, i = rho & 15; return 8 * (i >> 2) + 4 * n + (i & 3); }

struct Unit { int pm, pn; };
struct Gemm { const bf16_t* A; const bf16_t* Bt; int M, N, K; };

struct StaticOrder {
    int nM, nN, nwg, G, c;
    __host__ __device__ void init(int M, int N, int G_, int c_) { nM = M / BM; nN = N / BM; nwg = nM * nN; G = G_; c = c_; }
    __host__ __device__ bool next(int i, Unit& u) const {
        const long L = (long)i * G + c; if (L >= nwg) return false;
        int wgid = (int)L; { const int q = nwg / NXCD, r = nwg % NXCD, xcd = wgid % NXCD, off = wgid / NXCD; wgid = (xcd < r ? xcd * (q + 1) : r * (q + 1) + (xcd - r) * q) + off; }
        const int nig = WGM * nN, gid = wgid / nig, fm = gid * WGM, gsz = (nM - fm) < WGM ? (nM - fm) : WGM;
        u.pm = fm + ((wgid % nig) % gsz); u.pn = (wgid % nig) / gsz; return true;
    }
    __device__ __forceinline__ void a_ready(const Unit&) const {}
    __device__ __forceinline__ void done(const Unit&) const {}
};

__device__ __forceinline__ unsigned cvt_pk_bf16(float lo, float hi) { unsigned r; asm volatile("v_cvt_pk_bf16_f32 %0, %1, %2" : "=v"(r) : "v"(lo), "v"(hi)); return r; }
struct EpiBf16 {
    static constexpr bool PERM = true, AFTER_DRAIN = false;
    bf16_t* O; int ldc;
    __device__ __forceinline__ void operator()(const f32x4 (&acc)[2][2][4][2], const Unit& u, int wr, int wc, int fr, int fq) const {
        const int row0 = u.pm * BM + wr * 64 + fr; const int col0 = u.pn * BM + wc * 32 + 8 * fq;
#pragma unroll
        for (int ai = 0; ai < 2; ++ai)
#pragma unroll
            for (int m = 0; m < 4; ++m) { bf16_t* rowp = O + (size_t)(row0 + ai * HALF + m * 16) * ldc + col0;
#pragma unroll
                for (int bj = 0; bj < 2; ++bj) { const f32x4 v0 = acc[ai][bj][m][0], v1 = acc[ai][bj][m][1];
                    u32x4 w; w.x = cvt_pk_bf16(v0[0], v0[1]); w.y = cvt_pk_bf16(v0[2], v0[3]); w.z = cvt_pk_bf16(v1[0], v1[1]); w.w = cvt_pk_bf16(v1[2], v1[3]);
                    *(u32x4*)(rowp + bj * HALF) = w; } }
    }
};
__device__ __forceinline__ float bf_lo(unsigned w) { return __uint_as_float(w << 16); }
__device__ __forceinline__ float bf_hi(unsigned w) { return __uint_as_float(w & 0xffff0000u); }
__device__ __forceinline__ float sigmoid_f(float x) { return __builtin_amdgcn_rcpf(1.0f + __expf(-x)); }
template <bool FIRST> struct EpiGateAcc {
    static constexpr bool PERM = true, AFTER_DRAIN = false;
    bf16_t* O; int ldc; const bf16_t* G; int ldg;
    __device__ __forceinline__ void operator()(const f32x4 (&acc)[2][2][4][2], const Unit& u, int wr, int wc, int fr, int fq) const {
        const int row0 = u.pm * BM + wr * 64 + fr; const int col0 = u.pn * BM + wc * 32 + 8 * fq;
#pragma unroll
        for (int ai = 0; ai < 2; ++ai)
#pragma unroll
            for (int m = 0; m < 4; ++m) { const size_t row = (size_t)(row0 + ai * HALF + m * 16);
#pragma unroll
                for (int bj = 0; bj < 2; ++bj) { const f32x4 v0 = acc[ai][bj][m][0], v1 = acc[ai][bj][m][1];
                    const u32x4 g = *(const u32x4*)(G + row * ldg + col0 + bj * HALF);
                    u32x4 p = (u32x4){0u, 0u, 0u, 0u};
                    if (!FIRST) p = *(const u32x4*)(O + row * ldc + col0 + bj * HALF);
                    float o[8];
                    o[0] = bf_lo(p.x) + sigmoid_f(bf_lo(g.x)) * v0[0]; o[1] = bf_hi(p.x) + sigmoid_f(bf_hi(g.x)) * v0[1];
                    o[2] = bf_lo(p.y) + sigmoid_f(bf_lo(g.y)) * v0[2]; o[3] = bf_hi(p.y) + sigmoid_f(bf_hi(g.y)) * v0[3];
                    o[4] = bf_lo(p.z) + sigmoid_f(bf_lo(g.z)) * v1[0]; o[5] = bf_hi(p.z) + sigmoid_f(bf_hi(g.z)) * v1[1];
                    o[6] = bf_lo(p.w) + sigmoid_f(bf_lo(g.w)) * v1[2]; o[7] = bf_hi(p.w) + sigmoid_f(bf_hi(g.w)) * v1[3];
                    u32x4 w; w.x = cvt_pk_bf16(o[0], o[1]); w.y = cvt_pk_bf16(o[2], o[3]); w.z = cvt_pk_bf16(o[4], o[5]); w.w = cvt_pk_bf16(o[6], o[7]);
                    *(u32x4*)(O + row * ldc + col0 + bj * HALF) = w; } }
    }
};
struct EpiResF32 {
    static constexpr bool PERM = false, AFTER_DRAIN = false;
    const float* base; float* out; int ldc;
    __device__ __forceinline__ void operator()(const f32x4 (&acc)[2][2][4][2], const Unit& u, int wr, int wc, int fr, int fq) const {
        const int col0 = u.pn * BM + wc * 32 + 4 * fq;
#pragma unroll
        for (int ai = 0; ai < 2; ++ai)
#pragma unroll
            for (int m = 0; m < 4; ++m) { const size_t off = (size_t)(u.pm * BM + ai * HALF + wr * 64 + m * 16 + fr) * ldc + col0;
#pragma unroll
                for (int bj = 0; bj < 2; ++bj)
#pragma unroll
                    for (int n = 0; n < 2; ++n) { const f32x4 bs = *(const f32x4*)(base + off + bj * HALF + n * 16); *(f32x4*)(out + off + bj * HALF + n * 16) = bs + acc[ai][bj][m][n]; } }
    }
};

template <class Epi, class Sched, bool ALIGN_EPI = false, bool SP2 = false>
__device__ __forceinline__ void gemm_phase(PG8_LAS unsigned char* lds, const Gemm g, const Sched& S, const Epi& E) {
    int tid_ = threadIdx.x; asm volatile("" : "+v"(tid_));
    const int tid = tid_, wid = __builtin_amdgcn_readfirstlane(tid >> 6), lane = tid & 63, wr = wid >> 2, wc = wid & 3, fr = lane & 15, fq = lane >> 4;
    const int K = g.K, nt = K / BK;
    unsigned voffA[2], voffB[2];
#pragma unroll
    for (int i = 0; i < 2; ++i) { int R, C; stage_rc(tid * 16 + i * 8192, R, C); const int Rb = Epi::PERM ? ((R & ~31) + perm32(R & 31)) : R;
        voffA[i] = (unsigned)(R * K + C) * 2u; voffB[i] = (unsigned)(Rb * K + C) * 2u; }
    const size_t kstep = (size_t)(BK * 2);
    const size_t hstep = (size_t)HALF * K * 2;
    const size_t tstep = 2 * hstep;
    const unsigned ldsw = (unsigned)wid * 1024u;
    const int aoff = lds_byte(wr * 64 + fr, fq * 8), boff = lds_byte(wc * 32 + fr, fq * 8);
#define PG8_SA(b, h) (((b) * 2 + (h)) * HTB)
#define PG8_SB(b, h) ((4 + (b) * 2 + (h)) * HTB)
#define PG8_STAGE(bufoff, gbase, voff) do { _Pragma("unroll") for (int _i = 0; _i < 2; ++_i) \
        __builtin_amdgcn_global_load_lds((const unsigned*)((const char*)(gbase) + (voff)[_i]), (PG8_LAS unsigned*)(lds + (bufoff) + ldsw + _i * 8192), 16, 0, 0); } while (0)
#define PG8_LDA(dst, b, h) do { _Pragma("unroll") for (int m = 0; m < 4; ++m) _Pragma("unroll") for (int k = 0; k < 2; ++k) dst[m][k] = *(const PG8_LAS bf16x8*)(lds + PG8_SA(b, h) + aoff + m * 2048 + k * 1024); } while (0)
#define PG8_LDB(dst, b, h) do { _Pragma("unroll") for (int n = 0; n < 2; ++n) _Pragma("unroll") for (int k = 0; k < 2; ++k) dst[n][k] = *(const PG8_LAS bf16x8*)(lds + PG8_SB(b, h) + boff + n * 2048 + k * 1024); } while (0)
#define PG8_MMA(ai, bj, At, Bt) do { __builtin_amdgcn_s_setprio(1); _Pragma("unroll") for (int m = 0; m < 4; ++m) _Pragma("unroll") for (int n = 0; n < 2; ++n) _Pragma("unroll") for (int k = 0; k < 2; ++k) \
        acc[ai][bj][m][n] = __builtin_amdgcn_mfma_f32_16x16x32_bf16(Bt[n][k], At[m][k], acc[ai][bj][m][n], 0, 0, 0); __builtin_amdgcn_s_setprio(0); } while (0)
#define PG8_WAIT_V(n) asm volatile("s_waitcnt vmcnt(" #n ")" ::: "memory")
#define PG8_WAIT_L(n) asm volatile("s_waitcnt lgkmcnt(" #n ")" ::: "memory")
#define PG8_BAR __builtin_amdgcn_s_barrier()
#define PG8_SCHED __builtin_amdgcn_sched_barrier(0)
    Unit cur, nxt; int ui = 0;
    if (!S.next(0, cur)) return;
    f32x4 acc[2][2][4][2];
#pragma unroll
    for (int a = 0; a < 2; ++a)
#pragma unroll
        for (int b = 0; b < 2; ++b)
#pragma unroll
            for (int m = 0; m < 4; ++m)
#pragma unroll
                for (int n = 0; n < 2; ++n) acc[a][b][m][n] = (f32x4){0.f, 0.f, 0.f, 0.f};
    bf16x8 At[4][2], B0[2][2], B1[2][2];
    const char* cA = (const char*)g.A + (size_t)cur.pm * tstep; const char* cB = (const char*)g.Bt + (size_t)cur.pn * tstep;
    S.a_ready(cur);
    if constexpr (SP2) {
        PG8_STAGE(PG8_SB(0, 0), cB, voffB); PG8_STAGE(PG8_SB(0, 1), cB + hstep, voffB); PG8_STAGE(PG8_SA(0, 0), cA, voffA); PG8_STAGE(PG8_SA(0, 1), cA + hstep, voffA);
        if (wr == 1) PG8_BAR;
        PG8_WAIT_V(2); PG8_BAR;
        PG8_STAGE(PG8_SB(1, 0), cB + kstep, voffB); PG8_STAGE(PG8_SA(1, 0), cA + kstep, voffA); PG8_STAGE(PG8_SB(1, 1), cB + hstep + kstep, voffB);
        PG8_WAIT_V(6); PG8_BAR;
    } else {
        PG8_STAGE(PG8_SB(0, 0), cB, voffB); PG8_STAGE(PG8_SA(0, 0), cA, voffA); PG8_STAGE(PG8_SB(0, 1), cB + hstep, voffB); PG8_STAGE(PG8_SA(0, 1), cA + hstep, voffA);
        if (wr == 1) PG8_BAR;
        PG8_WAIT_V(4); PG8_BAR;
        PG8_STAGE(PG8_SB(1, 0), cB + kstep, voffB); PG8_STAGE(PG8_SA(1, 0), cA + kstep, voffA); PG8_STAGE(PG8_SB(1, 1), cB + hstep + kstep, voffB);
        PG8_WAIT_V(6); PG8_BAR;
    }
    for (;;) {
        const bool has_next = S.next(ui + 1, nxt);
        const char* nA = has_next ? (const char*)g.A + (size_t)nxt.pm * tstep : cA; const char* nB = has_next ? (const char*)g.Bt + (size_t)nxt.pn * tstep : cB;
        for (int t = 0; t < nt; t += 2) {
            const bool last = (t == nt - 2);
            const char* a1 = cA + (size_t)(t + 1) * kstep;
            const char* a2 = last ? nA : cA + (size_t)(t + 2) * kstep; const char* b2 = last ? nB : cB + (size_t)(t + 2) * kstep;
            const char* a3 = a2 + kstep; const char* b3 = b2 + kstep;
            if (last && has_next) S.a_ready(nxt);
            if constexpr (SP2) {
            PG8_LDB(B0, 0, 0); PG8_LDB(B1, 0, 1); PG8_SCHED; PG8_LDA(At, 0, 0); PG8_STAGE(PG8_SA(1, 1), a1 + hstep, voffA);
            PG8_WAIT_V(8); PG8_WAIT_L(0); PG8_BAR; PG8_MMA(0, 0, At, B0); PG8_MMA(0, 1, At, B1); PG8_BAR; PG8_SCHED;
            PG8_LDA(At, 0, 1); PG8_STAGE(PG8_SB(0, 0), b2, voffB); PG8_STAGE(PG8_SB(0, 1), b2 + hstep, voffB); PG8_STAGE(PG8_SA(0, 0), a2, voffA);
            PG8_WAIT_V(8); PG8_WAIT_L(0); PG8_BAR; PG8_MMA(1, 0, At, B0); PG8_MMA(1, 1, At, B1); PG8_BAR; PG8_SCHED;
            PG8_LDB(B0, 1, 0); PG8_LDB(B1, 1, 1); PG8_SCHED; PG8_LDA(At, 1, 0); PG8_STAGE(PG8_SA(0, 1), a2 + hstep, voffA);
            PG8_WAIT_V(8); PG8_WAIT_L(0); PG8_BAR; PG8_MMA(0, 0, At, B0); PG8_MMA(0, 1, At, B1); PG8_BAR; PG8_SCHED;
            PG8_LDA(At, 1, 1); PG8_STAGE(PG8_SB(1, 0), b3, voffB); PG8_STAGE(PG8_SB(1, 1), b3 + hstep, voffB); PG8_STAGE(PG8_SA(1, 0), a3, voffA);
            PG8_WAIT_V(8); PG8_WAIT_L(0); PG8_BAR; PG8_MMA(1, 0, At, B0); PG8_MMA(1, 1, At, B1); PG8_BAR; PG8_SCHED;
            } else {
            PG8_LDB(B0, 0, 0); PG8_SCHED; PG8_LDA(At, 0, 0); PG8_STAGE(PG8_SA(1, 1), a1 + hstep, voffA);
            PG8_WAIT_L(8); PG8_BAR; PG8_WAIT_L(0); PG8_MMA(0, 0, At, B0); PG8_BAR; PG8_SCHED;
            PG8_LDB(B1, 0, 1); PG8_STAGE(PG8_SB(0, 0), b2, voffB);
            PG8_BAR; PG8_WAIT_L(0); PG8_MMA(0, 1, At, B1); PG8_BAR;
            PG8_LDA(At, 0, 1); PG8_STAGE(PG8_SA(0, 0), a2, voffA);
            PG8_BAR; PG8_WAIT_L(0); PG8_MMA(1, 0, At, B0); PG8_BAR; PG8_SCHED;
            PG8_STAGE(PG8_SB(0, 1), b2 + hstep, voffB);
            PG8_WAIT_V(6); PG8_BAR; PG8_MMA(1, 1, At, B1); PG8_BAR;
            PG8_LDB(B0, 1, 0); PG8_SCHED; PG8_LDA(At, 1, 0); PG8_STAGE(PG8_SA(0, 1), a2 + hstep, voffA);
            PG8_WAIT_L(8); PG8_BAR; PG8_WAIT_L(0); PG8_MMA(0, 0, At, B0); PG8_BAR; PG8_SCHED;
            PG8_LDB(B1, 1, 1); PG8_STAGE(PG8_SB(1, 0), b3, voffB);
            PG8_BAR; PG8_WAIT_L(0); PG8_MMA(0, 1, At, B1); PG8_BAR;
            PG8_LDA(At, 1, 1); PG8_STAGE(PG8_SA(1, 0), a3, voffA);
            PG8_BAR; PG8_WAIT_L(0); PG8_MMA(1, 0, At, B0); PG8_BAR; PG8_SCHED;
            PG8_STAGE(PG8_SB(1, 1), b3 + hstep, voffB);
            PG8_WAIT_V(6); PG8_BAR; PG8_MMA(1, 1, At, B1); PG8_BAR;
            }
        }
        if constexpr (ALIGN_EPI) { if (wr == 0) PG8_BAR; }
        if constexpr (!Epi::AFTER_DRAIN) { E(acc, cur, wr, wc, fr, fq); S.done(cur); }
        if (!has_next) break;
#pragma unroll
        for (int a = 0; a < 2; ++a)
#pragma unroll
            for (int b = 0; b < 2; ++b)
#pragma unroll
                for (int m = 0; m < 4; ++m)
#pragma unroll
                    for (int n = 0; n < 2; ++n) acc[a][b][m][n] = (f32x4){0.f, 0.f, 0.f, 0.f};
        cur = nxt; cA = nA; cB = nB; ++ui;
        if constexpr (ALIGN_EPI) { if (wr == 1) PG8_BAR; }
    }
    PG8_WAIT_V(0);
    if constexpr (!ALIGN_EPI) { if (wr == 0) PG8_BAR; }
    PG8_BAR;
    if constexpr (Epi::AFTER_DRAIN) { E.fused(acc, cur, wr, wc, fr, fq, lds, wid, lane); S.done(cur); }
#undef PG8_SA
#undef PG8_SB
#undef PG8_STAGE
#undef PG8_LDA
#undef PG8_LDB
#undef PG8_MMA
#undef PG8_WAIT_V
#undef PG8_WAIT_L
#undef PG8_BAR
#undef PG8_SCHED
}
}

constexpr int NWAVES = 8;
constexpr int BATCH = 8, SEQ = 2048, DM = 2048, DEPTH = 4, M = BATCH * SEQ, NH = 8;
constexpr int NIN = 16400, NZ = 16384, DFF = 5632, NUP = 2 * DFF, NY = 3072;
constexpr int Z_RQ = 0, Z_RK = 1024, Z_RV = 2048, Z_RG = 3072, Z_MQ = 4096, Z_MK = 4608, Z_MV = 5120, Z_MO = 6144, Z_AQ = 7168, Z_AK = 8192, Z_AV = 9216, Z_GA = 10240, Z_GB = 12288, Z_GC = 14336;
constexpr int W_GATE_COL = 7168;
constexpr size_t MiB = 1u << 20;
constexpr size_t WS_CTL = 0, CTL_ZERO_BYTES = 1 * MiB;
constexpr size_t WS_TAB = 2 * MiB;
constexpr size_t WS_W16T = 4 * MiB;
constexpr size_t WS_KMEAN = 5 * MiB;
constexpr size_t WS_GIF = 6 * MiB;
constexpr size_t WS_WIN = 8 * MiB;
constexpr size_t WS_WP = 264 * MiB;
constexpr size_t WS_WOUT = 312 * MiB;
constexpr size_t WS_WUP = 344 * MiB;
constexpr size_t WS_WDN = 520 * MiB;
constexpr size_t WS_H = 608 * MiB;
constexpr size_t WS_Z = 672 * MiB;
constexpr size_t WS_Y = 1184 * MiB;
constexpr size_t WS_MG = 1280 * MiB;
constexpr size_t WS_ACT = 1344 * MiB;
constexpr size_t WS_END = 1520 * MiB;
constexpr int CW_TMO = 0, CW_CODE = 1;
constexpr int CW_BAR = 4096;
constexpr int CW_QUEUE = 8192;
constexpr int RING_OFF = 0, RING_BYTES = 131072;
constexpr int LDS_BYTES = 163840;
constexpr int LDSCTL_OFF = LDS_BYTES - 512, MISC_OFF = LDSCTL_OFF + 320;
static_assert(MISC_OFF + 128 <= LDS_BYTES, "LDS map");

#define GAS __attribute__((address_space(1)))
#define LAS __attribute__((address_space(3)))
typedef unsigned short bf16;
typedef unsigned v4u __attribute__((ext_vector_type(4)));
typedef unsigned v2u __attribute__((ext_vector_type(2)));
typedef float f32x4 __attribute__((ext_vector_type(4)));
typedef float f32x2 __attribute__((ext_vector_type(2)));
typedef GAS unsigned gu32;
#define RLX_AGENT __ATOMIC_RELAXED, __HIP_MEMORY_SCOPE_AGENT
#define LDS_WAIT() asm volatile("s_waitcnt lgkmcnt(0)" ::: "memory")
#define VM_WAIT() asm volatile("s_waitcnt vmcnt(0)" ::: "memory")
typedef __bf16 bf16x2_t __attribute__((ext_vector_type(2)));
__device__ __forceinline__ unsigned pk2(float lo, float hi) { const f32x2 v = {lo, hi}; const bf16x2_t b = __builtin_convertvector(v, bf16x2_t); return __builtin_bit_cast(unsigned, b); }
__device__ __forceinline__ unsigned f2bf(float f) { return pk2(f, f); }
__device__ __forceinline__ float bflo(unsigned w) { return __uint_as_float(w << 16); }
__device__ __forceinline__ float bfhi(unsigned w) { return __uint_as_float(w & 0xffff0000u); }
__device__ __forceinline__ float bf1(bf16 v) { return __uint_as_float((unsigned)v << 16); }
__device__ __forceinline__ float sigm(float x) { return 1.0f / (1.0f + __expf(-x)); }

#define XB_TMO      128
#define XB_XCNT(j)  (256  + 64 * (j))
#define XB_XSUB(j)  (1280 + 64 * (j))
#define XB_XGEN(j)  (2304 + 64 * (j))
#define XB_TOP      3328
#define XB_TOPGEN   3392
#define XCD_BAR_WORDS 3456
#define XB_SPIN_CAP (1u << 18)

__device__ __forceinline__ unsigned xb_ld(unsigned* p)              { return __hip_atomic_load(p, __ATOMIC_RELAXED, __HIP_MEMORY_SCOPE_AGENT); }
__device__ __forceinline__ unsigned xb_add(unsigned* p, unsigned v) { return __hip_atomic_fetch_add(p, v, __ATOMIC_RELAXED, __HIP_MEMORY_SCOPE_AGENT); }
__device__ __forceinline__ unsigned xb_xcc_id() { return (unsigned)__builtin_amdgcn_s_getreg((3 << 11) | 20) & 0xFu; }
#define XB_SPIN(cond, bar) do { unsigned _sp = 0; while (cond) { __builtin_amdgcn_s_sleep(1); \
    if ((++_sp & 255u) == 0u) { if (xb_ld(&(bar)[XB_TMO])) break; if (_sp > XB_SPIN_CAP) { atomicAdd(&(bar)[XB_TMO], 1u); break; } } } } while (0)

struct XcdBarrier {
    unsigned* bar; unsigned x;
    volatile LAS unsigned* st;
};

__device__ __forceinline__ XcdBarrier xcd_barrier_post(unsigned* bar, volatile LAS unsigned* st) {
    XcdBarrier b; b.bar = bar; b.x = xb_xcc_id(); b.st = st;
    if (threadIdx.x == 0) (void)xb_add(&bar[XB_XCNT(b.x)], 1u);
    return b;
}
__device__ __forceinline__ void xcd_barrier_complete(unsigned* bar, unsigned x, unsigned& nloc, unsigned& nx) {
    const unsigned G = gridDim.x * gridDim.y * gridDim.z;
    unsigned sum, cnt, mine, sp = 0u;
    for (;;) {
        sum = 0u; cnt = 0u; mine = 0u;
#pragma unroll
        for (unsigned j = 0; j < 16; ++j) { const unsigned c = xb_ld(&bar[XB_XCNT(j)]); sum += c; cnt += (c > 0u) ? 1u : 0u; mine = (j == x) ? c : mine; }
        if (sum == G) break;
        __builtin_amdgcn_s_sleep(1);
        if ((++sp & 255u) == 0u) { if (xb_ld(&bar[XB_TMO])) break; if (sp > XB_SPIN_CAP) { atomicAdd(&bar[XB_TMO], 1u); break; } }
    }
    nloc = mine > 0u ? mine : 1u; nx = cnt > 0u ? cnt : 1u;
}

__device__ __forceinline__ void xcd_barrier(const XcdBarrier& b) {
    asm volatile("s_waitcnt vmcnt(0)" ::: "memory");
    __syncthreads();
    if (threadIdx.x == 0) {
        unsigned* bar = b.bar;
        __builtin_amdgcn_s_waitcnt(0);
        unsigned nloc = b.st[0], nx = b.st[1];
        if (nloc == 0u) { xcd_barrier_complete(bar, b.x, nloc, nx); b.st[0] = nloc; b.st[1] = nx; }
        const unsigned old = xb_add(&bar[XB_XSUB(b.x)], 1u);
        const unsigned gen = old / nloc;
        if (old + 1u == (gen + 1u) * nloc) {
            __builtin_amdgcn_fence(__ATOMIC_RELEASE, "agent");
            asm volatile("s_waitcnt vmcnt(0)" ::: "memory");
            const unsigned og = xb_add(&bar[XB_TOP], 1u);
            const unsigned tg = og / nx;
            if (og + 1u == (tg + 1u) * nx) xb_add(&bar[XB_TOPGEN], 1u);
            else XB_SPIN(xb_ld(&bar[XB_TOPGEN]) == tg, bar);
            __builtin_amdgcn_fence(__ATOMIC_ACQUIRE, "agent");
            xb_add(&bar[XB_XGEN(b.x)], 1u);
            asm volatile("s_waitcnt vmcnt(0)" ::: "memory");
        } else {
            XB_SPIN(xb_ld(&bar[XB_XGEN(b.x)]) == gen, bar);
            __builtin_amdgcn_fence(__ATOMIC_ACQUIRE, "agent");
            asm volatile("s_waitcnt vmcnt(0)" ::: "memory");
        }
    }
    __syncthreads();
}

struct Args { const float* in[18]; float* out; unsigned char* ws; int ph_lo, ph_hi, li, pad; };
enum { I_X = 0, I_WIN, I_BIG, I_BFG, I_NMIX, I_RGN, I_MLN, I_QN, I_KN, I_WPA, I_WPB, I_WPC, I_WOUT, I_NFFN, I_WUP, I_CW, I_CB, I_WDN };
struct Frame {
    LAS unsigned char* lds;
    volatile LAS unsigned* MISC;
    unsigned char* ws;
    int tid, lane, wave, G, bx;
};
#define WSP(T, off) ((T*)(F.ws + (off)))
__device__ __forceinline__ float wave_sum(float v) {
#pragma unroll
    for (int o = 1; o < 64; o <<= 1) v += __shfl_xor(v, o);
    return v;
}
__device__ __forceinline__ float wave_max(float v) {
#pragma unroll
    for (int o = 1; o < 64; o <<= 1) v = fmaxf(v, __shfl_xor(v, o));
    return v;
}
__device__ __forceinline__ void p0_transpose_item(const float* W, int ldw, int K, int nblk, bf16* WT, LAS float* scr, int item, int lane) {
    const int kb = item / nblk, nb = item % nblk, k0 = 64 * kb, n0 = 32 * nb;
#pragma unroll 8
    for (int i = 0; i < 32; ++i) { const int kk = 2 * i + (lane >> 5); scr[kk * 33 + (lane & 31)] = W[(size_t)(k0 + kk) * ldw + n0 + (lane & 31)]; }
    LDS_WAIT(); asm volatile("" ::: "memory");
    const int c = lane & 7;
#pragma unroll
    for (int j = 0; j < 4; ++j) { const int n = (lane >> 3) + 8 * j; const LAS float* s = scr + (8 * c) * 33 + n;
        v4u o; o.x = pk2(s[0 * 33], s[1 * 33]); o.y = pk2(s[2 * 33], s[3 * 33]); o.z = pk2(s[4 * 33], s[5 * 33]); o.w = pk2(s[6 * 33], s[7 * 33]);
        *(GAS v4u*)(WT + (size_t)(n0 + n) * K + k0 + 8 * c) = o; }
    LDS_WAIT(); asm volatile("" ::: "memory");
}
__device__ __forceinline__ void p0_prologue(Frame& F, const Args& args) {
    LAS float* scr = (LAS float*)(F.lds + RING_OFF + F.wave * 16384);
    const int gw = F.bx * NWAVES + F.wave, NGW = F.G * NWAVES;
    constexpr int I_INA = 32 * 224, I_INB = 32 * 288, I_P = 16 * 64, I_OUT = 32 * 64, I_UP = 32 * 352, I_DN = 88 * 64;
    constexpr int I_LAYER = I_INA + I_INB + 3 * I_P + I_OUT + I_UP + I_DN;
    for (int it = gw; it < DEPTH * I_LAYER; it += NGW) {
        const int l = it / I_LAYER; int r = it % I_LAYER;
        const float* win = args.in[I_WIN] + (size_t)l * DM * NIN; bf16* wint = WSP(bf16, WS_WIN) + (size_t)l * NZ * DM;
        if (r < I_INA) { p0_transpose_item(win, NIN, DM, 224, wint, scr, r, F.lane); continue; } r -= I_INA;
        if (r < I_INB) { p0_transpose_item(win + 7184, NIN, DM, 288, wint + (size_t)7168 * DM, scr, r, F.lane); continue; } r -= I_INB;
        if (r < I_P) { p0_transpose_item(args.in[I_WPA] + (size_t)l * 1024 * DM, DM, 1024, 64, WSP(bf16, WS_WP) + ((size_t)l * 3 + 0) * DM * 1024, scr, r, F.lane); continue; } r -= I_P;
        if (r < I_P) { p0_transpose_item(args.in[I_WPB] + (size_t)l * 1024 * DM, DM, 1024, 64, WSP(bf16, WS_WP) + ((size_t)l * 3 + 1) * DM * 1024, scr, r, F.lane); continue; } r -= I_P;
        if (r < I_P) { p0_transpose_item(args.in[I_WPC] + (size_t)l * 1024 * DM, DM, 1024, 64, WSP(bf16, WS_WP) + ((size_t)l * 3 + 2) * DM * 1024, scr, r, F.lane); continue; } r -= I_P;
        if (r < I_OUT) { p0_transpose_item(args.in[I_WOUT] + (size_t)l * DM * DM, DM, DM, 64, WSP(bf16, WS_WOUT) + (size_t)l * DM * DM, scr, r, F.lane); continue; } r -= I_OUT;
        if (r < I_UP) { p0_transpose_item(args.in[I_WUP] + (size_t)l * DM * NUP, NUP, DM, 352, WSP(bf16, WS_WUP) + (size_t)l * NUP * DM, scr, r, F.lane); continue; } r -= I_UP;
        p0_transpose_item(args.in[I_WDN] + (size_t)l * DFF * DM, DM, DFF, 64, WSP(bf16, WS_WDN) + (size_t)l * DM * DFF, scr, r, F.lane);
    }
    const int gt = F.bx * (NWAVES * 64) + F.tid, NGT = F.G * NWAVES * 64;
    for (int i = gt; i < DEPTH * 16 * DM; i += NGT) { const int l = i / (16 * DM), c = (i / DM) % 16, k = i % DM; WSP(float, WS_W16T)[i] = args.in[I_WIN][((size_t)l * DM + k) * NIN + W_GATE_COL + c]; }
    for (int i = gt; i < 2 * SEQ * 64; i += NGT) { const int which = i / (SEQ * 64), pos = (i / 64) % SEQ, d = i % 64;
        const float ex = which == 0 ? (float)d / 63.0f : (float)(2 * d) / 128.0f;
        const float inv = 1.0f / powf(10000.0f, ex); const float ang = (float)pos * inv; float s, c; sincosf(ang, &s, &c); WSP(f32x2, WS_TAB)[i] = (f32x2){c, s}; }
}
template <bool GATES> __device__ __forceinline__ void norm_phase(Frame& F, const float* x, const float* g, const float* w16t, const float* big, const float* bfg) {
    LAS float* wl = (LAS float*)(F.lds + RING_OFF);
    if (GATES) { for (int i = F.tid; i < 16 * DM / 4; i += NWAVES * 64) ((LAS f32x4*)wl)[i] = ((const f32x4*)w16t)[i]; __syncthreads(); }
    const int gw = F.bx * NWAVES + F.wave, NGW = F.G * NWAVES, lane = F.lane;
    f32x4 gv[8];
#pragma unroll
    for (int j = 0; j < 8; ++j) gv[j] = ((const f32x4*)g)[64 * j + lane];
    for (int m = gw; m < M; m += NGW) {
        const f32x4* xr = (const f32x4*)(x + (size_t)m * DM) + lane;
        f32x4 v[8]; float s = 0.f;
#pragma unroll
        for (int j = 0; j < 8; ++j) { v[j] = xr[64 * j]; s += (v[j].x * v[j].x + v[j].y * v[j].y) + (v[j].z * v[j].z + v[j].w * v[j].w); }
        const float rstd = rsqrtf(wave_sum(s) * (1.f / DM) + 1e-6f);
        v2u* o8 = (v2u*)(WSP(bf16, WS_H) + (size_t)m * DM) + lane;
#pragma unroll
        for (int j = 0; j < 8; ++j) { v[j] = v[j] * rstd * gv[j]; v2u w; w.x = pk2(v[j].x, v[j].y); w.y = pk2(v[j].z, v[j].w); o8[64 * j] = w; }
        if (GATES) {
            float mine = 0.f;
#pragma unroll 1
            for (int c = 0; c < 16; ++c) { float p = 0.f;
#pragma unroll
                for (int j = 0; j < 8; ++j) { const f32x4 w = ((const LAS f32x4*)(wl + c * DM))[64 * j + lane]; p += (v[j].x * w.x + v[j].y * w.y) + (v[j].z * w.z + v[j].w * w.w); }
                p = wave_sum(p); if (lane == c) mine = p; }
            if (lane < 16) { const int hh = lane & 7; float pre = mine + (lane < 8 ? big[hh] : bfg[hh]);
                const float sc = 15.0f * tanhf(pre * (1.0f / 15.0f));
                float o = sc;
                if (lane >= 8) o = sc > 0.f ? -log1pf(__expf(-sc)) : sc - log1pf(__expf(sc));
                WSP(float, WS_GIF)[(size_t)m * 16 + lane] = o; }
        }
    }
}
__device__ __forceinline__ void prep_phase(Frame& F, const float* qn, const float* kn) {
    const int gw = F.bx * NWAVES + F.wave, NGW = F.G * NWAVES, lane = F.lane, rsub = lane >> 2, dg = lane & 3;
    const f32x2* trope = WSP(f32x2, WS_TAB) + SEQ * 64;
    for (int u = gw; u < 2 * BATCH * 16 * NH; u += NGW) {
        const int kind = u & 1, hh = (u >> 1) & 7, hb = (u >> 4) & 15, b = u >> 8;
        const float* wn = kind ? kn : qn;
        float wl[16], wh[16], s1[16], s2[16];
#pragma unroll
        for (int e = 0; e < 16; ++e) { wl[e] = wn[16 * dg + e]; wh[e] = wn[64 + 16 * dg + e]; s1[e] = 0.f; s2[e] = 0.f; }
        bf16* zb = WSP(bf16, WS_Z) + (size_t)(b * SEQ + hb * 128) * NZ + (kind ? Z_AK : Z_AQ) + hh * 128 + 16 * dg;
#pragma unroll 2
        for (int st = 0; st < 8; ++st) {
            const int r = rsub + 16 * st, pos = hb * 128 + r; bf16* zr = zb + (size_t)r * NZ;
            const v4u l0 = *(const v4u*)(zr), l1 = *(const v4u*)(zr + 8), h0 = *(const v4u*)(zr + 64), h1 = *(const v4u*)(zr + 72);
            float a[16] = {bflo(l0.x), bfhi(l0.x), bflo(l0.y), bfhi(l0.y), bflo(l0.z), bfhi(l0.z), bflo(l0.w), bfhi(l0.w), bflo(l1.x), bfhi(l1.x), bflo(l1.y), bfhi(l1.y), bflo(l1.z), bfhi(l1.z), bflo(l1.w), bfhi(l1.w)};
            float c[16] = {bflo(h0.x), bfhi(h0.x), bflo(h0.y), bfhi(h0.y), bflo(h0.z), bfhi(h0.z), bflo(h0.w), bfhi(h0.w), bflo(h1.x), bfhi(h1.x), bflo(h1.y), bfhi(h1.y), bflo(h1.z), bfhi(h1.z), bflo(h1.w), bfhi(h1.w)};
            float ss = 0.f;
#pragma unroll
            for (int e = 0; e < 16; ++e) ss += a[e] * a[e] + c[e] * c[e];
            ss += __shfl_xor(ss, 1); ss += __shfl_xor(ss, 2);
            const float rstd = rsqrtf(ss * (1.f / 128.f) + 1e-6f);
            const f32x2* tb = trope + pos * 64 + 16 * dg;
#pragma unroll
            for (int e = 0; e < 16; ++e) { const float x1 = a[e] * rstd * wl[e], x2 = c[e] * rstd * wh[e]; const f32x2 cs = tb[e]; a[e] = x1 * cs.x - x2 * cs.y; c[e] = x1 * cs.y + x2 * cs.x; s1[e] += a[e]; s2[e] += c[e]; }
            *(v4u*)(zr) = (v4u){pk2(a[0], a[1]), pk2(a[2], a[3]), pk2(a[4], a[5]), pk2(a[6], a[7])}; *(v4u*)(zr + 8) = (v4u){pk2(a[8], a[9]), pk2(a[10], a[11]), pk2(a[12], a[13]), pk2(a[14], a[15])};
            *(v4u*)(zr + 64) = (v4u){pk2(c[0], c[1]), pk2(c[2], c[3]), pk2(c[4], c[5]), pk2(c[6], c[7])}; *(v4u*)(zr + 72) = (v4u){pk2(c[8], c[9]), pk2(c[10], c[11]), pk2(c[12], c[13]), pk2(c[14], c[15])};
        }
        if (kind) {
            float* km = WSP(float, WS_KMEAN) + (size_t)((b * NH + hh) * 16 + hb) * 128 + 16 * dg;
#pragma unroll
            for (int e = 0; e < 16; ++e) { float x = s1[e], y = s2[e];
                x += __shfl_xor(x, 4); x += __shfl_xor(x, 8); x += __shfl_xor(x, 16); x += __shfl_xor(x, 32);
                y += __shfl_xor(y, 4); y += __shfl_xor(y, 8); y += __shfl_xor(y, 16); y += __shfl_xor(y, 32);
                if (rsub == 0) { km[e] = x * (1.f / 256.f); km[64 + e] = y * (1.f / 256.f); } }
        }
    }
}
__device__ __forceinline__ void glu_phase(Frame& F, const float* cw, const float* cb) {
    const int gw = F.bx * NWAVES + F.wave, NGW = F.G * NWAVES, lane = F.lane;
    constexpr int RB = 8, NCG = DFF / 512;
    const bf16* U = WSP(bf16, WS_Z); bf16* ACT = WSP(bf16, WS_ACT);
    for (int it = gw; it < (M / RB) * NCG; it += NGW) {
        const int cgp = it % NCG, rb = it / NCG, c8 = (cgp * 64 + lane) * 8, m0 = rb * RB; const bool first = (m0 & (SEQ - 1)) == 0;
        v4u ua[RB + 2], ub[RB + 2];
#pragma unroll
        for (int r = 0; r < RB + 2; ++r) { const int m = m0 - 2 + r;
            if (r < 2 && first) { ua[r] = (v4u){0u, 0u, 0u, 0u}; ub[r] = (v4u){0u, 0u, 0u, 0u}; }
            else { ua[r] = *(const v4u*)(U + (size_t)m * NUP + c8); ub[r] = *(const v4u*)(U + (size_t)m * NUP + DFF + c8); } }
        float wa[3][8], wb[3][8], ba[8], bb[8];
#pragma unroll
        for (int j = 0; j < 3; ++j) { const f32x4 a0 = *(const f32x4*)(cw + (size_t)j * NUP + c8), a1 = *(const f32x4*)(cw + (size_t)j * NUP + c8 + 4), b0 = *(const f32x4*)(cw + (size_t)j * NUP + DFF + c8), b1 = *(const f32x4*)(cw + (size_t)j * NUP + DFF + c8 + 4);
            wa[j][0] = a0.x; wa[j][1] = a0.y; wa[j][2] = a0.z; wa[j][3] = a0.w; wa[j][4] = a1.x; wa[j][5] = a1.y; wa[j][6] = a1.z; wa[j][7] = a1.w;
            wb[j][0] = b0.x; wb[j][1] = b0.y; wb[j][2] = b0.z; wb[j][3] = b0.w; wb[j][4] = b1.x; wb[j][5] = b1.y; wb[j][6] = b1.z; wb[j][7] = b1.w; }
        { const f32x4 a0 = *(const f32x4*)(cb + c8), a1 = *(const f32x4*)(cb + c8 + 4), b0 = *(const f32x4*)(cb + DFF + c8), b1 = *(const f32x4*)(cb + DFF + c8 + 4);
          ba[0] = a0.x; ba[1] = a0.y; ba[2] = a0.z; ba[3] = a0.w; ba[4] = a1.x; ba[5] = a1.y; ba[6] = a1.z; ba[7] = a1.w; bb[0] = b0.x; bb[1] = b0.y; bb[2] = b0.z; bb[3] = b0.w; bb[4] = b1.x; bb[5] = b1.y; bb[6] = b1.z; bb[7] = b1.w; }
#pragma unroll
        for (int r = 0; r < RB; ++r) {
            float xa[8], xb[8];
#pragma unroll
            for (int e = 0; e < 8; ++e) { xa[e] = ba[e]; xb[e] = bb[e]; }
#pragma unroll
            for (int j = 0; j < 3; ++j) { const v4u a = ua[r + j], b = ub[r + j];
                const float fa[8] = {bflo(a.x), bfhi(a.x), bflo(a.y), bfhi(a.y), bflo(a.z), bfhi(a.z), bflo(a.w), bfhi(a.w)};
                const float fb[8] = {bflo(b.x), bfhi(b.x), bflo(b.y), bfhi(b.y), bflo(b.z), bfhi(b.z), bflo(b.w), bfhi(b.w)};
#pragma unroll
                for (int e = 0; e < 8; ++e) { xa[e] += fa[e] * wa[j][e]; xb[e] += fb[e] * wb[j][e]; } }
            float o[8];
#pragma unroll
            for (int e = 0; e < 8; ++e) o[e] = xa[e] * __builtin_amdgcn_rcpf(1.0f + __expf(-xa[e])) * xb[e];
            *(v4u*)(ACT + (size_t)(m0 + r) * DFF + c8) = (v4u){pk2(o[0], o[1]), pk2(o[2], o[3]), pk2(o[4], o[5]), pk2(o[6], o[7])};
        }
    }
}
namespace mx {
typedef short bf16x8 __attribute__((ext_vector_type(8)));
typedef short s16x4 __attribute__((ext_vector_type(4)));
#define MFMA16(a, b, c) __builtin_amdgcn_mfma_f32_16x16x32_bf16((a), (b), (c), 0, 0, 0)
#define LDS_FENCE() asm volatile("s_waitcnt lgkmcnt(0)" ::: "memory")
#define SCHED_FENCE() __builtin_amdgcn_sched_barrier(0)
__device__ __forceinline__ bf16x8 frag_row(const LAS bf16* X, int ld, int r0, int c0, int lane) {
    return *(const LAS bf16x8*)(X + (r0 + (lane & 15)) * ld + c0 + 8 * (lane >> 4)); }
__device__ __forceinline__ bf16x8 frag_tr(const LAS bf16* X, int ld, int k0, int c0, int lane) {
    const int g = lane >> 4, q = (lane & 15) >> 2, p = lane & 3;
    const LAS bf16* a = X + (k0 + 8 * g + q) * ld + c0 + 4 * p;
    const s16x4 lo = __builtin_amdgcn_ds_read_tr16_b64_v4i16((LAS s16x4*)a);
    const s16x4 hi = __builtin_amdgcn_ds_read_tr16_b64_v4i16((LAS s16x4*)(a + 4 * ld));
    return __builtin_shufflevector(lo, hi, 0, 1, 2, 3, 4, 5, 6, 7);
}
__device__ __forceinline__ float red16_sum(float v) { v += __shfl_xor(v, 1); v += __shfl_xor(v, 2); v += __shfl_xor(v, 4); v += __shfl_xor(v, 8); return v; }
__device__ __forceinline__ float red16_max(float v) { v = fmaxf(v, __shfl_xor(v, 1)); v = fmaxf(v, __shfl_xor(v, 2)); v = fmaxf(v, __shfl_xor(v, 4)); v = fmaxf(v, __shfl_xor(v, 8)); return v; }
__device__ __forceinline__ void rot8(const v4u lo, const v4u hi, const f32x2* tb, float sc, v4u& olo, v4u& ohi) {
    float a[8] = {bflo(lo.x), bfhi(lo.x), bflo(lo.y), bfhi(lo.y), bflo(lo.z), bfhi(lo.z), bflo(lo.w), bfhi(lo.w)};
    float c[8] = {bflo(hi.x), bfhi(hi.x), bflo(hi.y), bfhi(hi.y), bflo(hi.z), bfhi(hi.z), bflo(hi.w), bfhi(hi.w)};
    float o1[8], o2[8];
#pragma unroll
    for (int e = 0; e < 8; ++e) { const f32x2 cs = tb[e]; o1[e] = (a[e] * cs.x - c[e] * cs.y) * sc; o2[e] = (a[e] * cs.y + c[e] * cs.x) * sc; }
    olo = (v4u){pk2(o1[0], o1[1]), pk2(o1[2], o1[3]), pk2(o1[4], o1[5]), pk2(o1[6], o1[7])};
    ohi = (v4u){pk2(o2[0], o2[1]), pk2(o2[2], o2[3]), pk2(o2[4], o2[5]), pk2(o2[6], o2[7])};
}
constexpr int LQ = 136;
__device__ __forceinline__ void ret_unit(Frame& F, const float* gn, int b, int h) {
    LAS bf16* Qs = (LAS bf16*)(F.lds); LAS bf16* Ks = Qs + 128 * LQ; LAS bf16* Vs = Ks + 128 * LQ; LAS bf16* Ts = Vs + 128 * LQ;
    const int tid = F.tid, lane = F.lane, w = tid >> 6, i16 = lane & 15, g = lane >> 4;
    const float gamma = 1.0f - exp2f(-5.0f - (float)h), lg = log2f(gamma);
    const float gC = exp2f(lg * 128.0f);
    f32x4 accT[8];
#pragma unroll
    for (int n = 0; n < 8; ++n) accT[n] = (f32x4){0.f, 0.f, 0.f, 0.f};
    for (int i = tid; i < 128 * LQ / 8; i += NWAVES * 64) ((LAS v4u*)Ts)[i] = (v4u){0u, 0u, 0u, 0u};
    const bf16* zb = WSP(bf16, WS_Z) + (size_t)(b * SEQ) * NZ + h * 128;
    const f32x2* tret = WSP(f32x2, WS_TAB);
    bf16* yb = WSP(bf16, WS_Y) + (size_t)(b * SEQ) * 1024 + h * 128;
    const int lr = tid >> 2, dg = tid & 3;
    v4u pq[4], pk[4], pv[4];
#define RET_FETCH(t0_) do { const bf16* zr_ = zb + (size_t)((t0_) + lr) * NZ; \
        pq[0] = *(const v4u*)(zr_ + Z_RQ + 16 * dg); pq[1] = *(const v4u*)(zr_ + Z_RQ + 64 + 16 * dg); pq[2] = *(const v4u*)(zr_ + Z_RQ + 16 * dg + 8); pq[3] = *(const v4u*)(zr_ + Z_RQ + 64 + 16 * dg + 8); \
        pk[0] = *(const v4u*)(zr_ + Z_RK + 16 * dg); pk[1] = *(const v4u*)(zr_ + Z_RK + 64 + 16 * dg); pk[2] = *(const v4u*)(zr_ + Z_RK + 16 * dg + 8); pk[3] = *(const v4u*)(zr_ + Z_RK + 64 + 16 * dg + 8); \
        _Pragma("unroll") for (int q_ = 0; q_ < 4; ++q_) pv[q_] = *(const v4u*)(zr_ + Z_RV + 32 * dg + 8 * q_); } while (0)
    RET_FETCH(0);
    const float sq = exp2f(lg * (float)lr), sk = exp2f(-lg * (float)lr) * 0.08838834764831845f;
    for (int c = 0; c < SEQ / 128; ++c) {
        const int t0 = c * 128;
        {
            const f32x2* tb = tret + (t0 + lr) * 64 + 16 * dg;
#pragma unroll
            for (int hh = 0; hh < 2; ++hh) {
                v4u o1, o2; rot8(pq[2 * hh], pq[2 * hh + 1], tb + 8 * hh, sq, o1, o2);
                *(LAS v4u*)(Qs + lr * LQ + 16 * dg + 8 * hh) = o1; *(LAS v4u*)(Qs + lr * LQ + 64 + 16 * dg + 8 * hh) = o2;
                rot8(pk[2 * hh], pk[2 * hh + 1], tb + 8 * hh, sk, o1, o2);
                *(LAS v4u*)(Ks + lr * LQ + 16 * dg + 8 * hh) = o1; *(LAS v4u*)(Ks + lr * LQ + 64 + 16 * dg + 8 * hh) = o2;
            }
#pragma unroll
            for (int q = 0; q < 4; ++q) *(LAS v4u*)(Vs + lr * LQ + 32 * dg + 8 * q) = pv[q];
            if (c + 1 < SEQ / 128) RET_FETCH(t0 + 128);
        }
        __syncthreads();
        bf16x8 aq[4];
#pragma unroll
        for (int s = 0; s < 4; ++s) aq[s] = frag_row(Qs, LQ, 16 * w, 32 * s, lane);
        f32x4 acco[8];
#pragma unroll
        for (int n = 0; n < 8; ++n) acco[n] = (f32x4){0.f, 0.f, 0.f, 0.f};
#pragma unroll
        for (int s = 0; s < 4; ++s) { bf16x8 bb[8];
#pragma unroll
            for (int n = 0; n < 8; ++n) bb[n] = frag_tr(Ts, LQ, 32 * s, 16 * n, lane);
            SCHED_FENCE();
#pragma unroll
            for (int n = 0; n < 8; ++n) acco[n] = MFMA16(aq[s], bb[n], acco[n]); }
        LDS_FENCE();
#pragma unroll
        for (int n = 0; n < 8; ++n) {
            if (n <= w) { f32x4 sa = (f32x4){0.f, 0.f, 0.f, 0.f}; bf16x8 bb[4];
#pragma unroll
                for (int s = 0; s < 4; ++s) bb[s] = frag_row(Ks, LQ, 16 * n, 32 * s, lane);
                SCHED_FENCE();
#pragma unroll
                for (int s = 0; s < 4; ++s) sa = MFMA16(aq[s], bb[s], sa);
#pragma unroll
                for (int r = 0; r < 4; ++r) { const int i = 16 * w + 4 * g + r, j = 16 * n + i16; Qs[i * LQ + j] = (bf16)f2bf(j <= i ? sa[r] : 0.f); } }
            else if (n == w + 1) {
#pragma unroll
                for (int r = 0; r < 4; ++r) Qs[(16 * w + 4 * g + r) * LQ + 16 * n + i16] = (bf16)0; }
        }
        LDS_FENCE();
#pragma unroll
        for (int s = 0; s < 4; ++s) if (s <= (w >> 1)) { const bf16x8 as = frag_row(Qs, LQ, 16 * w, 32 * s, lane); bf16x8 bb[8];
#pragma unroll
            for (int n = 0; n < 8; ++n) bb[n] = frag_tr(Vs, LQ, 32 * s, 16 * n, lane);
            SCHED_FENCE();
#pragma unroll
            for (int n = 0; n < 8; ++n) acco[n] = MFMA16(as, bb[n], acco[n]); }
#pragma unroll
        for (int n = 0; n < 8; ++n) accT[n] = accT[n] * gC;
#pragma unroll
        for (int s = 0; s < 4; ++s) { const bf16x8 ak = frag_tr(Ks, LQ, 32 * s, 16 * w, lane); bf16x8 bb[8];
#pragma unroll
            for (int n = 0; n < 8; ++n) bb[n] = frag_tr(Vs, LQ, 32 * s, 16 * n, lane);
            SCHED_FENCE();
#pragma unroll
            for (int n = 0; n < 8; ++n) accT[n] = MFMA16(ak, bb[n], accT[n]); }
        LDS_FENCE();
        __syncthreads();
#pragma unroll
        for (int n = 0; n < 8; ++n)
#pragma unroll
            for (int r = 0; r < 4; ++r) Ts[(16 * w + 4 * g + r) * LQ + 16 * n + i16] = (bf16)f2bf(gC * accT[n][r]);
#pragma unroll
        for (int r = 0; r < 4; ++r) {
            float s = 0.f;
#pragma unroll
            for (int n = 0; n < 8; ++n) s += acco[n][r];
            const float mean = red16_sum(s) * (1.f / 128.f); float q = 0.f;
#pragma unroll
            for (int n = 0; n < 8; ++n) { const float d = acco[n][r] - mean; q += d * d; }
            const float rstd = rsqrtf(red16_sum(q) * (1.f / 128.f) + 1e-5f);
            const int pos = t0 + 16 * w + 4 * g + r; const bf16* gr = zb + (size_t)pos * NZ + Z_RG; bf16* yr = yb + (size_t)pos * 1024;
#pragma unroll
            for (int n = 0; n < 8; ++n) { const int e = 16 * n + i16; const float gv = bf1(gr[e]); yr[e] = (bf16)f2bf((acco[n][r] - mean) * rstd * gn[h * 128 + e] * gv * sigm(gv)); }
        }
    }
    __syncthreads();
#undef RET_FETCH
}
constexpr int LK = 72, LV = 168;
__device__ __forceinline__ float scan64_sum(float x, int lane) {
#pragma unroll
    for (int o = 1; o < 64; o <<= 1) { const float y = __shfl_up(x, o); if (lane >= o) x += y; }
    return x; }
__device__ __forceinline__ float scan64_max(float x, int lane) {
#pragma unroll
    for (int o = 1; o < 64; o <<= 1) { const float y = __shfl_up(x, o); if (lane >= o) x = fmaxf(x, y); }
    return x; }
__device__ __forceinline__ void mlstm_unit(Frame& F, const float* nw, int b, int h) {
    LAS bf16* Qm = (LAS bf16*)(F.lds); LAS bf16* Km = Qm + 128 * LK; LAS bf16* Kw = Km + 128 * LK; LAS bf16* Vm = Kw + 128 * LK; LAS bf16* Pm = Vm + 128 * LV; LAS bf16* Cm = Pm + 128 * LQ;
    const int tid = F.tid, lane = F.lane, w = F.wave, i16 = lane & 15, g = lane >> 4;
    const int dt = w & 3, eh = w >> 2;
    f32x4 accC[5];
#pragma unroll
    for (int k = 0; k < 5; ++k) accC[k] = (f32x4){0.f, 0.f, 0.f, 0.f};
    for (int i = tid; i < 64 * LV / 8; i += NWAVES * 64) ((LAS v4u*)Cm)[i] = (v4u){0u, 0u, 0u, 0u};
    float m_prev = 0.f;
    const bf16* zb = WSP(bf16, WS_Z) + (size_t)(b * SEQ) * NZ;
    const float* gif = WSP(float, WS_GIF) + (size_t)(b * SEQ) * 16;
    bf16* yb = WSP(bf16, WS_Y) + (size_t)M * 1024 + (size_t)(b * SEQ) * 1024 + h * 128;
    const int lr = tid >> 2, dg = tid & 3;
    v4u pq[2], pk[2]; float fl0, fl1, il0, il1;
#define ML_FETCH(t0_) do { const bf16* zr_ = zb + (size_t)((t0_) + lr) * NZ; \
        pq[0] = *(const v4u*)(zr_ + Z_MQ + h * 64 + 16 * dg); pq[1] = *(const v4u*)(zr_ + Z_MQ + h * 64 + 16 * dg + 8); pk[0] = *(const v4u*)(zr_ + Z_MK + h * 64 + 16 * dg); pk[1] = *(const v4u*)(zr_ + Z_MK + h * 64 + 16 * dg + 8); \
        fl0 = gif[(size_t)((t0_) + lane) * 16 + 8 + h]; fl1 = gif[(size_t)((t0_) + 64 + lane) * 16 + 8 + h]; il0 = gif[(size_t)((t0_) + lane) * 16 + h]; il1 = gif[(size_t)((t0_) + 64 + lane) * 16 + h]; } while (0)
    ML_FETCH(0);
    for (int c = 0; c < SEQ / 128; ++c) {
        const int t0 = c * 128;
        const float a0 = scan64_sum(fl0, lane); const float a1 = scan64_sum(fl1, lane) + __shfl(a0, 63);
        const float b0 = il0 - a0, b1 = il1 - a1;
        const float pm0 = scan64_max(b0, lane); const float pm1 = fmaxf(scan64_max(b1, lane), __shfl(pm0, 63));
        const float a_last = __shfl(a1, 63), bmax = __shfl(pm1, 63);
        const float g_n = a_last + bmax, m_new = fmaxf(a_last + m_prev, g_n), s_old = __expf(a_last + m_prev - m_new), s_new = __expf(g_n - m_new);
        {
            const int r = lr;
            const float br = (r < 64) ? __shfl(b0, r & 63) : __shfl(b1, r & 63);
            const float wk = __expf(br - bmax) * 0.125f * s_new;
#pragma unroll
            for (int hh = 0; hh < 2; ++hh) {
                *(LAS v4u*)(Qm + r * LK + 16 * dg + 8 * hh) = pq[hh];
                const v4u kk = pk[hh];
                float kf[8] = {bflo(kk.x), bfhi(kk.x), bflo(kk.y), bfhi(kk.y), bflo(kk.z), bfhi(kk.z), bflo(kk.w), bfhi(kk.w)};
                *(LAS v4u*)(Km + r * LK + 16 * dg + 8 * hh) = (v4u){pk2(kf[0] * 0.125f, kf[1] * 0.125f), pk2(kf[2] * 0.125f, kf[3] * 0.125f), pk2(kf[4] * 0.125f, kf[5] * 0.125f), pk2(kf[6] * 0.125f, kf[7] * 0.125f)};
                *(LAS v4u*)(Kw + r * LK + 16 * dg + 8 * hh) = (v4u){pk2(kf[0] * wk, kf[1] * wk), pk2(kf[2] * wk, kf[3] * wk), pk2(kf[4] * wk, kf[5] * wk), pk2(kf[6] * wk, kf[7] * wk)};
            }
#pragma unroll
            for (int q = 0; q < 4; ++q) *(LAS v4u*)(Vm + r * LV + 32 * dg + 8 * q) = *(const v4u*)(zb + (size_t)(t0 + r) * NZ + Z_MV + h * 128 + 32 * dg + 8 * q);
            *(LAS v4u*)(Vm + r * LV + 128 + 8 * dg) = (v4u){dg == 0 ? 0x00003f80u : 0u, 0u, 0u, 0u};
            if (c + 1 < SEQ / 128) ML_FETCH(t0 + 128);
        }
        __syncthreads();
        float Mi[4], ai[4];
#pragma unroll
        for (int r = 0; r < 4; ++r) { const int i = 16 * w + 4 * g + r; const float pmi = (w < 4) ? __shfl(pm0, i & 63) : __shfl(pm1, i & 63); ai[r] = (w < 4) ? __shfl(a0, i & 63) : __shfl(a1, i & 63); Mi[r] = fmaxf(pmi, m_prev); }
        bf16x8 aq[2];
#pragma unroll
        for (int s = 0; s < 2; ++s) aq[s] = frag_row(Qm, LK, 16 * w, 32 * s, lane);
        f32x4 acco[9];
#pragma unroll
        for (int n = 0; n < 9; ++n) acco[n] = (f32x4){0.f, 0.f, 0.f, 0.f};
#pragma unroll
        for (int s = 0; s < 2; ++s) {
#pragma unroll
          for (int hf = 0; hf < 2; ++hf) { bf16x8 bb[5];
#pragma unroll
            for (int n = 0; n < 5 - hf; ++n) bb[n] = frag_tr(Cm, LV, 32 * s, 16 * (5 * hf + n), lane);
            SCHED_FENCE();
#pragma unroll
            for (int n = 0; n < 5 - hf; ++n) acco[5 * hf + n] = MFMA16(aq[s], bb[n], acco[5 * hf + n]); } }
        { float si[4];
#pragma unroll
          for (int r = 0; r < 4; ++r) si[r] = __expf(m_prev - Mi[r]);
#pragma unroll
          for (int n = 0; n < 9; ++n)
#pragma unroll
            for (int r = 0; r < 4; ++r) acco[n][r] *= si[r]; }
        LDS_FENCE();
#pragma unroll
        for (int n = 0; n < 8; ++n) {
            if (n <= w) { f32x4 sa = (f32x4){0.f, 0.f, 0.f, 0.f}; bf16x8 bb[2];
#pragma unroll
                for (int s = 0; s < 2; ++s) bb[s] = frag_row(Km, LK, 16 * n, 32 * s, lane);
                SCHED_FENCE();
#pragma unroll
                for (int s = 0; s < 2; ++s) sa = MFMA16(aq[s], bb[s], sa);
                const int j = 16 * n + i16; const float bj = (n < 4) ? __shfl(b0, j & 63) : __shfl(b1, j & 63);
#pragma unroll
                for (int r = 0; r < 4; ++r) { const int i = 16 * w + 4 * g + r; Pm[i * LQ + j] = (bf16)f2bf(j <= i ? sa[r] * __expf(bj - Mi[r]) : 0.f); } }
            else if (n == w + 1) {
#pragma unroll
                for (int r = 0; r < 4; ++r) Pm[(16 * w + 4 * g + r) * LQ + 16 * n + i16] = (bf16)0; }
        }
        LDS_FENCE();
#pragma unroll
        for (int s = 0; s < 4; ++s) if (s <= (w >> 1)) { const bf16x8 ap = frag_row(Pm, LQ, 16 * w, 32 * s, lane);
#pragma unroll
          for (int hf = 0; hf < 2; ++hf) { bf16x8 bb[5];
#pragma unroll
            for (int n = 0; n < 5 - hf; ++n) bb[n] = frag_tr(Vm, LV, 32 * s, 16 * (5 * hf + n), lane);
            SCHED_FENCE();
#pragma unroll
            for (int n = 0; n < 5 - hf; ++n) acco[5 * hf + n] = MFMA16(ap, bb[n], acco[5 * hf + n]); } }
#pragma unroll
        for (int k = 0; k < 5; ++k) accC[k] = accC[k] * s_old;
#pragma unroll
        for (int s = 0; s < 4; ++s) { const bf16x8 ak = frag_tr(Kw, LK, 32 * s, 16 * dt, lane); bf16x8 bb[5];
#pragma unroll
            for (int k = 0; k < 5; ++k) bb[k] = frag_tr(Vm, LV, 32 * s, 16 * (5 * eh + k), lane);
            SCHED_FENCE();
#pragma unroll
            for (int k = 0; k < 5; ++k) accC[k] = MFMA16(ak, bb[k], accC[k]); }
        LDS_FENCE();
        __syncthreads();
#pragma unroll
        for (int k = 0; k < 5; ++k)
#pragma unroll
            for (int r = 0; r < 4; ++r) Cm[(16 * dt + 4 * g + r) * LV + 16 * (5 * eh + k) + i16] = (bf16)f2bf(accC[k][r]);
#pragma unroll
        for (int r = 0; r < 4; ++r) {
            const float den = __shfl(acco[8][r], lane & 48);
            const float dd = 1.0f / fmaxf(fabsf(den), __expf(-(ai[r] + Mi[r])));
            float q = 0.f;
#pragma unroll
            for (int n = 0; n < 8; ++n) { acco[n][r] *= dd; q += acco[n][r] * acco[n][r]; }
            const float rstd = rsqrtf(red16_sum(q) * (1.f / 128.f) + 1e-6f);
            const int pos = t0 + 16 * w + 4 * g + r; const bf16* gr = zb + (size_t)pos * NZ + Z_MO + h * 128; bf16* yr = yb + (size_t)pos * 1024;
#pragma unroll
            for (int n = 0; n < 8; ++n) { const int e = 16 * n + i16; yr[e] = (bf16)f2bf(acco[n][r] * rstd * nw[h * 128 + e] * sigm(bf1(gr[e]))); }
        }
        m_prev = m_new;
    }
    __syncthreads();
#undef ML_FETCH
}
__device__ __forceinline__ void moba_unit(Frame& F, int b, int h, int qi) {
    LAS bf16* Kt = (LAS bf16*)(F.lds); LAS bf16* Vt = Kt + 128 * LQ; LAS bf16* Pm = Vt + 128 * LQ;
    const int tid = F.tid, lane = F.lane, w = tid >> 6, i16 = lane & 15, g = lane >> 4;
    const int blk = qi >> 1, qt = qi & 1, q0 = qi * 128;
    const bf16* zb = WSP(bf16, WS_Z) + (size_t)(b * SEQ) * NZ + h * 128;
    bf16x8 aq[4];
    { const bf16* qr = zb + (size_t)(q0 + 16 * w + i16) * NZ + Z_AQ + 8 * g;
#pragma unroll
      for (int s = 0; s < 4; ++s) aq[s] = *(const bf16x8*)(qr + 32 * s); }
    unsigned sel = 0u;
    {
        float gate[8];
        const float* km = WSP(float, WS_KMEAN) + (size_t)((b * NH + h) * 16) * 128 + 8 * g;
#pragma unroll
        for (int n = 0; n < 8; ++n) { gate[n] = -INFINITY;
            if (n < blk) { float p = 0.f;
#pragma unroll
                for (int s = 0; s < 4; ++s) { const f32x4 k0 = *(const f32x4*)(km + n * 256 + 32 * s) + *(const f32x4*)(km + n * 256 + 128 + 32 * s), k1 = *(const f32x4*)(km + n * 256 + 32 * s + 4) + *(const f32x4*)(km + n * 256 + 128 + 32 * s + 4);
                    p += bf1((bf16)aq[s][0]) * k0.x + bf1((bf16)aq[s][1]) * k0.y + bf1((bf16)aq[s][2]) * k0.z + bf1((bf16)aq[s][3]) * k0.w
                       + bf1((bf16)aq[s][4]) * k1.x + bf1((bf16)aq[s][5]) * k1.y + bf1((bf16)aq[s][6]) * k1.z + bf1((bf16)aq[s][7]) * k1.w; }
                p += __shfl_xor(p, 16); p += __shfl_xor(p, 32); gate[n] = p; } }
#pragma unroll
        for (int s = 0; s < 3; ++s) { float bv = -INFINITY; int best = -1;
#pragma unroll
            for (int n = 0; n < 8; ++n) { const bool c = !((sel >> n) & 1u) && gate[n] > bv; bv = c ? gate[n] : bv; best = c ? n : best; }
            if (best >= 0) sel |= 1u << best; }
    }
    unsigned rsel[4];
#pragma unroll
    for (int r = 0; r < 4; ++r) rsel[r] = (unsigned)__shfl((int)sel, 4 * g + r);
    f32x4 acco[8];
#pragma unroll
    for (int n = 0; n < 8; ++n) acco[n] = (f32x4){0.f, 0.f, 0.f, 0.f};
    float mrow[4], lrow[4];
#pragma unroll
    for (int r = 0; r < 4; ++r) { mrow[r] = -1e30f; lrow[r] = 0.f; }
    const int ntiles = 2 * blk + qt + 1;
    const int lr = tid >> 2, dg = tid & 3;
    v4u pk[4], pv[4];
#define MB_FETCH(k0_) do { const bf16* zr_ = zb + (size_t)((k0_) + lr) * NZ + 32 * dg; \
        _Pragma("unroll") for (int q_ = 0; q_ < 4; ++q_) { pk[q_] = *(const v4u*)(zr_ + Z_AK + 8 * q_); pv[q_] = *(const v4u*)(zr_ + Z_AV + 8 * q_); } } while (0)
    MB_FETCH(0);
    for (int kt = 0; kt < ntiles; ++kt) {
        const int k0 = kt * 128, kb = kt >> 1; const bool own = (kb == blk), diag = (kt == 2 * blk + qt);
        __syncthreads();
#pragma unroll
        for (int q = 0; q < 4; ++q) { *(LAS v4u*)(Kt + lr * LQ + 32 * dg + 8 * q) = pk[q]; *(LAS v4u*)(Vt + lr * LQ + 32 * dg + 8 * q) = pv[q]; }
        if (kt + 1 < ntiles) MB_FETCH(k0 + 128);
        __syncthreads();
        f32x4 sc[8];
#pragma unroll
        for (int n = 0; n < 8; ++n) sc[n] = (f32x4){0.f, 0.f, 0.f, 0.f};
#pragma unroll
        for (int s = 0; s < 4; ++s) { bf16x8 bb[8];
#pragma unroll
            for (int n = 0; n < 8; ++n) bb[n] = frag_row(Kt, LQ, 16 * n, 32 * s, lane);
            SCHED_FENCE();
#pragma unroll
            for (int n = 0; n < 8; ++n) sc[n] = MFMA16(aq[s], bb[n], sc[n]); }
#pragma unroll
        for (int r = 0; r < 4; ++r) {
            const int qpos = q0 + 16 * w + 4 * g + r; const bool rowsel = own || ((rsel[r] >> kb) & 1u);
            float mx = -1e30f; bool vld[8];
#pragma unroll
            for (int n = 0; n < 8; ++n) { vld[n] = rowsel && (!diag || (k0 + 16 * n + i16 <= qpos)); sc[n][r] = vld[n] ? sc[n][r] * 0.08838834764831845f : -1e30f; mx = fmaxf(mx, sc[n][r]); }
            mx = red16_max(mx);
            const float mnew = fmaxf(mrow[r], mx), alpha = __expf(mrow[r] - mnew); mrow[r] = mnew;
            float ps = 0.f;
#pragma unroll
            for (int n = 0; n < 8; ++n) { const float p = vld[n] ? __expf(sc[n][r] - mnew) : 0.f; ps += p; Pm[(16 * w + 4 * g + r) * LQ + 16 * n + i16] = (bf16)f2bf(p); }
            lrow[r] = lrow[r] * alpha + ps;
#pragma unroll
            for (int n = 0; n < 8; ++n) acco[n][r] *= alpha;
        }
        LDS_FENCE();
#pragma unroll
        for (int s = 0; s < 4; ++s) { const bf16x8 ap = frag_row(Pm, LQ, 16 * w, 32 * s, lane); bf16x8 bb[8];
#pragma unroll
            for (int n = 0; n < 8; ++n) bb[n] = frag_tr(Vt, LQ, 32 * s, 16 * n, lane);
            SCHED_FENCE();
#pragma unroll
            for (int n = 0; n < 8; ++n) acco[n] = MFMA16(ap, bb[n], acco[n]); }
        LDS_FENCE();
    }
    bf16* yb = WSP(bf16, WS_Y) + (size_t)2 * M * 1024 + (size_t)(b * SEQ + q0) * 1024 + h * 128;
#pragma unroll
    for (int r = 0; r < 4; ++r) { const float inv = 1.0f / red16_sum(lrow[r]); bf16* yr = yb + (size_t)(16 * w + 4 * g + r) * 1024;
#pragma unroll
        for (int n = 0; n < 8; ++n) yr[16 * n + i16] = (bf16)f2bf(acco[n][r] * inv); }
#undef MB_FETCH
}
__device__ __forceinline__ void mix_phase(Frame& F, const float* rgn, const float* mln, unsigned* head) {
    volatile LAS unsigned* slot = F.MISC;
    for (;;) {
        if (F.tid == 0) slot[0] = __hip_atomic_fetch_add(head, 1u, __ATOMIC_RELAXED, __HIP_MEMORY_SCOPE_AGENT);
        __syncthreads();
        const unsigned it = slot[0];
        __syncthreads();
        if (it >= 128u + 1024u) break;
        { int t_ = threadIdx.x; asm volatile("" : "+v"(t_)); F.tid = t_; F.lane = t_ & 63; }
        if (it < 64u) ret_unit(F, rgn, (int)(it >> 3), (int)(it & 7u));
        else if (it < 128u) mlstm_unit(F, mln, (int)((it - 64u) >> 3), (int)(it & 7u));
        else { const unsigned rank = it - 128u; moba_unit(F, (int)((rank & 63u) >> 3), (int)(rank & 7u), 15 - (int)(rank >> 6)); }
    }
}
}
constexpr int N_PHASES = 1 + 10 * DEPTH;
__global__ void __launch_bounds__(NWAVES * 64, 2) fwd(Args args) {
    extern __shared__ __attribute__((aligned(16))) unsigned char lds[];
    Frame F;
    F.lds = (LAS unsigned char*)lds;
    F.MISC = (volatile LAS unsigned*)(F.lds + MISC_OFF);
    F.tid = threadIdx.x; F.lane = F.tid & 63; F.wave = __builtin_amdgcn_readfirstlane(F.tid >> 6); F.G = gridDim.x; F.bx = blockIdx.x;
    F.ws = args.ws;
    for (int u = F.tid; u < (LDS_BYTES - LDSCTL_OFF) / 4; u += NWAVES * 64) ((LAS unsigned*)(F.lds + LDSCTL_OFF))[u] = 0u;
    __syncthreads();
    XcdBarrier bar = xcd_barrier_post((unsigned*)(F.ws + WS_CTL) + CW_BAR + args.li * XCD_BAR_WORDS, F.MISC + 8);
    const int lo = args.ph_lo, hi = args.ph_hi;
#define RUN(p) (lo <= (p) && (p) < hi)
#define SEAM(p) do { if ((p) + 1 < hi) xcd_barrier(bar); } while (0)
    if (RUN(0)) { p0_prologue(F, args); SEAM(0); }
    for (int l = 0; l < DEPTH; ++l) {
        const int p0 = 1 + 10 * l;
        { int t_ = threadIdx.x; asm volatile("" : "+v"(t_)); F.tid = t_; F.lane = t_ & 63; F.wave = __builtin_amdgcn_readfirstlane(t_ >> 6); int b_ = blockIdx.x; asm volatile("" : "+s"(b_)); F.bx = b_; }
        const float* xcur = (l == 0) ? args.in[I_X] : args.out;
        if (RUN(p0 + 0)) { norm_phase<true>(F, xcur, args.in[I_NMIX] + l * DM, WSP(float, WS_W16T) + (size_t)l * 16 * DM, args.in[I_BIG] + l * 8, args.in[I_BFG] + l * 8); SEAM(p0 + 0); }
        if (RUN(p0 + 1)) {
            pg8::Gemm g{WSP(bf16, WS_H), WSP(bf16, WS_WIN) + (size_t)l * NZ * DM, M, NZ, DM}; pg8::StaticOrder S; S.init(M, NZ, F.G, F.bx);
            pg8::EpiBf16 E{WSP(bf16, WS_Z), NZ};
            pg8::gemm_phase<pg8::EpiBf16, pg8::StaticOrder, true, true>(F.lds + RING_OFF, g, S, E);
            SEAM(p0 + 1); }
        if (RUN(p0 + 2)) { prep_phase(F, args.in[I_QN] + l * 128, args.in[I_KN] + l * 128); SEAM(p0 + 2); }
        if (RUN(p0 + 3)) { mx::mix_phase(F, args.in[I_RGN] + l * 1024, args.in[I_MLN] + l * 1024, (unsigned*)(F.ws + WS_CTL) + CW_QUEUE + 64 * l); SEAM(p0 + 3); }
        if (RUN(p0 + 4)) {
            pg8::StaticOrder S; S.init(M, DM, F.G, F.bx);
            { pg8::Gemm g{WSP(bf16, WS_Y), WSP(bf16, WS_WP) + ((size_t)l * 3 + 0) * DM * 1024, M, DM, 1024}; pg8::EpiGateAcc<true> E{WSP(bf16, WS_MG), DM, WSP(bf16, WS_Z) + Z_GA, NZ};
              pg8::gemm_phase<pg8::EpiGateAcc<true>, pg8::StaticOrder, true, true>(F.lds + RING_OFF, g, S, E); }
            for (int br = 1; br < 3; ++br) { __syncthreads();
              pg8::Gemm g{WSP(bf16, WS_Y) + (size_t)br * M * 1024, WSP(bf16, WS_WP) + ((size_t)l * 3 + br) * DM * 1024, M, DM, 1024}; pg8::EpiGateAcc<false> E{WSP(bf16, WS_MG), DM, WSP(bf16, WS_Z) + Z_GA + br * DM, NZ};
              pg8::gemm_phase<pg8::EpiGateAcc<false>, pg8::StaticOrder, true, true>(F.lds + RING_OFF, g, S, E); }
            SEAM(p0 + 4); }
        if (RUN(p0 + 5)) {
            pg8::Gemm g{WSP(bf16, WS_MG), WSP(bf16, WS_WOUT) + (size_t)l * DM * DM, M, DM, DM}; pg8::StaticOrder S; S.init(M, DM, F.G, F.bx);
            pg8::EpiResF32 E{xcur, args.out, DM};
            pg8::gemm_phase<pg8::EpiResF32, pg8::StaticOrder, true, true>(F.lds + RING_OFF, g, S, E);
            SEAM(p0 + 5); }
        if (RUN(p0 + 6)) { norm_phase<false>(F, args.out, args.in[I_NFFN] + l * DM, nullptr, nullptr, nullptr); SEAM(p0 + 6); }
        if (RUN(p0 + 7)) {
            pg8::Gemm g{WSP(bf16, WS_H), WSP(bf16, WS_WUP) + (size_t)l * NUP * DM, M, NUP, DM}; pg8::StaticOrder S; S.init(M, NUP, F.G, F.bx);
            pg8::EpiBf16 E{WSP(bf16, WS_Z), NUP};
            pg8::gemm_phase<pg8::EpiBf16, pg8::StaticOrder, true, true>(F.lds + RING_OFF, g, S, E);
            SEAM(p0 + 7); }
        if (RUN(p0 + 8)) { glu_phase(F, args.in[I_CW] + (size_t)l * 3 * NUP, args.in[I_CB] + (size_t)l * NUP); SEAM(p0 + 8); }
        if (RUN(p0 + 9)) {
            pg8::Gemm g{WSP(bf16, WS_ACT), WSP(bf16, WS_WDN) + (size_t)l * DM * DFF, M, DM, DFF}; pg8::StaticOrder S; S.init(M, DM, F.G, F.bx);
            pg8::EpiResF32 E{args.out, args.out, DM};
            pg8::gemm_phase<pg8::EpiResF32, pg8::StaticOrder, true, true>(F.lds + RING_OFF, g, S, E);
            SEAM(p0 + 9); }
    }
#undef RUN
#undef SEAM
}

#ifndef MK_N_LAUNCHES
#define MK_N_LAUNCHES 1
#endif
extern "C" void kernel_launch(void* const* d_in, const int* in_sizes, int n_in, void* d_out, int out_size, void* d_ws, size_t ws_size, hipStream_t stream) {
    static int grid = 0;
    if (grid == 0) {
        if (n_in != 18 || in_sizes[0] != M * DM || out_size != M * DM || ws_size < WS_END) { fprintf(stderr, "kernel_launch: unexpected shapes (n_in %d, in0 %d, out %d, ws %zu)\n", n_in, n_in > 0 ? in_sizes[0] : -1, out_size, ws_size); grid = -1; return; }
        int dev = 0, cus = 0, per_cu = 0;
        if (hipGetDevice(&dev) != hipSuccess || hipDeviceGetAttribute(&cus, hipDeviceAttributeMultiprocessorCount, dev) != hipSuccess) { grid = -1; return; }
        if (hipFuncSetAttribute((const void*)fwd, hipFuncAttributeMaxDynamicSharedMemorySize, LDS_BYTES) != hipSuccess) { fprintf(stderr, "kernel_launch: hipFuncSetAttribute failed\n"); grid = -1; return; }
        if (hipOccupancyMaxActiveBlocksPerMultiprocessor(&per_cu, (const void*)fwd, NWAVES * 64, LDS_BYTES) != hipSuccess || per_cu < 1) fprintf(stderr, "kernel_launch: occupancy query reports %d\n", per_cu);
        (void)hipGetLastError();
        grid = cus;
    }
    if (grid < 0) return;
    if (hipMemsetAsync((char*)d_ws + WS_CTL, 0, CTL_ZERO_BYTES, stream) != hipSuccess) return;
    Args a{};
    for (int i = 0; i < 18; ++i) a.in[i] = (const float*)d_in[i];
    a.out = (float*)d_out; a.ws = (unsigned char*)d_ws; a.pad = 0;
    constexpr int NL = MK_N_LAUNCHES;
    for (int li = 0; li < NL; ++li) {
        a.ph_lo = (NL == 1) ? 0 : li; a.ph_hi = (NL == 1) ? N_PHASES : li + 1; a.li = (NL == 1) ? 0 : 0;
        hipLaunchKernelGGL(fwd, dim3(grid), dim3(NWAVES * 64), LDS_BYTES, stream, a);
    }
}
```

```cpp
#include <hip/hip_runtime.h>
#include <cstdio>
#include <cstdint>
namespace pg8 {
#define PG8_LAS __attribute__((address_space(3)))
typedef unsigned short bf16_t;
typedef short bf16x8 __attribute__((ext_vector_type(8)));
typedef float f32x4 __attribute__((ext_vector_type(4)));
typedef unsigned u32x4 __attribute__((ext_vector_type(4)));
constexpr int BM = 256, BK = 64, HALF = 128, HTB = HALF * BK * 2  , STAGE_BYTES = 8 * HTB, NXCD = 8, WGM = 8;

__host__ __device__ __forceinline__ int lds_byte(int r, int c) { const int st = (r >> 4) * 2 + (c >> 5), rr = r & 15, cc = c & 31, ob = rr * 64 + cc * 2; return st * 1024 + (ob ^ (((ob >> 9) & 1) << 5)); }
__host__ __device__ __forceinline__ void stage_rc(int b, int& R, int& C) { const int st = b / 1024, sb = b % 1024, swz = sb ^ (((sb >> 9) & 1) << 5); R = (st >> 1) * 16 + swz / 64; C = (st & 1) * 32 + (swz % 64) / 2; }
__host__ __device__ __forceinline__ int perm32(int rho) { const int n = rho >> 4, i = rho & 15; return 8 * (i >> 2) + 4 * n + (i & 3); }

struct Unit { int pm, pn, z; };
struct Gemm { const bf16_t* A; const bf16_t* Bt; int M, N, K; size_t zA, zB; };

struct StaticOrder {
    int nM, nN, nwg, G, c;
    __host__ __device__ void init(int M, int N, int G_, int c_) { nM = M / BM; nN = N / BM; nwg = nM * nN; G = G_; c = c_; }
    __host__ __device__ bool next(int i, Unit& u) const {
        const long L = (long)i * G + c; if (L >= nwg) return false;
        int wgid = (int)L; { const int q = nwg / NXCD, r = nwg % NXCD, xcd = wgid % NXCD, off = wgid / NXCD; wgid = (xcd < r ? xcd * (q + 1) : r * (q + 1) + (xcd - r) * q) + off; }
        const int nig = WGM * nN, gid = wgid / nig, fm = gid * WGM, gsz = (nM - fm) < WGM ? (nM - fm) : WGM;
        u.pm = fm + ((wgid % nig) % gsz); u.pn = (wgid % nig) / gsz; u.z = 0; return true;
    }
    __device__ __forceinline__ void a_ready(const Unit&) const {}
    __device__ __forceinline__ void done(const Unit&) const {}
};

struct StaticOrder3 : StaticOrder {
    __host__ __device__ bool next(int i, Unit& u) const { if (!StaticOrder::next(i / 3, u)) return false; u.z = i % 3; return true; }
};
__device__ __forceinline__ unsigned cvt_pk_bf16(float lo, float hi) { unsigned r; asm volatile("v_cvt_pk_bf16_f32 %0, %1, %2" : "=v"(r) : "v"(lo), "v"(hi)); return r; }
struct EpiBf16 {
    static constexpr bool PERM = true, AFTER_DRAIN = false;
    bf16_t* O; int ldc;
    __device__ __forceinline__ void operator()(const f32x4 (&acc)[2][2][4][2], const Unit& u, int wr, int wc, int fr, int fq) const {
        const int row0 = u.pm * BM + wr * 64 + fr; const int col0 = u.pn * BM + wc * 32 + 8 * fq;
#pragma unroll
        for (int ai = 0; ai < 2; ++ai)
#pragma unroll
            for (int m = 0; m < 4; ++m) { bf16_t* rowp = O + (size_t)(row0 + ai * HALF + m * 16) * ldc + col0;
#pragma unroll
                for (int bj = 0; bj < 2; ++bj) { const f32x4 v0 = acc[ai][bj][m][0], v1 = acc[ai][bj][m][1];
                    u32x4 w; w.x = cvt_pk_bf16(v0[0], v0[1]); w.y = cvt_pk_bf16(v0[2], v0[3]); w.z = cvt_pk_bf16(v1[0], v1[1]); w.w = cvt_pk_bf16(v1[2], v1[3]);
                    *(u32x4*)(rowp + bj * HALF) = w; } }
    }
};
__device__ __forceinline__ float bf_lo(unsigned w) { return __uint_as_float(w << 16); }
__device__ __forceinline__ float bf_hi(unsigned w) { return __uint_as_float(w & 0xffff0000u); }
__device__ __forceinline__ float sigmoid_f(float x) { return __builtin_amdgcn_rcpf(1.0f + __expf(-x)); }
struct EpiGateAcc {
    static constexpr bool PERM = true, AFTER_DRAIN = false;
    bf16_t* O; int ldc; const bf16_t* G; int ldg; const float* rstd;
    __device__ __forceinline__ void operator()(const f32x4 (&acc)[2][2][4][2], const Unit& u, int wr, int wc, int fr, int fq) const {
        const int row0 = u.pm * BM + wr * 64 + fr; const int col0 = u.pn * BM + wc * 32 + 8 * fq; const bf16_t* Gz = G + (size_t)u.z * ldc; const bool FIRST = (u.z == 0);
#pragma unroll
        for (int ai = 0; ai < 2; ++ai)
#pragma unroll
            for (int m = 0; m < 4; ++m) { const size_t row = (size_t)(row0 + ai * HALF + m * 16); const float rr = rstd[row];
#pragma unroll
                for (int bj = 0; bj < 2; ++bj) { const f32x4 v0 = acc[ai][bj][m][0], v1 = acc[ai][bj][m][1];
                    const u32x4 g = *(const u32x4*)(Gz + row * ldg + col0 + bj * HALF);
                    u32x4 p = (u32x4){0u, 0u, 0u, 0u};
                    if (!FIRST) p = *(const u32x4*)(O + row * ldc + col0 + bj * HALF);
                    float o[8];
                    o[0] = bf_lo(p.x) + sigmoid_f(bf_lo(g.x) * rr) * v0[0]; o[1] = bf_hi(p.x) + sigmoid_f(bf_hi(g.x) * rr) * v0[1];
                    o[2] = bf_lo(p.y) + sigmoid_f(bf_lo(g.y) * rr) * v0[2]; o[3] = bf_hi(p.y) + sigmoid_f(bf_hi(g.y) * rr) * v0[3];
                    o[4] = bf_lo(p.z) + sigmoid_f(bf_lo(g.z) * rr) * v1[0]; o[5] = bf_hi(p.z) + sigmoid_f(bf_hi(g.z) * rr) * v1[1];
                    o[6] = bf_lo(p.w) + sigmoid_f(bf_lo(g.w) * rr) * v1[2]; o[7] = bf_hi(p.w) + sigmoid_f(bf_hi(g.w) * rr) * v1[3];
                    u32x4 w; w.x = cvt_pk_bf16(o[0], o[1]); w.y = cvt_pk_bf16(o[2], o[3]); w.z = cvt_pk_bf16(o[4], o[5]); w.w = cvt_pk_bf16(o[6], o[7]);
                    *(u32x4*)(O + row * ldc + col0 + bj * HALF) = w; } }
    }
};
template <bool LAST> struct EpiRes {
    static constexpr bool PERM = true, AFTER_DRAIN = false;
    bf16_t* xb; float* rs; float* out; int ldc;
    __device__ __forceinline__ void operator()(const f32x4 (&acc)[2][2][4][2], const Unit& u, int wr, int wc, int fr, int fq) const {
        const int row0 = u.pm * BM + wr * 64 + fr; const int col0 = u.pn * BM + wc * 32 + 8 * fq;
#pragma unroll
        for (int ai = 0; ai < 2; ++ai)
#pragma unroll
            for (int m = 0; m < 4; ++m) { const int row = row0 + ai * HALF + m * 16; const size_t off = (size_t)row * ldc + col0; float sq = 0.f;
#pragma unroll
                for (int bj = 0; bj < 2; ++bj) { const u32x4 p = *(const u32x4*)(xb + off + bj * HALF); const f32x4 v0 = acc[ai][bj][m][0], v1 = acc[ai][bj][m][1];
                    const float o0 = bf_lo(p.x) + v0[0], o1 = bf_hi(p.x) + v0[1], o2 = bf_lo(p.y) + v0[2], o3 = bf_hi(p.y) + v0[3], o4 = bf_lo(p.z) + v1[0], o5 = bf_hi(p.z) + v1[1], o6 = bf_lo(p.w) + v1[2], o7 = bf_hi(p.w) + v1[3];
                    if (LAST) { *(f32x4*)(out + off + bj * HALF) = (f32x4){o0, o1, o2, o3}; *(f32x4*)(out + off + bj * HALF + 4) = (f32x4){o4, o5, o6, o7}; }
                    else { sq += ((o0 * o0 + o1 * o1) + (o2 * o2 + o3 * o3)) + ((o4 * o4 + o5 * o5) + (o6 * o6 + o7 * o7));
                        u32x4 w; w.x = cvt_pk_bf16(o0, o1); w.y = cvt_pk_bf16(o2, o3); w.z = cvt_pk_bf16(o4, o5); w.w = cvt_pk_bf16(o6, o7); *(u32x4*)(xb + off + bj * HALF) = w; } }
                if (!LAST) { sq += __shfl_xor(sq, 16); sq += __shfl_xor(sq, 32); if (fq == 0) rs[(size_t)row * 32 + u.pn * 4 + wc] = sq; } }
    }
};

template <class Epi, class Sched, bool ALIGN_EPI = false, bool SP2 = false>
__device__ __forceinline__ void gemm_phase(PG8_LAS unsigned char* lds, const Gemm g, const Sched& S, const Epi& E) {
    int tid_ = threadIdx.x; asm volatile("" : "+v"(tid_));
    const int tid = tid_, wid = __builtin_amdgcn_readfirstlane(tid >> 6), lane = tid & 63, wr = wid >> 2, wc = wid & 3, fr = lane & 15, fq = lane >> 4;
    const int K = g.K, nt = K / BK;
    unsigned voffA[2], voffB[2];
#pragma unroll
    for (int i = 0; i < 2; ++i) { int R, C; stage_rc(tid * 16 + i * 8192, R, C); const int Rb = Epi::PERM ? ((R & ~31) + perm32(R & 31)) : R;
        voffA[i] = (unsigned)(R * K + C) * 2u; voffB[i] = (unsigned)(Rb * K + C) * 2u; }
    const size_t kstep = (size_t)(BK * 2);
    const size_t hstep = (size_t)HALF * K * 2;
    const size_t tstep = 2 * hstep;
    const unsigned ldsw = (unsigned)wid * 1024u;
    const int aoff = lds_byte(wr * 64 + fr, fq * 8), boff = lds_byte(wc * 32 + fr, fq * 8);
#define PG8_SA(b, h) (((b) * 2 + (h)) * HTB)
#define PG8_SB(b, h) ((4 + (b) * 2 + (h)) * HTB)
#define PG8_STAGE(bufoff, gbase, voff) do { _Pragma("unroll") for (int _i = 0; _i < 2; ++_i) \
        __builtin_amdgcn_global_load_lds((const unsigned*)((const char*)(gbase) + (voff)[_i]), (PG8_LAS unsigned*)(lds + (bufoff) + ldsw + _i * 8192), 16, 0, 0); } while (0)
#define PG8_LDA(dst, b, h) do { _Pragma("unroll") for (int m = 0; m < 4; ++m) _Pragma("unroll") for (int k = 0; k < 2; ++k) dst[m][k] = *(const PG8_LAS bf16x8*)(lds + PG8_SA(b, h) + aoff + m * 2048 + k * 1024); } while (0)
#define PG8_LDB(dst, b, h) do { _Pragma("unroll") for (int n = 0; n < 2; ++n) _Pragma("unroll") for (int k = 0; k < 2; ++k) dst[n][k] = *(const PG8_LAS bf16x8*)(lds + PG8_SB(b, h) + boff + n * 2048 + k * 1024); } while (0)
#define PG8_MMA(ai, bj, At, Bt) do { __builtin_amdgcn_s_setprio(1); _Pragma("unroll") for (int m = 0; m < 4; ++m) _Pragma("unroll") for (int n = 0; n < 2; ++n) _Pragma("unroll") for (int k = 0; k < 2; ++k) \
        acc[ai][bj][m][n] = __builtin_amdgcn_mfma_f32_16x16x32_bf16(Bt[n][k], At[m][k], acc[ai][bj][m][n], 0, 0, 0); __builtin_amdgcn_s_setprio(0); } while (0)
#define PG8_WAIT_V(n) asm volatile("s_waitcnt vmcnt(" #n ")" ::: "memory")
#define PG8_WAIT_L(n) asm volatile("s_waitcnt lgkmcnt(" #n ")" ::: "memory")
#define PG8_BAR __builtin_amdgcn_s_barrier()
#define PG8_SCHED __builtin_amdgcn_sched_barrier(0)
    Unit cur, nxt; int ui = 0;
    if (!S.next(0, cur)) return;
    f32x4 acc[2][2][4][2];
#pragma unroll
    for (int a = 0; a < 2; ++a)
#pragma unroll
        for (int b = 0; b < 2; ++b)
#pragma unroll
            for (int m = 0; m < 4; ++m)
#pragma unroll
                for (int n = 0; n < 2; ++n) acc[a][b][m][n] = (f32x4){0.f, 0.f, 0.f, 0.f};
    bf16x8 At[4][2], B0[2][2], B1[2][2];
    const char* cA = (const char*)(g.A + (size_t)cur.z * g.zA) + (size_t)cur.pm * tstep; const char* cB = (const char*)(g.Bt + (size_t)cur.z * g.zB) + (size_t)cur.pn * tstep;
    S.a_ready(cur);
    if constexpr (SP2) {
        PG8_STAGE(PG8_SB(0, 0), cB, voffB); PG8_STAGE(PG8_SB(0, 1), cB + hstep, voffB); PG8_STAGE(PG8_SA(0, 0), cA, voffA); PG8_STAGE(PG8_SA(0, 1), cA + hstep, voffA);
        if (wr == 1) PG8_BAR;
        PG8_WAIT_V(2); PG8_BAR;
        PG8_STAGE(PG8_SB(1, 0), cB + kstep, voffB); PG8_STAGE(PG8_SA(1, 0), cA + kstep, voffA); PG8_STAGE(PG8_SB(1, 1), cB + hstep + kstep, voffB);
        PG8_WAIT_V(6); PG8_BAR;
    } else {
        PG8_STAGE(PG8_SB(0, 0), cB, voffB); PG8_STAGE(PG8_SA(0, 0), cA, voffA); PG8_STAGE(PG8_SB(0, 1), cB + hstep, voffB); PG8_STAGE(PG8_SA(0, 1), cA + hstep, voffA);
        if (wr == 1) PG8_BAR;
        PG8_WAIT_V(4); PG8_BAR;
        PG8_STAGE(PG8_SB(1, 0), cB + kstep, voffB); PG8_STAGE(PG8_SA(1, 0), cA + kstep, voffA); PG8_STAGE(PG8_SB(1, 1), cB + hstep + kstep, voffB);
        PG8_WAIT_V(6); PG8_BAR;
    }
    for (;;) {
        const bool has_next = S.next(ui + 1, nxt);
        const char* nA = has_next ? (const char*)(g.A + (size_t)nxt.z * g.zA) + (size_t)nxt.pm * tstep : cA; const char* nB = has_next ? (const char*)(g.Bt + (size_t)nxt.z * g.zB) + (size_t)nxt.pn * tstep : cB;
        for (int t = 0; t < nt; t += 2) {
            const bool last = (t == nt - 2);
            const char* a1 = cA + (size_t)(t + 1) * kstep;
            const char* a2 = last ? nA : cA + (size_t)(t + 2) * kstep; const char* b2 = last ? nB : cB + (size_t)(t + 2) * kstep;
            const char* a3 = a2 + kstep; const char* b3 = b2 + kstep;
            if (last && has_next) S.a_ready(nxt);
            if constexpr (SP2) {
            PG8_LDB(B0, 0, 0); PG8_LDB(B1, 0, 1); PG8_SCHED; PG8_LDA(At, 0, 0); PG8_STAGE(PG8_SA(1, 1), a1 + hstep, voffA);
            PG8_WAIT_V(8); PG8_WAIT_L(0); PG8_BAR; PG8_MMA(0, 0, At, B0); PG8_MMA(0, 1, At, B1); PG8_BAR; PG8_SCHED;
            PG8_LDA(At, 0, 1); PG8_STAGE(PG8_SB(0, 0), b2, voffB); PG8_STAGE(PG8_SB(0, 1), b2 + hstep, voffB); PG8_STAGE(PG8_SA(0, 0), a2, voffA);
            PG8_WAIT_V(8); PG8_WAIT_L(0); PG8_BAR; PG8_MMA(1, 0, At, B0); PG8_MMA(1, 1, At, B1); PG8_BAR; PG8_SCHED;
            PG8_LDB(B0, 1, 0); PG8_LDB(B1, 1, 1); PG8_SCHED; PG8_LDA(At, 1, 0); PG8_STAGE(PG8_SA(0, 1), a2 + hstep, voffA);
            PG8_WAIT_V(8); PG8_WAIT_L(0); PG8_BAR; PG8_MMA(0, 0, At, B0); PG8_MMA(0, 1, At, B1); PG8_BAR; PG8_SCHED;
            PG8_LDA(At, 1, 1); PG8_STAGE(PG8_SB(1, 0), b3, voffB); PG8_STAGE(PG8_SB(1, 1), b3 + hstep, voffB); PG8_STAGE(PG8_SA(1, 0), a3, voffA);
            PG8_WAIT_V(8); PG8_WAIT_L(0); PG8_BAR; PG8_MMA(1, 0, At, B0); PG8_MMA(1, 1, At, B1); PG8_BAR; PG8_SCHED;
            } else {
            PG8_LDB(B0, 0, 0); PG8_SCHED; PG8_LDA(At, 0, 0); PG8_STAGE(PG8_SA(1, 1), a1 + hstep, voffA);
            PG8_WAIT_L(8); PG8_BAR; PG8_WAIT_L(0); PG8_MMA(0, 0, At, B0); PG8_BAR; PG8_SCHED;
            PG8_LDB(B1, 0, 1); PG8_STAGE(PG8_SB(0, 0), b2, voffB);
            PG8_BAR; PG8_WAIT_L(0); PG8_MMA(0, 1, At, B1); PG8_BAR;
            PG8_LDA(At, 0, 1); PG8_STAGE(PG8_SA(0, 0), a2, voffA);
            PG8_BAR; PG8_WAIT_L(0); PG8_MMA(1, 0, At, B0); PG8_BAR; PG8_SCHED;
            PG8_STAGE(PG8_SB(0, 1), b2 + hstep, voffB);
            PG8_WAIT_V(6); PG8_BAR; PG8_MMA(1, 1, At, B1); PG8_BAR;
            PG8_LDB(B0, 1, 0); PG8_SCHED; PG8_LDA(At, 1, 0); PG8_STAGE(PG8_SA(0, 1), a2 + hstep, voffA);
            PG8_WAIT_L(8); PG8_BAR; PG8_WAIT_L(0); PG8_MMA(0, 0, At, B0); PG8_BAR; PG8_SCHED;
            PG8_LDB(B1, 1, 1); PG8_STAGE(PG8_SB(1, 0), b3, voffB);
            PG8_BAR; PG8_WAIT_L(0); PG8_MMA(0, 1, At, B1); PG8_BAR;
            PG8_LDA(At, 1, 1); PG8_STAGE(PG8_SA(1, 0), a3, voffA);
            PG8_BAR; PG8_WAIT_L(0); PG8_MMA(1, 0, At, B0); PG8_BAR; PG8_SCHED;
            PG8_STAGE(PG8_SB(1, 1), b3 + hstep, voffB);
            PG8_WAIT_V(6); PG8_BAR; PG8_MMA(1, 1, At, B1); PG8_BAR;
            }
        }
        if constexpr (ALIGN_EPI) { if (wr == 0) PG8_BAR; }
        if constexpr (!Epi::AFTER_DRAIN) { E(acc, cur, wr, wc, fr, fq); S.done(cur); }
        if (!has_next) break;
#pragma unroll
        for (int a = 0; a < 2; ++a)
#pragma unroll
            for (int b = 0; b < 2; ++b)
#pragma unroll
                for (int m = 0; m < 4; ++m)
#pragma unroll
                    for (int n = 0; n < 2; ++n) acc[a][b][m][n] = (f32x4){0.f, 0.f, 0.f, 0.f};
        cur = nxt; cA = nA; cB = nB; ++ui;
        if constexpr (ALIGN_EPI) { if (wr == 1) PG8_BAR; }
    }
    PG8_WAIT_V(0);
    if constexpr (!ALIGN_EPI) { if (wr == 0) PG8_BAR; }
    PG8_BAR;
    if constexpr (Epi::AFTER_DRAIN) { E.fused(acc, cur, wr, wc, fr, fq, lds, wid, lane); S.done(cur); }
#undef PG8_SA
#undef PG8_SB
#undef PG8_STAGE
#undef PG8_LDA
#undef PG8_LDB
#undef PG8_MMA
#undef PG8_WAIT_V
#undef PG8_WAIT_L
#undef PG8_BAR
#undef PG8_SCHED
}
}

constexpr int NWAVES = 8;
constexpr int BATCH = 8, SEQ = 2048, DM = 2048, DEPTH = 4, M = BATCH * SEQ, NH = 8;
constexpr int NIN = 16400, NZ = 16384, DFF = 5632, NUP = 2 * DFF, NY = 3072;
constexpr int Z_RQ = 0, Z_RK = 1024, Z_RV = 2048, Z_RG = 3072, Z_MQ = 4096, Z_MK = 4608, Z_MV = 5120, Z_MO = 6144, Z_AQ = 7168, Z_AK = 8192, Z_AV = 9216, Z_GA = 10240, Z_GB = 12288, Z_GC = 14336;
constexpr int W_GATE_COL = 7168;
constexpr size_t MiB = 1u << 20;
constexpr size_t WS_CTL = 0, CTL_ZERO_BYTES = 1 * MiB;
constexpr size_t WS_RS = 1520 * MiB;
constexpr size_t WS_TAB = 2 * MiB + 512 * 1024;
constexpr size_t WS_RSTD = 7 * MiB + 512 * 1024;
constexpr size_t WS_W16G = 7 * MiB;
constexpr size_t WS_KMEAN = 5 * MiB;
constexpr size_t WS_GIF = 6 * MiB;
constexpr size_t WS_WIN = 8 * MiB;
constexpr size_t WS_WP = 264 * MiB;
constexpr size_t WS_WOUT = 312 * MiB;
constexpr size_t WS_WUP = 344 * MiB;
constexpr size_t WS_WDN = 520 * MiB;
constexpr size_t WS_XB = 608 * MiB;
constexpr size_t WS_Z = 672 * MiB;
constexpr size_t WS_Y = 1184 * MiB;
constexpr size_t WS_MG = 1280 * MiB;
constexpr size_t WS_ACT = 1344 * MiB;
constexpr size_t WS_END = 1536 * MiB;
constexpr int CW_TMO = 0, CW_CODE = 1;
constexpr int CW_BAR = 4096;
constexpr int CW_QUEUE = 8192;
constexpr int RING_OFF = 0, RING_BYTES = 131072;
constexpr int LDS_BYTES = 163840;
constexpr int LDSCTL_OFF = LDS_BYTES - 512, MISC_OFF = LDSCTL_OFF + 320;
static_assert(MISC_OFF + 128 <= LDS_BYTES, "LDS map");

#define GAS __attribute__((address_space(1)))
#define LAS __attribute__((address_space(3)))
typedef unsigned short bf16;
typedef unsigned v4u __attribute__((ext_vector_type(4)));
typedef unsigned v2u __attribute__((ext_vector_type(2)));
typedef float f32x4 __attribute__((ext_vector_type(4)));
typedef float f32x2 __attribute__((ext_vector_type(2)));
typedef GAS unsigned gu32;
#define RLX_AGENT __ATOMIC_RELAXED, __HIP_MEMORY_SCOPE_AGENT
#define LDS_WAIT() asm volatile("s_waitcnt lgkmcnt(0)" ::: "memory")
#define VM_WAIT() asm volatile("s_waitcnt vmcnt(0)" ::: "memory")
typedef __bf16 bf16x2_t __attribute__((ext_vector_type(2)));
__device__ __forceinline__ unsigned pk2(float lo, float hi) { const f32x2 v = {lo, hi}; const bf16x2_t b = __builtin_convertvector(v, bf16x2_t); return __builtin_bit_cast(unsigned, b); }
__device__ __forceinline__ unsigned f2bf(float f) { return pk2(f, f); }
__device__ __forceinline__ float bflo(unsigned w) { return __uint_as_float(w << 16); }
__device__ __forceinline__ float bfhi(unsigned w) { return __uint_as_float(w & 0xffff0000u); }
__device__ __forceinline__ float bf1(bf16 v) { return __uint_as_float((unsigned)v << 16); }
__device__ __forceinline__ float sigm(float x) { return 1.0f / (1.0f + __expf(-x)); }

#define XB_TMO      128
#define XB_XCNT(j)  (256  + 64 * (j))
#define XB_XSUB(j)  (1280 + 64 * (j))
#define XB_XGEN(j)  (2304 + 64 * (j))
#define XB_TOP      3328
#define XB_TOPGEN   3392
#define XCD_BAR_WORDS 3456
#define XB_SPIN_CAP (1u << 18)

__device__ __forceinline__ unsigned xb_ld(unsigned* p)              { return __hip_atomic_load(p, __ATOMIC_RELAXED, __HIP_MEMORY_SCOPE_AGENT); }
__device__ __forceinline__ unsigned xb_add(unsigned* p, unsigned v) { return __hip_atomic_fetch_add(p, v, __ATOMIC_RELAXED, __HIP_MEMORY_SCOPE_AGENT); }
__device__ __forceinline__ unsigned xb_xcc_id() { return (unsigned)__builtin_amdgcn_s_getreg((3 << 11) | 20) & 0xFu; }
#define XB_SPIN(cond, bar) do { unsigned _sp = 0; while (cond) { __builtin_amdgcn_s_sleep(1); \
    if ((++_sp & 255u) == 0u) { if (xb_ld(&(bar)[XB_TMO])) break; if (_sp > XB_SPIN_CAP) { atomicAdd(&(bar)[XB_TMO], 1u); break; } } } } while (0)

struct XcdBarrier {
    unsigned* bar; unsigned x;
    volatile LAS unsigned* st;
};

__device__ __forceinline__ XcdBarrier xcd_barrier_post(unsigned* bar, volatile LAS unsigned* st) {
    XcdBarrier b; b.bar = bar; b.x = xb_xcc_id(); b.st = st;
    if (threadIdx.x == 0) (void)xb_add(&bar[XB_XCNT(b.x)], 1u);
    return b;
}
__device__ __forceinline__ void xcd_barrier_complete(unsigned* bar, unsigned x, unsigned& nloc, unsigned& nx) {
    const unsigned G = gridDim.x * gridDim.y * gridDim.z;
    unsigned sum, cnt, mine, sp = 0u;
    for (;;) {
        sum = 0u; cnt = 0u; mine = 0u;
#pragma unroll
        for (unsigned j = 0; j < 16; ++j) { const unsigned c = xb_ld(&bar[XB_XCNT(j)]); sum += c; cnt += (c > 0u) ? 1u : 0u; mine = (j == x) ? c : mine; }
        if (sum == G) break;
        __builtin_amdgcn_s_sleep(1);
        if ((++sp & 255u) == 0u) { if (xb_ld(&bar[XB_TMO])) break; if (sp > XB_SPIN_CAP) { atomicAdd(&bar[XB_TMO], 1u); break; } }
    }
    nloc = mine > 0u ? mine : 1u; nx = cnt > 0u ? cnt : 1u;
}

__device__ __forceinline__ void xcd_barrier(const XcdBarrier& b) {
    asm volatile("s_waitcnt vmcnt(0)" ::: "memory");
    __syncthreads();
    if (threadIdx.x == 0) {
        unsigned* bar = b.bar;
        __builtin_amdgcn_s_waitcnt(0);
        unsigned nloc = b.st[0], nx = b.st[1];
        if (nloc == 0u) { xcd_barrier_complete(bar, b.x, nloc, nx); b.st[0] = nloc; b.st[1] = nx; }
        const unsigned old = xb_add(&bar[XB_XSUB(b.x)], 1u);
        const unsigned gen = old / nloc;
        if (old + 1u == (gen + 1u) * nloc) {
            __builtin_amdgcn_fence(__ATOMIC_RELEASE, "agent");
            asm volatile("s_waitcnt vmcnt(0)" ::: "memory");
            const unsigned og = xb_add(&bar[XB_TOP], 1u);
            const unsigned tg = og / nx;
            if (og + 1u == (tg + 1u) * nx) xb_add(&bar[XB_TOPGEN], 1u);
            else XB_SPIN(xb_ld(&bar[XB_TOPGEN]) == tg, bar);
            __builtin_amdgcn_fence(__ATOMIC_ACQUIRE, "agent");
            xb_add(&bar[XB_XGEN(b.x)], 1u);
            asm volatile("s_waitcnt vmcnt(0)" ::: "memory");
        } else {
            XB_SPIN(xb_ld(&bar[XB_XGEN(b.x)]) == gen, bar);
            __builtin_amdgcn_fence(__ATOMIC_ACQUIRE, "agent");
            asm volatile("s_waitcnt vmcnt(0)" ::: "memory");
        }
    }
    __syncthreads();
}

struct Args { const float* in[18]; float* out; unsigned char* ws; int ph_lo, ph_hi, li, pad; };
enum { I_X = 0, I_WIN, I_BIG, I_BFG, I_NMIX, I_RGN, I_MLN, I_QN, I_KN, I_WPA, I_WPB, I_WPC, I_WOUT, I_NFFN, I_WUP, I_CW, I_CB, I_WDN };
struct Frame {
    LAS unsigned char* lds;
    volatile LAS unsigned* MISC;
    unsigned char* ws;
    int tid, lane, wave, G, bx;
};
#define WSP(T, off) ((T*)(F.ws + (off)))
__device__ __forceinline__ float wave_sum(float v) {
#pragma unroll
    for (int o = 1; o < 64; o <<= 1) v += __shfl_xor(v, o);
    return v;
}
__device__ __forceinline__ float wave_max(float v) {
#pragma unroll
    for (int o = 1; o < 64; o <<= 1) v = fmaxf(v, __shfl_xor(v, o));
    return v;
}
__device__ __forceinline__ void p0_transpose_item(const float* W, int ldw, int K, int nblk, bf16* WT, LAS float* scr, int item, int lane, const float* gk = nullptr) {
    const int kb = item / nblk, nb = item % nblk, k0 = 64 * kb, n0 = 32 * nb;
#pragma unroll 8
    for (int i = 0; i < 32; ++i) { const int kk = 2 * i + (lane >> 5); scr[kk * 33 + (lane & 31)] = W[(size_t)(k0 + kk) * ldw + n0 + (lane & 31)]; }
    LDS_WAIT(); asm volatile("" ::: "memory");
    const int c = lane & 7;
    f32x4 g0 = (f32x4){1.f, 1.f, 1.f, 1.f}, g1 = g0;
    if (gk) { g0 = *(const f32x4*)(gk + k0 + 8 * c); g1 = *(const f32x4*)(gk + k0 + 8 * c + 4); }
#pragma unroll
    for (int j = 0; j < 4; ++j) { const int n = (lane >> 3) + 8 * j; const LAS float* s = scr + (8 * c) * 33 + n;
        v4u o; o.x = pk2(s[0 * 33] * g0[0], s[1 * 33] * g0[1]); o.y = pk2(s[2 * 33] * g0[2], s[3 * 33] * g0[3]); o.z = pk2(s[4 * 33] * g1[0], s[5 * 33] * g1[1]); o.w = pk2(s[6 * 33] * g1[2], s[7 * 33] * g1[3]);
        *(GAS v4u*)(WT + (size_t)(n0 + n) * K + k0 + 8 * c) = o; }
    LDS_WAIT(); asm volatile("" ::: "memory");
}
__device__ __forceinline__ void p0_prologue(Frame& F, const Args& args) {
    LAS float* scr = (LAS float*)(F.lds + RING_OFF + F.wave * 16384);
    const int gw = F.bx * NWAVES + F.wave, NGW = F.G * NWAVES;
    constexpr int I_INA = 32 * 224, I_INB = 32 * 288, I_P = 16 * 64, I_OUT = 32 * 64, I_UP = 32 * 352, I_DN = 88 * 64;
    constexpr int I_LAYER = I_INA + I_INB + 3 * I_P + I_OUT + I_UP + I_DN;
    for (int it = gw; it < DEPTH * I_LAYER; it += NGW) {
        const int l = it / I_LAYER; int r = it % I_LAYER;
        const float* win = args.in[I_WIN] + (size_t)l * DM * NIN; bf16* wint = WSP(bf16, WS_WIN) + (size_t)l * NZ * DM;
        if (r < I_INA) { p0_transpose_item(win, NIN, DM, 224, wint, scr, r, F.lane, args.in[I_NMIX] + l * DM); continue; } r -= I_INA;
        if (r < I_INB) { p0_transpose_item(win + 7184, NIN, DM, 288, wint + (size_t)7168 * DM, scr, r, F.lane, args.in[I_NMIX] + l * DM); continue; } r -= I_INB;
        if (r < I_P) { p0_transpose_item(args.in[I_WPA] + (size_t)l * 1024 * DM, DM, 1024, 64, WSP(bf16, WS_WP) + ((size_t)l * 3 + 0) * DM * 1024, scr, r, F.lane); continue; } r -= I_P;
        if (r < I_P) { p0_transpose_item(args.in[I_WPB] + (size_t)l * 1024 * DM, DM, 1024, 64, WSP(bf16, WS_WP) + ((size_t)l * 3 + 1) * DM * 1024, scr, r, F.lane); continue; } r -= I_P;
        if (r < I_P) { p0_transpose_item(args.in[I_WPC] + (size_t)l * 1024 * DM, DM, 1024, 64, WSP(bf16, WS_WP) + ((size_t)l * 3 + 2) * DM * 1024, scr, r, F.lane); continue; } r -= I_P;
        if (r < I_OUT) { p0_transpose_item(args.in[I_WOUT] + (size_t)l * DM * DM, DM, DM, 64, WSP(bf16, WS_WOUT) + (size_t)l * DM * DM, scr, r, F.lane); continue; } r -= I_OUT;
        if (r < I_UP) { p0_transpose_item(args.in[I_WUP] + (size_t)l * DM * NUP, NUP, DM, 352, WSP(bf16, WS_WUP) + (size_t)l * NUP * DM, scr, r, F.lane, args.in[I_NFFN] + l * DM); continue; } r -= I_UP;
        p0_transpose_item(args.in[I_WDN] + (size_t)l * DFF * DM, DM, DFF, 64, WSP(bf16, WS_WDN) + (size_t)l * DM * DFF, scr, r, F.lane);
    }
    const int gt = F.bx * (NWAVES * 64) + F.tid, NGT = F.G * NWAVES * 64;
    for (int i = gt; i < DEPTH * 16 * DM; i += NGT) { const int l = i / (16 * DM), c = (i / DM) % 16, k = i % DM; WSP(bf16, WS_W16G)[i] = (bf16)f2bf(args.in[I_WIN][((size_t)l * DM + k) * NIN + W_GATE_COL + c] * args.in[I_NMIX][l * DM + k]); }
    for (int m = gw; m < M; m += NGW) { const f32x4* xr = (const f32x4*)(args.in[I_X] + (size_t)m * DM) + F.lane; v2u* o8 = (v2u*)(WSP(bf16, WS_XB) + (size_t)m * DM) + F.lane; float s = 0.f;
#pragma unroll
        for (int j = 0; j < 8; ++j) { const f32x4 v = xr[64 * j]; s += (v.x * v.x + v.y * v.y) + (v.z * v.z + v.w * v.w); v2u w; w.x = pk2(v.x, v.y); w.y = pk2(v.z, v.w); o8[64 * j] = w; }
        s = wave_sum(s); if (F.lane < 32) WSP(float, WS_RS)[(size_t)m * 32 + F.lane] = (F.lane == 0) ? s : 0.f; }
    for (int i = gt; i < 2 * SEQ * 64; i += NGT) { const int which = i / (SEQ * 64), pos = (i / 64) % SEQ, d = i % 64;
        const float ex = which == 0 ? (float)d / 63.0f : (float)(2 * d) / 128.0f;
        const float inv = 1.0f / powf(10000.0f, ex); const float ang = (float)pos * inv; float s, c; sincosf(ang, &s, &c); WSP(f32x2, WS_TAB)[i] = (f32x2){c, s}; }
}
__device__ __forceinline__ void prep_phase(Frame& F, const float* qn, const float* kn, const bf16* w16g, const float* rs, const float* big, const float* bfg) {
    const int gw = F.bx * NWAVES + F.wave, NGW = F.G * NWAVES, lane = F.lane, rsub = lane >> 2, dg = lane & 3;
    const f32x2* trope = WSP(f32x2, WS_TAB) + SEQ * 64;
    for (int u = gw; u < 2 * BATCH * 16 * NH; u += NGW) {
        const int kind = u & 1, hh = (u >> 1) & 7, hb = (u >> 4) & 15, b = u >> 8;
        const float* wn = kind ? kn : qn;
        const float* rsb = rs + (size_t)(b * SEQ + hb * 128) * 32 + 8 * dg;
        float wl[16], wh[16], s1[16], s2[16];
#pragma unroll
        for (int e = 0; e < 16; ++e) { wl[e] = wn[16 * dg + e]; wh[e] = wn[64 + 16 * dg + e]; s1[e] = 0.f; s2[e] = 0.f; }
        bf16* zb = WSP(bf16, WS_Z) + (size_t)(b * SEQ + hb * 128) * NZ + (kind ? Z_AK : Z_AQ) + hh * 128 + 16 * dg;
#pragma unroll 2
        for (int st = 0; st < 8; ++st) {
            const int r = rsub + 16 * st, pos = hb * 128 + r; bf16* zr = zb + (size_t)r * NZ;
            const v4u l0 = *(const v4u*)(zr), l1 = *(const v4u*)(zr + 8), h0 = *(const v4u*)(zr + 64), h1 = *(const v4u*)(zr + 72);
            float a[16] = {bflo(l0.x), bfhi(l0.x), bflo(l0.y), bfhi(l0.y), bflo(l0.z), bfhi(l0.z), bflo(l0.w), bfhi(l0.w), bflo(l1.x), bfhi(l1.x), bflo(l1.y), bfhi(l1.y), bflo(l1.z), bfhi(l1.z), bflo(l1.w), bfhi(l1.w)};
            float c[16] = {bflo(h0.x), bfhi(h0.x), bflo(h0.y), bfhi(h0.y), bflo(h0.z), bfhi(h0.z), bflo(h0.w), bfhi(h0.w), bflo(h1.x), bfhi(h1.x), bflo(h1.y), bfhi(h1.y), bflo(h1.z), bfhi(h1.z), bflo(h1.w), bfhi(h1.w)};
            float ss = 0.f;
#pragma unroll
            for (int e = 0; e < 16; ++e) ss += a[e] * a[e] + c[e] * c[e];
            ss += __shfl_xor(ss, 1); ss += __shfl_xor(ss, 2);
            float rq; { const f32x4 s0 = *(const f32x4*)(rsb + (size_t)r * 32), s1 = *(const f32x4*)(rsb + (size_t)r * 32 + 4); rq = ((s0[0] + s0[1]) + (s0[2] + s0[3])) + ((s1[0] + s1[1]) + (s1[2] + s1[3])); }
            rq += __shfl_xor(rq, 1); rq += __shfl_xor(rq, 2);
            const float rr = rsqrtf(rq * (1.0f / 2048.0f) + 1e-6f);
            if ((u & 15) == 0 && dg == 0) WSP(float, WS_RSTD)[b * SEQ + hb * 128 + r] = rr;
            const float rstd = rr * rsqrtf(ss * rr * rr * (1.f / 128.f) + 1e-6f);
            const f32x2* tb = trope + pos * 64 + 16 * dg;
#pragma unroll
            for (int e = 0; e < 16; ++e) { const float x1 = a[e] * rstd * wl[e], x2 = c[e] * rstd * wh[e]; const f32x2 cs = tb[e]; a[e] = x1 * cs.x - x2 * cs.y; c[e] = x1 * cs.y + x2 * cs.x; s1[e] += a[e]; s2[e] += c[e]; }
            *(v4u*)(zr) = (v4u){pk2(a[0], a[1]), pk2(a[2], a[3]), pk2(a[4], a[5]), pk2(a[6], a[7])}; *(v4u*)(zr + 8) = (v4u){pk2(a[8], a[9]), pk2(a[10], a[11]), pk2(a[12], a[13]), pk2(a[14], a[15])};
            *(v4u*)(zr + 64) = (v4u){pk2(c[0], c[1]), pk2(c[2], c[3]), pk2(c[4], c[5]), pk2(c[6], c[7])}; *(v4u*)(zr + 72) = (v4u){pk2(c[8], c[9]), pk2(c[10], c[11]), pk2(c[12], c[13]), pk2(c[14], c[15])};
        }
        if (kind) {
            float* km = WSP(float, WS_KMEAN) + (size_t)((b * NH + hh) * 16 + hb) * 128 + 16 * dg;
#pragma unroll
            for (int e = 0; e < 16; ++e) { float x = s1[e], y = s2[e];
                x += __shfl_xor(x, 4); x += __shfl_xor(x, 8); x += __shfl_xor(x, 16); x += __shfl_xor(x, 32);
                y += __shfl_xor(y, 4); y += __shfl_xor(y, 8); y += __shfl_xor(y, 16); y += __shfl_xor(y, 32);
                if (rsub == 0) { km[e] = x * (1.f / 256.f); km[64 + e] = y * (1.f / 256.f); } }
        }
    }
    for (int it = gw; it < M / 32; it += NGW) {
#pragma unroll
        for (int st = 0; st < 8; ++st) { const int row = 32 * it + 4 * st + (lane >> 4), cg = lane & 15;
            const float* rp = rs + (size_t)row * 32; float rq = 0.f;
#pragma unroll
            for (int q = 0; q < 8; ++q) { const f32x4 s0 = *(const f32x4*)(rp + 4 * q); rq += (s0[0] + s0[1]) + (s0[2] + s0[3]); }
            const float rr = rsqrtf(rq * (1.0f / 2048.0f) + 1e-6f);
            bf16* vp = WSP(bf16, WS_Z) + (size_t)row * NZ + Z_AV + 8 * cg;
#pragma unroll
            for (int q = 0; q < 8; ++q) { const v4u x = *(const v4u*)(vp + 128 * q);
                *(v4u*)(vp + 128 * q) = (v4u){pk2(bflo(x.x) * rr, bfhi(x.x) * rr), pk2(bflo(x.y) * rr, bfhi(x.y) * rr), pk2(bflo(x.z) * rr, bfhi(x.z) * rr), pk2(bflo(x.w) * rr, bfhi(x.w) * rr)}; } }
    }
    for (int it = NGW - 1 - gw; it < M / 16; it += NGW) {
        const int i16 = lane & 15, g = lane >> 4; const bf16* ar = WSP(bf16, WS_XB) + (size_t)(16 * it + i16) * DM + 8 * g; const bf16* br = w16g + (size_t)i16 * DM + 8 * g;
        typedef short bf16x8_t __attribute__((ext_vector_type(8)));
        f32x4 acc = (f32x4){0.f, 0.f, 0.f, 0.f};
#pragma unroll 1
        for (int s0 = 0; s0 < DM / 32; s0 += 16) { bf16x8_t av[16], bv[16];
#pragma unroll
            for (int s = 0; s < 16; ++s) { av[s] = *(const bf16x8_t*)(ar + 32 * (s0 + s)); bv[s] = *(const bf16x8_t*)(br + 32 * (s0 + s)); }
#pragma unroll
            for (int s = 0; s < 16; ++s) acc = __builtin_amdgcn_mfma_f32_16x16x32_bf16(av[s], bv[s], acc, 0, 0, 0); }
#pragma unroll
        for (int r = 0; r < 4; ++r) { const int row = 16 * it + 4 * g + r; float ssq = 0.f;
#pragma unroll
            for (int q = 0; q < 8; ++q) { const f32x4 a = *(const f32x4*)(rs + (size_t)row * 32 + 4 * q); ssq += (a[0] + a[1]) + (a[2] + a[3]); }
            const float sr = rsqrtf(ssq * (1.0f / 2048.0f) + 1e-6f);
            const float pre = acc[r] * sr + (i16 < 8 ? big[i16 & 7] : bfg[i16 & 7]); const float sc = 15.0f * tanhf(pre * (1.0f / 15.0f));
            float o = sc; if (i16 >= 8) o = sc > 0.f ? -log1pf(__expf(-sc)) : sc - log1pf(__expf(sc));
            WSP(float, WS_GIF)[(size_t)row * 16 + i16] = o; }
    }
}
__device__ __forceinline__ void glu_phase(Frame& F, const float* cw, const float* cb, const float* rs) {
    const int gw = F.bx * NWAVES + F.wave, NGW = F.G * NWAVES, lane = F.lane;
    constexpr int RB = 8, NCG = DFF / 512;
    const bf16* U = WSP(bf16, WS_Z); bf16* ACT = WSP(bf16, WS_ACT);
    for (int it = gw; it < (M / RB) * NCG; it += NGW) {
        const int cgp = it % NCG, rb = it / NCG, c8 = (cgp * 64 + lane) * 8, m0 = rb * RB; const bool first = (m0 & (SEQ - 1)) == 0;
        float myrr; { const int wr_ = lane >> 2, pt = lane & 3; const int m = m0 - 2 + wr_; float q = 0.f;
            if (wr_ < RB + 2 && !(wr_ < 2 && first)) { const f32x4 s0 = *(const f32x4*)(rs + (size_t)m * 32 + 8 * pt), s1 = *(const f32x4*)(rs + (size_t)m * 32 + 8 * pt + 4); q = ((s0[0] + s0[1]) + (s0[2] + s0[3])) + ((s1[0] + s1[1]) + (s1[2] + s1[3])); }
            q += __shfl_xor(q, 1); q += __shfl_xor(q, 2); myrr = rsqrtf(q * (1.0f / 2048.0f) + 1e-6f); }
        v4u ua[RB + 2], ub[RB + 2];
#pragma unroll
        for (int r = 0; r < RB + 2; ++r) { const int m = m0 - 2 + r;
            if (r < 2 && first) { ua[r] = (v4u){0u, 0u, 0u, 0u}; ub[r] = (v4u){0u, 0u, 0u, 0u}; }
            else { ua[r] = *(const v4u*)(U + (size_t)m * NUP + c8); ub[r] = *(const v4u*)(U + (size_t)m * NUP + DFF + c8); } }
        float wa[3][8], wb[3][8], ba[8], bb[8];
#pragma unroll
        for (int j = 0; j < 3; ++j) { const f32x4 a0 = *(const f32x4*)(cw + (size_t)j * NUP + c8), a1 = *(const f32x4*)(cw + (size_t)j * NUP + c8 + 4), b0 = *(const f32x4*)(cw + (size_t)j * NUP + DFF + c8), b1 = *(const f32x4*)(cw + (size_t)j * NUP + DFF + c8 + 4);
            wa[j][0] = a0.x; wa[j][1] = a0.y; wa[j][2] = a0.z; wa[j][3] = a0.w; wa[j][4] = a1.x; wa[j][5] = a1.y; wa[j][6] = a1.z; wa[j][7] = a1.w;
            wb[j][0] = b0.x; wb[j][1] = b0.y; wb[j][2] = b0.z; wb[j][3] = b0.w; wb[j][4] = b1.x; wb[j][5] = b1.y; wb[j][6] = b1.z; wb[j][7] = b1.w; }
        { const f32x4 a0 = *(const f32x4*)(cb + c8), a1 = *(const f32x4*)(cb + c8 + 4), b0 = *(const f32x4*)(cb + DFF + c8), b1 = *(const f32x4*)(cb + DFF + c8 + 4);
          ba[0] = a0.x; ba[1] = a0.y; ba[2] = a0.z; ba[3] = a0.w; ba[4] = a1.x; ba[5] = a1.y; ba[6] = a1.z; ba[7] = a1.w; bb[0] = b0.x; bb[1] = b0.y; bb[2] = b0.z; bb[3] = b0.w; bb[4] = b1.x; bb[5] = b1.y; bb[6] = b1.z; bb[7] = b1.w; }
#pragma unroll
        for (int r = 0; r < RB; ++r) {
            float xa[8], xb[8];
#pragma unroll
            for (int e = 0; e < 8; ++e) { xa[e] = ba[e]; xb[e] = bb[e]; }
#pragma unroll
            for (int j = 0; j < 3; ++j) { const v4u a = ua[r + j], b = ub[r + j]; const float rsc = __shfl(myrr, 4 * (r + j));
                const float fa[8] = {bflo(a.x), bfhi(a.x), bflo(a.y), bfhi(a.y), bflo(a.z), bfhi(a.z), bflo(a.w), bfhi(a.w)};
                const float fb[8] = {bflo(b.x), bfhi(b.x), bflo(b.y), bfhi(b.y), bflo(b.z), bfhi(b.z), bflo(b.w), bfhi(b.w)};
#pragma unroll
                for (int e = 0; e < 8; ++e) { xa[e] += fa[e] * rsc * wa[j][e]; xb[e] += fb[e] * rsc * wb[j][e]; } }
            float o[8];
#pragma unroll
            for (int e = 0; e < 8; ++e) o[e] = xa[e] * __builtin_amdgcn_rcpf(1.0f + __expf(-xa[e])) * xb[e];
            *(v4u*)(ACT + (size_t)(m0 + r) * DFF + c8) = (v4u){pk2(o[0], o[1]), pk2(o[2], o[3]), pk2(o[4], o[5]), pk2(o[6], o[7])};
        }
    }
}
namespace mx {
typedef short bf16x8 __attribute__((ext_vector_type(8)));
typedef short s16x4 __attribute__((ext_vector_type(4)));
#define MFMA16(a, b, c) __builtin_amdgcn_mfma_f32_16x16x32_bf16((a), (b), (c), 0, 0, 0)
#define LDS_FENCE() asm volatile("s_waitcnt lgkmcnt(0)" ::: "memory")
#define SCHED_FENCE() __builtin_amdgcn_sched_barrier(0)
__device__ __forceinline__ bf16x8 frag_row(const LAS bf16* X, int ld, int r0, int c0, int lane) {
    return *(const LAS bf16x8*)(X + (r0 + (lane & 15)) * ld + c0 + 8 * (lane >> 4)); }
__device__ __forceinline__ bf16x8 frag_tr(const LAS bf16* X, int ld, int k0, int c0, int lane) {
    const int g = lane >> 4, q = (lane & 15) >> 2, p = lane & 3;
    const LAS bf16* a = X + (k0 + 8 * g + q) * ld + c0 + 4 * p;
    const s16x4 lo = __builtin_amdgcn_ds_read_tr16_b64_v4i16((LAS s16x4*)a);
    const s16x4 hi = __builtin_amdgcn_ds_read_tr16_b64_v4i16((LAS s16x4*)(a + 4 * ld));
    return __builtin_shufflevector(lo, hi, 0, 1, 2, 3, 4, 5, 6, 7);
}
__device__ __forceinline__ float red16_sum(float v) { v += __shfl_xor(v, 1); v += __shfl_xor(v, 2); v += __shfl_xor(v, 4); v += __shfl_xor(v, 8); return v; }
__device__ __forceinline__ float red16_max(float v) { v = fmaxf(v, __shfl_xor(v, 1)); v = fmaxf(v, __shfl_xor(v, 2)); v = fmaxf(v, __shfl_xor(v, 4)); v = fmaxf(v, __shfl_xor(v, 8)); return v; }
__device__ __forceinline__ void rot8(const v4u lo, const v4u hi, const f32x2* tb, float sc, v4u& olo, v4u& ohi) {
    float a[8] = {bflo(lo.x), bfhi(lo.x), bflo(lo.y), bfhi(lo.y), bflo(lo.z), bfhi(lo.z), bflo(lo.w), bfhi(lo.w)};
    float c[8] = {bflo(hi.x), bfhi(hi.x), bflo(hi.y), bfhi(hi.y), bflo(hi.z), bfhi(hi.z), bflo(hi.w), bfhi(hi.w)};
    float o1[8], o2[8];
#pragma unroll
    for (int e = 0; e < 8; ++e) { const f32x2 cs = tb[e]; o1[e] = (a[e] * cs.x - c[e] * cs.y) * sc; o2[e] = (a[e] * cs.y + c[e] * cs.x) * sc; }
    olo = (v4u){pk2(o1[0], o1[1]), pk2(o1[2], o1[3]), pk2(o1[4], o1[5]), pk2(o1[6], o1[7])};
    ohi = (v4u){pk2(o2[0], o2[1]), pk2(o2[2], o2[3]), pk2(o2[4], o2[5]), pk2(o2[6], o2[7])};
}
constexpr int LQ = 136;
__device__ __forceinline__ void ret_unit(Frame& F, const float* gn, int b, int h) {
    LAS bf16* Qs = (LAS bf16*)(F.lds); LAS bf16* Ks = Qs + 128 * LQ; LAS bf16* Vs = Ks + 128 * LQ; LAS bf16* Ts = Vs + 128 * LQ;
    const int tid = F.tid, lane = F.lane, w = tid >> 6, i16 = lane & 15, g = lane >> 4;
    const float gamma = 1.0f - exp2f(-5.0f - (float)h), lg = log2f(gamma);
    const float gC = exp2f(lg * 128.0f);
    f32x4 accT[8];
#pragma unroll
    for (int n = 0; n < 8; ++n) accT[n] = (f32x4){0.f, 0.f, 0.f, 0.f};
    for (int i = tid; i < 128 * LQ / 8; i += NWAVES * 64) ((LAS v4u*)Ts)[i] = (v4u){0u, 0u, 0u, 0u};
    const bf16* zb = WSP(bf16, WS_Z) + (size_t)(b * SEQ) * NZ + h * 128;
    const f32x2* tret = WSP(f32x2, WS_TAB);
    bf16* yb = WSP(bf16, WS_Y) + (size_t)(b * SEQ) * 1024 + h * 128;
    const int lr = tid >> 2, dg = tid & 3;
    v4u pq[4], pk[4], pv[4]; float prr;
    const float* rstd1 = WSP(float, WS_RSTD) + (size_t)(b * SEQ);
#define RET_FETCH(t0_) do { const bf16* zr_ = zb + (size_t)((t0_) + lr) * NZ; \
        pq[0] = *(const v4u*)(zr_ + Z_RQ + 16 * dg); pq[1] = *(const v4u*)(zr_ + Z_RQ + 64 + 16 * dg); pq[2] = *(const v4u*)(zr_ + Z_RQ + 16 * dg + 8); pq[3] = *(const v4u*)(zr_ + Z_RQ + 64 + 16 * dg + 8); \
        pk[0] = *(const v4u*)(zr_ + Z_RK + 16 * dg); pk[1] = *(const v4u*)(zr_ + Z_RK + 64 + 16 * dg); pk[2] = *(const v4u*)(zr_ + Z_RK + 16 * dg + 8); pk[3] = *(const v4u*)(zr_ + Z_RK + 64 + 16 * dg + 8); \
        _Pragma("unroll") for (int q_ = 0; q_ < 4; ++q_) pv[q_] = *(const v4u*)(zr_ + Z_RV + 32 * dg + 8 * q_); prr = rstd1[(t0_) + lr]; } while (0)
    RET_FETCH(0);
    const float sq = exp2f(lg * (float)lr), sk = exp2f(-lg * (float)lr) * 0.08838834764831845f;
    for (int c = 0; c < SEQ / 128; ++c) {
        const int t0 = c * 128;
        {
            const f32x2* tb = tret + (t0 + lr) * 64 + 16 * dg;
#pragma unroll
            for (int hh = 0; hh < 2; ++hh) {
                v4u o1, o2; rot8(pq[2 * hh], pq[2 * hh + 1], tb + 8 * hh, sq * prr, o1, o2);
                *(LAS v4u*)(Qs + lr * LQ + 16 * dg + 8 * hh) = o1; *(LAS v4u*)(Qs + lr * LQ + 64 + 16 * dg + 8 * hh) = o2;
                rot8(pk[2 * hh], pk[2 * hh + 1], tb + 8 * hh, sk * prr * prr, o1, o2);
                *(LAS v4u*)(Ks + lr * LQ + 16 * dg + 8 * hh) = o1; *(LAS v4u*)(Ks + lr * LQ + 64 + 16 * dg + 8 * hh) = o2;
            }
#pragma unroll
            for (int q = 0; q < 4; ++q) *(LAS v4u*)(Vs + lr * LQ + 32 * dg + 8 * q) = pv[q];
            if (c + 1 < SEQ / 128) RET_FETCH(t0 + 128);
        }
        __syncthreads();
        bf16x8 aq[4];
#pragma unroll
        for (int s = 0; s < 4; ++s) aq[s] = frag_row(Qs, LQ, 16 * w, 32 * s, lane);
        f32x4 acco[8];
#pragma unroll
        for (int n = 0; n < 8; ++n) acco[n] = (f32x4){0.f, 0.f, 0.f, 0.f};
#pragma unroll
        for (int s = 0; s < 4; ++s) { bf16x8 bb[8];
#pragma unroll
            for (int n = 0; n < 8; ++n) bb[n] = frag_tr(Ts, LQ, 32 * s, 16 * n, lane);
            SCHED_FENCE();
#pragma unroll
            for (int n = 0; n < 8; ++n) acco[n] = MFMA16(aq[s], bb[n], acco[n]); }
        LDS_FENCE();
#pragma unroll
        for (int n = 0; n < 8; ++n) {
            if (n <= w) { f32x4 sa = (f32x4){0.f, 0.f, 0.f, 0.f}; bf16x8 bb[4];
#pragma unroll
                for (int s = 0; s < 4; ++s) bb[s] = frag_row(Ks, LQ, 16 * n, 32 * s, lane);
                SCHED_FENCE();
#pragma unroll
                for (int s = 0; s < 4; ++s) sa = MFMA16(aq[s], bb[s], sa);
#pragma unroll
                for (int r = 0; r < 4; ++r) { const int i = 16 * w + 4 * g + r, j = 16 * n + i16; Qs[i * LQ + j] = (bf16)f2bf(j <= i ? sa[r] : 0.f); } }
            else if (n == w + 1) {
#pragma unroll
                for (int r = 0; r < 4; ++r) Qs[(16 * w + 4 * g + r) * LQ + 16 * n + i16] = (bf16)0; }
        }
        LDS_FENCE();
#pragma unroll
        for (int s = 0; s < 4; ++s) if (s <= (w >> 1)) { const bf16x8 as = frag_row(Qs, LQ, 16 * w, 32 * s, lane); bf16x8 bb[8];
#pragma unroll
            for (int n = 0; n < 8; ++n) bb[n] = frag_tr(Vs, LQ, 32 * s, 16 * n, lane);
            SCHED_FENCE();
#pragma unroll
            for (int n = 0; n < 8; ++n) acco[n] = MFMA16(as, bb[n], acco[n]); }
#pragma unroll
        for (int n = 0; n < 8; ++n) accT[n] = accT[n] * gC;
#pragma unroll
        for (int s = 0; s < 4; ++s) { const bf16x8 ak = frag_tr(Ks, LQ, 32 * s, 16 * w, lane); bf16x8 bb[8];
#pragma unroll
            for (int n = 0; n < 8; ++n) bb[n] = frag_tr(Vs, LQ, 32 * s, 16 * n, lane);
            SCHED_FENCE();
#pragma unroll
            for (int n = 0; n < 8; ++n) accT[n] = MFMA16(ak, bb[n], accT[n]); }
        LDS_FENCE();
        __syncthreads();
#pragma unroll
        for (int n = 0; n < 8; ++n)
#pragma unroll
            for (int r = 0; r < 4; ++r) Ts[(16 * w + 4 * g + r) * LQ + 16 * n + i16] = (bf16)f2bf(gC * accT[n][r]);
#pragma unroll
        for (int r = 0; r < 4; ++r) {
            float s = 0.f;
#pragma unroll
            for (int n = 0; n < 8; ++n) s += acco[n][r];
            const float mean = red16_sum(s) * (1.f / 128.f); float q = 0.f;
#pragma unroll
            for (int n = 0; n < 8; ++n) { const float d = acco[n][r] - mean; q += d * d; }
            const float rstd = rsqrtf(red16_sum(q) * (1.f / 128.f) + 1e-5f);
            const int pos = t0 + 16 * w + 4 * g + r; const bf16* gr = zb + (size_t)pos * NZ + Z_RG; bf16* yr = yb + (size_t)pos * 1024; const float rri = rstd1[pos];
#pragma unroll
            for (int n = 0; n < 8; ++n) { const int e = 16 * n + i16; const float gv = bf1(gr[e]) * rri; yr[e] = (bf16)f2bf((acco[n][r] - mean) * rstd * gn[h * 128 + e] * gv * sigm(gv)); }
        }
    }
    __syncthreads();
#undef RET_FETCH
}
constexpr int LK = 72, LV = 168;
__device__ __forceinline__ float scan64_sum(float x, int lane) {
#pragma unroll
    for (int o = 1; o < 64; o <<= 1) { const float y = __shfl_up(x, o); if (lane >= o) x += y; }
    return x; }
__device__ __forceinline__ float scan64_max(float x, int lane) {
#pragma unroll
    for (int o = 1; o < 64; o <<= 1) { const float y = __shfl_up(x, o); if (lane >= o) x = fmaxf(x, y); }
    return x; }
__device__ __forceinline__ void mlstm_unit(Frame& F, const float* nw, int b, int h) {
    LAS bf16* Qm = (LAS bf16*)(F.lds); LAS bf16* Km = Qm + 128 * LK; LAS bf16* Kw = Km + 128 * LK; LAS bf16* Vm = Kw + 128 * LK; LAS bf16* Pm = Vm + 128 * LV; LAS bf16* Cm = Pm + 128 * LQ;
    const int tid = F.tid, lane = F.lane, w = F.wave, i16 = lane & 15, g = lane >> 4;
    const int dt = w & 3, eh = w >> 2;
    f32x4 accC[5];
#pragma unroll
    for (int k = 0; k < 5; ++k) accC[k] = (f32x4){0.f, 0.f, 0.f, 0.f};
    for (int i = tid; i < 64 * LV / 8; i += NWAVES * 64) ((LAS v4u*)Cm)[i] = (v4u){0u, 0u, 0u, 0u};
    float m_prev = 0.f;
    const bf16* zb = WSP(bf16, WS_Z) + (size_t)(b * SEQ) * NZ;
    const float* gif = WSP(float, WS_GIF) + (size_t)(b * SEQ) * 16;
    bf16* yb = WSP(bf16, WS_Y) + (size_t)M * 1024 + (size_t)(b * SEQ) * 1024 + h * 128;
    const int lr = tid >> 2, dg = tid & 3;
    v4u pq[2], pk[2]; float fl0, fl1, il0, il1, prr;
    const float* rstd1 = WSP(float, WS_RSTD) + (size_t)(b * SEQ);
#define ML_FETCH(t0_) do { const bf16* zr_ = zb + (size_t)((t0_) + lr) * NZ; \
        pq[0] = *(const v4u*)(zr_ + Z_MQ + h * 64 + 16 * dg); pq[1] = *(const v4u*)(zr_ + Z_MQ + h * 64 + 16 * dg + 8); pk[0] = *(const v4u*)(zr_ + Z_MK + h * 64 + 16 * dg); pk[1] = *(const v4u*)(zr_ + Z_MK + h * 64 + 16 * dg + 8); \
        fl0 = gif[(size_t)((t0_) + lane) * 16 + 8 + h]; fl1 = gif[(size_t)((t0_) + 64 + lane) * 16 + 8 + h]; il0 = gif[(size_t)((t0_) + lane) * 16 + h]; il1 = gif[(size_t)((t0_) + 64 + lane) * 16 + h]; prr = rstd1[(t0_) + lr]; } while (0)
    ML_FETCH(0);
    for (int c = 0; c < SEQ / 128; ++c) {
        const int t0 = c * 128;
        const float a0 = scan64_sum(fl0, lane); const float a1 = scan64_sum(fl1, lane) + __shfl(a0, 63);
        const float b0 = il0 - a0, b1 = il1 - a1;
        const float pm0 = scan64_max(b0, lane); const float pm1 = fmaxf(scan64_max(b1, lane), __shfl(pm0, 63));
        const float a_last = __shfl(a1, 63), bmax = __shfl(pm1, 63);
        const float g_n = a_last + bmax, m_new = fmaxf(a_last + m_prev, g_n), s_old = __expf(a_last + m_prev - m_new), s_new = __expf(g_n - m_new);
        {
            const int r = lr;
            const float br = (r < 64) ? __shfl(b0, r & 63) : __shfl(b1, r & 63);
            const float rk = prr * 0.125f, wk = __expf(br - bmax) * rk * s_new;
#pragma unroll
            for (int hh = 0; hh < 2; ++hh) {
                *(LAS v4u*)(Qm + r * LK + 16 * dg + 8 * hh) = pq[hh];
                const v4u kk = pk[hh];
                float kf[8] = {bflo(kk.x), bfhi(kk.x), bflo(kk.y), bfhi(kk.y), bflo(kk.z), bfhi(kk.z), bflo(kk.w), bfhi(kk.w)};
                *(LAS v4u*)(Km + r * LK + 16 * dg + 8 * hh) = (v4u){pk2(kf[0] * rk, kf[1] * rk), pk2(kf[2] * rk, kf[3] * rk), pk2(kf[4] * rk, kf[5] * rk), pk2(kf[6] * rk, kf[7] * rk)};
                *(LAS v4u*)(Kw + r * LK + 16 * dg + 8 * hh) = (v4u){pk2(kf[0] * wk, kf[1] * wk), pk2(kf[2] * wk, kf[3] * wk), pk2(kf[4] * wk, kf[5] * wk), pk2(kf[6] * wk, kf[7] * wk)};
            }
#pragma unroll
            for (int q = 0; q < 4; ++q) { const v4u x = *(const v4u*)(zb + (size_t)(t0 + r) * NZ + Z_MV + h * 128 + 32 * dg + 8 * q); const float rv = prr;
                *(LAS v4u*)(Vm + r * LV + 32 * dg + 8 * q) = (v4u){pk2(bflo(x.x) * rv, bfhi(x.x) * rv), pk2(bflo(x.y) * rv, bfhi(x.y) * rv), pk2(bflo(x.z) * rv, bfhi(x.z) * rv), pk2(bflo(x.w) * rv, bfhi(x.w) * rv)}; }
            *(LAS v4u*)(Vm + r * LV + 128 + 8 * dg) = (v4u){dg == 0 ? 0x00003f80u : 0u, 0u, 0u, 0u};
            if (c + 1 < SEQ / 128) ML_FETCH(t0 + 128);
        }
        __syncthreads();
        float Mi[4], ai[4], rri[4];
#pragma unroll
        for (int r = 0; r < 4; ++r) { const int i = 16 * w + 4 * g + r; rri[r] = rstd1[t0 + i]; const float pmi = (w < 4) ? __shfl(pm0, i & 63) : __shfl(pm1, i & 63); ai[r] = (w < 4) ? __shfl(a0, i & 63) : __shfl(a1, i & 63); Mi[r] = fmaxf(pmi, m_prev); }
        bf16x8 aq[2];
#pragma unroll
        for (int s = 0; s < 2; ++s) aq[s] = frag_row(Qm, LK, 16 * w, 32 * s, lane);
        f32x4 acco[9];
#pragma unroll
        for (int n = 0; n < 9; ++n) acco[n] = (f32x4){0.f, 0.f, 0.f, 0.f};
#pragma unroll
        for (int s = 0; s < 2; ++s) {
#pragma unroll
          for (int hf = 0; hf < 2; ++hf) { bf16x8 bb[5];
#pragma unroll
            for (int n = 0; n < 5 - hf; ++n) bb[n] = frag_tr(Cm, LV, 32 * s, 16 * (5 * hf + n), lane);
            SCHED_FENCE();
#pragma unroll
            for (int n = 0; n < 5 - hf; ++n) acco[5 * hf + n] = MFMA16(aq[s], bb[n], acco[5 * hf + n]); } }
        { float si[4];
#pragma unroll
          for (int r = 0; r < 4; ++r) si[r] = __expf(m_prev - Mi[r]) * rri[r];
#pragma unroll
          for (int n = 0; n < 9; ++n)
#pragma unroll
            for (int r = 0; r < 4; ++r) acco[n][r] *= si[r]; }
        LDS_FENCE();
#pragma unroll
        for (int n = 0; n < 8; ++n) {
            if (n <= w) { f32x4 sa = (f32x4){0.f, 0.f, 0.f, 0.f}; bf16x8 bb[2];
#pragma unroll
                for (int s = 0; s < 2; ++s) bb[s] = frag_row(Km, LK, 16 * n, 32 * s, lane);
                SCHED_FENCE();
#pragma unroll
                for (int s = 0; s < 2; ++s) sa = MFMA16(aq[s], bb[s], sa);
                const int j = 16 * n + i16; const float bj = (n < 4) ? __shfl(b0, j & 63) : __shfl(b1, j & 63);
#pragma unroll
                for (int r = 0; r < 4; ++r) { const int i = 16 * w + 4 * g + r; Pm[i * LQ + j] = (bf16)f2bf(j <= i ? sa[r] * rri[r] * __expf(bj - Mi[r]) : 0.f); } }
            else if (n == w + 1) {
#pragma unroll
                for (int r = 0; r < 4; ++r) Pm[(16 * w + 4 * g + r) * LQ + 16 * n + i16] = (bf16)0; }
        }
        LDS_FENCE();
#pragma unroll
        for (int s = 0; s < 4; ++s) if (s <= (w >> 1)) { const bf16x8 ap = frag_row(Pm, LQ, 16 * w, 32 * s, lane);
#pragma unroll
          for (int hf = 0; hf < 2; ++hf) { bf16x8 bb[5];
#pragma unroll
            for (int n = 0; n < 5 - hf; ++n) bb[n] = frag_tr(Vm, LV, 32 * s, 16 * (5 * hf + n), lane);
            SCHED_FENCE();
#pragma unroll
            for (int n = 0; n < 5 - hf; ++n) acco[5 * hf + n] = MFMA16(ap, bb[n], acco[5 * hf + n]); } }
#pragma unroll
        for (int k = 0; k < 5; ++k) accC[k] = accC[k] * s_old;
#pragma unroll
        for (int s = 0; s < 4; ++s) { const bf16x8 ak = frag_tr(Kw, LK, 32 * s, 16 * dt, lane); bf16x8 bb[5];
#pragma unroll
            for (int k = 0; k < 5; ++k) bb[k] = frag_tr(Vm, LV, 32 * s, 16 * (5 * eh + k), lane);
            SCHED_FENCE();
#pragma unroll
            for (int k = 0; k < 5; ++k) accC[k] = MFMA16(ak, bb[k], accC[k]); }
        LDS_FENCE();
        __syncthreads();
#pragma unroll
        for (int k = 0; k < 5; ++k)
#pragma unroll
            for (int r = 0; r < 4; ++r) Cm[(16 * dt + 4 * g + r) * LV + 16 * (5 * eh + k) + i16] = (bf16)f2bf(accC[k][r]);
#pragma unroll
        for (int r = 0; r < 4; ++r) {
            const float den = __shfl(acco[8][r], lane & 48);
            const float dd = 1.0f / fmaxf(fabsf(den), __expf(-(ai[r] + Mi[r])));
            float q = 0.f;
#pragma unroll
            for (int n = 0; n < 8; ++n) { acco[n][r] *= dd; q += acco[n][r] * acco[n][r]; }
            const float rstd = rsqrtf(red16_sum(q) * (1.f / 128.f) + 1e-6f);
            const int pos = t0 + 16 * w + 4 * g + r; const bf16* gr = zb + (size_t)pos * NZ + Z_MO + h * 128; bf16* yr = yb + (size_t)pos * 1024;
#pragma unroll
            for (int n = 0; n < 8; ++n) { const int e = 16 * n + i16; yr[e] = (bf16)f2bf(acco[n][r] * rstd * nw[h * 128 + e] * sigm(bf1(gr[e]) * rri[r])); }
        }
        m_prev = m_new;
    }
    __syncthreads();
#undef ML_FETCH
}
template <int CTRL> __device__ __forceinline__ float dppf(float v) { return __builtin_bit_cast(float, __builtin_amdgcn_update_dpp(0, __builtin_bit_cast(int, v), CTRL, 0xf, 0xf, true)); }
__device__ __forceinline__ float r16max(float v) { v = fmaxf(v, dppf<0xB1>(v)); v = fmaxf(v, dppf<0x4E>(v)); v = fmaxf(v, dppf<0x141>(v)); v = fmaxf(v, dppf<0x140>(v)); return v; }
__device__ __forceinline__ float r16sum(float v) { v += dppf<0xB1>(v); v += dppf<0x4E>(v); v += dppf<0x141>(v); v += dppf<0x140>(v); return v; }
__device__ __forceinline__ void moba_unit(Frame& F, int b, int h, int qi) {
    LAS bf16* Kt = (LAS bf16*)(F.lds); LAS bf16* Vt = Kt + 128 * LQ; LAS bf16* Pm = Vt + 128 * LQ;
    const int tid = F.tid, lane = F.lane, w = tid >> 6, i16 = lane & 15, g = lane >> 4;
    const int blk = qi >> 1, qt = qi & 1, q0 = qi * 128;
    const bf16* zb = WSP(bf16, WS_Z) + (size_t)(b * SEQ) * NZ + h * 128;
    bf16x8 aq[4];
    { const bf16* qr = zb + (size_t)(q0 + 16 * w + i16) * NZ + Z_AQ + 8 * g;
#pragma unroll
      for (int s = 0; s < 4; ++s) aq[s] = *(const bf16x8*)(qr + 32 * s); }
    unsigned sel = 0u;
    {
        float gate[8];
        const float* km = WSP(float, WS_KMEAN) + (size_t)((b * NH + h) * 16) * 128 + 8 * g;
#pragma unroll
        for (int n = 0; n < 8; ++n) { gate[n] = -INFINITY;
            if (n < blk) { float p = 0.f;
#pragma unroll
                for (int s = 0; s < 4; ++s) { const f32x4 k0 = *(const f32x4*)(km + n * 256 + 32 * s) + *(const f32x4*)(km + n * 256 + 128 + 32 * s), k1 = *(const f32x4*)(km + n * 256 + 32 * s + 4) + *(const f32x4*)(km + n * 256 + 128 + 32 * s + 4);
                    p += bf1((bf16)aq[s][0]) * k0.x + bf1((bf16)aq[s][1]) * k0.y + bf1((bf16)aq[s][2]) * k0.z + bf1((bf16)aq[s][3]) * k0.w
                       + bf1((bf16)aq[s][4]) * k1.x + bf1((bf16)aq[s][5]) * k1.y + bf1((bf16)aq[s][6]) * k1.z + bf1((bf16)aq[s][7]) * k1.w; }
                p += __shfl_xor(p, 16); p += __shfl_xor(p, 32); gate[n] = p; } }
#pragma unroll
        for (int s = 0; s < 3; ++s) { float bv = -INFINITY; int best = -1;
#pragma unroll
            for (int n = 0; n < 8; ++n) { const bool c = !((sel >> n) & 1u) && gate[n] > bv; bv = c ? gate[n] : bv; best = c ? n : best; }
            if (best >= 0) sel |= 1u << best; }
    }
    unsigned rsel[4];
#pragma unroll
    for (int r = 0; r < 4; ++r) rsel[r] = (unsigned)__shfl((int)sel, 4 * g + r);
#pragma unroll
    for (int s = 0; s < 4; ++s) { const v4u u = __builtin_bit_cast(v4u, aq[s]); const float c2 = 0.08838834764831845f * 1.4426950408889634f;
        const v4u o = (v4u){pk2(bflo(u.x) * c2, bfhi(u.x) * c2), pk2(bflo(u.y) * c2, bfhi(u.y) * c2), pk2(bflo(u.z) * c2, bfhi(u.z) * c2), pk2(bflo(u.w) * c2, bfhi(u.w) * c2)}; aq[s] = __builtin_bit_cast(bf16x8, o); }
    f32x4 acco[8];
#pragma unroll
    for (int n = 0; n < 8; ++n) acco[n] = (f32x4){0.f, 0.f, 0.f, 0.f};
    float mrow[4], lrow[4];
#pragma unroll
    for (int r = 0; r < 4; ++r) { mrow[r] = -1e30f; lrow[r] = 0.f; }
    const int ntiles = 2 * blk + qt + 1;
    const int lr = tid >> 2, dg = tid & 3, vrow = 8 * (lr & 15) + (lr >> 4);
    v4u pk[4], pv[4];
#define MB_FETCH(k0_) do { const bf16* zr_ = zb + (size_t)((k0_) + lr) * NZ + 32 * dg; \
        _Pragma("unroll") for (int q_ = 0; q_ < 4; ++q_) { pk[q_] = *(const v4u*)(zr_ + Z_AK + 8 * q_); pv[q_] = *(const v4u*)(zr_ + Z_AV + 8 * q_); } } while (0)
    MB_FETCH(0);
    for (int kt = 0; kt < ntiles; ++kt) {
        const int k0 = kt * 128, kb = kt >> 1; const bool own = (kb == blk), diag = (kt == 2 * blk + qt);
        __syncthreads();
#pragma unroll
        for (int q = 0; q < 4; ++q) { *(LAS v4u*)(Kt + lr * LQ + 32 * dg + 8 * q) = pk[q]; *(LAS v4u*)(Vt + vrow * LQ + 32 * dg + 8 * q) = pv[q]; }
        if (kt + 1 < ntiles) MB_FETCH(k0 + 128);
        __syncthreads();
        f32x4 sc[8];
#pragma unroll
        for (int n = 0; n < 8; ++n) sc[n] = (f32x4){0.f, 0.f, 0.f, 0.f};
#pragma unroll
        for (int s = 0; s < 4; ++s) { bf16x8 bb[8];
#pragma unroll
            for (int n = 0; n < 8; ++n) bb[n] = frag_row(Kt, LQ, 16 * n, 32 * s, lane);
            SCHED_FENCE();
#pragma unroll
            for (int n = 0; n < 8; ++n) sc[n] = MFMA16(aq[s], bb[n], sc[n]); }
#pragma unroll
        for (int r = 0; r < 4; ++r) {
            if (diag) { const int qrel = 16 * w + 4 * g + r - i16;
#pragma unroll
                for (int n = 0; n < 8; ++n) sc[n][r] = (16 * n <= qrel) ? sc[n][r] : -1e30f; }
            const bool rowok = own || ((rsel[r] >> kb) & 1u);
            float mx = fmaxf(fmaxf(fmaxf(sc[0][r], sc[1][r]), fmaxf(sc[2][r], sc[3][r])), fmaxf(fmaxf(sc[4][r], sc[5][r]), fmaxf(sc[6][r], sc[7][r])));
            mx = r16max(mx);
            const float mnew = rowok ? fmaxf(mrow[r], mx) : mrow[r];
            const float alpha = __builtin_amdgcn_exp2f(mrow[r] - mnew); mrow[r] = mnew;
            const float msub = rowok ? mnew : 1e30f;
            float p[8], ps = 0.f;
#pragma unroll
            for (int n = 0; n < 8; ++n) { p[n] = __builtin_amdgcn_exp2f(sc[n][r] - msub); ps += p[n]; }
            lrow[r] = lrow[r] * alpha + ps;
            *(LAS v4u*)(Pm + (16 * w + 4 * g + r) * LQ + 8 * i16) = (v4u){pk2(p[0], p[1]), pk2(p[2], p[3]), pk2(p[4], p[5]), pk2(p[6], p[7])};
#pragma unroll
            for (int n = 0; n < 8; ++n) acco[n][r] *= alpha;
        }
        LDS_FENCE();
#pragma unroll
        for (int s = 0; s < 4; ++s) { const bf16x8 ap = frag_row(Pm, LQ, 16 * w, 32 * s, lane); bf16x8 bb[8];
#pragma unroll
            for (int n = 0; n < 8; ++n) bb[n] = frag_tr(Vt, LQ, 32 * s, 16 * n, lane);
            SCHED_FENCE();
#pragma unroll
            for (int n = 0; n < 8; ++n) acco[n] = MFMA16(ap, bb[n], acco[n]); }
        LDS_FENCE();
    }
    bf16* yb = WSP(bf16, WS_Y) + (size_t)2 * M * 1024 + (size_t)(b * SEQ + q0) * 1024 + h * 128;
#pragma unroll
    for (int r = 0; r < 4; ++r) { const float inv = 1.0f / r16sum(lrow[r]); bf16* yr = yb + (size_t)(16 * w + 4 * g + r) * 1024;
#pragma unroll
        for (int n = 0; n < 8; ++n) yr[16 * n + i16] = (bf16)f2bf(acco[n][r] * inv); }
#undef MB_FETCH
}
__device__ __forceinline__ void mix_phase(Frame& F, const float* rgn, const float* mln, unsigned* head) {
    volatile LAS unsigned* slot = F.MISC;
    for (;;) {
        if (F.tid == 0) slot[0] = __hip_atomic_fetch_add(head, 1u, __ATOMIC_RELAXED, __HIP_MEMORY_SCOPE_AGENT);
        __syncthreads();
        const unsigned it = slot[0];
        __syncthreads();
        if (it >= 128u + 1024u) break;
        { int t_ = threadIdx.x; asm volatile("" : "+v"(t_)); F.tid = t_; F.lane = t_ & 63; }
        if (it < 64u) ret_unit(F, rgn, (int)(it >> 3), (int)(it & 7u));
        else if (it < 128u) mlstm_unit(F, mln, (int)((it - 64u) >> 3), (int)(it & 7u));
        else { const unsigned rank = it - 128u; moba_unit(F, (int)((rank & 63u) >> 3), (int)(rank & 7u), 15 - (int)(rank >> 6)); }
    }
}
}
constexpr int N_PHASES = 1 + 8 * DEPTH;
__global__ void __launch_bounds__(NWAVES * 64, 2) fwd(Args args) {
    extern __shared__ __attribute__((aligned(16))) unsigned char lds[];
    Frame F;
    F.lds = (LAS unsigned char*)lds;
    F.MISC = (volatile LAS unsigned*)(F.lds + MISC_OFF);
    F.tid = threadIdx.x; F.lane = F.tid & 63; F.wave = __builtin_amdgcn_readfirstlane(F.tid >> 6); F.G = gridDim.x; F.bx = blockIdx.x;
    F.ws = args.ws;
    for (int u = F.tid; u < (LDS_BYTES - LDSCTL_OFF) / 4; u += NWAVES * 64) ((LAS unsigned*)(F.lds + LDSCTL_OFF))[u] = 0u;
    __syncthreads();
    XcdBarrier bar = xcd_barrier_post((unsigned*)(F.ws + WS_CTL) + CW_BAR + args.li * XCD_BAR_WORDS, F.MISC + 8);
    const int lo = args.ph_lo, hi = args.ph_hi;
#define RUN(p) (lo <= (p) && (p) < hi)
#define SEAM(p) do { if ((p) + 1 < hi) xcd_barrier(bar); } while (0)
    if (RUN(0)) { p0_prologue(F, args); SEAM(0); }
    for (int l = 0; l < DEPTH; ++l) {
        const int p0 = 1 + 8 * l;
        { int t_ = threadIdx.x; asm volatile("" : "+v"(t_)); F.tid = t_; F.lane = t_ & 63; F.wave = __builtin_amdgcn_readfirstlane(t_ >> 6); int b_ = blockIdx.x; asm volatile("" : "+s"(b_)); F.bx = b_; }
        float* rs = WSP(float, WS_RS) + (size_t)(2 * l) * M * 32;
        if (RUN(p0 + 0)) {
            pg8::Gemm g{WSP(bf16, WS_XB), WSP(bf16, WS_WIN) + (size_t)l * NZ * DM, M, NZ, DM}; pg8::StaticOrder S; S.init(M, NZ, F.G, F.bx);
            pg8::EpiBf16 E{WSP(bf16, WS_Z), NZ};
            pg8::gemm_phase<pg8::EpiBf16, pg8::StaticOrder, true, true>(F.lds + RING_OFF, g, S, E);
            SEAM(p0 + 0); }
        if (RUN(p0 + 1)) { prep_phase(F, args.in[I_QN] + l * 128, args.in[I_KN] + l * 128, WSP(bf16, WS_W16G) + (size_t)l * 16 * DM, rs, args.in[I_BIG] + l * 8, args.in[I_BFG] + l * 8); SEAM(p0 + 1); }
        if (RUN(p0 + 2)) { mx::mix_phase(F, args.in[I_RGN] + l * 1024, args.in[I_MLN] + l * 1024, (unsigned*)(F.ws + WS_CTL) + CW_QUEUE + 64 * l); SEAM(p0 + 2); }
        if (RUN(p0 + 3)) {
            pg8::StaticOrder3 S; S.init(M, DM, F.G, F.bx);
            pg8::Gemm g{WSP(bf16, WS_Y), WSP(bf16, WS_WP) + (size_t)l * 3 * DM * 1024, M, DM, 1024, (size_t)M * 1024, (size_t)DM * 1024}; pg8::EpiGateAcc E{WSP(bf16, WS_MG), DM, WSP(bf16, WS_Z) + Z_GA, NZ, WSP(float, WS_RSTD)};
            pg8::gemm_phase<pg8::EpiGateAcc, pg8::StaticOrder3, true, true>(F.lds + RING_OFF, g, S, E);
            SEAM(p0 + 3); }
        if (RUN(p0 + 4)) {
            pg8::Gemm g{WSP(bf16, WS_MG), WSP(bf16, WS_WOUT) + (size_t)l * DM * DM, M, DM, DM}; pg8::StaticOrder S; S.init(M, DM, F.G, F.bx);
            pg8::EpiRes<false> E{WSP(bf16, WS_XB), rs + (size_t)32 * M, nullptr, DM};
            pg8::gemm_phase<pg8::EpiRes<false>, pg8::StaticOrder, true, true>(F.lds + RING_OFF, g, S, E);
            SEAM(p0 + 4); }
        if (RUN(p0 + 5)) {
            pg8::Gemm g{WSP(bf16, WS_XB), WSP(bf16, WS_WUP) + (size_t)l * NUP * DM, M, NUP, DM}; pg8::StaticOrder S; S.init(M, NUP, F.G, F.bx);
            pg8::EpiBf16 E{WSP(bf16, WS_Z), NUP};
            pg8::gemm_phase<pg8::EpiBf16, pg8::StaticOrder, true, true>(F.lds + RING_OFF, g, S, E);
            SEAM(p0 + 5); }
        if (RUN(p0 + 6)) { glu_phase(F, args.in[I_CW] + (size_t)l * 3 * NUP, args.in[I_CB] + (size_t)l * NUP, rs + (size_t)32 * M); SEAM(p0 + 6); }
        if (RUN(p0 + 7)) {
            pg8::Gemm g{WSP(bf16, WS_ACT), WSP(bf16, WS_WDN) + (size_t)l * DM * DFF, M, DM, DFF}; pg8::StaticOrder S; S.init(M, DM, F.G, F.bx);
            if (l + 1 < DEPTH) { pg8::EpiRes<false> E{WSP(bf16, WS_XB), rs + (size_t)64 * M, nullptr, DM};
                pg8::gemm_phase<pg8::EpiRes<false>, pg8::StaticOrder, true, true>(F.lds + RING_OFF, g, S, E); }
            else { pg8::EpiRes<true> E{WSP(bf16, WS_XB), nullptr, args.out, DM};
                pg8::gemm_phase<pg8::EpiRes<true>, pg8::StaticOrder, true, true>(F.lds + RING_OFF, g, S, E); }
            SEAM(p0 + 7); }
    }
#undef RUN
#undef SEAM
}

#ifndef MK_N_LAUNCHES
#define MK_N_LAUNCHES 1
#endif
extern "C" void kernel_launch(void* const* d_in, const int* in_sizes, int n_in, void* d_out, int out_size, void* d_ws, size_t ws_size, hipStream_t stream) {
    static int grid = 0;
    if (grid == 0) {
        if (n_in != 18 || in_sizes[0] != M * DM || out_size != M * DM || ws_size < WS_END) { fprintf(stderr, "kernel_launch: unexpected shapes (n_in %d, in0 %d, out %d, ws %zu)\n", n_in, n_in > 0 ? in_sizes[0] : -1, out_size, ws_size); grid = -1; return; }
        int dev = 0, cus = 0, per_cu = 0;
        if (hipGetDevice(&dev) != hipSuccess || hipDeviceGetAttribute(&cus, hipDeviceAttributeMultiprocessorCount, dev) != hipSuccess) { grid = -1; return; }
        if (hipFuncSetAttribute((const void*)fwd, hipFuncAttributeMaxDynamicSharedMemorySize, LDS_BYTES) != hipSuccess) { fprintf(stderr, "kernel_launch: hipFuncSetAttribute failed\n"); grid = -1; return; }
        if (hipOccupancyMaxActiveBlocksPerMultiprocessor(&per_cu, (const void*)fwd, NWAVES * 64, LDS_BYTES) != hipSuccess || per_cu < 1) fprintf(stderr, "kernel_launch: occupancy query reports %d\n", per_cu);
        (void)hipGetLastError();
        grid = cus;
    }
    if (grid < 0) return;
    if (hipMemsetAsync((char*)d_ws + WS_CTL, 0, CTL_ZERO_BYTES, stream) != hipSuccess) return;
    Args a{};
    for (int i = 0; i < 18; ++i) a.in[i] = (const float*)d_in[i];
    a.out = (float*)d_out; a.ws = (unsigned char*)d_ws; a.pad = 0;
    constexpr int NL = MK_N_LAUNCHES;
    for (int li = 0; li < NL; ++li) {
        a.ph_lo = (NL == 1) ? 0 : li; a.ph_hi = (NL == 1) ? N_PHASES : li + 1; a.li = (NL == 1) ? 0 : 0;
        hipLaunchKernelGGL(fwd, dim3(grid), dim3(NWAVES * 64), LDS_BYTES, stream, a);
    }
}
```

```cpp
#include <hip/hip_runtime.h>
#include <cstdio>
#include <cstdint>
namespace pg8 {
#define PG8_LAS __attribute__((address_space(3)))
typedef unsigned short bf16_t;
typedef short bf16x8 __attribute__((ext_vector_type(8)));
typedef float f32x4 __attribute__((ext_vector_type(4)));
typedef unsigned u32x4 __attribute__((ext_vector_type(4)));
constexpr int BM = 256, BK = 64, HALF = 128, HTB = HALF * BK * 2  , STAGE_BYTES = 8 * HTB, NXCD = 8, WGM = 8;

__host__ __device__ __forceinline__ int lds_byte(int r, int c) { const int st = (r >> 4) * 2 + (c >> 5), rr = r & 15, cc = c & 31, ob = rr * 64 + cc * 2; return st * 1024 + (ob ^ (((ob >> 9) & 1) << 5)); }
__host__ __device__ __forceinline__ void stage_rc(int b, int& R, int& C) { const int st = b / 1024, sb = b % 1024, swz = sb ^ (((sb >> 9) & 1) << 5); R = (st >> 1) * 16 + swz / 64; C = (st & 1) * 32 + (swz % 64) / 2; }
__host__ __device__ __forceinline__ int perm32(int rho) { const int n = rho >> 4, i = rho & 15; return 8 * (i >> 2) + 4 * n + (i & 3); }

struct Unit { int pm, pn, z; };
struct Gemm { const bf16_t* A; const bf16_t* Bt; int M, N, K; size_t zA, zB; };

struct StaticOrder {
    int nM, nN, nwg, G, c;
    __host__ __device__ void init(int M, int N, int G_, int c_) { nM = M / BM; nN = N / BM; nwg = nM * nN; G = G_; c = c_; }
    __host__ __device__ bool next(int i, Unit& u) const {
        const long L = (long)i * G + c; if (L >= nwg) return false;
        int wgid = (int)L; { const int q = nwg / NXCD, r = nwg % NXCD, xcd = wgid % NXCD, off = wgid / NXCD; wgid = (xcd < r ? xcd * (q + 1) : r * (q + 1) + (xcd - r) * q) + off; }
        const int nig = WGM * nN, gid = wgid / nig, fm = gid * WGM, gsz = (nM - fm) < WGM ? (nM - fm) : WGM;
        u.pm = fm + ((wgid % nig) % gsz); u.pn = (wgid % nig) / gsz; u.z = 0; return true;
    }
    __device__ __forceinline__ void a_ready(const Unit&) const {}
    __device__ __forceinline__ void done(const Unit&) const {}
};

struct StaticOrder3 : StaticOrder {
    __host__ __device__ bool next(int i, Unit& u) const { if (!StaticOrder::next(i / 3, u)) return false; u.z = i % 3; return true; }
};
__device__ __forceinline__ unsigned cvt_pk_bf16(float lo, float hi) { unsigned r; asm volatile("v_cvt_pk_bf16_f32 %0, %1, %2" : "=v"(r) : "v"(lo), "v"(hi)); return r; }
typedef unsigned u32x2 __attribute__((ext_vector_type(2)));
struct EpiBf16 {
    static constexpr bool PERM = true, AFTER_DRAIN = false, KEEP = false;
    bf16_t* O; int ldc; unsigned char* G8; int g8_pn0, g8_ld;
    __device__ __forceinline__ void operator()(const f32x4 (&acc)[2][2][4][2], const Unit& u, int wr, int wc, int fr, int fq) const {
        const int row0 = u.pm * BM + wr * 64 + fr; const int col0 = u.pn * BM + wc * 32 + 8 * fq;
        if (g8_pn0 >= 0 && u.pn >= g8_pn0) { const int gc0 = (u.pn - g8_pn0) * BM + wc * 32 + 8 * fq;
#pragma unroll
            for (int ai = 0; ai < 2; ++ai)
#pragma unroll
                for (int m = 0; m < 4; ++m) { unsigned char* rowp = G8 + (size_t)(row0 + ai * HALF + m * 16) * g8_ld + gc0;
#pragma unroll
                    for (int bj = 0; bj < 2; ++bj) { const f32x4 v0 = acc[ai][bj][m][0], v1 = acc[ai][bj][m][1]; u32x2 w;
                        w.x = (unsigned)__builtin_amdgcn_cvt_pk_fp8_f32(v0[2], v0[3], __builtin_amdgcn_cvt_pk_fp8_f32(v0[0], v0[1], 0, false), true);
                        w.y = (unsigned)__builtin_amdgcn_cvt_pk_fp8_f32(v1[2], v1[3], __builtin_amdgcn_cvt_pk_fp8_f32(v1[0], v1[1], 0, false), true);
                        *(u32x2*)(rowp + bj * HALF) = w; } }
            return; }
#pragma unroll
        for (int ai = 0; ai < 2; ++ai)
#pragma unroll
            for (int m = 0; m < 4; ++m) { bf16_t* rowp = O + (size_t)(row0 + ai * HALF + m * 16) * ldc + col0;
#pragma unroll
                for (int bj = 0; bj < 2; ++bj) { const f32x4 v0 = acc[ai][bj][m][0], v1 = acc[ai][bj][m][1];
                    u32x4 w; w.x = cvt_pk_bf16(v0[0], v0[1]); w.y = cvt_pk_bf16(v0[2], v0[3]); w.z = cvt_pk_bf16(v1[0], v1[1]); w.w = cvt_pk_bf16(v1[2], v1[3]);
                    *(u32x4*)(rowp + bj * HALF) = w; } }
    }
};
__device__ __forceinline__ float bf_lo(unsigned w) { return __uint_as_float(w << 16); }
__device__ __forceinline__ float bf_hi(unsigned w) { return __uint_as_float(w & 0xffff0000u); }
__device__ __forceinline__ float sigmoid_f(float x) { return __builtin_amdgcn_rcpf(1.0f + __expf(-x)); }
struct EpiGateAcc {
    static constexpr bool PERM = true, AFTER_DRAIN = false, KEEP = true;
    bf16_t* O; int ldc; const unsigned char* G8; int g8_ld; const float* rstd;
    template <int E> static __device__ __forceinline__ float g8f(const u32x2 w) { return __builtin_amdgcn_cvt_f32_fp8((int)(E < 4 ? w.x : w.y), E & 3); }
    static __device__ __forceinline__ float em(float g, float rr) { return __expf(-fminf(fmaxf(g * rr, -40.f), 40.f)); }
    __device__ __forceinline__ void operator()(f32x4 (&acc)[2][2][4][2], const Unit& u, int wr, int wc, int fr, int fq) const {
        const int row0 = u.pm * BM + wr * 64 + fr; const int col0 = u.pn * BM + wc * 32 + 8 * fq; const bool last = (u.z == 2);
        const unsigned char* Gn = G8 + (size_t)u.z * ldc; const unsigned char* Gd = G8 + (size_t)(last ? u.z : u.z + 1) * ldc;
#pragma unroll
        for (int ai = 0; ai < 2; ++ai)
#pragma unroll
            for (int m = 0; m < 4; ++m) { const size_t row = (size_t)(row0 + ai * HALF + m * 16); const float rr = rstd[row];
#pragma unroll
                for (int bj = 0; bj < 2; ++bj) { f32x4& v0 = acc[ai][bj][m][0]; f32x4& v1 = acc[ai][bj][m][1];
                    const u32x2 gn = *(const u32x2*)(Gn + row * g8_ld + col0 + bj * HALF);
                    const float n0 = em(g8f<0>(gn), rr), n1 = em(g8f<1>(gn), rr), n2 = em(g8f<2>(gn), rr), n3 = em(g8f<3>(gn), rr), n4 = em(g8f<4>(gn), rr), n5 = em(g8f<5>(gn), rr), n6 = em(g8f<6>(gn), rr), n7 = em(g8f<7>(gn), rr);
                    if (!last) { const u32x2 gd = *(const u32x2*)(Gd + row * g8_ld + col0 + bj * HALF);
                        v0[0] *= (1.0f + em(g8f<0>(gd), rr)) * __builtin_amdgcn_rcpf(1.0f + n0); v0[1] *= (1.0f + em(g8f<1>(gd), rr)) * __builtin_amdgcn_rcpf(1.0f + n1);
                        v0[2] *= (1.0f + em(g8f<2>(gd), rr)) * __builtin_amdgcn_rcpf(1.0f + n2); v0[3] *= (1.0f + em(g8f<3>(gd), rr)) * __builtin_amdgcn_rcpf(1.0f + n3);
                        v1[0] *= (1.0f + em(g8f<4>(gd), rr)) * __builtin_amdgcn_rcpf(1.0f + n4); v1[1] *= (1.0f + em(g8f<5>(gd), rr)) * __builtin_amdgcn_rcpf(1.0f + n5);
                        v1[2] *= (1.0f + em(g8f<6>(gd), rr)) * __builtin_amdgcn_rcpf(1.0f + n6); v1[3] *= (1.0f + em(g8f<7>(gd), rr)) * __builtin_amdgcn_rcpf(1.0f + n7); }
                    else { u32x4 w;
                        w.x = cvt_pk_bf16(v0[0] * __builtin_amdgcn_rcpf(1.0f + n0), v0[1] * __builtin_amdgcn_rcpf(1.0f + n1)); w.y = cvt_pk_bf16(v0[2] * __builtin_amdgcn_rcpf(1.0f + n2), v0[3] * __builtin_amdgcn_rcpf(1.0f + n3));
                        w.z = cvt_pk_bf16(v1[0] * __builtin_amdgcn_rcpf(1.0f + n4), v1[1] * __builtin_amdgcn_rcpf(1.0f + n5)); w.w = cvt_pk_bf16(v1[2] * __builtin_amdgcn_rcpf(1.0f + n6), v1[3] * __builtin_amdgcn_rcpf(1.0f + n7));
                        *(u32x4*)(O + row * ldc + col0 + bj * HALF) = w; } } }
    }
};
template <bool LAST> struct EpiRes {
    static constexpr bool PERM = true, AFTER_DRAIN = false, KEEP = false;
    bf16_t* xb; float* rs; float* out; int ldc;
    __device__ __forceinline__ void operator()(const f32x4 (&acc)[2][2][4][2], const Unit& u, int wr, int wc, int fr, int fq) const {
        const int row0 = u.pm * BM + wr * 64 + fr; const int col0 = u.pn * BM + wc * 32 + 8 * fq;
#pragma unroll
        for (int ai = 0; ai < 2; ++ai)
#pragma unroll
            for (int m = 0; m < 4; ++m) { const int row = row0 + ai * HALF + m * 16; const size_t off = (size_t)row * ldc + col0; float sq = 0.f;
#pragma unroll
                for (int bj = 0; bj < 2; ++bj) { const u32x4 p = *(const u32x4*)(xb + off + bj * HALF); const f32x4 v0 = acc[ai][bj][m][0], v1 = acc[ai][bj][m][1];
                    const float o0 = bf_lo(p.x) + v0[0], o1 = bf_hi(p.x) + v0[1], o2 = bf_lo(p.y) + v0[2], o3 = bf_hi(p.y) + v0[3], o4 = bf_lo(p.z) + v1[0], o5 = bf_hi(p.z) + v1[1], o6 = bf_lo(p.w) + v1[2], o7 = bf_hi(p.w) + v1[3];
                    if (LAST) { *(f32x4*)(out + off + bj * HALF) = (f32x4){o0, o1, o2, o3}; *(f32x4*)(out + off + bj * HALF + 4) = (f32x4){o4, o5, o6, o7}; }
                    else { sq += ((o0 * o0 + o1 * o1) + (o2 * o2 + o3 * o3)) + ((o4 * o4 + o5 * o5) + (o6 * o6 + o7 * o7));
                        u32x4 w; w.x = cvt_pk_bf16(o0, o1); w.y = cvt_pk_bf16(o2, o3); w.z = cvt_pk_bf16(o4, o5); w.w = cvt_pk_bf16(o6, o7); *(u32x4*)(xb + off + bj * HALF) = w; } }
                if (!LAST) { sq += __shfl_xor(sq, 16); sq += __shfl_xor(sq, 32); if (fq == 0) rs[(size_t)row * 32 + u.pn * 4 + wc] = sq; } }
    }
};

template <class Epi, class Sched, bool ALIGN_EPI = false, bool SP2 = false>
__device__ __forceinline__ void gemm_phase(PG8_LAS unsigned char* lds, const Gemm g, const Sched& S, const Epi& E) {
    int tid_ = threadIdx.x; asm volatile("" : "+v"(tid_));
    const int tid = tid_, wid = __builtin_amdgcn_readfirstlane(tid >> 6), lane = tid & 63, wr = wid >> 2, wc = wid & 3, fr = lane & 15, fq = lane >> 4;
    const int K = g.K, nt = K / BK;
    unsigned voffA[2], voffB[2];
#pragma unroll
    for (int i = 0; i < 2; ++i) { int R, C; stage_rc(tid * 16 + i * 8192, R, C); const int Rb = Epi::PERM ? ((R & ~31) + perm32(R & 31)) : R;
        voffA[i] = (unsigned)(R * K + C) * 2u; voffB[i] = (unsigned)(Rb * K + C) * 2u; }
    const size_t kstep = (size_t)(BK * 2);
    const size_t hstep = (size_t)HALF * K * 2;
    const size_t tstep = 2 * hstep;
    const unsigned ldsw = (unsigned)wid * 1024u;
    const int aoff = lds_byte(wr * 64 + fr, fq * 8), boff = lds_byte(wc * 32 + fr, fq * 8);
#define PG8_SA(b, h) (((b) * 2 + (h)) * HTB)
#define PG8_SB(b, h) ((4 + (b) * 2 + (h)) * HTB)
#define PG8_STAGE(bufoff, gbase, voff) do { _Pragma("unroll") for (int _i = 0; _i < 2; ++_i) \
        __builtin_amdgcn_global_load_lds((const unsigned*)((const char*)(gbase) + (voff)[_i]), (PG8_LAS unsigned*)(lds + (bufoff) + ldsw + _i * 8192), 16, 0, 0); } while (0)
#define PG8_LDA(dst, b, h) do { _Pragma("unroll") for (int m = 0; m < 4; ++m) _Pragma("unroll") for (int k = 0; k < 2; ++k) dst[m][k] = *(const PG8_LAS bf16x8*)(lds + PG8_SA(b, h) + aoff + m * 2048 + k * 1024); } while (0)
#define PG8_LDB(dst, b, h) do { _Pragma("unroll") for (int n = 0; n < 2; ++n) _Pragma("unroll") for (int k = 0; k < 2; ++k) dst[n][k] = *(const PG8_LAS bf16x8*)(lds + PG8_SB(b, h) + boff + n * 2048 + k * 1024); } while (0)
#define PG8_MMA(ai, bj, At, Bt) do { __builtin_amdgcn_s_setprio(1); _Pragma("unroll") for (int m = 0; m < 4; ++m) _Pragma("unroll") for (int n = 0; n < 2; ++n) _Pragma("unroll") for (int k = 0; k < 2; ++k) \
        acc[ai][bj][m][n] = __builtin_amdgcn_mfma_f32_16x16x32_bf16(Bt[n][k], At[m][k], acc[ai][bj][m][n], 0, 0, 0); __builtin_amdgcn_s_setprio(0); } while (0)
#define PG8_WAIT_V(n) asm volatile("s_waitcnt vmcnt(" #n ")" ::: "memory")
#define PG8_WAIT_L(n) asm volatile("s_waitcnt lgkmcnt(" #n ")" ::: "memory")
#define PG8_BAR __builtin_amdgcn_s_barrier()
#define PG8_SCHED __builtin_amdgcn_sched_barrier(0)
    Unit cur, nxt; int ui = 0;
    if (!S.next(0, cur)) return;
    f32x4 acc[2][2][4][2];
#pragma unroll
    for (int a = 0; a < 2; ++a)
#pragma unroll
        for (int b = 0; b < 2; ++b)
#pragma unroll
            for (int m = 0; m < 4; ++m)
#pragma unroll
                for (int n = 0; n < 2; ++n) acc[a][b][m][n] = (f32x4){0.f, 0.f, 0.f, 0.f};
    bf16x8 At[4][2], B0[2][2], B1[2][2];
    const char* cA = (const char*)(g.A + (size_t)cur.z * g.zA) + (size_t)cur.pm * tstep; const char* cB = (const char*)(g.Bt + (size_t)cur.z * g.zB) + (size_t)cur.pn * tstep;
    S.a_ready(cur);
    if constexpr (SP2) {
        PG8_STAGE(PG8_SB(0, 0), cB, voffB); PG8_STAGE(PG8_SB(0, 1), cB + hstep, voffB); PG8_STAGE(PG8_SA(0, 0), cA, voffA); PG8_STAGE(PG8_SA(0, 1), cA + hstep, voffA);
        if (wr == 1) PG8_BAR;
        PG8_WAIT_V(2); PG8_BAR;
        PG8_STAGE(PG8_SB(1, 0), cB + kstep, voffB); PG8_STAGE(PG8_SA(1, 0), cA + kstep, voffA); PG8_STAGE(PG8_SB(1, 1), cB + hstep + kstep, voffB);
        PG8_WAIT_V(6); PG8_BAR;
    } else {
        PG8_STAGE(PG8_SB(0, 0), cB, voffB); PG8_STAGE(PG8_SA(0, 0), cA, voffA); PG8_STAGE(PG8_SB(0, 1), cB + hstep, voffB); PG8_STAGE(PG8_SA(0, 1), cA + hstep, voffA);
        if (wr == 1) PG8_BAR;
        PG8_WAIT_V(4); PG8_BAR;
        PG8_STAGE(PG8_SB(1, 0), cB + kstep, voffB); PG8_STAGE(PG8_SA(1, 0), cA + kstep, voffA); PG8_STAGE(PG8_SB(1, 1), cB + hstep + kstep, voffB);
        PG8_WAIT_V(6); PG8_BAR;
    }
    for (;;) {
        const bool has_next = S.next(ui + 1, nxt);
        const char* nA = has_next ? (const char*)(g.A + (size_t)nxt.z * g.zA) + (size_t)nxt.pm * tstep : cA; const char* nB = has_next ? (const char*)(g.Bt + (size_t)nxt.z * g.zB) + (size_t)nxt.pn * tstep : cB;
        for (int t = 0; t < nt; t += 2) {
            const bool last = (t == nt - 2);
            const char* a1 = cA + (size_t)(t + 1) * kstep;
            const char* a2 = last ? nA : cA + (size_t)(t + 2) * kstep; const char* b2 = last ? nB : cB + (size_t)(t + 2) * kstep;
            const char* a3 = a2 + kstep; const char* b3 = b2 + kstep;
            if (last && has_next) S.a_ready(nxt);
            if constexpr (SP2) {
            PG8_LDB(B0, 0, 0); PG8_LDB(B1, 0, 1); PG8_SCHED; PG8_LDA(At, 0, 0); PG8_STAGE(PG8_SA(1, 1), a1 + hstep, voffA);
            PG8_WAIT_V(8); PG8_WAIT_L(0); PG8_BAR; PG8_MMA(0, 0, At, B0); PG8_MMA(0, 1, At, B1); PG8_BAR; PG8_SCHED;
            PG8_LDA(At, 0, 1); PG8_STAGE(PG8_SB(0, 0), b2, voffB); PG8_STAGE(PG8_SB(0, 1), b2 + hstep, voffB); PG8_STAGE(PG8_SA(0, 0), a2, voffA);
            PG8_WAIT_V(8); PG8_WAIT_L(0); PG8_BAR; PG8_MMA(1, 0, At, B0); PG8_MMA(1, 1, At, B1); PG8_BAR; PG8_SCHED;
            PG8_LDB(B0, 1, 0); PG8_LDB(B1, 1, 1); PG8_SCHED; PG8_LDA(At, 1, 0); PG8_STAGE(PG8_SA(0, 1), a2 + hstep, voffA);
            PG8_WAIT_V(8); PG8_WAIT_L(0); PG8_BAR; PG8_MMA(0, 0, At, B0); PG8_MMA(0, 1, At, B1); PG8_BAR; PG8_SCHED;
            PG8_LDA(At, 1, 1); PG8_STAGE(PG8_SB(1, 0), b3, voffB); PG8_STAGE(PG8_SB(1, 1), b3 + hstep, voffB); PG8_STAGE(PG8_SA(1, 0), a3, voffA);
            PG8_WAIT_V(8); PG8_WAIT_L(0); PG8_BAR; PG8_MMA(1, 0, At, B0); PG8_MMA(1, 1, At, B1); PG8_BAR; PG8_SCHED;
            } else {
            PG8_LDB(B0, 0, 0); PG8_SCHED; PG8_LDA(At, 0, 0); PG8_STAGE(PG8_SA(1, 1), a1 + hstep, voffA);
            PG8_WAIT_L(8); PG8_BAR; PG8_WAIT_L(0); PG8_MMA(0, 0, At, B0); PG8_BAR; PG8_SCHED;
            PG8_LDB(B1, 0, 1); PG8_STAGE(PG8_SB(0, 0), b2, voffB);
            PG8_BAR; PG8_WAIT_L(0); PG8_MMA(0, 1, At, B1); PG8_BAR;
            PG8_LDA(At, 0, 1); PG8_STAGE(PG8_SA(0, 0), a2, voffA);
            PG8_BAR; PG8_WAIT_L(0); PG8_MMA(1, 0, At, B0); PG8_BAR; PG8_SCHED;
            PG8_STAGE(PG8_SB(0, 1), b2 + hstep, voffB);
            PG8_WAIT_V(6); PG8_BAR; PG8_MMA(1, 1, At, B1); PG8_BAR;
            PG8_LDB(B0, 1, 0); PG8_SCHED; PG8_LDA(At, 1, 0); PG8_STAGE(PG8_SA(0, 1), a2 + hstep, voffA);
            PG8_WAIT_L(8); PG8_BAR; PG8_WAIT_L(0); PG8_MMA(0, 0, At, B0); PG8_BAR; PG8_SCHED;
            PG8_LDB(B1, 1, 1); PG8_STAGE(PG8_SB(1, 0), b3, voffB);
            PG8_BAR; PG8_WAIT_L(0); PG8_MMA(0, 1, At, B1); PG8_BAR;
            PG8_LDA(At, 1, 1); PG8_STAGE(PG8_SA(1, 0), a3, voffA);
            PG8_BAR; PG8_WAIT_L(0); PG8_MMA(1, 0, At, B0); PG8_BAR; PG8_SCHED;
            PG8_STAGE(PG8_SB(1, 1), b3 + hstep, voffB);
            PG8_WAIT_V(6); PG8_BAR; PG8_MMA(1, 1, At, B1); PG8_BAR;
            }
        }
        if constexpr (ALIGN_EPI) { if (wr == 0) PG8_BAR; }
        if constexpr (!Epi::AFTER_DRAIN) { E(acc, cur, wr, wc, fr, fq); S.done(cur); }
        if (!has_next) break;
        if (!(Epi::KEEP && nxt.z != 0)) {
#pragma unroll
        for (int a = 0; a < 2; ++a)
#pragma unroll
            for (int b = 0; b < 2; ++b)
#pragma unroll
                for (int m = 0; m < 4; ++m)
#pragma unroll
                    for (int n = 0; n < 2; ++n) acc[a][b][m][n] = (f32x4){0.f, 0.f, 0.f, 0.f};
        }
        cur = nxt; cA = nA; cB = nB; ++ui;
        if constexpr (ALIGN_EPI) { if (wr == 1) PG8_BAR; }
    }
    PG8_WAIT_V(0);
    if constexpr (!ALIGN_EPI) { if (wr == 0) PG8_BAR; }
    PG8_BAR;
    if constexpr (Epi::AFTER_DRAIN) { E.fused(acc, cur, wr, wc, fr, fq, lds, wid, lane); S.done(cur); }
#undef PG8_SA
#undef PG8_SB
#undef PG8_STAGE
#undef PG8_LDA
#undef PG8_LDB
#undef PG8_MMA
#undef PG8_WAIT_V
#undef PG8_WAIT_L
#undef PG8_BAR
#undef PG8_SCHED
}
}

constexpr int NWAVES = 8;
constexpr int BATCH = 8, SEQ = 2048, DM = 2048, DEPTH = 4, M = BATCH * SEQ, NH = 8;
constexpr int NIN = 16400, NZ = 16384, DFF = 5632, NUP = 2 * DFF, NY = 3072;
constexpr int Z_RQ = 0, Z_RK = 1024, Z_RV = 2048, Z_RG = 3072, Z_MQ = 4096, Z_MK = 4608, Z_MV = 5120, Z_MO = 6144, Z_AQ = 7168, Z_AK = 8192, Z_AV = 9216, Z_GA = 10240, Z_GB = 12288, Z_GC = 14336;
constexpr int W_GATE_COL = 7168;
constexpr size_t MiB = 1u << 20;
constexpr size_t WS_CTL = 0, CTL_ZERO_BYTES = 1 * MiB;
constexpr size_t WS_RS = 1520 * MiB;
constexpr size_t WS_TAB = 2 * MiB + 512 * 1024;
constexpr size_t WS_RSTD = 7 * MiB + 512 * 1024;
constexpr size_t WS_W16G = 7 * MiB;
constexpr size_t WS_KMEAN = 5 * MiB;
constexpr size_t WS_GIF = 6 * MiB;
constexpr size_t WS_WIN = 8 * MiB;
constexpr size_t WS_WP = 264 * MiB;
constexpr size_t WS_WOUT = 312 * MiB;
constexpr size_t WS_WUP = 344 * MiB;
constexpr size_t WS_WDN = 520 * MiB;
constexpr size_t WS_XB = 608 * MiB;
constexpr size_t WS_Z = 672 * MiB;
constexpr size_t WS_Y = 1184 * MiB;
constexpr size_t WS_MG = 1280 * MiB;
constexpr size_t WS_ACT = 1344 * MiB;
constexpr size_t WS_ZG = 1536 * MiB;
constexpr size_t WS_END = 1632 * MiB;
constexpr int CW_TMO = 0, CW_CODE = 1;
constexpr int CW_BAR = 4096;
constexpr int CW_QUEUE = 8192;
constexpr int RING_OFF = 0, RING_BYTES = 131072;
constexpr int LDS_BYTES = 163840;
constexpr int LDSCTL_OFF = LDS_BYTES - 512, MISC_OFF = LDSCTL_OFF + 320;
static_assert(MISC_OFF + 128 <= LDS_BYTES, "LDS map");

#define GAS __attribute__((address_space(1)))
#define LAS __attribute__((address_space(3)))
typedef unsigned short bf16;
typedef unsigned v4u __attribute__((ext_vector_type(4)));
typedef unsigned v2u __attribute__((ext_vector_type(2)));
typedef float f32x4 __attribute__((ext_vector_type(4)));
typedef float f32x2 __attribute__((ext_vector_type(2)));
typedef GAS unsigned gu32;
#define RLX_AGENT __ATOMIC_RELAXED, __HIP_MEMORY_SCOPE_AGENT
#define LDS_WAIT() asm volatile("s_waitcnt lgkmcnt(0)" ::: "memory")
#define VM_WAIT() asm volatile("s_waitcnt vmcnt(0)" ::: "memory")
typedef __bf16 bf16x2_t __attribute__((ext_vector_type(2)));
__device__ __forceinline__ unsigned pk2(float lo, float hi) { const f32x2 v = {lo, hi}; const bf16x2_t b = __builtin_convertvector(v, bf16x2_t); return __builtin_bit_cast(unsigned, b); }
__device__ __forceinline__ unsigned f2bf(float f) { return pk2(f, f); }
__device__ __forceinline__ float bflo(unsigned w) { return __uint_as_float(w << 16); }
__device__ __forceinline__ float bfhi(unsigned w) { return __uint_as_float(w & 0xffff0000u); }
__device__ __forceinline__ float bf1(bf16 v) { return __uint_as_float((unsigned)v << 16); }
__device__ __forceinline__ float sigm(float x) { return 1.0f / (1.0f + __expf(-x)); }

#define XB_TMO      128
#define XB_XCNT(j)  (256  + 64 * (j))
#define XB_XSUB(j)  (1280 + 64 * (j))
#define XB_XGEN(j)  (2304 + 64 * (j))
#define XB_TOP      3328
#define XB_TOPGEN   3392
#define XCD_BAR_WORDS 3456
#define XB_SPIN_CAP (1u << 18)

__device__ __forceinline__ unsigned xb_ld(unsigned* p)              { return __hip_atomic_load(p, __ATOMIC_RELAXED, __HIP_MEMORY_SCOPE_AGENT); }
__device__ __forceinline__ unsigned xb_add(unsigned* p, unsigned v) { return __hip_atomic_fetch_add(p, v, __ATOMIC_RELAXED, __HIP_MEMORY_SCOPE_AGENT); }
__device__ __forceinline__ unsigned xb_xcc_id() { return (unsigned)__builtin_amdgcn_s_getreg((3 << 11) | 20) & 0xFu; }
#define XB_SPIN(cond, bar) do { unsigned _sp = 0; while (cond) { __builtin_amdgcn_s_sleep(1); \
    if ((++_sp & 255u) == 0u) { if (xb_ld(&(bar)[XB_TMO])) break; if (_sp > XB_SPIN_CAP) { atomicAdd(&(bar)[XB_TMO], 1u); break; } } } } while (0)

struct XcdBarrier {
    unsigned* bar; unsigned x;
    volatile LAS unsigned* st;
};

__device__ __forceinline__ XcdBarrier xcd_barrier_post(unsigned* bar, volatile LAS unsigned* st) {
    XcdBarrier b; b.bar = bar; b.x = xb_xcc_id(); b.st = st;
    if (threadIdx.x == 0) (void)xb_add(&bar[XB_XCNT(b.x)], 1u);
    return b;
}
__device__ __forceinline__ void xcd_barrier_complete(unsigned* bar, unsigned x, unsigned& nloc, unsigned& nx) {
    const unsigned G = gridDim.x * gridDim.y * gridDim.z;
    unsigned sum, cnt, mine, sp = 0u;
    for (;;) {
        sum = 0u; cnt = 0u; mine = 0u;
#pragma unroll
        for (unsigned j = 0; j < 16; ++j) { const unsigned c = xb_ld(&bar[XB_XCNT(j)]); sum += c; cnt += (c > 0u) ? 1u : 0u; mine = (j == x) ? c : mine; }
        if (sum == G) break;
        __builtin_amdgcn_s_sleep(1);
        if ((++sp & 255u) == 0u) { if (xb_ld(&bar[XB_TMO])) break; if (sp > XB_SPIN_CAP) { atomicAdd(&bar[XB_TMO], 1u); break; } }
    }
    nloc = mine > 0u ? mine : 1u; nx = cnt > 0u ? cnt : 1u;
}

__device__ __forceinline__ void xcd_barrier(const XcdBarrier& b) {
    asm volatile("s_waitcnt vmcnt(0)" ::: "memory");
    __syncthreads();
    if (threadIdx.x == 0) {
        unsigned* bar = b.bar;
        __builtin_amdgcn_s_waitcnt(0);
        unsigned nloc = b.st[0], nx = b.st[1];
        if (nloc == 0u) { xcd_barrier_complete(bar, b.x, nloc, nx); b.st[0] = nloc; b.st[1] = nx; }
        const unsigned old = xb_add(&bar[XB_XSUB(b.x)], 1u);
        const unsigned gen = old / nloc;
        if (old + 1u == (gen + 1u) * nloc) {
            __builtin_amdgcn_fence(__ATOMIC_RELEASE, "agent");
            asm volatile("s_waitcnt vmcnt(0)" ::: "memory");
            const unsigned og = xb_add(&bar[XB_TOP], 1u);
            const unsigned tg = og / nx;
            if (og + 1u == (tg + 1u) * nx) xb_add(&bar[XB_TOPGEN], 1u);
            else XB_SPIN(xb_ld(&bar[XB_TOPGEN]) == tg, bar);
            __builtin_amdgcn_fence(__ATOMIC_ACQUIRE, "agent");
            xb_add(&bar[XB_XGEN(b.x)], 1u);
            asm volatile("s_waitcnt vmcnt(0)" ::: "memory");
        } else {
            XB_SPIN(xb_ld(&bar[XB_XGEN(b.x)]) == gen, bar);
            __builtin_amdgcn_fence(__ATOMIC_ACQUIRE, "agent");
            asm volatile("s_waitcnt vmcnt(0)" ::: "memory");
        }
    }
    __syncthreads();
}

struct Args { const float* in[18]; float* out; unsigned char* ws; int ph_lo, ph_hi, li, pad; };
enum { I_X = 0, I_WIN, I_BIG, I_BFG, I_NMIX, I_RGN, I_MLN, I_QN, I_KN, I_WPA, I_WPB, I_WPC, I_WOUT, I_NFFN, I_WUP, I_CW, I_CB, I_WDN };
struct Frame {
    LAS unsigned char* lds;
    volatile LAS unsigned* MISC;
    unsigned char* ws;
    int tid, lane, wave, G, bx;
};
#define WSP(T, off) ((T*)(F.ws + (off)))
__device__ __forceinline__ float wave_sum(float v) {
#pragma unroll
    for (int o = 1; o < 64; o <<= 1) v += __shfl_xor(v, o);
    return v;
}
__device__ __forceinline__ float wave_max(float v) {
#pragma unroll
    for (int o = 1; o < 64; o <<= 1) v = fmaxf(v, __shfl_xor(v, o));
    return v;
}
__device__ __forceinline__ void p0_transpose_item(const float* W, int ldw, int K, int nblk, bf16* WT, LAS float* scr, int item, int lane, const float* gk = nullptr) {
    const int kb = item / nblk, nb = item % nblk, k0 = 64 * kb, n0 = 32 * nb;
#pragma unroll 8
    for (int i = 0; i < 32; ++i) { const int kk = 2 * i + (lane >> 5); scr[kk * 33 + (lane & 31)] = W[(size_t)(k0 + kk) * ldw + n0 + (lane & 31)]; }
    LDS_WAIT(); asm volatile("" ::: "memory");
    const int c = lane & 7;
    f32x4 g0 = (f32x4){1.f, 1.f, 1.f, 1.f}, g1 = g0;
    if (gk) { g0 = *(const f32x4*)(gk + k0 + 8 * c); g1 = *(const f32x4*)(gk + k0 + 8 * c + 4); }
#pragma unroll
    for (int j = 0; j < 4; ++j) { const int n = (lane >> 3) + 8 * j; const LAS float* s = scr + (8 * c) * 33 + n;
        v4u o; o.x = pk2(s[0 * 33] * g0[0], s[1 * 33] * g0[1]); o.y = pk2(s[2 * 33] * g0[2], s[3 * 33] * g0[3]); o.z = pk2(s[4 * 33] * g1[0], s[5 * 33] * g1[1]); o.w = pk2(s[6 * 33] * g1[2], s[7 * 33] * g1[3]);
        *(GAS v4u*)(WT + (size_t)(n0 + n) * K + k0 + 8 * c) = o; }
    LDS_WAIT(); asm volatile("" ::: "memory");
}
__device__ __forceinline__ void p0_prologue(Frame& F, const Args& args) {
    LAS float* scr = (LAS float*)(F.lds + RING_OFF + F.wave * 16384);
    const int gw = F.bx * NWAVES + F.wave, NGW = F.G * NWAVES;
    constexpr int I_INA = 32 * 224, I_INB = 32 * 288, I_P = 16 * 64, I_OUT = 32 * 64, I_UP = 32 * 352, I_DN = 88 * 64;
    constexpr int I_LAYER = I_INA + I_INB + 3 * I_P + I_OUT + I_UP + I_DN;
    for (int it = gw; it < DEPTH * I_LAYER; it += NGW) {
        const int l = it / I_LAYER; int r = it % I_LAYER;
        const float* win = args.in[I_WIN] + (size_t)l * DM * NIN; bf16* wint = WSP(bf16, WS_WIN) + (size_t)l * NZ * DM;
        if (r < I_INA) { p0_transpose_item(win, NIN, DM, 224, wint, scr, r, F.lane, args.in[I_NMIX] + l * DM); continue; } r -= I_INA;
        if (r < I_INB) { p0_transpose_item(win + 7184, NIN, DM, 288, wint + (size_t)7168 * DM, scr, r, F.lane, args.in[I_NMIX] + l * DM); continue; } r -= I_INB;
        if (r < I_P) { p0_transpose_item(args.in[I_WPA] + (size_t)l * 1024 * DM, DM, 1024, 64, WSP(bf16, WS_WP) + ((size_t)l * 3 + 0) * DM * 1024, scr, r, F.lane); continue; } r -= I_P;
        if (r < I_P) { p0_transpose_item(args.in[I_WPB] + (size_t)l * 1024 * DM, DM, 1024, 64, WSP(bf16, WS_WP) + ((size_t)l * 3 + 1) * DM * 1024, scr, r, F.lane); continue; } r -= I_P;
        if (r < I_P) { p0_transpose_item(args.in[I_WPC] + (size_t)l * 1024 * DM, DM, 1024, 64, WSP(bf16, WS_WP) + ((size_t)l * 3 + 2) * DM * 1024, scr, r, F.lane); continue; } r -= I_P;
        if (r < I_OUT) { p0_transpose_item(args.in[I_WOUT] + (size_t)l * DM * DM, DM, DM, 64, WSP(bf16, WS_WOUT) + (size_t)l * DM * DM, scr, r, F.lane); continue; } r -= I_OUT;
        if (r < I_UP) { p0_transpose_item(args.in[I_WUP] + (size_t)l * DM * NUP, NUP, DM, 352, WSP(bf16, WS_WUP) + (size_t)l * NUP * DM, scr, r, F.lane, args.in[I_NFFN] + l * DM); continue; } r -= I_UP;
        p0_transpose_item(args.in[I_WDN] + (size_t)l * DFF * DM, DM, DFF, 64, WSP(bf16, WS_WDN) + (size_t)l * DM * DFF, scr, r, F.lane);
    }
    const int gt = F.bx * (NWAVES * 64) + F.tid, NGT = F.G * NWAVES * 64;
    for (int i = gt; i < DEPTH * 16 * DM; i += NGT) { const int l = i / (16 * DM), c = (i / DM) % 16, k = i % DM; WSP(bf16, WS_W16G)[i] = (bf16)f2bf(args.in[I_WIN][((size_t)l * DM + k) * NIN + W_GATE_COL + c] * args.in[I_NMIX][l * DM + k]); }
    for (int m = gw; m < M; m += NGW) { const f32x4* xr = (const f32x4*)(args.in[I_X] + (size_t)m * DM) + F.lane; v2u* o8 = (v2u*)(WSP(bf16, WS_XB) + (size_t)m * DM) + F.lane; float s = 0.f;
#pragma unroll
        for (int j = 0; j < 8; ++j) { const f32x4 v = xr[64 * j]; s += (v.x * v.x + v.y * v.y) + (v.z * v.z + v.w * v.w); v2u w; w.x = pk2(v.x, v.y); w.y = pk2(v.z, v.w); o8[64 * j] = w; }
        s = wave_sum(s); if (F.lane < 32) WSP(float, WS_RS)[(size_t)m * 32 + F.lane] = (F.lane == 0) ? s : 0.f; }
    for (int i = gt; i < 2 * SEQ * 64; i += NGT) { const int which = i / (SEQ * 64), pos = (i / 64) % SEQ, d = i % 64;
        const float ex = which == 0 ? (float)d / 63.0f : (float)(2 * d) / 128.0f;
        const float inv = 1.0f / powf(10000.0f, ex); const float ang = (float)pos * inv; float s, c; sincosf(ang, &s, &c); WSP(f32x2, WS_TAB)[i] = (f32x2){c, s}; }
}
__device__ __forceinline__ void prep_phase(Frame& F, const float* qn, const float* kn, const bf16* w16g, const float* rs, const float* big, const float* bfg) {
    const int gw = F.bx * NWAVES + F.wave, NGW = F.G * NWAVES, lane = F.lane, rsub = lane >> 2, dg = lane & 3;
    const f32x2* trope = WSP(f32x2, WS_TAB) + SEQ * 64;
    for (int u = gw; u < 2 * BATCH * 16 * NH; u += NGW) {
        const int kind = u & 1, hh = (u >> 1) & 7, hb = (u >> 4) & 15, b = u >> 8;
        const float* wn = kind ? kn : qn;
        const float* rsb = rs + (size_t)(b * SEQ + hb * 128) * 32 + 8 * dg;
        float wl[16], wh[16], s1[16], s2[16];
#pragma unroll
        for (int e = 0; e < 16; ++e) { wl[e] = wn[16 * dg + e]; wh[e] = wn[64 + 16 * dg + e]; s1[e] = 0.f; s2[e] = 0.f; }
        bf16* zb = WSP(bf16, WS_Z) + (size_t)(b * SEQ + hb * 128) * NZ + (kind ? Z_AK : Z_AQ) + hh * 128 + 16 * dg;
#pragma unroll 2
        for (int st = 0; st < 8; ++st) {
            const int r = rsub + 16 * st, pos = hb * 128 + r; bf16* zr = zb + (size_t)r * NZ;
            const v4u l0 = *(const v4u*)(zr), l1 = *(const v4u*)(zr + 8), h0 = *(const v4u*)(zr + 64), h1 = *(const v4u*)(zr + 72);
            float a[16] = {bflo(l0.x), bfhi(l0.x), bflo(l0.y), bfhi(l0.y), bflo(l0.z), bfhi(l0.z), bflo(l0.w), bfhi(l0.w), bflo(l1.x), bfhi(l1.x), bflo(l1.y), bfhi(l1.y), bflo(l1.z), bfhi(l1.z), bflo(l1.w), bfhi(l1.w)};
            float c[16] = {bflo(h0.x), bfhi(h0.x), bflo(h0.y), bfhi(h0.y), bflo(h0.z), bfhi(h0.z), bflo(h0.w), bfhi(h0.w), bflo(h1.x), bfhi(h1.x), bflo(h1.y), bfhi(h1.y), bflo(h1.z), bfhi(h1.z), bflo(h1.w), bfhi(h1.w)};
            float ss = 0.f;
#pragma unroll
            for (int e = 0; e < 16; ++e) ss += a[e] * a[e] + c[e] * c[e];
            ss += __shfl_xor(ss, 1); ss += __shfl_xor(ss, 2);
            float rq; { const f32x4 s0 = *(const f32x4*)(rsb + (size_t)r * 32), s1 = *(const f32x4*)(rsb + (size_t)r * 32 + 4); rq = ((s0[0] + s0[1]) + (s0[2] + s0[3])) + ((s1[0] + s1[1]) + (s1[2] + s1[3])); }
            rq += __shfl_xor(rq, 1); rq += __shfl_xor(rq, 2);
            const float rr = rsqrtf(rq * (1.0f / 2048.0f) + 1e-6f);
            if ((u & 15) == 0 && dg == 0) WSP(float, WS_RSTD)[b * SEQ + hb * 128 + r] = rr;
            const float rstd = rr * rsqrtf(ss * rr * rr * (1.f / 128.f) + 1e-6f);
            const f32x2* tb = trope + pos * 64 + 16 * dg;
#pragma unroll
            for (int e = 0; e < 16; ++e) { const float x1 = a[e] * rstd * wl[e], x2 = c[e] * rstd * wh[e]; const f32x2 cs = tb[e]; a[e] = x1 * cs.x - x2 * cs.y; c[e] = x1 * cs.y + x2 * cs.x; s1[e] += a[e]; s2[e] += c[e]; }
            *(v4u*)(zr) = (v4u){pk2(a[0], a[1]), pk2(a[2], a[3]), pk2(a[4], a[5]), pk2(a[6], a[7])}; *(v4u*)(zr + 8) = (v4u){pk2(a[8], a[9]), pk2(a[10], a[11]), pk2(a[12], a[13]), pk2(a[14], a[15])};
            *(v4u*)(zr + 64) = (v4u){pk2(c[0], c[1]), pk2(c[2], c[3]), pk2(c[4], c[5]), pk2(c[6], c[7])}; *(v4u*)(zr + 72) = (v4u){pk2(c[8], c[9]), pk2(c[10], c[11]), pk2(c[12], c[13]), pk2(c[14], c[15])};
        }
        if (kind) {
            float* km = WSP(float, WS_KMEAN) + (size_t)((b * NH + hh) * 16 + hb) * 128 + 16 * dg;
#pragma unroll
            for (int e = 0; e < 16; ++e) { float x = s1[e], y = s2[e];
                x += __shfl_xor(x, 4); x += __shfl_xor(x, 8); x += __shfl_xor(x, 16); x += __shfl_xor(x, 32);
                y += __shfl_xor(y, 4); y += __shfl_xor(y, 8); y += __shfl_xor(y, 16); y += __shfl_xor(y, 32);
                if (rsub == 0) { km[e] = x * (1.f / 256.f); km[64 + e] = y * (1.f / 256.f); } }
        }
    }
    for (int it = gw; it < M / 32; it += NGW) {
#pragma unroll
        for (int st = 0; st < 8; ++st) { const int row = 32 * it + 4 * st + (lane >> 4), cg = lane & 15;
            const float* rp = rs + (size_t)row * 32; float rq = 0.f;
#pragma unroll
            for (int q = 0; q < 8; ++q) { const f32x4 s0 = *(const f32x4*)(rp + 4 * q); rq += (s0[0] + s0[1]) + (s0[2] + s0[3]); }
            const float rr = rsqrtf(rq * (1.0f / 2048.0f) + 1e-6f);
            bf16* vp = WSP(bf16, WS_Z) + (size_t)row * NZ + Z_AV + 8 * cg;
#pragma unroll
            for (int q = 0; q < 8; ++q) { const v4u x = *(const v4u*)(vp + 128 * q);
                *(v4u*)(vp + 128 * q) = (v4u){pk2(bflo(x.x) * rr, bfhi(x.x) * rr), pk2(bflo(x.y) * rr, bfhi(x.y) * rr), pk2(bflo(x.z) * rr, bfhi(x.z) * rr), pk2(bflo(x.w) * rr, bfhi(x.w) * rr)}; } }
    }
    for (int it = NGW - 1 - gw; it < M / 16; it += NGW) {
        const int i16 = lane & 15, g = lane >> 4; const bf16* ar = WSP(bf16, WS_XB) + (size_t)(16 * it + i16) * DM + 8 * g; const bf16* br = w16g + (size_t)i16 * DM + 8 * g;
        typedef short bf16x8_t __attribute__((ext_vector_type(8)));
        f32x4 acc = (f32x4){0.f, 0.f, 0.f, 0.f};
#pragma unroll 1
        for (int s0 = 0; s0 < DM / 32; s0 += 16) { bf16x8_t av[16], bv[16];
#pragma unroll
            for (int s = 0; s < 16; ++s) { av[s] = *(const bf16x8_t*)(ar + 32 * (s0 + s)); bv[s] = *(const bf16x8_t*)(br + 32 * (s0 + s)); }
#pragma unroll
            for (int s = 0; s < 16; ++s) acc = __builtin_amdgcn_mfma_f32_16x16x32_bf16(av[s], bv[s], acc, 0, 0, 0); }
#pragma unroll
        for (int r = 0; r < 4; ++r) { const int row = 16 * it + 4 * g + r; float ssq = 0.f;
#pragma unroll
            for (int q = 0; q < 8; ++q) { const f32x4 a = *(const f32x4*)(rs + (size_t)row * 32 + 4 * q); ssq += (a[0] + a[1]) + (a[2] + a[3]); }
            const float sr = rsqrtf(ssq * (1.0f / 2048.0f) + 1e-6f);
            const float pre = acc[r] * sr + (i16 < 8 ? big[i16 & 7] : bfg[i16 & 7]); const float sc = 15.0f * tanhf(pre * (1.0f / 15.0f));
            float o = sc; if (i16 >= 8) o = sc > 0.f ? -log1pf(__expf(-sc)) : sc - log1pf(__expf(sc));
            WSP(float, WS_GIF)[(size_t)row * 16 + i16] = o; }
    }
}
__device__ __forceinline__ void glu_phase(Frame& F, const float* cw, const float* cb, const float* rs) {
    const int gw = F.bx * NWAVES + F.wave, NGW = F.G * NWAVES, lane = F.lane;
    constexpr int RB = 8, NCG = DFF / 512;
    const bf16* U = WSP(bf16, WS_Z); bf16* ACT = WSP(bf16, WS_ACT);
    for (int it = gw; it < (M / RB) * NCG; it += NGW) {
        const int cgp = it % NCG, rb = it / NCG, c8 = (cgp * 64 + lane) * 8, m0 = rb * RB; const bool first = (m0 & (SEQ - 1)) == 0;
        float myrr; { const int wr_ = lane >> 2, pt = lane & 3; const int m = m0 - 2 + wr_; float q = 0.f;
            if (wr_ < RB + 2 && !(wr_ < 2 && first)) { const f32x4 s0 = *(const f32x4*)(rs + (size_t)m * 32 + 8 * pt), s1 = *(const f32x4*)(rs + (size_t)m * 32 + 8 * pt + 4); q = ((s0[0] + s0[1]) + (s0[2] + s0[3])) + ((s1[0] + s1[1]) + (s1[2] + s1[3])); }
            q += __shfl_xor(q, 1); q += __shfl_xor(q, 2); myrr = rsqrtf(q * (1.0f / 2048.0f) + 1e-6f); }
        v4u ua[RB + 2], ub[RB + 2];
#pragma unroll
        for (int r = 0; r < RB + 2; ++r) { const int m = m0 - 2 + r;
            if (r < 2 && first) { ua[r] = (v4u){0u, 0u, 0u, 0u}; ub[r] = (v4u){0u, 0u, 0u, 0u}; }
            else { ua[r] = *(const v4u*)(U + (size_t)m * NUP + c8); ub[r] = *(const v4u*)(U + (size_t)m * NUP + DFF + c8); } }
        float wa[3][8], wb[3][8], ba[8], bb[8];
#pragma unroll
        for (int j = 0; j < 3; ++j) { const f32x4 a0 = *(const f32x4*)(cw + (size_t)j * NUP + c8), a1 = *(const f32x4*)(cw + (size_t)j * NUP + c8 + 4), b0 = *(const f32x4*)(cw + (size_t)j * NUP + DFF + c8), b1 = *(const f32x4*)(cw + (size_t)j * NUP + DFF + c8 + 4);
            wa[j][0] = a0.x; wa[j][1] = a0.y; wa[j][2] = a0.z; wa[j][3] = a0.w; wa[j][4] = a1.x; wa[j][5] = a1.y; wa[j][6] = a1.z; wa[j][7] = a1.w;
            wb[j][0] = b0.x; wb[j][1] = b0.y; wb[j][2] = b0.z; wb[j][3] = b0.w; wb[j][4] = b1.x; wb[j][5] = b1.y; wb[j][6] = b1.z; wb[j][7] = b1.w; }
        { const f32x4 a0 = *(const f32x4*)(cb + c8), a1 = *(const f32x4*)(cb + c8 + 4), b0 = *(const f32x4*)(cb + DFF + c8), b1 = *(const f32x4*)(cb + DFF + c8 + 4);
          ba[0] = a0.x; ba[1] = a0.y; ba[2] = a0.z; ba[3] = a0.w; ba[4] = a1.x; ba[5] = a1.y; ba[6] = a1.z; ba[7] = a1.w; bb[0] = b0.x; bb[1] = b0.y; bb[2] = b0.z; bb[3] = b0.w; bb[4] = b1.x; bb[5] = b1.y; bb[6] = b1.z; bb[7] = b1.w; }
#pragma unroll
        for (int r = 0; r < RB; ++r) {
            float xa[8], xb[8];
#pragma unroll
            for (int e = 0; e < 8; ++e) { xa[e] = ba[e]; xb[e] = bb[e]; }
#pragma unroll
            for (int j = 0; j < 3; ++j) { const v4u a = ua[r + j], b = ub[r + j]; const float rsc = __shfl(myrr, 4 * (r + j));
                const float fa[8] = {bflo(a.x), bfhi(a.x), bflo(a.y), bfhi(a.y), bflo(a.z), bfhi(a.z), bflo(a.w), bfhi(a.w)};
                const float fb[8] = {bflo(b.x), bfhi(b.x), bflo(b.y), bfhi(b.y), bflo(b.z), bfhi(b.z), bflo(b.w), bfhi(b.w)};
#pragma unroll
                for (int e = 0; e < 8; ++e) { xa[e] += fa[e] * rsc * wa[j][e]; xb[e] += fb[e] * rsc * wb[j][e]; } }
            float o[8];
#pragma unroll
            for (int e = 0; e < 8; ++e) o[e] = xa[e] * __builtin_amdgcn_rcpf(1.0f + __expf(-xa[e])) * xb[e];
            *(v4u*)(ACT + (size_t)(m0 + r) * DFF + c8) = (v4u){pk2(o[0], o[1]), pk2(o[2], o[3]), pk2(o[4], o[5]), pk2(o[6], o[7])};
        }
    }
}
namespace mx {
typedef short bf16x8 __attribute__((ext_vector_type(8)));
typedef short s16x4 __attribute__((ext_vector_type(4)));
#define MFMA16(a, b, c) __builtin_amdgcn_mfma_f32_16x16x32_bf16((a), (b), (c), 0, 0, 0)
#define LDS_FENCE() asm volatile("s_waitcnt lgkmcnt(0)" ::: "memory")
#define SCHED_FENCE() __builtin_amdgcn_sched_barrier(0)
__device__ __forceinline__ bf16x8 frag_row(const LAS bf16* X, int ld, int r0, int c0, int lane) {
    return *(const LAS bf16x8*)(X + (r0 + (lane & 15)) * ld + c0 + 8 * (lane >> 4)); }
__device__ __forceinline__ bf16x8 frag_tr(const LAS bf16* X, int ld, int k0, int c0, int lane) {
    const int g = lane >> 4, q = (lane & 15) >> 2, p = lane & 3;
    const LAS bf16* a = X + (k0 + 8 * g + q) * ld + c0 + 4 * p;
    const s16x4 lo = __builtin_amdgcn_ds_read_tr16_b64_v4i16((LAS s16x4*)a);
    const s16x4 hi = __builtin_amdgcn_ds_read_tr16_b64_v4i16((LAS s16x4*)(a + 4 * ld));
    return __builtin_shufflevector(lo, hi, 0, 1, 2, 3, 4, 5, 6, 7);
}
__device__ __forceinline__ int trs_off(int row, int chunk) { return row * 128 + ((chunk ^ (((row & 3) << 1) | (((row >> 3) & 1) << 3))) << 3); }
__device__ __forceinline__ bf16x8 frag_trs(const LAS bf16* X, int k0, int c0, int lane) {
    const int g = lane >> 4, q = (lane & 15) >> 2, p = lane & 3;
    const LAS bf16* a = X + trs_off(k0 + 8 * g + q, (c0 >> 3) + (p >> 1)) + 4 * (p & 1);
    const s16x4 lo = __builtin_amdgcn_ds_read_tr16_b64_v4i16((LAS s16x4*)a);
    const s16x4 hi = __builtin_amdgcn_ds_read_tr16_b64_v4i16((LAS s16x4*)(a + 4 * 128));
    return __builtin_shufflevector(lo, hi, 0, 1, 2, 3, 4, 5, 6, 7);
}
__device__ __forceinline__ float red16_sum(float v) { v += __shfl_xor(v, 1); v += __shfl_xor(v, 2); v += __shfl_xor(v, 4); v += __shfl_xor(v, 8); return v; }
__device__ __forceinline__ float red16_max(float v) { v = fmaxf(v, __shfl_xor(v, 1)); v = fmaxf(v, __shfl_xor(v, 2)); v = fmaxf(v, __shfl_xor(v, 4)); v = fmaxf(v, __shfl_xor(v, 8)); return v; }
__device__ __forceinline__ void rot8(const v4u lo, const v4u hi, const f32x2* tb, float sc, v4u& olo, v4u& ohi) {
    float a[8] = {bflo(lo.x), bfhi(lo.x), bflo(lo.y), bfhi(lo.y), bflo(lo.z), bfhi(lo.z), bflo(lo.w), bfhi(lo.w)};
    float c[8] = {bflo(hi.x), bfhi(hi.x), bflo(hi.y), bfhi(hi.y), bflo(hi.z), bfhi(hi.z), bflo(hi.w), bfhi(hi.w)};
    float o1[8], o2[8];
#pragma unroll
    for (int e = 0; e < 8; ++e) { const f32x2 cs = tb[e]; o1[e] = (a[e] * cs.x - c[e] * cs.y) * sc; o2[e] = (a[e] * cs.y + c[e] * cs.x) * sc; }
    olo = (v4u){pk2(o1[0], o1[1]), pk2(o1[2], o1[3]), pk2(o1[4], o1[5]), pk2(o1[6], o1[7])};
    ohi = (v4u){pk2(o2[0], o2[1]), pk2(o2[2], o2[3]), pk2(o2[4], o2[5]), pk2(o2[6], o2[7])};
}
constexpr int LQ = 144;
__device__ __forceinline__ void ret_unit(Frame& F, const float* gn, int b, int h) {
    LAS bf16* Qs = (LAS bf16*)(F.lds); LAS bf16* Ks = Qs + 128 * LQ; LAS bf16* Vs = Ks + 128 * LQ; LAS bf16* Ts = Vs + 128 * LQ;
    const int tid = F.tid, lane = F.lane, w = tid >> 6, i16 = lane & 15, g = lane >> 4;
    const float gamma = 1.0f - exp2f(-5.0f - (float)h), lg = log2f(gamma);
    const float gC = exp2f(lg * 128.0f);
    f32x4 accT[8];
#pragma unroll
    for (int n = 0; n < 8; ++n) accT[n] = (f32x4){0.f, 0.f, 0.f, 0.f};
    for (int i = tid; i < 128 * LQ / 8; i += NWAVES * 64) ((LAS v4u*)Ts)[i] = (v4u){0u, 0u, 0u, 0u};
    const bf16* zb = WSP(bf16, WS_Z) + (size_t)(b * SEQ) * NZ + h * 128;
    const f32x2* tret = WSP(f32x2, WS_TAB);
    bf16* yb = WSP(bf16, WS_Y) + (size_t)(b * SEQ) * 1024 + h * 128;
    const int lr = tid >> 2, dg = tid & 3;
    v4u pq[4], pk[4], pv[4]; float prr;
    const float* rstd1 = WSP(float, WS_RSTD) + (size_t)(b * SEQ);
#define RET_FETCH(t0_) do { const bf16* zr_ = zb + (size_t)((t0_) + lr) * NZ; \
        pq[0] = *(const v4u*)(zr_ + Z_RQ + 16 * dg); pq[1] = *(const v4u*)(zr_ + Z_RQ + 64 + 16 * dg); pq[2] = *(const v4u*)(zr_ + Z_RQ + 16 * dg + 8); pq[3] = *(const v4u*)(zr_ + Z_RQ + 64 + 16 * dg + 8); \
        pk[0] = *(const v4u*)(zr_ + Z_RK + 16 * dg); pk[1] = *(const v4u*)(zr_ + Z_RK + 64 + 16 * dg); pk[2] = *(const v4u*)(zr_ + Z_RK + 16 * dg + 8); pk[3] = *(const v4u*)(zr_ + Z_RK + 64 + 16 * dg + 8); \
        _Pragma("unroll") for (int q_ = 0; q_ < 4; ++q_) pv[q_] = *(const v4u*)(zr_ + Z_RV + 32 * dg + 8 * q_); prr = rstd1[(t0_) + lr]; } while (0)
    RET_FETCH(0);
    const float sq = exp2f(lg * (float)lr), sk = exp2f(-lg * (float)lr) * 0.08838834764831845f;
    for (int c = 0; c < SEQ / 128; ++c) {
        const int t0 = c * 128;
        {
            const f32x2* tb = tret + (t0 + lr) * 64 + 16 * dg;
#pragma unroll
            for (int hh = 0; hh < 2; ++hh) {
                v4u o1, o2; rot8(pq[2 * hh], pq[2 * hh + 1], tb + 8 * hh, sq * prr, o1, o2);
                *(LAS v4u*)(Qs + lr * LQ + 16 * dg + 8 * hh) = o1; *(LAS v4u*)(Qs + lr * LQ + 64 + 16 * dg + 8 * hh) = o2;
                rot8(pk[2 * hh], pk[2 * hh + 1], tb + 8 * hh, sk * prr * prr, o1, o2);
                *(LAS v4u*)(Ks + lr * LQ + 16 * dg + 8 * hh) = o1; *(LAS v4u*)(Ks + lr * LQ + 64 + 16 * dg + 8 * hh) = o2;
            }
#pragma unroll
            for (int q = 0; q < 4; ++q) *(LAS v4u*)(Vs + lr * LQ + 32 * dg + 8 * q) = pv[q];
            if (c + 1 < SEQ / 128) RET_FETCH(t0 + 128);
        }
        __syncthreads();
        bf16x8 aq[4];
#pragma unroll
        for (int s = 0; s < 4; ++s) aq[s] = frag_row(Qs, LQ, 16 * w, 32 * s, lane);
        f32x4 acco[8];
#pragma unroll
        for (int n = 0; n < 8; ++n) acco[n] = (f32x4){0.f, 0.f, 0.f, 0.f};
#pragma unroll
        for (int s = 0; s < 4; ++s) { bf16x8 bb[8];
#pragma unroll
            for (int n = 0; n < 8; ++n) bb[n] = frag_tr(Ts, LQ, 32 * s, 16 * n, lane);
            SCHED_FENCE();
#pragma unroll
            for (int n = 0; n < 8; ++n) acco[n] = MFMA16(aq[s], bb[n], acco[n]); }
        LDS_FENCE();
#pragma unroll
        for (int n = 0; n < 8; ++n) {
            if (n <= w) { f32x4 sa = (f32x4){0.f, 0.f, 0.f, 0.f}; bf16x8 bb[4];
#pragma unroll
                for (int s = 0; s < 4; ++s) bb[s] = frag_row(Ks, LQ, 16 * n, 32 * s, lane);
                SCHED_FENCE();
#pragma unroll
                for (int s = 0; s < 4; ++s) sa = MFMA16(aq[s], bb[s], sa);
#pragma unroll
                for (int r = 0; r < 4; ++r) { const int i = 16 * w + 4 * g + r, j = 16 * n + i16; Qs[i * LQ + j] = (bf16)f2bf(j <= i ? sa[r] : 0.f); } }
            else if (n == w + 1) {
#pragma unroll
                for (int r = 0; r < 4; ++r) Qs[(16 * w + 4 * g + r) * LQ + 16 * n + i16] = (bf16)0; }
        }
        LDS_FENCE();
#pragma unroll
        for (int s = 0; s < 4; ++s) if (s <= (w >> 1)) { const bf16x8 as = frag_row(Qs, LQ, 16 * w, 32 * s, lane); bf16x8 bb[8];
#pragma unroll
            for (int n = 0; n < 8; ++n) bb[n] = frag_tr(Vs, LQ, 32 * s, 16 * n, lane);
            SCHED_FENCE();
#pragma unroll
            for (int n = 0; n < 8; ++n) acco[n] = MFMA16(as, bb[n], acco[n]); }
#pragma unroll
        for (int n = 0; n < 8; ++n) accT[n] = accT[n] * gC;
#pragma unroll
        for (int s = 0; s < 4; ++s) { const bf16x8 ak = frag_tr(Ks, LQ, 32 * s, 16 * w, lane); bf16x8 bb[8];
#pragma unroll
            for (int n = 0; n < 8; ++n) bb[n] = frag_tr(Vs, LQ, 32 * s, 16 * n, lane);
            SCHED_FENCE();
#pragma unroll
            for (int n = 0; n < 8; ++n) accT[n] = MFMA16(ak, bb[n], accT[n]); }
        LDS_FENCE();
        __syncthreads();
#pragma unroll
        for (int n = 0; n < 8; ++n)
#pragma unroll
            for (int r = 0; r < 4; ++r) Ts[(16 * w + 4 * g + r) * LQ + 16 * n + i16] = (bf16)f2bf(gC * accT[n][r]);
#pragma unroll
        for (int r = 0; r < 4; ++r) {
            float s = 0.f;
#pragma unroll
            for (int n = 0; n < 8; ++n) s += acco[n][r];
            const float mean = red16_sum(s) * (1.f / 128.f); float q = 0.f;
#pragma unroll
            for (int n = 0; n < 8; ++n) { const float d = acco[n][r] - mean; q += d * d; }
            const float rstd = rsqrtf(red16_sum(q) * (1.f / 128.f) + 1e-5f);
            const int pos = t0 + 16 * w + 4 * g + r; const bf16* gr = zb + (size_t)pos * NZ + Z_RG; bf16* yr = yb + (size_t)pos * 1024; const float rri = rstd1[pos];
#pragma unroll
            for (int n = 0; n < 8; ++n) { const int e = 16 * n + i16; const float gv = bf1(gr[e]) * rri; yr[e] = (bf16)f2bf((acco[n][r] - mean) * rstd * gn[h * 128 + e] * gv * sigm(gv)); }
        }
    }
    __syncthreads();
#undef RET_FETCH
}
constexpr int LK = 72, LV = 168;
__device__ __forceinline__ float scan64_sum(float x, int lane) {
#pragma unroll
    for (int o = 1; o < 64; o <<= 1) { const float y = __shfl_up(x, o); if (lane >= o) x += y; }
    return x; }
__device__ __forceinline__ float scan64_max(float x, int lane) {
#pragma unroll
    for (int o = 1; o < 64; o <<= 1) { const float y = __shfl_up(x, o); if (lane >= o) x = fmaxf(x, y); }
    return x; }
__device__ __forceinline__ void mlstm_unit(Frame& F, const float* nw, int b, int h) {
    LAS bf16* Qm = (LAS bf16*)(F.lds); LAS bf16* Km = Qm + 128 * LK; LAS bf16* Kw = Km + 128 * LK; LAS bf16* Vm = Kw + 128 * LK; LAS bf16* Pm = Vm + 128 * LV; LAS bf16* Cm = Pm + 128 * LQ;
    const int tid = F.tid, lane = F.lane, w = F.wave, i16 = lane & 15, g = lane >> 4;
    const int dt = w & 3, eh = w >> 2;
    f32x4 accC[5];
#pragma unroll
    for (int k = 0; k < 5; ++k) accC[k] = (f32x4){0.f, 0.f, 0.f, 0.f};
    for (int i = tid; i < 64 * LV / 8; i += NWAVES * 64) ((LAS v4u*)Cm)[i] = (v4u){0u, 0u, 0u, 0u};
    float m_prev = 0.f;
    const bf16* zb = WSP(bf16, WS_Z) + (size_t)(b * SEQ) * NZ;
    const float* gif = WSP(float, WS_GIF) + (size_t)(b * SEQ) * 16;
    bf16* yb = WSP(bf16, WS_Y) + (size_t)M * 1024 + (size_t)(b * SEQ) * 1024 + h * 128;
    const int lr = tid >> 2, dg = tid & 3;
    v4u pq[2], pk[2]; float fl0, fl1, il0, il1, prr;
    const float* rstd1 = WSP(float, WS_RSTD) + (size_t)(b * SEQ);
#define ML_FETCH(t0_) do { const bf16* zr_ = zb + (size_t)((t0_) + lr) * NZ; \
        pq[0] = *(const v4u*)(zr_ + Z_MQ + h * 64 + 16 * dg); pq[1] = *(const v4u*)(zr_ + Z_MQ + h * 64 + 16 * dg + 8); pk[0] = *(const v4u*)(zr_ + Z_MK + h * 64 + 16 * dg); pk[1] = *(const v4u*)(zr_ + Z_MK + h * 64 + 16 * dg + 8); \
        fl0 = gif[(size_t)((t0_) + lane) * 16 + 8 + h]; fl1 = gif[(size_t)((t0_) + 64 + lane) * 16 + 8 + h]; il0 = gif[(size_t)((t0_) + lane) * 16 + h]; il1 = gif[(size_t)((t0_) + 64 + lane) * 16 + h]; prr = rstd1[(t0_) + lr]; } while (0)
    ML_FETCH(0);
    for (int c = 0; c < SEQ / 128; ++c) {
        const int t0 = c * 128;
        const float a0 = scan64_sum(fl0, lane); const float a1 = scan64_sum(fl1, lane) + __shfl(a0, 63);
        const float b0 = il0 - a0, b1 = il1 - a1;
        const float pm0 = scan64_max(b0, lane); const float pm1 = fmaxf(scan64_max(b1, lane), __shfl(pm0, 63));
        const float a_last = __shfl(a1, 63), bmax = __shfl(pm1, 63);
        const float g_n = a_last + bmax, m_new = fmaxf(a_last + m_prev, g_n), s_old = __expf(a_last + m_prev - m_new), s_new = __expf(g_n - m_new);
        {
            const int r = lr;
            const float br = (r < 64) ? __shfl(b0, r & 63) : __shfl(b1, r & 63);
            const float rk = prr * 0.125f, wk = __expf(br - bmax) * rk * s_new;
#pragma unroll
            for (int hh = 0; hh < 2; ++hh) {
                *(LAS v4u*)(Qm + r * LK + 16 * dg + 8 * hh) = pq[hh];
                const v4u kk = pk[hh];
                float kf[8] = {bflo(kk.x), bfhi(kk.x), bflo(kk.y), bfhi(kk.y), bflo(kk.z), bfhi(kk.z), bflo(kk.w), bfhi(kk.w)};
                *(LAS v4u*)(Km + r * LK + 16 * dg + 8 * hh) = (v4u){pk2(kf[0] * rk, kf[1] * rk), pk2(kf[2] * rk, kf[3] * rk), pk2(kf[4] * rk, kf[5] * rk), pk2(kf[6] * rk, kf[7] * rk)};
                *(LAS v4u*)(Kw + r * LK + 16 * dg + 8 * hh) = (v4u){pk2(kf[0] * wk, kf[1] * wk), pk2(kf[2] * wk, kf[3] * wk), pk2(kf[4] * wk, kf[5] * wk), pk2(kf[6] * wk, kf[7] * wk)};
            }
#pragma unroll
            for (int q = 0; q < 4; ++q) { const v4u x = *(const v4u*)(zb + (size_t)(t0 + r) * NZ + Z_MV + h * 128 + 32 * dg + 8 * q); const float rv = prr;
                *(LAS v4u*)(Vm + r * LV + 32 * dg + 8 * q) = (v4u){pk2(bflo(x.x) * rv, bfhi(x.x) * rv), pk2(bflo(x.y) * rv, bfhi(x.y) * rv), pk2(bflo(x.z) * rv, bfhi(x.z) * rv), pk2(bflo(x.w) * rv, bfhi(x.w) * rv)}; }
            *(LAS v4u*)(Vm + r * LV + 128 + 8 * dg) = (v4u){dg == 0 ? 0x00003f80u : 0u, 0u, 0u, 0u};
            if (c + 1 < SEQ / 128) ML_FETCH(t0 + 128);
        }
        __syncthreads();
        float Mi[4], ai[4], rri[4];
#pragma unroll
        for (int r = 0; r < 4; ++r) { const int i = 16 * w + 4 * g + r; rri[r] = rstd1[t0 + i]; const float pmi = (w < 4) ? __shfl(pm0, i & 63) : __shfl(pm1, i & 63); ai[r] = (w < 4) ? __shfl(a0, i & 63) : __shfl(a1, i & 63); Mi[r] = fmaxf(pmi, m_prev); }
        bf16x8 aq[2];
#pragma unroll
        for (int s = 0; s < 2; ++s) aq[s] = frag_row(Qm, LK, 16 * w, 32 * s, lane);
        f32x4 acco[9];
#pragma unroll
        for (int n = 0; n < 9; ++n) acco[n] = (f32x4){0.f, 0.f, 0.f, 0.f};
#pragma unroll
        for (int s = 0; s < 2; ++s) {
#pragma unroll
          for (int hf = 0; hf < 2; ++hf) { bf16x8 bb[5];
#pragma unroll
            for (int n = 0; n < 5 - hf; ++n) bb[n] = frag_tr(Cm, LV, 32 * s, 16 * (5 * hf + n), lane);
            SCHED_FENCE();
#pragma unroll
            for (int n = 0; n < 5 - hf; ++n) acco[5 * hf + n] = MFMA16(aq[s], bb[n], acco[5 * hf + n]); } }
        { float si[4];
#pragma unroll
          for (int r = 0; r < 4; ++r) si[r] = __expf(m_prev - Mi[r]) * rri[r];
#pragma unroll
          for (int n = 0; n < 9; ++n)
#pragma unroll
            for (int r = 0; r < 4; ++r) acco[n][r] *= si[r]; }
        LDS_FENCE();
#pragma unroll
        for (int n = 0; n < 8; ++n) {
            if (n <= w) { f32x4 sa = (f32x4){0.f, 0.f, 0.f, 0.f}; bf16x8 bb[2];
#pragma unroll
                for (int s = 0; s < 2; ++s) bb[s] = frag_row(Km, LK, 16 * n, 32 * s, lane);
                SCHED_FENCE();
#pragma unroll
                for (int s = 0; s < 2; ++s) sa = MFMA16(aq[s], bb[s], sa);
                const int j = 16 * n + i16; const float bj = (n < 4) ? __shfl(b0, j & 63) : __shfl(b1, j & 63);
#pragma unroll
                for (int r = 0; r < 4; ++r) { const int i = 16 * w + 4 * g + r; Pm[i * LQ + j] = (bf16)f2bf(j <= i ? sa[r] * rri[r] * __expf(bj - Mi[r]) : 0.f); } }
            else if (n == w + 1) {
#pragma unroll
                for (int r = 0; r < 4; ++r) Pm[(16 * w + 4 * g + r) * LQ + 16 * n + i16] = (bf16)0; }
        }
        LDS_FENCE();
#pragma unroll
        for (int s = 0; s < 4; ++s) if (s <= (w >> 1)) { const bf16x8 ap = frag_row(Pm, LQ, 16 * w, 32 * s, lane);
#pragma unroll
          for (int hf = 0; hf < 2; ++hf) { bf16x8 bb[5];
#pragma unroll
            for (int n = 0; n < 5 - hf; ++n) bb[n] = frag_tr(Vm, LV, 32 * s, 16 * (5 * hf + n), lane);
            SCHED_FENCE();
#pragma unroll
            for (int n = 0; n < 5 - hf; ++n) acco[5 * hf + n] = MFMA16(ap, bb[n], acco[5 * hf + n]); } }
#pragma unroll
        for (int k = 0; k < 5; ++k) accC[k] = accC[k] * s_old;
#pragma unroll
        for (int s = 0; s < 4; ++s) { const bf16x8 ak = frag_tr(Kw, LK, 32 * s, 16 * dt, lane); bf16x8 bb[5];
#pragma unroll
            for (int k = 0; k < 5; ++k) bb[k] = frag_tr(Vm, LV, 32 * s, 16 * (5 * eh + k), lane);
            SCHED_FENCE();
#pragma unroll
            for (int k = 0; k < 5; ++k) accC[k] = MFMA16(ak, bb[k], accC[k]); }
        LDS_FENCE();
        __syncthreads();
#pragma unroll
        for (int k = 0; k < 5; ++k)
#pragma unroll
            for (int r = 0; r < 4; ++r) Cm[(16 * dt + 4 * g + r) * LV + 16 * (5 * eh + k) + i16] = (bf16)f2bf(accC[k][r]);
#pragma unroll
        for (int r = 0; r < 4; ++r) {
            const float den = __shfl(acco[8][r], lane & 48);
            const float dd = 1.0f / fmaxf(fabsf(den), __expf(-(ai[r] + Mi[r])));
            float q = 0.f;
#pragma unroll
            for (int n = 0; n < 8; ++n) { acco[n][r] *= dd; q += acco[n][r] * acco[n][r]; }
            const float rstd = rsqrtf(red16_sum(q) * (1.f / 128.f) + 1e-6f);
            const int pos = t0 + 16 * w + 4 * g + r; const bf16* gr = zb + (size_t)pos * NZ + Z_MO + h * 128; bf16* yr = yb + (size_t)pos * 1024;
#pragma unroll
            for (int n = 0; n < 8; ++n) { const int e = 16 * n + i16; yr[e] = (bf16)f2bf(acco[n][r] * rstd * nw[h * 128 + e] * sigm(bf1(gr[e]) * rri[r])); }
        }
        m_prev = m_new;
    }
    __syncthreads();
#undef ML_FETCH
}
template <int CTRL> __device__ __forceinline__ float dppf(float v) { return __builtin_bit_cast(float, __builtin_amdgcn_update_dpp(0, __builtin_bit_cast(int, v), CTRL, 0xf, 0xf, true)); }
__device__ __forceinline__ float r16max(float v) { v = fmaxf(v, dppf<0xB1>(v)); v = fmaxf(v, dppf<0x4E>(v)); v = fmaxf(v, dppf<0x141>(v)); v = fmaxf(v, dppf<0x140>(v)); return v; }
__device__ __forceinline__ float r16sum(float v) { v += dppf<0xB1>(v); v += dppf<0x4E>(v); v += dppf<0x141>(v); v += dppf<0x140>(v); return v; }
__device__ __forceinline__ void moba_unit(Frame& F, int b, int h, int qi) {
    LAS bf16* Kt = (LAS bf16*)(F.lds); LAS bf16* Vt = Kt + 128 * LQ; LAS bf16* Pm = Vt + 128 * 128;
    const int tid = F.tid, lane = F.lane, w = tid >> 6, i16 = lane & 15, g = lane >> 4;
    const int blk = qi >> 1, qt = qi & 1, q0 = qi * 128;
    const bf16* zb = WSP(bf16, WS_Z) + (size_t)(b * SEQ) * NZ + h * 128;
    bf16x8 aq[4];
    { const bf16* qr = zb + (size_t)(q0 + 16 * w + i16) * NZ + Z_AQ + 8 * g;
#pragma unroll
      for (int s = 0; s < 4; ++s) aq[s] = *(const bf16x8*)(qr + 32 * s); }
    unsigned sel = 0u;
    {
        float gate[8];
        const float* km = WSP(float, WS_KMEAN) + (size_t)((b * NH + h) * 16) * 128 + 8 * g;
#pragma unroll
        for (int n = 0; n < 8; ++n) { gate[n] = -INFINITY;
            if (n < blk) { float p = 0.f;
#pragma unroll
                for (int s = 0; s < 4; ++s) { const f32x4 k0 = *(const f32x4*)(km + n * 256 + 32 * s) + *(const f32x4*)(km + n * 256 + 128 + 32 * s), k1 = *(const f32x4*)(km + n * 256 + 32 * s + 4) + *(const f32x4*)(km + n * 256 + 128 + 32 * s + 4);
                    p += bf1((bf16)aq[s][0]) * k0.x + bf1((bf16)aq[s][1]) * k0.y + bf1((bf16)aq[s][2]) * k0.z + bf1((bf16)aq[s][3]) * k0.w
                       + bf1((bf16)aq[s][4]) * k1.x + bf1((bf16)aq[s][5]) * k1.y + bf1((bf16)aq[s][6]) * k1.z + bf1((bf16)aq[s][7]) * k1.w; }
                p += __shfl_xor(p, 16); p += __shfl_xor(p, 32); gate[n] = p; } }
#pragma unroll
        for (int s = 0; s < 3; ++s) { float bv = -INFINITY; int best = -1;
#pragma unroll
            for (int n = 0; n < 8; ++n) { const bool c = !((sel >> n) & 1u) && gate[n] > bv; bv = c ? gate[n] : bv; best = c ? n : best; }
            if (best >= 0) sel |= 1u << best; }
    }
    unsigned rsel[4];
#pragma unroll
    for (int r = 0; r < 4; ++r) rsel[r] = (unsigned)__shfl((int)sel, 4 * g + r);
#pragma unroll
    for (int s = 0; s < 4; ++s) { const v4u u = __builtin_bit_cast(v4u, aq[s]); const float c2 = 0.08838834764831845f * 1.4426950408889634f;
        const v4u o = (v4u){pk2(bflo(u.x) * c2, bfhi(u.x) * c2), pk2(bflo(u.y) * c2, bfhi(u.y) * c2), pk2(bflo(u.z) * c2, bfhi(u.z) * c2), pk2(bflo(u.w) * c2, bfhi(u.w) * c2)}; aq[s] = __builtin_bit_cast(bf16x8, o); }
    f32x4 acco[8];
#pragma unroll
    for (int n = 0; n < 8; ++n) acco[n] = (f32x4){0.f, 0.f, 0.f, 0.f};
    float mrow[4], lrow[4];
#pragma unroll
    for (int r = 0; r < 4; ++r) { mrow[r] = -1e30f; lrow[r] = 0.f; }
    const int ntiles = 2 * blk + qt + 1;
    const int lr = tid >> 2, dg = tid & 3, vrow = 8 * (lr & 15) + (lr >> 4);
    v4u pk[4], pv[4];
#define MB_FETCH(k0_) do { const bf16* zr_ = zb + (size_t)((k0_) + lr) * NZ + 32 * dg; \
        _Pragma("unroll") for (int q_ = 0; q_ < 4; ++q_) { pk[q_] = *(const v4u*)(zr_ + Z_AK + 8 * q_); pv[q_] = *(const v4u*)(zr_ + Z_AV + 8 * q_); } } while (0)
    MB_FETCH(0);
    for (int kt = 0; kt < ntiles; ++kt) {
        const int k0 = kt * 128, kb = kt >> 1; const bool own = (kb == blk), diag = (kt == 2 * blk + qt);
        __syncthreads();
#pragma unroll
        for (int q = 0; q < 4; ++q) { *(LAS v4u*)(Kt + lr * LQ + 32 * dg + 8 * q) = pk[q]; *(LAS v4u*)(Vt + trs_off(vrow, 4 * dg + q)) = pv[q]; }
        if (kt + 1 < ntiles) MB_FETCH(k0 + 128);
        __syncthreads();
        f32x4 sc[8];
#pragma unroll
        for (int n = 0; n < 8; ++n) sc[n] = (f32x4){0.f, 0.f, 0.f, 0.f};
#pragma unroll
        for (int s = 0; s < 4; ++s) { bf16x8 bb[8];
#pragma unroll
            for (int n = 0; n < 8; ++n) bb[n] = frag_row(Kt, LQ, 16 * n, 32 * s, lane);
            SCHED_FENCE();
#pragma unroll
            for (int n = 0; n < 8; ++n) sc[n] = MFMA16(aq[s], bb[n], sc[n]); }
#pragma unroll
        for (int r = 0; r < 4; ++r) {
            if (diag) { const int qrel = 16 * w + 4 * g + r - i16;
#pragma unroll
                for (int n = 0; n < 8; ++n) sc[n][r] = (16 * n <= qrel) ? sc[n][r] : -1e30f; }
            const bool rowok = own || ((rsel[r] >> kb) & 1u);
            float mx = fmaxf(fmaxf(fmaxf(sc[0][r], sc[1][r]), fmaxf(sc[2][r], sc[3][r])), fmaxf(fmaxf(sc[4][r], sc[5][r]), fmaxf(sc[6][r], sc[7][r])));
            mx = r16max(mx);
            const float mnew = rowok ? fmaxf(mrow[r], mx) : mrow[r];
            const float alpha = __builtin_amdgcn_exp2f(mrow[r] - mnew); mrow[r] = mnew;
            const float msub = rowok ? mnew : 1e30f;
            float p[8], ps = 0.f;
#pragma unroll
            for (int n = 0; n < 8; ++n) { p[n] = __builtin_amdgcn_exp2f(sc[n][r] - msub); ps += p[n]; }
            lrow[r] = lrow[r] * alpha + ps;
            *(LAS v4u*)(Pm + (16 * w + 4 * g + r) * LQ + 8 * i16) = (v4u){pk2(p[0], p[1]), pk2(p[2], p[3]), pk2(p[4], p[5]), pk2(p[6], p[7])};
#pragma unroll
            for (int n = 0; n < 8; ++n) acco[n][r] *= alpha;
        }
        LDS_FENCE();
#pragma unroll
        for (int s = 0; s < 4; ++s) { const bf16x8 ap = frag_row(Pm, LQ, 16 * w, 32 * s, lane); bf16x8 bb[8];
#pragma unroll
            for (int n = 0; n < 8; ++n) bb[n] = frag_trs(Vt, 32 * s, 16 * n, lane);
            SCHED_FENCE();
#pragma unroll
            for (int n = 0; n < 8; ++n) acco[n] = MFMA16(ap, bb[n], acco[n]); }
        LDS_FENCE();
    }
    bf16* yb = WSP(bf16, WS_Y) + (size_t)2 * M * 1024 + (size_t)(b * SEQ + q0) * 1024 + h * 128;
#pragma unroll
    for (int r = 0; r < 4; ++r) { const float inv = 1.0f / r16sum(lrow[r]); bf16* yr = yb + (size_t)(16 * w + 4 * g + r) * 1024;
#pragma unroll
        for (int n = 0; n < 8; ++n) yr[16 * n + i16] = (bf16)f2bf(acco[n][r] * inv); }
#undef MB_FETCH
}
__device__ __forceinline__ void mix_phase(Frame& F, const float* rgn, const float* mln, unsigned* head) {
    volatile LAS unsigned* slot = F.MISC;
    for (;;) {
        if (F.tid == 0) slot[0] = __hip_atomic_fetch_add(head, 1u, __ATOMIC_RELAXED, __HIP_MEMORY_SCOPE_AGENT);
        __syncthreads();
        const unsigned it = slot[0];
        __syncthreads();
        if (it >= 128u + 1024u) break;
        { int t_ = threadIdx.x; asm volatile("" : "+v"(t_)); F.tid = t_; F.lane = t_ & 63; }
        if (it < 64u) ret_unit(F, rgn, (int)(it >> 3), (int)(it & 7u));
        else if (it < 128u) mlstm_unit(F, mln, (int)((it - 64u) >> 3), (int)(it & 7u));
        else { const unsigned rank = it - 128u; moba_unit(F, (int)((rank & 63u) >> 3), (int)(rank & 7u), 15 - (int)(rank >> 6)); }
    }
}
}
constexpr int N_PHASES = 1 + 8 * DEPTH;
__global__ void __launch_bounds__(NWAVES * 64, 2) fwd(Args args) {
    extern __shared__ __attribute__((aligned(16))) unsigned char lds[];
    Frame F;
    F.lds = (LAS unsigned char*)lds;
    F.MISC = (volatile LAS unsigned*)(F.lds + MISC_OFF);
    F.tid = threadIdx.x; F.lane = F.tid & 63; F.wave = __builtin_amdgcn_readfirstlane(F.tid >> 6); F.G = gridDim.x; F.bx = blockIdx.x;
    F.ws = args.ws;
    for (int u = F.tid; u < (LDS_BYTES - LDSCTL_OFF) / 4; u += NWAVES * 64) ((LAS unsigned*)(F.lds + LDSCTL_OFF))[u] = 0u;
    __syncthreads();
    XcdBarrier bar = xcd_barrier_post((unsigned*)(F.ws + WS_CTL) + CW_BAR + args.li * XCD_BAR_WORDS, F.MISC + 8);
    const int lo = args.ph_lo, hi = args.ph_hi;
#define RUN(p) (lo <= (p) && (p) < hi)
#define SEAM(p) do { if ((p) + 1 < hi) xcd_barrier(bar); } while (0)
    if (RUN(0)) { p0_prologue(F, args); SEAM(0); }
    for (int l = 0; l < DEPTH; ++l) {
        const int p0 = 1 + 8 * l;
        { int t_ = threadIdx.x; asm volatile("" : "+v"(t_)); F.tid = t_; F.lane = t_ & 63; F.wave = __builtin_amdgcn_readfirstlane(t_ >> 6); int b_ = blockIdx.x; asm volatile("" : "+s"(b_)); F.bx = b_; }
        float* rs = WSP(float, WS_RS) + (size_t)(2 * l) * M * 32;
        if (RUN(p0 + 0)) {
            pg8::Gemm g{WSP(bf16, WS_XB), WSP(bf16, WS_WIN) + (size_t)l * NZ * DM, M, NZ, DM}; pg8::StaticOrder S; S.init(M, NZ, F.G, F.bx);
            pg8::EpiBf16 E{WSP(bf16, WS_Z), NZ, F.ws + WS_ZG, Z_GA / 256, 3 * DM};
            pg8::gemm_phase<pg8::EpiBf16, pg8::StaticOrder, false, true>(F.lds + RING_OFF, g, S, E);
            SEAM(p0 + 0); }
        if (RUN(p0 + 1)) { prep_phase(F, args.in[I_QN] + l * 128, args.in[I_KN] + l * 128, WSP(bf16, WS_W16G) + (size_t)l * 16 * DM, rs, args.in[I_BIG] + l * 8, args.in[I_BFG] + l * 8); SEAM(p0 + 1); }
        if (RUN(p0 + 2)) { mx::mix_phase(F, args.in[I_RGN] + l * 1024, args.in[I_MLN] + l * 1024, (unsigned*)(F.ws + WS_CTL) + CW_QUEUE + 64 * l); SEAM(p0 + 2); }
        if (RUN(p0 + 3)) {
            pg8::StaticOrder3 S; S.init(M, DM, F.G, F.bx);
            pg8::Gemm g{WSP(bf16, WS_Y), WSP(bf16, WS_WP) + (size_t)l * 3 * DM * 1024, M, DM, 1024, (size_t)M * 1024, (size_t)DM * 1024}; pg8::EpiGateAcc E{WSP(bf16, WS_MG), DM, F.ws + WS_ZG, 3 * DM, WSP(float, WS_RSTD)};
            pg8::gemm_phase<pg8::EpiGateAcc, pg8::StaticOrder3, true, true>(F.lds + RING_OFF, g, S, E);
            SEAM(p0 + 3); }
        if (RUN(p0 + 4)) {
            pg8::Gemm g{WSP(bf16, WS_MG), WSP(bf16, WS_WOUT) + (size_t)l * DM * DM, M, DM, DM}; pg8::StaticOrder S; S.init(M, DM, F.G, F.bx);
            pg8::EpiRes<false> E{WSP(bf16, WS_XB), rs + (size_t)32 * M, nullptr, DM};
            pg8::gemm_phase<pg8::EpiRes<false>, pg8::StaticOrder, true, true>(F.lds + RING_OFF, g, S, E);
            SEAM(p0 + 4); }
        if (RUN(p0 + 5)) {
            pg8::Gemm g{WSP(bf16, WS_XB), WSP(bf16, WS_WUP) + (size_t)l * NUP * DM, M, NUP, DM}; pg8::StaticOrder S; S.init(M, NUP, F.G, F.bx);
            pg8::EpiBf16 E{WSP(bf16, WS_Z), NUP, nullptr, -1, 0};
            pg8::gemm_phase<pg8::EpiBf16, pg8::StaticOrder, false, true>(F.lds + RING_OFF, g, S, E);
            SEAM(p0 + 5); }
        if (RUN(p0 + 6)) { glu_phase(F, args.in[I_CW] + (size_t)l * 3 * NUP, args.in[I_CB] + (size_t)l * NUP, rs + (size_t)32 * M); SEAM(p0 + 6); }
        if (RUN(p0 + 7)) {
            pg8::Gemm g{WSP(bf16, WS_ACT), WSP(bf16, WS_WDN) + (size_t)l * DM * DFF, M, DM, DFF}; pg8::StaticOrder S; S.init(M, DM, F.G, F.bx);
            if (l + 1 < DEPTH) { pg8::EpiRes<false> E{WSP(bf16, WS_XB), rs + (size_t)64 * M, nullptr, DM};
                pg8::gemm_phase<pg8::EpiRes<false>, pg8::StaticOrder, true, true>(F.lds + RING_OFF, g, S, E); }
            else { pg8::EpiRes<true> E{WSP(bf16, WS_XB), nullptr, args.out, DM};
                pg8::gemm_phase<pg8::EpiRes<true>, pg8::StaticOrder, true, true>(F.lds + RING_OFF, g, S, E); }
            SEAM(p0 + 7); }
    }
#undef RUN
#undef SEAM
}

#ifndef MK_N_LAUNCHES
#define MK_N_LAUNCHES 1
#endif
extern "C" void kernel_launch(void* const* d_in, const int* in_sizes, int n_in, void* d_out, int out_size, void* d_ws, size_t ws_size, hipStream_t stream) {
    static int grid = 0;
    if (grid == 0) {
        if (n_in != 18 || in_sizes[0] != M * DM || out_size != M * DM || ws_size < WS_END) { fprintf(stderr, "kernel_launch: unexpected shapes (n_in %d, in0 %d, out %d, ws %zu)\n", n_in, n_in > 0 ? in_sizes[0] : -1, out_size, ws_size); grid = -1; return; }
        int dev = 0, cus = 0, per_cu = 0;
        if (hipGetDevice(&dev) != hipSuccess || hipDeviceGetAttribute(&cus, hipDeviceAttributeMultiprocessorCount, dev) != hipSuccess) { grid = -1; return; }
        if (hipFuncSetAttribute((const void*)fwd, hipFuncAttributeMaxDynamicSharedMemorySize, LDS_BYTES) != hipSuccess) { fprintf(stderr, "kernel_launch: hipFuncSetAttribute failed\n"); grid = -1; return; }
        if (hipOccupancyMaxActiveBlocksPerMultiprocessor(&per_cu, (const void*)fwd, NWAVES * 64, LDS_BYTES) != hipSuccess || per_cu < 1) fprintf(stderr, "kernel_launch: occupancy query reports %d\n", per_cu);
        (void)hipGetLastError();
        grid = cus;
    }
    if (grid < 0) return;
    if (hipMemsetAsync((char*)d_ws + WS_CTL, 0, CTL_ZERO_BYTES, stream) != hipSuccess) return;
    Args a{};
    for (int i = 0; i < 18; ++i) a.in[i] = (const float*)d_in[i];
    a.out = (float*)d_out; a.ws = (unsigned char*)d_ws; a.pad = 0;
    constexpr int NL = MK_N_LAUNCHES;
    for (int li = 0; li < NL; ++li) {
        a.ph_lo = (NL == 1) ? 0 : li; a.ph_hi = (NL == 1) ? N_PHASES : li + 1; a.li = (NL == 1) ? 0 : 0;
        hipLaunchKernelGGL(fwd, dim3(grid), dim3(NWAVES * 64), LDS_BYTES, stream, a);
    }
}
```

```cpp
#include <hip/hip_runtime.h>
#include <cstdio>
#include <cstdint>
namespace pg8 {
#define PG8_LAS __attribute__((address_space(3)))
typedef unsigned short bf16_t;
typedef short bf16x8 __attribute__((ext_vector_type(8)));
typedef float f32x4 __attribute__((ext_vector_type(4)));
typedef unsigned u32x4 __attribute__((ext_vector_type(4)));
constexpr int BM = 256, BK = 64, HALF = 128, HTB = HALF * BK * 2  , STAGE_BYTES = 8 * HTB, NXCD = 8, WGM = 8;

__host__ __device__ __forceinline__ int lds_byte(int r, int c) { const int st = (r >> 4) * 2 + (c >> 5), rr = r & 15, cc = c & 31, ob = rr * 64 + cc * 2; return st * 1024 + (ob ^ (((ob >> 9) & 1) << 5)); }
__host__ __device__ __forceinline__ void stage_rc(int b, int& R, int& C) { const int st = b / 1024, sb = b % 1024, swz = sb ^ (((sb >> 9) & 1) << 5); R = (st >> 1) * 16 + swz / 64; C = (st & 1) * 32 + (swz % 64) / 2; }
__host__ __device__ __forceinline__ int perm32(int rho) { const int n = rho >> 4, i = rho & 15; return 8 * (i >> 2) + 4 * n + (i & 3); }

struct Unit { int pm, pn, z; };
struct Gemm { const bf16_t* A; const bf16_t* Bt; int M, N, K; size_t zA, zB; };

struct StaticOrder {
    int nM, nN, nwg, G, c;
    __host__ __device__ void init(int M, int N, int G_, int c_) { nM = M / BM; nN = N / BM; nwg = nM * nN; G = G_; c = c_; }
    __host__ __device__ bool next(int i, Unit& u) const {
        const long L = (long)i * G + c; if (L >= nwg) return false;
        int wgid = (int)L; { const int q = nwg / NXCD, r = nwg % NXCD, xcd = wgid % NXCD, off = wgid / NXCD; wgid = (xcd < r ? xcd * (q + 1) : r * (q + 1) + (xcd - r) * q) + off; }
        const int nig = WGM * nN, gid = wgid / nig, fm = gid * WGM, gsz = (nM - fm) < WGM ? (nM - fm) : WGM;
        u.pm = fm + ((wgid % nig) % gsz); u.pn = (wgid % nig) / gsz; u.z = 0; return true;
    }
    __device__ __forceinline__ void a_ready(const Unit&) const {}
    __device__ __forceinline__ void done(const Unit&) const {}
};

struct StaticOrder3 : StaticOrder {
    __host__ __device__ bool next(int i, Unit& u) const { if (!StaticOrder::next(i / 3, u)) return false; u.z = i % 3; return true; }
};
__device__ __forceinline__ unsigned cvt_pk_bf16(float lo, float hi) { unsigned r; asm volatile("v_cvt_pk_bf16_f32 %0, %1, %2" : "=v"(r) : "v"(lo), "v"(hi)); return r; }
typedef unsigned u32x2 __attribute__((ext_vector_type(2)));
struct EpiBf16 {
    static constexpr bool PERM = true, AFTER_DRAIN = false, KEEP = false;
    bf16_t* O; int ldc; unsigned char* G8; int g8_pn0, g8_ld;
    __device__ __forceinline__ void operator()(const f32x4 (&acc)[2][2][4][2], const Unit& u, int wr, int wc, int fr, int fq) const {
        const int row0 = u.pm * BM + wr * 64 + fr; const int col0 = u.pn * BM + wc * 32 + 8 * fq;
        if (g8_pn0 >= 0 && u.pn >= g8_pn0) { const int gc0 = (u.pn - g8_pn0) * BM + wc * 32 + 8 * fq;
#pragma unroll
            for (int ai = 0; ai < 2; ++ai)
#pragma unroll
                for (int m = 0; m < 4; ++m) { unsigned char* rowp = G8 + (size_t)(row0 + ai * HALF + m * 16) * g8_ld + gc0;
#pragma unroll
                    for (int bj = 0; bj < 2; ++bj) { const f32x4 v0 = acc[ai][bj][m][0], v1 = acc[ai][bj][m][1]; u32x2 w;
                        w.x = (unsigned)__builtin_amdgcn_cvt_pk_fp8_f32(v0[2], v0[3], __builtin_amdgcn_cvt_pk_fp8_f32(v0[0], v0[1], 0, false), true);
                        w.y = (unsigned)__builtin_amdgcn_cvt_pk_fp8_f32(v1[2], v1[3], __builtin_amdgcn_cvt_pk_fp8_f32(v1[0], v1[1], 0, false), true);
                        *(u32x2*)(rowp + bj * HALF) = w; } }
            return; }
#pragma unroll
        for (int ai = 0; ai < 2; ++ai)
#pragma unroll
            for (int m = 0; m < 4; ++m) { bf16_t* rowp = O + (size_t)(row0 + ai * HALF + m * 16) * ldc + col0;
#pragma unroll
                for (int bj = 0; bj < 2; ++bj) { const f32x4 v0 = acc[ai][bj][m][0], v1 = acc[ai][bj][m][1];
                    u32x4 w; w.x = cvt_pk_bf16(v0[0], v0[1]); w.y = cvt_pk_bf16(v0[2], v0[3]); w.z = cvt_pk_bf16(v1[0], v1[1]); w.w = cvt_pk_bf16(v1[2], v1[3]);
                    *(u32x4*)(rowp + bj * HALF) = w; } }
    }
};
__device__ __forceinline__ float bf_lo(unsigned w) { return __uint_as_float(w << 16); }
__device__ __forceinline__ float bf_hi(unsigned w) { return __uint_as_float(w & 0xffff0000u); }
__device__ __forceinline__ float sigmoid_f(float x) { return __builtin_amdgcn_rcpf(1.0f + __expf(-x)); }
struct EpiGateAcc {
    static constexpr bool PERM = true, AFTER_DRAIN = false, KEEP = true;
    bf16_t* O; int ldc; const unsigned char* G8; int g8_ld; const float* rstd;
    template <int E> static __device__ __forceinline__ float g8f(const u32x2 w) { return __builtin_amdgcn_cvt_f32_fp8((int)(E < 4 ? w.x : w.y), E & 3); }
    static __device__ __forceinline__ float em(float g, float rr) { return __expf(-fminf(fmaxf(g * rr, -40.f), 40.f)); }
    __device__ __forceinline__ void operator()(f32x4 (&acc)[2][2][4][2], const Unit& u, int wr, int wc, int fr, int fq) const {
        const int row0 = u.pm * BM + wr * 64 + fr; const int col0 = u.pn * BM + wc * 32 + 8 * fq; const bool last = (u.z == 2);
        const unsigned char* Gn = G8 + (size_t)u.z * ldc; const unsigned char* Gd = G8 + (size_t)(last ? u.z : u.z + 1) * ldc;
#pragma unroll
        for (int ai = 0; ai < 2; ++ai)
#pragma unroll
            for (int m = 0; m < 4; ++m) { const size_t row = (size_t)(row0 + ai * HALF + m * 16); const float rr = rstd[row];
#pragma unroll
                for (int bj = 0; bj < 2; ++bj) { f32x4& v0 = acc[ai][bj][m][0]; f32x4& v1 = acc[ai][bj][m][1];
                    const u32x2 gn = *(const u32x2*)(Gn + row * g8_ld + col0 + bj * HALF);
                    const float n0 = em(g8f<0>(gn), rr), n1 = em(g8f<1>(gn), rr), n2 = em(g8f<2>(gn), rr), n3 = em(g8f<3>(gn), rr), n4 = em(g8f<4>(gn), rr), n5 = em(g8f<5>(gn), rr), n6 = em(g8f<6>(gn), rr), n7 = em(g8f<7>(gn), rr);
                    if (!last) { const u32x2 gd = *(const u32x2*)(Gd + row * g8_ld + col0 + bj * HALF);
                        v0[0] *= (1.0f + em(g8f<0>(gd), rr)) * __builtin_amdgcn_rcpf(1.0f + n0); v0[1] *= (1.0f + em(g8f<1>(gd), rr)) * __builtin_amdgcn_rcpf(1.0f + n1);
                        v0[2] *= (1.0f + em(g8f<2>(gd), rr)) * __builtin_amdgcn_rcpf(1.0f + n2); v0[3] *= (1.0f + em(g8f<3>(gd), rr)) * __builtin_amdgcn_rcpf(1.0f + n3);
                        v1[0] *= (1.0f + em(g8f<4>(gd), rr)) * __builtin_amdgcn_rcpf(1.0f + n4); v1[1] *= (1.0f + em(g8f<5>(gd), rr)) * __builtin_amdgcn_rcpf(1.0f + n5);
                        v1[2] *= (1.0f + em(g8f<6>(gd), rr)) * __builtin_amdgcn_rcpf(1.0f + n6); v1[3] *= (1.0f + em(g8f<7>(gd), rr)) * __builtin_amdgcn_rcpf(1.0f + n7); }
                    else { u32x4 w;
                        w.x = cvt_pk_bf16(v0[0] * __builtin_amdgcn_rcpf(1.0f + n0), v0[1] * __builtin_amdgcn_rcpf(1.0f + n1)); w.y = cvt_pk_bf16(v0[2] * __builtin_amdgcn_rcpf(1.0f + n2), v0[3] * __builtin_amdgcn_rcpf(1.0f + n3));
                        w.z = cvt_pk_bf16(v1[0] * __builtin_amdgcn_rcpf(1.0f + n4), v1[1] * __builtin_amdgcn_rcpf(1.0f + n5)); w.w = cvt_pk_bf16(v1[2] * __builtin_amdgcn_rcpf(1.0f + n6), v1[3] * __builtin_amdgcn_rcpf(1.0f + n7));
                        *(u32x4*)(O + row * ldc + col0 + bj * HALF) = w; } } }
    }
};
template <bool LAST> struct EpiRes {
    static constexpr bool PERM = true, AFTER_DRAIN = false, KEEP = false;
    bf16_t* xb; float* rs; float* out; int ldc;
    __device__ __forceinline__ void operator()(const f32x4 (&acc)[2][2][4][2], const Unit& u, int wr, int wc, int fr, int fq) const {
        const int row0 = u.pm * BM + wr * 64 + fr; const int col0 = u.pn * BM + wc * 32 + 8 * fq;
#pragma unroll
        for (int ai = 0; ai < 2; ++ai)
#pragma unroll
            for (int m = 0; m < 4; ++m) { const int row = row0 + ai * HALF + m * 16; const size_t off = (size_t)row * ldc + col0; float sq = 0.f;
#pragma unroll
                for (int bj = 0; bj < 2; ++bj) { const u32x4 p = *(const u32x4*)(xb + off + bj * HALF); const f32x4 v0 = acc[ai][bj][m][0], v1 = acc[ai][bj][m][1];
                    const float o0 = bf_lo(p.x) + v0[0], o1 = bf_hi(p.x) + v0[1], o2 = bf_lo(p.y) + v0[2], o3 = bf_hi(p.y) + v0[3], o4 = bf_lo(p.z) + v1[0], o5 = bf_hi(p.z) + v1[1], o6 = bf_lo(p.w) + v1[2], o7 = bf_hi(p.w) + v1[3];
                    if (LAST) { *(f32x4*)(out + off + bj * HALF) = (f32x4){o0, o1, o2, o3}; *(f32x4*)(out + off + bj * HALF + 4) = (f32x4){o4, o5, o6, o7}; }
                    else { sq += ((o0 * o0 + o1 * o1) + (o2 * o2 + o3 * o3)) + ((o4 * o4 + o5 * o5) + (o6 * o6 + o7 * o7));
                        u32x4 w; w.x = cvt_pk_bf16(o0, o1); w.y = cvt_pk_bf16(o2, o3); w.z = cvt_pk_bf16(o4, o5); w.w = cvt_pk_bf16(o6, o7); *(u32x4*)(xb + off + bj * HALF) = w; } }
                if (!LAST) { sq += __shfl_xor(sq, 16); sq += __shfl_xor(sq, 32); if (fq == 0) rs[(size_t)row * 32 + u.pn * 4 + wc] = sq; } }
    }
};

template <class Epi, class Sched, bool ALIGN_EPI = false, bool SP2 = false>
__device__ __forceinline__ void gemm_phase(PG8_LAS unsigned char* lds, const Gemm g, const Sched& S, const Epi& E) {
    int tid_ = threadIdx.x; asm volatile("" : "+v"(tid_));
    const int tid = tid_, wid = __builtin_amdgcn_readfirstlane(tid >> 6), lane = tid & 63, wr = wid >> 2, wc = wid & 3, fr = lane & 15, fq = lane >> 4;
    const int K = g.K, nt = K / BK;
    unsigned voffA[2], voffB[2];
#pragma unroll
    for (int i = 0; i < 2; ++i) { int R, C; stage_rc(tid * 16 + i * 8192, R, C); const int Rb = Epi::PERM ? ((R & ~31) + perm32(R & 31)) : R;
        voffA[i] = (unsigned)(R * K + C) * 2u; voffB[i] = (unsigned)(Rb * K + C) * 2u; }
    const size_t kstep = (size_t)(BK * 2);
    const size_t hstep = (size_t)HALF * K * 2;
    const size_t tstep = 2 * hstep;
    const unsigned ldsw = (unsigned)wid * 1024u;
    const int aoff = lds_byte(wr * 64 + fr, fq * 8), boff = lds_byte(wc * 32 + fr, fq * 8);
#define PG8_SA(b, h) (((b) * 2 + (h)) * HTB)
#define PG8_SB(b, h) ((4 + (b) * 2 + (h)) * HTB)
#define PG8_STAGE(bufoff, gbase, voff) do { _Pragma("unroll") for (int _i = 0; _i < 2; ++_i) \
        __builtin_amdgcn_global_load_lds((const unsigned*)((const char*)(gbase) + (voff)[_i]), (PG8_LAS unsigned*)(lds + (bufoff) + ldsw + _i * 8192), 16, 0, 0); } while (0)
#define PG8_LDA(dst, b, h) do { _Pragma("unroll") for (int m = 0; m < 4; ++m) _Pragma("unroll") for (int k = 0; k < 2; ++k) dst[m][k] = *(const PG8_LAS bf16x8*)(lds + PG8_SA(b, h) + aoff + m * 2048 + k * 1024); } while (0)
#define PG8_LDB(dst, b, h) do { _Pragma("unroll") for (int n = 0; n < 2; ++n) _Pragma("unroll") for (int k = 0; k < 2; ++k) dst[n][k] = *(const PG8_LAS bf16x8*)(lds + PG8_SB(b, h) + boff + n * 2048 + k * 1024); } while (0)
#define PG8_MMA(ai, bj, At, Bt) do { __builtin_amdgcn_s_setprio(1); _Pragma("unroll") for (int m = 0; m < 4; ++m) _Pragma("unroll") for (int n = 0; n < 2; ++n) _Pragma("unroll") for (int k = 0; k < 2; ++k) \
        acc[ai][bj][m][n] = __builtin_amdgcn_mfma_f32_16x16x32_bf16(Bt[n][k], At[m][k], acc[ai][bj][m][n], 0, 0, 0); __builtin_amdgcn_s_setprio(0); } while (0)
#define PG8_WAIT_V(n) asm volatile("s_waitcnt vmcnt(" #n ")" ::: "memory")
#define PG8_WAIT_L(n) asm volatile("s_waitcnt lgkmcnt(" #n ")" ::: "memory")
#define PG8_BAR __builtin_amdgcn_s_barrier()
#define PG8_SCHED __builtin_amdgcn_sched_barrier(0)
    Unit cur, nxt; int ui = 0;
    if (!S.next(0, cur)) return;
    f32x4 acc[2][2][4][2];
#pragma unroll
    for (int a = 0; a < 2; ++a)
#pragma unroll
        for (int b = 0; b < 2; ++b)
#pragma unroll
            for (int m = 0; m < 4; ++m)
#pragma unroll
                for (int n = 0; n < 2; ++n) acc[a][b][m][n] = (f32x4){0.f, 0.f, 0.f, 0.f};
    bf16x8 At[4][2], B0[2][2], B1[2][2];
    const char* cA = (const char*)(g.A + (size_t)cur.z * g.zA) + (size_t)cur.pm * tstep; const char* cB = (const char*)(g.Bt + (size_t)cur.z * g.zB) + (size_t)cur.pn * tstep;
    S.a_ready(cur);
    if constexpr (SP2) {
        PG8_STAGE(PG8_SB(0, 0), cB, voffB); PG8_STAGE(PG8_SB(0, 1), cB + hstep, voffB); PG8_STAGE(PG8_SA(0, 0), cA, voffA); PG8_STAGE(PG8_SA(0, 1), cA + hstep, voffA);
        if (wr == 1) PG8_BAR;
        PG8_WAIT_V(2); PG8_BAR;
        PG8_STAGE(PG8_SB(1, 0), cB + kstep, voffB); PG8_STAGE(PG8_SA(1, 0), cA + kstep, voffA); PG8_STAGE(PG8_SB(1, 1), cB + hstep + kstep, voffB);
        PG8_WAIT_V(6); PG8_BAR;
    } else {
        PG8_STAGE(PG8_SB(0, 0), cB, voffB); PG8_STAGE(PG8_SA(0, 0), cA, voffA); PG8_STAGE(PG8_SB(0, 1), cB + hstep, voffB); PG8_STAGE(PG8_SA(0, 1), cA + hstep, voffA);
        if (wr == 1) PG8_BAR;
        PG8_WAIT_V(4); PG8_BAR;
        PG8_STAGE(PG8_SB(1, 0), cB + kstep, voffB); PG8_STAGE(PG8_SA(1, 0), cA + kstep, voffA); PG8_STAGE(PG8_SB(1, 1), cB + hstep + kstep, voffB);
        PG8_WAIT_V(6); PG8_BAR;
    }
    for (;;) {
        const bool has_next = S.next(ui + 1, nxt);
        const char* nA = has_next ? (const char*)(g.A + (size_t)nxt.z * g.zA) + (size_t)nxt.pm * tstep : cA; const char* nB = has_next ? (const char*)(g.Bt + (size_t)nxt.z * g.zB) + (size_t)nxt.pn * tstep : cB;
        for (int t = 0; t < nt; t += 2) {
            const bool last = (t == nt - 2);
            const char* a1 = cA + (size_t)(t + 1) * kstep;
            const char* a2 = last ? nA : cA + (size_t)(t + 2) * kstep; const char* b2 = last ? nB : cB + (size_t)(t + 2) * kstep;
            const char* a3 = a2 + kstep; const char* b3 = b2 + kstep;
            if (last && has_next) S.a_ready(nxt);
            if constexpr (SP2) {
            PG8_LDB(B0, 0, 0); PG8_LDB(B1, 0, 1); PG8_SCHED; PG8_LDA(At, 0, 0); PG8_STAGE(PG8_SA(1, 1), a1 + hstep, voffA);
            PG8_WAIT_V(8); PG8_WAIT_L(0); PG8_BAR; PG8_MMA(0, 0, At, B0); PG8_MMA(0, 1, At, B1); PG8_BAR; PG8_SCHED;
            PG8_LDA(At, 0, 1); PG8_STAGE(PG8_SB(0, 0), b2, voffB); PG8_STAGE(PG8_SB(0, 1), b2 + hstep, voffB); PG8_STAGE(PG8_SA(0, 0), a2, voffA);
            PG8_WAIT_V(8); PG8_WAIT_L(0); PG8_BAR; PG8_MMA(1, 0, At, B0); PG8_MMA(1, 1, At, B1); PG8_BAR; PG8_SCHED;
            PG8_LDB(B0, 1, 0); PG8_LDB(B1, 1, 1); PG8_SCHED; PG8_LDA(At, 1, 0); PG8_STAGE(PG8_SA(0, 1), a2 + hstep, voffA);
            PG8_WAIT_V(8); PG8_WAIT_L(0); PG8_BAR; PG8_MMA(0, 0, At, B0); PG8_MMA(0, 1, At, B1); PG8_BAR; PG8_SCHED;
            PG8_LDA(At, 1, 1); PG8_STAGE(PG8_SB(1, 0), b3, voffB); PG8_STAGE(PG8_SB(1, 1), b3 + hstep, voffB); PG8_STAGE(PG8_SA(1, 0), a3, voffA);
            PG8_WAIT_V(8); PG8_WAIT_L(0); PG8_BAR; PG8_MMA(1, 0, At, B0); PG8_MMA(1, 1, At, B1); PG8_BAR; PG8_SCHED;
            } else {
            PG8_LDB(B0, 0, 0); PG8_SCHED; PG8_LDA(At, 0, 0); PG8_STAGE(PG8_SA(1, 1), a1 + hstep, voffA);
            PG8_WAIT_L(8); PG8_BAR; PG8_WAIT_L(0); PG8_MMA(0, 0, At, B0); PG8_BAR; PG8_SCHED;
            PG8_LDB(B1, 0, 1); PG8_STAGE(PG8_SB(0, 0), b2, voffB);
            PG8_BAR; PG8_WAIT_L(0); PG8_MMA(0, 1, At, B1); PG8_BAR;
            PG8_LDA(At, 0, 1); PG8_STAGE(PG8_SA(0, 0), a2, voffA);
            PG8_BAR; PG8_WAIT_L(0); PG8_MMA(1, 0, At, B0); PG8_BAR; PG8_SCHED;
            PG8_STAGE(PG8_SB(0, 1), b2 + hstep, voffB);
            PG8_WAIT_V(6); PG8_BAR; PG8_MMA(1, 1, At, B1); PG8_BAR;
            PG8_LDB(B0, 1, 0); PG8_SCHED; PG8_LDA(At, 1, 0); PG8_STAGE(PG8_SA(0, 1), a2 + hstep, voffA);
            PG8_WAIT_L(8); PG8_BAR; PG8_WAIT_L(0); PG8_MMA(0, 0, At, B0); PG8_BAR; PG8_SCHED;
            PG8_LDB(B1, 1, 1); PG8_STAGE(PG8_SB(1, 0), b3, voffB);
            PG8_BAR; PG8_WAIT_L(0); PG8_MMA(0, 1, At, B1); PG8_BAR;
            PG8_LDA(At, 1, 1); PG8_STAGE(PG8_SA(1, 0), a3, voffA);
            PG8_BAR; PG8_WAIT_L(0); PG8_MMA(1, 0, At, B0); PG8_BAR; PG8_SCHED;
            PG8_STAGE(PG8_SB(1, 1), b3 + hstep, voffB);
            PG8_WAIT_V(6); PG8_BAR; PG8_MMA(1, 1, At, B1); PG8_BAR;
            }
        }
        if constexpr (ALIGN_EPI) { if (wr == 0) PG8_BAR; }
        if constexpr (!Epi::AFTER_DRAIN) { E(acc, cur, wr, wc, fr, fq); S.done(cur); }
        if (!has_next) break;
        if (!(Epi::KEEP && nxt.z != 0)) {
#pragma unroll
        for (int a = 0; a < 2; ++a)
#pragma unroll
            for (int b = 0; b < 2; ++b)
#pragma unroll
                for (int m = 0; m < 4; ++m)
#pragma unroll
                    for (int n = 0; n < 2; ++n) acc[a][b][m][n] = (f32x4){0.f, 0.f, 0.f, 0.f};
        }
        cur = nxt; cA = nA; cB = nB; ++ui;
        if constexpr (ALIGN_EPI) { if (wr == 1) PG8_BAR; }
    }
    PG8_WAIT_V(0);
    if constexpr (!ALIGN_EPI) { if (wr == 0) PG8_BAR; }
    PG8_BAR;
    if constexpr (Epi::AFTER_DRAIN) { E.fused(acc, cur, wr, wc, fr, fq, lds, wid, lane); S.done(cur); }
#undef PG8_SA
#undef PG8_SB
#undef PG8_STAGE
#undef PG8_LDA
#undef PG8_LDB
#undef PG8_MMA
#undef PG8_WAIT_V
#undef PG8_WAIT_L
#undef PG8_BAR
#undef PG8_SCHED
}
}

constexpr int NWAVES = 8;
constexpr int BATCH = 8, SEQ = 2048, DM = 2048, DEPTH = 4, M = BATCH * SEQ, NH = 8;
constexpr int NIN = 16400, NZ = 16384, DFF = 5632, NUP = 2 * DFF, NY = 3072;
constexpr int Z_RQ = 0, Z_RK = 1024, Z_RV = 2048, Z_RG = 3072, Z_MQ = 4096, Z_MK = 4608, Z_MV = 5120, Z_MO = 6144, Z_AQ = 7168, Z_AK = 8192, Z_AV = 9216, Z_GA = 10240, Z_GB = 12288, Z_GC = 14336;
constexpr int W_GATE_COL = 7168;
constexpr size_t MiB = 1u << 20;
constexpr size_t WS_CTL = 0, CTL_ZERO_BYTES = 1 * MiB;
constexpr size_t WS_RS = 1520 * MiB;
constexpr size_t WS_TAB = 2 * MiB + 512 * 1024;
constexpr size_t WS_RSTD = 7 * MiB + 512 * 1024;
constexpr size_t WS_W16G = 7 * MiB;
constexpr size_t WS_KMEAN = 5 * MiB;
constexpr size_t WS_GIF = 6 * MiB;
constexpr size_t WS_WIN = 8 * MiB;
constexpr size_t WS_WP = 264 * MiB;
constexpr size_t WS_WOUT = 312 * MiB;
constexpr size_t WS_WUP = 344 * MiB;
constexpr size_t WS_WDN = 520 * MiB;
constexpr size_t WS_XB = 608 * MiB;
constexpr size_t WS_Z = 672 * MiB;
constexpr size_t WS_Y = 1184 * MiB;
constexpr size_t WS_MG = 1280 * MiB;
constexpr size_t WS_ACT = 1344 * MiB;
constexpr size_t WS_ZG = 1536 * MiB;
constexpr size_t WS_END = 1632 * MiB;
constexpr int CW_TMO = 0, CW_CODE = 1;
constexpr int CW_BAR = 4096;
constexpr int CW_QUEUE = 8192;
constexpr int RING_OFF = 0, RING_BYTES = 131072;
constexpr int LDS_BYTES = 163840;
constexpr int LDSCTL_OFF = LDS_BYTES - 512, MISC_OFF = LDSCTL_OFF + 320;
static_assert(MISC_OFF + 128 <= LDS_BYTES, "LDS map");

#define GAS __attribute__((address_space(1)))
#define LAS __attribute__((address_space(3)))
typedef unsigned short bf16;
typedef unsigned v4u __attribute__((ext_vector_type(4)));
typedef unsigned v2u __attribute__((ext_vector_type(2)));
typedef float f32x4 __attribute__((ext_vector_type(4)));
typedef float f32x2 __attribute__((ext_vector_type(2)));
typedef GAS unsigned gu32;
#define RLX_AGENT __ATOMIC_RELAXED, __HIP_MEMORY_SCOPE_AGENT
#define LDS_WAIT() asm volatile("s_waitcnt lgkmcnt(0)" ::: "memory")
#define VM_WAIT() asm volatile("s_waitcnt vmcnt(0)" ::: "memory")
typedef __bf16 bf16x2_t __attribute__((ext_vector_type(2)));
__device__ __forceinline__ unsigned pk2(float lo, float hi) { const f32x2 v = {lo, hi}; const bf16x2_t b = __builtin_convertvector(v, bf16x2_t); return __builtin_bit_cast(unsigned, b); }
__device__ __forceinline__ unsigned f2bf(float f) { return pk2(f, f); }
__device__ __forceinline__ float bflo(unsigned w) { return __uint_as_float(w << 16); }
__device__ __forceinline__ float bfhi(unsigned w) { return __uint_as_float(w & 0xffff0000u); }
__device__ __forceinline__ float bf1(bf16 v) { return __uint_as_float((unsigned)v << 16); }
__device__ __forceinline__ float sigm(float x) { return 1.0f / (1.0f + __expf(-x)); }

#define XB_TMO      128
#define XB_XCNT(j)  (256  + 64 * (j))
#define XB_XSUB(j)  (1280 + 64 * (j))
#define XB_XGEN(j)  (2304 + 64 * (j))
#define XB_TOP      3328
#define XB_TOPGEN   3392
#define XCD_BAR_WORDS 3456
#define XB_SPIN_CAP (1u << 18)

__device__ __forceinline__ unsigned xb_ld(unsigned* p)              { return __hip_atomic_load(p, __ATOMIC_RELAXED, __HIP_MEMORY_SCOPE_AGENT); }
__device__ __forceinline__ unsigned xb_add(unsigned* p, unsigned v) { return __hip_atomic_fetch_add(p, v, __ATOMIC_RELAXED, __HIP_MEMORY_SCOPE_AGENT); }
__device__ __forceinline__ unsigned xb_xcc_id() { return (unsigned)__builtin_amdgcn_s_getreg((3 << 11) | 20) & 0xFu; }
#define XB_SPIN(cond, bar) do { unsigned _sp = 0; while (cond) { __builtin_amdgcn_s_sleep(1); \
    if ((++_sp & 255u) == 0u) { if (xb_ld(&(bar)[XB_TMO])) break; if (_sp > XB_SPIN_CAP) { atomicAdd(&(bar)[XB_TMO], 1u); break; } } } } while (0)

struct XcdBarrier {
    unsigned* bar; unsigned x;
    volatile LAS unsigned* st;
};

__device__ __forceinline__ XcdBarrier xcd_barrier_post(unsigned* bar, volatile LAS unsigned* st) {
    XcdBarrier b; b.bar = bar; b.x = xb_xcc_id(); b.st = st;
    if (threadIdx.x == 0) (void)xb_add(&bar[XB_XCNT(b.x)], 1u);
    return b;
}
__device__ __forceinline__ void xcd_barrier_complete(unsigned* bar, unsigned x, unsigned& nloc, unsigned& nx) {
    const unsigned G = gridDim.x * gridDim.y * gridDim.z;
    unsigned sum, cnt, mine, sp = 0u;
    for (;;) {
        sum = 0u; cnt = 0u; mine = 0u;
#pragma unroll
        for (unsigned j = 0; j < 16; ++j) { const unsigned c = xb_ld(&bar[XB_XCNT(j)]); sum += c; cnt += (c > 0u) ? 1u : 0u; mine = (j == x) ? c : mine; }
        if (sum == G) break;
        __builtin_amdgcn_s_sleep(1);
        if ((++sp & 255u) == 0u) { if (xb_ld(&bar[XB_TMO])) break; if (sp > XB_SPIN_CAP) { atomicAdd(&bar[XB_TMO], 1u); break; } }
    }
    nloc = mine > 0u ? mine : 1u; nx = cnt > 0u ? cnt : 1u;
}

__device__ __forceinline__ void xcd_barrier(const XcdBarrier& b) {
    asm volatile("s_waitcnt vmcnt(0)" ::: "memory");
    __syncthreads();
    if (threadIdx.x == 0) {
        unsigned* bar = b.bar;
        __builtin_amdgcn_s_waitcnt(0);
        unsigned nloc = b.st[0], nx = b.st[1];
        if (nloc == 0u) { xcd_barrier_complete(bar, b.x, nloc, nx); b.st[0] = nloc; b.st[1] = nx; }
        const unsigned old = xb_add(&bar[XB_XSUB(b.x)], 1u);
        const unsigned gen = old / nloc;
        if (old + 1u == (gen + 1u) * nloc) {
            __builtin_amdgcn_fence(__ATOMIC_RELEASE, "agent");
            asm volatile("s_waitcnt vmcnt(0)" ::: "memory");
            const unsigned og = xb_add(&bar[XB_TOP], 1u);
            const unsigned tg = og / nx;
            if (og + 1u == (tg + 1u) * nx) xb_add(&bar[XB_TOPGEN], 1u);
            else XB_SPIN(xb_ld(&bar[XB_TOPGEN]) == tg, bar);
            __builtin_amdgcn_fence(__ATOMIC_ACQUIRE, "agent");
            xb_add(&bar[XB_XGEN(b.x)], 1u);
            asm volatile("s_waitcnt vmcnt(0)" ::: "memory");
        } else {
            XB_SPIN(xb_ld(&bar[XB_XGEN(b.x)]) == gen, bar);
            __builtin_amdgcn_fence(__ATOMIC_ACQUIRE, "agent");
            asm volatile("s_waitcnt vmcnt(0)" ::: "memory");
        }
    }
    __syncthreads();
}

struct Args { const float* in[18]; float* out; unsigned char* ws; int ph_lo, ph_hi, li, pad; };
enum { I_X = 0, I_WIN, I_BIG, I_BFG, I_NMIX, I_RGN, I_MLN, I_QN, I_KN, I_WPA, I_WPB, I_WPC, I_WOUT, I_NFFN, I_WUP, I_CW, I_CB, I_WDN };
struct Frame {
    LAS unsigned char* lds;
    volatile LAS unsigned* MISC;
    unsigned char* ws;
    int tid, lane, wave, G, bx;
};
#define WSP(T, off) ((T*)(F.ws + (off)))
__device__ __forceinline__ float wave_sum(float v) {
#pragma unroll
    for (int o = 1; o < 64; o <<= 1) v += __shfl_xor(v, o);
    return v;
}
__device__ __forceinline__ float wave_max(float v) {
#pragma unroll
    for (int o = 1; o < 64; o <<= 1) v = fmaxf(v, __shfl_xor(v, o));
    return v;
}
__device__ __forceinline__ void p0_transpose_item(const float* W, int ldw, int K, int nblk, bf16* WT, LAS float* scr, int item, int lane, const float* gk = nullptr) {
    const int kb = item / nblk, nb = item % nblk, k0 = 64 * kb, n0 = 32 * nb;
#pragma unroll 8
    for (int i = 0; i < 32; ++i) { const int kk = 2 * i + (lane >> 5); scr[kk * 33 + (lane & 31)] = W[(size_t)(k0 + kk) * ldw + n0 + (lane & 31)]; }
    LDS_WAIT(); asm volatile("" ::: "memory");
    const int c = lane & 7;
    f32x4 g0 = (f32x4){1.f, 1.f, 1.f, 1.f}, g1 = g0;
    if (gk) { g0 = *(const f32x4*)(gk + k0 + 8 * c); g1 = *(const f32x4*)(gk + k0 + 8 * c + 4); }
#pragma unroll
    for (int j = 0; j < 4; ++j) { const int n = (lane >> 3) + 8 * j; const LAS float* s = scr + (8 * c) * 33 + n;
        v4u o; o.x = pk2(s[0 * 33] * g0[0], s[1 * 33] * g0[1]); o.y = pk2(s[2 * 33] * g0[2], s[3 * 33] * g0[3]); o.z = pk2(s[4 * 33] * g1[0], s[5 * 33] * g1[1]); o.w = pk2(s[6 * 33] * g1[2], s[7 * 33] * g1[3]);
        *(GAS v4u*)(WT + (size_t)(n0 + n) * K + k0 + 8 * c) = o; }
    LDS_WAIT(); asm volatile("" ::: "memory");
}
__device__ __forceinline__ void p0_prologue(Frame& F, const Args& args) {
    LAS float* scr = (LAS float*)(F.lds + RING_OFF + F.wave * 16384);
    const int gw = F.bx * NWAVES + F.wave, NGW = F.G * NWAVES;
    constexpr int I_INA = 32 * 224, I_INB = 32 * 288, I_P = 16 * 64, I_OUT = 32 * 64, I_UP = 32 * 352, I_DN = 88 * 64;
    constexpr int I_LAYER = I_INA + I_INB + 3 * I_P + I_OUT + I_UP + I_DN;
    for (int it = gw; it < DEPTH * I_LAYER; it += NGW) {
        const int l = it / I_LAYER; int r = it % I_LAYER;
        const float* win = args.in[I_WIN] + (size_t)l * DM * NIN; bf16* wint = WSP(bf16, WS_WIN) + (size_t)l * NZ * DM;
        if (r < I_INA) { p0_transpose_item(win, NIN, DM, 224, wint, scr, r, F.lane, args.in[I_NMIX] + l * DM); continue; } r -= I_INA;
        if (r < I_INB) { p0_transpose_item(win + 7184, NIN, DM, 288, wint + (size_t)7168 * DM, scr, r, F.lane, args.in[I_NMIX] + l * DM); continue; } r -= I_INB;
        if (r < I_P) { p0_transpose_item(args.in[I_WPA] + (size_t)l * 1024 * DM, DM, 1024, 64, WSP(bf16, WS_WP) + ((size_t)l * 3 + 0) * DM * 1024, scr, r, F.lane); continue; } r -= I_P;
        if (r < I_P) { p0_transpose_item(args.in[I_WPB] + (size_t)l * 1024 * DM, DM, 1024, 64, WSP(bf16, WS_WP) + ((size_t)l * 3 + 1) * DM * 1024, scr, r, F.lane); continue; } r -= I_P;
        if (r < I_P) { p0_transpose_item(args.in[I_WPC] + (size_t)l * 1024 * DM, DM, 1024, 64, WSP(bf16, WS_WP) + ((size_t)l * 3 + 2) * DM * 1024, scr, r, F.lane); continue; } r -= I_P;
        if (r < I_OUT) { p0_transpose_item(args.in[I_WOUT] + (size_t)l * DM * DM, DM, DM, 64, WSP(bf16, WS_WOUT) + (size_t)l * DM * DM, scr, r, F.lane); continue; } r -= I_OUT;
        if (r < I_UP) { p0_transpose_item(args.in[I_WUP] + (size_t)l * DM * NUP, NUP, DM, 352, WSP(bf16, WS_WUP) + (size_t)l * NUP * DM, scr, r, F.lane, args.in[I_NFFN] + l * DM); continue; } r -= I_UP;
        p0_transpose_item(args.in[I_WDN] + (size_t)l * DFF * DM, DM, DFF, 64, WSP(bf16, WS_WDN) + (size_t)l * DM * DFF, scr, r, F.lane);
    }
    const int gt = F.bx * (NWAVES * 64) + F.tid, NGT = F.G * NWAVES * 64;
    for (int i = gt; i < DEPTH * 16 * DM; i += NGT) { const int l = i / (16 * DM), c = (i / DM) % 16, k = i % DM; WSP(bf16, WS_W16G)[i] = (bf16)f2bf(args.in[I_WIN][((size_t)l * DM + k) * NIN + W_GATE_COL + c] * args.in[I_NMIX][l * DM + k]); }
    for (int m = gw; m < M; m += NGW) { const f32x4* xr = (const f32x4*)(args.in[I_X] + (size_t)m * DM) + F.lane; v2u* o8 = (v2u*)(WSP(bf16, WS_XB) + (size_t)m * DM) + F.lane; float s = 0.f;
#pragma unroll
        for (int j = 0; j < 8; ++j) { const f32x4 v = xr[64 * j]; s += (v.x * v.x + v.y * v.y) + (v.z * v.z + v.w * v.w); v2u w; w.x = pk2(v.x, v.y); w.y = pk2(v.z, v.w); o8[64 * j] = w; }
        s = wave_sum(s); if (F.lane < 32) WSP(float, WS_RS)[(size_t)m * 32 + F.lane] = (F.lane == 0) ? s : 0.f; }
    for (int i = gt; i < 2 * SEQ * 64; i += NGT) { const int which = i / (SEQ * 64), pos = (i / 64) % SEQ, d = i % 64;
        const float ex = which == 0 ? (float)d / 63.0f : (float)(2 * d) / 128.0f;
        const float inv = 1.0f / powf(10000.0f, ex); const float ang = (float)pos * inv; float s, c; sincosf(ang, &s, &c); WSP(f32x2, WS_TAB)[i] = (f32x2){c, s}; }
}
__device__ __forceinline__ void prep_phase(Frame& F, const float* qn, const float* kn, const bf16* w16g, const float* rs, const float* big, const float* bfg) {
    const int gw = F.bx * NWAVES + F.wave, NGW = F.G * NWAVES, lane = F.lane, rsub = lane >> 2, dg = lane & 3;
    const f32x2* trope = WSP(f32x2, WS_TAB) + SEQ * 64;
    for (int u = gw; u < 2 * BATCH * 16 * NH; u += NGW) {
        const int kind = u & 1, hh = (u >> 1) & 7, hb = (u >> 4) & 15, b = u >> 8;
        const float* wn = kind ? kn : qn;
        const float* rsb = rs + (size_t)(b * SEQ + hb * 128) * 32 + 8 * dg;
        float wl[16], wh[16], s1[16], s2[16];
#pragma unroll
        for (int e = 0; e < 16; ++e) { wl[e] = wn[16 * dg + e]; wh[e] = wn[64 + 16 * dg + e]; s1[e] = 0.f; s2[e] = 0.f; }
        bf16* zb = WSP(bf16, WS_Z) + (size_t)(b * SEQ + hb * 128) * NZ + (kind ? Z_AK : Z_AQ) + hh * 128 + 16 * dg;
#pragma unroll 2
        for (int st = 0; st < 8; ++st) {
            const int r = rsub + 16 * st, pos = hb * 128 + r; bf16* zr = zb + (size_t)r * NZ;
            const v4u l0 = *(const v4u*)(zr), l1 = *(const v4u*)(zr + 8), h0 = *(const v4u*)(zr + 64), h1 = *(const v4u*)(zr + 72);
            float a[16] = {bflo(l0.x), bfhi(l0.x), bflo(l0.y), bfhi(l0.y), bflo(l0.z), bfhi(l0.z), bflo(l0.w), bfhi(l0.w), bflo(l1.x), bfhi(l1.x), bflo(l1.y), bfhi(l1.y), bflo(l1.z), bfhi(l1.z), bflo(l1.w), bfhi(l1.w)};
            float c[16] = {bflo(h0.x), bfhi(h0.x), bflo(h0.y), bfhi(h0.y), bflo(h0.z), bfhi(h0.z), bflo(h0.w), bfhi(h0.w), bflo(h1.x), bfhi(h1.x), bflo(h1.y), bfhi(h1.y), bflo(h1.z), bfhi(h1.z), bflo(h1.w), bfhi(h1.w)};
            float ss = 0.f;
#pragma unroll
            for (int e = 0; e < 16; ++e) ss += a[e] * a[e] + c[e] * c[e];
            ss += __shfl_xor(ss, 1); ss += __shfl_xor(ss, 2);
            float rq; { const f32x4 s0 = *(const f32x4*)(rsb + (size_t)r * 32), s1 = *(const f32x4*)(rsb + (size_t)r * 32 + 4); rq = ((s0[0] + s0[1]) + (s0[2] + s0[3])) + ((s1[0] + s1[1]) + (s1[2] + s1[3])); }
            rq += __shfl_xor(rq, 1); rq += __shfl_xor(rq, 2);
            const float rr = rsqrtf(rq * (1.0f / 2048.0f) + 1e-6f);
            if ((u & 15) == 0 && dg == 0) WSP(float, WS_RSTD)[b * SEQ + hb * 128 + r] = rr;
            const float rstd = rr * rsqrtf(ss * rr * rr * (1.f / 128.f) + 1e-6f);
            const f32x2* tb = trope + pos * 64 + 16 * dg;
#pragma unroll
            for (int e = 0; e < 16; ++e) { const float x1 = a[e] * rstd * wl[e], x2 = c[e] * rstd * wh[e]; const f32x2 cs = tb[e]; a[e] = x1 * cs.x - x2 * cs.y; c[e] = x1 * cs.y + x2 * cs.x; s1[e] += a[e]; s2[e] += c[e]; }
            *(v4u*)(zr) = (v4u){pk2(a[0], a[1]), pk2(a[2], a[3]), pk2(a[4], a[5]), pk2(a[6], a[7])}; *(v4u*)(zr + 8) = (v4u){pk2(a[8], a[9]), pk2(a[10], a[11]), pk2(a[12], a[13]), pk2(a[14], a[15])};
            *(v4u*)(zr + 64) = (v4u){pk2(c[0], c[1]), pk2(c[2], c[3]), pk2(c[4], c[5]), pk2(c[6], c[7])}; *(v4u*)(zr + 72) = (v4u){pk2(c[8], c[9]), pk2(c[10], c[11]), pk2(c[12], c[13]), pk2(c[14], c[15])};
        }
        if (kind) {
            float* km = WSP(float, WS_KMEAN) + (size_t)((b * NH + hh) * 16 + hb) * 128 + 16 * dg;
#pragma unroll
            for (int e = 0; e < 16; ++e) { float x = s1[e], y = s2[e];
                x += __shfl_xor(x, 4); x += __shfl_xor(x, 8); x += __shfl_xor(x, 16); x += __shfl_xor(x, 32);
                y += __shfl_xor(y, 4); y += __shfl_xor(y, 8); y += __shfl_xor(y, 16); y += __shfl_xor(y, 32);
                if (rsub == 0) { km[e] = x * (1.f / 256.f); km[64 + e] = y * (1.f / 256.f); } }
        }
    }
    for (int it = gw; it < M / 32; it += NGW) {
#pragma unroll
        for (int st = 0; st < 8; ++st) { const int row = 32 * it + 4 * st + (lane >> 4), cg = lane & 15;
            const float* rp = rs + (size_t)row * 32; float rq = 0.f;
#pragma unroll
            for (int q = 0; q < 8; ++q) { const f32x4 s0 = *(const f32x4*)(rp + 4 * q); rq += (s0[0] + s0[1]) + (s0[2] + s0[3]); }
            const float rr = rsqrtf(rq * (1.0f / 2048.0f) + 1e-6f);
            bf16* vp = WSP(bf16, WS_Z) + (size_t)row * NZ + Z_AV + 8 * cg;
#pragma unroll
            for (int q = 0; q < 8; ++q) { const v4u x = *(const v4u*)(vp + 128 * q);
                *(v4u*)(vp + 128 * q) = (v4u){pk2(bflo(x.x) * rr, bfhi(x.x) * rr), pk2(bflo(x.y) * rr, bfhi(x.y) * rr), pk2(bflo(x.z) * rr, bfhi(x.z) * rr), pk2(bflo(x.w) * rr, bfhi(x.w) * rr)}; } }
    }
    for (int it = NGW - 1 - gw; it < M / 16; it += NGW) {
        const int i16 = lane & 15, g = lane >> 4; const bf16* ar = WSP(bf16, WS_XB) + (size_t)(16 * it + i16) * DM + 8 * g; const bf16* br = w16g + (size_t)i16 * DM + 8 * g;
        typedef short bf16x8_t __attribute__((ext_vector_type(8)));
        f32x4 acc = (f32x4){0.f, 0.f, 0.f, 0.f};
#pragma unroll 1
        for (int s0 = 0; s0 < DM / 32; s0 += 16) { bf16x8_t av[16], bv[16];
#pragma unroll
            for (int s = 0; s < 16; ++s) { av[s] = *(const bf16x8_t*)(ar + 32 * (s0 + s)); bv[s] = *(const bf16x8_t*)(br + 32 * (s0 + s)); }
#pragma unroll
            for (int s = 0; s < 16; ++s) acc = __builtin_amdgcn_mfma_f32_16x16x32_bf16(av[s], bv[s], acc, 0, 0, 0); }
#pragma unroll
        for (int r = 0; r < 4; ++r) { const int row = 16 * it + 4 * g + r; float ssq = 0.f;
#pragma unroll
            for (int q = 0; q < 8; ++q) { const f32x4 a = *(const f32x4*)(rs + (size_t)row * 32 + 4 * q); ssq += (a[0] + a[1]) + (a[2] + a[3]); }
            const float sr = rsqrtf(ssq * (1.0f / 2048.0f) + 1e-6f);
            const float pre = acc[r] * sr + (i16 < 8 ? big[i16 & 7] : bfg[i16 & 7]); const float sc = 15.0f * tanhf(pre * (1.0f / 15.0f));
            float o = sc; if (i16 >= 8) o = sc > 0.f ? -log1pf(__expf(-sc)) : sc - log1pf(__expf(sc));
            WSP(float, WS_GIF)[(size_t)row * 16 + i16] = o; }
    }
}
__device__ __forceinline__ void glu_phase(Frame& F, const float* cw, const float* cb, const float* rs) {
    const int gw = F.bx * NWAVES + F.wave, NGW = F.G * NWAVES, lane = F.lane;
    constexpr int RB = 8, NCG = DFF / 512;
    const bf16* U = WSP(bf16, WS_Z); bf16* ACT = WSP(bf16, WS_ACT);
    for (int it = gw; it < (M / RB) * NCG; it += NGW) {
        const int cgp = it % NCG, rb = it / NCG, c8 = (cgp * 64 + lane) * 8, m0 = rb * RB; const bool first = (m0 & (SEQ - 1)) == 0;
        float myrr; { const int wr_ = lane >> 2, pt = lane & 3; const int m = m0 - 2 + wr_; float q = 0.f;
            if (wr_ < RB + 2 && !(wr_ < 2 && first)) { const f32x4 s0 = *(const f32x4*)(rs + (size_t)m * 32 + 8 * pt), s1 = *(const f32x4*)(rs + (size_t)m * 32 + 8 * pt + 4); q = ((s0[0] + s0[1]) + (s0[2] + s0[3])) + ((s1[0] + s1[1]) + (s1[2] + s1[3])); }
            q += __shfl_xor(q, 1); q += __shfl_xor(q, 2); myrr = rsqrtf(q * (1.0f / 2048.0f) + 1e-6f); }
        v4u ua[RB + 2], ub[RB + 2];
#pragma unroll
        for (int r = 0; r < RB + 2; ++r) { const int m = m0 - 2 + r;
            if (r < 2 && first) { ua[r] = (v4u){0u, 0u, 0u, 0u}; ub[r] = (v4u){0u, 0u, 0u, 0u}; }
            else { ua[r] = *(const v4u*)(U + (size_t)m * NUP + c8); ub[r] = *(const v4u*)(U + (size_t)m * NUP + DFF + c8); } }
        float wa[3][8], wb[3][8], ba[8], bb[8];
#pragma unroll
        for (int j = 0; j < 3; ++j) { const f32x4 a0 = *(const f32x4*)(cw + (size_t)j * NUP + c8), a1 = *(const f32x4*)(cw + (size_t)j * NUP + c8 + 4), b0 = *(const f32x4*)(cw + (size_t)j * NUP + DFF + c8), b1 = *(const f32x4*)(cw + (size_t)j * NUP + DFF + c8 + 4);
            wa[j][0] = a0.x; wa[j][1] = a0.y; wa[j][2] = a0.z; wa[j][3] = a0.w; wa[j][4] = a1.x; wa[j][5] = a1.y; wa[j][6] = a1.z; wa[j][7] = a1.w;
            wb[j][0] = b0.x; wb[j][1] = b0.y; wb[j][2] = b0.z; wb[j][3] = b0.w; wb[j][4] = b1.x; wb[j][5] = b1.y; wb[j][6] = b1.z; wb[j][7] = b1.w; }
        { const f32x4 a0 = *(const f32x4*)(cb + c8), a1 = *(const f32x4*)(cb + c8 + 4), b0 = *(const f32x4*)(cb + DFF + c8), b1 = *(const f32x4*)(cb + DFF + c8 + 4);
          ba[0] = a0.x; ba[1] = a0.y; ba[2] = a0.z; ba[3] = a0.w; ba[4] = a1.x; ba[5] = a1.y; ba[6] = a1.z; ba[7] = a1.w; bb[0] = b0.x; bb[1] = b0.y; bb[2] = b0.z; bb[3] = b0.w; bb[4] = b1.x; bb[5] = b1.y; bb[6] = b1.z; bb[7] = b1.w; }
#pragma unroll
        for (int r = 0; r < RB; ++r) {
            float xa[8], xb[8];
#pragma unroll
            for (int e = 0; e < 8; ++e) { xa[e] = ba[e]; xb[e] = bb[e]; }
#pragma unroll
            for (int j = 0; j < 3; ++j) { const v4u a = ua[r + j], b = ub[r + j]; const float rsc = __shfl(myrr, 4 * (r + j));
                const float fa[8] = {bflo(a.x), bfhi(a.x), bflo(a.y), bfhi(a.y), bflo(a.z), bfhi(a.z), bflo(a.w), bfhi(a.w)};
                const float fb[8] = {bflo(b.x), bfhi(b.x), bflo(b.y), bfhi(b.y), bflo(b.z), bfhi(b.z), bflo(b.w), bfhi(b.w)};
#pragma unroll
                for (int e = 0; e < 8; ++e) { xa[e] += fa[e] * rsc * wa[j][e]; xb[e] += fb[e] * rsc * wb[j][e]; } }
            float o[8];
#pragma unroll
            for (int e = 0; e < 8; ++e) o[e] = xa[e] * __builtin_amdgcn_rcpf(1.0f + __expf(-xa[e])) * xb[e];
            *(v4u*)(ACT + (size_t)(m0 + r) * DFF + c8) = (v4u){pk2(o[0], o[1]), pk2(o[2], o[3]), pk2(o[4], o[5]), pk2(o[6], o[7])};
        }
    }
}
namespace mx {
typedef short bf16x8 __attribute__((ext_vector_type(8)));
typedef short s16x4 __attribute__((ext_vector_type(4)));
#define MFMA16(a, b, c) __builtin_amdgcn_mfma_f32_16x16x32_bf16((a), (b), (c), 0, 0, 0)
#define LDS_FENCE() asm volatile("s_waitcnt lgkmcnt(0)" ::: "memory")
#define SCHED_FENCE() __builtin_amdgcn_sched_barrier(0)
__device__ __forceinline__ bf16x8 frag_row(const LAS bf16* X, int ld, int r0, int c0, int lane) {
    return *(const LAS bf16x8*)(X + (r0 + (lane & 15)) * ld + c0 + 8 * (lane >> 4)); }
__device__ __forceinline__ bf16x8 frag_tr(const LAS bf16* X, int ld, int k0, int c0, int lane) {
    const int g = lane >> 4, q = (lane & 15) >> 2, p = lane & 3;
    const LAS bf16* a = X + (k0 + 8 * g + q) * ld + c0 + 4 * p;
    const s16x4 lo = __builtin_amdgcn_ds_read_tr16_b64_v4i16((LAS s16x4*)a);
    const s16x4 hi = __builtin_amdgcn_ds_read_tr16_b64_v4i16((LAS s16x4*)(a + 4 * ld));
    return __builtin_shufflevector(lo, hi, 0, 1, 2, 3, 4, 5, 6, 7);
}
__device__ __forceinline__ int trs_off(int row, int chunk) { return row * 128 + ((chunk ^ (((row & 3) << 1) | (((row >> 3) & 1) << 3))) << 3); }
__device__ __forceinline__ bf16x8 frag_trs(const LAS bf16* X, int k0, int c0, int lane) {
    const int g = lane >> 4, q = (lane & 15) >> 2, p = lane & 3;
    const LAS bf16* a = X + trs_off(k0 + 8 * g + q, (c0 >> 3) + (p >> 1)) + 4 * (p & 1);
    const s16x4 lo = __builtin_amdgcn_ds_read_tr16_b64_v4i16((LAS s16x4*)a);
    const s16x4 hi = __builtin_amdgcn_ds_read_tr16_b64_v4i16((LAS s16x4*)(a + 4 * 128));
    return __builtin_shufflevector(lo, hi, 0, 1, 2, 3, 4, 5, 6, 7);
}
template <int CTRL> __device__ __forceinline__ float dppf(float v) { return __builtin_bit_cast(float, __builtin_amdgcn_update_dpp(0, __builtin_bit_cast(int, v), CTRL, 0xf, 0xf, true)); }
__device__ __forceinline__ float r16max(float v) { v = fmaxf(v, dppf<0xB1>(v)); v = fmaxf(v, dppf<0x4E>(v)); v = fmaxf(v, dppf<0x141>(v)); v = fmaxf(v, dppf<0x140>(v)); return v; }
__device__ __forceinline__ float r16sum(float v) { v += dppf<0xB1>(v); v += dppf<0x4E>(v); v += dppf<0x141>(v); v += dppf<0x140>(v); return v; }
__device__ __forceinline__ float red16_sum(float v) { return r16sum(v); }
__device__ __forceinline__ float red16_max(float v) { return r16max(v); }
__device__ __forceinline__ void rot8(const v4u lo, const v4u hi, const f32x2* tb, float sc, v4u& olo, v4u& ohi) {
    float a[8] = {bflo(lo.x), bfhi(lo.x), bflo(lo.y), bfhi(lo.y), bflo(lo.z), bfhi(lo.z), bflo(lo.w), bfhi(lo.w)};
    float c[8] = {bflo(hi.x), bfhi(hi.x), bflo(hi.y), bfhi(hi.y), bflo(hi.z), bfhi(hi.z), bflo(hi.w), bfhi(hi.w)};
    float o1[8], o2[8];
#pragma unroll
    for (int e = 0; e < 8; ++e) { const f32x2 cs = tb[e]; o1[e] = (a[e] * cs.x - c[e] * cs.y) * sc; o2[e] = (a[e] * cs.y + c[e] * cs.x) * sc; }
    olo = (v4u){pk2(o1[0], o1[1]), pk2(o1[2], o1[3]), pk2(o1[4], o1[5]), pk2(o1[6], o1[7])};
    ohi = (v4u){pk2(o2[0], o2[1]), pk2(o2[2], o2[3]), pk2(o2[4], o2[5]), pk2(o2[6], o2[7])};
}
constexpr int LQ = 144;
__device__ __forceinline__ void ret_unit(Frame& F, const float* gn, int b, int h) {
    LAS bf16* Qs = (LAS bf16*)(F.lds); LAS bf16* Ks = Qs + 128 * LQ; LAS bf16* Vs = Ks + 128 * LQ; LAS bf16* Ts = Vs + 128 * LQ;
    const int tid = F.tid, lane = F.lane, w = tid >> 6, i16 = lane & 15, g = lane >> 4;
    const float gamma = 1.0f - exp2f(-5.0f - (float)h), lg = log2f(gamma);
    const float gC = exp2f(lg * 128.0f);
    f32x4 accT[8];
#pragma unroll
    for (int n = 0; n < 8; ++n) accT[n] = (f32x4){0.f, 0.f, 0.f, 0.f};
    for (int i = tid; i < 128 * LQ / 8; i += NWAVES * 64) ((LAS v4u*)Ts)[i] = (v4u){0u, 0u, 0u, 0u};
    const bf16* zb = WSP(bf16, WS_Z) + (size_t)(b * SEQ) * NZ + h * 128;
    const f32x2* tret = WSP(f32x2, WS_TAB);
    bf16* yb = WSP(bf16, WS_Y) + (size_t)(b * SEQ) * 1024 + h * 128;
    const int lr = tid >> 2, dg = tid & 3;
    v4u pq[4], pk[4], pv[4]; float prr;
    const float* rstd1 = WSP(float, WS_RSTD) + (size_t)(b * SEQ);
#define RET_FETCH(t0_) do { const bf16* zr_ = zb + (size_t)((t0_) + lr) * NZ; \
        pq[0] = *(const v4u*)(zr_ + Z_RQ + 16 * dg); pq[1] = *(const v4u*)(zr_ + Z_RQ + 64 + 16 * dg); pq[2] = *(const v4u*)(zr_ + Z_RQ + 16 * dg + 8); pq[3] = *(const v4u*)(zr_ + Z_RQ + 64 + 16 * dg + 8); \
        pk[0] = *(const v4u*)(zr_ + Z_RK + 16 * dg); pk[1] = *(const v4u*)(zr_ + Z_RK + 64 + 16 * dg); pk[2] = *(const v4u*)(zr_ + Z_RK + 16 * dg + 8); pk[3] = *(const v4u*)(zr_ + Z_RK + 64 + 16 * dg + 8); \
        _Pragma("unroll") for (int q_ = 0; q_ < 4; ++q_) pv[q_] = *(const v4u*)(zr_ + Z_RV + 32 * dg + 8 * q_); prr = rstd1[(t0_) + lr]; } while (0)
    RET_FETCH(0);
    const float sq = exp2f(lg * (float)lr), sk = exp2f(-lg * (float)lr) * 0.08838834764831845f;
    float gnv[8];
#pragma unroll
    for (int n = 0; n < 8; ++n) gnv[n] = gn[h * 128 + 16 * n + i16];
    for (int c = 0; c < SEQ / 128; ++c) {
        const int t0 = c * 128;
        {
            const f32x2* tb = tret + (t0 + lr) * 64 + 16 * dg;
#pragma unroll
            for (int hh = 0; hh < 2; ++hh) {
                v4u o1, o2; rot8(pq[2 * hh], pq[2 * hh + 1], tb + 8 * hh, sq * prr, o1, o2);
                *(LAS v4u*)(Qs + lr * LQ + 16 * dg + 8 * hh) = o1; *(LAS v4u*)(Qs + lr * LQ + 64 + 16 * dg + 8 * hh) = o2;
                rot8(pk[2 * hh], pk[2 * hh + 1], tb + 8 * hh, sk * prr * prr, o1, o2);
                *(LAS v4u*)(Ks + lr * LQ + 16 * dg + 8 * hh) = o1; *(LAS v4u*)(Ks + lr * LQ + 64 + 16 * dg + 8 * hh) = o2;
            }
#pragma unroll
            for (int q = 0; q < 4; ++q) *(LAS v4u*)(Vs + lr * LQ + 32 * dg + 8 * q) = pv[q];
            if (c + 1 < SEQ / 128) RET_FETCH(t0 + 128);
        }
        __syncthreads();
        bf16x8 aq[4];
#pragma unroll
        for (int s = 0; s < 4; ++s) aq[s] = frag_row(Qs, LQ, 16 * w, 32 * s, lane);
        f32x4 acco[8];
#pragma unroll
        for (int n = 0; n < 8; ++n) acco[n] = (f32x4){0.f, 0.f, 0.f, 0.f};
#pragma unroll
        for (int s = 0; s < 4; ++s) { bf16x8 bb[8];
#pragma unroll
            for (int n = 0; n < 8; ++n) bb[n] = frag_tr(Ts, LQ, 32 * s, 16 * n, lane);
            SCHED_FENCE();
#pragma unroll
            for (int n = 0; n < 8; ++n) acco[n] = MFMA16(aq[s], bb[n], acco[n]); }
        LDS_FENCE();
#pragma unroll
        for (int n = 0; n < 8; ++n) {
            if (n <= w) { f32x4 sa = (f32x4){0.f, 0.f, 0.f, 0.f}; bf16x8 bb[4];
#pragma unroll
                for (int s = 0; s < 4; ++s) bb[s] = frag_row(Ks, LQ, 16 * n, 32 * s, lane);
                SCHED_FENCE();
#pragma unroll
                for (int s = 0; s < 4; ++s) sa = MFMA16(aq[s], bb[s], sa);
#pragma unroll
                for (int r = 0; r < 4; ++r) { const int i = 16 * w + 4 * g + r, j = 16 * n + i16; Qs[i * LQ + j] = (bf16)f2bf(j <= i ? sa[r] : 0.f); } }
            else if (n == w + 1) {
#pragma unroll
                for (int r = 0; r < 4; ++r) Qs[(16 * w + 4 * g + r) * LQ + 16 * n + i16] = (bf16)0; }
        }
        LDS_FENCE();
#pragma unroll
        for (int s = 0; s < 4; ++s) if (s <= (w >> 1)) { const bf16x8 as = frag_row(Qs, LQ, 16 * w, 32 * s, lane); bf16x8 bb[8];
#pragma unroll
            for (int n = 0; n < 8; ++n) bb[n] = frag_tr(Vs, LQ, 32 * s, 16 * n, lane);
            SCHED_FENCE();
#pragma unroll
            for (int n = 0; n < 8; ++n) acco[n] = MFMA16(as, bb[n], acco[n]); }
#pragma unroll
        for (int n = 0; n < 8; ++n) accT[n] = accT[n] * gC;
#pragma unroll
        for (int s = 0; s < 4; ++s) { const bf16x8 ak = frag_tr(Ks, LQ, 32 * s, 16 * w, lane); bf16x8 bb[8];
#pragma unroll
            for (int n = 0; n < 8; ++n) bb[n] = frag_tr(Vs, LQ, 32 * s, 16 * n, lane);
            SCHED_FENCE();
#pragma unroll
            for (int n = 0; n < 8; ++n) accT[n] = MFMA16(ak, bb[n], accT[n]); }
        bf16 gvr[4][8]; float rrv[4];
#pragma unroll
        for (int r = 0; r < 4; ++r) { const int pos = t0 + 16 * w + 4 * g + r; const bf16* gr = zb + (size_t)pos * NZ + Z_RG + i16; rrv[r] = rstd1[pos];
#pragma unroll
            for (int n = 0; n < 8; ++n) gvr[r][n] = gr[16 * n]; }
        LDS_FENCE();
        __syncthreads();
#pragma unroll
        for (int n = 0; n < 8; ++n)
#pragma unroll
            for (int r = 0; r < 4; ++r) Ts[(16 * w + 4 * g + r) * LQ + 16 * n + i16] = (bf16)f2bf(gC * accT[n][r]);
#pragma unroll
        for (int r = 0; r < 4; ++r) {
            float s = 0.f;
#pragma unroll
            for (int n = 0; n < 8; ++n) s += acco[n][r];
            const float mean = red16_sum(s) * (1.f / 128.f); float q = 0.f;
#pragma unroll
            for (int n = 0; n < 8; ++n) { const float d = acco[n][r] - mean; q += d * d; }
            const float rstd = rsqrtf(red16_sum(q) * (1.f / 128.f) + 1e-5f);
            const int pos = t0 + 16 * w + 4 * g + r; bf16* yr = yb + (size_t)pos * 1024; const float rri = rrv[r];
#pragma unroll
            for (int n = 0; n < 8; ++n) { const int e = 16 * n + i16; const float gv = bf1(gvr[r][n]) * rri; yr[e] = (bf16)f2bf((acco[n][r] - mean) * rstd * gnv[n] * gv * sigm(gv)); }
        }
    }
    __syncthreads();
#undef RET_FETCH
}
constexpr int LK = 72, LV = 168;
__device__ __forceinline__ float scan64_sum(float x, int lane) {
#pragma unroll
    for (int o = 1; o < 64; o <<= 1) { const float y = __shfl_up(x, o); if (lane >= o) x += y; }
    return x; }
__device__ __forceinline__ float scan64_max(float x, int lane) {
#pragma unroll
    for (int o = 1; o < 64; o <<= 1) { const float y = __shfl_up(x, o); if (lane >= o) x = fmaxf(x, y); }
    return x; }
__device__ __forceinline__ void mlstm_unit(Frame& F, const float* nw, int b, int h) {
    LAS bf16* Qm = (LAS bf16*)(F.lds); LAS bf16* Km = Qm + 128 * LK; LAS bf16* Kw = Km + 128 * LK; LAS bf16* Vm = Kw + 128 * LK; LAS bf16* Pm = Vm + 128 * LV; LAS bf16* Cm = Pm + 128 * LQ;
    const int tid = F.tid, lane = F.lane, w = F.wave, i16 = lane & 15, g = lane >> 4;
    const int dt = w & 3, eh = w >> 2;
    f32x4 accC[5];
#pragma unroll
    for (int k = 0; k < 5; ++k) accC[k] = (f32x4){0.f, 0.f, 0.f, 0.f};
    for (int i = tid; i < 64 * LV / 8; i += NWAVES * 64) ((LAS v4u*)Cm)[i] = (v4u){0u, 0u, 0u, 0u};
    float m_prev = 0.f;
    const bf16* zb = WSP(bf16, WS_Z) + (size_t)(b * SEQ) * NZ;
    const float* gif = WSP(float, WS_GIF) + (size_t)(b * SEQ) * 16;
    bf16* yb = WSP(bf16, WS_Y) + (size_t)M * 1024 + (size_t)(b * SEQ) * 1024 + h * 128;
    const int lr = tid >> 2, dg = tid & 3;
    v4u pq[2], pk[2]; float fl0, fl1, il0, il1, prr;
    const float* rstd1 = WSP(float, WS_RSTD) + (size_t)(b * SEQ);
#define ML_FETCH(t0_) do { const bf16* zr_ = zb + (size_t)((t0_) + lr) * NZ; \
        pq[0] = *(const v4u*)(zr_ + Z_MQ + h * 64 + 16 * dg); pq[1] = *(const v4u*)(zr_ + Z_MQ + h * 64 + 16 * dg + 8); pk[0] = *(const v4u*)(zr_ + Z_MK + h * 64 + 16 * dg); pk[1] = *(const v4u*)(zr_ + Z_MK + h * 64 + 16 * dg + 8); \
        fl0 = gif[(size_t)((t0_) + lane) * 16 + 8 + h]; fl1 = gif[(size_t)((t0_) + 64 + lane) * 16 + 8 + h]; il0 = gif[(size_t)((t0_) + lane) * 16 + h]; il1 = gif[(size_t)((t0_) + 64 + lane) * 16 + h]; prr = rstd1[(t0_) + lr]; } while (0)
    ML_FETCH(0);
    float nwv[8];
#pragma unroll
    for (int n = 0; n < 8; ++n) nwv[n] = nw[h * 128 + 16 * n + i16];
    for (int c = 0; c < SEQ / 128; ++c) {
        const int t0 = c * 128;
        const float a0 = scan64_sum(fl0, lane); const float a1 = scan64_sum(fl1, lane) + __shfl(a0, 63);
        const float b0 = il0 - a0, b1 = il1 - a1;
        const float pm0 = scan64_max(b0, lane); const float pm1 = fmaxf(scan64_max(b1, lane), __shfl(pm0, 63));
        const float a_last = __shfl(a1, 63), bmax = __shfl(pm1, 63);
        const float g_n = a_last + bmax, m_new = fmaxf(a_last + m_prev, g_n), s_old = __expf(a_last + m_prev - m_new), s_new = __expf(g_n - m_new);
        {
            const int r = lr;
            const float br = (r < 64) ? __shfl(b0, r & 63) : __shfl(b1, r & 63);
            const float rk = prr * 0.125f, wk = __expf(br - bmax) * rk * s_new;
#pragma unroll
            for (int hh = 0; hh < 2; ++hh) {
                *(LAS v4u*)(Qm + r * LK + 16 * dg + 8 * hh) = pq[hh];
                const v4u kk = pk[hh];
                float kf[8] = {bflo(kk.x), bfhi(kk.x), bflo(kk.y), bfhi(kk.y), bflo(kk.z), bfhi(kk.z), bflo(kk.w), bfhi(kk.w)};
                *(LAS v4u*)(Km + r * LK + 16 * dg + 8 * hh) = (v4u){pk2(kf[0] * rk, kf[1] * rk), pk2(kf[2] * rk, kf[3] * rk), pk2(kf[4] * rk, kf[5] * rk), pk2(kf[6] * rk, kf[7] * rk)};
                *(LAS v4u*)(Kw + r * LK + 16 * dg + 8 * hh) = (v4u){pk2(kf[0] * wk, kf[1] * wk), pk2(kf[2] * wk, kf[3] * wk), pk2(kf[4] * wk, kf[5] * wk), pk2(kf[6] * wk, kf[7] * wk)};
            }
#pragma unroll
            for (int q = 0; q < 4; ++q) { const v4u x = *(const v4u*)(zb + (size_t)(t0 + r) * NZ + Z_MV + h * 128 + 32 * dg + 8 * q); const float rv = prr;
                *(LAS v4u*)(Vm + r * LV + 32 * dg + 8 * q) = (v4u){pk2(bflo(x.x) * rv, bfhi(x.x) * rv), pk2(bflo(x.y) * rv, bfhi(x.y) * rv), pk2(bflo(x.z) * rv, bfhi(x.z) * rv), pk2(bflo(x.w) * rv, bfhi(x.w) * rv)}; }
            *(LAS v4u*)(Vm + r * LV + 128 + 8 * dg) = (v4u){dg == 0 ? 0x00003f80u : 0u, 0u, 0u, 0u};
            if (c + 1 < SEQ / 128) ML_FETCH(t0 + 128);
        }
        __syncthreads();
        float Mi[4], ai[4], rri[4];
#pragma unroll
        for (int r = 0; r < 4; ++r) { const int i = 16 * w + 4 * g + r; rri[r] = rstd1[t0 + i]; const float pmi = (w < 4) ? __shfl(pm0, i & 63) : __shfl(pm1, i & 63); ai[r] = (w < 4) ? __shfl(a0, i & 63) : __shfl(a1, i & 63); Mi[r] = fmaxf(pmi, m_prev); }
        bf16x8 aq[2];
#pragma unroll
        for (int s = 0; s < 2; ++s) aq[s] = frag_row(Qm, LK, 16 * w, 32 * s, lane);
        f32x4 acco[9];
#pragma unroll
        for (int n = 0; n < 9; ++n) acco[n] = (f32x4){0.f, 0.f, 0.f, 0.f};
#pragma unroll
        for (int s = 0; s < 2; ++s) {
#pragma unroll
          for (int hf = 0; hf < 2; ++hf) { bf16x8 bb[5];
#pragma unroll
            for (int n = 0; n < 5 - hf; ++n) bb[n] = frag_tr(Cm, LV, 32 * s, 16 * (5 * hf + n), lane);
            SCHED_FENCE();
#pragma unroll
            for (int n = 0; n < 5 - hf; ++n) acco[5 * hf + n] = MFMA16(aq[s], bb[n], acco[5 * hf + n]); } }
        { float si[4];
#pragma unroll
          for (int r = 0; r < 4; ++r) si[r] = __expf(m_prev - Mi[r]) * rri[r];
#pragma unroll
          for (int n = 0; n < 9; ++n)
#pragma unroll
            for (int r = 0; r < 4; ++r) acco[n][r] *= si[r]; }
        LDS_FENCE();
#pragma unroll
        for (int n = 0; n < 8; ++n) {
            if (n <= w) { f32x4 sa = (f32x4){0.f, 0.f, 0.f, 0.f}; bf16x8 bb[2];
#pragma unroll
                for (int s = 0; s < 2; ++s) bb[s] = frag_row(Km, LK, 16 * n, 32 * s, lane);
                SCHED_FENCE();
#pragma unroll
                for (int s = 0; s < 2; ++s) sa = MFMA16(aq[s], bb[s], sa);
                const int j = 16 * n + i16; const float bj = (n < 4) ? __shfl(b0, j & 63) : __shfl(b1, j & 63);
#pragma unroll
                for (int r = 0; r < 4; ++r) { const int i = 16 * w + 4 * g + r; Pm[i * LQ + j] = (bf16)f2bf(j <= i ? sa[r] * rri[r] * __expf(bj - Mi[r]) : 0.f); } }
            else if (n == w + 1) {
#pragma unroll
                for (int r = 0; r < 4; ++r) Pm[(16 * w + 4 * g + r) * LQ + 16 * n + i16] = (bf16)0; }
        }
        LDS_FENCE();
#pragma unroll
        for (int s = 0; s < 4; ++s) if (s <= (w >> 1)) { const bf16x8 ap = frag_row(Pm, LQ, 16 * w, 32 * s, lane);
#pragma unroll
          for (int hf = 0; hf < 2; ++hf) { bf16x8 bb[5];
#pragma unroll
            for (int n = 0; n < 5 - hf; ++n) bb[n] = frag_tr(Vm, LV, 32 * s, 16 * (5 * hf + n), lane);
            SCHED_FENCE();
#pragma unroll
            for (int n = 0; n < 5 - hf; ++n) acco[5 * hf + n] = MFMA16(ap, bb[n], acco[5 * hf + n]); } }
#pragma unroll
        for (int k = 0; k < 5; ++k) accC[k] = accC[k] * s_old;
#pragma unroll
        for (int s = 0; s < 4; ++s) { const bf16x8 ak = frag_tr(Kw, LK, 32 * s, 16 * dt, lane); bf16x8 bb[5];
#pragma unroll
            for (int k = 0; k < 5; ++k) bb[k] = frag_tr(Vm, LV, 32 * s, 16 * (5 * eh + k), lane);
            SCHED_FENCE();
#pragma unroll
            for (int k = 0; k < 5; ++k) accC[k] = MFMA16(ak, bb[k], accC[k]); }
        bf16 gvr[4][8];
#pragma unroll
        for (int r = 0; r < 4; ++r) { const bf16* gr = zb + (size_t)(t0 + 16 * w + 4 * g + r) * NZ + Z_MO + h * 128 + i16;
#pragma unroll
            for (int n = 0; n < 8; ++n) gvr[r][n] = gr[16 * n]; }
        LDS_FENCE();
        __syncthreads();
#pragma unroll
        for (int k = 0; k < 5; ++k)
#pragma unroll
            for (int r = 0; r < 4; ++r) Cm[(16 * dt + 4 * g + r) * LV + 16 * (5 * eh + k) + i16] = (bf16)f2bf(accC[k][r]);
#pragma unroll
        for (int r = 0; r < 4; ++r) {
            const float den = __shfl(acco[8][r], lane & 48);
            const float dd = 1.0f / fmaxf(fabsf(den), __expf(-(ai[r] + Mi[r])));
            float q = 0.f;
#pragma unroll
            for (int n = 0; n < 8; ++n) { acco[n][r] *= dd; q += acco[n][r] * acco[n][r]; }
            const float rstd = rsqrtf(red16_sum(q) * (1.f / 128.f) + 1e-6f);
            const int pos = t0 + 16 * w + 4 * g + r; bf16* yr = yb + (size_t)pos * 1024;
#pragma unroll
            for (int n = 0; n < 8; ++n) { const int e = 16 * n + i16; yr[e] = (bf16)f2bf(acco[n][r] * rstd * nwv[n] * sigm(bf1(gvr[r][n]) * rri[r])); }
        }
        m_prev = m_new;
    }
    __syncthreads();
#undef ML_FETCH
}
__device__ __forceinline__ int vt_off(int row, int chunk) { return row * 128 + ((chunk ^ ((row & 7) << 1)) << 3); }
__device__ __forceinline__ bf16x8 frag_trp(const LAS bf16* X, int k0, int c0, int lane) {
    const int g = lane >> 4, q = (lane & 15) >> 2, p = lane & 3;
    const LAS bf16* a = X + vt_off(k0 + 4 * g + q, (c0 >> 3) + (p >> 1)) + 4 * (p & 1);
    const s16x4 lo = __builtin_amdgcn_ds_read_tr16_b64_v4i16((LAS s16x4*)a);
    const s16x4 hi = __builtin_amdgcn_ds_read_tr16_b64_v4i16((LAS s16x4*)(a + 16 * 128));
    return __builtin_shufflevector(lo, hi, 0, 1, 2, 3, 4, 5, 6, 7);
}
__device__ __forceinline__ void moba_unit(Frame& F, int b, int h, int qi) {
    constexpr int KT_E = 128 * LQ, VT_E = 128 * 128;
    LAS bf16* Kt0 = (LAS bf16*)(F.lds); LAS bf16* Vt0 = Kt0 + 2 * KT_E;
    const int tid = F.tid, lane = F.lane, w = tid >> 6, i16 = lane & 15, g = lane >> 4;
    const int blk = qi >> 1, qt = qi & 1, q0 = qi * 128;
    const bf16* zb = WSP(bf16, WS_Z) + (size_t)(b * SEQ) * NZ + h * 128;
    bf16x8 aq[4];
    { const bf16* qr = zb + (size_t)(q0 + 16 * w + i16) * NZ + Z_AQ + 8 * g;
#pragma unroll
      for (int s = 0; s < 4; ++s) aq[s] = *(const bf16x8*)(qr + 32 * s); }
    const int lr = tid >> 2, dg = tid & 3;
    v4u pk[4], pv[4];
#define MB_FETCH(k0_) do { const bf16* zr_ = zb + (size_t)((k0_) + lr) * NZ + 32 * dg; \
        _Pragma("unroll") for (int q_ = 0; q_ < 4; ++q_) { pk[q_] = *(const v4u*)(zr_ + Z_AK + 8 * q_); pv[q_] = *(const v4u*)(zr_ + Z_AV + 8 * q_); } } while (0)
#define MB_STAGE(buf_) do { LAS bf16* kd_ = Kt0 + (buf_) * KT_E + lr * LQ + 32 * dg; LAS bf16* vd_ = Vt0 + (buf_) * VT_E; \
        _Pragma("unroll") for (int q_ = 0; q_ < 4; ++q_) { *(LAS v4u*)(kd_ + 8 * q_) = pk[q_]; *(LAS v4u*)(vd_ + vt_off(lr, 4 * dg + q_)) = pv[q_]; } } while (0)
    MB_FETCH(0);
    unsigned sel = 0u;
    {
        float gate[8];
        const float* km = WSP(float, WS_KMEAN) + (size_t)((b * NH + h) * 16) * 128 + 8 * g;
#pragma unroll
        for (int n = 0; n < 8; ++n) { gate[n] = -INFINITY;
            if (n < blk) { float p = 0.f;
#pragma unroll
                for (int s = 0; s < 4; ++s) { const f32x4 k0 = *(const f32x4*)(km + n * 256 + 32 * s) + *(const f32x4*)(km + n * 256 + 128 + 32 * s), k1 = *(const f32x4*)(km + n * 256 + 32 * s + 4) + *(const f32x4*)(km + n * 256 + 128 + 32 * s + 4);
                    p += bf1((bf16)aq[s][0]) * k0.x + bf1((bf16)aq[s][1]) * k0.y + bf1((bf16)aq[s][2]) * k0.z + bf1((bf16)aq[s][3]) * k0.w
                       + bf1((bf16)aq[s][4]) * k1.x + bf1((bf16)aq[s][5]) * k1.y + bf1((bf16)aq[s][6]) * k1.z + bf1((bf16)aq[s][7]) * k1.w; }
                p += __shfl_xor(p, 16); p += __shfl_xor(p, 32); gate[n] = p; } }
#pragma unroll
        for (int s = 0; s < 3; ++s) { float bv = -INFINITY; int best = -1;
#pragma unroll
            for (int n = 0; n < 8; ++n) { const bool c = !((sel >> n) & 1u) && gate[n] > bv; bv = c ? gate[n] : bv; best = c ? n : best; }
            if (best >= 0) sel |= 1u << best; }
    }
#pragma unroll
    for (int s = 0; s < 4; ++s) { const v4u u = __builtin_bit_cast(v4u, aq[s]); const float c2 = 0.08838834764831845f * 1.4426950408889634f;
        const v4u o = (v4u){pk2(bflo(u.x) * c2, bfhi(u.x) * c2), pk2(bflo(u.y) * c2, bfhi(u.y) * c2), pk2(bflo(u.z) * c2, bfhi(u.z) * c2), pk2(bflo(u.w) * c2, bfhi(u.w) * c2)}; aq[s] = __builtin_bit_cast(bf16x8, o); }
    f32x4 acco[8];
#pragma unroll
    for (int n = 0; n < 8; ++n) acco[n] = (f32x4){0.f, 0.f, 0.f, 0.f};
    float mq = -1e30f, lq = 0.f;
    const int ntiles = 2 * blk + qt + 1;
    const int qrel = 16 * w + i16 - 4 * g;
    __syncthreads();
    MB_STAGE(0);
    if (ntiles > 1) MB_FETCH(128);
    __syncthreads();
    for (int kt = 0; kt < ntiles; ++kt) {
        const int kb = kt >> 1; const bool own = (kb == blk), diag = (kt == 2 * blk + qt);
        const LAS bf16* Kt = Kt0 + (kt & 1) * KT_E; const LAS bf16* Vt = Vt0 + (kt & 1) * VT_E;
        f32x4 sc[8];
#pragma unroll
        for (int n = 0; n < 8; ++n) sc[n] = (f32x4){0.f, 0.f, 0.f, 0.f};
#pragma unroll
        for (int s = 0; s < 4; ++s) { bf16x8 bb[8];
#pragma unroll
            for (int n = 0; n < 8; ++n) bb[n] = frag_row(Kt, LQ, 16 * n, 32 * s, lane);
            SCHED_FENCE();
#pragma unroll
            for (int n = 0; n < 8; ++n) sc[n] = MFMA16(bb[n], aq[s], sc[n]); }
        if (diag) {
#pragma unroll
            for (int n = 0; n < 8; ++n)
#pragma unroll
                for (int r = 0; r < 4; ++r) sc[n][r] = (16 * n + r <= qrel) ? sc[n][r] : -1e30f; }
        const bool rowok = own || ((sel >> kb) & 1u);
        float mx = -1e30f;
#pragma unroll
        for (int n = 0; n < 8; ++n) mx = fmaxf(mx, fmaxf(fmaxf(sc[n][0], sc[n][1]), fmaxf(sc[n][2], sc[n][3])));
        mx = fmaxf(mx, __shfl_xor(mx, 16)); mx = fmaxf(mx, __shfl_xor(mx, 32));
        const float mnew = rowok ? fmaxf(mq, mx) : mq;
        const float alpha = __builtin_amdgcn_exp2f(mq - mnew); mq = mnew;
        const float msub = rowok ? mnew : 1e30f;
        float ps = 0.f;
#pragma unroll
        for (int n = 0; n < 8; ++n)
#pragma unroll
            for (int r = 0; r < 4; ++r) { sc[n][r] = __builtin_amdgcn_exp2f(sc[n][r] - msub); ps += sc[n][r]; }
        lq = lq * alpha + ps;
#pragma unroll
        for (int n = 0; n < 8; ++n) acco[n] = acco[n] * alpha;
#pragma unroll
        for (int t = 0; t < 4; ++t) {
            const v4u pw = (v4u){pk2(sc[2 * t][0], sc[2 * t][1]), pk2(sc[2 * t][2], sc[2 * t][3]), pk2(sc[2 * t + 1][0], sc[2 * t + 1][1]), pk2(sc[2 * t + 1][2], sc[2 * t + 1][3])};
            const bf16x8 pf = __builtin_bit_cast(bf16x8, pw); bf16x8 bb[8];
#pragma unroll
            for (int n = 0; n < 8; ++n) bb[n] = frag_trp(Vt, 32 * t, 16 * n, lane);
            SCHED_FENCE();
#pragma unroll
            for (int n = 0; n < 8; ++n) acco[n] = MFMA16(bb[n], pf, acco[n]); }
        if (kt + 1 < ntiles) { MB_STAGE((kt + 1) & 1); if (kt + 2 < ntiles) MB_FETCH((kt + 2) * 128); }
        __syncthreads();
    }
    lq += __shfl_xor(lq, 16); lq += __shfl_xor(lq, 32);
    const float inv = 1.0f / lq;
    bf16* yr = WSP(bf16, WS_Y) + (size_t)2 * M * 1024 + (size_t)(b * SEQ + q0 + 16 * w + i16) * 1024 + h * 128 + 4 * g;
#pragma unroll
    for (int n = 0; n < 8; ++n) *(v2u*)(yr + 16 * n) = (v2u){pk2(acco[n][0] * inv, acco[n][1] * inv), pk2(acco[n][2] * inv, acco[n][3] * inv)};
#undef MB_FETCH
#undef MB_STAGE
}
__device__ __forceinline__ void mix_phase(Frame& F, const float* rgn, const float* mln, unsigned* head) {
    volatile LAS unsigned* slot = F.MISC;
    for (;;) {
        if (F.tid == 0) slot[0] = __hip_atomic_fetch_add(head, 1u, __ATOMIC_RELAXED, __HIP_MEMORY_SCOPE_AGENT);
        __syncthreads();
        const unsigned it = slot[0];
        __syncthreads();
        if (it >= 128u + 1024u) break;
        { int t_ = threadIdx.x; asm volatile("" : "+v"(t_)); F.tid = t_; F.lane = t_ & 63; }
        if (it < 64u) ret_unit(F, rgn, (int)(it >> 3), (int)(it & 7u));
        else if (it < 128u) mlstm_unit(F, mln, (int)((it - 64u) >> 3), (int)(it & 7u));
        else { const unsigned rank = it - 128u; moba_unit(F, (int)((rank & 63u) >> 3), (int)(rank & 7u), 15 - (int)(rank >> 6)); }
    }
}
}
constexpr int N_PHASES = 1 + 8 * DEPTH;
__global__ void __launch_bounds__(NWAVES * 64, 2) fwd(Args args) {
    extern __shared__ __attribute__((aligned(16))) unsigned char lds[];
    Frame F;
    F.lds = (LAS unsigned char*)lds;
    F.MISC = (volatile LAS unsigned*)(F.lds + MISC_OFF);
    F.tid = threadIdx.x; F.lane = F.tid & 63; F.wave = __builtin_amdgcn_readfirstlane(F.tid >> 6); F.G = gridDim.x; F.bx = blockIdx.x;
    F.ws = args.ws;
    for (int u = F.tid; u < (LDS_BYTES - LDSCTL_OFF) / 4; u += NWAVES * 64) ((LAS unsigned*)(F.lds + LDSCTL_OFF))[u] = 0u;
    __syncthreads();
    XcdBarrier bar = xcd_barrier_post((unsigned*)(F.ws + WS_CTL) + CW_BAR + args.li * XCD_BAR_WORDS, F.MISC + 8);
    const int lo = args.ph_lo, hi = args.ph_hi;
#define RUN(p) (lo <= (p) && (p) < hi)
#define SEAM(p) do { if ((p) + 1 < hi) xcd_barrier(bar); } while (0)
    if (RUN(0)) { p0_prologue(F, args); SEAM(0); }
    for (int l = 0; l < DEPTH; ++l) {
        const int p0 = 1 + 8 * l;
        { int t_ = threadIdx.x; asm volatile("" : "+v"(t_)); F.tid = t_; F.lane = t_ & 63; F.wave = __builtin_amdgcn_readfirstlane(t_ >> 6); int b_ = blockIdx.x; asm volatile("" : "+s"(b_)); F.bx = b_; }
        float* rs = WSP(float, WS_RS) + (size_t)(2 * l) * M * 32;
        if (RUN(p0 + 0)) {
            pg8::Gemm g{WSP(bf16, WS_XB), WSP(bf16, WS_WIN) + (size_t)l * NZ * DM, M, NZ, DM}; pg8::StaticOrder S; S.init(M, NZ, F.G, F.bx);
            pg8::EpiBf16 E{WSP(bf16, WS_Z), NZ, F.ws + WS_ZG, Z_GA / 256, 3 * DM};
            pg8::gemm_phase<pg8::EpiBf16, pg8::StaticOrder, false, true>(F.lds + RING_OFF, g, S, E);
            SEAM(p0 + 0); }
        if (RUN(p0 + 1)) { prep_phase(F, args.in[I_QN] + l * 128, args.in[I_KN] + l * 128, WSP(bf16, WS_W16G) + (size_t)l * 16 * DM, rs, args.in[I_BIG] + l * 8, args.in[I_BFG] + l * 8); SEAM(p0 + 1); }
        if (RUN(p0 + 2)) { mx::mix_phase(F, args.in[I_RGN] + l * 1024, args.in[I_MLN] + l * 1024, (unsigned*)(F.ws + WS_CTL) + CW_QUEUE + 64 * l); SEAM(p0 + 2); }
        if (RUN(p0 + 3)) {
            pg8::StaticOrder3 S; S.init(M, DM, F.G, F.bx);
            pg8::Gemm g{WSP(bf16, WS_Y), WSP(bf16, WS_WP) + (size_t)l * 3 * DM * 1024, M, DM, 1024, (size_t)M * 1024, (size_t)DM * 1024}; pg8::EpiGateAcc E{WSP(bf16, WS_MG), DM, F.ws + WS_ZG, 3 * DM, WSP(float, WS_RSTD)};
            pg8::gemm_phase<pg8::EpiGateAcc, pg8::StaticOrder3, true, true>(F.lds + RING_OFF, g, S, E);
            SEAM(p0 + 3); }
        if (RUN(p0 + 4)) {
            pg8::Gemm g{WSP(bf16, WS_MG), WSP(bf16, WS_WOUT) + (size_t)l * DM * DM, M, DM, DM}; pg8::StaticOrder S; S.init(M, DM, F.G, F.bx);
            pg8::EpiRes<false> E{WSP(bf16, WS_XB), rs + (size_t)32 * M, nullptr, DM};
            pg8::gemm_phase<pg8::EpiRes<false>, pg8::StaticOrder, true, true>(F.lds + RING_OFF, g, S, E);
            SEAM(p0 + 4); }
        if (RUN(p0 + 5)) {
            pg8::Gemm g{WSP(bf16, WS_XB), WSP(bf16, WS_WUP) + (size_t)l * NUP * DM, M, NUP, DM}; pg8::StaticOrder S; S.init(M, NUP, F.G, F.bx);
            pg8::EpiBf16 E{WSP(bf16, WS_Z), NUP, nullptr, -1, 0};
            pg8::gemm_phase<pg8::EpiBf16, pg8::StaticOrder, false, true>(F.lds + RING_OFF, g, S, E);
            SEAM(p0 + 5); }
        if (RUN(p0 + 6)) { glu_phase(F, args.in[I_CW] + (size_t)l * 3 * NUP, args.in[I_CB] + (size_t)l * NUP, rs + (size_t)32 * M); SEAM(p0 + 6); }
        if (RUN(p0 + 7)) {
            pg8::Gemm g{WSP(bf16, WS_ACT), WSP(bf16, WS_WDN) + (size_t)l * DM * DFF, M, DM, DFF}; pg8::StaticOrder S; S.init(M, DM, F.G, F.bx);
            if (l + 1 < DEPTH) { pg8::EpiRes<false> E{WSP(bf16, WS_XB), rs + (size_t)64 * M, nullptr, DM};
                pg8::gemm_phase<pg8::EpiRes<false>, pg8::StaticOrder, true, true>(F.lds + RING_OFF, g, S, E); }
            else { pg8::EpiRes<true> E{WSP(bf16, WS_XB), nullptr, args.out, DM};
                pg8::gemm_phase<pg8::EpiRes<true>, pg8::StaticOrder, true, true>(F.lds + RING_OFF, g, S, E); }
            SEAM(p0 + 7); }
    }
#undef RUN
#undef SEAM
}

#ifndef MK_N_LAUNCHES
#define MK_N_LAUNCHES 1
#endif
extern "C" void kernel_launch(void* const* d_in, const int* in_sizes, int n_in, void* d_out, int out_size, void* d_ws, size_t ws_size, hipStream_t stream) {
    static int grid = 0;
    if (grid == 0) {
        if (n_in != 18 || in_sizes[0] != M * DM || out_size != M * DM || ws_size < WS_END) { fprintf(stderr, "kernel_launch: unexpected shapes (n_in %d, in0 %d, out %d, ws %zu)\n", n_in, n_in > 0 ? in_sizes[0] : -1, out_size, ws_size); grid = -1; return; }
        int dev = 0, cus = 0, per_cu = 0;
        if (hipGetDevice(&dev) != hipSuccess || hipDeviceGetAttribute(&cus, hipDeviceAttributeMultiprocessorCount, dev) != hipSuccess) { grid = -1; return; }
        if (hipFuncSetAttribute((const void*)fwd, hipFuncAttributeMaxDynamicSharedMemorySize, LDS_BYTES) != hipSuccess) { fprintf(stderr, "kernel_launch: hipFuncSetAttribute failed\n"); grid = -1; return; }
        if (hipOccupancyMaxActiveBlocksPerMultiprocessor(&per_cu, (const void*)fwd, NWAVES * 64, LDS_BYTES) != hipSuccess || per_cu < 1) fprintf(stderr, "kernel_launch: occupancy query reports %d\n", per_cu);
        (void)hipGetLastError();
        grid = cus;
    }
    if (grid < 0) return;
    if (hipMemsetAsync((char*)d_ws + WS_CTL, 0, CTL_ZERO_BYTES, stream) != hipSuccess) return;
    Args a{};
    for (int i = 0; i < 18; ++i) a.in[i] = (const float*)d_in[i];
    a.out = (float*)d_out; a.ws = (unsigned char*)d_ws; a.pad = 0;
    constexpr int NL = MK_N_LAUNCHES;
    for (int li = 0; li < NL; ++li) {
        a.ph_lo = (NL == 1) ? 0 : li; a.ph_hi = (NL == 1) ? N_PHASES : li + 1; a.li = (NL == 1) ? 0 : 0;
        hipLaunchKernelGGL(fwd, dim3(grid), dim3(NWAVES * 64), LDS_BYTES, stream, a);
    }
}
```

```cpp
#include <hip/hip_runtime.h>
#include <cstdio>
#include <cstdint>
namespace pg8 {
#define PG8_LAS __attribute__((address_space(3)))
typedef unsigned short bf16_t;
typedef short bf16x8 __attribute__((ext_vector_type(8)));
typedef float f32x4 __attribute__((ext_vector_type(4)));
typedef unsigned u32x4 __attribute__((ext_vector_type(4)));
constexpr int BM = 256, BK = 64, HALF = 128, HTB = HALF * BK * 2  , STAGE_BYTES = 8 * HTB, NXCD = 8, WGM = 8;

__host__ __device__ __forceinline__ int lds_byte(int r, int c) { const int st = (r >> 4) * 2 + (c >> 5), rr = r & 15, cc = c & 31, ob = rr * 64 + cc * 2; return st * 1024 + (ob ^ (((ob >> 9) & 1) << 5)); }
__host__ __device__ __forceinline__ void stage_rc(int b, int& R, int& C) { const int st = b / 1024, sb = b % 1024, swz = sb ^ (((sb >> 9) & 1) << 5); R = (st >> 1) * 16 + swz / 64; C = (st & 1) * 32 + (swz % 64) / 2; }
__host__ __device__ __forceinline__ int perm32(int rho) { const int n = rho >> 4, i = rho & 15; return 8 * (i >> 2) + 4 * n + (i & 3); }

struct Unit { int pm, pn, z; };
struct Gemm { const bf16_t* A; const bf16_t* Bt; int M, N, K; size_t zA, zB; };

struct StaticOrder {
    int nM, nN, nwg, G, c;
    __host__ __device__ void init(int M, int N, int G_, int c_) { nM = M / BM; nN = N / BM; nwg = nM * nN; G = G_; c = c_; }
    __host__ __device__ bool next(int i, Unit& u) const {
        const long L = (long)i * G + c; if (L >= nwg) return false;
        int wgid = (int)L; { const int q = nwg / NXCD, r = nwg % NXCD, xcd = wgid % NXCD, off = wgid / NXCD; wgid = (xcd < r ? xcd * (q + 1) : r * (q + 1) + (xcd - r) * q) + off; }
        const int nig = WGM * nN, gid = wgid / nig, fm = gid * WGM, gsz = (nM - fm) < WGM ? (nM - fm) : WGM;
        u.pm = fm + ((wgid % nig) % gsz); u.pn = (wgid % nig) / gsz; u.z = 0; return true;
    }
    __device__ __forceinline__ void a_ready(const Unit&) const {}
    __device__ __forceinline__ void done(const Unit&) const {}
};

struct StaticOrder3 : StaticOrder {
    __host__ __device__ bool next(int i, Unit& u) const { if (!StaticOrder::next(i / 3, u)) return false; u.z = i % 3; return true; }
};
__device__ __forceinline__ unsigned cvt_pk_bf16(float lo, float hi) { unsigned r; asm volatile("v_cvt_pk_bf16_f32 %0, %1, %2" : "=v"(r) : "v"(lo), "v"(hi)); return r; }
typedef unsigned u32x2 __attribute__((ext_vector_type(2)));
struct EpiBf16 {
    static constexpr bool PERM = true, AFTER_DRAIN = false, KEEP = false, APERM = false;
    bf16_t* O; int ldc; unsigned char* G8; int g8_pn0, g8_ld;
    __device__ __forceinline__ void operator()(const f32x4 (&acc)[2][2][4][2], const Unit& u, int wr, int wc, int fr, int fq) const {
        const int row0 = u.pm * BM + wr * 64 + fr; const int col0 = u.pn * BM + wc * 32 + 8 * fq;
        if (g8_pn0 >= 0 && u.pn >= g8_pn0) { const int gc0 = (u.pn - g8_pn0) * BM + wc * 32 + 8 * fq;
#pragma unroll
            for (int ai = 0; ai < 2; ++ai)
#pragma unroll
                for (int m = 0; m < 4; ++m) { unsigned char* rowp = G8 + (size_t)(row0 + ai * HALF + m * 16) * g8_ld + gc0;
#pragma unroll
                    for (int bj = 0; bj < 2; ++bj) { const f32x4 v0 = acc[ai][bj][m][0], v1 = acc[ai][bj][m][1]; u32x2 w;
                        w.x = (unsigned)__builtin_amdgcn_cvt_pk_fp8_f32(v0[2], v0[3], __builtin_amdgcn_cvt_pk_fp8_f32(v0[0], v0[1], 0, false), true);
                        w.y = (unsigned)__builtin_amdgcn_cvt_pk_fp8_f32(v1[2], v1[3], __builtin_amdgcn_cvt_pk_fp8_f32(v1[0], v1[1], 0, false), true);
                        *(u32x2*)(rowp + bj * HALF) = w; } }
            return; }
#pragma unroll
        for (int ai = 0; ai < 2; ++ai)
#pragma unroll
            for (int m = 0; m < 4; ++m) { bf16_t* rowp = O + (size_t)(row0 + ai * HALF + m * 16) * ldc + col0;
#pragma unroll
                for (int bj = 0; bj < 2; ++bj) { const f32x4 v0 = acc[ai][bj][m][0], v1 = acc[ai][bj][m][1];
                    u32x4 w; w.x = cvt_pk_bf16(v0[0], v0[1]); w.y = cvt_pk_bf16(v0[2], v0[3]); w.z = cvt_pk_bf16(v1[0], v1[1]); w.w = cvt_pk_bf16(v1[2], v1[3]);
                    *(u32x4*)(rowp + bj * HALF) = w; } }
    }
};
__device__ __forceinline__ float bf_lo(unsigned w) { return __uint_as_float(w << 16); }
__device__ __forceinline__ float bf_hi(unsigned w) { return __uint_as_float(w & 0xffff0000u); }
__device__ __forceinline__ float sigmoid_f(float x) { return __builtin_amdgcn_rcpf(1.0f + __expf(-x)); }
struct EpiGateAcc {
    static constexpr bool PERM = true, AFTER_DRAIN = false, KEEP = true, APERM = false;
    bf16_t* O; int ldc; const unsigned char* G8; int g8_ld; const float* rstd;
    template <int E> static __device__ __forceinline__ float g8f(const u32x2 w) { return __builtin_amdgcn_cvt_f32_fp8((int)(E < 4 ? w.x : w.y), E & 3); }
    static __device__ __forceinline__ float em(float g, float rr) { return __expf(-fminf(fmaxf(g * rr, -40.f), 40.f)); }
    __device__ __forceinline__ void operator()(f32x4 (&acc)[2][2][4][2], const Unit& u, int wr, int wc, int fr, int fq) const {
        const int row0 = u.pm * BM + wr * 64 + fr; const int col0 = u.pn * BM + wc * 32 + 8 * fq; const bool last = (u.z == 2);
        const unsigned char* Gn = G8 + (size_t)u.z * ldc; const unsigned char* Gd = G8 + (size_t)(last ? u.z : u.z + 1) * ldc;
#pragma unroll
        for (int ai = 0; ai < 2; ++ai)
#pragma unroll
            for (int m = 0; m < 4; ++m) { const size_t row = (size_t)(row0 + ai * HALF + m * 16); const float rr = rstd[row];
#pragma unroll
                for (int bj = 0; bj < 2; ++bj) { f32x4& v0 = acc[ai][bj][m][0]; f32x4& v1 = acc[ai][bj][m][1];
                    const u32x2 gn = *(const u32x2*)(Gn + row * g8_ld + col0 + bj * HALF);
                    const float n0 = em(g8f<0>(gn), rr), n1 = em(g8f<1>(gn), rr), n2 = em(g8f<2>(gn), rr), n3 = em(g8f<3>(gn), rr), n4 = em(g8f<4>(gn), rr), n5 = em(g8f<5>(gn), rr), n6 = em(g8f<6>(gn), rr), n7 = em(g8f<7>(gn), rr);
                    if (!last) { const u32x2 gd = *(const u32x2*)(Gd + row * g8_ld + col0 + bj * HALF);
                        v0[0] *= (1.0f + em(g8f<0>(gd), rr)) * __builtin_amdgcn_rcpf(1.0f + n0); v0[1] *= (1.0f + em(g8f<1>(gd), rr)) * __builtin_amdgcn_rcpf(1.0f + n1);
                        v0[2] *= (1.0f + em(g8f<2>(gd), rr)) * __builtin_amdgcn_rcpf(1.0f + n2); v0[3] *= (1.0f + em(g8f<3>(gd), rr)) * __builtin_amdgcn_rcpf(1.0f + n3);
                        v1[0] *= (1.0f + em(g8f<4>(gd), rr)) * __builtin_amdgcn_rcpf(1.0f + n4); v1[1] *= (1.0f + em(g8f<5>(gd), rr)) * __builtin_amdgcn_rcpf(1.0f + n5);
                        v1[2] *= (1.0f + em(g8f<6>(gd), rr)) * __builtin_amdgcn_rcpf(1.0f + n6); v1[3] *= (1.0f + em(g8f<7>(gd), rr)) * __builtin_amdgcn_rcpf(1.0f + n7); }
                    else { u32x4 w;
                        w.x = cvt_pk_bf16(v0[0] * __builtin_amdgcn_rcpf(1.0f + n0), v0[1] * __builtin_amdgcn_rcpf(1.0f + n1)); w.y = cvt_pk_bf16(v0[2] * __builtin_amdgcn_rcpf(1.0f + n2), v0[3] * __builtin_amdgcn_rcpf(1.0f + n3));
                        w.z = cvt_pk_bf16(v1[0] * __builtin_amdgcn_rcpf(1.0f + n4), v1[1] * __builtin_amdgcn_rcpf(1.0f + n5)); w.w = cvt_pk_bf16(v1[2] * __builtin_amdgcn_rcpf(1.0f + n6), v1[3] * __builtin_amdgcn_rcpf(1.0f + n7));
                        *(u32x4*)(O + row * ldc + col0 + bj * HALF) = w; } } }
    }
};
template <bool LAST> struct EpiRes {
    static constexpr bool PERM = true, AFTER_DRAIN = false, KEEP = false, APERM = false;
    bf16_t* xb; float* rs; float* out; int ldc;
    __device__ __forceinline__ void operator()(const f32x4 (&acc)[2][2][4][2], const Unit& u, int wr, int wc, int fr, int fq) const {
        const int row0 = u.pm * BM + wr * 64 + fr; const int col0 = u.pn * BM + wc * 32 + 8 * fq;
#pragma unroll
        for (int ai = 0; ai < 2; ++ai)
#pragma unroll
            for (int m = 0; m < 4; ++m) { const int row = row0 + ai * HALF + m * 16; const size_t off = (size_t)row * ldc + col0; float sq = 0.f;
#pragma unroll
                for (int bj = 0; bj < 2; ++bj) { const u32x4 p = *(const u32x4*)(xb + off + bj * HALF); const f32x4 v0 = acc[ai][bj][m][0], v1 = acc[ai][bj][m][1];
                    const float o0 = bf_lo(p.x) + v0[0], o1 = bf_hi(p.x) + v0[1], o2 = bf_lo(p.y) + v0[2], o3 = bf_hi(p.y) + v0[3], o4 = bf_lo(p.z) + v1[0], o5 = bf_hi(p.z) + v1[1], o6 = bf_lo(p.w) + v1[2], o7 = bf_hi(p.w) + v1[3];
                    if (LAST) { *(f32x4*)(out + off + bj * HALF) = (f32x4){o0, o1, o2, o3}; *(f32x4*)(out + off + bj * HALF + 4) = (f32x4){o4, o5, o6, o7}; }
                    else { sq += ((o0 * o0 + o1 * o1) + (o2 * o2 + o3 * o3)) + ((o4 * o4 + o5 * o5) + (o6 * o6 + o7 * o7));
                        u32x4 w; w.x = cvt_pk_bf16(o0, o1); w.y = cvt_pk_bf16(o2, o3); w.z = cvt_pk_bf16(o4, o5); w.w = cvt_pk_bf16(o6, o7); *(u32x4*)(xb + off + bj * HALF) = w; } }
                if (!LAST) { sq += __shfl_xor(sq, 16); sq += __shfl_xor(sq, 32); if (fq == 0) rs[(size_t)row * 32 + u.pn * 4 + wc] = sq; } }
    }
};

struct EpiGLU {
    static constexpr bool PERM = true, AFTER_DRAIN = false, KEEP = false, APERM = true;
    bf16_t* ACT; const float* cw; const float* cb; const float* rs; bf16_t* SB;
    static __device__ __forceinline__ f32x4 prev_lane(const f32x4 v, int src) { f32x4 o;
#pragma unroll
        for (int k = 0; k < 4; ++k) o[k] = __shfl(v[k], src); return o; }
    static __device__ __forceinline__ f32x4 silu4(const f32x4 a) { f32x4 o;
#pragma unroll
        for (int k = 0; k < 4; ++k) o[k] = a[k] * __builtin_amdgcn_rcpf(1.0f + __expf(-a[k])); return o; }
    __device__ __forceinline__ void operator()(const f32x4 (&acc)[2][2][4][2], const Unit& u, int wr, int wc, int fr, int fq) const {
        constexpr int DFF_ = 5632, NUP_ = 2 * DFF_;
        const int T0 = u.pm * BM + 8 * (16 * wr + fr), jq = u.pn * HALF + wc * 32 + 8 * fq, grp = 2 * u.pm + wr;
        float s0 = 0.f, s1 = 0.f;
        { const int L = fq * 16 + fr; const float* p0 = rs + (size_t)(u.pm * BM + 128 * wr + 2 * L) * 32;
#pragma unroll
          for (int q = 0; q < 8; ++q) { const f32x4 a = *(const f32x4*)(p0 + 4 * q), b = *(const f32x4*)(p0 + 32 + 4 * q); s0 += (a[0] + a[1]) + (a[2] + a[3]); s1 += (b[0] + b[1]) + (b[2] + b[3]); }
          s0 = __builtin_amdgcn_rsqf(s0 * (1.0f / 2048.0f) + 1e-6f); s1 = __builtin_amdgcn_rsqf(s1 * (1.0f / 2048.0f) + 1e-6f); }
        float rr[8];
#pragma unroll
        for (int i = 0; i < 8; ++i) rr[i] = __shfl((i & 1) ? s1 : s0, 4 * fr + (i >> 1));
#pragma unroll
        for (int n = 0; n < 2; ++n) { const int j = jq + 4 * n;
            const f32x4 ca = *(const f32x4*)(cb + j), cbv = *(const f32x4*)(cb + DFF_ + j);
            const f32x4 a0 = *(const f32x4*)(cw + j), a1 = *(const f32x4*)(cw + NUP_ + j), a2 = *(const f32x4*)(cw + 2 * NUP_ + j);
            const f32x4 b0 = *(const f32x4*)(cw + DFF_ + j), b1 = *(const f32x4*)(cw + NUP_ + DFF_ + j), b2 = *(const f32x4*)(cw + 2 * NUP_ + DFF_ + j);
            f32x4 va[8], vb[8];
#pragma unroll
            for (int i = 0; i < 8; ++i) { va[i] = acc[i >> 2][0][i & 3][n] * rr[i]; vb[i] = acc[i >> 2][1][i & 3][n] * rr[i]; }
            const int psrc = fq * 16 + ((fr + 15) & 15); const f32x4 pa6 = prev_lane(va[6], psrc), pa7 = prev_lane(va[7], psrc), pb6 = prev_lane(vb[6], psrc), pb7 = prev_lane(vb[7], psrc);
#pragma unroll
            for (int i = 0; i < 8; ++i) {
                const f32x4 xa1 = i >= 1 ? va[i - 1] : pa7, xa2 = i >= 2 ? va[i - 2] : (i == 1 ? pa7 : pa6), xb1 = i >= 1 ? vb[i - 1] : pb7, xb2 = i >= 2 ? vb[i - 2] : (i == 1 ? pb7 : pb6);
                const f32x4 ua = ca + a0 * xa2 + a1 * xa1 + a2 * va[i], ub = cbv + b0 * xb2 + b1 * xb1 + b2 * vb[i];
                const f32x4 o = silu4(ua) * ub;
                if (i >= 2 || fr != 0) { u32x2 w; w.x = cvt_pk_bf16(o[0], o[1]); w.y = cvt_pk_bf16(o[2], o[3]); *(u32x2*)(ACT + (size_t)(T0 + i) * DFF_ + j) = w; } }
            if (fr == 0) {
#pragma unroll
                for (int i = 0; i < 2; ++i) { u32x2 w; w.x = cvt_pk_bf16(va[i][0], va[i][1]); w.y = cvt_pk_bf16(va[i][2], va[i][3]); *(u32x2*)(SB + ((size_t)grp * 4 + 2 + i) * NUP_ + j) = w;
                    w.x = cvt_pk_bf16(vb[i][0], vb[i][1]); w.y = cvt_pk_bf16(vb[i][2], vb[i][3]); *(u32x2*)(SB + ((size_t)grp * 4 + 2 + i) * NUP_ + DFF_ + j) = w; } }
            if (fr == 15) {
#pragma unroll
                for (int i = 0; i < 2; ++i) { u32x2 w; w.x = cvt_pk_bf16(va[6 + i][0], va[6 + i][1]); w.y = cvt_pk_bf16(va[6 + i][2], va[6 + i][3]); *(u32x2*)(SB + ((size_t)(grp + 1) * 4 + i) * NUP_ + j) = w;
                    w.x = cvt_pk_bf16(vb[6 + i][0], vb[6 + i][1]); w.y = cvt_pk_bf16(vb[6 + i][2], vb[6 + i][3]); *(u32x2*)(SB + ((size_t)(grp + 1) * 4 + i) * NUP_ + DFF_ + j) = w; } }
        }
    }
};

template <class Epi, class Sched, bool ALIGN_EPI = false, bool SP2 = false>
__device__ __forceinline__ void gemm_phase(PG8_LAS unsigned char* lds, const Gemm g, const Sched& S, const Epi& E) {
    int tid_ = threadIdx.x; asm volatile("" : "+v"(tid_));
    const int tid = tid_, wid = __builtin_amdgcn_readfirstlane(tid >> 6), lane = tid & 63, wr = wid >> 2, wc = wid & 3, fr = lane & 15, fq = lane >> 4;
    const int K = g.K, nt = K / BK;
    unsigned voffA[2], voffB[2];
#pragma unroll
    for (int i = 0; i < 2; ++i) { int R, C; stage_rc(tid * 16 + i * 8192, R, C); const int Rb = Epi::PERM ? ((R & ~31) + perm32(R & 31)) : R;
        const int Ra = Epi::APERM ? (8 * (16 * (R >> 6) + (R & 15)) + ((R >> 4) & 3)) : R;
        voffA[i] = (unsigned)(Ra * K + C) * 2u; voffB[i] = (unsigned)(Rb * K + C) * 2u; }
    const size_t kstep = (size_t)(BK * 2);
    const size_t hstep = (size_t)HALF * K * 2;
    const size_t hstepA = Epi::APERM ? (size_t)4 * K * 2 : hstep;
    const size_t tstep = 2 * hstep;
    const unsigned ldsw = (unsigned)wid * 1024u;
    const int aoff = lds_byte(wr * 64 + fr, fq * 8), boff = lds_byte(wc * 32 + fr, fq * 8);
#define PG8_SA(b, h) (((b) * 2 + (h)) * HTB)
#define PG8_SB(b, h) ((4 + (b) * 2 + (h)) * HTB)
#define PG8_STAGE(bufoff, gbase, voff) do { _Pragma("unroll") for (int _i = 0; _i < 2; ++_i) \
        __builtin_amdgcn_global_load_lds((const unsigned*)((const char*)(gbase) + (voff)[_i]), (PG8_LAS unsigned*)(lds + (bufoff) + ldsw + _i * 8192), 16, 0, 0); } while (0)
#define PG8_LDA(dst, b, h) do { _Pragma("unroll") for (int m = 0; m < 4; ++m) _Pragma("unroll") for (int k = 0; k < 2; ++k) dst[m][k] = *(const PG8_LAS bf16x8*)(lds + PG8_SA(b, h) + aoff + m * 2048 + k * 1024); } while (0)
#define PG8_LDB(dst, b, h) do { _Pragma("unroll") for (int n = 0; n < 2; ++n) _Pragma("unroll") for (int k = 0; k < 2; ++k) dst[n][k] = *(const PG8_LAS bf16x8*)(lds + PG8_SB(b, h) + boff + n * 2048 + k * 1024); } while (0)
#define PG8_MMA(ai, bj, At, Bt) do { __builtin_amdgcn_s_setprio(1); _Pragma("unroll") for (int m = 0; m < 4; ++m) _Pragma("unroll") for (int n = 0; n < 2; ++n) _Pragma("unroll") for (int k = 0; k < 2; ++k) \
        acc[ai][bj][m][n] = __builtin_amdgcn_mfma_f32_16x16x32_bf16(Bt[n][k], At[m][k], acc[ai][bj][m][n], 0, 0, 0); __builtin_amdgcn_s_setprio(0); } while (0)
#define PG8_WAIT_V(n) asm volatile("s_waitcnt vmcnt(" #n ")" ::: "memory")
#define PG8_WAIT_L(n) asm volatile("s_waitcnt lgkmcnt(" #n ")" ::: "memory")
#define PG8_BAR __builtin_amdgcn_s_barrier()
#define PG8_SCHED __builtin_amdgcn_sched_barrier(0)
    Unit cur, nxt; int ui = 0;
    if (!S.next(0, cur)) return;
    f32x4 acc[2][2][4][2];
#pragma unroll
    for (int a = 0; a < 2; ++a)
#pragma unroll
        for (int b = 0; b < 2; ++b)
#pragma unroll
            for (int m = 0; m < 4; ++m)
#pragma unroll
                for (int n = 0; n < 2; ++n) acc[a][b][m][n] = (f32x4){0.f, 0.f, 0.f, 0.f};
    bf16x8 At[4][2], B0[2][2], B1[2][2];
    const char* cA = (const char*)(g.A + (size_t)cur.z * g.zA) + (size_t)cur.pm * tstep; const char* cB = (const char*)(g.Bt + (size_t)cur.z * g.zB) + (size_t)cur.pn * tstep;
    S.a_ready(cur);
    if constexpr (SP2) {
        PG8_STAGE(PG8_SB(0, 0), cB, voffB); PG8_STAGE(PG8_SB(0, 1), cB + hstep, voffB); PG8_STAGE(PG8_SA(0, 0), cA, voffA); PG8_STAGE(PG8_SA(0, 1), cA + hstepA, voffA);
        if (wr == 1) PG8_BAR;
        PG8_WAIT_V(2); PG8_BAR;
        PG8_STAGE(PG8_SB(1, 0), cB + kstep, voffB); PG8_STAGE(PG8_SA(1, 0), cA + kstep, voffA); PG8_STAGE(PG8_SB(1, 1), cB + hstep + kstep, voffB);
        PG8_WAIT_V(6); PG8_BAR;
    } else {
        PG8_STAGE(PG8_SB(0, 0), cB, voffB); PG8_STAGE(PG8_SA(0, 0), cA, voffA); PG8_STAGE(PG8_SB(0, 1), cB + hstep, voffB); PG8_STAGE(PG8_SA(0, 1), cA + hstepA, voffA);
        if (wr == 1) PG8_BAR;
        PG8_WAIT_V(4); PG8_BAR;
        PG8_STAGE(PG8_SB(1, 0), cB + kstep, voffB); PG8_STAGE(PG8_SA(1, 0), cA + kstep, voffA); PG8_STAGE(PG8_SB(1, 1), cB + hstep + kstep, voffB);
        PG8_WAIT_V(6); PG8_BAR;
    }
    for (;;) {
        const bool has_next = S.next(ui + 1, nxt);
        const char* nA = has_next ? (const char*)(g.A + (size_t)nxt.z * g.zA) + (size_t)nxt.pm * tstep : cA; const char* nB = has_next ? (const char*)(g.Bt + (size_t)nxt.z * g.zB) + (size_t)nxt.pn * tstep : cB;
        for (int t = 0; t < nt; t += 2) {
            const bool last = (t == nt - 2);
            const char* a1 = cA + (size_t)(t + 1) * kstep;
            const char* a2 = last ? nA : cA + (size_t)(t + 2) * kstep; const char* b2 = last ? nB : cB + (size_t)(t + 2) * kstep;
            const char* a3 = a2 + kstep; const char* b3 = b2 + kstep;
            if (last && has_next) S.a_ready(nxt);
            if constexpr (SP2) {
            PG8_LDB(B0, 0, 0); PG8_LDB(B1, 0, 1); PG8_SCHED; PG8_LDA(At, 0, 0); PG8_STAGE(PG8_SA(1, 1), a1 + hstepA, voffA);
            PG8_WAIT_V(8); PG8_WAIT_L(0); PG8_BAR; PG8_MMA(0, 0, At, B0); PG8_MMA(0, 1, At, B1); PG8_BAR; PG8_SCHED;
            PG8_LDA(At, 0, 1); PG8_STAGE(PG8_SB(0, 0), b2, voffB); PG8_STAGE(PG8_SB(0, 1), b2 + hstep, voffB); PG8_STAGE(PG8_SA(0, 0), a2, voffA);
            PG8_WAIT_V(8); PG8_WAIT_L(0); PG8_BAR; PG8_MMA(1, 0, At, B0); PG8_MMA(1, 1, At, B1); PG8_BAR; PG8_SCHED;
            PG8_LDB(B0, 1, 0); PG8_LDB(B1, 1, 1); PG8_SCHED; PG8_LDA(At, 1, 0); PG8_STAGE(PG8_SA(0, 1), a2 + hstepA, voffA);
            PG8_WAIT_V(8); PG8_WAIT_L(0); PG8_BAR; PG8_MMA(0, 0, At, B0); PG8_MMA(0, 1, At, B1); PG8_BAR; PG8_SCHED;
            PG8_LDA(At, 1, 1); PG8_STAGE(PG8_SB(1, 0), b3, voffB); PG8_STAGE(PG8_SB(1, 1), b3 + hstep, voffB); PG8_STAGE(PG8_SA(1, 0), a3, voffA);
            PG8_WAIT_V(8); PG8_WAIT_L(0); PG8_BAR; PG8_MMA(1, 0, At, B0); PG8_MMA(1, 1, At, B1); PG8_BAR; PG8_SCHED;
            } else {
            PG8_LDB(B0, 0, 0); PG8_SCHED; PG8_LDA(At, 0, 0); PG8_STAGE(PG8_SA(1, 1), a1 + hstepA, voffA);
            PG8_WAIT_L(8); PG8_BAR; PG8_WAIT_L(0); PG8_MMA(0, 0, At, B0); PG8_BAR; PG8_SCHED;
            PG8_LDB(B1, 0, 1); PG8_STAGE(PG8_SB(0, 0), b2, voffB);
            PG8_BAR; PG8_WAIT_L(0); PG8_MMA(0, 1, At, B1); PG8_BAR;
            PG8_LDA(At, 0, 1); PG8_STAGE(PG8_SA(0, 0), a2, voffA);
            PG8_BAR; PG8_WAIT_L(0); PG8_MMA(1, 0, At, B0); PG8_BAR; PG8_SCHED;
            PG8_STAGE(PG8_SB(0, 1), b2 + hstep, voffB);
            PG8_WAIT_V(6); PG8_BAR; PG8_MMA(1, 1, At, B1); PG8_BAR;
            PG8_LDB(B0, 1, 0); PG8_SCHED; PG8_LDA(At, 1, 0); PG8_STAGE(PG8_SA(0, 1), a2 + hstepA, voffA);
            PG8_WAIT_L(8); PG8_BAR; PG8_WAIT_L(0); PG8_MMA(0, 0, At, B0); PG8_BAR; PG8_SCHED;
            PG8_LDB(B1, 1, 1); PG8_STAGE(PG8_SB(1, 0), b3, voffB);
            PG8_BAR; PG8_WAIT_L(0); PG8_MMA(0, 1, At, B1); PG8_BAR;
            PG8_LDA(At, 1, 1); PG8_STAGE(PG8_SA(1, 0), a3, voffA);
            PG8_BAR; PG8_WAIT_L(0); PG8_MMA(1, 0, At, B0); PG8_BAR; PG8_SCHED;
            PG8_STAGE(PG8_SB(1, 1), b3 + hstep, voffB);
            PG8_WAIT_V(6); PG8_BAR; PG8_MMA(1, 1, At, B1); PG8_BAR;
            }
        }
        if constexpr (ALIGN_EPI) { if (wr == 0) PG8_BAR; }
        if constexpr (!Epi::AFTER_DRAIN) { E(acc, cur, wr, wc, fr, fq); S.done(cur); }
        if (!has_next) break;
        if (!(Epi::KEEP && nxt.z != 0)) {
#pragma unroll
        for (int a = 0; a < 2; ++a)
#pragma unroll
            for (int b = 0; b < 2; ++b)
#pragma unroll
                for (int m = 0; m < 4; ++m)
#pragma unroll
                    for (int n = 0; n < 2; ++n) acc[a][b][m][n] = (f32x4){0.f, 0.f, 0.f, 0.f};
        }
        cur = nxt; cA = nA; cB = nB; ++ui;
        if constexpr (ALIGN_EPI) { if (wr == 1) PG8_BAR; }
    }
    PG8_WAIT_V(0);
    if constexpr (!ALIGN_EPI) { if (wr == 0) PG8_BAR; }
    PG8_BAR;
    if constexpr (Epi::AFTER_DRAIN) { E.fused(acc, cur, wr, wc, fr, fq, lds, wid, lane); S.done(cur); }
#undef PG8_SA
#undef PG8_SB
#undef PG8_STAGE
#undef PG8_LDA
#undef PG8_LDB
#undef PG8_MMA
#undef PG8_WAIT_V
#undef PG8_WAIT_L
#undef PG8_BAR
#undef PG8_SCHED
}
}

constexpr int NWAVES = 8;
constexpr int BATCH = 8, SEQ = 2048, DM = 2048, DEPTH = 4, M = BATCH * SEQ, NH = 8;
constexpr int NIN = 16400, NZ = 16384, DFF = 5632, NUP = 2 * DFF, NY = 3072;
constexpr int Z_RQ = 0, Z_RK = 1024, Z_RV = 2048, Z_RG = 3072, Z_MQ = 4096, Z_MK = 4608, Z_MV = 5120, Z_MO = 6144, Z_AQ = 7168, Z_AK = 8192, Z_AV = 9216, Z_GA = 10240, Z_GB = 12288, Z_GC = 14336;
constexpr int W_GATE_COL = 7168;
constexpr size_t MiB = 1u << 20;
constexpr size_t WS_CTL = 0, CTL_ZERO_BYTES = 1 * MiB;
constexpr size_t WS_RS = 1520 * MiB;
constexpr size_t WS_TAB = 2 * MiB + 512 * 1024;
constexpr size_t WS_RSTD = 7 * MiB + 512 * 1024;
constexpr size_t WS_W16G = 7 * MiB;
constexpr size_t WS_KMEAN = 5 * MiB;
constexpr size_t WS_GIF = 6 * MiB;
constexpr size_t WS_WIN = 8 * MiB;
constexpr size_t WS_WP = 264 * MiB;
constexpr size_t WS_WOUT = 312 * MiB;
constexpr size_t WS_WUP = 344 * MiB;
constexpr size_t WS_WDN = 520 * MiB;
constexpr size_t WS_XB = 608 * MiB;
constexpr size_t WS_Z = 672 * MiB;
constexpr size_t WS_Y = 1184 * MiB;
constexpr size_t WS_MG = 1280 * MiB;
constexpr size_t WS_ACT = 1344 * MiB;
constexpr size_t WS_ZG = 1536 * MiB;
constexpr size_t WS_SB = 1632 * MiB;
constexpr size_t WS_END = 1648 * MiB;
constexpr int CW_TMO = 0, CW_CODE = 1;
constexpr int CW_BAR = 4096;
constexpr int CW_QUEUE = 8192;
constexpr int RING_OFF = 0, RING_BYTES = 131072;
constexpr int LDS_BYTES = 163840;
constexpr int LDSCTL_OFF = LDS_BYTES - 512, MISC_OFF = LDSCTL_OFF + 320;
static_assert(MISC_OFF + 128 <= LDS_BYTES, "LDS map");

#define GAS __attribute__((address_space(1)))
#define LAS __attribute__((address_space(3)))
typedef unsigned short bf16;
typedef unsigned v4u __attribute__((ext_vector_type(4)));
typedef unsigned v2u __attribute__((ext_vector_type(2)));
typedef float f32x4 __attribute__((ext_vector_type(4)));
typedef float f32x2 __attribute__((ext_vector_type(2)));
typedef GAS unsigned gu32;
#define RLX_AGENT __ATOMIC_RELAXED, __HIP_MEMORY_SCOPE_AGENT
#define LDS_WAIT() asm volatile("s_waitcnt lgkmcnt(0)" ::: "memory")
#define VM_WAIT() asm volatile("s_waitcnt vmcnt(0)" ::: "memory")
typedef __bf16 bf16x2_t __attribute__((ext_vector_type(2)));
__device__ __forceinline__ unsigned pk2(float lo, float hi) { const f32x2 v = {lo, hi}; const bf16x2_t b = __builtin_convertvector(v, bf16x2_t); return __builtin_bit_cast(unsigned, b); }
__device__ __forceinline__ unsigned f2bf(float f) { return pk2(f, f); }
__device__ __forceinline__ float bflo(unsigned w) { return __uint_as_float(w << 16); }
__device__ __forceinline__ float bfhi(unsigned w) { return __uint_as_float(w & 0xffff0000u); }
__device__ __forceinline__ float bf1(bf16 v) { return __uint_as_float((unsigned)v << 16); }
__device__ __forceinline__ float sigm(float x) { return 1.0f / (1.0f + __expf(-x)); }

#define XB_TMO      128
#define XB_XCNT(j)  (256  + 64 * (j))
#define XB_XSUB(j)  (1280 + 64 * (j))
#define XB_XGEN(j)  (2304 + 64 * (j))
#define XB_TOP      3328
#define XB_TOPGEN   3392
#define XCD_BAR_WORDS 3456
#define XB_SPIN_CAP (1u << 18)

__device__ __forceinline__ unsigned xb_ld(unsigned* p)              { return __hip_atomic_load(p, __ATOMIC_RELAXED, __HIP_MEMORY_SCOPE_AGENT); }
__device__ __forceinline__ unsigned xb_add(unsigned* p, unsigned v) { return __hip_atomic_fetch_add(p, v, __ATOMIC_RELAXED, __HIP_MEMORY_SCOPE_AGENT); }
__device__ __forceinline__ unsigned xb_xcc_id() { return (unsigned)__builtin_amdgcn_s_getreg((3 << 11) | 20) & 0xFu; }
#define XB_SPIN(cond, bar) do { unsigned _sp = 0; while (cond) { __builtin_amdgcn_s_sleep(1); \
    if ((++_sp & 255u) == 0u) { if (xb_ld(&(bar)[XB_TMO])) break; if (_sp > XB_SPIN_CAP) { atomicAdd(&(bar)[XB_TMO], 1u); break; } } } } while (0)

struct XcdBarrier {
    unsigned* bar; unsigned x;
    volatile LAS unsigned* st;
};

__device__ __forceinline__ XcdBarrier xcd_barrier_post(unsigned* bar, volatile LAS unsigned* st) {
    XcdBarrier b; b.bar = bar; b.x = xb_xcc_id(); b.st = st;
    if (threadIdx.x == 0) (void)xb_add(&bar[XB_XCNT(b.x)], 1u);
    return b;
}
__device__ __forceinline__ void xcd_barrier_complete(unsigned* bar, unsigned x, unsigned& nloc, unsigned& nx) {
    const unsigned G = gridDim.x * gridDim.y * gridDim.z;
    unsigned sum, cnt, mine, sp = 0u;
    for (;;) {
        sum = 0u; cnt = 0u; mine = 0u;
#pragma unroll
        for (unsigned j = 0; j < 16; ++j) { const unsigned c = xb_ld(&bar[XB_XCNT(j)]); sum += c; cnt += (c > 0u) ? 1u : 0u; mine = (j == x) ? c : mine; }
        if (sum == G) break;
        __builtin_amdgcn_s_sleep(1);
        if ((++sp & 255u) == 0u) { if (xb_ld(&bar[XB_TMO])) break; if (sp > XB_SPIN_CAP) { atomicAdd(&bar[XB_TMO], 1u); break; } }
    }
    nloc = mine > 0u ? mine : 1u; nx = cnt > 0u ? cnt : 1u;
}

__device__ __forceinline__ void xcd_barrier(const XcdBarrier& b) {
    asm volatile("s_waitcnt vmcnt(0)" ::: "memory");
    __syncthreads();
    if (threadIdx.x == 0) {
        unsigned* bar = b.bar;
        __builtin_amdgcn_s_waitcnt(0);
        unsigned nloc = b.st[0], nx = b.st[1];
        if (nloc == 0u) { xcd_barrier_complete(bar, b.x, nloc, nx); b.st[0] = nloc; b.st[1] = nx; }
        const unsigned old = xb_add(&bar[XB_XSUB(b.x)], 1u);
        const unsigned gen = old / nloc;
        if (old + 1u == (gen + 1u) * nloc) {
            __builtin_amdgcn_fence(__ATOMIC_RELEASE, "agent");
            asm volatile("s_waitcnt vmcnt(0)" ::: "memory");
            const unsigned og = xb_add(&bar[XB_TOP], 1u);
            const unsigned tg = og / nx;
            if (og + 1u == (tg + 1u) * nx) xb_add(&bar[XB_TOPGEN], 1u);
            else XB_SPIN(xb_ld(&bar[XB_TOPGEN]) == tg, bar);
            __builtin_amdgcn_fence(__ATOMIC_ACQUIRE, "agent");
            xb_add(&bar[XB_XGEN(b.x)], 1u);
            asm volatile("s_waitcnt vmcnt(0)" ::: "memory");
        } else {
            XB_SPIN(xb_ld(&bar[XB_XGEN(b.x)]) == gen, bar);
            __builtin_amdgcn_fence(__ATOMIC_ACQUIRE, "agent");
            asm volatile("s_waitcnt vmcnt(0)" ::: "memory");
        }
    }
    __syncthreads();
}

struct Args { const float* in[18]; float* out; unsigned char* ws; int ph_lo, ph_hi, li, pad; };
enum { I_X = 0, I_WIN, I_BIG, I_BFG, I_NMIX, I_RGN, I_MLN, I_QN, I_KN, I_WPA, I_WPB, I_WPC, I_WOUT, I_NFFN, I_WUP, I_CW, I_CB, I_WDN };
struct Frame {
    LAS unsigned char* lds;
    volatile LAS unsigned* MISC;
    unsigned char* ws;
    int tid, lane, wave, G, bx;
};
#define WSP(T, off) ((T*)(F.ws + (off)))
__device__ __forceinline__ float wave_sum(float v) {
#pragma unroll
    for (int o = 1; o < 64; o <<= 1) v += __shfl_xor(v, o);
    return v;
}
__device__ __forceinline__ float wave_max(float v) {
#pragma unroll
    for (int o = 1; o < 64; o <<= 1) v = fmaxf(v, __shfl_xor(v, o));
    return v;
}
__device__ __forceinline__ void p0_transpose_item(const float* W, int ldw, int K, int nblk, bf16* WT, LAS float* scr, int item, int lane, const float* gk = nullptr) {
    const int kb = item / nblk, nb = item % nblk, k0 = 64 * kb, n0 = 32 * nb;
#pragma unroll 8
    for (int i = 0; i < 32; ++i) { const int kk = 2 * i + (lane >> 5); scr[kk * 33 + (lane & 31)] = W[(size_t)(k0 + kk) * ldw + n0 + (lane & 31)]; }
    LDS_WAIT(); asm volatile("" ::: "memory");
    const int c = lane & 7;
    f32x4 g0 = (f32x4){1.f, 1.f, 1.f, 1.f}, g1 = g0;
    if (gk) { g0 = *(const f32x4*)(gk + k0 + 8 * c); g1 = *(const f32x4*)(gk + k0 + 8 * c + 4); }
#pragma unroll
    for (int j = 0; j < 4; ++j) { const int n = (lane >> 3) + 8 * j; const LAS float* s = scr + (8 * c) * 33 + n;
        v4u o; o.x = pk2(s[0 * 33] * g0[0], s[1 * 33] * g0[1]); o.y = pk2(s[2 * 33] * g0[2], s[3 * 33] * g0[3]); o.z = pk2(s[4 * 33] * g1[0], s[5 * 33] * g1[1]); o.w = pk2(s[6 * 33] * g1[2], s[7 * 33] * g1[3]);
        *(GAS v4u*)(WT + (size_t)(n0 + n) * K + k0 + 8 * c) = o; }
    LDS_WAIT(); asm volatile("" ::: "memory");
}
__device__ __forceinline__ void p0_prologue(Frame& F, const Args& args) {
    LAS float* scr = (LAS float*)(F.lds + RING_OFF + F.wave * 16384);
    const int gw = F.bx * NWAVES + F.wave, NGW = F.G * NWAVES;
    constexpr int I_INA = 32 * 224, I_INB = 32 * 288, I_P = 16 * 64, I_OUT = 32 * 64, I_UP = 32 * 352, I_DN = 88 * 64;
    constexpr int I_LAYER = I_INA + I_INB + 3 * I_P + I_OUT + I_UP + I_DN;
    for (int it = gw; it < DEPTH * I_LAYER; it += NGW) {
        const int l = it / I_LAYER; int r = it % I_LAYER;
        const float* win = args.in[I_WIN] + (size_t)l * DM * NIN; bf16* wint = WSP(bf16, WS_WIN) + (size_t)l * NZ * DM;
        if (r < I_INA) { p0_transpose_item(win, NIN, DM, 224, wint, scr, r, F.lane, args.in[I_NMIX] + l * DM); continue; } r -= I_INA;
        if (r < I_INB) { p0_transpose_item(win + 7184, NIN, DM, 288, wint + (size_t)7168 * DM, scr, r, F.lane, args.in[I_NMIX] + l * DM); continue; } r -= I_INB;
        if (r < I_P) { p0_transpose_item(args.in[I_WPA] + (size_t)l * 1024 * DM, DM, 1024, 64, WSP(bf16, WS_WP) + ((size_t)l * 3 + 0) * DM * 1024, scr, r, F.lane); continue; } r -= I_P;
        if (r < I_P) { p0_transpose_item(args.in[I_WPB] + (size_t)l * 1024 * DM, DM, 1024, 64, WSP(bf16, WS_WP) + ((size_t)l * 3 + 1) * DM * 1024, scr, r, F.lane); continue; } r -= I_P;
        if (r < I_P) { p0_transpose_item(args.in[I_WPC] + (size_t)l * 1024 * DM, DM, 1024, 64, WSP(bf16, WS_WP) + ((size_t)l * 3 + 2) * DM * 1024, scr, r, F.lane); continue; } r -= I_P;
        if (r < I_OUT) { p0_transpose_item(args.in[I_WOUT] + (size_t)l * DM * DM, DM, DM, 64, WSP(bf16, WS_WOUT) + (size_t)l * DM * DM, scr, r, F.lane); continue; } r -= I_OUT;
        if (r < I_UP) {
            const int nb = r % 352, tile = nb >> 3, wi = nb & 7, src = (wi < 4) ? 128 * tile + 32 * wi : DFF + 128 * tile + 32 * (wi - 4);
            p0_transpose_item(args.in[I_WUP] + (size_t)l * DM * NUP + (src - 32 * nb), NUP, DM, 352, WSP(bf16, WS_WUP) + (size_t)l * NUP * DM, scr, r, F.lane, args.in[I_NFFN] + l * DM); continue; } r -= I_UP;
        p0_transpose_item(args.in[I_WDN] + (size_t)l * DFF * DM, DM, DFF, 64, WSP(bf16, WS_WDN) + (size_t)l * DM * DFF, scr, r, F.lane);
    }
    const int gt = F.bx * (NWAVES * 64) + F.tid, NGT = F.G * NWAVES * 64;
    for (int i = gt; i < DEPTH * 16 * DM; i += NGT) { const int l = i / (16 * DM), c = (i / DM) % 16, k = i % DM; WSP(bf16, WS_W16G)[i] = (bf16)f2bf(args.in[I_WIN][((size_t)l * DM + k) * NIN + W_GATE_COL + c] * args.in[I_NMIX][l * DM + k]); }
    for (int m = gw; m < M; m += NGW) { const f32x4* xr = (const f32x4*)(args.in[I_X] + (size_t)m * DM) + F.lane; v2u* o8 = (v2u*)(WSP(bf16, WS_XB) + (size_t)m * DM) + F.lane; float s = 0.f;
#pragma unroll
        for (int j = 0; j < 8; ++j) { const f32x4 v = xr[64 * j]; s += (v.x * v.x + v.y * v.y) + (v.z * v.z + v.w * v.w); v2u w; w.x = pk2(v.x, v.y); w.y = pk2(v.z, v.w); o8[64 * j] = w; }
        s = wave_sum(s); if (F.lane < 32) WSP(float, WS_RS)[(size_t)m * 32 + F.lane] = (F.lane == 0) ? s : 0.f; }
    for (int i = gt; i < 2 * SEQ * 64; i += NGT) { const int which = i / (SEQ * 64), pos = (i / 64) % SEQ, d = i % 64;
        const float ex = which == 0 ? (float)d / 63.0f : (float)(2 * d) / 128.0f;
        const float inv = 1.0f / powf(10000.0f, ex); const float ang = (float)pos * inv; float s, c; sincosf(ang, &s, &c); WSP(f32x2, WS_TAB)[i] = (f32x2){c, s}; }
}
__device__ __forceinline__ void prep_phase(Frame& F, const float* qn, const float* kn, const bf16* w16g, const float* rs, const float* big, const float* bfg) {
    const int gw = F.bx * NWAVES + F.wave, NGW = F.G * NWAVES, lane = F.lane, rsub = lane >> 2, dg = lane & 3;
    const f32x2* trope = WSP(f32x2, WS_TAB) + SEQ * 64;
    for (int u = gw; u < 2 * BATCH * 16 * NH; u += NGW) {
        const int kind = u & 1, hh = (u >> 1) & 7, hb = (u >> 4) & 15, b = u >> 8;
        const float* wn = kind ? kn : qn;
        const float* rsb = rs + (size_t)(b * SEQ + hb * 128) * 32 + 8 * dg;
        float wl[16], wh[16], s1[16], s2[16];
#pragma unroll
        for (int e = 0; e < 16; ++e) { wl[e] = wn[16 * dg + e]; wh[e] = wn[64 + 16 * dg + e]; s1[e] = 0.f; s2[e] = 0.f; }
        bf16* zb = WSP(bf16, WS_Z) + (size_t)(b * SEQ + hb * 128) * NZ + (kind ? Z_AK : Z_AQ) + hh * 128 + 16 * dg;
#pragma unroll 2
        for (int st = 0; st < 8; ++st) {
            const int r = rsub + 16 * st, pos = hb * 128 + r; bf16* zr = zb + (size_t)r * NZ;
            const v4u l0 = *(const v4u*)(zr), l1 = *(const v4u*)(zr + 8), h0 = *(const v4u*)(zr + 64), h1 = *(const v4u*)(zr + 72);
            float a[16] = {bflo(l0.x), bfhi(l0.x), bflo(l0.y), bfhi(l0.y), bflo(l0.z), bfhi(l0.z), bflo(l0.w), bfhi(l0.w), bflo(l1.x), bfhi(l1.x), bflo(l1.y), bfhi(l1.y), bflo(l1.z), bfhi(l1.z), bflo(l1.w), bfhi(l1.w)};
            float c[16] = {bflo(h0.x), bfhi(h0.x), bflo(h0.y), bfhi(h0.y), bflo(h0.z), bfhi(h0.z), bflo(h0.w), bfhi(h0.w), bflo(h1.x), bfhi(h1.x), bflo(h1.y), bfhi(h1.y), bflo(h1.z), bfhi(h1.z), bflo(h1.w), bfhi(h1.w)};
            float ss = 0.f;
#pragma unroll
            for (int e = 0; e < 16; ++e) ss += a[e] * a[e] + c[e] * c[e];
            ss += __shfl_xor(ss, 1); ss += __shfl_xor(ss, 2);
            float rq; { const f32x4 s0 = *(const f32x4*)(rsb + (size_t)r * 32), s1 = *(const f32x4*)(rsb + (size_t)r * 32 + 4); rq = ((s0[0] + s0[1]) + (s0[2] + s0[3])) + ((s1[0] + s1[1]) + (s1[2] + s1[3])); }
            rq += __shfl_xor(rq, 1); rq += __shfl_xor(rq, 2);
            const float rr = rsqrtf(rq * (1.0f / 2048.0f) + 1e-6f);
            if ((u & 15) == 0 && dg == 0) WSP(float, WS_RSTD)[b * SEQ + hb * 128 + r] = rr;
            const float rstd = rr * rsqrtf(ss * rr * rr * (1.f / 128.f) + 1e-6f);
            const f32x2* tb = trope + pos * 64 + 16 * dg;
#pragma unroll
            for (int e = 0; e < 16; ++e) { const float x1 = a[e] * rstd * wl[e], x2 = c[e] * rstd * wh[e]; const f32x2 cs = tb[e]; a[e] = x1 * cs.x - x2 * cs.y; c[e] = x1 * cs.y + x2 * cs.x; s1[e] += a[e]; s2[e] += c[e]; }
            *(v4u*)(zr) = (v4u){pk2(a[0], a[1]), pk2(a[2], a[3]), pk2(a[4], a[5]), pk2(a[6], a[7])}; *(v4u*)(zr + 8) = (v4u){pk2(a[8], a[9]), pk2(a[10], a[11]), pk2(a[12], a[13]), pk2(a[14], a[15])};
            *(v4u*)(zr + 64) = (v4u){pk2(c[0], c[1]), pk2(c[2], c[3]), pk2(c[4], c[5]), pk2(c[6], c[7])}; *(v4u*)(zr + 72) = (v4u){pk2(c[8], c[9]), pk2(c[10], c[11]), pk2(c[12], c[13]), pk2(c[14], c[15])};
        }
        if (kind) {
            float* km = WSP(float, WS_KMEAN) + (size_t)((b * NH + hh) * 16 + hb) * 128 + 16 * dg;
#pragma unroll
            for (int e = 0; e < 16; ++e) { float x = s1[e], y = s2[e];
                x += __shfl_xor(x, 4); x += __shfl_xor(x, 8); x += __shfl_xor(x, 16); x += __shfl_xor(x, 32);
                y += __shfl_xor(y, 4); y += __shfl_xor(y, 8); y += __shfl_xor(y, 16); y += __shfl_xor(y, 32);
                if (rsub == 0) { km[e] = x * (1.f / 256.f); km[64 + e] = y * (1.f / 256.f); } }
        }
    }
    for (int it = gw; it < M / 32; it += NGW) {
#pragma unroll
        for (int st = 0; st < 8; ++st) { const int row = 32 * it + 4 * st + (lane >> 4), cg = lane & 15;
            const float* rp = rs + (size_t)row * 32; float rq = 0.f;
#pragma unroll
            for (int q = 0; q < 8; ++q) { const f32x4 s0 = *(const f32x4*)(rp + 4 * q); rq += (s0[0] + s0[1]) + (s0[2] + s0[3]); }
            const float rr = rsqrtf(rq * (1.0f / 2048.0f) + 1e-6f);
            bf16* vp = WSP(bf16, WS_Z) + (size_t)row * NZ + Z_AV + 8 * cg;
#pragma unroll
            for (int q = 0; q < 8; ++q) { const v4u x = *(const v4u*)(vp + 128 * q);
                *(v4u*)(vp + 128 * q) = (v4u){pk2(bflo(x.x) * rr, bfhi(x.x) * rr), pk2(bflo(x.y) * rr, bfhi(x.y) * rr), pk2(bflo(x.z) * rr, bfhi(x.z) * rr), pk2(bflo(x.w) * rr, bfhi(x.w) * rr)}; } }
    }
    for (int it = NGW - 1 - gw; it < M / 16; it += NGW) {
        const int i16 = lane & 15, g = lane >> 4; const bf16* ar = WSP(bf16, WS_XB) + (size_t)(16 * it + i16) * DM + 8 * g; const bf16* br = w16g + (size_t)i16 * DM + 8 * g;
        typedef short bf16x8_t __attribute__((ext_vector_type(8)));
        f32x4 acc = (f32x4){0.f, 0.f, 0.f, 0.f};
#pragma unroll 1
        for (int s0 = 0; s0 < DM / 32; s0 += 16) { bf16x8_t av[16], bv[16];
#pragma unroll
            for (int s = 0; s < 16; ++s) { av[s] = *(const bf16x8_t*)(ar + 32 * (s0 + s)); bv[s] = *(const bf16x8_t*)(br + 32 * (s0 + s)); }
#pragma unroll
            for (int s = 0; s < 16; ++s) acc = __builtin_amdgcn_mfma_f32_16x16x32_bf16(av[s], bv[s], acc, 0, 0, 0); }
#pragma unroll
        for (int r = 0; r < 4; ++r) { const int row = 16 * it + 4 * g + r; float ssq = 0.f;
#pragma unroll
            for (int q = 0; q < 8; ++q) { const f32x4 a = *(const f32x4*)(rs + (size_t)row * 32 + 4 * q); ssq += (a[0] + a[1]) + (a[2] + a[3]); }
            const float sr = rsqrtf(ssq * (1.0f / 2048.0f) + 1e-6f);
            const float pre = acc[r] * sr + (i16 < 8 ? big[i16 & 7] : bfg[i16 & 7]); const float sc = 15.0f * tanhf(pre * (1.0f / 15.0f));
            float o = sc; if (i16 >= 8) o = sc > 0.f ? -log1pf(__expf(-sc)) : sc - log1pf(__expf(sc));
            WSP(float, WS_GIF)[(size_t)row * 16 + i16] = o; }
    }
}
__device__ __forceinline__ void glu_fix_phase(Frame& F, const float* cw, const float* cb) {
    const bf16* SB = WSP(bf16, WS_SB); bf16* ACT = WSP(bf16, WS_ACT);
    for (int gI = F.bx; gI < M / 128; gI += F.G) {
        const bool first = ((gI * 128) & (SEQ - 1)) == 0; const bf16* sb = SB + (size_t)gI * 4 * NUP;
        for (int it = F.tid; it < 2 * (DFF / 8); it += NWAVES * 64) {
            const int i = it / (DFF / 8), c8 = (it % (DFF / 8)) * 8;
            float r[2][8];
#pragma unroll
            for (int hf = 0; hf < 2; ++hf) { const int col = hf * DFF + c8;
                const f32x4 b0 = *(const f32x4*)(cb + col), b1 = *(const f32x4*)(cb + col + 4);
                float a[8] = {b0.x, b0.y, b0.z, b0.w, b1.x, b1.y, b1.z, b1.w};
#pragma unroll
                for (int j = 0; j < 3; ++j) { const int slot = i + j;
                    if (slot >= 2 || !first) { const v4u uw = *(const v4u*)(sb + (size_t)slot * NUP + col); const f32x4 w0 = *(const f32x4*)(cw + (size_t)j * NUP + col), w1 = *(const f32x4*)(cw + (size_t)j * NUP + col + 4);
                        a[0] += bflo(uw.x) * w0.x; a[1] += bfhi(uw.x) * w0.y; a[2] += bflo(uw.y) * w0.z; a[3] += bfhi(uw.y) * w0.w; a[4] += bflo(uw.z) * w1.x; a[5] += bfhi(uw.z) * w1.y; a[6] += bflo(uw.w) * w1.z; a[7] += bfhi(uw.w) * w1.w; } }
#pragma unroll
                for (int e = 0; e < 8; ++e) r[hf][e] = a[e]; }
            float o[8];
#pragma unroll
            for (int e = 0; e < 8; ++e) o[e] = r[0][e] * __builtin_amdgcn_rcpf(1.0f + __expf(-r[0][e])) * r[1][e];
            *(v4u*)(ACT + (size_t)(gI * 128 + i) * DFF + c8) = (v4u){pk2(o[0], o[1]), pk2(o[2], o[3]), pk2(o[4], o[5]), pk2(o[6], o[7])};
        }
    }
}
namespace mx {
typedef short bf16x8 __attribute__((ext_vector_type(8)));
typedef short s16x4 __attribute__((ext_vector_type(4)));
#define MFMA16(a, b, c) __builtin_amdgcn_mfma_f32_16x16x32_bf16((a), (b), (c), 0, 0, 0)
#define LDS_FENCE() asm volatile("s_waitcnt lgkmcnt(0)" ::: "memory")
#define SCHED_FENCE() __builtin_amdgcn_sched_barrier(0)
__device__ __forceinline__ bf16x8 frag_row(const LAS bf16* X, int ld, int r0, int c0, int lane) {
    return *(const LAS bf16x8*)(X + (r0 + (lane & 15)) * ld + c0 + 8 * (lane >> 4)); }
__device__ __forceinline__ bf16x8 frag_tr(const LAS bf16* X, int ld, int k0, int c0, int lane) {
    const int g = lane >> 4, q = (lane & 15) >> 2, p = lane & 3;
    const LAS bf16* a = X + (k0 + 8 * g + q) * ld + c0 + 4 * p;
    const s16x4 lo = __builtin_amdgcn_ds_read_tr16_b64_v4i16((LAS s16x4*)a);
    const s16x4 hi = __builtin_amdgcn_ds_read_tr16_b64_v4i16((LAS s16x4*)(a + 4 * ld));
    return __builtin_shufflevector(lo, hi, 0, 1, 2, 3, 4, 5, 6, 7);
}
__device__ __forceinline__ int trs_off(int row, int chunk) { return row * 128 + ((chunk ^ (((row & 3) << 1) | (((row >> 3) & 1) << 3))) << 3); }
__device__ __forceinline__ bf16x8 frag_trs(const LAS bf16* X, int k0, int c0, int lane) {
    const int g = lane >> 4, q = (lane & 15) >> 2, p = lane & 3;
    const LAS bf16* a = X + trs_off(k0 + 8 * g + q, (c0 >> 3) + (p >> 1)) + 4 * (p & 1);
    const s16x4 lo = __builtin_amdgcn_ds_read_tr16_b64_v4i16((LAS s16x4*)a);
    const s16x4 hi = __builtin_amdgcn_ds_read_tr16_b64_v4i16((LAS s16x4*)(a + 4 * 128));
    return __builtin_shufflevector(lo, hi, 0, 1, 2, 3, 4, 5, 6, 7);
}
template <int CTRL> __device__ __forceinline__ float dppf(float v) { return __builtin_bit_cast(float, __builtin_amdgcn_update_dpp(0, __builtin_bit_cast(int, v), CTRL, 0xf, 0xf, true)); }
__device__ __forceinline__ float r16max(float v) { v = fmaxf(v, dppf<0xB1>(v)); v = fmaxf(v, dppf<0x4E>(v)); v = fmaxf(v, dppf<0x141>(v)); v = fmaxf(v, dppf<0x140>(v)); return v; }
__device__ __forceinline__ float r16sum(float v) { v += dppf<0xB1>(v); v += dppf<0x4E>(v); v += dppf<0x141>(v); v += dppf<0x140>(v); return v; }
__device__ __forceinline__ float red16_sum(float v) { return r16sum(v); }
__device__ __forceinline__ float red16_max(float v) { return r16max(v); }
__device__ __forceinline__ void rot8(const v4u lo, const v4u hi, const f32x2* tb, float sc, v4u& olo, v4u& ohi) {
    float a[8] = {bflo(lo.x), bfhi(lo.x), bflo(lo.y), bfhi(lo.y), bflo(lo.z), bfhi(lo.z), bflo(lo.w), bfhi(lo.w)};
    float c[8] = {bflo(hi.x), bfhi(hi.x), bflo(hi.y), bfhi(hi.y), bflo(hi.z), bfhi(hi.z), bflo(hi.w), bfhi(hi.w)};
    float o1[8], o2[8];
#pragma unroll
    for (int e = 0; e < 8; ++e) { const f32x2 cs = tb[e]; o1[e] = (a[e] * cs.x - c[e] * cs.y) * sc; o2[e] = (a[e] * cs.y + c[e] * cs.x) * sc; }
    olo = (v4u){pk2(o1[0], o1[1]), pk2(o1[2], o1[3]), pk2(o1[4], o1[5]), pk2(o1[6], o1[7])};
    ohi = (v4u){pk2(o2[0], o2[1]), pk2(o2[2], o2[3]), pk2(o2[4], o2[5]), pk2(o2[6], o2[7])};
}
constexpr int LQ = 144;
__device__ __forceinline__ void ret_unit(Frame& F, const float* gn, int b, int h) {
    LAS bf16* Qs = (LAS bf16*)(F.lds); LAS bf16* Ks = Qs + 128 * LQ; LAS bf16* Vs = Ks + 128 * LQ; LAS bf16* Ts = Vs + 128 * LQ;
    const int tid = F.tid, lane = F.lane, w = tid >> 6, i16 = lane & 15, g = lane >> 4;
    const float gamma = 1.0f - exp2f(-5.0f - (float)h), lg = log2f(gamma);
    const float gC = exp2f(lg * 128.0f);
    f32x4 accT[8];
#pragma unroll
    for (int n = 0; n < 8; ++n) accT[n] = (f32x4){0.f, 0.f, 0.f, 0.f};
    for (int i = tid; i < 128 * LQ / 8; i += NWAVES * 64) ((LAS v4u*)Ts)[i] = (v4u){0u, 0u, 0u, 0u};
    const bf16* zb = WSP(bf16, WS_Z) + (size_t)(b * SEQ) * NZ + h * 128;
    const f32x2* tret = WSP(f32x2, WS_TAB);
    bf16* yb = WSP(bf16, WS_Y) + (size_t)(b * SEQ) * 1024 + h * 128;
    const int lr = tid >> 2, dg = tid & 3;
    v4u pq[4], pk[4], pv[4]; float prr;
    const float* rstd1 = WSP(float, WS_RSTD) + (size_t)(b * SEQ);
#define RET_FETCH(t0_) do { const bf16* zr_ = zb + (size_t)((t0_) + lr) * NZ; \
        pq[0] = *(const v4u*)(zr_ + Z_RQ + 16 * dg); pq[1] = *(const v4u*)(zr_ + Z_RQ + 64 + 16 * dg); pq[2] = *(const v4u*)(zr_ + Z_RQ + 16 * dg + 8); pq[3] = *(const v4u*)(zr_ + Z_RQ + 64 + 16 * dg + 8); \
        pk[0] = *(const v4u*)(zr_ + Z_RK + 16 * dg); pk[1] = *(const v4u*)(zr_ + Z_RK + 64 + 16 * dg); pk[2] = *(const v4u*)(zr_ + Z_RK + 16 * dg + 8); pk[3] = *(const v4u*)(zr_ + Z_RK + 64 + 16 * dg + 8); \
        _Pragma("unroll") for (int q_ = 0; q_ < 4; ++q_) pv[q_] = *(const v4u*)(zr_ + Z_RV + 32 * dg + 8 * q_); prr = rstd1[(t0_) + lr]; } while (0)
    RET_FETCH(0);
    const float sq = exp2f(lg * (float)lr), sk = exp2f(-lg * (float)lr) * 0.08838834764831845f;
    float gnv[8];
#pragma unroll
    for (int n = 0; n < 8; ++n) gnv[n] = gn[h * 128 + 16 * n + i16];
    for (int c = 0; c < SEQ / 128; ++c) {
        const int t0 = c * 128;
        {
            const f32x2* tb = tret + (t0 + lr) * 64 + 16 * dg;
#pragma unroll
            for (int hh = 0; hh < 2; ++hh) {
                v4u o1, o2; rot8(pq[2 * hh], pq[2 * hh + 1], tb + 8 * hh, sq * prr, o1, o2);
                *(LAS v4u*)(Qs + lr * LQ + 16 * dg + 8 * hh) = o1; *(LAS v4u*)(Qs + lr * LQ + 64 + 16 * dg + 8 * hh) = o2;
                rot8(pk[2 * hh], pk[2 * hh + 1], tb + 8 * hh, sk * prr * prr, o1, o2);
                *(LAS v4u*)(Ks + lr * LQ + 16 * dg + 8 * hh) = o1; *(LAS v4u*)(Ks + lr * LQ + 64 + 16 * dg + 8 * hh) = o2;
            }
#pragma unroll
            for (int q = 0; q < 4; ++q) *(LAS v4u*)(Vs + lr * LQ + 32 * dg + 8 * q) = pv[q];
            if (c + 1 < SEQ / 128) RET_FETCH(t0 + 128);
        }
        __syncthreads();
        bf16x8 aq[4];
#pragma unroll
        for (int s = 0; s < 4; ++s) aq[s] = frag_row(Qs, LQ, 16 * w, 32 * s, lane);
        f32x4 acco[8];
#pragma unroll
        for (int n = 0; n < 8; ++n) acco[n] = (f32x4){0.f, 0.f, 0.f, 0.f};
#pragma unroll
        for (int s = 0; s < 4; ++s) { bf16x8 bb[8];
#pragma unroll
            for (int n = 0; n < 8; ++n) bb[n] = frag_tr(Ts, LQ, 32 * s, 16 * n, lane);
            SCHED_FENCE();
#pragma unroll
            for (int n = 0; n < 8; ++n) acco[n] = MFMA16(aq[s], bb[n], acco[n]); }
        LDS_FENCE();
#pragma unroll
        for (int n = 0; n < 8; ++n) {
            if (n <= w) { f32x4 sa = (f32x4){0.f, 0.f, 0.f, 0.f}; bf16x8 bb[4];
#pragma unroll
                for (int s = 0; s < 4; ++s) bb[s] = frag_row(Ks, LQ, 16 * n, 32 * s, lane);
                SCHED_FENCE();
#pragma unroll
                for (int s = 0; s < 4; ++s) sa = MFMA16(aq[s], bb[s], sa);
#pragma unroll
                for (int r = 0; r < 4; ++r) { const int i = 16 * w + 4 * g + r, j = 16 * n + i16; Qs[i * LQ + j] = (bf16)f2bf(j <= i ? sa[r] : 0.f); } }
            else if (n == w + 1) {
#pragma unroll
                for (int r = 0; r < 4; ++r) Qs[(16 * w + 4 * g + r) * LQ + 16 * n + i16] = (bf16)0; }
        }
        LDS_FENCE();
#pragma unroll
        for (int n = 0; n < 8; ++n) accT[n] = accT[n] * gC;
#pragma unroll
        for (int s = 0; s < 4; ++s) { const bf16x8 ak = frag_tr(Ks, LQ, 32 * s, 16 * w, lane); const bool doi = (s <= (w >> 1)); bf16x8 as = ak; bf16x8 bb[8];
            if (doi) as = frag_row(Qs, LQ, 16 * w, 32 * s, lane);
#pragma unroll
            for (int n = 0; n < 8; ++n) bb[n] = frag_tr(Vs, LQ, 32 * s, 16 * n, lane);
            SCHED_FENCE();
            if (doi) {
#pragma unroll
                for (int n = 0; n < 8; ++n) acco[n] = MFMA16(as, bb[n], acco[n]); }
#pragma unroll
            for (int n = 0; n < 8; ++n) accT[n] = MFMA16(ak, bb[n], accT[n]); }
        bf16 gvr[4][8]; float rrv[4];
#pragma unroll
        for (int r = 0; r < 4; ++r) { const int pos = t0 + 16 * w + 4 * g + r; const bf16* gr = zb + (size_t)pos * NZ + Z_RG + i16; rrv[r] = rstd1[pos];
#pragma unroll
            for (int n = 0; n < 8; ++n) gvr[r][n] = gr[16 * n]; }
        LDS_FENCE();
        __syncthreads();
#pragma unroll
        for (int n = 0; n < 8; ++n)
#pragma unroll
            for (int r = 0; r < 4; ++r) Ts[(16 * w + 4 * g + r) * LQ + 16 * n + i16] = (bf16)f2bf(gC * accT[n][r]);
#pragma unroll
        for (int r = 0; r < 4; ++r) {
            float s = 0.f;
#pragma unroll
            for (int n = 0; n < 8; ++n) s += acco[n][r];
            const float mean = red16_sum(s) * (1.f / 128.f); float q = 0.f;
#pragma unroll
            for (int n = 0; n < 8; ++n) { const float d = acco[n][r] - mean; q += d * d; }
            const float rstd = rsqrtf(red16_sum(q) * (1.f / 128.f) + 1e-5f);
            const int pos = t0 + 16 * w + 4 * g + r; bf16* yr = yb + (size_t)pos * 1024; const float rri = rrv[r];
#pragma unroll
            for (int n = 0; n < 8; ++n) { const int e = 16 * n + i16; const float gv = bf1(gvr[r][n]) * rri; yr[e] = (bf16)f2bf((acco[n][r] - mean) * rstd * gnv[n] * gv * sigm(gv)); }
        }
    }
    __syncthreads();
#undef RET_FETCH
}
constexpr int LK = 72, LV = 168;
__device__ __forceinline__ float scan64_sum(float x, int lane) {
#pragma unroll
    for (int o = 1; o < 64; o <<= 1) { const float y = __shfl_up(x, o); if (lane >= o) x += y; }
    return x; }
__device__ __forceinline__ float scan64_max(float x, int lane) {
#pragma unroll
    for (int o = 1; o < 64; o <<= 1) { const float y = __shfl_up(x, o); if (lane >= o) x = fmaxf(x, y); }
    return x; }
__device__ __forceinline__ void mlstm_unit(Frame& F, const float* nw, int b, int h) {
    LAS bf16* Qm = (LAS bf16*)(F.lds); LAS bf16* Km = Qm + 128 * LK; LAS bf16* Kw = Km + 128 * LK; LAS bf16* Vm = Kw + 128 * LK; LAS bf16* Pm = Vm + 128 * LV; LAS bf16* Cm = Pm + 128 * LQ;
    const int tid = F.tid, lane = F.lane, w = F.wave, i16 = lane & 15, g = lane >> 4;
    const int dt = w & 3, eh = w >> 2;
    f32x4 accC[5];
#pragma unroll
    for (int k = 0; k < 5; ++k) accC[k] = (f32x4){0.f, 0.f, 0.f, 0.f};
    for (int i = tid; i < 64 * LV / 8; i += NWAVES * 64) ((LAS v4u*)Cm)[i] = (v4u){0u, 0u, 0u, 0u};
    float m_prev = 0.f;
    const bf16* zb = WSP(bf16, WS_Z) + (size_t)(b * SEQ) * NZ;
    const float* gif = WSP(float, WS_GIF) + (size_t)(b * SEQ) * 16;
    bf16* yb = WSP(bf16, WS_Y) + (size_t)M * 1024 + (size_t)(b * SEQ) * 1024 + h * 128;
    const int lr = tid >> 2, dg = tid & 3;
    v4u pq[2], pk[2]; float fl0, fl1, il0, il1, prr;
    const float* rstd1 = WSP(float, WS_RSTD) + (size_t)(b * SEQ);
#define ML_FETCH(t0_) do { const bf16* zr_ = zb + (size_t)((t0_) + lr) * NZ; \
        pq[0] = *(const v4u*)(zr_ + Z_MQ + h * 64 + 16 * dg); pq[1] = *(const v4u*)(zr_ + Z_MQ + h * 64 + 16 * dg + 8); pk[0] = *(const v4u*)(zr_ + Z_MK + h * 64 + 16 * dg); pk[1] = *(const v4u*)(zr_ + Z_MK + h * 64 + 16 * dg + 8); \
        fl0 = gif[(size_t)((t0_) + lane) * 16 + 8 + h]; fl1 = gif[(size_t)((t0_) + 64 + lane) * 16 + 8 + h]; il0 = gif[(size_t)((t0_) + lane) * 16 + h]; il1 = gif[(size_t)((t0_) + 64 + lane) * 16 + h]; prr = rstd1[(t0_) + lr]; } while (0)
    ML_FETCH(0);
    float nwv[8];
#pragma unroll
    for (int n = 0; n < 8; ++n) nwv[n] = nw[h * 128 + 16 * n + i16];
    for (int c = 0; c < SEQ / 128; ++c) {
        const int t0 = c * 128;
        const float a0 = scan64_sum(fl0, lane); const float a1 = scan64_sum(fl1, lane) + __shfl(a0, 63);
        const float b0 = il0 - a0, b1 = il1 - a1;
        const float pm0 = scan64_max(b0, lane); const float pm1 = fmaxf(scan64_max(b1, lane), __shfl(pm0, 63));
        const float a_last = __shfl(a1, 63), bmax = __shfl(pm1, 63);
        const float g_n = a_last + bmax, m_new = fmaxf(a_last + m_prev, g_n), s_old = __expf(a_last + m_prev - m_new), s_new = __expf(g_n - m_new);
        {
            const int r = lr;
            const float br = (r < 64) ? __shfl(b0, r & 63) : __shfl(b1, r & 63);
            const float rk = prr * 0.125f, wk = __expf(br - bmax) * rk * s_new;
#pragma unroll
            for (int hh = 0; hh < 2; ++hh) {
                *(LAS v4u*)(Qm + r * LK + 16 * dg + 8 * hh) = pq[hh];
                const v4u kk = pk[hh];
                float kf[8] = {bflo(kk.x), bfhi(kk.x), bflo(kk.y), bfhi(kk.y), bflo(kk.z), bfhi(kk.z), bflo(kk.w), bfhi(kk.w)};
                *(LAS v4u*)(Km + r * LK + 16 * dg + 8 * hh) = (v4u){pk2(kf[0] * rk, kf[1] * rk), pk2(kf[2] * rk, kf[3] * rk), pk2(kf[4] * rk, kf[5] * rk), pk2(kf[6] * rk, kf[7] * rk)};
                *(LAS v4u*)(Kw + r * LK + 16 * dg + 8 * hh) = (v4u){pk2(kf[0] * wk, kf[1] * wk), pk2(kf[2] * wk, kf[3] * wk), pk2(kf[4] * wk, kf[5] * wk), pk2(kf[6] * wk, kf[7] * wk)};
            }
#pragma unroll
            for (int q = 0; q < 4; ++q) { const v4u x = *(const v4u*)(zb + (size_t)(t0 + r) * NZ + Z_MV + h * 128 + 32 * dg + 8 * q); const float rv = prr;
                *(LAS v4u*)(Vm + r * LV + 32 * dg + 8 * q) = (v4u){pk2(bflo(x.x) * rv, bfhi(x.x) * rv), pk2(bflo(x.y) * rv, bfhi(x.y) * rv), pk2(bflo(x.z) * rv, bfhi(x.z) * rv), pk2(bflo(x.w) * rv, bfhi(x.w) * rv)}; }
            *(LAS v4u*)(Vm + r * LV + 128 + 8 * dg) = (v4u){dg == 0 ? 0x00003f80u : 0u, 0u, 0u, 0u};
            if (c + 1 < SEQ / 128) ML_FETCH(t0 + 128);
        }
        __syncthreads();
        float Mi[4], ai[4], rri[4];
#pragma unroll
        for (int r = 0; r < 4; ++r) { const int i = 16 * w + 4 * g + r; rri[r] = rstd1[t0 + i]; const float pmi = (w < 4) ? __shfl(pm0, i & 63) : __shfl(pm1, i & 63); ai[r] = (w < 4) ? __shfl(a0, i & 63) : __shfl(a1, i & 63); Mi[r] = fmaxf(pmi, m_prev); }
        bf16x8 aq[2];
#pragma unroll
        for (int s = 0; s < 2; ++s) aq[s] = frag_row(Qm, LK, 16 * w, 32 * s, lane);
        f32x4 acco[9];
#pragma unroll
        for (int n = 0; n < 9; ++n) acco[n] = (f32x4){0.f, 0.f, 0.f, 0.f};
#pragma unroll
        for (int s = 0; s < 2; ++s) {
#pragma unroll
          for (int hf = 0; hf < 2; ++hf) { bf16x8 bb[5];
#pragma unroll
            for (int n = 0; n < 5 - hf; ++n) bb[n] = frag_tr(Cm, LV, 32 * s, 16 * (5 * hf + n), lane);
            SCHED_FENCE();
#pragma unroll
            for (int n = 0; n < 5 - hf; ++n) acco[5 * hf + n] = MFMA16(aq[s], bb[n], acco[5 * hf + n]); } }
        { float si[4];
#pragma unroll
          for (int r = 0; r < 4; ++r) si[r] = __expf(m_prev - Mi[r]) * rri[r];
#pragma unroll
          for (int n = 0; n < 9; ++n)
#pragma unroll
            for (int r = 0; r < 4; ++r) acco[n][r] *= si[r]; }
        LDS_FENCE();
#pragma unroll
        for (int n = 0; n < 8; ++n) {
            if (n <= w) { f32x4 sa = (f32x4){0.f, 0.f, 0.f, 0.f}; bf16x8 bb[2];
#pragma unroll
                for (int s = 0; s < 2; ++s) bb[s] = frag_row(Km, LK, 16 * n, 32 * s, lane);
                SCHED_FENCE();
#pragma unroll
                for (int s = 0; s < 2; ++s) sa = MFMA16(aq[s], bb[s], sa);
                const int j = 16 * n + i16; const float bj = (n < 4) ? __shfl(b0, j & 63) : __shfl(b1, j & 63);
#pragma unroll
                for (int r = 0; r < 4; ++r) { const int i = 16 * w + 4 * g + r; Pm[i * LQ + j] = (bf16)f2bf(j <= i ? sa[r] * rri[r] * __expf(bj - Mi[r]) : 0.f); } }
            else if (n == w + 1) {
#pragma unroll
                for (int r = 0; r < 4; ++r) Pm[(16 * w + 4 * g + r) * LQ + 16 * n + i16] = (bf16)0; }
        }
        LDS_FENCE();
#pragma unroll
        for (int k = 0; k < 5; ++k) accC[k] = accC[k] * s_old;
#pragma unroll
        for (int s = 0; s < 4; ++s) { const bf16x8 ak = frag_tr(Kw, LK, 32 * s, 16 * dt, lane); const bool doi = (s <= (w >> 1)); bf16x8 ap = ak;
            if (doi) ap = frag_row(Pm, LQ, 16 * w, 32 * s, lane);
#pragma unroll
          for (int hf = 0; hf < 2; ++hf) { const bool dos = (hf == eh);
            if (doi || dos) { bf16x8 bb[5];
#pragma unroll
              for (int n = 0; n < 5; ++n) bb[n] = frag_tr(Vm, LV, 32 * s, 16 * (5 * hf + n), lane);
              SCHED_FENCE();
              if (doi) {
#pragma unroll
                for (int n = 0; n < 5 - hf; ++n) acco[5 * hf + n] = MFMA16(ap, bb[n], acco[5 * hf + n]); }
              if (dos) {
#pragma unroll
                for (int k = 0; k < 5; ++k) accC[k] = MFMA16(ak, bb[k], accC[k]); } } } }
        bf16 gvr[4][8];
#pragma unroll
        for (int r = 0; r < 4; ++r) { const bf16* gr = zb + (size_t)(t0 + 16 * w + 4 * g + r) * NZ + Z_MO + h * 128 + i16;
#pragma unroll
            for (int n = 0; n < 8; ++n) gvr[r][n] = gr[16 * n]; }
        LDS_FENCE();
        __syncthreads();
#pragma unroll
        for (int k = 0; k < 5; ++k)
#pragma unroll
            for (int r = 0; r < 4; ++r) Cm[(16 * dt + 4 * g + r) * LV + 16 * (5 * eh + k) + i16] = (bf16)f2bf(accC[k][r]);
#pragma unroll
        for (int r = 0; r < 4; ++r) {
            const float den = __shfl(acco[8][r], lane & 48);
            const float dd = 1.0f / fmaxf(fabsf(den), __expf(-(ai[r] + Mi[r])));
            float q = 0.f;
#pragma unroll
            for (int n = 0; n < 8; ++n) { acco[n][r] *= dd; q += acco[n][r] * acco[n][r]; }
            const float rstd = rsqrtf(red16_sum(q) * (1.f / 128.f) + 1e-6f);
            const int pos = t0 + 16 * w + 4 * g + r; bf16* yr = yb + (size_t)pos * 1024;
#pragma unroll
            for (int n = 0; n < 8; ++n) { const int e = 16 * n + i16; yr[e] = (bf16)f2bf(acco[n][r] * rstd * nwv[n] * sigm(bf1(gvr[r][n]) * rri[r])); }
        }
        m_prev = m_new;
    }
    __syncthreads();
#undef ML_FETCH
}
__device__ __forceinline__ int vt_off(int row, int chunk) { return row * 128 + ((chunk ^ ((row & 7) << 1)) << 3); }
__device__ __forceinline__ bf16x8 frag_trp(const LAS bf16* X, int k0, int c0, int lane) {
    const int g = lane >> 4, q = (lane & 15) >> 2, p = lane & 3;
    const LAS bf16* a = X + vt_off(k0 + 4 * g + q, (c0 >> 3) + (p >> 1)) + 4 * (p & 1);
    const s16x4 lo = __builtin_amdgcn_ds_read_tr16_b64_v4i16((LAS s16x4*)a);
    const s16x4 hi = __builtin_amdgcn_ds_read_tr16_b64_v4i16((LAS s16x4*)(a + 16 * 128));
    return __builtin_shufflevector(lo, hi, 0, 1, 2, 3, 4, 5, 6, 7);
}
__device__ __forceinline__ void moba_unit(Frame& F, int b, int h, int qi) {
    constexpr int KT_E = 128 * LQ, VT_E = 128 * 128;
    LAS bf16* Kt0 = (LAS bf16*)(F.lds); LAS bf16* Vt0 = Kt0 + 2 * KT_E;
    const int tid = F.tid, lane = F.lane, w = tid >> 6, i16 = lane & 15, g = lane >> 4;
    const int blk = qi >> 1, qt = qi & 1, q0 = qi * 128;
    const bf16* zb = WSP(bf16, WS_Z) + (size_t)(b * SEQ) * NZ + h * 128;
    bf16x8 aq[4];
    { const bf16* qr = zb + (size_t)(q0 + 16 * w + i16) * NZ + Z_AQ + 8 * g;
#pragma unroll
      for (int s = 0; s < 4; ++s) aq[s] = *(const bf16x8*)(qr + 32 * s); }
    const int lr = tid >> 2, dg = tid & 3;
    v4u pk[4], pv[4];
#define MB_FETCH(k0_) do { const bf16* zr_ = zb + (size_t)((k0_) + lr) * NZ + 32 * dg; \
        _Pragma("unroll") for (int q_ = 0; q_ < 4; ++q_) { pk[q_] = *(const v4u*)(zr_ + Z_AK + 8 * q_); pv[q_] = *(const v4u*)(zr_ + Z_AV + 8 * q_); } } while (0)
#define MB_STAGE(buf_) do { LAS bf16* kd_ = Kt0 + (buf_) * KT_E + lr * LQ + 32 * dg; LAS bf16* vd_ = Vt0 + (buf_) * VT_E; \
        _Pragma("unroll") for (int q_ = 0; q_ < 4; ++q_) { *(LAS v4u*)(kd_ + 8 * q_) = pk[q_]; *(LAS v4u*)(vd_ + vt_off(lr, 4 * dg + q_)) = pv[q_]; } } while (0)
    MB_FETCH(0);
    unsigned sel = 0u;
    {
        float gate[8];
        const float* km = WSP(float, WS_KMEAN) + (size_t)((b * NH + h) * 16) * 128 + 8 * g;
#pragma unroll
        for (int n = 0; n < 8; ++n) { gate[n] = -INFINITY;
            if (n < blk) { float p = 0.f;
#pragma unroll
                for (int s = 0; s < 4; ++s) { const f32x4 k0 = *(const f32x4*)(km + n * 256 + 32 * s) + *(const f32x4*)(km + n * 256 + 128 + 32 * s), k1 = *(const f32x4*)(km + n * 256 + 32 * s + 4) + *(const f32x4*)(km + n * 256 + 128 + 32 * s + 4);
                    p += bf1((bf16)aq[s][0]) * k0.x + bf1((bf16)aq[s][1]) * k0.y + bf1((bf16)aq[s][2]) * k0.z + bf1((bf16)aq[s][3]) * k0.w
                       + bf1((bf16)aq[s][4]) * k1.x + bf1((bf16)aq[s][5]) * k1.y + bf1((bf16)aq[s][6]) * k1.z + bf1((bf16)aq[s][7]) * k1.w; }
                p += __shfl_xor(p, 16); p += __shfl_xor(p, 32); gate[n] = p; } }
#pragma unroll
        for (int s = 0; s < 3; ++s) { float bv = -INFINITY; int best = -1;
#pragma unroll
            for (int n = 0; n < 8; ++n) { const bool c = !((sel >> n) & 1u) && gate[n] > bv; bv = c ? gate[n] : bv; best = c ? n : best; }
            if (best >= 0) sel |= 1u << best; }
    }
#pragma unroll
    for (int s = 0; s < 4; ++s) { const v4u u = __builtin_bit_cast(v4u, aq[s]); const float c2 = 0.08838834764831845f * 1.4426950408889634f;
        const v4u o = (v4u){pk2(bflo(u.x) * c2, bfhi(u.x) * c2), pk2(bflo(u.y) * c2, bfhi(u.y) * c2), pk2(bflo(u.z) * c2, bfhi(u.z) * c2), pk2(bflo(u.w) * c2, bfhi(u.w) * c2)}; aq[s] = __builtin_bit_cast(bf16x8, o); }
    f32x4 acco[8];
#pragma unroll
    for (int n = 0; n < 8; ++n) acco[n] = (f32x4){0.f, 0.f, 0.f, 0.f};
    float mq = -1e30f, lq = 0.f;
    const int ntiles = 2 * blk + qt + 1;
    const int qrel = 16 * w + i16 - 4 * g;
    __syncthreads();
    MB_STAGE(0);
    if (ntiles > 1) MB_FETCH(128);
    __syncthreads();
    for (int kt = 0; kt < ntiles; ++kt) {
        const int kb = kt >> 1; const bool own = (kb == blk), diag = (kt == 2 * blk + qt);
        const LAS bf16* Kt = Kt0 + (kt & 1) * KT_E; const LAS bf16* Vt = Vt0 + (kt & 1) * VT_E;
        f32x4 sc[8];
#pragma unroll
        for (int n = 0; n < 8; ++n) sc[n] = (f32x4){0.f, 0.f, 0.f, 0.f};
#pragma unroll
        for (int s = 0; s < 4; ++s) { bf16x8 bb[8];
#pragma unroll
            for (int n = 0; n < 8; ++n) bb[n] = frag_row(Kt, LQ, 16 * n, 32 * s, lane);
            SCHED_FENCE();
#pragma unroll
            for (int n = 0; n < 8; ++n) sc[n] = MFMA16(bb[n], aq[s], sc[n]); }
        if (diag) {
#pragma unroll
            for (int n = 0; n < 8; ++n)
#pragma unroll
                for (int r = 0; r < 4; ++r) sc[n][r] = (16 * n + r <= qrel) ? sc[n][r] : -1e30f; }
        const bool rowok = own || ((sel >> kb) & 1u);
        float mx = -1e30f;
#pragma unroll
        for (int n = 0; n < 8; ++n) mx = fmaxf(mx, fmaxf(fmaxf(sc[n][0], sc[n][1]), fmaxf(sc[n][2], sc[n][3])));
        mx = fmaxf(mx, __shfl_xor(mx, 16)); mx = fmaxf(mx, __shfl_xor(mx, 32));
        const float mnew = rowok ? fmaxf(mq, mx) : mq;
        const float alpha = __builtin_amdgcn_exp2f(mq - mnew); mq = mnew;
        const float msub = rowok ? mnew : 1e30f;
        float ps = 0.f;
#pragma unroll
        for (int n = 0; n < 8; ++n)
#pragma unroll
            for (int r = 0; r < 4; ++r) { sc[n][r] = __builtin_amdgcn_exp2f(sc[n][r] - msub); ps += sc[n][r]; }
        lq = lq * alpha + ps;
#pragma unroll
        for (int n = 0; n < 8; ++n) acco[n] = acco[n] * alpha;
#pragma unroll
        for (int t = 0; t < 4; ++t) {
            const v4u pw = (v4u){pk2(sc[2 * t][0], sc[2 * t][1]), pk2(sc[2 * t][2], sc[2 * t][3]), pk2(sc[2 * t + 1][0], sc[2 * t + 1][1]), pk2(sc[2 * t + 1][2], sc[2 * t + 1][3])};
            const bf16x8 pf = __builtin_bit_cast(bf16x8, pw); bf16x8 bb[8];
#pragma unroll
            for (int n = 0; n < 8; ++n) bb[n] = frag_trp(Vt, 32 * t, 16 * n, lane);
            SCHED_FENCE();
#pragma unroll
            for (int n = 0; n < 8; ++n) acco[n] = MFMA16(bb[n], pf, acco[n]); }
        if (kt + 1 < ntiles) { MB_STAGE((kt + 1) & 1); if (kt + 2 < ntiles) MB_FETCH((kt + 2) * 128); }
        __syncthreads();
    }
    lq += __shfl_xor(lq, 16); lq += __shfl_xor(lq, 32);
    const float inv = 1.0f / lq;
    bf16* yr = WSP(bf16, WS_Y) + (size_t)2 * M * 1024 + (size_t)(b * SEQ + q0 + 16 * w + i16) * 1024 + h * 128 + 4 * g;
#pragma unroll
    for (int n = 0; n < 8; ++n) *(v2u*)(yr + 16 * n) = (v2u){pk2(acco[n][0] * inv, acco[n][1] * inv), pk2(acco[n][2] * inv, acco[n][3] * inv)};
#undef MB_FETCH
#undef MB_STAGE
}
__device__ __forceinline__ void mix_phase(Frame& F, const float* rgn, const float* mln, unsigned* head) {
    volatile LAS unsigned* slot = F.MISC;
    for (;;) {
        if (F.tid == 0) slot[0] = __hip_atomic_fetch_add(head, 1u, __ATOMIC_RELAXED, __HIP_MEMORY_SCOPE_AGENT);
        __syncthreads();
        const unsigned it = slot[0];
        __syncthreads();
        if (it >= 128u + 1024u) break;
        { int t_ = threadIdx.x; asm volatile("" : "+v"(t_)); F.tid = t_; F.lane = t_ & 63; }
        if (it < 64u) ret_unit(F, rgn, (int)(it >> 3), (int)(it & 7u));
        else if (it < 128u) mlstm_unit(F, mln, (int)((it - 64u) >> 3), (int)(it & 7u));
        else { const unsigned rank = it - 128u; moba_unit(F, (int)((rank & 63u) >> 3), (int)(rank & 7u), 15 - (int)(rank >> 6)); }
    }
}
}
constexpr int N_PHASES = 1 + 8 * DEPTH;
__global__ void __launch_bounds__(NWAVES * 64, 2) fwd(Args args) {
    extern __shared__ __attribute__((aligned(16))) unsigned char lds[];
    Frame F;
    F.lds = (LAS unsigned char*)lds;
    F.MISC = (volatile LAS unsigned*)(F.lds + MISC_OFF);
    F.tid = threadIdx.x; F.lane = F.tid & 63; F.wave = __builtin_amdgcn_readfirstlane(F.tid >> 6); F.G = gridDim.x; F.bx = blockIdx.x;
    F.ws = args.ws;
    for (int u = F.tid; u < (LDS_BYTES - LDSCTL_OFF) / 4; u += NWAVES * 64) ((LAS unsigned*)(F.lds + LDSCTL_OFF))[u] = 0u;
    __syncthreads();
    XcdBarrier bar = xcd_barrier_post((unsigned*)(F.ws + WS_CTL) + CW_BAR + args.li * XCD_BAR_WORDS, F.MISC + 8);
    const int lo = args.ph_lo, hi = args.ph_hi;
#define RUN(p) (lo <= (p) && (p) < hi)
#define SEAM(p) do { if ((p) + 1 < hi) xcd_barrier(bar); } while (0)
    if (RUN(0)) { p0_prologue(F, args); SEAM(0); }
    for (int l = 0; l < DEPTH; ++l) {
        const int p0 = 1 + 8 * l;
        { int t_ = threadIdx.x; asm volatile("" : "+v"(t_)); F.tid = t_; F.lane = t_ & 63; F.wave = __builtin_amdgcn_readfirstlane(t_ >> 6); int b_ = blockIdx.x; asm volatile("" : "+s"(b_)); F.bx = b_; }
        float* rs = WSP(float, WS_RS) + (size_t)(2 * l) * M * 32;
        if (RUN(p0 + 0)) {
            pg8::Gemm g{WSP(bf16, WS_XB), WSP(bf16, WS_WIN) + (size_t)l * NZ * DM, M, NZ, DM}; pg8::StaticOrder S; S.init(M, NZ, F.G, F.bx);
            pg8::EpiBf16 E{WSP(bf16, WS_Z), NZ, F.ws + WS_ZG, Z_GA / 256, 3 * DM};
            pg8::gemm_phase<pg8::EpiBf16, pg8::StaticOrder, false, true>(F.lds + RING_OFF, g, S, E);
            SEAM(p0 + 0); }
        if (RUN(p0 + 1)) { prep_phase(F, args.in[I_QN] + l * 128, args.in[I_KN] + l * 128, WSP(bf16, WS_W16G) + (size_t)l * 16 * DM, rs, args.in[I_BIG] + l * 8, args.in[I_BFG] + l * 8); SEAM(p0 + 1); }
        if (RUN(p0 + 2)) { mx::mix_phase(F, args.in[I_RGN] + l * 1024, args.in[I_MLN] + l * 1024, (unsigned*)(F.ws + WS_CTL) + CW_QUEUE + 64 * l); SEAM(p0 + 2); }
        if (RUN(p0 + 3)) {
            pg8::StaticOrder3 S; S.init(M, DM, F.G, F.bx);
            pg8::Gemm g{WSP(bf16, WS_Y), WSP(bf16, WS_WP) + (size_t)l * 3 * DM * 1024, M, DM, 1024, (size_t)M * 1024, (size_t)DM * 1024}; pg8::EpiGateAcc E{WSP(bf16, WS_MG), DM, F.ws + WS_ZG, 3 * DM, WSP(float, WS_RSTD)};
            pg8::gemm_phase<pg8::EpiGateAcc, pg8::StaticOrder3, true, true>(F.lds + RING_OFF, g, S, E);
            SEAM(p0 + 3); }
        if (RUN(p0 + 4)) {
            pg8::Gemm g{WSP(bf16, WS_MG), WSP(bf16, WS_WOUT) + (size_t)l * DM * DM, M, DM, DM}; pg8::StaticOrder S; S.init(M, DM, F.G, F.bx);
            pg8::EpiRes<false> E{WSP(bf16, WS_XB), rs + (size_t)32 * M, nullptr, DM};
            pg8::gemm_phase<pg8::EpiRes<false>, pg8::StaticOrder, true, true>(F.lds + RING_OFF, g, S, E);
            SEAM(p0 + 4); }
        if (RUN(p0 + 5)) {
            pg8::Gemm g{WSP(bf16, WS_XB), WSP(bf16, WS_WUP) + (size_t)l * NUP * DM, M, NUP, DM}; pg8::StaticOrder S; S.init(M, NUP, F.G, F.bx);
            pg8::EpiGLU E{WSP(bf16, WS_ACT), args.in[I_CW] + (size_t)l * 3 * NUP, args.in[I_CB] + (size_t)l * NUP, rs + (size_t)32 * M, WSP(bf16, WS_SB)};
            pg8::gemm_phase<pg8::EpiGLU, pg8::StaticOrder, false, true>(F.lds + RING_OFF, g, S, E);
            SEAM(p0 + 5); }
        if (RUN(p0 + 6)) { glu_fix_phase(F, args.in[I_CW] + (size_t)l * 3 * NUP, args.in[I_CB] + (size_t)l * NUP); SEAM(p0 + 6); }
        if (RUN(p0 + 7)) {
            pg8::Gemm g{WSP(bf16, WS_ACT), WSP(bf16, WS_WDN) + (size_t)l * DM * DFF, M, DM, DFF}; pg8::StaticOrder S; S.init(M, DM, F.G, F.bx);
            if (l + 1 < DEPTH) { pg8::EpiRes<false> E{WSP(bf16, WS_XB), rs + (size_t)64 * M, nullptr, DM};
                pg8::gemm_phase<pg8::EpiRes<false>, pg8::StaticOrder, true, true>(F.lds + RING_OFF, g, S, E); }
            else { pg8::EpiRes<true> E{WSP(bf16, WS_XB), nullptr, args.out, DM};
                pg8::gemm_phase<pg8::EpiRes<true>, pg8::StaticOrder, true, true>(F.lds + RING_OFF, g, S, E); }
            SEAM(p0 + 7); }
    }
#undef RUN
#undef SEAM
}

#ifndef MK_N_LAUNCHES
#define MK_N_LAUNCHES 1
#endif
extern "C" void kernel_launch(void* const* d_in, const int* in_sizes, int n_in, void* d_out, int out_size, void* d_ws, size_t ws_size, hipStream_t stream) {
    static int grid = 0;
    if (grid == 0) {
        if (n_in != 18 || in_sizes[0] != M * DM || out_size != M * DM || ws_size < WS_END) { fprintf(stderr, "kernel_launch: unexpected shapes (n_in %d, in0 %d, out %d, ws %zu)\n", n_in, n_in > 0 ? in_sizes[0] : -1, out_size, ws_size); grid = -1; return; }
        int dev = 0, cus = 0, per_cu = 0;
        if (hipGetDevice(&dev) != hipSuccess || hipDeviceGetAttribute(&cus, hipDeviceAttributeMultiprocessorCount, dev) != hipSuccess) { grid = -1; return; }
        if (hipFuncSetAttribute((const void*)fwd, hipFuncAttributeMaxDynamicSharedMemorySize, LDS_BYTES) != hipSuccess) { fprintf(stderr, "kernel_launch: hipFuncSetAttribute failed\n"); grid = -1; return; }
        if (hipOccupancyMaxActiveBlocksPerMultiprocessor(&per_cu, (const void*)fwd, NWAVES * 64, LDS_BYTES) != hipSuccess || per_cu < 1) fprintf(stderr, "kernel_launch: occupancy query reports %d\n", per_cu);
        (void)hipGetLastError();
        grid = cus;
    }
    if (grid < 0) return;
    if (hipMemsetAsync((char*)d_ws + WS_CTL, 0, CTL_ZERO_BYTES, stream) != hipSuccess) return;
    Args a{};
    for (int i = 0; i < 18; ++i) a.in[i] = (const float*)d_in[i];
    a.out = (float*)d_out; a.ws = (unsigned char*)d_ws; a.pad = 0;
    constexpr int NL = MK_N_LAUNCHES;
    for (int li = 0; li < NL; ++li) {
        a.ph_lo = (NL == 1) ? 0 : li; a.ph_hi = (NL == 1) ? N_PHASES : li + 1; a.li = (NL == 1) ? 0 : 0;
        hipLaunchKernelGGL(fwd, dim3(grid), dim3(NWAVES * 64), LDS_BYTES, stream, a);
    }
}
```

```cpp
#include <hip/hip_runtime.h>
#include <cstdio>
#include <cstdint>
namespace pg8 {
#define PG8_LAS __attribute__((address_space(3)))
typedef unsigned short bf16_t;
typedef short bf16x8 __attribute__((ext_vector_type(8)));
typedef float f32x4 __attribute__((ext_vector_type(4)));
typedef unsigned u32x4 __attribute__((ext_vector_type(4)));
constexpr int BM = 256, BK = 64, HALF = 128, HTB = HALF * BK * 2  , STAGE_BYTES = 8 * HTB, NXCD = 8, WGM = 8;

__host__ __device__ __forceinline__ int lds_byte(int r, int c) { const int st = (r >> 4) * 2 + (c >> 5), rr = r & 15, cc = c & 31, ob = rr * 64 + cc * 2; return st * 1024 + (ob ^ (((ob >> 9) & 1) << 5)); }
__host__ __device__ __forceinline__ void stage_rc(int b, int& R, int& C) { const int st = b / 1024, sb = b % 1024, swz = sb ^ (((sb >> 9) & 1) << 5); R = (st >> 1) * 16 + swz / 64; C = (st & 1) * 32 + (swz % 64) / 2; }
__host__ __device__ __forceinline__ int perm32(int rho) { const int n = rho >> 4, i = rho & 15; return 8 * (i >> 2) + 4 * n + (i & 3); }

struct Unit { int pm, pn, z; };
struct Gemm { const bf16_t* A; const bf16_t* Bt; int M, N, K; size_t zA, zB; };

struct StaticOrder {
    int nM, nN, nwg, G, c;
    __host__ __device__ void init(int M, int N, int G_, int c_) { nM = M / BM; nN = N / BM; nwg = nM * nN; G = G_; c = c_; }
    __host__ __device__ bool next(int i, Unit& u) const {
        const long L = (long)i * G + c; if (L >= nwg) return false;
        int wgid = (int)L; { const int q = nwg / NXCD, r = nwg % NXCD, xcd = wgid % NXCD, off = wgid / NXCD; wgid = (xcd < r ? xcd * (q + 1) : r * (q + 1) + (xcd - r) * q) + off; }
        const int nig = WGM * nN, gid = wgid / nig, fm = gid * WGM, gsz = (nM - fm) < WGM ? (nM - fm) : WGM;
        u.pm = fm + ((wgid % nig) % gsz); u.pn = (wgid % nig) / gsz; u.z = 0; return true;
    }
    __device__ __forceinline__ void a_ready(const Unit&) const {}
    __device__ __forceinline__ void done(const Unit&) const {}
};

struct StaticOrder3 : StaticOrder {
    __host__ __device__ bool next(int i, Unit& u) const { if (!StaticOrder::next(i / 3, u)) return false; u.z = i % 3; return true; }
};
__device__ __forceinline__ unsigned cvt_pk_bf16(float lo, float hi) { unsigned r; asm volatile("v_cvt_pk_bf16_f32 %0, %1, %2" : "=v"(r) : "v"(lo), "v"(hi)); return r; }
typedef unsigned u32x2 __attribute__((ext_vector_type(2)));
struct EpiBf16 {
    static constexpr bool PERM = true, AFTER_DRAIN = false, KEEP = false, APERM = false;
    bf16_t* O; int ldc; unsigned char* G8; int g8_pn0, g8_ld;
    __device__ __forceinline__ void operator()(const f32x4 (&acc)[2][2][4][2], const Unit& u, int wr, int wc, int fr, int fq) const {
        const int row0 = u.pm * BM + wr * 64 + fr; const int col0 = u.pn * BM + wc * 32 + 8 * fq;
        if (g8_pn0 >= 0 && u.pn >= g8_pn0) { const int gc0 = (u.pn - g8_pn0) * BM + wc * 32 + 8 * fq;
#pragma unroll
            for (int ai = 0; ai < 2; ++ai)
#pragma unroll
                for (int m = 0; m < 4; ++m) { unsigned char* rowp = G8 + (size_t)(row0 + ai * HALF + m * 16) * g8_ld + gc0;
#pragma unroll
                    for (int bj = 0; bj < 2; ++bj) { const f32x4 v0 = acc[ai][bj][m][0], v1 = acc[ai][bj][m][1]; u32x2 w;
                        w.x = (unsigned)__builtin_amdgcn_cvt_pk_fp8_f32(v0[2], v0[3], __builtin_amdgcn_cvt_pk_fp8_f32(v0[0], v0[1], 0, false), true);
                        w.y = (unsigned)__builtin_amdgcn_cvt_pk_fp8_f32(v1[2], v1[3], __builtin_amdgcn_cvt_pk_fp8_f32(v1[0], v1[1], 0, false), true);
                        *(u32x2*)(rowp + bj * HALF) = w; } }
            return; }
#pragma unroll
        for (int ai = 0; ai < 2; ++ai)
#pragma unroll
            for (int m = 0; m < 4; ++m) { bf16_t* rowp = O + (size_t)(row0 + ai * HALF + m * 16) * ldc + col0;
#pragma unroll
                for (int bj = 0; bj < 2; ++bj) { const f32x4 v0 = acc[ai][bj][m][0], v1 = acc[ai][bj][m][1];
                    u32x4 w; w.x = cvt_pk_bf16(v0[0], v0[1]); w.y = cvt_pk_bf16(v0[2], v0[3]); w.z = cvt_pk_bf16(v1[0], v1[1]); w.w = cvt_pk_bf16(v1[2], v1[3]);
                    *(u32x4*)(rowp + bj * HALF) = w; } }
    }
};
__device__ __forceinline__ float bf_lo(unsigned w) { return __uint_as_float(w << 16); }
__device__ __forceinline__ float bf_hi(unsigned w) { return __uint_as_float(w & 0xffff0000u); }
__device__ __forceinline__ float sigmoid_f(float x) { return __builtin_amdgcn_rcpf(1.0f + __expf(-x)); }
struct EpiGateAcc {
    static constexpr bool PERM = true, AFTER_DRAIN = false, KEEP = true, APERM = false;
    bf16_t* O; int ldc; const unsigned char* G8; int g8_ld; const float* rstd;
    template <int E> static __device__ __forceinline__ float g8f(const u32x2 w) { return __builtin_amdgcn_cvt_f32_fp8((int)(E < 4 ? w.x : w.y), E & 3); }
    static __device__ __forceinline__ float em(float g, float rr) { return __expf(-fminf(fmaxf(g * rr, -40.f), 40.f)); }
    __device__ __forceinline__ void operator()(f32x4 (&acc)[2][2][4][2], const Unit& u, int wr, int wc, int fr, int fq) const {
        const int row0 = u.pm * BM + wr * 64 + fr; const int col0 = u.pn * BM + wc * 32 + 8 * fq; const bool last = (u.z == 2); const float dmask = last ? 0.0f : 1.0f;
        const unsigned char* Gn = G8 + (size_t)u.z * ldc; const unsigned char* Gd = G8 + (size_t)(last ? u.z : u.z + 1) * ldc;
#pragma unroll
        for (int ai = 0; ai < 2; ++ai)
#pragma unroll
            for (int m = 0; m < 4; ++m) { const size_t row = (size_t)(row0 + ai * HALF + m * 16); const float rr = rstd[row];
#pragma unroll
                for (int bj = 0; bj < 2; ++bj) {
                    const u32x2 gn = *(const u32x2*)(Gn + row * g8_ld + col0 + bj * HALF), gd = *(const u32x2*)(Gd + row * g8_ld + col0 + bj * HALF);
                    f32x4 v0 = acc[ai][bj][m][0], v1 = acc[ai][bj][m][1];
#define GA_MUL(E) ((1.0f + dmask * em(g8f<E>(gd), rr)) * __builtin_amdgcn_rcpf(1.0f + em(g8f<E>(gn), rr)))
                    v0[0] *= GA_MUL(0); v0[1] *= GA_MUL(1); v0[2] *= GA_MUL(2); v0[3] *= GA_MUL(3); v1[0] *= GA_MUL(4); v1[1] *= GA_MUL(5); v1[2] *= GA_MUL(6); v1[3] *= GA_MUL(7);
#undef GA_MUL
                    acc[ai][bj][m][0] = v0; acc[ai][bj][m][1] = v1;
                    if (last) { u32x4 w; w.x = cvt_pk_bf16(v0[0], v0[1]); w.y = cvt_pk_bf16(v0[2], v0[3]); w.z = cvt_pk_bf16(v1[0], v1[1]); w.w = cvt_pk_bf16(v1[2], v1[3]); *(u32x4*)(O + row * ldc + col0 + bj * HALF) = w; } } }
    }
};
template <bool LAST> struct EpiRes {
    static constexpr bool PERM = true, AFTER_DRAIN = false, KEEP = false, APERM = false;
    bf16_t* xb; float* rs; float* out; int ldc;
    __device__ __forceinline__ void operator()(const f32x4 (&acc)[2][2][4][2], const Unit& u, int wr, int wc, int fr, int fq) const {
        const int row0 = u.pm * BM + wr * 64 + fr; const int col0 = u.pn * BM + wc * 32 + 8 * fq;
#pragma unroll
        for (int ai = 0; ai < 2; ++ai)
#pragma unroll
            for (int m = 0; m < 4; ++m) { const int row = row0 + ai * HALF + m * 16; const size_t off = (size_t)row * ldc + col0; float sq = 0.f;
#pragma unroll
                for (int bj = 0; bj < 2; ++bj) { const u32x4 p = *(const u32x4*)(xb + off + bj * HALF); const f32x4 v0 = acc[ai][bj][m][0], v1 = acc[ai][bj][m][1];
                    const float o0 = bf_lo(p.x) + v0[0], o1 = bf_hi(p.x) + v0[1], o2 = bf_lo(p.y) + v0[2], o3 = bf_hi(p.y) + v0[3], o4 = bf_lo(p.z) + v1[0], o5 = bf_hi(p.z) + v1[1], o6 = bf_lo(p.w) + v1[2], o7 = bf_hi(p.w) + v1[3];
                    if (LAST) { *(f32x4*)(out + off + bj * HALF) = (f32x4){o0, o1, o2, o3}; *(f32x4*)(out + off + bj * HALF + 4) = (f32x4){o4, o5, o6, o7}; }
                    else { sq += ((o0 * o0 + o1 * o1) + (o2 * o2 + o3 * o3)) + ((o4 * o4 + o5 * o5) + (o6 * o6 + o7 * o7));
                        u32x4 w; w.x = cvt_pk_bf16(o0, o1); w.y = cvt_pk_bf16(o2, o3); w.z = cvt_pk_bf16(o4, o5); w.w = cvt_pk_bf16(o6, o7); *(u32x4*)(xb + off + bj * HALF) = w; } }
                if (!LAST) { sq += __shfl_xor(sq, 16); sq += __shfl_xor(sq, 32); if (fq == 0) rs[(size_t)row * 32 + u.pn * 4 + wc] = sq; } }
    }
};

struct EpiGLU {
    static constexpr bool PERM = true, AFTER_DRAIN = false, KEEP = false, APERM = true;
    bf16_t* ACT; const float* cw; const float* cb; const float* rs; bf16_t* SB;
    static __device__ __forceinline__ f32x4 prev_lane(const f32x4 v, int src) { f32x4 o;
#pragma unroll
        for (int k = 0; k < 4; ++k) o[k] = __shfl(v[k], src); return o; }
    static __device__ __forceinline__ f32x4 silu4(const f32x4 a) { f32x4 o;
#pragma unroll
        for (int k = 0; k < 4; ++k) o[k] = a[k] * __builtin_amdgcn_rcpf(1.0f + __expf(-a[k])); return o; }
    __device__ __forceinline__ void operator()(const f32x4 (&acc)[2][2][4][2], const Unit& u, int wr, int wc, int fr, int fq) const {
        constexpr int DFF_ = 5632, NUP_ = 2 * DFF_;
        const int T0 = u.pm * BM + 8 * (16 * wr + fr), jq = u.pn * HALF + wc * 32 + 8 * fq, grp = 2 * u.pm + wr;
        float s0 = 0.f, s1 = 0.f;
        { const int L = fq * 16 + fr; const float* p0 = rs + (size_t)(u.pm * BM + 128 * wr + 2 * L) * 32;
#pragma unroll
          for (int q = 0; q < 8; ++q) { const f32x4 a = *(const f32x4*)(p0 + 4 * q), b = *(const f32x4*)(p0 + 32 + 4 * q); s0 += (a[0] + a[1]) + (a[2] + a[3]); s1 += (b[0] + b[1]) + (b[2] + b[3]); }
          s0 = __builtin_amdgcn_rsqf(s0 * (1.0f / 2048.0f) + 1e-6f); s1 = __builtin_amdgcn_rsqf(s1 * (1.0f / 2048.0f) + 1e-6f); }
        float rr[8];
#pragma unroll
        for (int i = 0; i < 8; ++i) rr[i] = __shfl((i & 1) ? s1 : s0, 4 * fr + (i >> 1));
#pragma unroll
        for (int n = 0; n < 2; ++n) { const int j = jq + 4 * n;
            const f32x4 ca = *(const f32x4*)(cb + j), cbv = *(const f32x4*)(cb + DFF_ + j);
            const f32x4 a0 = *(const f32x4*)(cw + j), a1 = *(const f32x4*)(cw + NUP_ + j), a2 = *(const f32x4*)(cw + 2 * NUP_ + j);
            const f32x4 b0 = *(const f32x4*)(cw + DFF_ + j), b1 = *(const f32x4*)(cw + NUP_ + DFF_ + j), b2 = *(const f32x4*)(cw + 2 * NUP_ + DFF_ + j);
            f32x4 va[8], vb[8];
#pragma unroll
            for (int i = 0; i < 8; ++i) { va[i] = acc[i >> 2][0][i & 3][n] * rr[i]; vb[i] = acc[i >> 2][1][i & 3][n] * rr[i]; }
            const int psrc = fq * 16 + ((fr + 15) & 15); const f32x4 pa6 = prev_lane(va[6], psrc), pa7 = prev_lane(va[7], psrc), pb6 = prev_lane(vb[6], psrc), pb7 = prev_lane(vb[7], psrc);
#pragma unroll
            for (int i = 0; i < 8; ++i) {
                const f32x4 xa1 = i >= 1 ? va[i - 1] : pa7, xa2 = i >= 2 ? va[i - 2] : (i == 1 ? pa7 : pa6), xb1 = i >= 1 ? vb[i - 1] : pb7, xb2 = i >= 2 ? vb[i - 2] : (i == 1 ? pb7 : pb6);
                const f32x4 ua = ca + a0 * xa2 + a1 * xa1 + a2 * va[i], ub = cbv + b0 * xb2 + b1 * xb1 + b2 * vb[i];
                const f32x4 o = silu4(ua) * ub;
                if (i >= 2 || fr != 0) { u32x2 w; w.x = cvt_pk_bf16(o[0], o[1]); w.y = cvt_pk_bf16(o[2], o[3]); *(u32x2*)(ACT + (size_t)(T0 + i) * DFF_ + j) = w; } }
            if (fr == 0) {
#pragma unroll
                for (int i = 0; i < 2; ++i) { u32x2 w; w.x = cvt_pk_bf16(va[i][0], va[i][1]); w.y = cvt_pk_bf16(va[i][2], va[i][3]); *(u32x2*)(SB + ((size_t)grp * 4 + 2 + i) * NUP_ + j) = w;
                    w.x = cvt_pk_bf16(vb[i][0], vb[i][1]); w.y = cvt_pk_bf16(vb[i][2], vb[i][3]); *(u32x2*)(SB + ((size_t)grp * 4 + 2 + i) * NUP_ + DFF_ + j) = w; } }
            if (fr == 15) {
#pragma unroll
                for (int i = 0; i < 2; ++i) { u32x2 w; w.x = cvt_pk_bf16(va[6 + i][0], va[6 + i][1]); w.y = cvt_pk_bf16(va[6 + i][2], va[6 + i][3]); *(u32x2*)(SB + ((size_t)(grp + 1) * 4 + i) * NUP_ + j) = w;
                    w.x = cvt_pk_bf16(vb[6 + i][0], vb[6 + i][1]); w.y = cvt_pk_bf16(vb[6 + i][2], vb[6 + i][3]); *(u32x2*)(SB + ((size_t)(grp + 1) * 4 + i) * NUP_ + DFF_ + j) = w; } }
        }
    }
};

template <class Epi, class Sched, bool ALIGN_EPI = false, bool SP2 = false>
__device__ __forceinline__ void gemm_phase(PG8_LAS unsigned char* lds, const Gemm g, const Sched& S, const Epi& E) {
    int tid_ = threadIdx.x; asm volatile("" : "+v"(tid_));
    const int tid = tid_, wid = __builtin_amdgcn_readfirstlane(tid >> 6), lane = tid & 63, wr = wid >> 2, wc = wid & 3, fr = lane & 15, fq = lane >> 4;
    const int K = g.K, nt = K / BK;
    unsigned voffA[2], voffB[2];
#pragma unroll
    for (int i = 0; i < 2; ++i) { int R, C; stage_rc(tid * 16 + i * 8192, R, C); const int Rb = Epi::PERM ? ((R & ~31) + perm32(R & 31)) : R;
        const int Ra = Epi::APERM ? (8 * (16 * (R >> 6) + (R & 15)) + ((R >> 4) & 3)) : R;
        voffA[i] = (unsigned)(Ra * K + C) * 2u; voffB[i] = (unsigned)(Rb * K + C) * 2u; }
    const size_t kstep = (size_t)(BK * 2);
    const size_t hstep = (size_t)HALF * K * 2;
    const size_t hstepA = Epi::APERM ? (size_t)4 * K * 2 : hstep;
    const size_t tstep = 2 * hstep;
    const unsigned ldsw = (unsigned)wid * 1024u;
    const int aoff = lds_byte(wr * 64 + fr, fq * 8), boff = lds_byte(wc * 32 + fr, fq * 8);
#define PG8_SA(b, h) (((b) * 2 + (h)) * HTB)
#define PG8_SB(b, h) ((4 + (b) * 2 + (h)) * HTB)
#define PG8_STAGE(bufoff, gbase, voff) do { _Pragma("unroll") for (int _i = 0; _i < 2; ++_i) \
        __builtin_amdgcn_global_load_lds((const unsigned*)((const char*)(gbase) + (voff)[_i]), (PG8_LAS unsigned*)(lds + (bufoff) + ldsw + _i * 8192), 16, 0, 0); } while (0)
#define PG8_LDA(dst, b, h) do { _Pragma("unroll") for (int m = 0; m < 4; ++m) _Pragma("unroll") for (int k = 0; k < 2; ++k) dst[m][k] = *(const PG8_LAS bf16x8*)(lds + PG8_SA(b, h) + aoff + m * 2048 + k * 1024); } while (0)
#define PG8_LDB(dst, b, h) do { _Pragma("unroll") for (int n = 0; n < 2; ++n) _Pragma("unroll") for (int k = 0; k < 2; ++k) dst[n][k] = *(const PG8_LAS bf16x8*)(lds + PG8_SB(b, h) + boff + n * 2048 + k * 1024); } while (0)
#define PG8_MMA(ai, bj, At, Bt) do { __builtin_amdgcn_s_setprio(1); _Pragma("unroll") for (int m = 0; m < 4; ++m) _Pragma("unroll") for (int n = 0; n < 2; ++n) _Pragma("unroll") for (int k = 0; k < 2; ++k) \
        acc[ai][bj][m][n] = __builtin_amdgcn_mfma_f32_16x16x32_bf16(Bt[n][k], At[m][k], acc[ai][bj][m][n], 0, 0, 0); __builtin_amdgcn_s_setprio(0); } while (0)
#define PG8_WAIT_V(n) asm volatile("s_waitcnt vmcnt(" #n ")" ::: "memory")
#define PG8_WAIT_L(n) asm volatile("s_waitcnt lgkmcnt(" #n ")" ::: "memory")
#define PG8_BAR __builtin_amdgcn_s_barrier()
#define PG8_SCHED __builtin_amdgcn_sched_barrier(0)
    Unit cur, nxt; int ui = 0;
    if (!S.next(0, cur)) return;
    f32x4 acc[2][2][4][2];
#pragma unroll
    for (int a = 0; a < 2; ++a)
#pragma unroll
        for (int b = 0; b < 2; ++b)
#pragma unroll
            for (int m = 0; m < 4; ++m)
#pragma unroll
                for (int n = 0; n < 2; ++n) acc[a][b][m][n] = (f32x4){0.f, 0.f, 0.f, 0.f};
    bf16x8 At[4][2], B0[2][2], B1[2][2];
    const char* cA = (const char*)(g.A + (size_t)cur.z * g.zA) + (size_t)cur.pm * tstep; const char* cB = (const char*)(g.Bt + (size_t)cur.z * g.zB) + (size_t)cur.pn * tstep;
    S.a_ready(cur);
    if constexpr (SP2) {
        PG8_STAGE(PG8_SB(0, 0), cB, voffB); PG8_STAGE(PG8_SB(0, 1), cB + hstep, voffB); PG8_STAGE(PG8_SA(0, 0), cA, voffA); PG8_STAGE(PG8_SA(0, 1), cA + hstepA, voffA);
        if (wr == 1) PG8_BAR;
        PG8_WAIT_V(2); PG8_BAR;
        PG8_STAGE(PG8_SB(1, 0), cB + kstep, voffB); PG8_STAGE(PG8_SA(1, 0), cA + kstep, voffA); PG8_STAGE(PG8_SB(1, 1), cB + hstep + kstep, voffB);
        PG8_WAIT_V(6); PG8_BAR;
    } else {
        PG8_STAGE(PG8_SB(0, 0), cB, voffB); PG8_STAGE(PG8_SA(0, 0), cA, voffA); PG8_STAGE(PG8_SB(0, 1), cB + hstep, voffB); PG8_STAGE(PG8_SA(0, 1), cA + hstepA, voffA);
        if (wr == 1) PG8_BAR;
        PG8_WAIT_V(4); PG8_BAR;
        PG8_STAGE(PG8_SB(1, 0), cB + kstep, voffB); PG8_STAGE(PG8_SA(1, 0), cA + kstep, voffA); PG8_STAGE(PG8_SB(1, 1), cB + hstep + kstep, voffB);
        PG8_WAIT_V(6); PG8_BAR;
    }
    for (;;) {
        const bool has_next = S.next(ui + 1, nxt);
        const char* nA = has_next ? (const char*)(g.A + (size_t)nxt.z * g.zA) + (size_t)nxt.pm * tstep : cA; const char* nB = has_next ? (const char*)(g.Bt + (size_t)nxt.z * g.zB) + (size_t)nxt.pn * tstep : cB;
        for (int t = 0; t < nt; t += 2) {
            const bool last = (t == nt - 2);
            const char* a1 = cA + (size_t)(t + 1) * kstep;
            const char* a2 = last ? nA : cA + (size_t)(t + 2) * kstep; const char* b2 = last ? nB : cB + (size_t)(t + 2) * kstep;
            const char* a3 = a2 + kstep; const char* b3 = b2 + kstep;
            if (last && has_next) S.a_ready(nxt);
            if constexpr (SP2) {
            PG8_LDB(B0, 0, 0); PG8_LDB(B1, 0, 1); PG8_SCHED; PG8_LDA(At, 0, 0); PG8_STAGE(PG8_SA(1, 1), a1 + hstepA, voffA);
            PG8_WAIT_V(8); PG8_WAIT_L(0); PG8_BAR; PG8_MMA(0, 0, At, B0); PG8_MMA(0, 1, At, B1); PG8_BAR; PG8_SCHED;
            PG8_LDA(At, 0, 1); PG8_STAGE(PG8_SB(0, 0), b2, voffB); PG8_STAGE(PG8_SB(0, 1), b2 + hstep, voffB); PG8_STAGE(PG8_SA(0, 0), a2, voffA);
            PG8_WAIT_V(8); PG8_WAIT_L(0); PG8_BAR; PG8_MMA(1, 0, At, B0); PG8_MMA(1, 1, At, B1); PG8_BAR; PG8_SCHED;
            PG8_LDB(B0, 1, 0); PG8_LDB(B1, 1, 1); PG8_SCHED; PG8_LDA(At, 1, 0); PG8_STAGE(PG8_SA(0, 1), a2 + hstepA, voffA);
            PG8_WAIT_V(8); PG8_WAIT_L(0); PG8_BAR; PG8_MMA(0, 0, At, B0); PG8_MMA(0, 1, At, B1); PG8_BAR; PG8_SCHED;
            PG8_LDA(At, 1, 1); PG8_STAGE(PG8_SB(1, 0), b3, voffB); PG8_STAGE(PG8_SB(1, 1), b3 + hstep, voffB); PG8_STAGE(PG8_SA(1, 0), a3, voffA);
            PG8_WAIT_V(8); PG8_WAIT_L(0); PG8_BAR; PG8_MMA(1, 0, At, B0); PG8_MMA(1, 1, At, B1); PG8_BAR; PG8_SCHED;
            } else {
            PG8_LDB(B0, 0, 0); PG8_SCHED; PG8_LDA(At, 0, 0); PG8_STAGE(PG8_SA(1, 1), a1 + hstepA, voffA);
            PG8_WAIT_L(8); PG8_BAR; PG8_WAIT_L(0); PG8_MMA(0, 0, At, B0); PG8_BAR; PG8_SCHED;
            PG8_LDB(B1, 0, 1); PG8_STAGE(PG8_SB(0, 0), b2, voffB);
            PG8_BAR; PG8_WAIT_L(0); PG8_MMA(0, 1, At, B1); PG8_BAR;
            PG8_LDA(At, 0, 1); PG8_STAGE(PG8_SA(0, 0), a2, voffA);
            PG8_BAR; PG8_WAIT_L(0); PG8_MMA(1, 0, At, B0); PG8_BAR; PG8_SCHED;
            PG8_STAGE(PG8_SB(0, 1), b2 + hstep, voffB);
            PG8_WAIT_V(6); PG8_BAR; PG8_MMA(1, 1, At, B1); PG8_BAR;
            PG8_LDB(B0, 1, 0); PG8_SCHED; PG8_LDA(At, 1, 0); PG8_STAGE(PG8_SA(0, 1), a2 + hstepA, voffA);
            PG8_WAIT_L(8); PG8_BAR; PG8_WAIT_L(0); PG8_MMA(0, 0, At, B0); PG8_BAR; PG8_SCHED;
            PG8_LDB(B1, 1, 1); PG8_STAGE(PG8_SB(1, 0), b3, voffB);
            PG8_BAR; PG8_WAIT_L(0); PG8_MMA(0, 1, At, B1); PG8_BAR;
            PG8_LDA(At, 1, 1); PG8_STAGE(PG8_SA(1, 0), a3, voffA);
            PG8_BAR; PG8_WAIT_L(0); PG8_MMA(1, 0, At, B0); PG8_BAR; PG8_SCHED;
            PG8_STAGE(PG8_SB(1, 1), b3 + hstep, voffB);
            PG8_WAIT_V(6); PG8_BAR; PG8_MMA(1, 1, At, B1); PG8_BAR;
            }
        }
        if constexpr (ALIGN_EPI) { if (wr == 0) PG8_BAR; }
        if constexpr (!Epi::AFTER_DRAIN) { E(acc, cur, wr, wc, fr, fq); S.done(cur); }
        if (!has_next) break;
        if (!(Epi::KEEP && nxt.z != 0)) {
#pragma unroll
        for (int a = 0; a < 2; ++a)
#pragma unroll
            for (int b = 0; b < 2; ++b)
#pragma unroll
                for (int m = 0; m < 4; ++m)
#pragma unroll
                    for (int n = 0; n < 2; ++n) acc[a][b][m][n] = (f32x4){0.f, 0.f, 0.f, 0.f};
        }
        cur = nxt; cA = nA; cB = nB; ++ui;
        if constexpr (ALIGN_EPI) { if (wr == 1) PG8_BAR; }
    }
    PG8_WAIT_V(0);
    if constexpr (!ALIGN_EPI) { if (wr == 0) PG8_BAR; }
    PG8_BAR;
    if constexpr (Epi::AFTER_DRAIN) { E.fused(acc, cur, wr, wc, fr, fq, lds, wid, lane); S.done(cur); }
#undef PG8_SA
#undef PG8_SB
#undef PG8_STAGE
#undef PG8_LDA
#undef PG8_LDB
#undef PG8_MMA
#undef PG8_WAIT_V
#undef PG8_WAIT_L
#undef PG8_BAR
#undef PG8_SCHED
}
}

constexpr int NWAVES = 8;
constexpr int BATCH = 8, SEQ = 2048, DM = 2048, DEPTH = 4, M = BATCH * SEQ, NH = 8;
constexpr int NIN = 16400, NZ = 16384, DFF = 5632, NUP = 2 * DFF, NY = 3072;
constexpr int Z_RQ = 0, Z_RK = 1024, Z_RV = 2048, Z_RG = 3072, Z_MQ = 4096, Z_MK = 4608, Z_MV = 5120, Z_MO = 6144, Z_AQ = 7168, Z_AK = 8192, Z_AV = 9216, Z_GA = 10240, Z_GB = 12288, Z_GC = 14336;
constexpr int W_GATE_COL = 7168;
constexpr size_t MiB = 1u << 20;
constexpr size_t WS_CTL = 0, CTL_ZERO_BYTES = 1 * MiB;
constexpr size_t WS_RS = 1520 * MiB;
constexpr size_t WS_TAB = 2 * MiB + 512 * 1024;
constexpr size_t WS_RSTD = 7 * MiB + 512 * 1024;
constexpr size_t WS_W16G = 7 * MiB;
constexpr size_t WS_KMEAN = 5 * MiB;
constexpr size_t WS_GIF = 6 * MiB;
constexpr size_t WS_WIN = 8 * MiB;
constexpr size_t WS_WP = 264 * MiB;
constexpr size_t WS_WOUT = 312 * MiB;
constexpr size_t WS_WUP = 344 * MiB;
constexpr size_t WS_WDN = 520 * MiB;
constexpr size_t WS_XB = 608 * MiB;
constexpr size_t WS_Z = 672 * MiB;
constexpr size_t WS_Y = 1184 * MiB;
constexpr size_t WS_MG = 1280 * MiB;
constexpr size_t WS_ACT = 1344 * MiB;
constexpr size_t WS_ZG = 1536 * MiB;
constexpr size_t WS_SB = 1632 * MiB;
constexpr size_t WS_END = 1648 * MiB;
constexpr int CW_TMO = 0, CW_CODE = 1;
constexpr int CW_BAR = 4096;
constexpr int CW_QUEUE = 8192;
constexpr int RING_OFF = 0, RING_BYTES = 131072;
constexpr int LDS_BYTES = 163840;
constexpr int LDSCTL_OFF = LDS_BYTES - 512, MISC_OFF = LDSCTL_OFF + 320;
static_assert(MISC_OFF + 128 <= LDS_BYTES, "LDS map");

#define GAS __attribute__((address_space(1)))
#define LAS __attribute__((address_space(3)))
typedef unsigned short bf16;
typedef unsigned v4u __attribute__((ext_vector_type(4)));
typedef unsigned v2u __attribute__((ext_vector_type(2)));
typedef float f32x4 __attribute__((ext_vector_type(4)));
typedef float f32x2 __attribute__((ext_vector_type(2)));
typedef GAS unsigned gu32;
#define RLX_AGENT __ATOMIC_RELAXED, __HIP_MEMORY_SCOPE_AGENT
#define LDS_WAIT() asm volatile("s_waitcnt lgkmcnt(0)" ::: "memory")
#define VM_WAIT() asm volatile("s_waitcnt vmcnt(0)" ::: "memory")
typedef __bf16 bf16x2_t __attribute__((ext_vector_type(2)));
__device__ __forceinline__ unsigned pk2(float lo, float hi) { const f32x2 v = {lo, hi}; const bf16x2_t b = __builtin_convertvector(v, bf16x2_t); return __builtin_bit_cast(unsigned, b); }
__device__ __forceinline__ unsigned f2bf(float f) { return pk2(f, f); }
__device__ __forceinline__ float bflo(unsigned w) { return __uint_as_float(w << 16); }
__device__ __forceinline__ float bfhi(unsigned w) { return __uint_as_float(w & 0xffff0000u); }
__device__ __forceinline__ float bf1(bf16 v) { return __uint_as_float((unsigned)v << 16); }
__device__ __forceinline__ float sigm(float x) { return 1.0f / (1.0f + __expf(-x)); }

#define XB_TMO      128
#define XB_XCNT(j)  (256  + 64 * (j))
#define XB_XSUB(j)  (1280 + 64 * (j))
#define XB_XGEN(j)  (2304 + 64 * (j))
#define XB_TOP      3328
#define XB_TOPGEN   3392
#define XCD_BAR_WORDS 3456
#define XB_SPIN_CAP (1u << 18)

__device__ __forceinline__ unsigned xb_ld(unsigned* p)              { return __hip_atomic_load(p, __ATOMIC_RELAXED, __HIP_MEMORY_SCOPE_AGENT); }
__device__ __forceinline__ unsigned xb_add(unsigned* p, unsigned v) { return __hip_atomic_fetch_add(p, v, __ATOMIC_RELAXED, __HIP_MEMORY_SCOPE_AGENT); }
__device__ __forceinline__ unsigned xb_xcc_id() { return (unsigned)__builtin_amdgcn_s_getreg((3 << 11) | 20) & 0xFu; }
#define XB_SPIN(cond, bar) do { unsigned _sp = 0; while (cond) { __builtin_amdgcn_s_sleep(1); \
    if ((++_sp & 255u) == 0u) { if (xb_ld(&(bar)[XB_TMO])) break; if (_sp > XB_SPIN_CAP) { atomicAdd(&(bar)[XB_TMO], 1u); break; } } } } while (0)

struct XcdBarrier {
    unsigned* bar; unsigned x;
    volatile LAS unsigned* st;
};

__device__ __forceinline__ XcdBarrier xcd_barrier_post(unsigned* bar, volatile LAS unsigned* st) {
    XcdBarrier b; b.bar = bar; b.x = xb_xcc_id(); b.st = st;
    if (threadIdx.x == 0) (void)xb_add(&bar[XB_XCNT(b.x)], 1u);
    return b;
}
__device__ __forceinline__ void xcd_barrier_complete(unsigned* bar, unsigned x, unsigned& nloc, unsigned& nx) {
    const unsigned G = gridDim.x * gridDim.y * gridDim.z;
    unsigned sum, cnt, mine, sp = 0u;
    for (;;) {
        sum = 0u; cnt = 0u; mine = 0u;
#pragma unroll
        for (unsigned j = 0; j < 16; ++j) { const unsigned c = xb_ld(&bar[XB_XCNT(j)]); sum += c; cnt += (c > 0u) ? 1u : 0u; mine = (j == x) ? c : mine; }
        if (sum == G) break;
        __builtin_amdgcn_s_sleep(1);
        if ((++sp & 255u) == 0u) { if (xb_ld(&bar[XB_TMO])) break; if (sp > XB_SPIN_CAP) { atomicAdd(&bar[XB_TMO], 1u); break; } }
    }
    nloc = mine > 0u ? mine : 1u; nx = cnt > 0u ? cnt : 1u;
}

__device__ __forceinline__ void xcd_barrier(const XcdBarrier& b) {
    asm volatile("s_waitcnt vmcnt(0)" ::: "memory");
    __syncthreads();
    if (threadIdx.x == 0) {
        unsigned* bar = b.bar;
        __builtin_amdgcn_s_waitcnt(0);
        unsigned nloc = b.st[0], nx = b.st[1];
        if (nloc == 0u) { xcd_barrier_complete(bar, b.x, nloc, nx); b.st[0] = nloc; b.st[1] = nx; }
        const unsigned old = xb_add(&bar[XB_XSUB(b.x)], 1u);
        const unsigned gen = old / nloc;
        if (old + 1u == (gen + 1u) * nloc) {
            __builtin_amdgcn_fence(__ATOMIC_RELEASE, "agent");
            asm volatile("s_waitcnt vmcnt(0)" ::: "memory");
            const unsigned og = xb_add(&bar[XB_TOP], 1u);
            const unsigned tg = og / nx;
            if (og + 1u == (tg + 1u) * nx) xb_add(&bar[XB_TOPGEN], 1u);
            else XB_SPIN(xb_ld(&bar[XB_TOPGEN]) == tg, bar);
            __builtin_amdgcn_fence(__ATOMIC_ACQUIRE, "agent");
            xb_add(&bar[XB_XGEN(b.x)], 1u);
            asm volatile("s_waitcnt vmcnt(0)" ::: "memory");
        } else {
            XB_SPIN(xb_ld(&bar[XB_XGEN(b.x)]) == gen, bar);
            __builtin_amdgcn_fence(__ATOMIC_ACQUIRE, "agent");
            asm volatile("s_waitcnt vmcnt(0)" ::: "memory");
        }
    }
    __syncthreads();
}

struct Args { const float* in[18]; float* out; unsigned char* ws; int ph_lo, ph_hi, li, pad; };
enum { I_X = 0, I_WIN, I_BIG, I_BFG, I_NMIX, I_RGN, I_MLN, I_QN, I_KN, I_WPA, I_WPB, I_WPC, I_WOUT, I_NFFN, I_WUP, I_CW, I_CB, I_WDN };
struct Frame {
    LAS unsigned char* lds;
    volatile LAS unsigned* MISC;
    unsigned char* ws;
    int tid, lane, wave, G, bx;
};
#define WSP(T, off) ((T*)(F.ws + (off)))
__device__ __forceinline__ float wave_sum(float v) {
#pragma unroll
    for (int o = 1; o < 64; o <<= 1) v += __shfl_xor(v, o);
    return v;
}
__device__ __forceinline__ float wave_max(float v) {
#pragma unroll
    for (int o = 1; o < 64; o <<= 1) v = fmaxf(v, __shfl_xor(v, o));
    return v;
}
__device__ __forceinline__ void p0_transpose_item(const float* W, int ldw, int K, int nblk, bf16* WT, LAS float* scr, int item, int lane, const float* gk = nullptr) {
    const int kb = item / nblk, nb = item % nblk, k0 = 64 * kb, n0 = 32 * nb;
#pragma unroll 8
    for (int i = 0; i < 32; ++i) { const int kk = 2 * i + (lane >> 5); scr[kk * 33 + (lane & 31)] = W[(size_t)(k0 + kk) * ldw + n0 + (lane & 31)]; }
    LDS_WAIT(); asm volatile("" ::: "memory");
    const int c = lane & 7;
    f32x4 g0 = (f32x4){1.f, 1.f, 1.f, 1.f}, g1 = g0;
    if (gk) { g0 = *(const f32x4*)(gk + k0 + 8 * c); g1 = *(const f32x4*)(gk + k0 + 8 * c + 4); }
#pragma unroll
    for (int j = 0; j < 4; ++j) { const int n = (lane >> 3) + 8 * j; const LAS float* s = scr + (8 * c) * 33 + n;
        v4u o; o.x = pk2(s[0 * 33] * g0[0], s[1 * 33] * g0[1]); o.y = pk2(s[2 * 33] * g0[2], s[3 * 33] * g0[3]); o.z = pk2(s[4 * 33] * g1[0], s[5 * 33] * g1[1]); o.w = pk2(s[6 * 33] * g1[2], s[7 * 33] * g1[3]);
        *(GAS v4u*)(WT + (size_t)(n0 + n) * K + k0 + 8 * c) = o; }
    LDS_WAIT(); asm volatile("" ::: "memory");
}
__device__ __forceinline__ void p0_prologue(Frame& F, const Args& args) {
    LAS float* scr = (LAS float*)(F.lds + RING_OFF + F.wave * 16384);
    const int gw = F.bx * NWAVES + F.wave, NGW = F.G * NWAVES;
    constexpr int I_INA = 32 * 224, I_INB = 32 * 288, I_P = 16 * 64, I_OUT = 32 * 64, I_UP = 32 * 352, I_DN = 88 * 64;
    constexpr int I_LAYER = I_INA + I_INB + 3 * I_P + I_OUT + I_UP + I_DN;
    for (int it = gw; it < DEPTH * I_LAYER; it += NGW) {
        const int l = it / I_LAYER; int r = it % I_LAYER;
        const float* win = args.in[I_WIN] + (size_t)l * DM * NIN; bf16* wint = WSP(bf16, WS_WIN) + (size_t)l * NZ * DM;
        if (r < I_INA) { p0_transpose_item(win, NIN, DM, 224, wint, scr, r, F.lane, args.in[I_NMIX] + l * DM); continue; } r -= I_INA;
        if (r < I_INB) { p0_transpose_item(win + 7184, NIN, DM, 288, wint + (size_t)7168 * DM, scr, r, F.lane, args.in[I_NMIX] + l * DM); continue; } r -= I_INB;
        if (r < I_P) { p0_transpose_item(args.in[I_WPA] + (size_t)l * 1024 * DM, DM, 1024, 64, WSP(bf16, WS_WP) + ((size_t)l * 3 + 0) * DM * 1024, scr, r, F.lane); continue; } r -= I_P;
        if (r < I_P) { p0_transpose_item(args.in[I_WPB] + (size_t)l * 1024 * DM, DM, 1024, 64, WSP(bf16, WS_WP) + ((size_t)l * 3 + 1) * DM * 1024, scr, r, F.lane); continue; } r -= I_P;
        if (r < I_P) { p0_transpose_item(args.in[I_WPC] + (size_t)l * 1024 * DM, DM, 1024, 64, WSP(bf16, WS_WP) + ((size_t)l * 3 + 2) * DM * 1024, scr, r, F.lane); continue; } r -= I_P;
        if (r < I_OUT) { p0_transpose_item(args.in[I_WOUT] + (size_t)l * DM * DM, DM, DM, 64, WSP(bf16, WS_WOUT) + (size_t)l * DM * DM, scr, r, F.lane); continue; } r -= I_OUT;
        if (r < I_UP) {
            const int nb = r % 352, tile = nb >> 3, wi = nb & 7, src = (wi < 4) ? 128 * tile + 32 * wi : DFF + 128 * tile + 32 * (wi - 4);
            p0_transpose_item(args.in[I_WUP] + (size_t)l * DM * NUP + (src - 32 * nb), NUP, DM, 352, WSP(bf16, WS_WUP) + (size_t)l * NUP * DM, scr, r, F.lane, args.in[I_NFFN] + l * DM); continue; } r -= I_UP;
        p0_transpose_item(args.in[I_WDN] + (size_t)l * DFF * DM, DM, DFF, 64, WSP(bf16, WS_WDN) + (size_t)l * DM * DFF, scr, r, F.lane);
    }
    const int gt = F.bx * (NWAVES * 64) + F.tid, NGT = F.G * NWAVES * 64;
    for (int i = gt; i < DEPTH * 16 * DM; i += NGT) { const int l = i / (16 * DM), c = (i / DM) % 16, k = i % DM; WSP(bf16, WS_W16G)[i] = (bf16)f2bf(args.in[I_WIN][((size_t)l * DM + k) * NIN + W_GATE_COL + c] * args.in[I_NMIX][l * DM + k]); }
    for (int m = gw; m < M; m += NGW) { const f32x4* xr = (const f32x4*)(args.in[I_X] + (size_t)m * DM) + F.lane; v2u* o8 = (v2u*)(WSP(bf16, WS_XB) + (size_t)m * DM) + F.lane; float s = 0.f;
#pragma unroll
        for (int j = 0; j < 8; ++j) { const f32x4 v = xr[64 * j]; s += (v.x * v.x + v.y * v.y) + (v.z * v.z + v.w * v.w); v2u w; w.x = pk2(v.x, v.y); w.y = pk2(v.z, v.w); o8[64 * j] = w; }
        s = wave_sum(s); if (F.lane < 32) WSP(float, WS_RS)[(size_t)m * 32 + F.lane] = (F.lane == 0) ? s : 0.f; }
    for (int i = gt; i < 2 * SEQ * 64; i += NGT) { const int which = i / (SEQ * 64), pos = (i / 64) % SEQ, d = i % 64;
        const float ex = which == 0 ? (float)d / 63.0f : (float)(2 * d) / 128.0f;
        const float inv = 1.0f / powf(10000.0f, ex); const float ang = (float)pos * inv; float s, c; sincosf(ang, &s, &c); WSP(f32x2, WS_TAB)[i] = (f32x2){c, s}; }
}
__device__ __forceinline__ void prep_phase(Frame& F, const float* qn, const float* kn, const bf16* w16g, const float* rs, const float* big, const float* bfg) {
    const int gw = F.bx * NWAVES + F.wave, NGW = F.G * NWAVES, lane = F.lane, rsub = lane >> 2, dg = lane & 3;
    const f32x2* trope = WSP(f32x2, WS_TAB) + SEQ * 64;
    for (int u = gw; u < 2 * BATCH * 16 * NH; u += NGW) {
        const int kind = u & 1, hh = (u >> 1) & 7, hb = (u >> 4) & 15, b = u >> 8;
        const float* wn = kind ? kn : qn;
        const float* rsb = rs + (size_t)(b * SEQ + hb * 128) * 32 + 8 * dg;
        float wl[16], wh[16], s1[16], s2[16];
#pragma unroll
        for (int e = 0; e < 16; ++e) { wl[e] = wn[16 * dg + e]; wh[e] = wn[64 + 16 * dg + e]; s1[e] = 0.f; s2[e] = 0.f; }
        bf16* zb = WSP(bf16, WS_Z) + (size_t)(b * SEQ + hb * 128) * NZ + (kind ? Z_AK : Z_AQ) + hh * 128 + 16 * dg;
#pragma unroll 2
        for (int st = 0; st < 8; ++st) {
            const int r = rsub + 16 * st, pos = hb * 128 + r; bf16* zr = zb + (size_t)r * NZ;
            const v4u l0 = *(const v4u*)(zr), l1 = *(const v4u*)(zr + 8), h0 = *(const v4u*)(zr + 64), h1 = *(const v4u*)(zr + 72);
            float a[16] = {bflo(l0.x), bfhi(l0.x), bflo(l0.y), bfhi(l0.y), bflo(l0.z), bfhi(l0.z), bflo(l0.w), bfhi(l0.w), bflo(l1.x), bfhi(l1.x), bflo(l1.y), bfhi(l1.y), bflo(l1.z), bfhi(l1.z), bflo(l1.w), bfhi(l1.w)};
            float c[16] = {bflo(h0.x), bfhi(h0.x), bflo(h0.y), bfhi(h0.y), bflo(h0.z), bfhi(h0.z), bflo(h0.w), bfhi(h0.w), bflo(h1.x), bfhi(h1.x), bflo(h1.y), bfhi(h1.y), bflo(h1.z), bfhi(h1.z), bflo(h1.w), bfhi(h1.w)};
            float ss = 0.f;
#pragma unroll
            for (int e = 0; e < 16; ++e) ss += a[e] * a[e] + c[e] * c[e];
            ss += __shfl_xor(ss, 1); ss += __shfl_xor(ss, 2);
            float rq; { const f32x4 s0 = *(const f32x4*)(rsb + (size_t)r * 32), s1 = *(const f32x4*)(rsb + (size_t)r * 32 + 4); rq = ((s0[0] + s0[1]) + (s0[2] + s0[3])) + ((s1[0] + s1[1]) + (s1[2] + s1[3])); }
            rq += __shfl_xor(rq, 1); rq += __shfl_xor(rq, 2);
            const float rr = rsqrtf(rq * (1.0f / 2048.0f) + 1e-6f);
            if ((u & 15) == 0 && dg == 0) WSP(float, WS_RSTD)[b * SEQ + hb * 128 + r] = rr;
            const float rstd = rr * rsqrtf(ss * rr * rr * (1.f / 128.f) + 1e-6f);
            const f32x2* tb = trope + pos * 64 + 16 * dg;
#pragma unroll
            for (int e = 0; e < 16; ++e) { const float x1 = a[e] * rstd * wl[e], x2 = c[e] * rstd * wh[e]; const f32x2 cs = tb[e]; a[e] = x1 * cs.x - x2 * cs.y; c[e] = x1 * cs.y + x2 * cs.x; s1[e] += a[e]; s2[e] += c[e]; }
            *(v4u*)(zr) = (v4u){pk2(a[0], a[1]), pk2(a[2], a[3]), pk2(a[4], a[5]), pk2(a[6], a[7])}; *(v4u*)(zr + 8) = (v4u){pk2(a[8], a[9]), pk2(a[10], a[11]), pk2(a[12], a[13]), pk2(a[14], a[15])};
            *(v4u*)(zr + 64) = (v4u){pk2(c[0], c[1]), pk2(c[2], c[3]), pk2(c[4], c[5]), pk2(c[6], c[7])}; *(v4u*)(zr + 72) = (v4u){pk2(c[8], c[9]), pk2(c[10], c[11]), pk2(c[12], c[13]), pk2(c[14], c[15])};
        }
        if (kind) {
            float* km = WSP(float, WS_KMEAN) + (size_t)((b * NH + hh) * 16 + hb) * 128 + 16 * dg;
#pragma unroll
            for (int e = 0; e < 16; ++e) { float x = s1[e], y = s2[e];
                x += __shfl_xor(x, 4); x += __shfl_xor(x, 8); x += __shfl_xor(x, 16); x += __shfl_xor(x, 32);
                y += __shfl_xor(y, 4); y += __shfl_xor(y, 8); y += __shfl_xor(y, 16); y += __shfl_xor(y, 32);
                if (rsub == 0) { km[e] = x * (1.f / 256.f); km[64 + e] = y * (1.f / 256.f); } }
        }
    }
    for (int it = gw; it < M / 32; it += NGW) {
#pragma unroll
        for (int st = 0; st < 8; ++st) { const int row = 32 * it + 4 * st + (lane >> 4), cg = lane & 15;
            const float* rp = rs + (size_t)row * 32; float rq = 0.f;
#pragma unroll
            for (int q = 0; q < 8; ++q) { const f32x4 s0 = *(const f32x4*)(rp + 4 * q); rq += (s0[0] + s0[1]) + (s0[2] + s0[3]); }
            const float rr = rsqrtf(rq * (1.0f / 2048.0f) + 1e-6f);
            bf16* vp = WSP(bf16, WS_Z) + (size_t)row * NZ + Z_AV + 8 * cg;
#pragma unroll
            for (int q = 0; q < 8; ++q) { const v4u x = *(const v4u*)(vp + 128 * q);
                *(v4u*)(vp + 128 * q) = (v4u){pk2(bflo(x.x) * rr, bfhi(x.x) * rr), pk2(bflo(x.y) * rr, bfhi(x.y) * rr), pk2(bflo(x.z) * rr, bfhi(x.z) * rr), pk2(bflo(x.w) * rr, bfhi(x.w) * rr)}; } }
    }
    for (int it = NGW - 1 - gw; it < M / 16; it += NGW) {
        const int i16 = lane & 15, g = lane >> 4; const bf16* ar = WSP(bf16, WS_XB) + (size_t)(16 * it + i16) * DM + 8 * g; const bf16* br = w16g + (size_t)i16 * DM + 8 * g;
        typedef short bf16x8_t __attribute__((ext_vector_type(8)));
        f32x4 acc = (f32x4){0.f, 0.f, 0.f, 0.f};
#pragma unroll 1
        for (int s0 = 0; s0 < DM / 32; s0 += 16) { bf16x8_t av[16], bv[16];
#pragma unroll
            for (int s = 0; s < 16; ++s) { av[s] = *(const bf16x8_t*)(ar + 32 * (s0 + s)); bv[s] = *(const bf16x8_t*)(br + 32 * (s0 + s)); }
#pragma unroll
            for (int s = 0; s < 16; ++s) acc = __builtin_amdgcn_mfma_f32_16x16x32_bf16(av[s], bv[s], acc, 0, 0, 0); }
#pragma unroll
        for (int r = 0; r < 4; ++r) { const int row = 16 * it + 4 * g + r; float ssq = 0.f;
#pragma unroll
            for (int q = 0; q < 8; ++q) { const f32x4 a = *(const f32x4*)(rs + (size_t)row * 32 + 4 * q); ssq += (a[0] + a[1]) + (a[2] + a[3]); }
            const float sr = rsqrtf(ssq * (1.0f / 2048.0f) + 1e-6f);
            const float pre = acc[r] * sr + (i16 < 8 ? big[i16 & 7] : bfg[i16 & 7]); const float sc = 15.0f * tanhf(pre * (1.0f / 15.0f));
            float o = sc; if (i16 >= 8) o = sc > 0.f ? -log1pf(__expf(-sc)) : sc - log1pf(__expf(sc));
            WSP(float, WS_GIF)[(size_t)row * 16 + i16] = o; }
    }
}
__device__ __forceinline__ void glu_fix_phase(Frame& F, const float* cw, const float* cb) {
    const bf16* SB = WSP(bf16, WS_SB); bf16* ACT = WSP(bf16, WS_ACT);
    for (int gI = F.bx; gI < M / 128; gI += F.G) {
        const bool first = ((gI * 128) & (SEQ - 1)) == 0; const bf16* sb = SB + (size_t)gI * 4 * NUP;
        for (int it = F.tid; it < 2 * (DFF / 8); it += NWAVES * 64) {
            const int i = it / (DFF / 8), c8 = (it % (DFF / 8)) * 8;
            float r[2][8];
#pragma unroll
            for (int hf = 0; hf < 2; ++hf) { const int col = hf * DFF + c8;
                const f32x4 b0 = *(const f32x4*)(cb + col), b1 = *(const f32x4*)(cb + col + 4);
                float a[8] = {b0.x, b0.y, b0.z, b0.w, b1.x, b1.y, b1.z, b1.w};
#pragma unroll
                for (int j = 0; j < 3; ++j) { const int slot = i + j;
                    if (slot >= 2 || !first) { const v4u uw = *(const v4u*)(sb + (size_t)slot * NUP + col); const f32x4 w0 = *(const f32x4*)(cw + (size_t)j * NUP + col), w1 = *(const f32x4*)(cw + (size_t)j * NUP + col + 4);
                        a[0] += bflo(uw.x) * w0.x; a[1] += bfhi(uw.x) * w0.y; a[2] += bflo(uw.y) * w0.z; a[3] += bfhi(uw.y) * w0.w; a[4] += bflo(uw.z) * w1.x; a[5] += bfhi(uw.z) * w1.y; a[6] += bflo(uw.w) * w1.z; a[7] += bfhi(uw.w) * w1.w; } }
#pragma unroll
                for (int e = 0; e < 8; ++e) r[hf][e] = a[e]; }
            float o[8];
#pragma unroll
            for (int e = 0; e < 8; ++e) o[e] = r[0][e] * __builtin_amdgcn_rcpf(1.0f + __expf(-r[0][e])) * r[1][e];
            *(v4u*)(ACT + (size_t)(gI * 128 + i) * DFF + c8) = (v4u){pk2(o[0], o[1]), pk2(o[2], o[3]), pk2(o[4], o[5]), pk2(o[6], o[7])};
        }
    }
}
namespace mx {
typedef short bf16x8 __attribute__((ext_vector_type(8)));
typedef short s16x4 __attribute__((ext_vector_type(4)));
#define MFMA16(a, b, c) __builtin_amdgcn_mfma_f32_16x16x32_bf16((a), (b), (c), 0, 0, 0)
#define LDS_FENCE() asm volatile("s_waitcnt lgkmcnt(0)" ::: "memory")
#define SCHED_FENCE() __builtin_amdgcn_sched_barrier(0)
__device__ __forceinline__ bf16x8 frag_row(const LAS bf16* X, int ld, int r0, int c0, int lane) {
    return *(const LAS bf16x8*)(X + (r0 + (lane & 15)) * ld + c0 + 8 * (lane >> 4)); }
__device__ __forceinline__ bf16x8 frag_tr(const LAS bf16* X, int ld, int k0, int c0, int lane) {
    const int g = lane >> 4, q = (lane & 15) >> 2, p = lane & 3;
    const LAS bf16* a = X + (k0 + 8 * g + q) * ld + c0 + 4 * p;
    const s16x4 lo = __builtin_amdgcn_ds_read_tr16_b64_v4i16((LAS s16x4*)a);
    const s16x4 hi = __builtin_amdgcn_ds_read_tr16_b64_v4i16((LAS s16x4*)(a + 4 * ld));
    return __builtin_shufflevector(lo, hi, 0, 1, 2, 3, 4, 5, 6, 7);
}
__device__ __forceinline__ int trs_off(int row, int chunk) { return row * 128 + ((chunk ^ (((row & 3) << 1) | (((row >> 3) & 1) << 3))) << 3); }
__device__ __forceinline__ bf16x8 frag_trs(const LAS bf16* X, int k0, int c0, int lane) {
    const int g = lane >> 4, q = (lane & 15) >> 2, p = lane & 3;
    const LAS bf16* a = X + trs_off(k0 + 8 * g + q, (c0 >> 3) + (p >> 1)) + 4 * (p & 1);
    const s16x4 lo = __builtin_amdgcn_ds_read_tr16_b64_v4i16((LAS s16x4*)a);
    const s16x4 hi = __builtin_amdgcn_ds_read_tr16_b64_v4i16((LAS s16x4*)(a + 4 * 128));
    return __builtin_shufflevector(lo, hi, 0, 1, 2, 3, 4, 5, 6, 7);
}
template <int CTRL> __device__ __forceinline__ float dppf(float v) { return __builtin_bit_cast(float, __builtin_amdgcn_update_dpp(0, __builtin_bit_cast(int, v), CTRL, 0xf, 0xf, true)); }
__device__ __forceinline__ float r16max(float v) { v = fmaxf(v, dppf<0xB1>(v)); v = fmaxf(v, dppf<0x4E>(v)); v = fmaxf(v, dppf<0x141>(v)); v = fmaxf(v, dppf<0x140>(v)); return v; }
__device__ __forceinline__ float r16sum(float v) { v += dppf<0xB1>(v); v += dppf<0x4E>(v); v += dppf<0x141>(v); v += dppf<0x140>(v); return v; }
__device__ __forceinline__ float red16_sum(float v) { return r16sum(v); }
__device__ __forceinline__ float red16_max(float v) { return r16max(v); }
__device__ __forceinline__ void rot8(const v4u lo, const v4u hi, const f32x2* tb, float sc, v4u& olo, v4u& ohi) {
    float a[8] = {bflo(lo.x), bfhi(lo.x), bflo(lo.y), bfhi(lo.y), bflo(lo.z), bfhi(lo.z), bflo(lo.w), bfhi(lo.w)};
    float c[8] = {bflo(hi.x), bfhi(hi.x), bflo(hi.y), bfhi(hi.y), bflo(hi.z), bfhi(hi.z), bflo(hi.w), bfhi(hi.w)};
    float o1[8], o2[8];
#pragma unroll
    for (int e = 0; e < 8; ++e) { const f32x2 cs = tb[e]; o1[e] = (a[e] * cs.x - c[e] * cs.y) * sc; o2[e] = (a[e] * cs.y + c[e] * cs.x) * sc; }
    olo = (v4u){pk2(o1[0], o1[1]), pk2(o1[2], o1[3]), pk2(o1[4], o1[5]), pk2(o1[6], o1[7])};
    ohi = (v4u){pk2(o2[0], o2[1]), pk2(o2[2], o2[3]), pk2(o2[4], o2[5]), pk2(o2[6], o2[7])};
}
constexpr int LQ = 144;
__device__ __forceinline__ void ret_unit(Frame& F, const float* gn, int b, int h) {
    LAS bf16* Qs = (LAS bf16*)(F.lds); LAS bf16* Ks = Qs + 128 * LQ; LAS bf16* Vs = Ks + 128 * LQ; LAS bf16* Ts = Vs + 128 * LQ;
    const int tid = F.tid, lane = F.lane, w = tid >> 6, i16 = lane & 15, g = lane >> 4;
    const float gamma = 1.0f - exp2f(-5.0f - (float)h), lg = log2f(gamma);
    const float gC = exp2f(lg * 128.0f);
    f32x4 accT[8];
#pragma unroll
    for (int n = 0; n < 8; ++n) accT[n] = (f32x4){0.f, 0.f, 0.f, 0.f};
    for (int i = tid; i < 128 * LQ / 8; i += NWAVES * 64) ((LAS v4u*)Ts)[i] = (v4u){0u, 0u, 0u, 0u};
    const bf16* zb = WSP(bf16, WS_Z) + (size_t)(b * SEQ) * NZ + h * 128;
    const f32x2* tret = WSP(f32x2, WS_TAB);
    bf16* yb = WSP(bf16, WS_Y) + (size_t)(b * SEQ) * 1024 + h * 128;
    const int lr = tid >> 2, dg = tid & 3;
    v4u pq[4], pk[4], pv[4]; float prr;
    const float* rstd1 = WSP(float, WS_RSTD) + (size_t)(b * SEQ);
#define RET_FETCH(t0_) do { const bf16* zr_ = zb + (size_t)((t0_) + lr) * NZ; \
        pq[0] = *(const v4u*)(zr_ + Z_RQ + 16 * dg); pq[1] = *(const v4u*)(zr_ + Z_RQ + 64 + 16 * dg); pq[2] = *(const v4u*)(zr_ + Z_RQ + 16 * dg + 8); pq[3] = *(const v4u*)(zr_ + Z_RQ + 64 + 16 * dg + 8); \
        pk[0] = *(const v4u*)(zr_ + Z_RK + 16 * dg); pk[1] = *(const v4u*)(zr_ + Z_RK + 64 + 16 * dg); pk[2] = *(const v4u*)(zr_ + Z_RK + 16 * dg + 8); pk[3] = *(const v4u*)(zr_ + Z_RK + 64 + 16 * dg + 8); \
        _Pragma("unroll") for (int q_ = 0; q_ < 4; ++q_) pv[q_] = *(const v4u*)(zr_ + Z_RV + 32 * dg + 8 * q_); prr = rstd1[(t0_) + lr]; } while (0)
    RET_FETCH(0);
    const float sq = exp2f(lg * (float)lr), sk = exp2f(-lg * (float)lr) * 0.08838834764831845f;
    float gnv[8];
#pragma unroll
    for (int n = 0; n < 8; ++n) gnv[n] = gn[h * 128 + 16 * n + i16];
    for (int c = 0; c < SEQ / 128; ++c) {
        const int t0 = c * 128;
        {
            const f32x2* tb = tret + (t0 + lr) * 64 + 16 * dg;
#pragma unroll
            for (int hh = 0; hh < 2; ++hh) {
                v4u o1, o2; rot8(pq[2 * hh], pq[2 * hh + 1], tb + 8 * hh, sq * prr, o1, o2);
                *(LAS v4u*)(Qs + lr * LQ + 16 * dg + 8 * hh) = o1; *(LAS v4u*)(Qs + lr * LQ + 64 + 16 * dg + 8 * hh) = o2;
                rot8(pk[2 * hh], pk[2 * hh + 1], tb + 8 * hh, sk * prr * prr, o1, o2);
                *(LAS v4u*)(Ks + lr * LQ + 16 * dg + 8 * hh) = o1; *(LAS v4u*)(Ks + lr * LQ + 64 + 16 * dg + 8 * hh) = o2;
            }
#pragma unroll
            for (int q = 0; q < 4; ++q) *(LAS v4u*)(Vs + lr * LQ + 32 * dg + 8 * q) = pv[q];
            if (c + 1 < SEQ / 128) RET_FETCH(t0 + 128);
        }
        __syncthreads();
        bf16x8 aq[4];
#pragma unroll
        for (int s = 0; s < 4; ++s) aq[s] = frag_row(Qs, LQ, 16 * w, 32 * s, lane);
        f32x4 acco[8];
#pragma unroll
        for (int n = 0; n < 8; ++n) acco[n] = (f32x4){0.f, 0.f, 0.f, 0.f};
#pragma unroll
        for (int s = 0; s < 4; ++s) { bf16x8 bb[8];
#pragma unroll
            for (int n = 0; n < 8; ++n) bb[n] = frag_tr(Ts, LQ, 32 * s, 16 * n, lane);
            SCHED_FENCE();
#pragma unroll
            for (int n = 0; n < 8; ++n) acco[n] = MFMA16(aq[s], bb[n], acco[n]); }
        LDS_FENCE();
#pragma unroll
        for (int n = 0; n < 8; ++n) {
            if (n <= w) { f32x4 sa = (f32x4){0.f, 0.f, 0.f, 0.f}; bf16x8 bb[4];
#pragma unroll
                for (int s = 0; s < 4; ++s) bb[s] = frag_row(Ks, LQ, 16 * n, 32 * s, lane);
                SCHED_FENCE();
#pragma unroll
                for (int s = 0; s < 4; ++s) sa = MFMA16(aq[s], bb[s], sa);
#pragma unroll
                for (int r = 0; r < 4; ++r) { const int i = 16 * w + 4 * g + r, j = 16 * n + i16; Qs[i * LQ + j] = (bf16)f2bf(j <= i ? sa[r] : 0.f); } }
            else if (n == w + 1) {
#pragma unroll
                for (int r = 0; r < 4; ++r) Qs[(16 * w + 4 * g + r) * LQ + 16 * n + i16] = (bf16)0; }
        }
        LDS_FENCE();
#pragma unroll
        for (int n = 0; n < 8; ++n) accT[n] = accT[n] * gC;
#pragma unroll
        for (int s = 0; s < 4; ++s) { const bf16x8 ak = frag_tr(Ks, LQ, 32 * s, 16 * w, lane); const bool doi = (s <= (w >> 1)); bf16x8 as = ak; bf16x8 bb[8];
            if (doi) as = frag_row(Qs, LQ, 16 * w, 32 * s, lane);
#pragma unroll
            for (int n = 0; n < 8; ++n) bb[n] = frag_tr(Vs, LQ, 32 * s, 16 * n, lane);
            SCHED_FENCE();
            if (doi) {
#pragma unroll
                for (int n = 0; n < 8; ++n) acco[n] = MFMA16(as, bb[n], acco[n]); }
#pragma unroll
            for (int n = 0; n < 8; ++n) accT[n] = MFMA16(ak, bb[n], accT[n]); }
        bf16 gvr[4][8]; float rrv[4];
#pragma unroll
        for (int r = 0; r < 4; ++r) { const int pos = t0 + 16 * w + 4 * g + r; const bf16* gr = zb + (size_t)pos * NZ + Z_RG + i16; rrv[r] = rstd1[pos];
#pragma unroll
            for (int n = 0; n < 8; ++n) gvr[r][n] = gr[16 * n]; }
        LDS_FENCE();
        __syncthreads();
#pragma unroll
        for (int n = 0; n < 8; ++n)
#pragma unroll
            for (int r = 0; r < 4; ++r) Ts[(16 * w + 4 * g + r) * LQ + 16 * n + i16] = (bf16)f2bf(gC * accT[n][r]);
#pragma unroll
        for (int r = 0; r < 4; ++r) {
            float s = 0.f;
#pragma unroll
            for (int n = 0; n < 8; ++n) s += acco[n][r];
            const float mean = red16_sum(s) * (1.f / 128.f); float q = 0.f;
#pragma unroll
            for (int n = 0; n < 8; ++n) { const float d = acco[n][r] - mean; q += d * d; }
            const float rstd = rsqrtf(red16_sum(q) * (1.f / 128.f) + 1e-5f);
            const int pos = t0 + 16 * w + 4 * g + r; bf16* yr = yb + (size_t)pos * 1024; const float rri = rrv[r];
#pragma unroll
            for (int n = 0; n < 8; ++n) { const int e = 16 * n + i16; const float gv = bf1(gvr[r][n]) * rri; yr[e] = (bf16)f2bf((acco[n][r] - mean) * rstd * gnv[n] * gv * sigm(gv)); }
        }
    }
    __syncthreads();
#undef RET_FETCH
}
constexpr int LK = 72, LV = 168;
__device__ __forceinline__ float scan64_sum(float x, int lane) {
#pragma unroll
    for (int o = 1; o < 64; o <<= 1) { const float y = __shfl_up(x, o); if (lane >= o) x += y; }
    return x; }
__device__ __forceinline__ float scan64_max(float x, int lane) {
#pragma unroll
    for (int o = 1; o < 64; o <<= 1) { const float y = __shfl_up(x, o); if (lane >= o) x = fmaxf(x, y); }
    return x; }
__device__ __forceinline__ void mlstm_unit(Frame& F, const float* nw, int b, int h) {
    LAS bf16* Qm = (LAS bf16*)(F.lds); LAS bf16* Km = Qm + 128 * LK; LAS bf16* Kw = Km + 128 * LK; LAS bf16* Vm = Kw + 128 * LK; LAS bf16* Pm = Vm + 128 * LV; LAS bf16* Cm = Pm + 128 * LQ;
    const int tid = F.tid, lane = F.lane, w = F.wave, i16 = lane & 15, g = lane >> 4;
    const int dt = w & 3, eh = w >> 2;
    f32x4 accC[5];
#pragma unroll
    for (int k = 0; k < 5; ++k) accC[k] = (f32x4){0.f, 0.f, 0.f, 0.f};
    for (int i = tid; i < 64 * LV / 8; i += NWAVES * 64) ((LAS v4u*)Cm)[i] = (v4u){0u, 0u, 0u, 0u};
    float m_prev = 0.f;
    const bf16* zb = WSP(bf16, WS_Z) + (size_t)(b * SEQ) * NZ;
    const float* gif = WSP(float, WS_GIF) + (size_t)(b * SEQ) * 16;
    bf16* yb = WSP(bf16, WS_Y) + (size_t)M * 1024 + (size_t)(b * SEQ) * 1024 + h * 128;
    const int lr = tid >> 2, dg = tid & 3;
    v4u pq[2], pk[2]; float fl0, fl1, il0, il1, prr;
    const float* rstd1 = WSP(float, WS_RSTD) + (size_t)(b * SEQ);
#define ML_FETCH(t0_) do { const bf16* zr_ = zb + (size_t)((t0_) + lr) * NZ; \
        pq[0] = *(const v4u*)(zr_ + Z_MQ + h * 64 + 16 * dg); pq[1] = *(const v4u*)(zr_ + Z_MQ + h * 64 + 16 * dg + 8); pk[0] = *(const v4u*)(zr_ + Z_MK + h * 64 + 16 * dg); pk[1] = *(const v4u*)(zr_ + Z_MK + h * 64 + 16 * dg + 8); \
        fl0 = gif[(size_t)((t0_) + lane) * 16 + 8 + h]; fl1 = gif[(size_t)((t0_) + 64 + lane) * 16 + 8 + h]; il0 = gif[(size_t)((t0_) + lane) * 16 + h]; il1 = gif[(size_t)((t0_) + 64 + lane) * 16 + h]; prr = rstd1[(t0_) + lr]; } while (0)
    ML_FETCH(0);
    float nwv[8];
#pragma unroll
    for (int n = 0; n < 8; ++n) nwv[n] = nw[h * 128 + 16 * n + i16];
    for (int c = 0; c < SEQ / 128; ++c) {
        const int t0 = c * 128;
        const float a0 = scan64_sum(fl0, lane); const float a1 = scan64_sum(fl1, lane) + __shfl(a0, 63);
        const float b0 = il0 - a0, b1 = il1 - a1;
        const float pm0 = scan64_max(b0, lane); const float pm1 = fmaxf(scan64_max(b1, lane), __shfl(pm0, 63));
        const float a_last = __shfl(a1, 63), bmax = __shfl(pm1, 63);
        const float g_n = a_last + bmax, m_new = fmaxf(a_last + m_prev, g_n), s_old = __expf(a_last + m_prev - m_new), s_new = __expf(g_n - m_new);
        {
            const int r = lr;
            const float br = (r < 64) ? __shfl(b0, r & 63) : __shfl(b1, r & 63);
            const float rk = prr * 0.125f, wk = __expf(br - bmax) * rk * s_new;
#pragma unroll
            for (int hh = 0; hh < 2; ++hh) {
                *(LAS v4u*)(Qm + r * LK + 16 * dg + 8 * hh) = pq[hh];
                const v4u kk = pk[hh];
                float kf[8] = {bflo(kk.x), bfhi(kk.x), bflo(kk.y), bfhi(kk.y), bflo(kk.z), bfhi(kk.z), bflo(kk.w), bfhi(kk.w)};
                *(LAS v4u*)(Km + r * LK + 16 * dg + 8 * hh) = (v4u){pk2(kf[0] * rk, kf[1] * rk), pk2(kf[2] * rk, kf[3] * rk), pk2(kf[4] * rk, kf[5] * rk), pk2(kf[6] * rk, kf[7] * rk)};
                *(LAS v4u*)(Kw + r * LK + 16 * dg + 8 * hh) = (v4u){pk2(kf[0] * wk, kf[1] * wk), pk2(kf[2] * wk, kf[3] * wk), pk2(kf[4] * wk, kf[5] * wk), pk2(kf[6] * wk, kf[7] * wk)};
            }
#pragma unroll
            for (int q = 0; q < 4; ++q) { const v4u x = *(const v4u*)(zb + (size_t)(t0 + r) * NZ + Z_MV + h * 128 + 32 * dg + 8 * q); const float rv = prr;
                *(LAS v4u*)(Vm + r * LV + 32 * dg + 8 * q) = (v4u){pk2(bflo(x.x) * rv, bfhi(x.x) * rv), pk2(bflo(x.y) * rv, bfhi(x.y) * rv), pk2(bflo(x.z) * rv, bfhi(x.z) * rv), pk2(bflo(x.w) * rv, bfhi(x.w) * rv)}; }
            *(LAS v4u*)(Vm + r * LV + 128 + 8 * dg) = (v4u){dg == 0 ? 0x00003f80u : 0u, 0u, 0u, 0u};
            if (c + 1 < SEQ / 128) ML_FETCH(t0 + 128);
        }
        __syncthreads();
        float Mi[4], ai[4], rri[4];
#pragma unroll
        for (int r = 0; r < 4; ++r) { const int i = 16 * w + 4 * g + r; rri[r] = rstd1[t0 + i]; const float pmi = (w < 4) ? __shfl(pm0, i & 63) : __shfl(pm1, i & 63); ai[r] = (w < 4) ? __shfl(a0, i & 63) : __shfl(a1, i & 63); Mi[r] = fmaxf(pmi, m_prev); }
        bf16x8 aq[2];
#pragma unroll
        for (int s = 0; s < 2; ++s) aq[s] = frag_row(Qm, LK, 16 * w, 32 * s, lane);
        f32x4 acco[9];
#pragma unroll
        for (int n = 0; n < 9; ++n) acco[n] = (f32x4){0.f, 0.f, 0.f, 0.f};
#pragma unroll
        for (int s = 0; s < 2; ++s) {
#pragma unroll
          for (int hf = 0; hf < 2; ++hf) { bf16x8 bb[5];
#pragma unroll
            for (int n = 0; n < 5 - hf; ++n) bb[n] = frag_tr(Cm, LV, 32 * s, 16 * (5 * hf + n), lane);
            SCHED_FENCE();
#pragma unroll
            for (int n = 0; n < 5 - hf; ++n) acco[5 * hf + n] = MFMA16(aq[s], bb[n], acco[5 * hf + n]); } }
        { float si[4];
#pragma unroll
          for (int r = 0; r < 4; ++r) si[r] = __expf(m_prev - Mi[r]) * rri[r];
#pragma unroll
          for (int n = 0; n < 9; ++n)
#pragma unroll
            for (int r = 0; r < 4; ++r) acco[n][r] *= si[r]; }
        LDS_FENCE();
#pragma unroll
        for (int n = 0; n < 8; ++n) {
            if (n <= w) { f32x4 sa = (f32x4){0.f, 0.f, 0.f, 0.f}; bf16x8 bb[2];
#pragma unroll
                for (int s = 0; s < 2; ++s) bb[s] = frag_row(Km, LK, 16 * n, 32 * s, lane);
                SCHED_FENCE();
#pragma unroll
                for (int s = 0; s < 2; ++s) sa = MFMA16(aq[s], bb[s], sa);
                const int j = 16 * n + i16; const float bj = (n < 4) ? __shfl(b0, j & 63) : __shfl(b1, j & 63);
#pragma unroll
                for (int r = 0; r < 4; ++r) { const int i = 16 * w + 4 * g + r; Pm[i * LQ + j] = (bf16)f2bf(j <= i ? sa[r] * rri[r] * __expf(bj - Mi[r]) : 0.f); } }
            else if (n == w + 1) {
#pragma unroll
                for (int r = 0; r < 4; ++r) Pm[(16 * w + 4 * g + r) * LQ + 16 * n + i16] = (bf16)0; }
        }
        LDS_FENCE();
#pragma unroll
        for (int k = 0; k < 5; ++k) accC[k] = accC[k] * s_old;
#pragma unroll
        for (int s = 0; s < 4; ++s) { const bf16x8 ak = frag_tr(Kw, LK, 32 * s, 16 * dt, lane); const bool doi = (s <= (w >> 1)); bf16x8 ap = ak;
            if (doi) ap = frag_row(Pm, LQ, 16 * w, 32 * s, lane);
#pragma unroll
          for (int hf = 0; hf < 2; ++hf) { const bool dos = (hf == eh);
            if (doi || dos) { bf16x8 bb[5];
#pragma unroll
              for (int n = 0; n < 5; ++n) bb[n] = frag_tr(Vm, LV, 32 * s, 16 * (5 * hf + n), lane);
              SCHED_FENCE();
              if (doi) {
#pragma unroll
                for (int n = 0; n < 5 - hf; ++n) acco[5 * hf + n] = MFMA16(ap, bb[n], acco[5 * hf + n]); }
              if (dos) {
#pragma unroll
                for (int k = 0; k < 5; ++k) accC[k] = MFMA16(ak, bb[k], accC[k]); } } } }
        bf16 gvr[4][8];
#pragma unroll
        for (int r = 0; r < 4; ++r) { const bf16* gr = zb + (size_t)(t0 + 16 * w + 4 * g + r) * NZ + Z_MO + h * 128 + i16;
#pragma unroll
            for (int n = 0; n < 8; ++n) gvr[r][n] = gr[16 * n]; }
        LDS_FENCE();
        __syncthreads();
#pragma unroll
        for (int k = 0; k < 5; ++k)
#pragma unroll
            for (int r = 0; r < 4; ++r) Cm[(16 * dt + 4 * g + r) * LV + 16 * (5 * eh + k) + i16] = (bf16)f2bf(accC[k][r]);
#pragma unroll
        for (int r = 0; r < 4; ++r) {
            const float den = __shfl(acco[8][r], lane & 48);
            const float dd = 1.0f / fmaxf(fabsf(den), __expf(-(ai[r] + Mi[r])));
            float q = 0.f;
#pragma unroll
            for (int n = 0; n < 8; ++n) { acco[n][r] *= dd; q += acco[n][r] * acco[n][r]; }
            const float rstd = rsqrtf(red16_sum(q) * (1.f / 128.f) + 1e-6f);
            const int pos = t0 + 16 * w + 4 * g + r; bf16* yr = yb + (size_t)pos * 1024;
#pragma unroll
            for (int n = 0; n < 8; ++n) { const int e = 16 * n + i16; yr[e] = (bf16)f2bf(acco[n][r] * rstd * nwv[n] * sigm(bf1(gvr[r][n]) * rri[r])); }
        }
        m_prev = m_new;
    }
    __syncthreads();
#undef ML_FETCH
}
__device__ __forceinline__ int vt_off(int row, int chunk) { return row * 128 + ((chunk ^ ((row & 7) << 1)) << 3); }
__device__ __forceinline__ bf16x8 frag_trp(const LAS bf16* X, int k0, int c0, int lane) {
    const int g = lane >> 4, q = (lane & 15) >> 2, p = lane & 3;
    const LAS bf16* a = X + vt_off(k0 + 4 * g + q, (c0 >> 3) + (p >> 1)) + 4 * (p & 1);
    const s16x4 lo = __builtin_amdgcn_ds_read_tr16_b64_v4i16((LAS s16x4*)a);
    const s16x4 hi = __builtin_amdgcn_ds_read_tr16_b64_v4i16((LAS s16x4*)(a + 16 * 128));
    return __builtin_shufflevector(lo, hi, 0, 1, 2, 3, 4, 5, 6, 7);
}
__device__ __forceinline__ void moba_unit(Frame& F, int b, int h, int qi) {
    constexpr int KT_E = 128 * LQ, VT_E = 128 * 128;
    LAS bf16* Kt0 = (LAS bf16*)(F.lds); LAS bf16* Vt0 = Kt0 + 2 * KT_E;
    const int tid = F.tid, lane = F.lane, w = tid >> 6, i16 = lane & 15, g = lane >> 4;
    const int blk = qi >> 1, qt = qi & 1, q0 = qi * 128;
    const bf16* zb = WSP(bf16, WS_Z) + (size_t)(b * SEQ) * NZ + h * 128;
    bf16x8 aq[4];
    { const bf16* qr = zb + (size_t)(q0 + 16 * w + i16) * NZ + Z_AQ + 8 * g;
#pragma unroll
      for (int s = 0; s < 4; ++s) aq[s] = *(const bf16x8*)(qr + 32 * s); }
    const int lr = tid >> 2, dg = tid & 3;
    v4u pk[4], pv[4];
#define MB_FETCH(k0_) do { const bf16* zr_ = zb + (size_t)((k0_) + lr) * NZ + 32 * dg; \
        _Pragma("unroll") for (int q_ = 0; q_ < 4; ++q_) { pk[q_] = *(const v4u*)(zr_ + Z_AK + 8 * q_); pv[q_] = *(const v4u*)(zr_ + Z_AV + 8 * q_); } } while (0)
#define MB_STAGE(buf_) do { LAS bf16* kd_ = Kt0 + (buf_) * KT_E + lr * LQ + 32 * dg; LAS bf16* vd_ = Vt0 + (buf_) * VT_E; \
        _Pragma("unroll") for (int q_ = 0; q_ < 4; ++q_) { *(LAS v4u*)(kd_ + 8 * q_) = pk[q_]; *(LAS v4u*)(vd_ + vt_off(lr, 4 * dg + q_)) = pv[q_]; } } while (0)
    MB_FETCH(0);
    unsigned sel = 0u;
    {
        f32x4 gacc = (f32x4){0.f, 0.f, 0.f, 0.f};
        const float* km = WSP(float, WS_KMEAN) + (size_t)((b * NH + h) * 16) * 128 + (size_t)(i16 & 7) * 256 + 8 * g;
        const bool live = i16 < blk;
#pragma unroll
        for (int s = 0; s < 4; ++s) { f32x4 k0 = (f32x4){0.f, 0.f, 0.f, 0.f}, k1 = k0;
            if (live) { k0 = *(const f32x4*)(km + 32 * s) + *(const f32x4*)(km + 128 + 32 * s); k1 = *(const f32x4*)(km + 32 * s + 4) + *(const f32x4*)(km + 128 + 32 * s + 4); }
            const v4u hi = (v4u){pk2(k0.x, k0.y), pk2(k0.z, k0.w), pk2(k1.x, k1.y), pk2(k1.z, k1.w)};
            const v4u lo = (v4u){pk2(k0.x - bflo(hi.x), k0.y - bfhi(hi.x)), pk2(k0.z - bflo(hi.y), k0.w - bfhi(hi.y)), pk2(k1.x - bflo(hi.z), k1.y - bfhi(hi.z)), pk2(k1.z - bflo(hi.w), k1.w - bfhi(hi.w))};
            gacc = MFMA16(__builtin_bit_cast(bf16x8, hi), aq[s], gacc); gacc = MFMA16(__builtin_bit_cast(bf16x8, lo), aq[s], gacc); }
        float gate[8];
#pragma unroll
        for (int n = 0; n < 8; ++n) { const float gv = __shfl(gacc[n & 3], i16 + 16 * (n >> 2)); gate[n] = (n < blk) ? gv : -INFINITY; }
#pragma unroll
        for (int s = 0; s < 3; ++s) { float bv = -INFINITY; int best = -1;
#pragma unroll
            for (int n = 0; n < 8; ++n) { const bool c = !((sel >> n) & 1u) && gate[n] > bv; bv = c ? gate[n] : bv; best = c ? n : best; }
            if (best >= 0) sel |= 1u << best; }
    }
#pragma unroll
    for (int s = 0; s < 4; ++s) { const v4u u = __builtin_bit_cast(v4u, aq[s]); const float c2 = 0.08838834764831845f * 1.4426950408889634f;
        const v4u o = (v4u){pk2(bflo(u.x) * c2, bfhi(u.x) * c2), pk2(bflo(u.y) * c2, bfhi(u.y) * c2), pk2(bflo(u.z) * c2, bfhi(u.z) * c2), pk2(bflo(u.w) * c2, bfhi(u.w) * c2)}; aq[s] = __builtin_bit_cast(bf16x8, o); }
    f32x4 acco[8];
#pragma unroll
    for (int n = 0; n < 8; ++n) acco[n] = (f32x4){0.f, 0.f, 0.f, 0.f};
    float mq = -1e30f, lq = 0.f;
    const int ntiles = 2 * blk + qt + 1;
    const int qrel = 16 * w + i16 - 4 * g;
    __syncthreads();
    MB_STAGE(0);
    if (ntiles > 1) MB_FETCH(128);
    __syncthreads();
    for (int kt = 0; kt < ntiles; ++kt) {
        const int kb = kt >> 1; const bool own = (kb == blk), diag = (kt == 2 * blk + qt);
        const LAS bf16* Kt = Kt0 + (kt & 1) * KT_E; const LAS bf16* Vt = Vt0 + (kt & 1) * VT_E;
        f32x4 sc[8];
#pragma unroll
        for (int n = 0; n < 8; ++n) sc[n] = (f32x4){0.f, 0.f, 0.f, 0.f};
#pragma unroll
        for (int s = 0; s < 4; ++s) { bf16x8 bb[8];
#pragma unroll
            for (int n = 0; n < 8; ++n) bb[n] = frag_row(Kt, LQ, 16 * n, 32 * s, lane);
            SCHED_FENCE();
#pragma unroll
            for (int n = 0; n < 8; ++n) sc[n] = MFMA16(bb[n], aq[s], sc[n]); }
        if (diag) {
#pragma unroll
            for (int n = 0; n < 8; ++n)
#pragma unroll
                for (int r = 0; r < 4; ++r) sc[n][r] = (16 * n + r <= qrel) ? sc[n][r] : -1e30f; }
        const bool rowok = own || ((sel >> kb) & 1u);
        float mx = -1e30f;
#pragma unroll
        for (int n = 0; n < 8; ++n) mx = fmaxf(mx, fmaxf(fmaxf(sc[n][0], sc[n][1]), fmaxf(sc[n][2], sc[n][3])));
        mx = fmaxf(mx, __shfl_xor(mx, 16)); mx = fmaxf(mx, __shfl_xor(mx, 32));
        const float mnew = rowok ? fmaxf(mq, mx) : mq;
        const float alpha = __builtin_amdgcn_exp2f(mq - mnew); mq = mnew;
        const float msub = rowok ? mnew : 1e30f;
        float ps = 0.f;
#pragma unroll
        for (int n = 0; n < 8; ++n)
#pragma unroll
            for (int r = 0; r < 4; ++r) { sc[n][r] = __builtin_amdgcn_exp2f(sc[n][r] - msub); ps += sc[n][r]; }
        lq = lq * alpha + ps;
#pragma unroll
        for (int n = 0; n < 8; ++n) acco[n] = acco[n] * alpha;
#pragma unroll
        for (int t = 0; t < 4; ++t) {
            const v4u pw = (v4u){pk2(sc[2 * t][0], sc[2 * t][1]), pk2(sc[2 * t][2], sc[2 * t][3]), pk2(sc[2 * t + 1][0], sc[2 * t + 1][1]), pk2(sc[2 * t + 1][2], sc[2 * t + 1][3])};
            const bf16x8 pf = __builtin_bit_cast(bf16x8, pw); bf16x8 bb[8];
#pragma unroll
            for (int n = 0; n < 8; ++n) bb[n] = frag_trp(Vt, 32 * t, 16 * n, lane);
            SCHED_FENCE();
#pragma unroll
            for (int n = 0; n < 8; ++n) acco[n] = MFMA16(bb[n], pf, acco[n]); }
        if (kt + 1 < ntiles) { MB_STAGE((kt + 1) & 1); if (kt + 2 < ntiles) MB_FETCH((kt + 2) * 128); }
        __syncthreads();
    }
    lq += __shfl_xor(lq, 16); lq += __shfl_xor(lq, 32);
    const float inv = 1.0f / lq;
    bf16* yr = WSP(bf16, WS_Y) + (size_t)2 * M * 1024 + (size_t)(b * SEQ + q0 + 16 * w + i16) * 1024 + h * 128 + 4 * g;
#pragma unroll
    for (int n = 0; n < 8; ++n) *(v2u*)(yr + 16 * n) = (v2u){pk2(acco[n][0] * inv, acco[n][1] * inv), pk2(acco[n][2] * inv, acco[n][3] * inv)};
#undef MB_FETCH
#undef MB_STAGE
}
__device__ __forceinline__ void mix_phase(Frame& F, const float* rgn, const float* mln, unsigned* head) {
    volatile LAS unsigned* slot = F.MISC;
    for (;;) {
        if (F.tid == 0) slot[0] = __hip_atomic_fetch_add(head, 1u, __ATOMIC_RELAXED, __HIP_MEMORY_SCOPE_AGENT);
        __syncthreads();
        const unsigned it = slot[0];
        __syncthreads();
        if (it >= 128u + 1024u) break;
        { int t_ = threadIdx.x; asm volatile("" : "+v"(t_)); F.tid = t_; F.lane = t_ & 63; }
        if (it < 64u) ret_unit(F, rgn, (int)(it >> 3), (int)(it & 7u));
        else if (it < 128u) mlstm_unit(F, mln, (int)((it - 64u) >> 3), (int)(it & 7u));
        else { const unsigned rank = it - 128u; moba_unit(F, (int)((rank & 63u) >> 3), (int)(rank & 7u), 15 - (int)(rank >> 6)); }
    }
}
}
constexpr int N_PHASES = 1 + 8 * DEPTH;
__global__ void __launch_bounds__(NWAVES * 64, 2) fwd(Args args) {
    extern __shared__ __attribute__((aligned(16))) unsigned char lds[];
    Frame F;
    F.lds = (LAS unsigned char*)lds;
    F.MISC = (volatile LAS unsigned*)(F.lds + MISC_OFF);
    F.tid = threadIdx.x; F.lane = F.tid & 63; F.wave = __builtin_amdgcn_readfirstlane(F.tid >> 6); F.G = gridDim.x; F.bx = blockIdx.x;
    F.ws = args.ws;
    for (int u = F.tid; u < (LDS_BYTES - LDSCTL_OFF) / 4; u += NWAVES * 64) ((LAS unsigned*)(F.lds + LDSCTL_OFF))[u] = 0u;
    __syncthreads();
    XcdBarrier bar = xcd_barrier_post((unsigned*)(F.ws + WS_CTL) + CW_BAR + args.li * XCD_BAR_WORDS, F.MISC + 8);
    const int lo = args.ph_lo, hi = args.ph_hi;
#define RUN(p) (lo <= (p) && (p) < hi)
#define SEAM(p) do { if ((p) + 1 < hi) xcd_barrier(bar); } while (0)
    if (RUN(0)) { p0_prologue(F, args); SEAM(0); }
    for (int l = 0; l < DEPTH; ++l) {
        const int p0 = 1 + 8 * l;
        { int t_ = threadIdx.x; asm volatile("" : "+v"(t_)); F.tid = t_; F.lane = t_ & 63; F.wave = __builtin_amdgcn_readfirstlane(t_ >> 6); int b_ = blockIdx.x; asm volatile("" : "+s"(b_)); F.bx = b_; }
        float* rs = WSP(float, WS_RS) + (size_t)(2 * l) * M * 32;
        if (RUN(p0 + 0)) {
            pg8::Gemm g{WSP(bf16, WS_XB), WSP(bf16, WS_WIN) + (size_t)l * NZ * DM, M, NZ, DM}; pg8::StaticOrder S; S.init(M, NZ, F.G, F.bx);
            pg8::EpiBf16 E{WSP(bf16, WS_Z), NZ, F.ws + WS_ZG, Z_GA / 256, 3 * DM};
            pg8::gemm_phase<pg8::EpiBf16, pg8::StaticOrder, false, true>(F.lds + RING_OFF, g, S, E);
            SEAM(p0 + 0); }
        if (RUN(p0 + 1)) { prep_phase(F, args.in[I_QN] + l * 128, args.in[I_KN] + l * 128, WSP(bf16, WS_W16G) + (size_t)l * 16 * DM, rs, args.in[I_BIG] + l * 8, args.in[I_BFG] + l * 8); SEAM(p0 + 1); }
        if (RUN(p0 + 2)) { mx::mix_phase(F, args.in[I_RGN] + l * 1024, args.in[I_MLN] + l * 1024, (unsigned*)(F.ws + WS_CTL) + CW_QUEUE + 64 * l); SEAM(p0 + 2); }
        if (RUN(p0 + 3)) {
            pg8::StaticOrder3 S; S.init(M, DM, F.G, F.bx);
            pg8::Gemm g{WSP(bf16, WS_Y), WSP(bf16, WS_WP) + (size_t)l * 3 * DM * 1024, M, DM, 1024, (size_t)M * 1024, (size_t)DM * 1024}; pg8::EpiGateAcc E{WSP(bf16, WS_MG), DM, F.ws + WS_ZG, 3 * DM, WSP(float, WS_RSTD)};
            pg8::gemm_phase<pg8::EpiGateAcc, pg8::StaticOrder3, true, true>(F.lds + RING_OFF, g, S, E);
            SEAM(p0 + 3); }
        if (RUN(p0 + 4)) {
            pg8::Gemm g{WSP(bf16, WS_MG), WSP(bf16, WS_WOUT) + (size_t)l * DM * DM, M, DM, DM}; pg8::StaticOrder S; S.init(M, DM, F.G, F.bx);
            pg8::EpiRes<false> E{WSP(bf16, WS_XB), rs + (size_t)32 * M, nullptr, DM};
            pg8::gemm_phase<pg8::EpiRes<false>, pg8::StaticOrder, true, true>(F.lds + RING_OFF, g, S, E);
            SEAM(p0 + 4); }
        if (RUN(p0 + 5)) {
            pg8::Gemm g{WSP(bf16, WS_XB), WSP(bf16, WS_WUP) + (size_t)l * NUP * DM, M, NUP, DM}; pg8::StaticOrder S; S.init(M, NUP, F.G, F.bx);
            pg8::EpiGLU E{WSP(bf16, WS_ACT), args.in[I_CW] + (size_t)l * 3 * NUP, args.in[I_CB] + (size_t)l * NUP, rs + (size_t)32 * M, WSP(bf16, WS_SB)};
            pg8::gemm_phase<pg8::EpiGLU, pg8::StaticOrder, false, true>(F.lds + RING_OFF, g, S, E);
            SEAM(p0 + 5); }
        if (RUN(p0 + 6)) { glu_fix_phase(F, args.in[I_CW] + (size_t)l * 3 * NUP, args.in[I_CB] + (size_t)l * NUP); SEAM(p0 + 6); }
        if (RUN(p0 + 7)) {
            pg8::Gemm g{WSP(bf16, WS_ACT), WSP(bf16, WS_WDN) + (size_t)l * DM * DFF, M, DM, DFF}; pg8::StaticOrder S; S.init(M, DM, F.G, F.bx);
            if (l + 1 < DEPTH) { pg8::EpiRes<false> E{WSP(bf16, WS_XB), rs + (size_t)64 * M, nullptr, DM};
                pg8::gemm_phase<pg8::EpiRes<false>, pg8::StaticOrder, true, true>(F.lds + RING_OFF, g, S, E); }
            else { pg8::EpiRes<true> E{WSP(bf16, WS_XB), nullptr, args.out, DM};
                pg8::gemm_phase<pg8::EpiRes<true>, pg8::StaticOrder, true, true>(F.lds + RING_OFF, g, S, E); }
            SEAM(p0 + 7); }
    }
#undef RUN
#undef SEAM
}

#ifndef MK_N_LAUNCHES
#define MK_N_LAUNCHES 1
#endif
extern "C" void kernel_launch(void* const* d_in, const int* in_sizes, int n_in, void* d_out, int out_size, void* d_ws, size_t ws_size, hipStream_t stream) {
    static int grid = 0;
    if (grid == 0) {
        if (n_in != 18 || in_sizes[0] != M * DM || out_size != M * DM || ws_size < WS_END) { fprintf(stderr, "kernel_launch: unexpected shapes (n_in %d, in0 %d, out %d, ws %zu)\n", n_in, n_in > 0 ? in_sizes[0] : -1, out_size, ws_size); grid = -1; return; }
        int dev = 0, cus = 0, per_cu = 0;
        if (hipGetDevice(&dev) != hipSuccess || hipDeviceGetAttribute(&cus, hipDeviceAttributeMultiprocessorCount, dev) != hipSuccess) { grid = -1; return; }
        if (hipFuncSetAttribute((const void*)fwd, hipFuncAttributeMaxDynamicSharedMemorySize, LDS_BYTES) != hipSuccess) { fprintf(stderr, "kernel_launch: hipFuncSetAttribute failed\n"); grid = -1; return; }
        if (hipOccupancyMaxActiveBlocksPerMultiprocessor(&per_cu, (const void*)fwd, NWAVES * 64, LDS_BYTES) != hipSuccess || per_cu < 1) fprintf(stderr, "kernel_launch: occupancy query reports %d\n", per_cu);
        (void)hipGetLastError();
        grid = cus;
    }
    if (grid < 0) return;
    if (hipMemsetAsync((char*)d_ws + WS_CTL, 0, CTL_ZERO_BYTES, stream) != hipSuccess) return;
    Args a{};
    for (int i = 0; i < 18; ++i) a.in[i] = (const float*)d_in[i];
    a.out = (float*)d_out; a.ws = (unsigned char*)d_ws; a.pad = 0;
    constexpr int NL = MK_N_LAUNCHES;
    for (int li = 0; li < NL; ++li) {
        a.ph_lo = (NL == 1) ? 0 : li; a.ph_hi = (NL == 1) ? N_PHASES : li + 1; a.li = (NL == 1) ? 0 : 0;
        hipLaunchKernelGGL(fwd, dim3(grid), dim3(NWAVES * 64), LDS_BYTES, stream, a);
    }
}
```

```cpp
#include <hip/hip_runtime.h>
#include <cstdio>
#include <cstdint>
namespace pg8 {
#define PG8_LAS __attribute__((address_space(3)))
typedef unsigned short bf16_t;
typedef short bf16x8 __attribute__((ext_vector_type(8)));
typedef float f32x4 __attribute__((ext_vector_type(4)));
typedef unsigned u32x4 __attribute__((ext_vector_type(4)));
constexpr int BM = 256, BK = 64, HALF = 128, HTB = HALF * BK * 2  , STAGE_BYTES = 8 * HTB, NXCD = 8, WGM = 8;

__host__ __device__ __forceinline__ int lds_byte(int r, int c) { const int st = (r >> 4) * 2 + (c >> 5), rr = r & 15, cc = c & 31, ob = rr * 64 + cc * 2; return st * 1024 + (ob ^ (((ob >> 9) & 1) << 5)); }
__host__ __device__ __forceinline__ void stage_rc(int b, int& R, int& C) { const int st = b / 1024, sb = b % 1024, swz = sb ^ (((sb >> 9) & 1) << 5); R = (st >> 1) * 16 + swz / 64; C = (st & 1) * 32 + (swz % 64) / 2; }
__host__ __device__ __forceinline__ int perm32(int rho) { const int n = rho >> 4, i = rho & 15; return 8 * (i >> 2) + 4 * n + (i & 3); }

struct Unit { int pm, pn, z; };
struct Gemm { const bf16_t* A; const bf16_t* Bt; int M, N, K; size_t zA, zB; };

struct StaticOrder {
    int nM, nN, nwg, G, c;
    __host__ __device__ void init(int M, int N, int G_, int c_) { nM = M / BM; nN = N / BM; nwg = nM * nN; G = G_; c = c_; }
    __host__ __device__ bool next(int i, Unit& u) const {
        const long L = (long)i * G + c; if (L >= nwg) return false;
        int wgid = (int)L; { const int q = nwg / NXCD, r = nwg % NXCD, xcd = wgid % NXCD, off = wgid / NXCD; wgid = (xcd < r ? xcd * (q + 1) : r * (q + 1) + (xcd - r) * q) + off; }
        const int nig = WGM * nN, gid = wgid / nig, fm = gid * WGM, gsz = (nM - fm) < WGM ? (nM - fm) : WGM;
        u.pm = fm + ((wgid % nig) % gsz); u.pn = (wgid % nig) / gsz; u.z = 0; return true;
    }
    __device__ __forceinline__ void a_ready(const Unit&) const {}
    __device__ __forceinline__ void done(const Unit&) const {}
};

struct StaticOrder3 : StaticOrder {
    __host__ __device__ bool next(int i, Unit& u) const { if (!StaticOrder::next(i / 3, u)) return false; u.z = i % 3; return true; }
};
__device__ __forceinline__ unsigned cvt_pk_bf16(float lo, float hi) { unsigned r; asm volatile("v_cvt_pk_bf16_f32 %0, %1, %2" : "=v"(r) : "v"(lo), "v"(hi)); return r; }
typedef unsigned u32x2 __attribute__((ext_vector_type(2)));
struct EpiBf16 {
    static constexpr bool PERM = true, AFTER_DRAIN = false, KEEP = false, APERM = false;
    bf16_t* O; int ldc; unsigned char* G8; int g8_pn0, g8_ld;
    __device__ __forceinline__ void operator()(const f32x4 (&acc)[2][2][4][2], const Unit& u, int wr, int wc, int fr, int fq) const {
        const int row0 = u.pm * BM + wr * 64 + fr; const int col0 = u.pn * BM + wc * 32 + 8 * fq;
        if (g8_pn0 >= 0 && u.pn >= g8_pn0) { const int gc0 = (u.pn - g8_pn0) * BM + wc * 32 + 8 * fq;
#pragma unroll
            for (int ai = 0; ai < 2; ++ai)
#pragma unroll
                for (int m = 0; m < 4; ++m) { unsigned char* rowp = G8 + (size_t)(row0 + ai * HALF + m * 16) * g8_ld + gc0;
#pragma unroll
                    for (int bj = 0; bj < 2; ++bj) { const f32x4 v0 = acc[ai][bj][m][0], v1 = acc[ai][bj][m][1]; u32x2 w;
                        w.x = (unsigned)__builtin_amdgcn_cvt_pk_fp8_f32(v0[2], v0[3], __builtin_amdgcn_cvt_pk_fp8_f32(v0[0], v0[1], 0, false), true);
                        w.y = (unsigned)__builtin_amdgcn_cvt_pk_fp8_f32(v1[2], v1[3], __builtin_amdgcn_cvt_pk_fp8_f32(v1[0], v1[1], 0, false), true);
                        *(u32x2*)(rowp + bj * HALF) = w; } }
            return; }
#pragma unroll
        for (int ai = 0; ai < 2; ++ai)
#pragma unroll
            for (int m = 0; m < 4; ++m) { bf16_t* rowp = O + (size_t)(row0 + ai * HALF + m * 16) * ldc + col0;
#pragma unroll
                for (int bj = 0; bj < 2; ++bj) { const f32x4 v0 = acc[ai][bj][m][0], v1 = acc[ai][bj][m][1];
                    u32x4 w; w.x = cvt_pk_bf16(v0[0], v0[1]); w.y = cvt_pk_bf16(v0[2], v0[3]); w.z = cvt_pk_bf16(v1[0], v1[1]); w.w = cvt_pk_bf16(v1[2], v1[3]);
                    *(u32x4*)(rowp + bj * HALF) = w; } }
    }
};
__device__ __forceinline__ float bf_lo(unsigned w) { return __uint_as_float(w << 16); }
__device__ __forceinline__ float bf_hi(unsigned w) { return __uint_as_float(w & 0xffff0000u); }
__device__ __forceinline__ float sigmoid_f(float x) { return __builtin_amdgcn_rcpf(1.0f + __expf(-x)); }
struct EpiGateAcc {
    static constexpr bool PERM = true, AFTER_DRAIN = false, KEEP = true, APERM = false;
    bf16_t* O; int ldc; const unsigned char* G8; int g8_ld; const float* rstd;
    template <int E> static __device__ __forceinline__ float g8f(const u32x2 w) { return __builtin_amdgcn_cvt_f32_fp8((int)(E < 4 ? w.x : w.y), E & 3); }
    static __device__ __forceinline__ float em(float g, float rr) { return __expf(-fminf(fmaxf(g * rr, -40.f), 40.f)); }
    __device__ __forceinline__ void operator()(f32x4 (&acc)[2][2][4][2], const Unit& u, int wr, int wc, int fr, int fq) const {
        const int row0 = u.pm * BM + wr * 64 + fr; const int col0 = u.pn * BM + wc * 32 + 8 * fq; const bool last = (u.z == 2); const float dmask = last ? 0.0f : 1.0f;
        const unsigned char* Gn = G8 + (size_t)u.z * ldc; const unsigned char* Gd = G8 + (size_t)(last ? u.z : u.z + 1) * ldc;
#pragma unroll
        for (int ai = 0; ai < 2; ++ai)
#pragma unroll
            for (int m = 0; m < 4; ++m) { const size_t row = (size_t)(row0 + ai * HALF + m * 16); const float rr = rstd[row];
#pragma unroll
                for (int bj = 0; bj < 2; ++bj) {
                    const u32x2 gn = *(const u32x2*)(Gn + row * g8_ld + col0 + bj * HALF), gd = *(const u32x2*)(Gd + row * g8_ld + col0 + bj * HALF);
                    f32x4 v0 = acc[ai][bj][m][0], v1 = acc[ai][bj][m][1];
#define GA_MUL(E) ((1.0f + dmask * em(g8f<E>(gd), rr)) * __builtin_amdgcn_rcpf(1.0f + em(g8f<E>(gn), rr)))
                    v0[0] *= GA_MUL(0); v0[1] *= GA_MUL(1); v0[2] *= GA_MUL(2); v0[3] *= GA_MUL(3); v1[0] *= GA_MUL(4); v1[1] *= GA_MUL(5); v1[2] *= GA_MUL(6); v1[3] *= GA_MUL(7);
#undef GA_MUL
                    acc[ai][bj][m][0] = v0; acc[ai][bj][m][1] = v1;
                    if (last) { u32x4 w; w.x = cvt_pk_bf16(v0[0], v0[1]); w.y = cvt_pk_bf16(v0[2], v0[3]); w.z = cvt_pk_bf16(v1[0], v1[1]); w.w = cvt_pk_bf16(v1[2], v1[3]); *(u32x4*)(O + row * ldc + col0 + bj * HALF) = w; } } }
    }
};
template <bool LAST> struct EpiRes {
    static constexpr bool PERM = true, AFTER_DRAIN = false, KEEP = false, APERM = false;
    bf16_t* xb; float* rs; float* out; int ldc;
    __device__ __forceinline__ void operator()(const f32x4 (&acc)[2][2][4][2], const Unit& u, int wr, int wc, int fr, int fq) const {
        const int row0 = u.pm * BM + wr * 64 + fr; const int col0 = u.pn * BM + wc * 32 + 8 * fq;
#pragma unroll
        for (int ai = 0; ai < 2; ++ai)
#pragma unroll
            for (int m = 0; m < 4; ++m) { const int row = row0 + ai * HALF + m * 16; const size_t off = (size_t)row * ldc + col0; float sq = 0.f;
#pragma unroll
                for (int bj = 0; bj < 2; ++bj) { const u32x4 p = *(const u32x4*)(xb + off + bj * HALF); const f32x4 v0 = acc[ai][bj][m][0], v1 = acc[ai][bj][m][1];
                    const float o0 = bf_lo(p.x) + v0[0], o1 = bf_hi(p.x) + v0[1], o2 = bf_lo(p.y) + v0[2], o3 = bf_hi(p.y) + v0[3], o4 = bf_lo(p.z) + v1[0], o5 = bf_hi(p.z) + v1[1], o6 = bf_lo(p.w) + v1[2], o7 = bf_hi(p.w) + v1[3];
                    if (LAST) { *(f32x4*)(out + off + bj * HALF) = (f32x4){o0, o1, o2, o3}; *(f32x4*)(out + off + bj * HALF + 4) = (f32x4){o4, o5, o6, o7}; }
                    else { sq += ((o0 * o0 + o1 * o1) + (o2 * o2 + o3 * o3)) + ((o4 * o4 + o5 * o5) + (o6 * o6 + o7 * o7));
                        u32x4 w; w.x = cvt_pk_bf16(o0, o1); w.y = cvt_pk_bf16(o2, o3); w.z = cvt_pk_bf16(o4, o5); w.w = cvt_pk_bf16(o6, o7); *(u32x4*)(xb + off + bj * HALF) = w; } }
                if (!LAST) { sq += __shfl_xor(sq, 16); sq += __shfl_xor(sq, 32); if (fq == 0) rs[(size_t)row * 32 + u.pn * 4 + wc] = sq; } }
    }
};

struct EpiGLU {
    static constexpr bool PERM = true, AFTER_DRAIN = false, KEEP = false, APERM = true;
    bf16_t* ACT; const float* cw; const float* cb; const float* rs; bf16_t* SB;
    static __device__ __forceinline__ f32x4 prev_lane(const f32x4 v, int src) { f32x4 o;
#pragma unroll
        for (int k = 0; k < 4; ++k) o[k] = __shfl(v[k], src); return o; }
    static __device__ __forceinline__ f32x4 silu4(const f32x4 a) { f32x4 o;
#pragma unroll
        for (int k = 0; k < 4; ++k) o[k] = a[k] * __builtin_amdgcn_rcpf(1.0f + __expf(-a[k])); return o; }
    __device__ __forceinline__ void operator()(const f32x4 (&acc)[2][2][4][2], const Unit& u, int wr, int wc, int fr, int fq) const {
        constexpr int DFF_ = 5632, NUP_ = 2 * DFF_;
        const int T0 = u.pm * BM + 8 * (16 * wr + fr), jq = u.pn * HALF + wc * 32 + 8 * fq, grp = 2 * u.pm + wr;
        float s0 = 0.f, s1 = 0.f;
        { const int L = fq * 16 + fr; const float* p0 = rs + (size_t)(u.pm * BM + 128 * wr + 2 * L) * 32;
#pragma unroll
          for (int q = 0; q < 8; ++q) { const f32x4 a = *(const f32x4*)(p0 + 4 * q), b = *(const f32x4*)(p0 + 32 + 4 * q); s0 += (a[0] + a[1]) + (a[2] + a[3]); s1 += (b[0] + b[1]) + (b[2] + b[3]); }
          s0 = __builtin_amdgcn_rsqf(s0 * (1.0f / 2048.0f) + 1e-6f); s1 = __builtin_amdgcn_rsqf(s1 * (1.0f / 2048.0f) + 1e-6f); }
        float rr[8];
#pragma unroll
        for (int i = 0; i < 8; ++i) rr[i] = __shfl((i & 1) ? s1 : s0, 4 * fr + (i >> 1));
#pragma unroll
        for (int n = 0; n < 2; ++n) { const int j = jq + 4 * n;
            const f32x4 ca = *(const f32x4*)(cb + j), cbv = *(const f32x4*)(cb + DFF_ + j);
            const f32x4 a0 = *(const f32x4*)(cw + j), a1 = *(const f32x4*)(cw + NUP_ + j), a2 = *(const f32x4*)(cw + 2 * NUP_ + j);
            const f32x4 b0 = *(const f32x4*)(cw + DFF_ + j), b1 = *(const f32x4*)(cw + NUP_ + DFF_ + j), b2 = *(const f32x4*)(cw + 2 * NUP_ + DFF_ + j);
            f32x4 va[8], vb[8];
#pragma unroll
            for (int i = 0; i < 8; ++i) { va[i] = acc[i >> 2][0][i & 3][n] * rr[i]; vb[i] = acc[i >> 2][1][i & 3][n] * rr[i]; }
            const int psrc = fq * 16 + ((fr + 15) & 15); const f32x4 pa6 = prev_lane(va[6], psrc), pa7 = prev_lane(va[7], psrc), pb6 = prev_lane(vb[6], psrc), pb7 = prev_lane(vb[7], psrc);
#pragma unroll
            for (int i = 0; i < 8; ++i) {
                const f32x4 xa1 = i >= 1 ? va[i - 1] : pa7, xa2 = i >= 2 ? va[i - 2] : (i == 1 ? pa7 : pa6), xb1 = i >= 1 ? vb[i - 1] : pb7, xb2 = i >= 2 ? vb[i - 2] : (i == 1 ? pb7 : pb6);
                const f32x4 ua = ca + a0 * xa2 + a1 * xa1 + a2 * va[i], ub = cbv + b0 * xb2 + b1 * xb1 + b2 * vb[i];
                const f32x4 o = silu4(ua) * ub;
                if (i >= 2 || fr != 0) { u32x2 w; w.x = cvt_pk_bf16(o[0], o[1]); w.y = cvt_pk_bf16(o[2], o[3]); *(u32x2*)(ACT + (size_t)(T0 + i) * DFF_ + j) = w; } }
            if (fr == 0) {
#pragma unroll
                for (int i = 0; i < 2; ++i) { u32x2 w; w.x = cvt_pk_bf16(va[i][0], va[i][1]); w.y = cvt_pk_bf16(va[i][2], va[i][3]); *(u32x2*)(SB + ((size_t)grp * 4 + 2 + i) * NUP_ + j) = w;
                    w.x = cvt_pk_bf16(vb[i][0], vb[i][1]); w.y = cvt_pk_bf16(vb[i][2], vb[i][3]); *(u32x2*)(SB + ((size_t)grp * 4 + 2 + i) * NUP_ + DFF_ + j) = w; } }
            if (fr == 15) {
#pragma unroll
                for (int i = 0; i < 2; ++i) { u32x2 w; w.x = cvt_pk_bf16(va[6 + i][0], va[6 + i][1]); w.y = cvt_pk_bf16(va[6 + i][2], va[6 + i][3]); *(u32x2*)(SB + ((size_t)(grp + 1) * 4 + i) * NUP_ + j) = w;
                    w.x = cvt_pk_bf16(vb[6 + i][0], vb[6 + i][1]); w.y = cvt_pk_bf16(vb[6 + i][2], vb[6 + i][3]); *(u32x2*)(SB + ((size_t)(grp + 1) * 4 + i) * NUP_ + DFF_ + j) = w; } }
        }
    }
};

template <class Epi, class Sched, bool ALIGN_EPI = false, bool SP2 = false>
__device__ __forceinline__ void gemm_phase(PG8_LAS unsigned char* lds, const Gemm g, const Sched& S, const Epi& E) {
    int tid_ = threadIdx.x; asm volatile("" : "+v"(tid_));
    const int tid = tid_, wid = __builtin_amdgcn_readfirstlane(tid >> 6), lane = tid & 63, wr = wid >> 2, wc = wid & 3, fr = lane & 15, fq = lane >> 4;
    const int K = g.K, nt = K / BK;
    unsigned voffA[2], voffB[2];
#pragma unroll
    for (int i = 0; i < 2; ++i) { int R, C; stage_rc(tid * 16 + i * 8192, R, C); const int Rb = Epi::PERM ? ((R & ~31) + perm32(R & 31)) : R;
        const int Ra = Epi::APERM ? (8 * (16 * (R >> 6) + (R & 15)) + ((R >> 4) & 3)) : R;
        voffA[i] = (unsigned)(Ra * K + C) * 2u; voffB[i] = (unsigned)(Rb * K + C) * 2u; }
    const size_t kstep = (size_t)(BK * 2);
    const size_t hstep = (size_t)HALF * K * 2;
    const size_t hstepA = Epi::APERM ? (size_t)4 * K * 2 : hstep;
    const size_t tstep = 2 * hstep;
    const unsigned ldsw = (unsigned)wid * 1024u;
    const int aoff = lds_byte(wr * 64 + fr, fq * 8), boff = lds_byte(wc * 32 + fr, fq * 8);
#define PG8_SA(b, h) (((b) * 2 + (h)) * HTB)
#define PG8_SB(b, h) ((4 + (b) * 2 + (h)) * HTB)
#define PG8_STAGE(bufoff, gbase, voff) do { _Pragma("unroll") for (int _i = 0; _i < 2; ++_i) \
        __builtin_amdgcn_global_load_lds((const unsigned*)((const char*)(gbase) + (voff)[_i]), (PG8_LAS unsigned*)(lds + (bufoff) + ldsw + _i * 8192), 16, 0, 0); } while (0)
#define PG8_LDA(dst, b, h) do { _Pragma("unroll") for (int m = 0; m < 4; ++m) _Pragma("unroll") for (int k = 0; k < 2; ++k) dst[m][k] = *(const PG8_LAS bf16x8*)(lds + PG8_SA(b, h) + aoff + m * 2048 + k * 1024); } while (0)
#define PG8_LDB(dst, b, h) do { _Pragma("unroll") for (int n = 0; n < 2; ++n) _Pragma("unroll") for (int k = 0; k < 2; ++k) dst[n][k] = *(const PG8_LAS bf16x8*)(lds + PG8_SB(b, h) + boff + n * 2048 + k * 1024); } while (0)
#define PG8_MMA(ai, bj, At, Bt) do { __builtin_amdgcn_s_setprio(1); _Pragma("unroll") for (int m = 0; m < 4; ++m) _Pragma("unroll") for (int n = 0; n < 2; ++n) _Pragma("unroll") for (int k = 0; k < 2; ++k) \
        acc[ai][bj][m][n] = __builtin_amdgcn_mfma_f32_16x16x32_bf16(Bt[n][k], At[m][k], acc[ai][bj][m][n], 0, 0, 0); __builtin_amdgcn_s_setprio(0); } while (0)
#define PG8_WAIT_V(n) asm volatile("s_waitcnt vmcnt(" #n ")" ::: "memory")
#define PG8_WAIT_L(n) asm volatile("s_waitcnt lgkmcnt(" #n ")" ::: "memory")
#define PG8_BAR __builtin_amdgcn_s_barrier()
#define PG8_SCHED __builtin_amdgcn_sched_barrier(0)
    Unit cur, nxt; int ui = 0;
    if (!S.next(0, cur)) return;
    f32x4 acc[2][2][4][2];
#pragma unroll
    for (int a = 0; a < 2; ++a)
#pragma unroll
        for (int b = 0; b < 2; ++b)
#pragma unroll
            for (int m = 0; m < 4; ++m)
#pragma unroll
                for (int n = 0; n < 2; ++n) acc[a][b][m][n] = (f32x4){0.f, 0.f, 0.f, 0.f};
    bf16x8 At[4][2], B0[2][2], B1[2][2];
    const char* cA = (const char*)(g.A + (size_t)cur.z * g.zA) + (size_t)cur.pm * tstep; const char* cB = (const char*)(g.Bt + (size_t)cur.z * g.zB) + (size_t)cur.pn * tstep;
    S.a_ready(cur);
    if constexpr (SP2) {
        PG8_STAGE(PG8_SB(0, 0), cB, voffB); PG8_STAGE(PG8_SB(0, 1), cB + hstep, voffB); PG8_STAGE(PG8_SA(0, 0), cA, voffA); PG8_STAGE(PG8_SA(0, 1), cA + hstepA, voffA);
        if (wr == 1) PG8_BAR;
        PG8_WAIT_V(2); PG8_BAR;
        PG8_STAGE(PG8_SB(1, 0), cB + kstep, voffB); PG8_STAGE(PG8_SA(1, 0), cA + kstep, voffA); PG8_STAGE(PG8_SB(1, 1), cB + hstep + kstep, voffB);
        PG8_WAIT_V(6); PG8_BAR;
    } else {
        PG8_STAGE(PG8_SB(0, 0), cB, voffB); PG8_STAGE(PG8_SA(0, 0), cA, voffA); PG8_STAGE(PG8_SB(0, 1), cB + hstep, voffB); PG8_STAGE(PG8_SA(0, 1), cA + hstepA, voffA);
        if (wr == 1) PG8_BAR;
        PG8_WAIT_V(4); PG8_BAR;
        PG8_STAGE(PG8_SB(1, 0), cB + kstep, voffB); PG8_STAGE(PG8_SA(1, 0), cA + kstep, voffA); PG8_STAGE(PG8_SB(1, 1), cB + hstep + kstep, voffB);
        PG8_WAIT_V(6); PG8_BAR;
    }
    for (;;) {
        const bool has_next = S.next(ui + 1, nxt);
        const char* nA = has_next ? (const char*)(g.A + (size_t)nxt.z * g.zA) + (size_t)nxt.pm * tstep : cA; const char* nB = has_next ? (const char*)(g.Bt + (size_t)nxt.z * g.zB) + (size_t)nxt.pn * tstep : cB;
        for (int t = 0; t < nt; t += 2) {
            const bool last = (t == nt - 2);
            const char* a1 = cA + (size_t)(t + 1) * kstep;
            const char* a2 = last ? nA : cA + (size_t)(t + 2) * kstep; const char* b2 = last ? nB : cB + (size_t)(t + 2) * kstep;
            const char* a3 = a2 + kstep; const char* b3 = b2 + kstep;
            if (last && has_next) S.a_ready(nxt);
            if constexpr (SP2) {
            PG8_LDB(B0, 0, 0); PG8_LDB(B1, 0, 1); PG8_SCHED; PG8_LDA(At, 0, 0); PG8_STAGE(PG8_SA(1, 1), a1 + hstepA, voffA);
            PG8_WAIT_V(8); PG8_WAIT_L(0); PG8_BAR; PG8_MMA(0, 0, At, B0); PG8_MMA(0, 1, At, B1); PG8_BAR; PG8_SCHED;
            PG8_LDA(At, 0, 1); PG8_STAGE(PG8_SB(0, 0), b2, voffB); PG8_STAGE(PG8_SB(0, 1), b2 + hstep, voffB); PG8_STAGE(PG8_SA(0, 0), a2, voffA);
            PG8_WAIT_V(8); PG8_WAIT_L(0); PG8_BAR; PG8_MMA(1, 0, At, B0); PG8_MMA(1, 1, At, B1); PG8_BAR; PG8_SCHED;
            PG8_LDB(B0, 1, 0); PG8_LDB(B1, 1, 1); PG8_SCHED; PG8_LDA(At, 1, 0); PG8_STAGE(PG8_SA(0, 1), a2 + hstepA, voffA);
            PG8_WAIT_V(8); PG8_WAIT_L(0); PG8_BAR; PG8_MMA(0, 0, At, B0); PG8_MMA(0, 1, At, B1); PG8_BAR; PG8_SCHED;
            PG8_LDA(At, 1, 1); PG8_STAGE(PG8_SB(1, 0), b3, voffB); PG8_STAGE(PG8_SB(1, 1), b3 + hstep, voffB); PG8_STAGE(PG8_SA(1, 0), a3, voffA);
            PG8_WAIT_V(8); PG8_WAIT_L(0); PG8_BAR; PG8_MMA(1, 0, At, B0); PG8_MMA(1, 1, At, B1); PG8_BAR; PG8_SCHED;
            } else {
            PG8_LDB(B0, 0, 0); PG8_SCHED; PG8_LDA(At, 0, 0); PG8_STAGE(PG8_SA(1, 1), a1 + hstepA, voffA);
            PG8_WAIT_L(8); PG8_BAR; PG8_WAIT_L(0); PG8_MMA(0, 0, At, B0); PG8_BAR; PG8_SCHED;
            PG8_LDB(B1, 0, 1); PG8_STAGE(PG8_SB(0, 0), b2, voffB);
            PG8_BAR; PG8_WAIT_L(0); PG8_MMA(0, 1, At, B1); PG8_BAR;
            PG8_LDA(At, 0, 1); PG8_STAGE(PG8_SA(0, 0), a2, voffA);
            PG8_BAR; PG8_WAIT_L(0); PG8_MMA(1, 0, At, B0); PG8_BAR; PG8_SCHED;
            PG8_STAGE(PG8_SB(0, 1), b2 + hstep, voffB);
            PG8_WAIT_V(6); PG8_BAR; PG8_MMA(1, 1, At, B1); PG8_BAR;
            PG8_LDB(B0, 1, 0); PG8_SCHED; PG8_LDA(At, 1, 0); PG8_STAGE(PG8_SA(0, 1), a2 + hstepA, voffA);
            PG8_WAIT_L(8); PG8_BAR; PG8_WAIT_L(0); PG8_MMA(0, 0, At, B0); PG8_BAR; PG8_SCHED;
            PG8_LDB(B1, 1, 1); PG8_STAGE(PG8_SB(1, 0), b3, voffB);
            PG8_BAR; PG8_WAIT_L(0); PG8_MMA(0, 1, At, B1); PG8_BAR;
            PG8_LDA(At, 1, 1); PG8_STAGE(PG8_SA(1, 0), a3, voffA);
            PG8_BAR; PG8_WAIT_L(0); PG8_MMA(1, 0, At, B0); PG8_BAR; PG8_SCHED;
            PG8_STAGE(PG8_SB(1, 1), b3 + hstep, voffB);
            PG8_WAIT_V(6); PG8_BAR; PG8_MMA(1, 1, At, B1); PG8_BAR;
            }
        }
        if constexpr (ALIGN_EPI) { if (wr == 0) PG8_BAR; }
        if constexpr (!Epi::AFTER_DRAIN) { E(acc, cur, wr, wc, fr, fq); S.done(cur); }
        if (!has_next) break;
        if (!(Epi::KEEP && nxt.z != 0)) {
#pragma unroll
        for (int a = 0; a < 2; ++a)
#pragma unroll
            for (int b = 0; b < 2; ++b)
#pragma unroll
                for (int m = 0; m < 4; ++m)
#pragma unroll
                    for (int n = 0; n < 2; ++n) acc[a][b][m][n] = (f32x4){0.f, 0.f, 0.f, 0.f};
        }
        cur = nxt; cA = nA; cB = nB; ++ui;
        if constexpr (ALIGN_EPI) { if (wr == 1) PG8_BAR; }
    }
    PG8_WAIT_V(0);
    if constexpr (!ALIGN_EPI) { if (wr == 0) PG8_BAR; }
    PG8_BAR;
    if constexpr (Epi::AFTER_DRAIN) { E.fused(acc, cur, wr, wc, fr, fq, lds, wid, lane); S.done(cur); }
#undef PG8_SA
#undef PG8_SB
#undef PG8_STAGE
#undef PG8_LDA
#undef PG8_LDB
#undef PG8_MMA
#undef PG8_WAIT_V
#undef PG8_WAIT_L
#undef PG8_BAR
#undef PG8_SCHED
}
}

constexpr int NWAVES = 8;
constexpr int BATCH = 8, SEQ = 2048, DM = 2048, DEPTH = 4, M = BATCH * SEQ, NH = 8;
constexpr int NIN = 16400, NZ = 16384, DFF = 5632, NUP = 2 * DFF, NY = 3072;
constexpr int Z_RQ = 0, Z_RK = 1024, Z_RV = 2048, Z_RG = 3072, Z_MQ = 4096, Z_MK = 4608, Z_MV = 5120, Z_MO = 6144, Z_AQ = 7168, Z_AK = 8192, Z_AV = 9216, Z_GA = 10240, Z_GB = 12288, Z_GC = 14336;
constexpr int W_GATE_COL = 7168;
constexpr size_t MiB = 1u << 20;
constexpr size_t WS_CTL = 0, CTL_ZERO_BYTES = 1 * MiB;
constexpr size_t WS_RS = 1520 * MiB;
constexpr size_t WS_TAB = 2 * MiB + 512 * 1024;
constexpr size_t WS_RSTD = 7 * MiB + 512 * 1024;
constexpr size_t WS_W16G = 7 * MiB;
constexpr size_t WS_KMEAN = 5 * MiB;
constexpr size_t WS_GIF = 6 * MiB;
constexpr size_t WS_WIN = 8 * MiB;
constexpr size_t WS_WP = 264 * MiB;
constexpr size_t WS_WOUT = 312 * MiB;
constexpr size_t WS_WUP = 344 * MiB;
constexpr size_t WS_WDN = 520 * MiB;
constexpr size_t WS_XB = 608 * MiB;
constexpr size_t WS_Z = 672 * MiB;
constexpr size_t WS_Y = 1184 * MiB;
constexpr size_t WS_MG = 1280 * MiB;
constexpr size_t WS_ACT = 1344 * MiB;
constexpr size_t WS_ZG = 1536 * MiB;
constexpr size_t WS_SB = 1632 * MiB;
constexpr size_t WS_END = 1648 * MiB;
constexpr int CW_TMO = 0, CW_CODE = 1;
constexpr int CW_BAR = 4096;
constexpr int CW_QUEUE = 8192;
constexpr int RING_OFF = 0, RING_BYTES = 131072;
constexpr int LDS_BYTES = 163840;
constexpr int LDSCTL_OFF = LDS_BYTES - 512, MISC_OFF = LDSCTL_OFF + 320;
static_assert(MISC_OFF + 128 <= LDS_BYTES, "LDS map");

#define GAS __attribute__((address_space(1)))
#define LAS __attribute__((address_space(3)))
typedef unsigned short bf16;
typedef unsigned v4u __attribute__((ext_vector_type(4)));
typedef unsigned v2u __attribute__((ext_vector_type(2)));
typedef float f32x4 __attribute__((ext_vector_type(4)));
typedef float f32x2 __attribute__((ext_vector_type(2)));
typedef GAS unsigned gu32;
#define RLX_AGENT __ATOMIC_RELAXED, __HIP_MEMORY_SCOPE_AGENT
#define LDS_WAIT() asm volatile("s_waitcnt lgkmcnt(0)" ::: "memory")
#define VM_WAIT() asm volatile("s_waitcnt vmcnt(0)" ::: "memory")
typedef __bf16 bf16x2_t __attribute__((ext_vector_type(2)));
__device__ __forceinline__ unsigned pk2(float lo, float hi) { const f32x2 v = {lo, hi}; const bf16x2_t b = __builtin_convertvector(v, bf16x2_t); return __builtin_bit_cast(unsigned, b); }
__device__ __forceinline__ unsigned f2bf(float f) { return pk2(f, f); }
__device__ __forceinline__ float bflo(unsigned w) { return __uint_as_float(w << 16); }
__device__ __forceinline__ float bfhi(unsigned w) { return __uint_as_float(w & 0xffff0000u); }
__device__ __forceinline__ float bf1(bf16 v) { return __uint_as_float((unsigned)v << 16); }
__device__ __forceinline__ float sigm(float x) { return 1.0f / (1.0f + __expf(-x)); }

#define XB_TMO      128
#define XB_XCNT(j)  (256  + 64 * (j))
#define XB_XSUB(j)  (1280 + 64 * (j))
#define XB_XGEN(j)  (2304 + 64 * (j))
#define XB_TOP      3328
#define XB_TOPGEN   3392
#define XCD_BAR_WORDS 3456
#define XB_SPIN_CAP (1u << 18)

__device__ __forceinline__ unsigned xb_ld(unsigned* p)              { return __hip_atomic_load(p, __ATOMIC_RELAXED, __HIP_MEMORY_SCOPE_AGENT); }
__device__ __forceinline__ unsigned xb_add(unsigned* p, unsigned v) { return __hip_atomic_fetch_add(p, v, __ATOMIC_RELAXED, __HIP_MEMORY_SCOPE_AGENT); }
__device__ __forceinline__ unsigned xb_xcc_id() { return (unsigned)__builtin_amdgcn_s_getreg((3 << 11) | 20) & 0xFu; }
#define XB_SPIN(cond, bar) do { unsigned _sp = 0; while (cond) { __builtin_amdgcn_s_sleep(1); \
    if ((++_sp & 255u) == 0u) { if (xb_ld(&(bar)[XB_TMO])) break; if (_sp > XB_SPIN_CAP) { atomicAdd(&(bar)[XB_TMO], 1u); break; } } } } while (0)

struct XcdBarrier {
    unsigned* bar; unsigned x;
    volatile LAS unsigned* st;
};

__device__ __forceinline__ XcdBarrier xcd_barrier_post(unsigned* bar, volatile LAS unsigned* st) {
    XcdBarrier b; b.bar = bar; b.x = xb_xcc_id(); b.st = st;
    if (threadIdx.x == 0) (void)xb_add(&bar[XB_XCNT(b.x)], 1u);
    return b;
}
__device__ __forceinline__ void xcd_barrier_complete(unsigned* bar, unsigned x, unsigned& nloc, unsigned& nx) {
    const unsigned G = gridDim.x * gridDim.y * gridDim.z;
    unsigned sum, cnt, mine, sp = 0u;
    for (;;) {
        sum = 0u; cnt = 0u; mine = 0u;
#pragma unroll
        for (unsigned j = 0; j < 16; ++j) { const unsigned c = xb_ld(&bar[XB_XCNT(j)]); sum += c; cnt += (c > 0u) ? 1u : 0u; mine = (j == x) ? c : mine; }
        if (sum == G) break;
        __builtin_amdgcn_s_sleep(1);
        if ((++sp & 255u) == 0u) { if (xb_ld(&bar[XB_TMO])) break; if (sp > XB_SPIN_CAP) { atomicAdd(&bar[XB_TMO], 1u); break; } }
    }
    nloc = mine > 0u ? mine : 1u; nx = cnt > 0u ? cnt : 1u;
}

__device__ __forceinline__ void xcd_barrier(const XcdBarrier& b) {
    asm volatile("s_waitcnt vmcnt(0)" ::: "memory");
    __syncthreads();
    if (threadIdx.x == 0) {
        unsigned* bar = b.bar;
        __builtin_amdgcn_s_waitcnt(0);
        unsigned nloc = b.st[0], nx = b.st[1];
        if (nloc == 0u) { xcd_barrier_complete(bar, b.x, nloc, nx); b.st[0] = nloc; b.st[1] = nx; }
        const unsigned old = xb_add(&bar[XB_XSUB(b.x)], 1u);
        const unsigned gen = old / nloc;
        if (old + 1u == (gen + 1u) * nloc) {
            __builtin_amdgcn_fence(__ATOMIC_RELEASE, "agent");
            asm volatile("s_waitcnt vmcnt(0)" ::: "memory");
            const unsigned og = xb_add(&bar[XB_TOP], 1u);
            const unsigned tg = og / nx;
            if (og + 1u == (tg + 1u) * nx) xb_add(&bar[XB_TOPGEN], 1u);
            else XB_SPIN(xb_ld(&bar[XB_TOPGEN]) == tg, bar);
            __builtin_amdgcn_fence(__ATOMIC_ACQUIRE, "agent");
            xb_add(&bar[XB_XGEN(b.x)], 1u);
            asm volatile("s_waitcnt vmcnt(0)" ::: "memory");
        } else {
            XB_SPIN(xb_ld(&bar[XB_XGEN(b.x)]) == gen, bar);
            __builtin_amdgcn_fence(__ATOMIC_ACQUIRE, "agent");
            asm volatile("s_waitcnt vmcnt(0)" ::: "memory");
        }
    }
    __syncthreads();
}

struct Args { const float* in[18]; float* out; unsigned char* ws; int ph_lo, ph_hi, li, pad; };
enum { I_X = 0, I_WIN, I_BIG, I_BFG, I_NMIX, I_RGN, I_MLN, I_QN, I_KN, I_WPA, I_WPB, I_WPC, I_WOUT, I_NFFN, I_WUP, I_CW, I_CB, I_WDN };
struct Frame {
    LAS unsigned char* lds;
    volatile LAS unsigned* MISC;
    unsigned char* ws;
    int tid, lane, wave, G, bx;
};
#define WSP(T, off) ((T*)(F.ws + (off)))
__device__ __forceinline__ float wave_sum(float v) {
#pragma unroll
    for (int o = 1; o < 64; o <<= 1) v += __shfl_xor(v, o);
    return v;
}
__device__ __forceinline__ float wave_max(float v) {
#pragma unroll
    for (int o = 1; o < 64; o <<= 1) v = fmaxf(v, __shfl_xor(v, o));
    return v;
}
__device__ __forceinline__ void p0_transpose_item(const float* W, int ldw, int K, int nblk, bf16* WT, LAS float* scr, int item, int lane, const float* gk = nullptr) {
    const int kb = item / nblk, nb = item % nblk, k0 = 64 * kb, n0 = 32 * nb;
#pragma unroll 8
    for (int i = 0; i < 32; ++i) { const int kk = 2 * i + (lane >> 5); scr[kk * 33 + (lane & 31)] = W[(size_t)(k0 + kk) * ldw + n0 + (lane & 31)]; }
    LDS_WAIT(); asm volatile("" ::: "memory");
    const int c = lane & 7;
    f32x4 g0 = (f32x4){1.f, 1.f, 1.f, 1.f}, g1 = g0;
    if (gk) { g0 = *(const f32x4*)(gk + k0 + 8 * c); g1 = *(const f32x4*)(gk + k0 + 8 * c + 4); }
#pragma unroll
    for (int j = 0; j < 4; ++j) { const int n = (lane >> 3) + 8 * j; const LAS float* s = scr + (8 * c) * 33 + n;
        v4u o; o.x = pk2(s[0 * 33] * g0[0], s[1 * 33] * g0[1]); o.y = pk2(s[2 * 33] * g0[2], s[3 * 33] * g0[3]); o.z = pk2(s[4 * 33] * g1[0], s[5 * 33] * g1[1]); o.w = pk2(s[6 * 33] * g1[2], s[7 * 33] * g1[3]);
        *(GAS v4u*)(WT + (size_t)(n0 + n) * K + k0 + 8 * c) = o; }
    LDS_WAIT(); asm volatile("" ::: "memory");
}
__device__ __forceinline__ void p0_prologue(Frame& F, const Args& args) {
    LAS float* scr = (LAS float*)(F.lds + RING_OFF + F.wave * 16384);
    const int gw = F.bx * NWAVES + F.wave, NGW = F.G * NWAVES;
    constexpr int I_INA = 32 * 224, I_INB = 32 * 288, I_P = 16 * 64, I_OUT = 32 * 64, I_UP = 32 * 352, I_DN = 88 * 64;
    constexpr int I_LAYER = I_INA + I_INB + 3 * I_P + I_OUT + I_UP + I_DN;
    for (int it = gw; it < DEPTH * I_LAYER; it += NGW) {
        const int l = it / I_LAYER; int r = it % I_LAYER;
        const float* win = args.in[I_WIN] + (size_t)l * DM * NIN; bf16* wint = WSP(bf16, WS_WIN) + (size_t)l * NZ * DM;
        if (r < I_INA) { p0_transpose_item(win, NIN, DM, 224, wint, scr, r, F.lane, args.in[I_NMIX] + l * DM); continue; } r -= I_INA;
        if (r < I_INB) { p0_transpose_item(win + 7184, NIN, DM, 288, wint + (size_t)7168 * DM, scr, r, F.lane, args.in[I_NMIX] + l * DM); continue; } r -= I_INB;
        if (r < I_P) { p0_transpose_item(args.in[I_WPA] + (size_t)l * 1024 * DM, DM, 1024, 64, WSP(bf16, WS_WP) + ((size_t)l * 3 + 0) * DM * 1024, scr, r, F.lane); continue; } r -= I_P;
        if (r < I_P) { p0_transpose_item(args.in[I_WPB] + (size_t)l * 1024 * DM, DM, 1024, 64, WSP(bf16, WS_WP) + ((size_t)l * 3 + 1) * DM * 1024, scr, r, F.lane); continue; } r -= I_P;
        if (r < I_P) { p0_transpose_item(args.in[I_WPC] + (size_t)l * 1024 * DM, DM, 1024, 64, WSP(bf16, WS_WP) + ((size_t)l * 3 + 2) * DM * 1024, scr, r, F.lane); continue; } r -= I_P;
        if (r < I_OUT) { p0_transpose_item(args.in[I_WOUT] + (size_t)l * DM * DM, DM, DM, 64, WSP(bf16, WS_WOUT) + (size_t)l * DM * DM, scr, r, F.lane); continue; } r -= I_OUT;
        if (r < I_UP) {
            const int nb = r % 352, tile = nb >> 3, wi = nb & 7, src = (wi < 4) ? 128 * tile + 32 * wi : DFF + 128 * tile + 32 * (wi - 4);
            p0_transpose_item(args.in[I_WUP] + (size_t)l * DM * NUP + (src - 32 * nb), NUP, DM, 352, WSP(bf16, WS_WUP) + (size_t)l * NUP * DM, scr, r, F.lane, args.in[I_NFFN] + l * DM); continue; } r -= I_UP;
        p0_transpose_item(args.in[I_WDN] + (size_t)l * DFF * DM, DM, DFF, 64, WSP(bf16, WS_WDN) + (size_t)l * DM * DFF, scr, r, F.lane);
    }
    const int gt = F.bx * (NWAVES * 64) + F.tid, NGT = F.G * NWAVES * 64;
    for (int i = gt; i < DEPTH * 16 * DM; i += NGT) { const int l = i / (16 * DM), c = (i / DM) % 16, k = i % DM; WSP(bf16, WS_W16G)[i] = (bf16)f2bf(args.in[I_WIN][((size_t)l * DM + k) * NIN + W_GATE_COL + c] * args.in[I_NMIX][l * DM + k]); }
    for (int m = gw; m < M; m += NGW) { const f32x4* xr = (const f32x4*)(args.in[I_X] + (size_t)m * DM) + F.lane; v2u* o8 = (v2u*)(WSP(bf16, WS_XB) + (size_t)m * DM) + F.lane; float s = 0.f;
#pragma unroll
        for (int j = 0; j < 8; ++j) { const f32x4 v = xr[64 * j]; s += (v.x * v.x + v.y * v.y) + (v.z * v.z + v.w * v.w); v2u w; w.x = pk2(v.x, v.y); w.y = pk2(v.z, v.w); o8[64 * j] = w; }
        s = wave_sum(s); if (F.lane < 32) WSP(float, WS_RS)[(size_t)m * 32 + F.lane] = (F.lane == 0) ? s : 0.f; }
    for (int i = gt; i < 2 * SEQ * 64; i += NGT) { const int which = i / (SEQ * 64), pos = (i / 64) % SEQ, d = i % 64;
        const float ex = which == 0 ? (float)d / 63.0f : (float)(2 * d) / 128.0f;
        const float inv = 1.0f / powf(10000.0f, ex); const float ang = (float)pos * inv; float s, c; sincosf(ang, &s, &c); WSP(f32x2, WS_TAB)[i] = (f32x2){c, s}; }
}
__device__ __forceinline__ void prep_phase(Frame& F, const float* qn, const float* kn, const bf16* w16g, const float* rs, const float* big, const float* bfg) {
    const int gw = F.bx * NWAVES + F.wave, NGW = F.G * NWAVES, lane = F.lane, rsub = lane >> 2, dg = lane & 3;
    const f32x2* trope = WSP(f32x2, WS_TAB) + SEQ * 64;
    for (int u = gw; u < BATCH * 16 * NH; u += NGW) {
        const int kind = 1, hh = u & 7, hb = (u >> 3) & 15, b = u >> 7;
        const float* wn = kn;
        const float* rsb = rs + (size_t)(b * SEQ + hb * 128) * 32 + 8 * dg;
        float wl[16], wh[16], s1[16], s2[16];
#pragma unroll
        for (int e = 0; e < 16; ++e) { wl[e] = wn[16 * dg + e]; wh[e] = wn[64 + 16 * dg + e]; s1[e] = 0.f; s2[e] = 0.f; }
        bf16* zb = WSP(bf16, WS_Z) + (size_t)(b * SEQ + hb * 128) * NZ + (kind ? Z_AK : Z_AQ) + hh * 128 + 16 * dg;
#pragma unroll 2
        for (int st = 0; st < 8; ++st) {
            const int r = rsub + 16 * st, pos = hb * 128 + r; bf16* zr = zb + (size_t)r * NZ;
            const v4u l0 = *(const v4u*)(zr), l1 = *(const v4u*)(zr + 8), h0 = *(const v4u*)(zr + 64), h1 = *(const v4u*)(zr + 72);
            float a[16] = {bflo(l0.x), bfhi(l0.x), bflo(l0.y), bfhi(l0.y), bflo(l0.z), bfhi(l0.z), bflo(l0.w), bfhi(l0.w), bflo(l1.x), bfhi(l1.x), bflo(l1.y), bfhi(l1.y), bflo(l1.z), bfhi(l1.z), bflo(l1.w), bfhi(l1.w)};
            float c[16] = {bflo(h0.x), bfhi(h0.x), bflo(h0.y), bfhi(h0.y), bflo(h0.z), bfhi(h0.z), bflo(h0.w), bfhi(h0.w), bflo(h1.x), bfhi(h1.x), bflo(h1.y), bfhi(h1.y), bflo(h1.z), bfhi(h1.z), bflo(h1.w), bfhi(h1.w)};
            float ss = 0.f;
#pragma unroll
            for (int e = 0; e < 16; ++e) ss += a[e] * a[e] + c[e] * c[e];
            ss += __shfl_xor(ss, 1); ss += __shfl_xor(ss, 2);
            float rq; { const f32x4 s0 = *(const f32x4*)(rsb + (size_t)r * 32), s1 = *(const f32x4*)(rsb + (size_t)r * 32 + 4); rq = ((s0[0] + s0[1]) + (s0[2] + s0[3])) + ((s1[0] + s1[1]) + (s1[2] + s1[3])); }
            rq += __shfl_xor(rq, 1); rq += __shfl_xor(rq, 2);
            const float rr = rsqrtf(rq * (1.0f / 2048.0f) + 1e-6f);
            if (hh == 0 && dg == 0) WSP(float, WS_RSTD)[b * SEQ + hb * 128 + r] = rr;
            const float rstd = rr * rsqrtf(ss * rr * rr * (1.f / 128.f) + 1e-6f);
            const f32x2* tb = trope + pos * 64 + 16 * dg;
#pragma unroll
            for (int e = 0; e < 16; ++e) { const float x1 = a[e] * rstd * wl[e], x2 = c[e] * rstd * wh[e]; const f32x2 cs = tb[e]; a[e] = x1 * cs.x - x2 * cs.y; c[e] = x1 * cs.y + x2 * cs.x; s1[e] += a[e]; s2[e] += c[e]; }
            *(v4u*)(zr) = (v4u){pk2(a[0], a[1]), pk2(a[2], a[3]), pk2(a[4], a[5]), pk2(a[6], a[7])}; *(v4u*)(zr + 8) = (v4u){pk2(a[8], a[9]), pk2(a[10], a[11]), pk2(a[12], a[13]), pk2(a[14], a[15])};
            *(v4u*)(zr + 64) = (v4u){pk2(c[0], c[1]), pk2(c[2], c[3]), pk2(c[4], c[5]), pk2(c[6], c[7])}; *(v4u*)(zr + 72) = (v4u){pk2(c[8], c[9]), pk2(c[10], c[11]), pk2(c[12], c[13]), pk2(c[14], c[15])};
        }
        if (kind) {
            float* km = WSP(float, WS_KMEAN) + (size_t)((b * NH + hh) * 16 + hb) * 128 + 16 * dg;
#pragma unroll
            for (int e = 0; e < 16; ++e) { float x = s1[e], y = s2[e];
                x += __shfl_xor(x, 4); x += __shfl_xor(x, 8); x += __shfl_xor(x, 16); x += __shfl_xor(x, 32);
                y += __shfl_xor(y, 4); y += __shfl_xor(y, 8); y += __shfl_xor(y, 16); y += __shfl_xor(y, 32);
                if (rsub == 0) { km[e] = x * (1.f / 256.f); km[64 + e] = y * (1.f / 256.f); } }
        }
    }
    for (int it = NGW - 1 - gw; it < M / 16; it += NGW) {
        const int i16 = lane & 15, g = lane >> 4; const bf16* ar = WSP(bf16, WS_XB) + (size_t)(16 * it + i16) * DM + 8 * g; const bf16* br = w16g + (size_t)i16 * DM + 8 * g;
        typedef short bf16x8_t __attribute__((ext_vector_type(8)));
        f32x4 acc = (f32x4){0.f, 0.f, 0.f, 0.f};
#pragma unroll 1
        for (int s0 = 0; s0 < DM / 32; s0 += 16) { bf16x8_t av[16], bv[16];
#pragma unroll
            for (int s = 0; s < 16; ++s) { av[s] = *(const bf16x8_t*)(ar + 32 * (s0 + s)); bv[s] = *(const bf16x8_t*)(br + 32 * (s0 + s)); }
#pragma unroll
            for (int s = 0; s < 16; ++s) acc = __builtin_amdgcn_mfma_f32_16x16x32_bf16(av[s], bv[s], acc, 0, 0, 0); }
#pragma unroll
        for (int r = 0; r < 4; ++r) { const int row = 16 * it + 4 * g + r; float ssq = 0.f;
#pragma unroll
            for (int q = 0; q < 8; ++q) { const f32x4 a = *(const f32x4*)(rs + (size_t)row * 32 + 4 * q); ssq += (a[0] + a[1]) + (a[2] + a[3]); }
            const float sr = rsqrtf(ssq * (1.0f / 2048.0f) + 1e-6f);
            const float pre = acc[r] * sr + (i16 < 8 ? big[i16 & 7] : bfg[i16 & 7]); const float sc = 15.0f * tanhf(pre * (1.0f / 15.0f));
            float o = sc; if (i16 >= 8) o = sc > 0.f ? -log1pf(__expf(-sc)) : sc - log1pf(__expf(sc));
            WSP(float, WS_GIF)[(size_t)row * 16 + i16] = o; }
    }
}
__device__ __forceinline__ void glu_fix_phase(Frame& F, const float* cw, const float* cb) {
    const bf16* SB = WSP(bf16, WS_SB); bf16* ACT = WSP(bf16, WS_ACT);
    for (int gI = F.bx; gI < M / 128; gI += F.G) {
        const bool first = ((gI * 128) & (SEQ - 1)) == 0; const bf16* sb = SB + (size_t)gI * 4 * NUP;
        for (int it = F.tid; it < 2 * (DFF / 8); it += NWAVES * 64) {
            const int i = it / (DFF / 8), c8 = (it % (DFF / 8)) * 8;
            float r[2][8];
#pragma unroll
            for (int hf = 0; hf < 2; ++hf) { const int col = hf * DFF + c8;
                const f32x4 b0 = *(const f32x4*)(cb + col), b1 = *(const f32x4*)(cb + col + 4);
                float a[8] = {b0.x, b0.y, b0.z, b0.w, b1.x, b1.y, b1.z, b1.w};
#pragma unroll
                for (int j = 0; j < 3; ++j) { const int slot = i + j;
                    if (slot >= 2 || !first) { const v4u uw = *(const v4u*)(sb + (size_t)slot * NUP + col); const f32x4 w0 = *(const f32x4*)(cw + (size_t)j * NUP + col), w1 = *(const f32x4*)(cw + (size_t)j * NUP + col + 4);
                        a[0] += bflo(uw.x) * w0.x; a[1] += bfhi(uw.x) * w0.y; a[2] += bflo(uw.y) * w0.z; a[3] += bfhi(uw.y) * w0.w; a[4] += bflo(uw.z) * w1.x; a[5] += bfhi(uw.z) * w1.y; a[6] += bflo(uw.w) * w1.z; a[7] += bfhi(uw.w) * w1.w; } }
#pragma unroll
                for (int e = 0; e < 8; ++e) r[hf][e] = a[e]; }
            float o[8];
#pragma unroll
            for (int e = 0; e < 8; ++e) o[e] = r[0][e] * __builtin_amdgcn_rcpf(1.0f + __expf(-r[0][e])) * r[1][e];
            *(v4u*)(ACT + (size_t)(gI * 128 + i) * DFF + c8) = (v4u){pk2(o[0], o[1]), pk2(o[2], o[3]), pk2(o[4], o[5]), pk2(o[6], o[7])};
        }
    }
}
namespace mx {
typedef short bf16x8 __attribute__((ext_vector_type(8)));
typedef short s16x4 __attribute__((ext_vector_type(4)));
#define MFMA16(a, b, c) __builtin_amdgcn_mfma_f32_16x16x32_bf16((a), (b), (c), 0, 0, 0)
#define LDS_FENCE() asm volatile("s_waitcnt lgkmcnt(0)" ::: "memory")
#define SCHED_FENCE() __builtin_amdgcn_sched_barrier(0)
__device__ __forceinline__ bf16x8 frag_row(const LAS bf16* X, int ld, int r0, int c0, int lane) {
    return *(const LAS bf16x8*)(X + (r0 + (lane & 15)) * ld + c0 + 8 * (lane >> 4)); }
__device__ __forceinline__ bf16x8 frag_tr(const LAS bf16* X, int ld, int k0, int c0, int lane) {
    const int g = lane >> 4, q = (lane & 15) >> 2, p = lane & 3;
    const LAS bf16* a = X + (k0 + 8 * g + q) * ld + c0 + 4 * p;
    const s16x4 lo = __builtin_amdgcn_ds_read_tr16_b64_v4i16((LAS s16x4*)a);
    const s16x4 hi = __builtin_amdgcn_ds_read_tr16_b64_v4i16((LAS s16x4*)(a + 4 * ld));
    return __builtin_shufflevector(lo, hi, 0, 1, 2, 3, 4, 5, 6, 7);
}
__device__ __forceinline__ int trs_off(int row, int chunk) { return row * 128 + ((chunk ^ (((row & 3) << 1) | (((row >> 3) & 1) << 3))) << 3); }
__device__ __forceinline__ bf16x8 frag_trs(const LAS bf16* X, int k0, int c0, int lane) {
    const int g = lane >> 4, q = (lane & 15) >> 2, p = lane & 3;
    const LAS bf16* a = X + trs_off(k0 + 8 * g + q, (c0 >> 3) + (p >> 1)) + 4 * (p & 1);
    const s16x4 lo = __builtin_amdgcn_ds_read_tr16_b64_v4i16((LAS s16x4*)a);
    const s16x4 hi = __builtin_amdgcn_ds_read_tr16_b64_v4i16((LAS s16x4*)(a + 4 * 128));
    return __builtin_shufflevector(lo, hi, 0, 1, 2, 3, 4, 5, 6, 7);
}
template <int CTRL> __device__ __forceinline__ float dppf(float v) { return __builtin_bit_cast(float, __builtin_amdgcn_update_dpp(0, __builtin_bit_cast(int, v), CTRL, 0xf, 0xf, true)); }
__device__ __forceinline__ float r16max(float v) { v = fmaxf(v, dppf<0xB1>(v)); v = fmaxf(v, dppf<0x4E>(v)); v = fmaxf(v, dppf<0x141>(v)); v = fmaxf(v, dppf<0x140>(v)); return v; }
__device__ __forceinline__ float r16sum(float v) { v += dppf<0xB1>(v); v += dppf<0x4E>(v); v += dppf<0x141>(v); v += dppf<0x140>(v); return v; }
__device__ __forceinline__ float red16_sum(float v) { return r16sum(v); }
__device__ __forceinline__ float red16_max(float v) { return r16max(v); }
__device__ __forceinline__ void rot8(const v4u lo, const v4u hi, const f32x2* tb, float sc, v4u& olo, v4u& ohi) {
    float a[8] = {bflo(lo.x), bfhi(lo.x), bflo(lo.y), bfhi(lo.y), bflo(lo.z), bfhi(lo.z), bflo(lo.w), bfhi(lo.w)};
    float c[8] = {bflo(hi.x), bfhi(hi.x), bflo(hi.y), bfhi(hi.y), bflo(hi.z), bfhi(hi.z), bflo(hi.w), bfhi(hi.w)};
    float o1[8], o2[8];
#pragma unroll
    for (int e = 0; e < 8; ++e) { const f32x2 cs = tb[e]; o1[e] = (a[e] * cs.x - c[e] * cs.y) * sc; o2[e] = (a[e] * cs.y + c[e] * cs.x) * sc; }
    olo = (v4u){pk2(o1[0], o1[1]), pk2(o1[2], o1[3]), pk2(o1[4], o1[5]), pk2(o1[6], o1[7])};
    ohi = (v4u){pk2(o2[0], o2[1]), pk2(o2[2], o2[3]), pk2(o2[4], o2[5]), pk2(o2[6], o2[7])};
}
constexpr int LQ = 144;
__device__ __forceinline__ void ret_unit(Frame& F, const float* gn, int b, int h) {
    LAS bf16* Qs = (LAS bf16*)(F.lds); LAS bf16* Ks = Qs + 128 * LQ; LAS bf16* Vs = Ks + 128 * LQ; LAS bf16* Ts = Vs + 128 * LQ;
    const int tid = F.tid, lane = F.lane, w = tid >> 6, i16 = lane & 15, g = lane >> 4;
    const float gamma = 1.0f - exp2f(-5.0f - (float)h), lg = log2f(gamma);
    const float gC = exp2f(lg * 128.0f);
    f32x4 accT[8];
#pragma unroll
    for (int n = 0; n < 8; ++n) accT[n] = (f32x4){0.f, 0.f, 0.f, 0.f};
    for (int i = tid; i < 128 * LQ / 8; i += NWAVES * 64) ((LAS v4u*)Ts)[i] = (v4u){0u, 0u, 0u, 0u};
    const bf16* zb = WSP(bf16, WS_Z) + (size_t)(b * SEQ) * NZ + h * 128;
    const f32x2* tret = WSP(f32x2, WS_TAB);
    bf16* yb = WSP(bf16, WS_Y) + (size_t)(b * SEQ) * 1024 + h * 128;
    const int lr = tid >> 2, dg = tid & 3;
    v4u pq[4], pk[4], pv[4]; float prr;
    const float* rstd1 = WSP(float, WS_RSTD) + (size_t)(b * SEQ);
#define RET_FETCH(t0_) do { const bf16* zr_ = zb + (size_t)((t0_) + lr) * NZ; \
        pq[0] = *(const v4u*)(zr_ + Z_RQ + 16 * dg); pq[1] = *(const v4u*)(zr_ + Z_RQ + 64 + 16 * dg); pq[2] = *(const v4u*)(zr_ + Z_RQ + 16 * dg + 8); pq[3] = *(const v4u*)(zr_ + Z_RQ + 64 + 16 * dg + 8); \
        pk[0] = *(const v4u*)(zr_ + Z_RK + 16 * dg); pk[1] = *(const v4u*)(zr_ + Z_RK + 64 + 16 * dg); pk[2] = *(const v4u*)(zr_ + Z_RK + 16 * dg + 8); pk[3] = *(const v4u*)(zr_ + Z_RK + 64 + 16 * dg + 8); \
        _Pragma("unroll") for (int q_ = 0; q_ < 4; ++q_) pv[q_] = *(const v4u*)(zr_ + Z_RV + 32 * dg + 8 * q_); prr = rstd1[(t0_) + lr]; } while (0)
    RET_FETCH(0);
    const float sq = exp2f(lg * (float)lr), sk = exp2f(-lg * (float)lr) * 0.08838834764831845f;
    float gnv[8];
#pragma unroll
    for (int n = 0; n < 8; ++n) gnv[n] = gn[h * 128 + 16 * n + i16];
    for (int c = 0; c < SEQ / 128; ++c) {
        const int t0 = c * 128;
        {
            const f32x2* tb = tret + (t0 + lr) * 64 + 16 * dg;
#pragma unroll
            for (int hh = 0; hh < 2; ++hh) {
                v4u o1, o2; rot8(pq[2 * hh], pq[2 * hh + 1], tb + 8 * hh, sq * prr, o1, o2);
                *(LAS v4u*)(Qs + lr * LQ + 16 * dg + 8 * hh) = o1; *(LAS v4u*)(Qs + lr * LQ + 64 + 16 * dg + 8 * hh) = o2;
                rot8(pk[2 * hh], pk[2 * hh + 1], tb + 8 * hh, sk * prr * prr, o1, o2);
                *(LAS v4u*)(Ks + lr * LQ + 16 * dg + 8 * hh) = o1; *(LAS v4u*)(Ks + lr * LQ + 64 + 16 * dg + 8 * hh) = o2;
            }
#pragma unroll
            for (int q = 0; q < 4; ++q) *(LAS v4u*)(Vs + lr * LQ + 32 * dg + 8 * q) = pv[q];
            if (c + 1 < SEQ / 128) RET_FETCH(t0 + 128);
        }
        __syncthreads();
        bf16x8 aq[4];
#pragma unroll
        for (int s = 0; s < 4; ++s) aq[s] = frag_row(Qs, LQ, 16 * w, 32 * s, lane);
        f32x4 acco[8];
#pragma unroll
        for (int n = 0; n < 8; ++n) acco[n] = (f32x4){0.f, 0.f, 0.f, 0.f};
#pragma unroll
        for (int s = 0; s < 4; ++s) { bf16x8 bb[8];
#pragma unroll
            for (int n = 0; n < 8; ++n) bb[n] = frag_tr(Ts, LQ, 32 * s, 16 * n, lane);
            SCHED_FENCE();
#pragma unroll
            for (int n = 0; n < 8; ++n) acco[n] = MFMA16(aq[s], bb[n], acco[n]); }
        LDS_FENCE();
#pragma unroll
        for (int n = 0; n < 8; ++n) {
            if (n <= w) { f32x4 sa = (f32x4){0.f, 0.f, 0.f, 0.f}; bf16x8 bb[4];
#pragma unroll
                for (int s = 0; s < 4; ++s) bb[s] = frag_row(Ks, LQ, 16 * n, 32 * s, lane);
                SCHED_FENCE();
#pragma unroll
                for (int s = 0; s < 4; ++s) sa = MFMA16(aq[s], bb[s], sa);
#pragma unroll
                for (int r = 0; r < 4; ++r) { const int i = 16 * w + 4 * g + r, j = 16 * n + i16; Qs[i * LQ + j] = (bf16)f2bf(j <= i ? sa[r] : 0.f); } }
            else if (n == w + 1) {
#pragma unroll
                for (int r = 0; r < 4; ++r) Qs[(16 * w + 4 * g + r) * LQ + 16 * n + i16] = (bf16)0; }
        }
        LDS_FENCE();
#pragma unroll
        for (int n = 0; n < 8; ++n) accT[n] = accT[n] * gC;
#pragma unroll
        for (int s = 0; s < 4; ++s) { const bf16x8 ak = frag_tr(Ks, LQ, 32 * s, 16 * w, lane); const bool doi = (s <= (w >> 1)); bf16x8 as = ak; bf16x8 bb[8];
            if (doi) as = frag_row(Qs, LQ, 16 * w, 32 * s, lane);
#pragma unroll
            for (int n = 0; n < 8; ++n) bb[n] = frag_tr(Vs, LQ, 32 * s, 16 * n, lane);
            SCHED_FENCE();
            if (doi) {
#pragma unroll
                for (int n = 0; n < 8; ++n) acco[n] = MFMA16(as, bb[n], acco[n]); }
#pragma unroll
            for (int n = 0; n < 8; ++n) accT[n] = MFMA16(ak, bb[n], accT[n]); }
        bf16 gvr[4][8]; float rrv[4];
#pragma unroll
        for (int r = 0; r < 4; ++r) { const int pos = t0 + 16 * w + 4 * g + r; const bf16* gr = zb + (size_t)pos * NZ + Z_RG + i16; rrv[r] = rstd1[pos];
#pragma unroll
            for (int n = 0; n < 8; ++n) gvr[r][n] = gr[16 * n]; }
        LDS_FENCE();
        __syncthreads();
#pragma unroll
        for (int n = 0; n < 8; ++n)
#pragma unroll
            for (int r = 0; r < 4; ++r) Ts[(16 * w + 4 * g + r) * LQ + 16 * n + i16] = (bf16)f2bf(gC * accT[n][r]);
#pragma unroll
        for (int r = 0; r < 4; ++r) {
            float s = 0.f;
#pragma unroll
            for (int n = 0; n < 8; ++n) s += acco[n][r];
            const float mean = red16_sum(s) * (1.f / 128.f); float q = 0.f;
#pragma unroll
            for (int n = 0; n < 8; ++n) { const float d = acco[n][r] - mean; q += d * d; }
            const float rstd = rsqrtf(red16_sum(q) * (1.f / 128.f) + 1e-5f);
            const int pos = t0 + 16 * w + 4 * g + r; bf16* yr = yb + (size_t)pos * 1024; const float rri = rrv[r];
#pragma unroll
            for (int n = 0; n < 8; ++n) { const int e = 16 * n + i16; const float gv = bf1(gvr[r][n]) * rri; yr[e] = (bf16)f2bf((acco[n][r] - mean) * rstd * gnv[n] * gv * sigm(gv)); }
        }
    }
    __syncthreads();
#undef RET_FETCH
}
constexpr int LK = 72, LV = 168;
__device__ __forceinline__ float scan64_sum(float x, int lane) {
#pragma unroll
    for (int o = 1; o < 64; o <<= 1) { const float y = __shfl_up(x, o); if (lane >= o) x += y; }
    return x; }
__device__ __forceinline__ float scan64_max(float x, int lane) {
#pragma unroll
    for (int o = 1; o < 64; o <<= 1) { const float y = __shfl_up(x, o); if (lane >= o) x = fmaxf(x, y); }
    return x; }
__device__ __forceinline__ void mlstm_unit(Frame& F, const float* nw, int b, int h) {
    LAS bf16* Qm = (LAS bf16*)(F.lds); LAS bf16* Km = Qm + 128 * LK; LAS bf16* Kw = Km + 128 * LK; LAS bf16* Vm = Kw + 128 * LK; LAS bf16* Pm = Vm + 128 * LV; LAS bf16* Cm = Pm + 128 * LQ;
    const int tid = F.tid, lane = F.lane, w = F.wave, i16 = lane & 15, g = lane >> 4;
    const int dt = w & 3, eh = w >> 2;
    f32x4 accC[5];
#pragma unroll
    for (int k = 0; k < 5; ++k) accC[k] = (f32x4){0.f, 0.f, 0.f, 0.f};
    for (int i = tid; i < 64 * LV / 8; i += NWAVES * 64) ((LAS v4u*)Cm)[i] = (v4u){0u, 0u, 0u, 0u};
    float m_prev = 0.f;
    const bf16* zb = WSP(bf16, WS_Z) + (size_t)(b * SEQ) * NZ;
    const float* gif = WSP(float, WS_GIF) + (size_t)(b * SEQ) * 16;
    bf16* yb = WSP(bf16, WS_Y) + (size_t)M * 1024 + (size_t)(b * SEQ) * 1024 + h * 128;
    const int lr = tid >> 2, dg = tid & 3;
    v4u pq[2], pk[2]; float fl0, fl1, il0, il1, prr;
    const float* rstd1 = WSP(float, WS_RSTD) + (size_t)(b * SEQ);
#define ML_FETCH(t0_) do { const bf16* zr_ = zb + (size_t)((t0_) + lr) * NZ; \
        pq[0] = *(const v4u*)(zr_ + Z_MQ + h * 64 + 16 * dg); pq[1] = *(const v4u*)(zr_ + Z_MQ + h * 64 + 16 * dg + 8); pk[0] = *(const v4u*)(zr_ + Z_MK + h * 64 + 16 * dg); pk[1] = *(const v4u*)(zr_ + Z_MK + h * 64 + 16 * dg + 8); \
        fl0 = gif[(size_t)((t0_) + lane) * 16 + 8 + h]; fl1 = gif[(size_t)((t0_) + 64 + lane) * 16 + 8 + h]; il0 = gif[(size_t)((t0_) + lane) * 16 + h]; il1 = gif[(size_t)((t0_) + 64 + lane) * 16 + h]; prr = rstd1[(t0_) + lr]; } while (0)
    ML_FETCH(0);
    float nwv[8];
#pragma unroll
    for (int n = 0; n < 8; ++n) nwv[n] = nw[h * 128 + 16 * n + i16];
    for (int c = 0; c < SEQ / 128; ++c) {
        const int t0 = c * 128;
        const float a0 = scan64_sum(fl0, lane); const float a1 = scan64_sum(fl1, lane) + __shfl(a0, 63);
        const float b0 = il0 - a0, b1 = il1 - a1;
        const float pm0 = scan64_max(b0, lane); const float pm1 = fmaxf(scan64_max(b1, lane), __shfl(pm0, 63));
        const float a_last = __shfl(a1, 63), bmax = __shfl(pm1, 63);
        const float g_n = a_last + bmax, m_new = fmaxf(a_last + m_prev, g_n), s_old = __expf(a_last + m_prev - m_new), s_new = __expf(g_n - m_new);
        {
            const int r = lr;
            const float br = (r < 64) ? __shfl(b0, r & 63) : __shfl(b1, r & 63);
            const float rk = prr * 0.125f, wk = __expf(br - bmax) * rk * s_new;
#pragma unroll
            for (int hh = 0; hh < 2; ++hh) {
                *(LAS v4u*)(Qm + r * LK + 16 * dg + 8 * hh) = pq[hh];
                const v4u kk = pk[hh];
                float kf[8] = {bflo(kk.x), bfhi(kk.x), bflo(kk.y), bfhi(kk.y), bflo(kk.z), bfhi(kk.z), bflo(kk.w), bfhi(kk.w)};
                *(LAS v4u*)(Km + r * LK + 16 * dg + 8 * hh) = (v4u){pk2(kf[0] * rk, kf[1] * rk), pk2(kf[2] * rk, kf[3] * rk), pk2(kf[4] * rk, kf[5] * rk), pk2(kf[6] * rk, kf[7] * rk)};
                *(LAS v4u*)(Kw + r * LK + 16 * dg + 8 * hh) = (v4u){pk2(kf[0] * wk, kf[1] * wk), pk2(kf[2] * wk, kf[3] * wk), pk2(kf[4] * wk, kf[5] * wk), pk2(kf[6] * wk, kf[7] * wk)};
            }
#pragma unroll
            for (int q = 0; q < 4; ++q) { const v4u x = *(const v4u*)(zb + (size_t)(t0 + r) * NZ + Z_MV + h * 128 + 32 * dg + 8 * q); const float rv = prr;
                *(LAS v4u*)(Vm + r * LV + 32 * dg + 8 * q) = (v4u){pk2(bflo(x.x) * rv, bfhi(x.x) * rv), pk2(bflo(x.y) * rv, bfhi(x.y) * rv), pk2(bflo(x.z) * rv, bfhi(x.z) * rv), pk2(bflo(x.w) * rv, bfhi(x.w) * rv)}; }
            *(LAS v4u*)(Vm + r * LV + 128 + 8 * dg) = (v4u){dg == 0 ? 0x00003f80u : 0u, 0u, 0u, 0u};
            if (c + 1 < SEQ / 128) ML_FETCH(t0 + 128);
        }
        __syncthreads();
        float Mi[4], ai[4], rri[4];
#pragma unroll
        for (int r = 0; r < 4; ++r) { const int i = 16 * w + 4 * g + r; rri[r] = rstd1[t0 + i]; const float pmi = (w < 4) ? __shfl(pm0, i & 63) : __shfl(pm1, i & 63); ai[r] = (w < 4) ? __shfl(a0, i & 63) : __shfl(a1, i & 63); Mi[r] = fmaxf(pmi, m_prev); }
        bf16x8 aq[2];
#pragma unroll
        for (int s = 0; s < 2; ++s) aq[s] = frag_row(Qm, LK, 16 * w, 32 * s, lane);
        f32x4 acco[9];
#pragma unroll
        for (int n = 0; n < 9; ++n) acco[n] = (f32x4){0.f, 0.f, 0.f, 0.f};
#pragma unroll
        for (int s = 0; s < 2; ++s) {
#pragma unroll
          for (int hf = 0; hf < 2; ++hf) { bf16x8 bb[5];
#pragma unroll
            for (int n = 0; n < 5 - hf; ++n) bb[n] = frag_tr(Cm, LV, 32 * s, 16 * (5 * hf + n), lane);
            SCHED_FENCE();
#pragma unroll
            for (int n = 0; n < 5 - hf; ++n) acco[5 * hf + n] = MFMA16(aq[s], bb[n], acco[5 * hf + n]); } }
        { float si[4];
#pragma unroll
          for (int r = 0; r < 4; ++r) si[r] = __expf(m_prev - Mi[r]) * rri[r];
#pragma unroll
          for (int n = 0; n < 9; ++n)
#pragma unroll
            for (int r = 0; r < 4; ++r) acco[n][r] *= si[r]; }
        LDS_FENCE();
#pragma unroll
        for (int n = 0; n < 8; ++n) {
            if (n <= w) { f32x4 sa = (f32x4){0.f, 0.f, 0.f, 0.f}; bf16x8 bb[2];
#pragma unroll
                for (int s = 0; s < 2; ++s) bb[s] = frag_row(Km, LK, 16 * n, 32 * s, lane);
                SCHED_FENCE();
#pragma unroll
                for (int s = 0; s < 2; ++s) sa = MFMA16(aq[s], bb[s], sa);
                const int j = 16 * n + i16; const float bj = (n < 4) ? __shfl(b0, j & 63) : __shfl(b1, j & 63);
#pragma unroll
                for (int r = 0; r < 4; ++r) { const int i = 16 * w + 4 * g + r; Pm[i * LQ + j] = (bf16)f2bf(j <= i ? sa[r] * rri[r] * __expf(bj - Mi[r]) : 0.f); } }
            else if (n == w + 1) {
#pragma unroll
                for (int r = 0; r < 4; ++r) Pm[(16 * w + 4 * g + r) * LQ + 16 * n + i16] = (bf16)0; }
        }
        LDS_FENCE();
#pragma unroll
        for (int k = 0; k < 5; ++k) accC[k] = accC[k] * s_old;
#pragma unroll
        for (int s = 0; s < 4; ++s) { const bf16x8 ak = frag_tr(Kw, LK, 32 * s, 16 * dt, lane); const bool doi = (s <= (w >> 1)); bf16x8 ap = ak;
            if (doi) ap = frag_row(Pm, LQ, 16 * w, 32 * s, lane);
#pragma unroll
          for (int hf = 0; hf < 2; ++hf) { const bool dos = (hf == eh);
            if (doi || dos) { bf16x8 bb[5];
#pragma unroll
              for (int n = 0; n < 5; ++n) bb[n] = frag_tr(Vm, LV, 32 * s, 16 * (5 * hf + n), lane);
              SCHED_FENCE();
              if (doi) {
#pragma unroll
                for (int n = 0; n < 5 - hf; ++n) acco[5 * hf + n] = MFMA16(ap, bb[n], acco[5 * hf + n]); }
              if (dos) {
#pragma unroll
                for (int k = 0; k < 5; ++k) accC[k] = MFMA16(ak, bb[k], accC[k]); } } } }
        bf16 gvr[4][8];
#pragma unroll
        for (int r = 0; r < 4; ++r) { const bf16* gr = zb + (size_t)(t0 + 16 * w + 4 * g + r) * NZ + Z_MO + h * 128 + i16;
#pragma unroll
            for (int n = 0; n < 8; ++n) gvr[r][n] = gr[16 * n]; }
        LDS_FENCE();
        __syncthreads();
#pragma unroll
        for (int k = 0; k < 5; ++k)
#pragma unroll
            for (int r = 0; r < 4; ++r) Cm[(16 * dt + 4 * g + r) * LV + 16 * (5 * eh + k) + i16] = (bf16)f2bf(accC[k][r]);
#pragma unroll
        for (int r = 0; r < 4; ++r) {
            const float den = __shfl(acco[8][r], lane & 48);
            const float dd = 1.0f / fmaxf(fabsf(den), __expf(-(ai[r] + Mi[r])));
            float q = 0.f;
#pragma unroll
            for (int n = 0; n < 8; ++n) { acco[n][r] *= dd; q += acco[n][r] * acco[n][r]; }
            const float rstd = rsqrtf(red16_sum(q) * (1.f / 128.f) + 1e-6f);
            const int pos = t0 + 16 * w + 4 * g + r; bf16* yr = yb + (size_t)pos * 1024;
#pragma unroll
            for (int n = 0; n < 8; ++n) { const int e = 16 * n + i16; yr[e] = (bf16)f2bf(acco[n][r] * rstd * nwv[n] * sigm(bf1(gvr[r][n]) * rri[r])); }
        }
        m_prev = m_new;
    }
    __syncthreads();
#undef ML_FETCH
}
__device__ __forceinline__ int vt_off(int row, int chunk) { return row * 128 + ((chunk ^ ((row & 7) << 1)) << 3); }
__device__ __forceinline__ bf16x8 frag_trp(const LAS bf16* X, int k0, int c0, int lane) {
    const int g = lane >> 4, q = (lane & 15) >> 2, p = lane & 3;
    const LAS bf16* a = X + vt_off(k0 + 4 * g + q, (c0 >> 3) + (p >> 1)) + 4 * (p & 1);
    const s16x4 lo = __builtin_amdgcn_ds_read_tr16_b64_v4i16((LAS s16x4*)a);
    const s16x4 hi = __builtin_amdgcn_ds_read_tr16_b64_v4i16((LAS s16x4*)(a + 16 * 128));
    return __builtin_shufflevector(lo, hi, 0, 1, 2, 3, 4, 5, 6, 7);
}
__device__ __forceinline__ void moba_unit(Frame& F, const float* qn, int b, int h, int qi) {
    constexpr int KT_E = 128 * LQ, VT_E = 128 * 128;
    LAS bf16* Kt0 = (LAS bf16*)(F.lds); LAS bf16* Vt0 = Kt0 + 2 * KT_E; LAS float* RR = (LAS float*)(Vt0 + 2 * VT_E);
    const int tid = F.tid, lane = F.lane, w = tid >> 6, i16 = lane & 15, g = lane >> 4;
    const int blk = qi >> 1, qt = qi & 1, q0 = qi * 128;
    const bf16* zb = WSP(bf16, WS_Z) + (size_t)(b * SEQ) * NZ + h * 128;
    bf16x8 aq[4];
    { const bf16* qr = zb + (size_t)(q0 + 16 * w + i16) * NZ + Z_AQ + 8 * g;
#pragma unroll
      for (int s = 0; s < 4; ++s) aq[s] = *(const bf16x8*)(qr + 32 * s); }
    const int lr = tid >> 2, dg = tid & 3;
    v4u pk[4], pv[4]; float prr;
    const float* rstdb = WSP(float, WS_RSTD) + (size_t)(b * SEQ);
#define MB_FETCH(k0_) do { const bf16* zr_ = zb + (size_t)((k0_) + lr) * NZ + 32 * dg; \
        _Pragma("unroll") for (int q_ = 0; q_ < 4; ++q_) { pk[q_] = *(const v4u*)(zr_ + Z_AK + 8 * q_); pv[q_] = *(const v4u*)(zr_ + Z_AV + 8 * q_); } prr = rstdb[(k0_) + lr]; } while (0)
#define MB_STAGE(buf_) do { LAS bf16* kd_ = Kt0 + (buf_) * KT_E + lr * LQ + 32 * dg; LAS bf16* vd_ = Vt0 + (buf_) * VT_E; \
        _Pragma("unroll") for (int q_ = 0; q_ < 4; ++q_) { *(LAS v4u*)(kd_ + 8 * q_) = pk[q_]; *(LAS v4u*)(vd_ + vt_off(lr, 4 * dg + q_)) = pv[q_]; } if (dg == 0) RR[(buf_) * 128 + lr] = prr; } while (0)
    MB_FETCH(0);
    { float ss = 0.f; float qf[4][8];
#pragma unroll
      for (int s = 0; s < 4; ++s) { const v4u x = __builtin_bit_cast(v4u, aq[s]); qf[s][0] = bflo(x.x); qf[s][1] = bfhi(x.x); qf[s][2] = bflo(x.y); qf[s][3] = bfhi(x.y); qf[s][4] = bflo(x.z); qf[s][5] = bfhi(x.z); qf[s][6] = bflo(x.w); qf[s][7] = bfhi(x.w);
#pragma unroll
          for (int j = 0; j < 8; ++j) ss += qf[s][j] * qf[s][j]; }
      ss += __shfl_xor(ss, 16); ss += __shfl_xor(ss, 32);
      const int pos = q0 + 16 * w + i16; const float rr = rstdb[pos]; const float f = rr * rsqrtf(ss * rr * rr * (1.f / 128.f) + 1e-6f);
      const f32x2* tb = WSP(f32x2, WS_TAB) + SEQ * 64 + pos * 64 + 8 * g;
#pragma unroll
      for (int s = 0; s < 2; ++s) {
#pragma unroll
          for (int j = 0; j < 8; ++j) { const float x1 = qf[s][j] * f * qn[32 * s + 8 * g + j], x2 = qf[s + 2][j] * f * qn[64 + 32 * s + 8 * g + j]; const f32x2 cs = tb[32 * s + j];
              qf[s][j] = x1 * cs.x - x2 * cs.y; qf[s + 2][j] = x1 * cs.y + x2 * cs.x; } }
#pragma unroll
      for (int s = 0; s < 4; ++s) { const v4u o = (v4u){pk2(qf[s][0], qf[s][1]), pk2(qf[s][2], qf[s][3]), pk2(qf[s][4], qf[s][5]), pk2(qf[s][6], qf[s][7])}; aq[s] = __builtin_bit_cast(bf16x8, o); } }
    unsigned sel = 0u;
    {
        f32x4 gacc = (f32x4){0.f, 0.f, 0.f, 0.f};
        const float* km = WSP(float, WS_KMEAN) + (size_t)((b * NH + h) * 16) * 128 + (size_t)(i16 & 7) * 256 + 8 * g;
        const bool live = i16 < blk;
#pragma unroll
        for (int s = 0; s < 4; ++s) { f32x4 k0 = (f32x4){0.f, 0.f, 0.f, 0.f}, k1 = k0;
            if (live) { k0 = *(const f32x4*)(km + 32 * s) + *(const f32x4*)(km + 128 + 32 * s); k1 = *(const f32x4*)(km + 32 * s + 4) + *(const f32x4*)(km + 128 + 32 * s + 4); }
            const v4u hi = (v4u){pk2(k0.x, k0.y), pk2(k0.z, k0.w), pk2(k1.x, k1.y), pk2(k1.z, k1.w)};
            const v4u lo = (v4u){pk2(k0.x - bflo(hi.x), k0.y - bfhi(hi.x)), pk2(k0.z - bflo(hi.y), k0.w - bfhi(hi.y)), pk2(k1.x - bflo(hi.z), k1.y - bfhi(hi.z)), pk2(k1.z - bflo(hi.w), k1.w - bfhi(hi.w))};
            gacc = MFMA16(__builtin_bit_cast(bf16x8, hi), aq[s], gacc); gacc = MFMA16(__builtin_bit_cast(bf16x8, lo), aq[s], gacc); }
        float gate[8];
#pragma unroll
        for (int n = 0; n < 8; ++n) { const float gv = __shfl(gacc[n & 3], i16 + 16 * (n >> 2)); gate[n] = (n < blk) ? gv : -INFINITY; }
#pragma unroll
        for (int s = 0; s < 3; ++s) { float bv = -INFINITY; int best = -1;
#pragma unroll
            for (int n = 0; n < 8; ++n) { const bool c = !((sel >> n) & 1u) && gate[n] > bv; bv = c ? gate[n] : bv; best = c ? n : best; }
            if (best >= 0) sel |= 1u << best; }
    }
#pragma unroll
    for (int s = 0; s < 4; ++s) { const v4u u = __builtin_bit_cast(v4u, aq[s]); const float c2 = 0.08838834764831845f * 1.4426950408889634f;
        const v4u o = (v4u){pk2(bflo(u.x) * c2, bfhi(u.x) * c2), pk2(bflo(u.y) * c2, bfhi(u.y) * c2), pk2(bflo(u.z) * c2, bfhi(u.z) * c2), pk2(bflo(u.w) * c2, bfhi(u.w) * c2)}; aq[s] = __builtin_bit_cast(bf16x8, o); }
    f32x4 acco[8];
#pragma unroll
    for (int n = 0; n < 8; ++n) acco[n] = (f32x4){0.f, 0.f, 0.f, 0.f};
    float mq = -1e30f, lq = 0.f;
    const int ntiles = 2 * blk + qt + 1;
    const int qrel = 16 * w + i16 - 4 * g;
    __syncthreads();
    MB_STAGE(0);
    if (ntiles > 1) MB_FETCH(128);
    __syncthreads();
    for (int kt = 0; kt < ntiles; ++kt) {
        const int kb = kt >> 1; const bool own = (kb == blk), diag = (kt == 2 * blk + qt);
        const LAS bf16* Kt = Kt0 + (kt & 1) * KT_E; const LAS bf16* Vt = Vt0 + (kt & 1) * VT_E;
        f32x4 sc[8];
#pragma unroll
        for (int n = 0; n < 8; ++n) sc[n] = (f32x4){0.f, 0.f, 0.f, 0.f};
#pragma unroll
        for (int s = 0; s < 4; ++s) { bf16x8 bb[8];
#pragma unroll
            for (int n = 0; n < 8; ++n) bb[n] = frag_row(Kt, LQ, 16 * n, 32 * s, lane);
            SCHED_FENCE();
#pragma unroll
            for (int n = 0; n < 8; ++n) sc[n] = MFMA16(bb[n], aq[s], sc[n]); }
        if (diag) {
#pragma unroll
            for (int n = 0; n < 8; ++n)
#pragma unroll
                for (int r = 0; r < 4; ++r) sc[n][r] = (16 * n + r <= qrel) ? sc[n][r] : -1e30f; }
        const bool rowok = own || ((sel >> kb) & 1u);
        float mx = -1e30f;
#pragma unroll
        for (int n = 0; n < 8; ++n) mx = fmaxf(mx, fmaxf(fmaxf(sc[n][0], sc[n][1]), fmaxf(sc[n][2], sc[n][3])));
        mx = fmaxf(mx, __shfl_xor(mx, 16)); mx = fmaxf(mx, __shfl_xor(mx, 32));
        const float mnew = rowok ? fmaxf(mq, mx) : mq;
        const float alpha = __builtin_amdgcn_exp2f(mq - mnew); mq = mnew;
        const float msub = rowok ? mnew : 1e30f;
        float ps = 0.f;
#pragma unroll
        for (int n = 0; n < 8; ++n)
#pragma unroll
            for (int r = 0; r < 4; ++r) { sc[n][r] = __builtin_amdgcn_exp2f(sc[n][r] - msub); ps += sc[n][r]; }
        lq = lq * alpha + ps;
        { const LAS float* rrt = RR + (kt & 1) * 128 + 4 * g;
#pragma unroll
          for (int n = 0; n < 8; ++n) sc[n] = sc[n] * *(const LAS f32x4*)(rrt + 16 * n); }
        if (!__all(alpha == 1.0f)) {
#pragma unroll
            for (int n = 0; n < 8; ++n) acco[n] = acco[n] * alpha; }
#pragma unroll
        for (int t = 0; t < 4; ++t) {
            const v4u pw = (v4u){pk2(sc[2 * t][0], sc[2 * t][1]), pk2(sc[2 * t][2], sc[2 * t][3]), pk2(sc[2 * t + 1][0], sc[2 * t + 1][1]), pk2(sc[2 * t + 1][2], sc[2 * t + 1][3])};
            const bf16x8 pf = __builtin_bit_cast(bf16x8, pw); bf16x8 bb[8];
#pragma unroll
            for (int n = 0; n < 8; ++n) bb[n] = frag_trp(Vt, 32 * t, 16 * n, lane);
            SCHED_FENCE();
#pragma unroll
            for (int n = 0; n < 8; ++n) acco[n] = MFMA16(bb[n], pf, acco[n]); }
        if (kt + 1 < ntiles) { MB_STAGE((kt + 1) & 1); if (kt + 2 < ntiles) MB_FETCH((kt + 2) * 128); }
        __syncthreads();
    }
    lq += __shfl_xor(lq, 16); lq += __shfl_xor(lq, 32);
    const float inv = 1.0f / lq;
    bf16* yr = WSP(bf16, WS_Y) + (size_t)2 * M * 1024 + (size_t)(b * SEQ + q0 + 16 * w + i16) * 1024 + h * 128 + 4 * g;
#pragma unroll
    for (int n = 0; n < 8; ++n) *(v2u*)(yr + 16 * n) = (v2u){pk2(acco[n][0] * inv, acco[n][1] * inv), pk2(acco[n][2] * inv, acco[n][3] * inv)};
#undef MB_FETCH
#undef MB_STAGE
}
__device__ __forceinline__ void mix_phase(Frame& F, const float* rgn, const float* mln, const float* qn, unsigned* head) {
    volatile LAS unsigned* slot = F.MISC;
    for (;;) {
        if (F.tid == 0) slot[0] = __hip_atomic_fetch_add(head, 1u, __ATOMIC_RELAXED, __HIP_MEMORY_SCOPE_AGENT);
        __syncthreads();
        const unsigned it = slot[0];
        __syncthreads();
        if (it >= 128u + 1024u) break;
        { int t_ = threadIdx.x; asm volatile("" : "+v"(t_)); F.tid = t_; F.lane = t_ & 63; }
        if (it < 64u) ret_unit(F, rgn, (int)(it >> 3), (int)(it & 7u));
        else if (it < 128u) mlstm_unit(F, mln, (int)((it - 64u) >> 3), (int)(it & 7u));
        else { const unsigned rank = it - 128u; moba_unit(F, qn, (int)((rank & 63u) >> 3), (int)(rank & 7u), 15 - (int)(rank >> 6)); }
    }
}
}
constexpr int N_PHASES = 1 + 8 * DEPTH;
__global__ void __launch_bounds__(NWAVES * 64, 2) fwd(Args args) {
    extern __shared__ __attribute__((aligned(16))) unsigned char lds[];
    Frame F;
    F.lds = (LAS unsigned char*)lds;
    F.MISC = (volatile LAS unsigned*)(F.lds + MISC_OFF);
    F.tid = threadIdx.x; F.lane = F.tid & 63; F.wave = __builtin_amdgcn_readfirstlane(F.tid >> 6); F.G = gridDim.x; F.bx = blockIdx.x;
    F.ws = args.ws;
    for (int u = F.tid; u < (LDS_BYTES - LDSCTL_OFF) / 4; u += NWAVES * 64) ((LAS unsigned*)(F.lds + LDSCTL_OFF))[u] = 0u;
    __syncthreads();
    XcdBarrier bar = xcd_barrier_post((unsigned*)(F.ws + WS_CTL) + CW_BAR + args.li * XCD_BAR_WORDS, F.MISC + 8);
    const int lo = args.ph_lo, hi = args.ph_hi;
#define RUN(p) (lo <= (p) && (p) < hi)
#define SEAM(p) do { if ((p) + 1 < hi) xcd_barrier(bar); } while (0)
    if (RUN(0)) { p0_prologue(F, args); SEAM(0); }
    for (int l = 0; l < DEPTH; ++l) {
        const int p0 = 1 + 8 * l;
        { int t_ = threadIdx.x; asm volatile("" : "+v"(t_)); F.tid = t_; F.lane = t_ & 63; F.wave = __builtin_amdgcn_readfirstlane(t_ >> 6); int b_ = blockIdx.x; asm volatile("" : "+s"(b_)); F.bx = b_; }
        float* rs = WSP(float, WS_RS) + (size_t)(2 * l) * M * 32;
        if (RUN(p0 + 0)) {
            pg8::Gemm g{WSP(bf16, WS_XB), WSP(bf16, WS_WIN) + (size_t)l * NZ * DM, M, NZ, DM}; pg8::StaticOrder S; S.init(M, NZ, F.G, F.bx);
            pg8::EpiBf16 E{WSP(bf16, WS_Z), NZ, F.ws + WS_ZG, Z_GA / 256, 3 * DM};
            pg8::gemm_phase<pg8::EpiBf16, pg8::StaticOrder, false, true>(F.lds + RING_OFF, g, S, E);
            SEAM(p0 + 0); }
        if (RUN(p0 + 1)) { prep_phase(F, args.in[I_QN] + l * 128, args.in[I_KN] + l * 128, WSP(bf16, WS_W16G) + (size_t)l * 16 * DM, rs, args.in[I_BIG] + l * 8, args.in[I_BFG] + l * 8); SEAM(p0 + 1); }
        if (RUN(p0 + 2)) { mx::mix_phase(F, args.in[I_RGN] + l * 1024, args.in[I_MLN] + l * 1024, args.in[I_QN] + l * 128, (unsigned*)(F.ws + WS_CTL) + CW_QUEUE + 64 * l); SEAM(p0 + 2); }
        if (RUN(p0 + 3)) {
            pg8::StaticOrder3 S; S.init(M, DM, F.G, F.bx);
            pg8::Gemm g{WSP(bf16, WS_Y), WSP(bf16, WS_WP) + (size_t)l * 3 * DM * 1024, M, DM, 1024, (size_t)M * 1024, (size_t)DM * 1024}; pg8::EpiGateAcc E{WSP(bf16, WS_MG), DM, F.ws + WS_ZG, 3 * DM, WSP(float, WS_RSTD)};
            pg8::gemm_phase<pg8::EpiGateAcc, pg8::StaticOrder3, true, true>(F.lds + RING_OFF, g, S, E);
            SEAM(p0 + 3); }
        if (RUN(p0 + 4)) {
            pg8::Gemm g{WSP(bf16, WS_MG), WSP(bf16, WS_WOUT) + (size_t)l * DM * DM, M, DM, DM}; pg8::StaticOrder S; S.init(M, DM, F.G, F.bx);
            pg8::EpiRes<false> E{WSP(bf16, WS_XB), rs + (size_t)32 * M, nullptr, DM};
            pg8::gemm_phase<pg8::EpiRes<false>, pg8::StaticOrder, true, true>(F.lds + RING_OFF, g, S, E);
            SEAM(p0 + 4); }
        if (RUN(p0 + 5)) {
            pg8::Gemm g{WSP(bf16, WS_XB), WSP(bf16, WS_WUP) + (size_t)l * NUP * DM, M, NUP, DM}; pg8::StaticOrder S; S.init(M, NUP, F.G, F.bx);
            pg8::EpiGLU E{WSP(bf16, WS_ACT), args.in[I_CW] + (size_t)l * 3 * NUP, args.in[I_CB] + (size_t)l * NUP, rs + (size_t)32 * M, WSP(bf16, WS_SB)};
            pg8::gemm_phase<pg8::EpiGLU, pg8::StaticOrder, false, true>(F.lds + RING_OFF, g, S, E);
            SEAM(p0 + 5); }
        if (RUN(p0 + 6)) { glu_fix_phase(F, args.in[I_CW] + (size_t)l * 3 * NUP, args.in[I_CB] + (size_t)l * NUP); SEAM(p0 + 6); }
        if (RUN(p0 + 7)) {
            pg8::Gemm g{WSP(bf16, WS_ACT), WSP(bf16, WS_WDN) + (size_t)l * DM * DFF, M, DM, DFF}; pg8::StaticOrder S; S.init(M, DM, F.G, F.bx);
            if (l + 1 < DEPTH) { pg8::EpiRes<false> E{WSP(bf16, WS_XB), rs + (size_t)64 * M, nullptr, DM};
                pg8::gemm_phase<pg8::EpiRes<false>, pg8::StaticOrder, true, true>(F.lds + RING_OFF, g, S, E); }
            else { pg8::EpiRes<true> E{WSP(bf16, WS_XB), nullptr, args.out, DM};
                pg8::gemm_phase<pg8::EpiRes<true>, pg8::StaticOrder, true, true>(F.lds + RING_OFF, g, S, E); }
            SEAM(p0 + 7); }
    }
#undef RUN
#undef SEAM
}

#ifndef MK_N_LAUNCHES
#define MK_N_LAUNCHES 1
#endif
extern "C" void kernel_launch(void* const* d_in, const int* in_sizes, int n_in, void* d_out, int out_size, void* d_ws, size_t ws_size, hipStream_t stream) {
    static int grid = 0;
    if (grid == 0) {
        if (n_in != 18 || in_sizes[0] != M * DM || out_size != M * DM || ws_size < WS_END) { fprintf(stderr, "kernel_launch: unexpected shapes (n_in %d, in0 %d, out %d, ws %zu)\n", n_in, n_in > 0 ? in_sizes[0] : -1, out_size, ws_size); grid = -1; return; }
        int dev = 0, cus = 0, per_cu = 0;
        if (hipGetDevice(&dev) != hipSuccess || hipDeviceGetAttribute(&cus, hipDeviceAttributeMultiprocessorCount, dev) != hipSuccess) { grid = -1; return; }
        if (hipFuncSetAttribute((const void*)fwd, hipFuncAttributeMaxDynamicSharedMemorySize, LDS_BYTES) != hipSuccess) { fprintf(stderr, "kernel_launch: hipFuncSetAttribute failed\n"); grid = -1; return; }
        if (hipOccupancyMaxActiveBlocksPerMultiprocessor(&per_cu, (const void*)fwd, NWAVES * 64, LDS_BYTES) != hipSuccess || per_cu < 1) fprintf(stderr, "kernel_launch: occupancy query reports %d\n", per_cu);
        (void)hipGetLastError();
        grid = cus;
    }
    if (grid < 0) return;
    if (hipMemsetAsync((char*)d_ws + WS_CTL, 0, CTL_ZERO_BYTES, stream) != hipSuccess) return;
    Args a{};
    for (int i = 0; i < 18; ++i) a.in[i] = (const float*)d_in[i];
    a.out = (float*)d_out; a.ws = (unsigned char*)d_ws; a.pad = 0;
    constexpr int NL = MK_N_LAUNCHES;
    for (int li = 0; li < NL; ++li) {
        a.ph_lo = (NL == 1) ? 0 : li; a.ph_hi = (NL == 1) ? N_PHASES : li + 1; a.li = (NL == 1) ? 0 : 0;
        hipLaunchKernelGGL(fwd, dim3(grid), dim3(NWAVES * 64), LDS_BYTES, stream, a);
    }
}
```

```cpp
#include <hip/hip_runtime.h>
#include <cstdio>
#include <cstdint>
namespace pg8 {
#define PG8_LAS __attribute__((address_space(3)))
typedef unsigned short bf16_t;
typedef short bf16x8 __attribute__((ext_vector_type(8)));
typedef float f32x4 __attribute__((ext_vector_type(4)));
typedef unsigned u32x4 __attribute__((ext_vector_type(4)));
constexpr int BM = 256, BK = 64, HALF = 128, HTB = HALF * BK * 2  , STAGE_BYTES = 8 * HTB, NXCD = 8, WGM = 8;

__host__ __device__ __forceinline__ int lds_byte(int r, int c) { const int st = (r >> 4) * 2 + (c >> 5), rr = r & 15, cc = c & 31, ob = rr * 64 + cc * 2; return st * 1024 + (ob ^ (((ob >> 9) & 1) << 5)); }
__host__ __device__ __forceinline__ void stage_rc(int b, int& R, int& C) { const int st = b / 1024, sb = b % 1024, swz = sb ^ (((sb >> 9) & 1) << 5); R = (st >> 1) * 16 + swz / 64; C = (st & 1) * 32 + (swz % 64) / 2; }
__host__ __device__ __forceinline__ int perm32(int rho) { const int n = rho >> 4, i = rho & 15; return 8 * (i >> 2) + 4 * n + (i & 3); }

struct Unit { int pm, pn, z; };
struct Gemm { const bf16_t* A; const bf16_t* Bt; int M, N, K; size_t zA, zB; };

struct StaticOrder {
    int nM, nN, nwg, G, c;
    __host__ __device__ void init(int M, int N, int G_, int c_) { nM = M / BM; nN = N / BM; nwg = nM * nN; G = G_; c = c_; }
    __host__ __device__ bool next(int i, Unit& u) const {
        const long L = (long)i * G + c; if (L >= nwg) return false;
        int wgid = (int)L; { const int q = nwg / NXCD, r = nwg % NXCD, xcd = wgid % NXCD, off = wgid / NXCD; wgid = (xcd < r ? xcd * (q + 1) : r * (q + 1) + (xcd - r) * q) + off; }
        const int nig = WGM * nN, gid = wgid / nig, fm = gid * WGM, gsz = (nM - fm) < WGM ? (nM - fm) : WGM;
        u.pm = fm + ((wgid % nig) % gsz); u.pn = (wgid % nig) / gsz; u.z = 0; return true;
    }
    __device__ __forceinline__ void a_ready(const Unit&) const {}
    __device__ __forceinline__ void done(const Unit&) const {}
};

struct SkipOrder : StaticOrder {
    int skip0, nskip;
    __host__ __device__ bool next(int i, Unit& u) const { if (!StaticOrder::next(i, u)) return false; if (u.pn >= skip0) u.pn += nskip; return true; }
};
template <class Base> struct RangeOrder {
    Base b; int i0, n;
    __host__ __device__ bool next(int i, Unit& u) const { return i < n && b.next(i0 + i, u); }
    __device__ __forceinline__ void a_ready(const Unit&) const {}
    __device__ __forceinline__ void done(const Unit&) const {}
};
struct StaticOrder3 : StaticOrder {
    __host__ __device__ bool next(int i, Unit& u) const { if (!StaticOrder::next(i / 3, u)) return false; u.z = i % 3; return true; }
};
__device__ __forceinline__ unsigned cvt_pk_bf16(float lo, float hi) { unsigned r; asm volatile("v_cvt_pk_bf16_f32 %0, %1, %2" : "=v"(r) : "v"(lo), "v"(hi)); return r; }
typedef unsigned u32x2 __attribute__((ext_vector_type(2)));
typedef float f32x2 __attribute__((ext_vector_type(2)));
__device__ __forceinline__ u32x4 qgather(const u32x4 w, int lane) { const int src = 4 * (16 * (lane & 3) + (lane >> 2)); u32x4 o;
#pragma unroll
    for (int k = 0; k < 4; ++k) o[k] = (unsigned)__builtin_amdgcn_ds_bpermute(src, (int)w[k]); return o; }
__device__ __forceinline__ u32x4 qscatter(const u32x4 w, int lane) { const int src = 4 * (4 * (lane & 15) + (lane >> 4)); u32x4 o;
#pragma unroll
    for (int k = 0; k < 4; ++k) o[k] = (unsigned)__builtin_amdgcn_ds_bpermute(src, (int)w[k]); return o; }
struct EpiBf16 {
    static constexpr bool PERM = true, AFTER_DRAIN = false, KEEP = false, APERM = false;
    bf16_t* O; int ldc; unsigned char* G8; int g8_pn0, g8_ld;
    __device__ __forceinline__ void operator()(const f32x4 (&acc)[2][2][4][2], const Unit& u, int wr, int wc, int fr, int fq) const {
        const int lane = 16 * fq + fr; const int row0 = u.pm * BM + wr * 64 + (lane >> 2); const int col0 = u.pn * BM + wc * 32 + 8 * (lane & 3);
#pragma unroll
        for (int ai = 0; ai < 2; ++ai)
#pragma unroll
            for (int m = 0; m < 4; ++m) { bf16_t* rowp = O + (size_t)(row0 + ai * HALF + m * 16) * ldc + col0;
#pragma unroll
                for (int bj = 0; bj < 2; ++bj) { const f32x4 v0 = acc[ai][bj][m][0], v1 = acc[ai][bj][m][1];
                    u32x4 w; w.x = cvt_pk_bf16(v0[0], v0[1]); w.y = cvt_pk_bf16(v0[2], v0[3]); w.z = cvt_pk_bf16(v1[0], v1[1]); w.w = cvt_pk_bf16(v1[2], v1[3]);
                    *(u32x4*)(rowp + bj * HALF) = qgather(w, lane); } }
    }
};
struct EpiGate8 {
    static constexpr bool PERM = true, AFTER_DRAIN = false, KEEP = false, APERM = false;
    unsigned char* G8; int g8_ld; float sc; bf16_t* O; int ldc, o_pn0, o_col0;
    __device__ __forceinline__ void operator()(const f32x4 (&acc)[2][2][4][2], const Unit& u, int wr, int wc, int fr, int fq) const {
        const int lane = 16 * fq + fr; const int row0 = u.pm * BM + wr * 64 + (lane >> 2); const int pc = wc * 32 + 8 * (lane & 3);
        if (u.pn >= o_pn0) { const int col0 = o_col0 + (u.pn - o_pn0) * BM + pc;
#pragma unroll
            for (int ai = 0; ai < 2; ++ai)
#pragma unroll
                for (int m = 0; m < 4; ++m) { bf16_t* rowp = O + (size_t)(row0 + ai * HALF + m * 16) * ldc + col0;
#pragma unroll
                    for (int bj = 0; bj < 2; ++bj) { const f32x4 v0 = acc[ai][bj][m][0] * sc, v1 = acc[ai][bj][m][1] * sc;
                        u32x4 w; w.x = cvt_pk_bf16(v0[0], v0[1]); w.y = cvt_pk_bf16(v0[2], v0[3]); w.z = cvt_pk_bf16(v1[0], v1[1]); w.w = cvt_pk_bf16(v1[2], v1[3]);
                        *(u32x4*)(rowp + bj * HALF) = qgather(w, lane); } }
            return; }
        const int gc0 = u.pn * BM + pc; const int src = 4 * (16 * (lane & 3) + (lane >> 2));
#pragma unroll
        for (int ai = 0; ai < 2; ++ai)
#pragma unroll
            for (int m = 0; m < 4; ++m) { unsigned char* rowp = G8 + (size_t)(row0 + ai * HALF + m * 16) * g8_ld + gc0;
#pragma unroll
                for (int bj = 0; bj < 2; ++bj) { const f32x4 v0 = acc[ai][bj][m][0] * sc, v1 = acc[ai][bj][m][1] * sc; u32x2 w;
                    w.x = (unsigned)__builtin_amdgcn_cvt_pk_fp8_f32(v0[2], v0[3], __builtin_amdgcn_cvt_pk_fp8_f32(v0[0], v0[1], 0, false), true);
                    w.y = (unsigned)__builtin_amdgcn_cvt_pk_fp8_f32(v1[2], v1[3], __builtin_amdgcn_cvt_pk_fp8_f32(v1[0], v1[1], 0, false), true);
                    w.x = (unsigned)__builtin_amdgcn_ds_bpermute(src, (int)w.x); w.y = (unsigned)__builtin_amdgcn_ds_bpermute(src, (int)w.y);
                    *(u32x2*)(rowp + bj * HALF) = w; } }
    }
};
__device__ __forceinline__ float bf_lo(unsigned w) { return __uint_as_float(w << 16); }
__device__ __forceinline__ float bf_hi(unsigned w) { return __uint_as_float(w & 0xffff0000u); }
__device__ __forceinline__ float sigmoid_f(float x) { return __builtin_amdgcn_rcpf(1.0f + __expf(-x)); }
struct EpiGateAcc {
    static constexpr bool PERM = true, AFTER_DRAIN = false, KEEP = true, APERM = false;
    bf16_t* O; int ldc; const unsigned char* G8; int g8_ld; const float* rstd;
    __device__ __forceinline__ void operator()(f32x4 (&acc)[2][2][4][2], const Unit& u, int wr, int wc, int fr, int fq) const {
        const int row0 = u.pm * BM + wr * 64 + fr; const int col0 = u.pn * BM + wc * 32 + 8 * fq; const bool last = (u.z == 2);
        const unsigned char* Gn = G8 + (size_t)u.z * ldc; const unsigned char* Gd = G8 + (size_t)(last ? u.z : u.z + 1) * ldc;
#pragma unroll
        for (int ai = 0; ai < 2; ++ai)
#pragma unroll
            for (int m = 0; m < 4; ++m) { const size_t row = (size_t)(row0 + ai * HALF + m * 16); const float r2 = rstd[row] * -1.44269504f;
#pragma unroll
                for (int bj = 0; bj < 2; ++bj) {
                    const u32x2 gn = *(const u32x2*)(Gn + row * g8_ld + col0 + bj * HALF), gd = *(const u32x2*)(Gd + row * g8_ld + col0 + bj * HALF);
                    f32x4 v0 = acc[ai][bj][m][0], v1 = acc[ai][bj][m][1];
                    f32x2 q0, q1, q2, q3;
#define GA_UN(W, P) (__builtin_amdgcn_cvt_pk_f32_fp8((int)(W), P) * r2)
#define GA_RC(X, Q) { Q.x = __builtin_amdgcn_rcpf(1.0f + __builtin_amdgcn_exp2f(fminf(X.x, 57.70780f))); Q.y = __builtin_amdgcn_rcpf(1.0f + __builtin_amdgcn_exp2f(fminf(X.y, 57.70780f))); }
#define GA_UD(X, Q) { f32x2 ud; ud.x = 1.0f + __builtin_amdgcn_exp2f(fminf(X.x, 57.70780f)); ud.y = 1.0f + __builtin_amdgcn_exp2f(fminf(X.y, 57.70780f)); Q *= ud; }
                    { const f32x2 a0 = GA_UN(gn.x, false), a1 = GA_UN(gn.x, true), a2 = GA_UN(gn.y, false), a3 = GA_UN(gn.y, true); GA_RC(a0, q0) GA_RC(a1, q1) GA_RC(a2, q2) GA_RC(a3, q3) }
                    if (!last) { const f32x2 d0 = GA_UN(gd.x, false), d1 = GA_UN(gd.x, true), d2 = GA_UN(gd.y, false), d3 = GA_UN(gd.y, true); GA_UD(d0, q0) GA_UD(d1, q1) GA_UD(d2, q2) GA_UD(d3, q3) }
#undef GA_UN
#undef GA_RC
#undef GA_UD
                    v0 *= (f32x4){q0.x, q0.y, q1.x, q1.y}; v1 *= (f32x4){q2.x, q2.y, q3.x, q3.y};
                    acc[ai][bj][m][0] = v0; acc[ai][bj][m][1] = v1;
                    if (last) { u32x4 w; w.x = cvt_pk_bf16(v0[0], v0[1]); w.y = cvt_pk_bf16(v0[2], v0[3]); w.z = cvt_pk_bf16(v1[0], v1[1]); w.w = cvt_pk_bf16(v1[2], v1[3]); *(u32x4*)(O + row * ldc + col0 + bj * HALF) = w; } } }
    }
};
template <bool LAST, bool F8 = false> struct EpiRes {
    static constexpr bool PERM = true, AFTER_DRAIN = false, KEEP = false, APERM = false;
    bf16_t* xb; float* rs; float* out; int ldc; unsigned char* x8;
    __device__ __forceinline__ void operator()(const f32x4 (&acc)[2][2][4][2], const Unit& u, int wr, int wc, int fr, int fq) const {
        const int row0 = u.pm * BM + wr * 64 + fr; const int col0 = u.pn * BM + wc * 32 + 8 * fq;
#pragma unroll
        for (int ai = 0; ai < 2; ++ai)
#pragma unroll
            for (int m = 0; m < 4; ++m) { const int row = row0 + ai * HALF + m * 16; const size_t off = (size_t)row * ldc + col0; float sq = 0.f;
#pragma unroll
                for (int bj = 0; bj < 2; ++bj) { const u32x4 p = *(const u32x4*)(xb + off + bj * HALF); const f32x4 v0 = acc[ai][bj][m][0], v1 = acc[ai][bj][m][1];
                    const float o0 = bf_lo(p.x) + v0[0], o1 = bf_hi(p.x) + v0[1], o2 = bf_lo(p.y) + v0[2], o3 = bf_hi(p.y) + v0[3], o4 = bf_lo(p.z) + v1[0], o5 = bf_hi(p.z) + v1[1], o6 = bf_lo(p.w) + v1[2], o7 = bf_hi(p.w) + v1[3];
                    if (LAST) { *(f32x4*)(out + off + bj * HALF) = (f32x4){o0, o1, o2, o3}; *(f32x4*)(out + off + bj * HALF + 4) = (f32x4){o4, o5, o6, o7}; }
                    else { sq += ((o0 * o0 + o1 * o1) + (o2 * o2 + o3 * o3)) + ((o4 * o4 + o5 * o5) + (o6 * o6 + o7 * o7));
                        u32x4 w; w.x = cvt_pk_bf16(o0, o1); w.y = cvt_pk_bf16(o2, o3); w.z = cvt_pk_bf16(o4, o5); w.w = cvt_pk_bf16(o6, o7); *(u32x4*)(xb + off + bj * HALF) = w;
                        if (F8) { u32x2 q; q.x = (unsigned)__builtin_amdgcn_cvt_pk_fp8_f32(o2, o3, __builtin_amdgcn_cvt_pk_fp8_f32(o0, o1, 0, false), true); q.y = (unsigned)__builtin_amdgcn_cvt_pk_fp8_f32(o6, o7, __builtin_amdgcn_cvt_pk_fp8_f32(o4, o5, 0, false), true);
                            *(u32x2*)(x8 + off + bj * HALF) = q; } } }
                if (!LAST) { sq += __shfl_xor(sq, 16); sq += __shfl_xor(sq, 32); if (fq == 0) rs[(size_t)row * 32 + u.pn * 4 + wc] = sq; } }
    }
};

struct EpiGLU {
    static constexpr bool PERM = true, AFTER_DRAIN = false, KEEP = false, APERM = true;
    bf16_t* ACT; const float* cw; const float* cb; const float* rs; bf16_t* SB;
    static __device__ __forceinline__ f32x4 prev_lane(const f32x4 v, int src) { f32x4 o;
#pragma unroll
        for (int k = 0; k < 4; ++k) o[k] = __shfl(v[k], src); return o; }
    static __device__ __forceinline__ f32x4 silu4(const f32x4 a) { f32x4 o;
#pragma unroll
        for (int k = 0; k < 4; ++k) o[k] = a[k] * __builtin_amdgcn_rcpf(1.0f + __expf(-a[k])); return o; }
    __device__ __forceinline__ void operator()(const f32x4 (&acc)[2][2][4][2], const Unit& u, int wr, int wc, int fr, int fq) const {
        constexpr int DFF_ = 5632, NUP_ = 2 * DFF_;
        const int T0 = u.pm * BM + 8 * (16 * wr + fr), jq = u.pn * HALF + wc * 32 + 8 * fq, grp = 2 * u.pm + wr;
        const int lane = 16 * fq + fr, qsrc = 4 * (16 * (lane & 3) + (lane >> 2)), Tq = u.pm * BM + 8 * (16 * wr + (lane >> 2)), jqq = u.pn * HALF + wc * 32 + 8 * (lane & 3);
        float s0 = 0.f, s1 = 0.f;
        { const int L = fq * 16 + fr; const float* p0 = rs + (size_t)(u.pm * BM + 128 * wr + 2 * L) * 32;
#pragma unroll
          for (int q = 0; q < 8; ++q) { const f32x4 a = *(const f32x4*)(p0 + 4 * q), b = *(const f32x4*)(p0 + 32 + 4 * q); s0 += (a[0] + a[1]) + (a[2] + a[3]); s1 += (b[0] + b[1]) + (b[2] + b[3]); }
          s0 = __builtin_amdgcn_rsqf(s0 * (1.0f / 2048.0f) + 1e-6f); s1 = __builtin_amdgcn_rsqf(s1 * (1.0f / 2048.0f) + 1e-6f); }
        float rr[8];
#pragma unroll
        for (int i = 0; i < 8; ++i) rr[i] = __shfl((i & 1) ? s1 : s0, 4 * fr + (i >> 1));
#pragma unroll
        for (int n = 0; n < 2; ++n) { const int j = jq + 4 * n;
            const f32x4 ca = *(const f32x4*)(cb + j), cbv = *(const f32x4*)(cb + DFF_ + j);
            const f32x4 a0 = *(const f32x4*)(cw + j), a1 = *(const f32x4*)(cw + NUP_ + j), a2 = *(const f32x4*)(cw + 2 * NUP_ + j);
            const f32x4 b0 = *(const f32x4*)(cw + DFF_ + j), b1 = *(const f32x4*)(cw + NUP_ + DFF_ + j), b2 = *(const f32x4*)(cw + 2 * NUP_ + DFF_ + j);
            f32x4 va[8], vb[8];
#pragma unroll
            for (int i = 0; i < 8; ++i) { va[i] = acc[i >> 2][0][i & 3][n] * rr[i]; vb[i] = acc[i >> 2][1][i & 3][n] * rr[i]; }
            const int psrc = fq * 16 + ((fr + 15) & 15); const f32x4 pa6 = prev_lane(va[6], psrc), pa7 = prev_lane(va[7], psrc), pb6 = prev_lane(vb[6], psrc), pb7 = prev_lane(vb[7], psrc);
#pragma unroll
            for (int i = 0; i < 8; ++i) {
                const f32x4 xa1 = i >= 1 ? va[i - 1] : pa7, xa2 = i >= 2 ? va[i - 2] : (i == 1 ? pa7 : pa6), xb1 = i >= 1 ? vb[i - 1] : pb7, xb2 = i >= 2 ? vb[i - 2] : (i == 1 ? pb7 : pb6);
                const f32x4 ua = ca + a0 * xa2 + a1 * xa1 + a2 * va[i], ub = cbv + b0 * xb2 + b1 * xb1 + b2 * vb[i];
                const f32x4 o = silu4(ua) * ub;
                { u32x2 w; w.x = cvt_pk_bf16(o[0], o[1]); w.y = cvt_pk_bf16(o[2], o[3]);
                  w.x = (unsigned)__builtin_amdgcn_ds_bpermute(qsrc, (int)w.x); w.y = (unsigned)__builtin_amdgcn_ds_bpermute(qsrc, (int)w.y);
                  if (i >= 2 || (lane >> 2) != 0) *(u32x2*)(ACT + (size_t)(Tq + i) * DFF_ + jqq + 4 * n) = w; } }
            if (fr == 0) {
#pragma unroll
                for (int i = 0; i < 2; ++i) { u32x2 w; w.x = cvt_pk_bf16(va[i][0], va[i][1]); w.y = cvt_pk_bf16(va[i][2], va[i][3]); *(u32x2*)(SB + ((size_t)grp * 4 + 2 + i) * NUP_ + j) = w;
                    w.x = cvt_pk_bf16(vb[i][0], vb[i][1]); w.y = cvt_pk_bf16(vb[i][2], vb[i][3]); *(u32x2*)(SB + ((size_t)grp * 4 + 2 + i) * NUP_ + DFF_ + j) = w; } }
            if (fr == 15) {
#pragma unroll
                for (int i = 0; i < 2; ++i) { u32x2 w; w.x = cvt_pk_bf16(va[6 + i][0], va[6 + i][1]); w.y = cvt_pk_bf16(va[6 + i][2], va[6 + i][3]); *(u32x2*)(SB + ((size_t)(grp + 1) * 4 + i) * NUP_ + j) = w;
                    w.x = cvt_pk_bf16(vb[6 + i][0], vb[6 + i][1]); w.y = cvt_pk_bf16(vb[6 + i][2], vb[6 + i][3]); *(u32x2*)(SB + ((size_t)(grp + 1) * 4 + i) * NUP_ + DFF_ + j) = w; } }
        }
    }
};

template <class E, class = void> struct EpiB64 { static constexpr bool v = false; };
template <class E> struct EpiB64<E, decltype((void)E::B64)> { static constexpr bool v = E::B64; };
typedef int i32x4_t __attribute__((ext_vector_type(4)));
typedef int i32x8_t __attribute__((ext_vector_type(8)));
__device__ __forceinline__ i32x8_t cat8(const bf16x8 a, const bf16x8 b) { return __builtin_shufflevector((i32x4_t)a, (i32x4_t)b, 0, 1, 2, 3, 4, 5, 6, 7); }
template <class Epi, class Sched, bool ALIGN_EPI = false, bool SP2 = false, bool F8 = false>
__device__ __forceinline__ void gemm_phase(PG8_LAS unsigned char* lds, const Gemm g, const Sched& S, const Epi& E) {
    int tid_ = threadIdx.x; asm volatile("" : "+v"(tid_));
    const int tid = tid_, wid = __builtin_amdgcn_readfirstlane(tid >> 6), lane = tid & 63, wr = wid >> 2, wc = wid & 3, fr = lane & 15, fq = lane >> 4;
    const int K = g.K, nt = K / BK;
    unsigned voffA[2], voffB[2];
#pragma unroll
    for (int i = 0; i < 2; ++i) { int R, C; stage_rc(tid * 16 + i * 8192, R, C); const int Rb = EpiB64<Epi>::v ? (2 * (R & ~31) + perm32(R & 31)) : Epi::PERM ? ((R & ~31) + perm32(R & 31)) : R;
        const int Ra = Epi::APERM ? (8 * (16 * (R >> 6) + (R & 15)) + ((R >> 4) & 3)) : R;
        voffA[i] = (unsigned)(Ra * K + C) * 2u; voffB[i] = (unsigned)(Rb * K + C) * 2u; }
    const size_t kstep = (size_t)(BK * 2);
    const size_t hstep = (size_t)HALF * K * 2;
    const size_t hstepA = Epi::APERM ? (size_t)4 * K * 2 : hstep;
    const size_t hstepB = EpiB64<Epi>::v ? (size_t)32 * K * 2 : hstep;
    const size_t tstep = 2 * hstep;
    const unsigned ldsw = (unsigned)wid * 1024u;
    const int aoff = lds_byte(wr * 64 + fr, fq * 8), boff = lds_byte(wc * 32 + fr, fq * 8);
#define PG8_SA(b, h) (((b) * 2 + (h)) * HTB)
#define PG8_SB(b, h) ((4 + (b) * 2 + (h)) * HTB)
#define PG8_STAGE(bufoff, gbase, voff) do { _Pragma("unroll") for (int _i = 0; _i < 2; ++_i) \
        __builtin_amdgcn_global_load_lds((const unsigned*)((const char*)(gbase) + (voff)[_i]), (PG8_LAS unsigned*)(lds + (bufoff) + ldsw + _i * 8192), 16, 0, 0); } while (0)
#define PG8_LDA(dst, b, h) do { _Pragma("unroll") for (int m = 0; m < 4; ++m) _Pragma("unroll") for (int k = 0; k < 2; ++k) dst[m][k] = *(const PG8_LAS bf16x8*)(lds + PG8_SA(b, h) + aoff + m * 2048 + k * 1024); } while (0)
#define PG8_LDB(dst, b, h) do { _Pragma("unroll") for (int n = 0; n < 2; ++n) _Pragma("unroll") for (int k = 0; k < 2; ++k) dst[n][k] = *(const PG8_LAS bf16x8*)(lds + PG8_SB(b, h) + boff + n * 2048 + k * 1024); } while (0)
#define PG8_MMA(ai, bj, At, Bt) do { __builtin_amdgcn_s_setprio(1); if constexpr (F8) { _Pragma("unroll") for (int m = 0; m < 4; ++m) _Pragma("unroll") for (int n = 0; n < 2; ++n) \
        asm volatile("v_mfma_f32_16x16x128_f8f6f4 %0, %1, %2, %0" : "+v"(acc[ai][bj][m][n]) : "v"(cat8(Bt[n][0], Bt[n][1])), "v"(cat8(At[m][0], At[m][1]))); } else { \
        _Pragma("unroll") for (int m = 0; m < 4; ++m) _Pragma("unroll") for (int n = 0; n < 2; ++n) _Pragma("unroll") for (int k = 0; k < 2; ++k) \
        acc[ai][bj][m][n] = __builtin_amdgcn_mfma_f32_16x16x32_bf16(Bt[n][k], At[m][k], acc[ai][bj][m][n], 0, 0, 0); } __builtin_amdgcn_s_setprio(0); } while (0)
#define PG8_WAIT_V(n) asm volatile("s_waitcnt vmcnt(" #n ")" ::: "memory")
#define PG8_WAIT_L(n) asm volatile("s_waitcnt lgkmcnt(" #n ")" ::: "memory")
#define PG8_BAR __builtin_amdgcn_s_barrier()
#define PG8_SCHED __builtin_amdgcn_sched_barrier(0)
    Unit cur, nxt; int ui = 0;
    if (!S.next(0, cur)) return;
    f32x4 acc[2][2][4][2];
#pragma unroll
    for (int a = 0; a < 2; ++a)
#pragma unroll
        for (int b = 0; b < 2; ++b)
#pragma unroll
            for (int m = 0; m < 4; ++m)
#pragma unroll
                for (int n = 0; n < 2; ++n) acc[a][b][m][n] = (f32x4){0.f, 0.f, 0.f, 0.f};
    bf16x8 At[4][2], B0[2][2], B1[2][2];
    const char* cA = (const char*)(g.A + (size_t)cur.z * g.zA) + (size_t)cur.pm * tstep; const char* cB = (const char*)(g.Bt + (size_t)cur.z * g.zB) + (size_t)cur.pn * tstep;
    S.a_ready(cur);
    if constexpr (SP2) {
        PG8_STAGE(PG8_SB(0, 0), cB, voffB); PG8_STAGE(PG8_SB(0, 1), cB + hstepB, voffB); PG8_STAGE(PG8_SA(0, 0), cA, voffA); PG8_STAGE(PG8_SA(0, 1), cA + hstepA, voffA);
        if (wr == 1) PG8_BAR;
        PG8_WAIT_V(2); PG8_BAR;
        PG8_STAGE(PG8_SB(1, 0), cB + kstep, voffB); PG8_STAGE(PG8_SA(1, 0), cA + kstep, voffA); PG8_STAGE(PG8_SB(1, 1), cB + hstepB + kstep, voffB);
        PG8_WAIT_V(6); PG8_BAR;
    } else {
        PG8_STAGE(PG8_SB(0, 0), cB, voffB); PG8_STAGE(PG8_SA(0, 0), cA, voffA); PG8_STAGE(PG8_SB(0, 1), cB + hstepB, voffB); PG8_STAGE(PG8_SA(0, 1), cA + hstepA, voffA);
        if (wr == 1) PG8_BAR;
        PG8_WAIT_V(4); PG8_BAR;
        PG8_STAGE(PG8_SB(1, 0), cB + kstep, voffB); PG8_STAGE(PG8_SA(1, 0), cA + kstep, voffA); PG8_STAGE(PG8_SB(1, 1), cB + hstepB + kstep, voffB);
        PG8_WAIT_V(6); PG8_BAR;
    }
    for (;;) {
        const bool has_next = S.next(ui + 1, nxt);
        const char* nA = has_next ? (const char*)(g.A + (size_t)nxt.z * g.zA) + (size_t)nxt.pm * tstep : cA; const char* nB = has_next ? (const char*)(g.Bt + (size_t)nxt.z * g.zB) + (size_t)nxt.pn * tstep : cB;
        for (int t = 0; t < nt; t += 2) {
            const bool last = (t == nt - 2);
            const char* a1 = cA + (size_t)(t + 1) * kstep;
            const char* a2 = last ? nA : cA + (size_t)(t + 2) * kstep; const char* b2 = last ? nB : cB + (size_t)(t + 2) * kstep;
            const char* a3 = a2 + kstep; const char* b3 = b2 + kstep;
            if (last && has_next) S.a_ready(nxt);
            if constexpr (SP2) {
            PG8_LDB(B0, 0, 0); PG8_LDB(B1, 0, 1); PG8_SCHED; PG8_LDA(At, 0, 0); PG8_STAGE(PG8_SA(1, 1), a1 + hstepA, voffA);
            PG8_WAIT_V(8); PG8_WAIT_L(0); PG8_BAR; PG8_MMA(0, 0, At, B0); PG8_MMA(0, 1, At, B1); PG8_BAR; PG8_SCHED;
            PG8_LDA(At, 0, 1); PG8_STAGE(PG8_SB(0, 0), b2, voffB); PG8_STAGE(PG8_SB(0, 1), b2 + hstepB, voffB); PG8_STAGE(PG8_SA(0, 0), a2, voffA);
            PG8_WAIT_V(8); PG8_WAIT_L(0); PG8_BAR; PG8_MMA(1, 0, At, B0); PG8_MMA(1, 1, At, B1); PG8_BAR; PG8_SCHED;
            PG8_LDB(B0, 1, 0); PG8_LDB(B1, 1, 1); PG8_SCHED; PG8_LDA(At, 1, 0); PG8_STAGE(PG8_SA(0, 1), a2 + hstepA, voffA);
            PG8_WAIT_V(8); PG8_WAIT_L(0); PG8_BAR; PG8_MMA(0, 0, At, B0); PG8_MMA(0, 1, At, B1); PG8_BAR; PG8_SCHED;
            PG8_LDA(At, 1, 1); PG8_STAGE(PG8_SB(1, 0), b3, voffB); PG8_STAGE(PG8_SB(1, 1), b3 + hstepB, voffB); PG8_STAGE(PG8_SA(1, 0), a3, voffA);
            PG8_WAIT_V(8); PG8_WAIT_L(0); PG8_BAR; PG8_MMA(1, 0, At, B0); PG8_MMA(1, 1, At, B1); PG8_BAR; PG8_SCHED;
            } else {
            PG8_LDB(B0, 0, 0); PG8_SCHED; PG8_LDA(At, 0, 0); PG8_STAGE(PG8_SA(1, 1), a1 + hstepA, voffA);
            PG8_WAIT_L(8); PG8_BAR; PG8_WAIT_L(0); PG8_MMA(0, 0, At, B0); PG8_BAR; PG8_SCHED;
            PG8_LDB(B1, 0, 1); PG8_STAGE(PG8_SB(0, 0), b2, voffB);
            PG8_BAR; PG8_WAIT_L(0); PG8_MMA(0, 1, At, B1); PG8_BAR;
            PG8_LDA(At, 0, 1); PG8_STAGE(PG8_SA(0, 0), a2, voffA);
            PG8_BAR; PG8_WAIT_L(0); PG8_MMA(1, 0, At, B0); PG8_BAR; PG8_SCHED;
            PG8_STAGE(PG8_SB(0, 1), b2 + hstepB, voffB);
            PG8_WAIT_V(6); PG8_BAR; PG8_MMA(1, 1, At, B1); PG8_BAR;
            PG8_LDB(B0, 1, 0); PG8_SCHED; PG8_LDA(At, 1, 0); PG8_STAGE(PG8_SA(0, 1), a2 + hstepA, voffA);
            PG8_WAIT_L(8); PG8_BAR; PG8_WAIT_L(0); PG8_MMA(0, 0, At, B0); PG8_BAR; PG8_SCHED;
            PG8_LDB(B1, 1, 1); PG8_STAGE(PG8_SB(1, 0), b3, voffB);
            PG8_BAR; PG8_WAIT_L(0); PG8_MMA(0, 1, At, B1); PG8_BAR;
            PG8_LDA(At, 1, 1); PG8_STAGE(PG8_SA(1, 0), a3, voffA);
            PG8_BAR; PG8_WAIT_L(0); PG8_MMA(1, 0, At, B0); PG8_BAR; PG8_SCHED;
            PG8_STAGE(PG8_SB(1, 1), b3 + hstepB, voffB);
            PG8_WAIT_V(6); PG8_BAR; PG8_MMA(1, 1, At, B1); PG8_BAR;
            }
        }
        if constexpr (F8) asm volatile("s_nop 15\n\ts_nop 15\n\ts_nop 15\n\ts_nop 15" ::: "memory");
        if constexpr (ALIGN_EPI) { if (wr == 0) PG8_BAR; }
        if constexpr (!Epi::AFTER_DRAIN) { E(acc, cur, wr, wc, fr, fq); S.done(cur); }
        if (!has_next) break;
        if (!(Epi::KEEP && nxt.z != 0)) {
#pragma unroll
        for (int a = 0; a < 2; ++a)
#pragma unroll
            for (int b = 0; b < 2; ++b)
#pragma unroll
                for (int m = 0; m < 4; ++m)
#pragma unroll
                    for (int n = 0; n < 2; ++n) acc[a][b][m][n] = (f32x4){0.f, 0.f, 0.f, 0.f};
        }
        cur = nxt; cA = nA; cB = nB; ++ui;
        if constexpr (ALIGN_EPI) { if (wr == 1) PG8_BAR; }
    }
    PG8_WAIT_V(0);
    if constexpr (!ALIGN_EPI) { if (wr == 0) PG8_BAR; }
    PG8_BAR;
    if constexpr (Epi::AFTER_DRAIN) { E.fused(acc, cur, wr, wc, fr, fq, lds, wid, lane); S.done(cur); }
#undef PG8_SA
#undef PG8_SB
#undef PG8_STAGE
#undef PG8_LDA
#undef PG8_LDB
#undef PG8_MMA
#undef PG8_WAIT_V
#undef PG8_WAIT_L
#undef PG8_BAR
#undef PG8_SCHED
}
}

constexpr int NWAVES = 8;
constexpr int BATCH = 8, SEQ = 2048, DM = 2048, DEPTH = 4, M = BATCH * SEQ, NH = 8;
constexpr int NIN = 16400, NZ = 16384, DFF = 5632, NUP = 2 * DFF, NY = 3072;
constexpr int Z_RQ = 0, Z_RK = 1024, Z_RV = 2048, Z_RG = 3072, Z_MQ = 4096, Z_MK = 4608, Z_MV = 5120, Z_MO = 6144, Z_AQ = 7168, Z_AK = 8192, Z_AV = 9216, Z_GA = 10240, Z_GB = 12288, Z_GC = 14336;
constexpr int W_GATE_COL = 7168;
constexpr size_t MiB = 1u << 20;
constexpr size_t WS_CTL = 0, CTL_ZERO_BYTES = 1 * MiB;
constexpr size_t WS_RS = 1520 * MiB;
constexpr size_t WS_TAB = 2 * MiB + 512 * 1024;
constexpr size_t WS_RSTD = 7 * MiB + 512 * 1024;
constexpr size_t WS_W16G = 7 * MiB;
constexpr size_t WS_KMEAN = 5 * MiB;
constexpr size_t WS_GIF = 6 * MiB;
constexpr size_t WS_WIN = 8 * MiB;
constexpr size_t WS_WP = 264 * MiB;
constexpr size_t WS_WOUT = 312 * MiB;
constexpr size_t WS_WUP = 344 * MiB;
constexpr size_t WS_WDN = 520 * MiB;
constexpr size_t WS_XB = 608 * MiB;
constexpr size_t WS_Z = 672 * MiB;
constexpr size_t WS_Y = 1184 * MiB;
constexpr size_t WS_MG = 1280 * MiB;
constexpr size_t WS_ACT = 1344 * MiB;
constexpr size_t WS_ZG = 1536 * MiB;
constexpr size_t WS_SB = 1632 * MiB;
constexpr size_t WS_XB8 = 1648 * MiB;
constexpr size_t WS_END = 1680 * MiB;
constexpr int N8 = 3 * DM + 1024;
__host__ __device__ constexpr size_t ws_win8(int l) { return WS_WIN + ((size_t)l * NZ + Z_GA) * DM * 2; }
constexpr int CW_TMO = 0, CW_CODE = 1;
constexpr int CW_BAR = 4096;
constexpr int CW_QUEUE = 8192;
constexpr int RING_OFF = 0, RING_BYTES = 131072;
constexpr int LDS_BYTES = 163840;
constexpr int LDSCTL_OFF = LDS_BYTES - 512, MISC_OFF = LDSCTL_OFF + 320;
static_assert(MISC_OFF + 128 <= LDS_BYTES, "LDS map");

#define GAS __attribute__((address_space(1)))
#define LAS __attribute__((address_space(3)))
typedef unsigned short bf16;
typedef unsigned v4u __attribute__((ext_vector_type(4)));
typedef unsigned v2u __attribute__((ext_vector_type(2)));
typedef float f32x4 __attribute__((ext_vector_type(4)));
typedef float f32x2 __attribute__((ext_vector_type(2)));
typedef GAS unsigned gu32;
#define RLX_AGENT __ATOMIC_RELAXED, __HIP_MEMORY_SCOPE_AGENT
#define LDS_WAIT() asm volatile("s_waitcnt lgkmcnt(0)" ::: "memory")
#define VM_WAIT() asm volatile("s_waitcnt vmcnt(0)" ::: "memory")
typedef __bf16 bf16x2_t __attribute__((ext_vector_type(2)));
__device__ __forceinline__ unsigned pk2(float lo, float hi) { const f32x2 v = {lo, hi}; const bf16x2_t b = __builtin_convertvector(v, bf16x2_t); return __builtin_bit_cast(unsigned, b); }
__device__ __forceinline__ unsigned f2bf(float f) { return pk2(f, f); }
__device__ __forceinline__ float bflo(unsigned w) { return __uint_as_float(w << 16); }
__device__ __forceinline__ float bfhi(unsigned w) { return __uint_as_float(w & 0xffff0000u); }
__device__ __forceinline__ float bf1(bf16 v) { return __uint_as_float((unsigned)v << 16); }
__device__ __forceinline__ float sigm(float x) { return 1.0f / (1.0f + __expf(-x)); }

#define XB_TMO      128
#define XB_XCNT(j)  (256  + 64 * (j))
#define XB_XSUB(j)  (1280 + 64 * (j))
#define XB_XGEN(j)  (2304 + 64 * (j))
#define XB_TOP      3328
#define XB_TOPGEN   3392
#define XCD_BAR_WORDS 3456
#define XB_SPIN_CAP (1u << 18)

__device__ __forceinline__ unsigned xb_ld(unsigned* p)              { return __hip_atomic_load(p, __ATOMIC_RELAXED, __HIP_MEMORY_SCOPE_AGENT); }
__device__ __forceinline__ unsigned xb_add(unsigned* p, unsigned v) { return __hip_atomic_fetch_add(p, v, __ATOMIC_RELAXED, __HIP_MEMORY_SCOPE_AGENT); }
__device__ __forceinline__ unsigned xb_xcc_id() { return (unsigned)__builtin_amdgcn_s_getreg((3 << 11) | 20) & 0xFu; }
#define XB_SPIN(cond, bar) do { unsigned _sp = 0; while (cond) { __builtin_amdgcn_s_sleep(1); \
    if ((++_sp & 255u) == 0u) { if (xb_ld(&(bar)[XB_TMO])) break; if (_sp > XB_SPIN_CAP) { atomicAdd(&(bar)[XB_TMO], 1u); break; } } } } while (0)

struct XcdBarrier {
    unsigned* bar; unsigned x;
    volatile LAS unsigned* st;
};

__device__ __forceinline__ XcdBarrier xcd_barrier_post(unsigned* bar, volatile LAS unsigned* st) {
    XcdBarrier b; b.bar = bar; b.x = xb_xcc_id(); b.st = st;
    if (threadIdx.x == 0) (void)xb_add(&bar[XB_XCNT(b.x)], 1u);
    return b;
}
__device__ __forceinline__ void xcd_barrier_complete(unsigned* bar, unsigned x, unsigned& nloc, unsigned& nx) {
    const unsigned G = gridDim.x * gridDim.y * gridDim.z;
    unsigned sum, cnt, mine, sp = 0u;
    for (;;) {
        sum = 0u; cnt = 0u; mine = 0u;
#pragma unroll
        for (unsigned j = 0; j < 16; ++j) { const unsigned c = xb_ld(&bar[XB_XCNT(j)]); sum += c; cnt += (c > 0u) ? 1u : 0u; mine = (j == x) ? c : mine; }
        if (sum == G) break;
        __builtin_amdgcn_s_sleep(1);
        if ((++sp & 255u) == 0u) { if (xb_ld(&bar[XB_TMO])) break; if (sp > XB_SPIN_CAP) { atomicAdd(&bar[XB_TMO], 1u); break; } }
    }
    nloc = mine > 0u ? mine : 1u; nx = cnt > 0u ? cnt : 1u;
}

__device__ __forceinline__ void xcd_barrier(const XcdBarrier& b) {
    asm volatile("s_waitcnt vmcnt(0)" ::: "memory");
    __syncthreads();
    if (threadIdx.x == 0) {
        unsigned* bar = b.bar;
        __builtin_amdgcn_s_waitcnt(0);
        unsigned nloc = b.st[0], nx = b.st[1];
        if (nloc == 0u) { xcd_barrier_complete(bar, b.x, nloc, nx); b.st[0] = nloc; b.st[1] = nx; }
        const unsigned old = xb_add(&bar[XB_XSUB(b.x)], 1u);
        const unsigned gen = old / nloc;
        if (old + 1u == (gen + 1u) * nloc) {
            __builtin_amdgcn_fence(__ATOMIC_RELEASE, "agent");
            asm volatile("s_waitcnt vmcnt(0)" ::: "memory");
            const unsigned og = xb_add(&bar[XB_TOP], 1u);
            const unsigned tg = og / nx;
            if (og + 1u == (tg + 1u) * nx) xb_add(&bar[XB_TOPGEN], 1u);
            else XB_SPIN(xb_ld(&bar[XB_TOPGEN]) == tg, bar);
            __builtin_amdgcn_fence(__ATOMIC_ACQUIRE, "agent");
            xb_add(&bar[XB_XGEN(b.x)], 1u);
            asm volatile("s_waitcnt vmcnt(0)" ::: "memory");
        } else {
            XB_SPIN(xb_ld(&bar[XB_XGEN(b.x)]) == gen, bar);
            __builtin_amdgcn_fence(__ATOMIC_ACQUIRE, "agent");
            asm volatile("s_waitcnt vmcnt(0)" ::: "memory");
        }
    }
    __syncthreads();
}

struct Args { const float* in[18]; float* out; unsigned char* ws; int ph_lo, ph_hi, li, pad; };
enum { I_X = 0, I_WIN, I_BIG, I_BFG, I_NMIX, I_RGN, I_MLN, I_QN, I_KN, I_WPA, I_WPB, I_WPC, I_WOUT, I_NFFN, I_WUP, I_CW, I_CB, I_WDN };
struct Frame {
    LAS unsigned char* lds;
    volatile LAS unsigned* MISC;
    unsigned char* ws;
    int tid, lane, wave, G, bx;
};
#define WSP(T, off) ((T*)(F.ws + (off)))
__device__ __forceinline__ float wave_sum(float v) {
#pragma unroll
    for (int o = 1; o < 64; o <<= 1) v += __shfl_xor(v, o);
    return v;
}
__device__ __forceinline__ float wave_max(float v) {
#pragma unroll
    for (int o = 1; o < 64; o <<= 1) v = fmaxf(v, __shfl_xor(v, o));
    return v;
}
__device__ __forceinline__ void p0_transpose_item(const float* W, int ldw, int K, int nblk, bf16* WT, LAS float* scr, int item, int lane, const float* gk = nullptr, unsigned char* WT8 = nullptr, int nb8 = 0) {
    const int kb = item / nblk, nb = item % nblk, k0 = 64 * kb, n0 = 32 * nb;
#pragma unroll 8
    for (int i = 0; i < 32; ++i) { const int kk = 2 * i + (lane >> 5); scr[kk * 33 + (lane & 31)] = W[(size_t)(k0 + kk) * ldw + n0 + (lane & 31)]; }
    LDS_WAIT(); asm volatile("" ::: "memory");
    const int c = lane & 7;
    f32x4 g0 = (f32x4){1.f, 1.f, 1.f, 1.f}, g1 = g0;
    if (gk) { g0 = *(const f32x4*)(gk + k0 + 8 * c); g1 = *(const f32x4*)(gk + k0 + 8 * c + 4); }
    if (WT8 && nb >= nb8) {
#pragma unroll
        for (int j = 0; j < 4; ++j) { const int n = (lane >> 3) + 8 * j; const LAS float* s = scr + (8 * c) * 33 + n; const f32x4 h0 = g0 * 64.f, h1 = g1 * 64.f;
            v2u o; o.x = (unsigned)__builtin_amdgcn_cvt_pk_fp8_f32(s[2 * 33] * h0[2], s[3 * 33] * h0[3], __builtin_amdgcn_cvt_pk_fp8_f32(s[0 * 33] * h0[0], s[1 * 33] * h0[1], 0, false), true);
            o.y = (unsigned)__builtin_amdgcn_cvt_pk_fp8_f32(s[6 * 33] * h1[2], s[7 * 33] * h1[3], __builtin_amdgcn_cvt_pk_fp8_f32(s[4 * 33] * h1[0], s[5 * 33] * h1[1], 0, false), true);
            *(GAS v2u*)(WT8 + (size_t)(n0 - 32 * nb8 + n) * K + k0 + 8 * c) = o; }
    } else
#pragma unroll
    for (int j = 0; j < 4; ++j) { const int n = (lane >> 3) + 8 * j; const LAS float* s = scr + (8 * c) * 33 + n;
        v4u o; o.x = pk2(s[0 * 33] * g0[0], s[1 * 33] * g0[1]); o.y = pk2(s[2 * 33] * g0[2], s[3 * 33] * g0[3]); o.z = pk2(s[4 * 33] * g1[0], s[5 * 33] * g1[1]); o.w = pk2(s[6 * 33] * g1[2], s[7 * 33] * g1[3]);
        *(GAS v4u*)(WT + (size_t)(n0 + n) * K + k0 + 8 * c) = o; }
    LDS_WAIT(); asm volatile("" ::: "memory");
}
__device__ __forceinline__ void p0_prologue(Frame& F, const Args& args) {
    LAS float* scr = (LAS float*)(F.lds + RING_OFF + F.wave * 16384);
    const int gw = F.bx * NWAVES + F.wave, NGW = F.G * NWAVES;
    constexpr int I_INA = 32 * 224, I_INB = 32 * 288, I_P = 16 * 64, I_OUT = 32 * 64, I_UP = 32 * 352, I_DN = 88 * 64;
    constexpr int I_LAYER = I_INA + I_INB + 3 * I_P + I_OUT + I_UP + I_DN;
    for (int it = gw; it < DEPTH * I_LAYER; it += NGW) {
        const int l = it / I_LAYER; int r = it % I_LAYER;
        const float* win = args.in[I_WIN] + (size_t)l * DM * NIN; bf16* wint = WSP(bf16, WS_WIN) + (size_t)l * NZ * DM;
        if (r < I_INA) { p0_transpose_item(win, NIN, DM, 224, wint, scr, r, F.lane, args.in[I_NMIX] + l * DM, F.ws + ws_win8(l) + (size_t)3 * DM * DM, Z_MO / 32); continue; } r -= I_INA;
        if (r < I_INB) { p0_transpose_item(win + 7184, NIN, DM, 288, wint + (size_t)7168 * DM, scr, r, F.lane, args.in[I_NMIX] + l * DM, F.ws + ws_win8(l), 96); continue; } r -= I_INB;
        if (r < I_P) { p0_transpose_item(args.in[I_WPA] + (size_t)l * 1024 * DM, DM, 1024, 64, WSP(bf16, WS_WP) + ((size_t)l * 3 + 0) * DM * 1024, scr, r, F.lane); continue; } r -= I_P;
        if (r < I_P) { p0_transpose_item(args.in[I_WPB] + (size_t)l * 1024 * DM, DM, 1024, 64, WSP(bf16, WS_WP) + ((size_t)l * 3 + 1) * DM * 1024, scr, r, F.lane); continue; } r -= I_P;
        if (r < I_P) { p0_transpose_item(args.in[I_WPC] + (size_t)l * 1024 * DM, DM, 1024, 64, WSP(bf16, WS_WP) + ((size_t)l * 3 + 2) * DM * 1024, scr, r, F.lane); continue; } r -= I_P;
        if (r < I_OUT) { p0_transpose_item(args.in[I_WOUT] + (size_t)l * DM * DM, DM, DM, 64, WSP(bf16, WS_WOUT) + (size_t)l * DM * DM, scr, r, F.lane); continue; } r -= I_OUT;
        if (r < I_UP) {
            const int nb = r % 352, tile = nb >> 3, wi = nb & 7, src = (wi < 4) ? 128 * tile + 32 * wi : DFF + 128 * tile + 32 * (wi - 4);
            p0_transpose_item(args.in[I_WUP] + (size_t)l * DM * NUP + (src - 32 * nb), NUP, DM, 352, WSP(bf16, WS_WUP) + (size_t)l * NUP * DM, scr, r, F.lane, args.in[I_NFFN] + l * DM); continue; } r -= I_UP;
        p0_transpose_item(args.in[I_WDN] + (size_t)l * DFF * DM, DM, DFF, 64, WSP(bf16, WS_WDN) + (size_t)l * DM * DFF, scr, r, F.lane);
    }
    const int gt = F.bx * (NWAVES * 64) + F.tid, NGT = F.G * NWAVES * 64;
    for (int i = gt; i < DEPTH * 16 * DM; i += NGT) { const int l = i / (16 * DM), c = (i / DM) % 16, k = i % DM; WSP(bf16, WS_W16G)[i] = (bf16)f2bf(args.in[I_WIN][((size_t)l * DM + k) * NIN + W_GATE_COL + c] * args.in[I_NMIX][l * DM + k]); }
    for (int m = gw; m < M; m += NGW) { const f32x4* xr = (const f32x4*)(args.in[I_X] + (size_t)m * DM) + F.lane; v2u* o8 = (v2u*)(WSP(bf16, WS_XB) + (size_t)m * DM) + F.lane; float s = 0.f;
        unsigned* q8 = (unsigned*)(F.ws + WS_XB8 + (size_t)m * DM) + F.lane;
#pragma unroll
        for (int j = 0; j < 8; ++j) { const f32x4 v = xr[64 * j]; s += (v.x * v.x + v.y * v.y) + (v.z * v.z + v.w * v.w); v2u w; w.x = pk2(v.x, v.y); w.y = pk2(v.z, v.w); o8[64 * j] = w;
            q8[64 * j] = (unsigned)__builtin_amdgcn_cvt_pk_fp8_f32(v.z, v.w, __builtin_amdgcn_cvt_pk_fp8_f32(v.x, v.y, 0, false), true); }
        s = wave_sum(s); if (F.lane < 32) WSP(float, WS_RS)[(size_t)m * 32 + F.lane] = (F.lane == 0) ? s : 0.f; }
    for (int i = gt; i < 2 * SEQ * 64; i += NGT) { const int which = i / (SEQ * 64), pos = (i / 64) % SEQ, d = i % 64;
        const float ex = which == 0 ? (float)d / 63.0f : (float)(2 * d) / 128.0f;
        const float inv = 1.0f / powf(10000.0f, ex); const float ang = (float)pos * inv; float s, c; sincosf(ang, &s, &c); WSP(f32x2, WS_TAB)[i] = (f32x2){c, s}; }
}
__device__ __forceinline__ void prep_phase(Frame& F, const float* qn, const float* kn, const bf16* w16g, const float* rs, const float* big, const float* bfg) {
    const int gw = F.bx * NWAVES + F.wave, NGW = F.G * NWAVES, lane = F.lane, rsub = lane >> 2, dg = lane & 3;
    const f32x2* trope = WSP(f32x2, WS_TAB) + SEQ * 64;
    for (int u = gw; u < BATCH * 16 * NH; u += NGW) {
        const int kind = 1, hh = u & 7, hb = (u >> 3) & 15, b = u >> 7;
        const float* wn = kn;
        const float* rsb = rs + (size_t)(b * SEQ + hb * 128) * 32 + 8 * dg;
        float wl[16], wh[16], s1[16], s2[16];
#pragma unroll
        for (int e = 0; e < 16; ++e) { wl[e] = wn[16 * dg + e]; wh[e] = wn[64 + 16 * dg + e]; s1[e] = 0.f; s2[e] = 0.f; }
        bf16* zb = WSP(bf16, WS_Z) + (size_t)(b * SEQ + hb * 128) * NZ + (kind ? Z_AK : Z_AQ) + hh * 128 + 16 * dg;
#pragma unroll 2
        for (int st = 0; st < 8; ++st) {
            const int r = rsub + 16 * st, pos = hb * 128 + r; bf16* zr = zb + (size_t)r * NZ;
            const v4u l0 = *(const v4u*)(zr), l1 = *(const v4u*)(zr + 8), h0 = *(const v4u*)(zr + 64), h1 = *(const v4u*)(zr + 72);
            float a[16] = {bflo(l0.x), bfhi(l0.x), bflo(l0.y), bfhi(l0.y), bflo(l0.z), bfhi(l0.z), bflo(l0.w), bfhi(l0.w), bflo(l1.x), bfhi(l1.x), bflo(l1.y), bfhi(l1.y), bflo(l1.z), bfhi(l1.z), bflo(l1.w), bfhi(l1.w)};
            float c[16] = {bflo(h0.x), bfhi(h0.x), bflo(h0.y), bfhi(h0.y), bflo(h0.z), bfhi(h0.z), bflo(h0.w), bfhi(h0.w), bflo(h1.x), bfhi(h1.x), bflo(h1.y), bfhi(h1.y), bflo(h1.z), bfhi(h1.z), bflo(h1.w), bfhi(h1.w)};
            float ss = 0.f;
#pragma unroll
            for (int e = 0; e < 16; ++e) ss += a[e] * a[e] + c[e] * c[e];
            ss += __shfl_xor(ss, 1); ss += __shfl_xor(ss, 2);
            float rq; { const f32x4 s0 = *(const f32x4*)(rsb + (size_t)r * 32), s1 = *(const f32x4*)(rsb + (size_t)r * 32 + 4); rq = ((s0[0] + s0[1]) + (s0[2] + s0[3])) + ((s1[0] + s1[1]) + (s1[2] + s1[3])); }
            rq += __shfl_xor(rq, 1); rq += __shfl_xor(rq, 2);
            const float rr = rsqrtf(rq * (1.0f / 2048.0f) + 1e-6f);
            if (hh == 0 && dg == 0) WSP(float, WS_RSTD)[b * SEQ + hb * 128 + r] = rr;
            const float rstd = rr * rsqrtf(ss * rr * rr * (1.f / 128.f) + 1e-6f);
            const f32x2* tb = trope + pos * 64 + 16 * dg;
#pragma unroll
            for (int e = 0; e < 16; ++e) { const float x1 = a[e] * rstd * wl[e], x2 = c[e] * rstd * wh[e]; const f32x2 cs = tb[e]; a[e] = x1 * cs.x - x2 * cs.y; c[e] = x1 * cs.y + x2 * cs.x; s1[e] += a[e]; s2[e] += c[e]; }
            *(v4u*)(zr) = (v4u){pk2(a[0], a[1]), pk2(a[2], a[3]), pk2(a[4], a[5]), pk2(a[6], a[7])}; *(v4u*)(zr + 8) = (v4u){pk2(a[8], a[9]), pk2(a[10], a[11]), pk2(a[12], a[13]), pk2(a[14], a[15])};
            *(v4u*)(zr + 64) = (v4u){pk2(c[0], c[1]), pk2(c[2], c[3]), pk2(c[4], c[5]), pk2(c[6], c[7])}; *(v4u*)(zr + 72) = (v4u){pk2(c[8], c[9]), pk2(c[10], c[11]), pk2(c[12], c[13]), pk2(c[14], c[15])};
        }
        if (kind) {
            float* km = WSP(float, WS_KMEAN) + (size_t)((b * NH + hh) * 16 + hb) * 128 + 16 * dg;
#pragma unroll
            for (int e = 0; e < 16; ++e) { float x = s1[e], y = s2[e];
                x += __shfl_xor(x, 4); x += __shfl_xor(x, 8); x += __shfl_xor(x, 16); x += __shfl_xor(x, 32);
                y += __shfl_xor(y, 4); y += __shfl_xor(y, 8); y += __shfl_xor(y, 16); y += __shfl_xor(y, 32);
                if (rsub == 0) { km[e] = x * (1.f / 256.f); km[64 + e] = y * (1.f / 256.f); } }
        }
    }
    for (int it = NGW - 1 - gw; it < M / 16; it += NGW) {
        const int i16 = lane & 15, g = lane >> 4; const bf16* ar = WSP(bf16, WS_XB) + (size_t)(16 * it + i16) * DM + 8 * g; const bf16* br = w16g + (size_t)i16 * DM + 8 * g;
        typedef short bf16x8_t __attribute__((ext_vector_type(8)));
        f32x4 acc = (f32x4){0.f, 0.f, 0.f, 0.f};
#pragma unroll 1
        for (int s0 = 0; s0 < DM / 32; s0 += 16) { bf16x8_t av[16], bv[16];
#pragma unroll
            for (int s = 0; s < 16; ++s) { av[s] = *(const bf16x8_t*)(ar + 32 * (s0 + s)); bv[s] = *(const bf16x8_t*)(br + 32 * (s0 + s)); }
#pragma unroll
            for (int s = 0; s < 16; ++s) acc = __builtin_amdgcn_mfma_f32_16x16x32_bf16(av[s], bv[s], acc, 0, 0, 0); }
#pragma unroll
        for (int r = 0; r < 4; ++r) { const int row = 16 * it + 4 * g + r; float ssq = 0.f;
#pragma unroll
            for (int q = 0; q < 8; ++q) { const f32x4 a = *(const f32x4*)(rs + (size_t)row * 32 + 4 * q); ssq += (a[0] + a[1]) + (a[2] + a[3]); }
            const float sr = rsqrtf(ssq * (1.0f / 2048.0f) + 1e-6f);
            const float pre = acc[r] * sr + (i16 < 8 ? big[i16 & 7] : bfg[i16 & 7]); const float sc = 15.0f * tanhf(pre * (1.0f / 15.0f));
            float o = sc; if (i16 >= 8) o = sc > 0.f ? -log1pf(__expf(-sc)) : sc - log1pf(__expf(sc));
            WSP(float, WS_GIF)[(size_t)row * 16 + i16] = o; }
    }
}
__device__ __forceinline__ void glu_fix_phase(Frame& F, const float* cw, const float* cb) {
    const bf16* SB = WSP(bf16, WS_SB); bf16* ACT = WSP(bf16, WS_ACT);
    for (int gI = F.bx; gI < M / 128; gI += F.G) {
        const bool first = ((gI * 128) & (SEQ - 1)) == 0; const bf16* sb = SB + (size_t)gI * 4 * NUP;
        for (int it = F.tid; it < 2 * (DFF / 8); it += NWAVES * 64) {
            const int i = it / (DFF / 8), c8 = (it % (DFF / 8)) * 8;
            float r[2][8];
#pragma unroll
            for (int hf = 0; hf < 2; ++hf) { const int col = hf * DFF + c8;
                const f32x4 b0 = *(const f32x4*)(cb + col), b1 = *(const f32x4*)(cb + col + 4);
                float a[8] = {b0.x, b0.y, b0.z, b0.w, b1.x, b1.y, b1.z, b1.w};
#pragma unroll
                for (int j = 0; j < 3; ++j) { const int slot = i + j;
                    if (slot >= 2 || !first) { const v4u uw = *(const v4u*)(sb + (size_t)slot * NUP + col); const f32x4 w0 = *(const f32x4*)(cw + (size_t)j * NUP + col), w1 = *(const f32x4*)(cw + (size_t)j * NUP + col + 4);
                        a[0] += bflo(uw.x) * w0.x; a[1] += bfhi(uw.x) * w0.y; a[2] += bflo(uw.y) * w0.z; a[3] += bfhi(uw.y) * w0.w; a[4] += bflo(uw.z) * w1.x; a[5] += bfhi(uw.z) * w1.y; a[6] += bflo(uw.w) * w1.z; a[7] += bfhi(uw.w) * w1.w; } }
#pragma unroll
                for (int e = 0; e < 8; ++e) r[hf][e] = a[e]; }
            float o[8];
#pragma unroll
            for (int e = 0; e < 8; ++e) o[e] = r[0][e] * __builtin_amdgcn_rcpf(1.0f + __expf(-r[0][e])) * r[1][e];
            *(v4u*)(ACT + (size_t)(gI * 128 + i) * DFF + c8) = (v4u){pk2(o[0], o[1]), pk2(o[2], o[3]), pk2(o[4], o[5]), pk2(o[6], o[7])};
        }
    }
}
namespace mx {
typedef short bf16x8 __attribute__((ext_vector_type(8)));
typedef short s16x4 __attribute__((ext_vector_type(4)));
#define MFMA16(a, b, c) __builtin_amdgcn_mfma_f32_16x16x32_bf16((a), (b), (c), 0, 0, 0)
#define LDS_FENCE() asm volatile("s_waitcnt lgkmcnt(0)" ::: "memory")
#define SCHED_FENCE() __builtin_amdgcn_sched_barrier(0)
__device__ __forceinline__ bf16x8 frag_row(const LAS bf16* X, int ld, int r0, int c0, int lane) {
    return *(const LAS bf16x8*)(X + (r0 + (lane & 15)) * ld + c0 + 8 * (lane >> 4)); }
__device__ __forceinline__ bf16x8 frag_tr(const LAS bf16* X, int ld, int k0, int c0, int lane) {
    const int g = lane >> 4, q = (lane & 15) >> 2, p = lane & 3;
    const LAS bf16* a = X + (k0 + 8 * g + q) * ld + c0 + 4 * p;
    const s16x4 lo = __builtin_amdgcn_ds_read_tr16_b64_v4i16((LAS s16x4*)a);
    const s16x4 hi = __builtin_amdgcn_ds_read_tr16_b64_v4i16((LAS s16x4*)(a + 4 * ld));
    return __builtin_shufflevector(lo, hi, 0, 1, 2, 3, 4, 5, 6, 7);
}
__device__ __forceinline__ int trs_off(int row, int chunk) { return row * 128 + ((chunk ^ (((row & 3) << 1) | (((row >> 3) & 1) << 3))) << 3); }
__device__ __forceinline__ bf16x8 frag_trs(const LAS bf16* X, int k0, int c0, int lane) {
    const int g = lane >> 4, q = (lane & 15) >> 2, p = lane & 3;
    const LAS bf16* a = X + trs_off(k0 + 8 * g + q, (c0 >> 3) + (p >> 1)) + 4 * (p & 1);
    const s16x4 lo = __builtin_amdgcn_ds_read_tr16_b64_v4i16((LAS s16x4*)a);
    const s16x4 hi = __builtin_amdgcn_ds_read_tr16_b64_v4i16((LAS s16x4*)(a + 4 * 128));
    return __builtin_shufflevector(lo, hi, 0, 1, 2, 3, 4, 5, 6, 7);
}
template <int CTRL> __device__ __forceinline__ float dppf(float v) { return __builtin_bit_cast(float, __builtin_amdgcn_update_dpp(0, __builtin_bit_cast(int, v), CTRL, 0xf, 0xf, true)); }
__device__ __forceinline__ float r16max(float v) { v = fmaxf(v, dppf<0xB1>(v)); v = fmaxf(v, dppf<0x4E>(v)); v = fmaxf(v, dppf<0x141>(v)); v = fmaxf(v, dppf<0x140>(v)); return v; }
__device__ __forceinline__ float r16sum(float v) { v += dppf<0xB1>(v); v += dppf<0x4E>(v); v += dppf<0x141>(v); v += dppf<0x140>(v); return v; }
__device__ __forceinline__ float red16_sum(float v) { return r16sum(v); }
__device__ __forceinline__ float red16_max(float v) { return r16max(v); }
__device__ __forceinline__ void rot8(const v4u lo, const v4u hi, const f32x2* tb, float sc, v4u& olo, v4u& ohi) {
    float a[8] = {bflo(lo.x), bfhi(lo.x), bflo(lo.y), bfhi(lo.y), bflo(lo.z), bfhi(lo.z), bflo(lo.w), bfhi(lo.w)};
    float c[8] = {bflo(hi.x), bfhi(hi.x), bflo(hi.y), bfhi(hi.y), bflo(hi.z), bfhi(hi.z), bflo(hi.w), bfhi(hi.w)};
    float o1[8], o2[8];
#pragma unroll
    for (int e = 0; e < 8; ++e) { const f32x2 cs = tb[e]; o1[e] = (a[e] * cs.x - c[e] * cs.y) * sc; o2[e] = (a[e] * cs.y + c[e] * cs.x) * sc; }
    olo = (v4u){pk2(o1[0], o1[1]), pk2(o1[2], o1[3]), pk2(o1[4], o1[5]), pk2(o1[6], o1[7])};
    ohi = (v4u){pk2(o2[0], o2[1]), pk2(o2[2], o2[3]), pk2(o2[4], o2[5]), pk2(o2[6], o2[7])};
}
constexpr int LQ = 144;
__device__ __forceinline__ void ret_unit(Frame& F, const float* gn, int b, int h) {
    LAS bf16* Qs = (LAS bf16*)(F.lds); LAS bf16* Ks = Qs + 128 * LQ; LAS bf16* Vs = Ks + 128 * LQ; LAS bf16* Ts = Vs + 128 * LQ;
    const int tid = F.tid, lane = F.lane, w = tid >> 6, i16 = lane & 15, g = lane >> 4;
    const float gamma = 1.0f - exp2f(-5.0f - (float)h), lg = log2f(gamma);
    const float gC = exp2f(lg * 128.0f);
    f32x4 accT[8];
#pragma unroll
    for (int n = 0; n < 8; ++n) accT[n] = (f32x4){0.f, 0.f, 0.f, 0.f};
    for (int i = tid; i < 128 * LQ / 8; i += NWAVES * 64) ((LAS v4u*)Ts)[i] = (v4u){0u, 0u, 0u, 0u};
    const bf16* zb = WSP(bf16, WS_Z) + (size_t)(b * SEQ) * NZ + h * 128;
    const f32x2* tret = WSP(f32x2, WS_TAB);
    bf16* yb = WSP(bf16, WS_Y) + (size_t)(b * SEQ) * 1024 + h * 128;
    const int lr = tid >> 2, dg = tid & 3;
    v4u pq[4], pk[4], pv[4]; float prr;
    const float* rstd1 = WSP(float, WS_RSTD) + (size_t)(b * SEQ);
#define RET_FETCH(t0_) do { const bf16* zr_ = zb + (size_t)((t0_) + lr) * NZ; \
        pq[0] = *(const v4u*)(zr_ + Z_RQ + 16 * dg); pq[1] = *(const v4u*)(zr_ + Z_RQ + 64 + 16 * dg); pq[2] = *(const v4u*)(zr_ + Z_RQ + 16 * dg + 8); pq[3] = *(const v4u*)(zr_ + Z_RQ + 64 + 16 * dg + 8); \
        pk[0] = *(const v4u*)(zr_ + Z_RK + 16 * dg); pk[1] = *(const v4u*)(zr_ + Z_RK + 64 + 16 * dg); pk[2] = *(const v4u*)(zr_ + Z_RK + 16 * dg + 8); pk[3] = *(const v4u*)(zr_ + Z_RK + 64 + 16 * dg + 8); \
        _Pragma("unroll") for (int q_ = 0; q_ < 4; ++q_) pv[q_] = *(const v4u*)(zr_ + Z_RV + 32 * dg + 8 * q_); prr = rstd1[(t0_) + lr]; } while (0)
    RET_FETCH(0);
    const float sq = exp2f(lg * (float)lr), sk = exp2f(-lg * (float)lr) * 0.08838834764831845f;
    float gnv[8];
#pragma unroll
    for (int n = 0; n < 8; ++n) gnv[n] = gn[h * 128 + 16 * n + i16];
    for (int c = 0; c < SEQ / 128; ++c) {
        const int t0 = c * 128;
        {
            const f32x2* tb = tret + (t0 + lr) * 64 + 16 * dg;
#pragma unroll
            for (int hh = 0; hh < 2; ++hh) {
                v4u o1, o2; rot8(pq[2 * hh], pq[2 * hh + 1], tb + 8 * hh, sq * prr, o1, o2);
                *(LAS v4u*)(Qs + lr * LQ + 16 * dg + 8 * hh) = o1; *(LAS v4u*)(Qs + lr * LQ + 64 + 16 * dg + 8 * hh) = o2;
                rot8(pk[2 * hh], pk[2 * hh + 1], tb + 8 * hh, sk * prr * prr, o1, o2);
                *(LAS v4u*)(Ks + lr * LQ + 16 * dg + 8 * hh) = o1; *(LAS v4u*)(Ks + lr * LQ + 64 + 16 * dg + 8 * hh) = o2;
            }
#pragma unroll
            for (int q = 0; q < 4; ++q) *(LAS v4u*)(Vs + lr * LQ + 32 * dg + 8 * q) = pv[q];
            if (c + 1 < SEQ / 128) RET_FETCH(t0 + 128);
        }
        __syncthreads();
        bf16x8 aq[4];
#pragma unroll
        for (int s = 0; s < 4; ++s) aq[s] = frag_row(Qs, LQ, 16 * w, 32 * s, lane);
        f32x4 acco[8];
#pragma unroll
        for (int n = 0; n < 8; ++n) acco[n] = (f32x4){0.f, 0.f, 0.f, 0.f};
#pragma unroll
        for (int s = 0; s < 4; ++s) { bf16x8 bb[8];
#pragma unroll
            for (int n = 0; n < 8; ++n) bb[n] = frag_tr(Ts, LQ, 32 * s, 16 * n, lane);
            SCHED_FENCE();
#pragma unroll
            for (int n = 0; n < 8; ++n) acco[n] = MFMA16(aq[s], bb[n], acco[n]); }
        LDS_FENCE();
#pragma unroll
        for (int n = 0; n < 8; ++n) {
            if (n <= w) { f32x4 sa = (f32x4){0.f, 0.f, 0.f, 0.f}; bf16x8 bb[4];
#pragma unroll
                for (int s = 0; s < 4; ++s) bb[s] = frag_row(Ks, LQ, 16 * n, 32 * s, lane);
                SCHED_FENCE();
#pragma unroll
                for (int s = 0; s < 4; ++s) sa = MFMA16(aq[s], bb[s], sa);
#pragma unroll
                for (int r = 0; r < 4; ++r) { const int i = 16 * w + 4 * g + r, j = 16 * n + i16; Qs[i * LQ + j] = (bf16)f2bf(j <= i ? sa[r] : 0.f); } }
            else if (n == w + 1) {
#pragma unroll
                for (int r = 0; r < 4; ++r) Qs[(16 * w + 4 * g + r) * LQ + 16 * n + i16] = (bf16)0; }
        }
        LDS_FENCE();
#pragma unroll
        for (int n = 0; n < 8; ++n) accT[n] = accT[n] * gC;
#pragma unroll
        for (int s = 0; s < 4; ++s) { const bf16x8 ak = frag_tr(Ks, LQ, 32 * s, 16 * w, lane); const bool doi = (s <= (w >> 1)); bf16x8 as = ak; bf16x8 bb[8];
            if (doi) as = frag_row(Qs, LQ, 16 * w, 32 * s, lane);
#pragma unroll
            for (int n = 0; n < 8; ++n) bb[n] = frag_tr(Vs, LQ, 32 * s, 16 * n, lane);
            SCHED_FENCE();
            if (doi) {
#pragma unroll
                for (int n = 0; n < 8; ++n) acco[n] = MFMA16(as, bb[n], acco[n]); }
#pragma unroll
            for (int n = 0; n < 8; ++n) accT[n] = MFMA16(ak, bb[n], accT[n]); }
        bf16 gvr[4][8]; float rrv[4];
#pragma unroll
        for (int r = 0; r < 4; ++r) { const int pos = t0 + 16 * w + 4 * g + r; const bf16* gr = zb + (size_t)pos * NZ + Z_RG + i16; rrv[r] = rstd1[pos];
#pragma unroll
            for (int n = 0; n < 8; ++n) gvr[r][n] = gr[16 * n]; }
        LDS_FENCE();
        __syncthreads();
#pragma unroll
        for (int n = 0; n < 8; ++n)
#pragma unroll
            for (int r = 0; r < 4; ++r) Ts[(16 * w + 4 * g + r) * LQ + 16 * n + i16] = (bf16)f2bf(gC * accT[n][r]);
#pragma unroll
        for (int r = 0; r < 4; ++r) {
            float s = 0.f;
#pragma unroll
            for (int n = 0; n < 8; ++n) s += acco[n][r];
            const float mean = red16_sum(s) * (1.f / 128.f); float q = 0.f;
#pragma unroll
            for (int n = 0; n < 8; ++n) { const float d = acco[n][r] - mean; q += d * d; }
            const float rstd = rsqrtf(red16_sum(q) * (1.f / 128.f) + 1e-5f);
            const int pos = t0 + 16 * w + 4 * g + r; bf16* yr = yb + (size_t)pos * 1024; const float rri = rrv[r];
#pragma unroll
            for (int n = 0; n < 8; ++n) { const int e = 16 * n + i16; const float gv = bf1(gvr[r][n]) * rri; yr[e] = (bf16)f2bf((acco[n][r] - mean) * rstd * gnv[n] * gv * sigm(gv)); }
        }
    }
    __syncthreads();
#undef RET_FETCH
}
constexpr int LK = 72, LV = 168;
__device__ __forceinline__ float scan64_sum(float x, int lane) {
#pragma unroll
    for (int o = 1; o < 64; o <<= 1) { const float y = __shfl_up(x, o); if (lane >= o) x += y; }
    return x; }
__device__ __forceinline__ float scan64_max(float x, int lane) {
#pragma unroll
    for (int o = 1; o < 64; o <<= 1) { const float y = __shfl_up(x, o); if (lane >= o) x = fmaxf(x, y); }
    return x; }
__device__ __forceinline__ void mlstm_unit(Frame& F, const float* nw, int b, int h) {
    LAS bf16* Qm = (LAS bf16*)(F.lds); LAS bf16* Km = Qm + 128 * LK; LAS bf16* Kw = Km + 128 * LK; LAS bf16* Vm = Kw + 128 * LK; LAS bf16* Pm = Vm + 128 * LV; LAS bf16* Cm = Pm + 128 * LQ;
    const int tid = F.tid, lane = F.lane, w = F.wave, i16 = lane & 15, g = lane >> 4;
    const int dt = w & 3, eh = w >> 2;
    f32x4 accC[5];
#pragma unroll
    for (int k = 0; k < 5; ++k) accC[k] = (f32x4){0.f, 0.f, 0.f, 0.f};
    for (int i = tid; i < 64 * LV / 8; i += NWAVES * 64) ((LAS v4u*)Cm)[i] = (v4u){0u, 0u, 0u, 0u};
    float m_prev = 0.f;
    const bf16* zb = WSP(bf16, WS_Z) + (size_t)(b * SEQ) * NZ;
    const float* gif = WSP(float, WS_GIF) + (size_t)(b * SEQ) * 16;
    bf16* yb = WSP(bf16, WS_Y) + (size_t)M * 1024 + (size_t)(b * SEQ) * 1024 + h * 128;
    const int lr = tid >> 2, dg = tid & 3;
    v4u pq[2], pk[2]; float fl0, fl1, il0, il1, prr;
    const float* rstd1 = WSP(float, WS_RSTD) + (size_t)(b * SEQ);
#define ML_FETCH(t0_) do { const bf16* zr_ = zb + (size_t)((t0_) + lr) * NZ; \
        pq[0] = *(const v4u*)(zr_ + Z_MQ + h * 64 + 16 * dg); pq[1] = *(const v4u*)(zr_ + Z_MQ + h * 64 + 16 * dg + 8); pk[0] = *(const v4u*)(zr_ + Z_MK + h * 64 + 16 * dg); pk[1] = *(const v4u*)(zr_ + Z_MK + h * 64 + 16 * dg + 8); \
        fl0 = gif[(size_t)((t0_) + lane) * 16 + 8 + h]; fl1 = gif[(size_t)((t0_) + 64 + lane) * 16 + 8 + h]; il0 = gif[(size_t)((t0_) + lane) * 16 + h]; il1 = gif[(size_t)((t0_) + 64 + lane) * 16 + h]; prr = rstd1[(t0_) + lr]; } while (0)
    ML_FETCH(0);
    float nwv[8];
#pragma unroll
    for (int n = 0; n < 8; ++n) nwv[n] = nw[h * 128 + 16 * n + i16];
    for (int c = 0; c < SEQ / 128; ++c) {
        const int t0 = c * 128;
        const float a0 = scan64_sum(fl0, lane); const float a1 = scan64_sum(fl1, lane) + __shfl(a0, 63);
        const float b0 = il0 - a0, b1 = il1 - a1;
        const float pm0 = scan64_max(b0, lane); const float pm1 = fmaxf(scan64_max(b1, lane), __shfl(pm0, 63));
        const float a_last = __shfl(a1, 63), bmax = __shfl(pm1, 63);
        const float g_n = a_last + bmax, m_new = fmaxf(a_last + m_prev, g_n), s_old = __expf(a_last + m_prev - m_new), s_new = __expf(g_n - m_new);
        {
            const int r = lr;
            const float br = (r < 64) ? __shfl(b0, r & 63) : __shfl(b1, r & 63);
            const float rk = prr * 0.125f, wk = __expf(br - bmax) * rk * s_new;
#pragma unroll
            for (int hh = 0; hh < 2; ++hh) {
                *(LAS v4u*)(Qm + r * LK + 16 * dg + 8 * hh) = pq[hh];
                const v4u kk = pk[hh];
                float kf[8] = {bflo(kk.x), bfhi(kk.x), bflo(kk.y), bfhi(kk.y), bflo(kk.z), bfhi(kk.z), bflo(kk.w), bfhi(kk.w)};
                *(LAS v4u*)(Km + r * LK + 16 * dg + 8 * hh) = (v4u){pk2(kf[0] * rk, kf[1] * rk), pk2(kf[2] * rk, kf[3] * rk), pk2(kf[4] * rk, kf[5] * rk), pk2(kf[6] * rk, kf[7] * rk)};
                *(LAS v4u*)(Kw + r * LK + 16 * dg + 8 * hh) = (v4u){pk2(kf[0] * wk, kf[1] * wk), pk2(kf[2] * wk, kf[3] * wk), pk2(kf[4] * wk, kf[5] * wk), pk2(kf[6] * wk, kf[7] * wk)};
            }
#pragma unroll
            for (int q = 0; q < 4; ++q) { const v4u x = *(const v4u*)(zb + (size_t)(t0 + r) * NZ + Z_MV + h * 128 + 32 * dg + 8 * q); const float rv = prr;
                *(LAS v4u*)(Vm + r * LV + 32 * dg + 8 * q) = (v4u){pk2(bflo(x.x) * rv, bfhi(x.x) * rv), pk2(bflo(x.y) * rv, bfhi(x.y) * rv), pk2(bflo(x.z) * rv, bfhi(x.z) * rv), pk2(bflo(x.w) * rv, bfhi(x.w) * rv)}; }
            *(LAS v4u*)(Vm + r * LV + 128 + 8 * dg) = (v4u){dg == 0 ? 0x00003f80u : 0u, 0u, 0u, 0u};
            if (c + 1 < SEQ / 128) ML_FETCH(t0 + 128);
        }
        __syncthreads();
        float Mi[4], ai[4], rri[4];
#pragma unroll
        for (int r = 0; r < 4; ++r) { const int i = 16 * w + 4 * g + r; rri[r] = rstd1[t0 + i]; const float pmi = (w < 4) ? __shfl(pm0, i & 63) : __shfl(pm1, i & 63); ai[r] = (w < 4) ? __shfl(a0, i & 63) : __shfl(a1, i & 63); Mi[r] = fmaxf(pmi, m_prev); }
        bf16x8 aq[2];
#pragma unroll
        for (int s = 0; s < 2; ++s) aq[s] = frag_row(Qm, LK, 16 * w, 32 * s, lane);
        f32x4 acco[9];
#pragma unroll
        for (int n = 0; n < 9; ++n) acco[n] = (f32x4){0.f, 0.f, 0.f, 0.f};
#pragma unroll
        for (int s = 0; s < 2; ++s) {
#pragma unroll
          for (int hf = 0; hf < 2; ++hf) { bf16x8 bb[5];
#pragma unroll
            for (int n = 0; n < 5 - hf; ++n) bb[n] = frag_tr(Cm, LV, 32 * s, 16 * (5 * hf + n), lane);
            SCHED_FENCE();
#pragma unroll
            for (int n = 0; n < 5 - hf; ++n) acco[5 * hf + n] = MFMA16(aq[s], bb[n], acco[5 * hf + n]); } }
        { float si[4];
#pragma unroll
          for (int r = 0; r < 4; ++r) si[r] = __expf(m_prev - Mi[r]) * rri[r];
#pragma unroll
          for (int n = 0; n < 9; ++n)
#pragma unroll
            for (int r = 0; r < 4; ++r) acco[n][r] *= si[r]; }
        LDS_FENCE();
#pragma unroll
        for (int n = 0; n < 8; ++n) {
            if (n <= w) { f32x4 sa = (f32x4){0.f, 0.f, 0.f, 0.f}; bf16x8 bb[2];
#pragma unroll
                for (int s = 0; s < 2; ++s) bb[s] = frag_row(Km, LK, 16 * n, 32 * s, lane);
                SCHED_FENCE();
#pragma unroll
                for (int s = 0; s < 2; ++s) sa = MFMA16(aq[s], bb[s], sa);
                const int j = 16 * n + i16; const float bj = (n < 4) ? __shfl(b0, j & 63) : __shfl(b1, j & 63);
#pragma unroll
                for (int r = 0; r < 4; ++r) { const int i = 16 * w + 4 * g + r; Pm[i * LQ + j] = (bf16)f2bf(j <= i ? sa[r] * rri[r] * __expf(bj - Mi[r]) : 0.f); } }
            else if (n == w + 1) {
#pragma unroll
                for (int r = 0; r < 4; ++r) Pm[(16 * w + 4 * g + r) * LQ + 16 * n + i16] = (bf16)0; }
        }
        LDS_FENCE();
#pragma unroll
        for (int k = 0; k < 5; ++k) accC[k] = accC[k] * s_old;
#pragma unroll
        for (int s = 0; s < 4; ++s) { const bf16x8 ak = frag_tr(Kw, LK, 32 * s, 16 * dt, lane); const bool doi = (s <= (w >> 1)); bf16x8 ap = ak;
            if (doi) ap = frag_row(Pm, LQ, 16 * w, 32 * s, lane);
#pragma unroll
          for (int hf = 0; hf < 2; ++hf) { const bool dos = (hf == eh);
            if (doi || dos) { bf16x8 bb[5];
#pragma unroll
              for (int n = 0; n < 5; ++n) bb[n] = frag_tr(Vm, LV, 32 * s, 16 * (5 * hf + n), lane);
              SCHED_FENCE();
              if (doi) {
#pragma unroll
                for (int n = 0; n < 5 - hf; ++n) acco[5 * hf + n] = MFMA16(ap, bb[n], acco[5 * hf + n]); }
              if (dos) {
#pragma unroll
                for (int k = 0; k < 5; ++k) accC[k] = MFMA16(ak, bb[k], accC[k]); } } } }
        bf16 gvr[4][8];
#pragma unroll
        for (int r = 0; r < 4; ++r) { const bf16* gr = zb + (size_t)(t0 + 16 * w + 4 * g + r) * NZ + Z_MO + h * 128 + i16;
#pragma unroll
            for (int n = 0; n < 8; ++n) gvr[r][n] = gr[16 * n]; }
        LDS_FENCE();
        __syncthreads();
#pragma unroll
        for (int k = 0; k < 5; ++k)
#pragma unroll
            for (int r = 0; r < 4; ++r) Cm[(16 * dt + 4 * g + r) * LV + 16 * (5 * eh + k) + i16] = (bf16)f2bf(accC[k][r]);
#pragma unroll
        for (int r = 0; r < 4; ++r) {
            const float den = __shfl(acco[8][r], lane & 48);
            const float dd = 1.0f / fmaxf(fabsf(den), __expf(-(ai[r] + Mi[r])));
            float q = 0.f;
#pragma unroll
            for (int n = 0; n < 8; ++n) { acco[n][r] *= dd; q += acco[n][r] * acco[n][r]; }
            const float rstd = rsqrtf(red16_sum(q) * (1.f / 128.f) + 1e-6f);
            const int pos = t0 + 16 * w + 4 * g + r; bf16* yr = yb + (size_t)pos * 1024;
#pragma unroll
            for (int n = 0; n < 8; ++n) { const int e = 16 * n + i16; yr[e] = (bf16)f2bf(acco[n][r] * rstd * nwv[n] * sigm(bf1(gvr[r][n]) * rri[r])); }
        }
        m_prev = m_new;
    }
    __syncthreads();
#undef ML_FETCH
}
__device__ __forceinline__ int vt_off(int row, int chunk) { return row * 128 + ((chunk ^ ((row & 7) << 1)) << 3); }
__device__ __forceinline__ bf16x8 frag_trp(const LAS bf16* X, int k0, int c0, int lane) {
    const int g = lane >> 4, q = (lane & 15) >> 2, p = lane & 3;
    const LAS bf16* a = X + vt_off(k0 + 4 * g + q, (c0 >> 3) + (p >> 1)) + 4 * (p & 1);
    const s16x4 lo = __builtin_amdgcn_ds_read_tr16_b64_v4i16((LAS s16x4*)a);
    const s16x4 hi = __builtin_amdgcn_ds_read_tr16_b64_v4i16((LAS s16x4*)(a + 16 * 128));
    return __builtin_shufflevector(lo, hi, 0, 1, 2, 3, 4, 5, 6, 7);
}
__device__ __forceinline__ void moba_unit(Frame& F, const float* qn, int b, int h, int qi) {
    constexpr int KT_E = 128 * LQ, VT_E = 128 * 128;
    LAS bf16* Kt0 = (LAS bf16*)(F.lds); LAS bf16* Vt0 = Kt0 + 2 * KT_E; LAS float* RR = (LAS float*)(Vt0 + 2 * VT_E);
    const int tid = F.tid, lane = F.lane, w = tid >> 6, i16 = lane & 15, g = lane >> 4;
    const int blk = qi >> 1, qt = qi & 1, q0 = qi * 128;
    const bf16* zb = WSP(bf16, WS_Z) + (size_t)(b * SEQ) * NZ + h * 128;
    bf16x8 aq[4];
    { const bf16* qr = zb + (size_t)(q0 + 16 * w + i16) * NZ + Z_AQ + 8 * g;
#pragma unroll
      for (int s = 0; s < 4; ++s) aq[s] = *(const bf16x8*)(qr + 32 * s); }
    const int lr = tid >> 2, dg = tid & 3;
    v4u pk[4], pv[4]; float prr;
    const float* rstdb = WSP(float, WS_RSTD) + (size_t)(b * SEQ);
#define MB_FETCH(k0_) do { const bf16* zr_ = zb + (size_t)((k0_) + lr) * NZ + 32 * dg; \
        _Pragma("unroll") for (int q_ = 0; q_ < 4; ++q_) { pk[q_] = *(const v4u*)(zr_ + Z_AK + 8 * q_); pv[q_] = *(const v4u*)(zr_ + Z_AV + 8 * q_); } prr = rstdb[(k0_) + lr]; } while (0)
#define MB_STAGE(buf_) do { LAS bf16* kd_ = Kt0 + (buf_) * KT_E + lr * LQ + 32 * dg; LAS bf16* vd_ = Vt0 + (buf_) * VT_E; \
        _Pragma("unroll") for (int q_ = 0; q_ < 4; ++q_) { *(LAS v4u*)(kd_ + 8 * q_) = pk[q_]; *(LAS v4u*)(vd_ + vt_off(lr, 4 * dg + q_)) = pv[q_]; } if (dg == 0) RR[(buf_) * 128 + lr] = prr; } while (0)
    MB_FETCH(0);
    { float ss = 0.f; float qf[4][8];
#pragma unroll
      for (int s = 0; s < 4; ++s) { const v4u x = __builtin_bit_cast(v4u, aq[s]); qf[s][0] = bflo(x.x); qf[s][1] = bfhi(x.x); qf[s][2] = bflo(x.y); qf[s][3] = bfhi(x.y); qf[s][4] = bflo(x.z); qf[s][5] = bfhi(x.z); qf[s][6] = bflo(x.w); qf[s][7] = bfhi(x.w);
#pragma unroll
          for (int j = 0; j < 8; ++j) ss += qf[s][j] * qf[s][j]; }
      ss += __shfl_xor(ss, 16); ss += __shfl_xor(ss, 32);
      const int pos = q0 + 16 * w + i16; const float rr = rstdb[pos]; const float f = rr * rsqrtf(ss * rr * rr * (1.f / 128.f) + 1e-6f);
      const f32x2* tb = WSP(f32x2, WS_TAB) + SEQ * 64 + pos * 64 + 8 * g;
#pragma unroll
      for (int s = 0; s < 2; ++s) {
#pragma unroll
          for (int j = 0; j < 8; ++j) { const float x1 = qf[s][j] * f * qn[32 * s + 8 * g + j], x2 = qf[s + 2][j] * f * qn[64 + 32 * s + 8 * g + j]; const f32x2 cs = tb[32 * s + j];
              qf[s][j] = x1 * cs.x - x2 * cs.y; qf[s + 2][j] = x1 * cs.y + x2 * cs.x; } }
#pragma unroll
      for (int s = 0; s < 4; ++s) { const v4u o = (v4u){pk2(qf[s][0], qf[s][1]), pk2(qf[s][2], qf[s][3]), pk2(qf[s][4], qf[s][5]), pk2(qf[s][6], qf[s][7])}; aq[s] = __builtin_bit_cast(bf16x8, o); } }
    unsigned sel = 0u;
    {
        f32x4 gacc = (f32x4){0.f, 0.f, 0.f, 0.f};
        const float* km = WSP(float, WS_KMEAN) + (size_t)((b * NH + h) * 16) * 128 + (size_t)(i16 & 7) * 256 + 8 * g;
        const bool live = i16 < blk;
#pragma unroll
        for (int s = 0; s < 4; ++s) { f32x4 k0 = (f32x4){0.f, 0.f, 0.f, 0.f}, k1 = k0;
            if (live) { k0 = *(const f32x4*)(km + 32 * s) + *(const f32x4*)(km + 128 + 32 * s); k1 = *(const f32x4*)(km + 32 * s + 4) + *(const f32x4*)(km + 128 + 32 * s + 4); }
            const v4u hi = (v4u){pk2(k0.x, k0.y), pk2(k0.z, k0.w), pk2(k1.x, k1.y), pk2(k1.z, k1.w)};
            const v4u lo = (v4u){pk2(k0.x - bflo(hi.x), k0.y - bfhi(hi.x)), pk2(k0.z - bflo(hi.y), k0.w - bfhi(hi.y)), pk2(k1.x - bflo(hi.z), k1.y - bfhi(hi.z)), pk2(k1.z - bflo(hi.w), k1.w - bfhi(hi.w))};
            gacc = MFMA16(__builtin_bit_cast(bf16x8, hi), aq[s], gacc); gacc = MFMA16(__builtin_bit_cast(bf16x8, lo), aq[s], gacc); }
        float gate[8];
#pragma unroll
        for (int n = 0; n < 8; ++n) { const float gv = __shfl(gacc[n & 3], i16 + 16 * (n >> 2)); gate[n] = (n < blk) ? gv : -INFINITY; }
#pragma unroll
        for (int s = 0; s < 3; ++s) { float bv = -INFINITY; int best = -1;
#pragma unroll
            for (int n = 0; n < 8; ++n) { const bool c = !((sel >> n) & 1u) && gate[n] > bv; bv = c ? gate[n] : bv; best = c ? n : best; }
            if (best >= 0) sel |= 1u << best; }
    }
#pragma unroll
    for (int s = 0; s < 4; ++s) { const v4u u = __builtin_bit_cast(v4u, aq[s]); const float c2 = 0.08838834764831845f * 1.4426950408889634f;
        const v4u o = (v4u){pk2(bflo(u.x) * c2, bfhi(u.x) * c2), pk2(bflo(u.y) * c2, bfhi(u.y) * c2), pk2(bflo(u.z) * c2, bfhi(u.z) * c2), pk2(bflo(u.w) * c2, bfhi(u.w) * c2)}; aq[s] = __builtin_bit_cast(bf16x8, o); }
    f32x4 acco[8];
#pragma unroll
    for (int n = 0; n < 8; ++n) acco[n] = (f32x4){0.f, 0.f, 0.f, 0.f};
    float mq = -1e30f, lq = 0.f;
    const int ntiles = 2 * blk + qt + 1;
    const int qrel = 16 * w + i16 - 4 * g;
    __syncthreads();
    MB_STAGE(0);
    if (ntiles > 1) MB_FETCH(128);
    __syncthreads();
    for (int kt = 0; kt < ntiles; ++kt) {
        const int kb = kt >> 1; const bool own = (kb == blk), diag = (kt == 2 * blk + qt);
        const LAS bf16* Kt = Kt0 + (kt & 1) * KT_E; const LAS bf16* Vt = Vt0 + (kt & 1) * VT_E;
        f32x4 sc[8];
#pragma unroll
        for (int n = 0; n < 8; ++n) sc[n] = (f32x4){0.f, 0.f, 0.f, 0.f};
#pragma unroll
        for (int s = 0; s < 4; ++s) { bf16x8 bb[8];
#pragma unroll
            for (int n = 0; n < 8; ++n) bb[n] = frag_row(Kt, LQ, 16 * n, 32 * s, lane);
            SCHED_FENCE();
#pragma unroll
            for (int n = 0; n < 8; ++n) sc[n] = MFMA16(bb[n], aq[s], sc[n]); }
        if (diag) {
#pragma unroll
            for (int n = 0; n < 8; ++n)
#pragma unroll
                for (int r = 0; r < 4; ++r) sc[n][r] = (16 * n + r <= qrel) ? sc[n][r] : -1e30f; }
        const bool rowok = own || ((sel >> kb) & 1u);
        float mx = -1e30f;
#pragma unroll
        for (int n = 0; n < 8; ++n) mx = fmaxf(mx, fmaxf(fmaxf(sc[n][0], sc[n][1]), fmaxf(sc[n][2], sc[n][3])));
        mx = fmaxf(mx, __shfl_xor(mx, 16)); mx = fmaxf(mx, __shfl_xor(mx, 32));
        const float mnew = rowok ? fmaxf(mq, mx) : mq;
        const float alpha = __builtin_amdgcn_exp2f(mq - mnew); mq = mnew;
        const float msub = rowok ? mnew : 1e30f;
        float ps = 0.f;
#pragma unroll
        for (int n = 0; n < 8; ++n)
#pragma unroll
            for (int r = 0; r < 4; ++r) { sc[n][r] = __builtin_amdgcn_exp2f(sc[n][r] - msub); ps += sc[n][r]; }
        lq = lq * alpha + ps;
        { const LAS float* rrt = RR + (kt & 1) * 128 + 4 * g;
#pragma unroll
          for (int n = 0; n < 8; ++n) sc[n] = sc[n] * *(const LAS f32x4*)(rrt + 16 * n); }
        if (!__all(alpha == 1.0f)) {
#pragma unroll
            for (int n = 0; n < 8; ++n) acco[n] = acco[n] * alpha; }
#pragma unroll
        for (int t = 0; t < 4; ++t) {
            const v4u pw = (v4u){pk2(sc[2 * t][0], sc[2 * t][1]), pk2(sc[2 * t][2], sc[2 * t][3]), pk2(sc[2 * t + 1][0], sc[2 * t + 1][1]), pk2(sc[2 * t + 1][2], sc[2 * t + 1][3])};
            const bf16x8 pf = __builtin_bit_cast(bf16x8, pw); bf16x8 bb[8];
#pragma unroll
            for (int n = 0; n < 8; ++n) bb[n] = frag_trp(Vt, 32 * t, 16 * n, lane);
            SCHED_FENCE();
#pragma unroll
            for (int n = 0; n < 8; ++n) acco[n] = MFMA16(bb[n], pf, acco[n]); }
        if (kt + 1 < ntiles) { MB_STAGE((kt + 1) & 1); if (kt + 2 < ntiles) MB_FETCH((kt + 2) * 128); }
        __syncthreads();
    }
    lq += __shfl_xor(lq, 16); lq += __shfl_xor(lq, 32);
    const float inv = 1.0f / lq;
    bf16* yr = WSP(bf16, WS_Y) + (size_t)2 * M * 1024 + (size_t)(b * SEQ + q0 + 16 * w + i16) * 1024 + h * 128 + 4 * g;
#pragma unroll
    for (int n = 0; n < 8; ++n) *(v2u*)(yr + 16 * n) = (v2u){pk2(acco[n][0] * inv, acco[n][1] * inv), pk2(acco[n][2] * inv, acco[n][3] * inv)};
#undef MB_FETCH
#undef MB_STAGE
}
__device__ __forceinline__ void mix_phase(Frame& F, const float* rgn, const float* mln, const float* qn, unsigned* head) {
    volatile LAS unsigned* slot = F.MISC;
    for (;;) {
        if (F.tid == 0) slot[0] = __hip_atomic_fetch_add(head, 1u, __ATOMIC_RELAXED, __HIP_MEMORY_SCOPE_AGENT);
        __syncthreads();
        const unsigned it = slot[0];
        __syncthreads();
        if (it >= 128u + 1024u) break;
        { int t_ = threadIdx.x; asm volatile("" : "+v"(t_)); F.tid = t_; F.lane = t_ & 63; }
        if (it < 64u) ret_unit(F, rgn, (int)(it >> 3), (int)(it & 7u));
        else if (it < 128u) mlstm_unit(F, mln, (int)((it - 64u) >> 3), (int)(it & 7u));
        else { const unsigned rank = it - 128u; moba_unit(F, qn, (int)((rank & 63u) >> 3), (int)(rank & 7u), 15 - (int)(rank >> 6)); }
    }
}
}
constexpr int N_PHASES = 1 + 8 * DEPTH;
__global__ void __launch_bounds__(NWAVES * 64, 2) fwd(Args args) {
    extern __shared__ __attribute__((aligned(16))) unsigned char lds[];
    Frame F;
    F.lds = (LAS unsigned char*)lds;
    F.MISC = (volatile LAS unsigned*)(F.lds + MISC_OFF);
    F.tid = threadIdx.x; F.lane = F.tid & 63; F.wave = __builtin_amdgcn_readfirstlane(F.tid >> 6); F.G = gridDim.x; F.bx = blockIdx.x;
    F.ws = args.ws;
    for (int u = F.tid; u < (LDS_BYTES - LDSCTL_OFF) / 4; u += NWAVES * 64) ((LAS unsigned*)(F.lds + LDSCTL_OFF))[u] = 0u;
    __syncthreads();
    XcdBarrier bar = xcd_barrier_post((unsigned*)(F.ws + WS_CTL) + CW_BAR + args.li * XCD_BAR_WORDS, F.MISC + 8);
    const int lo = args.ph_lo, hi = args.ph_hi;
#define RUN(p) (lo <= (p) && (p) < hi)
#define SEAM(p) do { if ((p) + 1 < hi) xcd_barrier(bar); } while (0)
    if (RUN(0)) { p0_prologue(F, args); SEAM(0); }
    for (int l = 0; l < DEPTH; ++l) {
        const int p0 = 1 + 8 * l;
        { int t_ = threadIdx.x; asm volatile("" : "+v"(t_)); F.tid = t_; F.lane = t_ & 63; F.wave = __builtin_amdgcn_readfirstlane(t_ >> 6); int b_ = blockIdx.x; asm volatile("" : "+s"(b_)); F.bx = b_; }
        float* rs = WSP(float, WS_RS) + (size_t)(2 * l) * M * 32;
        if (RUN(p0 + 0)) {
            { const int kf = (((F.bx >> 3) & 7) >> 2);
#define IN_F8_CALL(I0, NN) { pg8::Gemm g8{WSP(bf16, WS_XB8), (const bf16*)(F.ws + ws_win8(l)), M, N8, DM / 2}; pg8::RangeOrder<pg8::StaticOrder> S8; S8.b.init(M, N8, F.G, F.bx); S8.i0 = (I0); S8.n = (NN); \
                pg8::EpiGate8 E8{F.ws + WS_ZG, 3 * DM, 1.0f / 64.0f, WSP(bf16, WS_Z), NZ, 3 * DM / 256, Z_MO}; \
                pg8::gemm_phase<pg8::EpiGate8, pg8::RangeOrder<pg8::StaticOrder>, false, true, true>(F.lds + RING_OFF, g8, S8, E8); }
              IN_F8_CALL(0, kf)
              { pg8::Gemm g{WSP(bf16, WS_XB), WSP(bf16, WS_WIN) + (size_t)l * NZ * DM, M, Z_GA - 1024, DM}; pg8::SkipOrder S; S.init(M, Z_GA - 1024, F.G, F.bx); S.skip0 = Z_MO / 256; S.nskip = 4;
                pg8::EpiBf16 E{WSP(bf16, WS_Z), NZ, nullptr, -1, 0};
                pg8::gemm_phase<pg8::EpiBf16, pg8::SkipOrder, false, true>(F.lds + RING_OFF, g, S, E); }
              { int kf2 = (((F.bx >> 3) & 7) >> 2); asm volatile("" : "+s"(kf2));
                IN_F8_CALL(kf2, 1 << 20) }
#undef IN_F8_CALL
            }
            SEAM(p0 + 0); }
        if (RUN(p0 + 1)) { prep_phase(F, args.in[I_QN] + l * 128, args.in[I_KN] + l * 128, WSP(bf16, WS_W16G) + (size_t)l * 16 * DM, rs, args.in[I_BIG] + l * 8, args.in[I_BFG] + l * 8); SEAM(p0 + 1); }
        if (RUN(p0 + 2)) { mx::mix_phase(F, args.in[I_RGN] + l * 1024, args.in[I_MLN] + l * 1024, args.in[I_QN] + l * 128, (unsigned*)(F.ws + WS_CTL) + CW_QUEUE + 64 * l); SEAM(p0 + 2); }
        if (RUN(p0 + 3)) {
            pg8::StaticOrder3 S; S.init(M, DM, F.G, F.bx);
            pg8::Gemm g{WSP(bf16, WS_Y), WSP(bf16, WS_WP) + (size_t)l * 3 * DM * 1024, M, DM, 1024, (size_t)M * 1024, (size_t)DM * 1024}; pg8::EpiGateAcc E{WSP(bf16, WS_MG), DM, F.ws + WS_ZG, 3 * DM, WSP(float, WS_RSTD)};
            pg8::gemm_phase<pg8::EpiGateAcc, pg8::StaticOrder3, true, true>(F.lds + RING_OFF, g, S, E);
            SEAM(p0 + 3); }
        if (RUN(p0 + 4)) {
            pg8::Gemm g{WSP(bf16, WS_MG), WSP(bf16, WS_WOUT) + (size_t)l * DM * DM, M, DM, DM}; pg8::StaticOrder S; S.init(M, DM, F.G, F.bx);
            pg8::EpiRes<false> E{WSP(bf16, WS_XB), rs + (size_t)32 * M, nullptr, DM};
            pg8::gemm_phase<pg8::EpiRes<false>, pg8::StaticOrder, true, true>(F.lds + RING_OFF, g, S, E);
            SEAM(p0 + 4); }
        if (RUN(p0 + 5)) {
            pg8::Gemm g{WSP(bf16, WS_XB), WSP(bf16, WS_WUP) + (size_t)l * NUP * DM, M, NUP, DM}; pg8::StaticOrder S; S.init(M, NUP, F.G, F.bx);
            pg8::EpiGLU E{WSP(bf16, WS_ACT), args.in[I_CW] + (size_t)l * 3 * NUP, args.in[I_CB] + (size_t)l * NUP, rs + (size_t)32 * M, WSP(bf16, WS_SB)};
            pg8::gemm_phase<pg8::EpiGLU, pg8::StaticOrder, false, true>(F.lds + RING_OFF, g, S, E);
            SEAM(p0 + 5); }
        if (RUN(p0 + 6)) { glu_fix_phase(F, args.in[I_CW] + (size_t)l * 3 * NUP, args.in[I_CB] + (size_t)l * NUP); SEAM(p0 + 6); }
        if (RUN(p0 + 7)) {
            pg8::Gemm g{WSP(bf16, WS_ACT), WSP(bf16, WS_WDN) + (size_t)l * DM * DFF, M, DM, DFF}; pg8::StaticOrder S; S.init(M, DM, F.G, F.bx);
            if (l + 1 < DEPTH) { pg8::EpiRes<false, true> E{WSP(bf16, WS_XB), rs + (size_t)64 * M, nullptr, DM, F.ws + WS_XB8};
                pg8::gemm_phase<pg8::EpiRes<false, true>, pg8::StaticOrder, true, true>(F.lds + RING_OFF, g, S, E); }
            else { pg8::EpiRes<true> E{WSP(bf16, WS_XB), nullptr, args.out, DM};
                pg8::gemm_phase<pg8::EpiRes<true>, pg8::StaticOrder, true, true>(F.lds + RING_OFF, g, S, E); }
            SEAM(p0 + 7); }
    }
#undef RUN
#undef SEAM
}

#ifndef MK_N_LAUNCHES
#define MK_N_LAUNCHES 1
#endif
extern "C" void kernel_launch(void* const* d_in, const int* in_sizes, int n_in, void* d_out, int out_size, void* d_ws, size_t ws_size, hipStream_t stream) {
    static int grid = 0;
    if (grid == 0) {
        if (n_in != 18 || in_sizes[0] != M * DM || out_size != M * DM || ws_size < WS_END) { fprintf(stderr, "kernel_launch: unexpected shapes (n_in %d, in0 %d, out %d, ws %zu)\n", n_in, n_in > 0 ? in_sizes[0] : -1, out_size, ws_size); grid = -1; return; }
        int dev = 0, cus = 0, per_cu = 0;
        if (hipGetDevice(&dev) != hipSuccess || hipDeviceGetAttribute(&cus, hipDeviceAttributeMultiprocessorCount, dev) != hipSuccess) { grid = -1; return; }
        if (hipFuncSetAttribute((const void*)fwd, hipFuncAttributeMaxDynamicSharedMemorySize, LDS_BYTES) != hipSuccess) { fprintf(stderr, "kernel_launch: hipFuncSetAttribute failed\n"); grid = -1; return; }
        if (hipOccupancyMaxActiveBlocksPerMultiprocessor(&per_cu, (const void*)fwd, NWAVES * 64, LDS_BYTES) != hipSuccess || per_cu < 1) fprintf(stderr, "kernel_launch: occupancy query reports %d\n", per_cu);
        (void)hipGetLastError();
        grid = cus;
    }
    if (grid < 0) return;
    if (hipMemsetAsync((char*)d_ws + WS_CTL, 0, CTL_ZERO_BYTES, stream) != hipSuccess) return;
    Args a{};
    for (int i = 0; i < 18; ++i) a.in[i] = (const float*)d_in[i];
    a.out = (float*)d_out; a.ws = (unsigned char*)d_ws; a.pad = 0;
    constexpr int NL = MK_N_LAUNCHES;
    for (int li = 0; li < NL; ++li) {
        a.ph_lo = (NL == 1) ? 0 : li; a.ph_hi = (NL == 1) ? N_PHASES : li + 1; a.li = (NL == 1) ? 0 : 0;
        hipLaunchKernelGGL(fwd, dim3(grid), dim3(NWAVES * 64), LDS_BYTES, stream, a);
    }
}
```

```cpp
#include <hip/hip_runtime.h>
#include <cstdio>
#include <cstdint>
namespace pg8 {
#define PG8_LAS __attribute__((address_space(3)))
typedef unsigned short bf16_t;
typedef short bf16x8 __attribute__((ext_vector_type(8)));
typedef float f32x4 __attribute__((ext_vector_type(4)));
typedef unsigned u32x4 __attribute__((ext_vector_type(4)));
constexpr int BM = 256, BK = 64, HALF = 128, HTB = HALF * BK * 2  , STAGE_BYTES = 8 * HTB, NXCD = 8, WGM = 8;

__host__ __device__ __forceinline__ int lds_byte(int r, int c) { const int st = (r >> 4) * 2 + (c >> 5), rr = r & 15, cc = c & 31, ob = rr * 64 + cc * 2; return st * 1024 + (ob ^ (((ob >> 9) & 1) << 5)); }
__host__ __device__ __forceinline__ void stage_rc(int b, int& R, int& C) { const int st = b / 1024, sb = b % 1024, swz = sb ^ (((sb >> 9) & 1) << 5); R = (st >> 1) * 16 + swz / 64; C = (st & 1) * 32 + (swz % 64) / 2; }
__host__ __device__ __forceinline__ int perm32(int rho) { const int n = rho >> 4, i = rho & 15; return 8 * (i >> 2) + 4 * n + (i & 3); }

struct Unit { int pm, pn, z; };
struct Gemm { const bf16_t* A; const bf16_t* Bt; int M, N, K; size_t zA, zB; };

struct StaticOrder {
    int nM, nN, nwg, G, c;
    __host__ __device__ void init(int M, int N, int G_, int c_) { nM = M / BM; nN = N / BM; nwg = nM * nN; G = G_; c = c_; }
    __host__ __device__ bool next(int i, Unit& u) const {
        const long L = (long)i * G + c; if (L >= nwg) return false;
        int wgid = (int)L; { const int q = nwg / NXCD, r = nwg % NXCD, xcd = wgid % NXCD, off = wgid / NXCD; wgid = (xcd < r ? xcd * (q + 1) : r * (q + 1) + (xcd - r) * q) + off; }
        const int nig = WGM * nN, gid = wgid / nig, fm = gid * WGM, gsz = (nM - fm) < WGM ? (nM - fm) : WGM;
        u.pm = fm + ((wgid % nig) % gsz); u.pn = (wgid % nig) / gsz; u.z = 0; return true;
    }
    __device__ __forceinline__ void a_ready(const Unit&) const {}
    __device__ __forceinline__ void done(const Unit&) const {}
};

struct SkipOrder : StaticOrder {
    int skip0, nskip;
    __host__ __device__ bool next(int i, Unit& u) const { if (!StaticOrder::next(i, u)) return false; if (u.pn >= skip0) u.pn += nskip; return true; }
};
template <class Base> struct RangeOrder {
    Base b; int i0, n;
    __host__ __device__ bool next(int i, Unit& u) const { return i < n && b.next(i0 + i, u); }
    __device__ __forceinline__ void a_ready(const Unit&) const {}
    __device__ __forceinline__ void done(const Unit&) const {}
};
struct StaticOrder3 : StaticOrder {
    __host__ __device__ bool next(int i, Unit& u) const { if (!StaticOrder::next(i / 3, u)) return false; u.z = i % 3; return true; }
};
__device__ __forceinline__ unsigned cvt_pk_bf16(float lo, float hi) { unsigned r; asm volatile("v_cvt_pk_bf16_f32 %0, %1, %2" : "=v"(r) : "v"(lo), "v"(hi)); return r; }
typedef unsigned u32x2 __attribute__((ext_vector_type(2)));
__device__ __forceinline__ u32x4 qgather(const u32x4 w, int lane) { const int src = 4 * (16 * (lane & 3) + (lane >> 2)); u32x4 o;
#pragma unroll
    for (int k = 0; k < 4; ++k) o[k] = (unsigned)__builtin_amdgcn_ds_bpermute(src, (int)w[k]); return o; }
__device__ __forceinline__ u32x4 qscatter(const u32x4 w, int lane) { const int src = 4 * (4 * (lane & 15) + (lane >> 4)); u32x4 o;
#pragma unroll
    for (int k = 0; k < 4; ++k) o[k] = (unsigned)__builtin_amdgcn_ds_bpermute(src, (int)w[k]); return o; }
struct EpiBf16 {
    static constexpr bool PERM = true, AFTER_DRAIN = false, KEEP = false, APERM = false;
    bf16_t* O; int ldc; unsigned char* G8; int g8_pn0, g8_ld;
    __device__ __forceinline__ void operator()(const f32x4 (&acc)[2][2][4][2], const Unit& u, int wr, int wc, int fr, int fq) const {
        const int lane = 16 * fq + fr; const int row0 = u.pm * BM + wr * 64 + (lane >> 2); const int col0 = u.pn * BM + wc * 32 + 8 * (lane & 3);
#pragma unroll
        for (int ai = 0; ai < 2; ++ai)
#pragma unroll
            for (int m = 0; m < 4; ++m) { bf16_t* rowp = O + (size_t)(row0 + ai * HALF + m * 16) * ldc + col0;
#pragma unroll
                for (int bj = 0; bj < 2; ++bj) { const f32x4 v0 = acc[ai][bj][m][0], v1 = acc[ai][bj][m][1];
                    u32x4 w; w.x = cvt_pk_bf16(v0[0], v0[1]); w.y = cvt_pk_bf16(v0[2], v0[3]); w.z = cvt_pk_bf16(v1[0], v1[1]); w.w = cvt_pk_bf16(v1[2], v1[3]);
                    *(u32x4*)(rowp + bj * HALF) = qgather(w, lane); } }
    }
};
struct EpiGate8 {
    static constexpr bool PERM = true, AFTER_DRAIN = false, KEEP = false, APERM = false;
    unsigned char* G8; int g8_ld; float sc; bf16_t* O; int ldc, o_pn0, o_col0;
    __device__ __forceinline__ void operator()(const f32x4 (&acc)[2][2][4][2], const Unit& u, int wr, int wc, int fr, int fq) const {
        const int lane = 16 * fq + fr; const int row0 = u.pm * BM + wr * 64 + (lane >> 2); const int pc = wc * 32 + 8 * (lane & 3);
        if (u.pn >= o_pn0) { const int col0 = o_col0 + (u.pn - o_pn0) * BM + pc;
#pragma unroll
            for (int ai = 0; ai < 2; ++ai)
#pragma unroll
                for (int m = 0; m < 4; ++m) { bf16_t* rowp = O + (size_t)(row0 + ai * HALF + m * 16) * ldc + col0;
#pragma unroll
                    for (int bj = 0; bj < 2; ++bj) { const f32x4 v0 = acc[ai][bj][m][0] * sc, v1 = acc[ai][bj][m][1] * sc;
                        u32x4 w; w.x = cvt_pk_bf16(v0[0], v0[1]); w.y = cvt_pk_bf16(v0[2], v0[3]); w.z = cvt_pk_bf16(v1[0], v1[1]); w.w = cvt_pk_bf16(v1[2], v1[3]);
                        *(u32x4*)(rowp + bj * HALF) = qgather(w, lane); } }
            return; }
        const int gc0 = u.pn * BM + pc; const int src = 4 * (16 * (lane & 3) + (lane >> 2));
#pragma unroll
        for (int ai = 0; ai < 2; ++ai)
#pragma unroll
            for (int m = 0; m < 4; ++m) { unsigned char* rowp = G8 + (size_t)(row0 + ai * HALF + m * 16) * g8_ld + gc0;
#pragma unroll
                for (int bj = 0; bj < 2; ++bj) { const f32x4 v0 = acc[ai][bj][m][0] * sc, v1 = acc[ai][bj][m][1] * sc; u32x2 w;
                    w.x = (unsigned)__builtin_amdgcn_cvt_pk_fp8_f32(v0[2], v0[3], __builtin_amdgcn_cvt_pk_fp8_f32(v0[0], v0[1], 0, false), true);
                    w.y = (unsigned)__builtin_amdgcn_cvt_pk_fp8_f32(v1[2], v1[3], __builtin_amdgcn_cvt_pk_fp8_f32(v1[0], v1[1], 0, false), true);
                    w.x = (unsigned)__builtin_amdgcn_ds_bpermute(src, (int)w.x); w.y = (unsigned)__builtin_amdgcn_ds_bpermute(src, (int)w.y);
                    *(u32x2*)(rowp + bj * HALF) = w; } }
    }
};
__device__ __forceinline__ float bf_lo(unsigned w) { return __uint_as_float(w << 16); }
__device__ __forceinline__ float bf_hi(unsigned w) { return __uint_as_float(w & 0xffff0000u); }
__device__ __forceinline__ float sigmoid_f(float x) { return __builtin_amdgcn_rcpf(1.0f + __expf(-x)); }
struct EpiGateAcc {
    static constexpr bool PERM = true, AFTER_DRAIN = false, KEEP = true, APERM = false;
    bf16_t* O; int ldc; const unsigned char* G8; int g8_ld; const float* rstd;
    template <int E> static __device__ __forceinline__ float g8f(const u32x2 w) { return __builtin_amdgcn_cvt_f32_fp8((int)(E < 4 ? w.x : w.y), E & 3); }
    static __device__ __forceinline__ float em(float g, float r2) { return __builtin_amdgcn_exp2f(fminf(fmaxf(g * r2, -57.70780f), 57.70780f)); }
    __device__ __forceinline__ void operator()(f32x4 (&acc)[2][2][4][2], const Unit& u, int wr, int wc, int fr, int fq) const {
        const int row0 = u.pm * BM + wr * 64 + fr; const int col0 = u.pn * BM + wc * 32 + 8 * fq; const bool last = (u.z == 2); const float dmask = last ? 0.0f : 1.0f;
        const unsigned char* Gn = G8 + (size_t)u.z * ldc; const unsigned char* Gd = G8 + (size_t)(last ? u.z : u.z + 1) * ldc;
#pragma unroll
        for (int ai = 0; ai < 2; ++ai)
#pragma unroll
            for (int m = 0; m < 4; ++m) { const size_t row = (size_t)(row0 + ai * HALF + m * 16); const float rr = rstd[row] * -1.44269504f;
#pragma unroll
                for (int bj = 0; bj < 2; ++bj) {
                    const u32x2 gn = *(const u32x2*)(Gn + row * g8_ld + col0 + bj * HALF), gd = *(const u32x2*)(Gd + row * g8_ld + col0 + bj * HALF);
                    f32x4 v0 = acc[ai][bj][m][0], v1 = acc[ai][bj][m][1];
#define GA_MUL(E) ((1.0f + dmask * em(g8f<E>(gd), rr)) * __builtin_amdgcn_rcpf(1.0f + em(g8f<E>(gn), rr)))
                    v0[0] *= GA_MUL(0); v0[1] *= GA_MUL(1); v0[2] *= GA_MUL(2); v0[3] *= GA_MUL(3); v1[0] *= GA_MUL(4); v1[1] *= GA_MUL(5); v1[2] *= GA_MUL(6); v1[3] *= GA_MUL(7);
#undef GA_MUL
                    acc[ai][bj][m][0] = v0; acc[ai][bj][m][1] = v1;
                    if (last) { u32x4 w; w.x = cvt_pk_bf16(v0[0], v0[1]); w.y = cvt_pk_bf16(v0[2], v0[3]); w.z = cvt_pk_bf16(v1[0], v1[1]); w.w = cvt_pk_bf16(v1[2], v1[3]); *(u32x4*)(O + row * ldc + col0 + bj * HALF) = w; } } }
    }
};
template <bool LAST, bool F8 = false> struct EpiRes {
    static constexpr bool PERM = true, AFTER_DRAIN = false, KEEP = false, APERM = false;
    bf16_t* xb; float* rs; float* out; int ldc; unsigned char* x8;
    __device__ __forceinline__ void operator()(const f32x4 (&acc)[2][2][4][2], const Unit& u, int wr, int wc, int fr, int fq) const {
        const int row0 = u.pm * BM + wr * 64 + fr; const int col0 = u.pn * BM + wc * 32 + 8 * fq;
#pragma unroll
        for (int ai = 0; ai < 2; ++ai)
#pragma unroll
            for (int m = 0; m < 4; ++m) { const int row = row0 + ai * HALF + m * 16; const size_t off = (size_t)row * ldc + col0; float sq = 0.f;
#pragma unroll
                for (int bj = 0; bj < 2; ++bj) { const u32x4 p = *(const u32x4*)(xb + off + bj * HALF); const f32x4 v0 = acc[ai][bj][m][0], v1 = acc[ai][bj][m][1];
                    const float o0 = bf_lo(p.x) + v0[0], o1 = bf_hi(p.x) + v0[1], o2 = bf_lo(p.y) + v0[2], o3 = bf_hi(p.y) + v0[3], o4 = bf_lo(p.z) + v1[0], o5 = bf_hi(p.z) + v1[1], o6 = bf_lo(p.w) + v1[2], o7 = bf_hi(p.w) + v1[3];
                    if (LAST) { *(f32x4*)(out + off + bj * HALF) = (f32x4){o0, o1, o2, o3}; *(f32x4*)(out + off + bj * HALF + 4) = (f32x4){o4, o5, o6, o7}; }
                    else { sq += ((o0 * o0 + o1 * o1) + (o2 * o2 + o3 * o3)) + ((o4 * o4 + o5 * o5) + (o6 * o6 + o7 * o7));
                        u32x4 w; w.x = cvt_pk_bf16(o0, o1); w.y = cvt_pk_bf16(o2, o3); w.z = cvt_pk_bf16(o4, o5); w.w = cvt_pk_bf16(o6, o7); *(u32x4*)(xb + off + bj * HALF) = w;
                        if (F8) { u32x2 q; q.x = (unsigned)__builtin_amdgcn_cvt_pk_fp8_f32(o2, o3, __builtin_amdgcn_cvt_pk_fp8_f32(o0, o1, 0, false), true); q.y = (unsigned)__builtin_amdgcn_cvt_pk_fp8_f32(o6, o7, __builtin_amdgcn_cvt_pk_fp8_f32(o4, o5, 0, false), true);
                            *(u32x2*)(x8 + off + bj * HALF) = q; } } }
                if (!LAST) { sq += __shfl_xor(sq, 16); sq += __shfl_xor(sq, 32); if (fq == 0) rs[(size_t)row * 32 + u.pn * 4 + wc] = sq; } }
    }
};

struct EpiGLU {
    static constexpr bool PERM = true, AFTER_DRAIN = false, KEEP = false, APERM = true;
    bf16_t* ACT; const float* cw; const float* cb; const float* rs; bf16_t* SB;
    static __device__ __forceinline__ f32x4 prev_lane(const f32x4 v, int src) { f32x4 o;
#pragma unroll
        for (int k = 0; k < 4; ++k) o[k] = __shfl(v[k], src); return o; }
    static __device__ __forceinline__ f32x4 silu4(const f32x4 a) { f32x4 o;
#pragma unroll
        for (int k = 0; k < 4; ++k) o[k] = a[k] * __builtin_amdgcn_rcpf(1.0f + __expf(-a[k])); return o; }
    __device__ __forceinline__ void operator()(const f32x4 (&acc)[2][2][4][2], const Unit& u, int wr, int wc, int fr, int fq) const {
        constexpr int DFF_ = 5632, NUP_ = 2 * DFF_;
        const int T0 = u.pm * BM + 8 * (16 * wr + fr), jq = u.pn * HALF + wc * 32 + 8 * fq, grp = 2 * u.pm + wr;
        const int lane = 16 * fq + fr, qsrc = 4 * (16 * (lane & 3) + (lane >> 2)), Tq = u.pm * BM + 8 * (16 * wr + (lane >> 2)), jqq = u.pn * HALF + wc * 32 + 8 * (lane & 3);
        float s0 = 0.f, s1 = 0.f;
        { const int L = fq * 16 + fr; const float* p0 = rs + (size_t)(u.pm * BM + 128 * wr + 2 * L) * 32;
#pragma unroll
          for (int q = 0; q < 8; ++q) { const f32x4 a = *(const f32x4*)(p0 + 4 * q), b = *(const f32x4*)(p0 + 32 + 4 * q); s0 += (a[0] + a[1]) + (a[2] + a[3]); s1 += (b[0] + b[1]) + (b[2] + b[3]); }
          s0 = __builtin_amdgcn_rsqf(s0 * (1.0f / 2048.0f) + 1e-6f); s1 = __builtin_amdgcn_rsqf(s1 * (1.0f / 2048.0f) + 1e-6f); }
        float rr[8];
#pragma unroll
        for (int i = 0; i < 8; ++i) rr[i] = __shfl((i & 1) ? s1 : s0, 4 * fr + (i >> 1));
#pragma unroll
        for (int n = 0; n < 2; ++n) { const int j = jq + 4 * n;
            const f32x4 ca = *(const f32x4*)(cb + j), cbv = *(const f32x4*)(cb + DFF_ + j);
            const f32x4 a0 = *(const f32x4*)(cw + j), a1 = *(const f32x4*)(cw + NUP_ + j), a2 = *(const f32x4*)(cw + 2 * NUP_ + j);
            const f32x4 b0 = *(const f32x4*)(cw + DFF_ + j), b1 = *(const f32x4*)(cw + NUP_ + DFF_ + j), b2 = *(const f32x4*)(cw + 2 * NUP_ + DFF_ + j);
            f32x4 va[8], vb[8];
#pragma unroll
            for (int i = 0; i < 8; ++i) { va[i] = acc[i >> 2][0][i & 3][n] * rr[i]; vb[i] = acc[i >> 2][1][i & 3][n] * rr[i]; }
            const int psrc = fq * 16 + ((fr + 15) & 15); const f32x4 pa6 = prev_lane(va[6], psrc), pa7 = prev_lane(va[7], psrc), pb6 = prev_lane(vb[6], psrc), pb7 = prev_lane(vb[7], psrc);
#pragma unroll
            for (int i = 0; i < 8; ++i) {
                const f32x4 xa1 = i >= 1 ? va[i - 1] : pa7, xa2 = i >= 2 ? va[i - 2] : (i == 1 ? pa7 : pa6), xb1 = i >= 1 ? vb[i - 1] : pb7, xb2 = i >= 2 ? vb[i - 2] : (i == 1 ? pb7 : pb6);
                const f32x4 ua = ca + a0 * xa2 + a1 * xa1 + a2 * va[i], ub = cbv + b0 * xb2 + b1 * xb1 + b2 * vb[i];
                const f32x4 o = silu4(ua) * ub;
                { u32x2 w; w.x = cvt_pk_bf16(o[0], o[1]); w.y = cvt_pk_bf16(o[2], o[3]);
                  w.x = (unsigned)__builtin_amdgcn_ds_bpermute(qsrc, (int)w.x); w.y = (unsigned)__builtin_amdgcn_ds_bpermute(qsrc, (int)w.y);
                  if (i >= 2 || (lane >> 2) != 0) *(u32x2*)(ACT + (size_t)(Tq + i) * DFF_ + jqq + 4 * n) = w; } }
            if (fr == 0) {
#pragma unroll
                for (int i = 0; i < 2; ++i) { u32x2 w; w.x = cvt_pk_bf16(va[i][0], va[i][1]); w.y = cvt_pk_bf16(va[i][2], va[i][3]); *(u32x2*)(SB + ((size_t)grp * 4 + 2 + i) * NUP_ + j) = w;
                    w.x = cvt_pk_bf16(vb[i][0], vb[i][1]); w.y = cvt_pk_bf16(vb[i][2], vb[i][3]); *(u32x2*)(SB + ((size_t)grp * 4 + 2 + i) * NUP_ + DFF_ + j) = w; } }
            if (fr == 15) {
#pragma unroll
                for (int i = 0; i < 2; ++i) { u32x2 w; w.x = cvt_pk_bf16(va[6 + i][0], va[6 + i][1]); w.y = cvt_pk_bf16(va[6 + i][2], va[6 + i][3]); *(u32x2*)(SB + ((size_t)(grp + 1) * 4 + i) * NUP_ + j) = w;
                    w.x = cvt_pk_bf16(vb[6 + i][0], vb[6 + i][1]); w.y = cvt_pk_bf16(vb[6 + i][2], vb[6 + i][3]); *(u32x2*)(SB + ((size_t)(grp + 1) * 4 + i) * NUP_ + DFF_ + j) = w; } }
        }
    }
};

template <class E, class = void> struct EpiB64 { static constexpr bool v = false; };
template <class E> struct EpiB64<E, decltype((void)E::B64)> { static constexpr bool v = E::B64; };
typedef int i32x4_t __attribute__((ext_vector_type(4)));
typedef int i32x8_t __attribute__((ext_vector_type(8)));
__device__ __forceinline__ i32x8_t cat8(const bf16x8 a, const bf16x8 b) { return __builtin_shufflevector((i32x4_t)a, (i32x4_t)b, 0, 1, 2, 3, 4, 5, 6, 7); }
template <class Epi, class Sched, bool ALIGN_EPI = false, bool SP2 = false, bool F8 = false>
__device__ __forceinline__ void gemm_phase(PG8_LAS unsigned char* lds, const Gemm g, const Sched& S, const Epi& E) {
    int tid_ = threadIdx.x; asm volatile("" : "+v"(tid_));
    const int tid = tid_, wid = __builtin_amdgcn_readfirstlane(tid >> 6), lane = tid & 63, wr = wid >> 2, wc = wid & 3, fr = lane & 15, fq = lane >> 4;
    const int K = g.K, nt = K / BK;
    unsigned voffA[2], voffB[2];
#pragma unroll
    for (int i = 0; i < 2; ++i) { int R, C; stage_rc(tid * 16 + i * 8192, R, C); const int Rb = EpiB64<Epi>::v ? (2 * (R & ~31) + perm32(R & 31)) : Epi::PERM ? ((R & ~31) + perm32(R & 31)) : R;
        const int Ra = Epi::APERM ? (8 * (16 * (R >> 6) + (R & 15)) + ((R >> 4) & 3)) : R;
        voffA[i] = (unsigned)(Ra * K + C) * 2u; voffB[i] = (unsigned)(Rb * K + C) * 2u; }
    const size_t kstep = (size_t)(BK * 2);
    const size_t hstep = (size_t)HALF * K * 2;
    const size_t hstepA = Epi::APERM ? (size_t)4 * K * 2 : hstep;
    const size_t hstepB = EpiB64<Epi>::v ? (size_t)32 * K * 2 : hstep;
    const size_t tstep = 2 * hstep;
    const unsigned ldsw = (unsigned)wid * 1024u;
    const int aoff = lds_byte(wr * 64 + fr, fq * 8), boff = lds_byte(wc * 32 + fr, fq * 8);
#define PG8_SA(b, h) (((b) * 2 + (h)) * HTB)
#define PG8_SB(b, h) ((4 + (b) * 2 + (h)) * HTB)
#define PG8_STAGE(bufoff, gbase, voff) do { _Pragma("unroll") for (int _i = 0; _i < 2; ++_i) \
        __builtin_amdgcn_global_load_lds((const unsigned*)((const char*)(gbase) + (voff)[_i]), (PG8_LAS unsigned*)(lds + (bufoff) + ldsw + _i * 8192), 16, 0, 0); } while (0)
#define PG8_LDA(dst, b, h) do { _Pragma("unroll") for (int m = 0; m < 4; ++m) _Pragma("unroll") for (int k = 0; k < 2; ++k) dst[m][k] = *(const PG8_LAS bf16x8*)(lds + PG8_SA(b, h) + aoff + m * 2048 + k * 1024); } while (0)
#define PG8_LDB(dst, b, h) do { _Pragma("unroll") for (int n = 0; n < 2; ++n) _Pragma("unroll") for (int k = 0; k < 2; ++k) dst[n][k] = *(const PG8_LAS bf16x8*)(lds + PG8_SB(b, h) + boff + n * 2048 + k * 1024); } while (0)
#define PG8_MMA(ai, bj, At, Bt) do { __builtin_amdgcn_s_setprio(1); if constexpr (F8) { _Pragma("unroll") for (int m = 0; m < 4; ++m) _Pragma("unroll") for (int n = 0; n < 2; ++n) \
        asm volatile("v_mfma_f32_16x16x128_f8f6f4 %0, %1, %2, %0" : "+v"(acc[ai][bj][m][n]) : "v"(cat8(Bt[n][0], Bt[n][1])), "v"(cat8(At[m][0], At[m][1]))); } else { \
        _Pragma("unroll") for (int m = 0; m < 4; ++m) _Pragma("unroll") for (int n = 0; n < 2; ++n) _Pragma("unroll") for (int k = 0; k < 2; ++k) \
        acc[ai][bj][m][n] = __builtin_amdgcn_mfma_f32_16x16x32_bf16(Bt[n][k], At[m][k], acc[ai][bj][m][n], 0, 0, 0); } __builtin_amdgcn_s_setprio(0); } while (0)
#define PG8_WAIT_V(n) asm volatile("s_waitcnt vmcnt(" #n ")" ::: "memory")
#define PG8_WAIT_L(n) asm volatile("s_waitcnt lgkmcnt(" #n ")" ::: "memory")
#define PG8_BAR __builtin_amdgcn_s_barrier()
#define PG8_SCHED __builtin_amdgcn_sched_barrier(0)
    Unit cur, nxt; int ui = 0;
    if (!S.next(0, cur)) return;
    f32x4 acc[2][2][4][2];
#pragma unroll
    for (int a = 0; a < 2; ++a)
#pragma unroll
        for (int b = 0; b < 2; ++b)
#pragma unroll
            for (int m = 0; m < 4; ++m)
#pragma unroll
                for (int n = 0; n < 2; ++n) acc[a][b][m][n] = (f32x4){0.f, 0.f, 0.f, 0.f};
    bf16x8 At[4][2], B0[2][2], B1[2][2];
    const char* cA = (const char*)(g.A + (size_t)cur.z * g.zA) + (size_t)cur.pm * tstep; const char* cB = (const char*)(g.Bt + (size_t)cur.z * g.zB) + (size_t)cur.pn * tstep;
    S.a_ready(cur);
    if constexpr (SP2) {
        PG8_STAGE(PG8_SB(0, 0), cB, voffB); PG8_STAGE(PG8_SB(0, 1), cB + hstepB, voffB); PG8_STAGE(PG8_SA(0, 0), cA, voffA); PG8_STAGE(PG8_SA(0, 1), cA + hstepA, voffA);
        if (wr == 1) PG8_BAR;
        PG8_WAIT_V(2); PG8_BAR;
        PG8_STAGE(PG8_SB(1, 0), cB + kstep, voffB); PG8_STAGE(PG8_SA(1, 0), cA + kstep, voffA); PG8_STAGE(PG8_SB(1, 1), cB + hstepB + kstep, voffB);
        PG8_WAIT_V(6); PG8_BAR;
    } else {
        PG8_STAGE(PG8_SB(0, 0), cB, voffB); PG8_STAGE(PG8_SA(0, 0), cA, voffA); PG8_STAGE(PG8_SB(0, 1), cB + hstepB, voffB); PG8_STAGE(PG8_SA(0, 1), cA + hstepA, voffA);
        if (wr == 1) PG8_BAR;
        PG8_WAIT_V(4); PG8_BAR;
        PG8_STAGE(PG8_SB(1, 0), cB + kstep, voffB); PG8_STAGE(PG8_SA(1, 0), cA + kstep, voffA); PG8_STAGE(PG8_SB(1, 1), cB + hstepB + kstep, voffB);
        PG8_WAIT_V(6); PG8_BAR;
    }
    for (;;) {
        const bool has_next = S.next(ui + 1, nxt);
        const char* nA = has_next ? (const char*)(g.A + (size_t)nxt.z * g.zA) + (size_t)nxt.pm * tstep : cA; const char* nB = has_next ? (const char*)(g.Bt + (size_t)nxt.z * g.zB) + (size_t)nxt.pn * tstep : cB;
        for (int t = 0; t < nt; t += 2) {
            const bool last = (t == nt - 2);
            const char* a1 = cA + (size_t)(t + 1) * kstep;
            const char* a2 = last ? nA : cA + (size_t)(t + 2) * kstep; const char* b2 = last ? nB : cB + (size_t)(t + 2) * kstep;
            const char* a3 = a2 + kstep; const char* b3 = b2 + kstep;
            if (last && has_next) S.a_ready(nxt);
            if constexpr (SP2) {
            PG8_LDB(B0, 0, 0); PG8_LDB(B1, 0, 1); PG8_SCHED; PG8_LDA(At, 0, 0); PG8_STAGE(PG8_SA(1, 1), a1 + hstepA, voffA);
            PG8_WAIT_V(8); PG8_WAIT_L(0); PG8_BAR; PG8_MMA(0, 0, At, B0); PG8_MMA(0, 1, At, B1); PG8_BAR; PG8_SCHED;
            PG8_LDA(At, 0, 1); PG8_STAGE(PG8_SB(0, 0), b2, voffB); PG8_STAGE(PG8_SB(0, 1), b2 + hstepB, voffB); PG8_STAGE(PG8_SA(0, 0), a2, voffA);
            PG8_WAIT_V(8); PG8_WAIT_L(0); PG8_BAR; PG8_MMA(1, 0, At, B0); PG8_MMA(1, 1, At, B1); PG8_BAR; PG8_SCHED;
            PG8_LDB(B0, 1, 0); PG8_LDB(B1, 1, 1); PG8_SCHED; PG8_LDA(At, 1, 0); PG8_STAGE(PG8_SA(0, 1), a2 + hstepA, voffA);
            PG8_WAIT_V(8); PG8_WAIT_L(0); PG8_BAR; PG8_MMA(0, 0, At, B0); PG8_MMA(0, 1, At, B1); PG8_BAR; PG8_SCHED;
            PG8_LDA(At, 1, 1); PG8_STAGE(PG8_SB(1, 0), b3, voffB); PG8_STAGE(PG8_SB(1, 1), b3 + hstepB, voffB); PG8_STAGE(PG8_SA(1, 0), a3, voffA);
            PG8_WAIT_V(8); PG8_WAIT_L(0); PG8_BAR; PG8_MMA(1, 0, At, B0); PG8_MMA(1, 1, At, B1); PG8_BAR; PG8_SCHED;
            } else {
            PG8_LDB(B0, 0, 0); PG8_SCHED; PG8_LDA(At, 0, 0); PG8_STAGE(PG8_SA(1, 1), a1 + hstepA, voffA);
            PG8_WAIT_L(8); PG8_BAR; PG8_WAIT_L(0); PG8_MMA(0, 0, At, B0); PG8_BAR; PG8_SCHED;
            PG8_LDB(B1, 0, 1); PG8_STAGE(PG8_SB(0, 0), b2, voffB);
            PG8_BAR; PG8_WAIT_L(0); PG8_MMA(0, 1, At, B1); PG8_BAR;
            PG8_LDA(At, 0, 1); PG8_STAGE(PG8_SA(0, 0), a2, voffA);
            PG8_BAR; PG8_WAIT_L(0); PG8_MMA(1, 0, At, B0); PG8_BAR; PG8_SCHED;
            PG8_STAGE(PG8_SB(0, 1), b2 + hstepB, voffB);
            PG8_WAIT_V(6); PG8_BAR; PG8_MMA(1, 1, At, B1); PG8_BAR;
            PG8_LDB(B0, 1, 0); PG8_SCHED; PG8_LDA(At, 1, 0); PG8_STAGE(PG8_SA(0, 1), a2 + hstepA, voffA);
            PG8_WAIT_L(8); PG8_BAR; PG8_WAIT_L(0); PG8_MMA(0, 0, At, B0); PG8_BAR; PG8_SCHED;
            PG8_LDB(B1, 1, 1); PG8_STAGE(PG8_SB(1, 0), b3, voffB);
            PG8_BAR; PG8_WAIT_L(0); PG8_MMA(0, 1, At, B1); PG8_BAR;
            PG8_LDA(At, 1, 1); PG8_STAGE(PG8_SA(1, 0), a3, voffA);
            PG8_BAR; PG8_WAIT_L(0); PG8_MMA(1, 0, At, B0); PG8_BAR; PG8_SCHED;
            PG8_STAGE(PG8_SB(1, 1), b3 + hstepB, voffB);
            PG8_WAIT_V(6); PG8_BAR; PG8_MMA(1, 1, At, B1); PG8_BAR;
            }
        }
        if constexpr (F8) asm volatile("s_nop 15\n\ts_nop 15\n\ts_nop 15\n\ts_nop 15" ::: "memory");
        if constexpr (ALIGN_EPI) { if (wr == 0) PG8_BAR; }
        if constexpr (!Epi::AFTER_DRAIN) { E(acc, cur, wr, wc, fr, fq); S.done(cur); }
        if (!has_next) break;
        if (!(Epi::KEEP && nxt.z != 0)) {
#pragma unroll
        for (int a = 0; a < 2; ++a)
#pragma unroll
            for (int b = 0; b < 2; ++b)
#pragma unroll
                for (int m = 0; m < 4; ++m)
#pragma unroll
                    for (int n = 0; n < 2; ++n) acc[a][b][m][n] = (f32x4){0.f, 0.f, 0.f, 0.f};
        }
        cur = nxt; cA = nA; cB = nB; ++ui;
        if constexpr (ALIGN_EPI) { if (wr == 1) PG8_BAR; }
    }
    PG8_WAIT_V(0);
    if constexpr (!ALIGN_EPI) { if (wr == 0) PG8_BAR; }
    PG8_BAR;
    if constexpr (Epi::AFTER_DRAIN) { E.fused(acc, cur, wr, wc, fr, fq, lds, wid, lane); S.done(cur); }
#undef PG8_SA
#undef PG8_SB
#undef PG8_STAGE
#undef PG8_LDA
#undef PG8_LDB
#undef PG8_MMA
#undef PG8_WAIT_V
#undef PG8_WAIT_L
#undef PG8_BAR
#undef PG8_SCHED
}
}

constexpr int NWAVES = 8;
constexpr int BATCH = 8, SEQ = 2048, DM = 2048, DEPTH = 4, M = BATCH * SEQ, NH = 8;
constexpr int NIN = 16400, NZ = 16384, DFF = 5632, NUP = 2 * DFF, NY = 3072;
constexpr int Z_RQ = 0, Z_RK = 1024, Z_RV = 2048, Z_RG = 3072, Z_MQ = 4096, Z_MK = 4608, Z_MV = 5120, Z_MO = 6144, Z_AQ = 7168, Z_AK = 8192, Z_AV = 9216, Z_GA = 10240, Z_GB = 12288, Z_GC = 14336;
constexpr int W_GATE_COL = 7168;
constexpr size_t MiB = 1u << 20;
constexpr size_t WS_CTL = 0, CTL_ZERO_BYTES = 1 * MiB;
constexpr size_t WS_RS = 1520 * MiB;
constexpr size_t WS_TAB = 2 * MiB + 512 * 1024;
constexpr size_t WS_RSTD = 7 * MiB + 512 * 1024;
constexpr size_t WS_W16G = 7 * MiB;
constexpr size_t WS_KMEAN = 5 * MiB;
constexpr size_t WS_GIF = 6 * MiB;
constexpr size_t WS_WIN = 8 * MiB;
constexpr size_t WS_WP = 264 * MiB;
constexpr size_t WS_WOUT = 312 * MiB;
constexpr size_t WS_WUP = 344 * MiB;
constexpr size_t WS_WDN = 520 * MiB;
constexpr size_t WS_XB = 608 * MiB;
constexpr size_t WS_Z = 672 * MiB;
constexpr size_t WS_Y = 1184 * MiB;
constexpr size_t WS_MG = 1280 * MiB;
constexpr size_t WS_ACT = 1344 * MiB;
constexpr size_t WS_ZG = 1536 * MiB;
constexpr size_t WS_SB = 1632 * MiB;
constexpr size_t WS_XB8 = 1648 * MiB;
constexpr size_t WS_END = 1680 * MiB;
constexpr int N8 = 3 * DM + 1024;
__host__ __device__ constexpr size_t ws_win8(int l) { return WS_WIN + ((size_t)l * NZ + Z_GA) * DM * 2; }
constexpr int CW_TMO = 0, CW_CODE = 1;
constexpr int CW_BAR = 4096;
constexpr int CW_QUEUE = 8192;
constexpr int RING_OFF = 0, RING_BYTES = 131072;
constexpr int LDS_BYTES = 163840;
constexpr int LDSCTL_OFF = LDS_BYTES - 512, MISC_OFF = LDSCTL_OFF + 320;
static_assert(MISC_OFF + 128 <= LDS_BYTES, "LDS map");

#define GAS __attribute__((address_space(1)))
#define LAS __attribute__((address_space(3)))
typedef unsigned short bf16;
typedef unsigned v4u __attribute__((ext_vector_type(4)));
typedef unsigned v2u __attribute__((ext_vector_type(2)));
typedef float f32x4 __attribute__((ext_vector_type(4)));
typedef float f32x2 __attribute__((ext_vector_type(2)));
typedef GAS unsigned gu32;
#define RLX_AGENT __ATOMIC_RELAXED, __HIP_MEMORY_SCOPE_AGENT
#define LDS_WAIT() asm volatile("s_waitcnt lgkmcnt(0)" ::: "memory")
#define VM_WAIT() asm volatile("s_waitcnt vmcnt(0)" ::: "memory")
typedef __bf16 bf16x2_t __attribute__((ext_vector_type(2)));
__device__ __forceinline__ unsigned pk2(float lo, float hi) { const f32x2 v = {lo, hi}; const bf16x2_t b = __builtin_convertvector(v, bf16x2_t); return __builtin_bit_cast(unsigned, b); }
__device__ __forceinline__ unsigned f2bf(float f) { return pk2(f, f); }
__device__ __forceinline__ float bflo(unsigned w) { return __uint_as_float(w << 16); }
__device__ __forceinline__ float bfhi(unsigned w) { return __uint_as_float(w & 0xffff0000u); }
__device__ __forceinline__ float bf1(bf16 v) { return __uint_as_float((unsigned)v << 16); }
__device__ __forceinline__ float sigm(float x) { return 1.0f / (1.0f + __expf(-x)); }

#define XB_TMO      128
#define XB_XCNT(j)  (256  + 64 * (j))
#define XB_XSUB(j)  (1280 + 64 * (j))
#define XB_XGEN(j)  (2304 + 64 * (j))
#define XB_TOP      3328
#define XB_TOPGEN   3392
#define XCD_BAR_WORDS 3456
#define XB_SPIN_CAP (1u << 18)

__device__ __forceinline__ unsigned xb_ld(unsigned* p)              { return __hip_atomic_load(p, __ATOMIC_RELAXED, __HIP_MEMORY_SCOPE_AGENT); }
__device__ __forceinline__ unsigned xb_add(unsigned* p, unsigned v) { return __hip_atomic_fetch_add(p, v, __ATOMIC_RELAXED, __HIP_MEMORY_SCOPE_AGENT); }
__device__ __forceinline__ unsigned xb_xcc_id() { return (unsigned)__builtin_amdgcn_s_getreg((3 << 11) | 20) & 0xFu; }
#define XB_SPIN(cond, bar) do { unsigned _sp = 0; while (cond) { __builtin_amdgcn_s_sleep(1); \
    if ((++_sp & 255u) == 0u) { if (xb_ld(&(bar)[XB_TMO])) break; if (_sp > XB_SPIN_CAP) { atomicAdd(&(bar)[XB_TMO], 1u); break; } } } } while (0)

struct XcdBarrier {
    unsigned* bar; unsigned x;
    volatile LAS unsigned* st;
};

__device__ __forceinline__ XcdBarrier xcd_barrier_post(unsigned* bar, volatile LAS unsigned* st) {
    XcdBarrier b; b.bar = bar; b.x = xb_xcc_id(); b.st = st;
    if (threadIdx.x == 0) (void)xb_add(&bar[XB_XCNT(b.x)], 1u);
    return b;
}
__device__ __forceinline__ void xcd_barrier_complete(unsigned* bar, unsigned x, unsigned& nloc, unsigned& nx) {
    const unsigned G = gridDim.x * gridDim.y * gridDim.z;
    unsigned sum, cnt, mine, sp = 0u;
    for (;;) {
        sum = 0u; cnt = 0u; mine = 0u;
#pragma unroll
        for (unsigned j = 0; j < 16; ++j) { const unsigned c = xb_ld(&bar[XB_XCNT(j)]); sum += c; cnt += (c > 0u) ? 1u : 0u; mine = (j == x) ? c : mine; }
        if (sum == G) break;
        __builtin_amdgcn_s_sleep(1);
        if ((++sp & 255u) == 0u) { if (xb_ld(&bar[XB_TMO])) break; if (sp > XB_SPIN_CAP) { atomicAdd(&bar[XB_TMO], 1u); break; } }
    }
    nloc = mine > 0u ? mine : 1u; nx = cnt > 0u ? cnt : 1u;
}

__device__ __forceinline__ void xcd_barrier(const XcdBarrier& b) {
    asm volatile("s_waitcnt vmcnt(0)" ::: "memory");
    __syncthreads();
    if (threadIdx.x == 0) {
        unsigned* bar = b.bar;
        __builtin_amdgcn_s_waitcnt(0);
        unsigned nloc = b.st[0], nx = b.st[1];
        if (nloc == 0u) { xcd_barrier_complete(bar, b.x, nloc, nx); b.st[0] = nloc; b.st[1] = nx; }
        const unsigned old = xb_add(&bar[XB_XSUB(b.x)], 1u);
        const unsigned gen = old / nloc;
        if (old + 1u == (gen + 1u) * nloc) {
            __builtin_amdgcn_fence(__ATOMIC_RELEASE, "agent");
            asm volatile("s_waitcnt vmcnt(0)" ::: "memory");
            const unsigned og = xb_add(&bar[XB_TOP], 1u);
            const unsigned tg = og / nx;
            if (og + 1u == (tg + 1u) * nx) xb_add(&bar[XB_TOPGEN], 1u);
            else XB_SPIN(xb_ld(&bar[XB_TOPGEN]) == tg, bar);
            __builtin_amdgcn_fence(__ATOMIC_ACQUIRE, "agent");
            xb_add(&bar[XB_XGEN(b.x)], 1u);
            asm volatile("s_waitcnt vmcnt(0)" ::: "memory");
        } else {
            XB_SPIN(xb_ld(&bar[XB_XGEN(b.x)]) == gen, bar);
            __builtin_amdgcn_fence(__ATOMIC_ACQUIRE, "agent");
            asm volatile("s_waitcnt vmcnt(0)" ::: "memory");
        }
    }
    __syncthreads();
}

struct Args { const float* in[18]; float* out; unsigned char* ws; int ph_lo, ph_hi, li, pad; };
enum { I_X = 0, I_WIN, I_BIG, I_BFG, I_NMIX, I_RGN, I_MLN, I_QN, I_KN, I_WPA, I_WPB, I_WPC, I_WOUT, I_NFFN, I_WUP, I_CW, I_CB, I_WDN };
struct Frame {
    LAS unsigned char* lds;
    volatile LAS unsigned* MISC;
    unsigned char* ws;
    int tid, lane, wave, G, bx;
};
#define WSP(T, off) ((T*)(F.ws + (off)))
__device__ __forceinline__ float wave_sum(float v) {
#pragma unroll
    for (int o = 1; o < 64; o <<= 1) v += __shfl_xor(v, o);
    return v;
}
__device__ __forceinline__ float wave_max(float v) {
#pragma unroll
    for (int o = 1; o < 64; o <<= 1) v = fmaxf(v, __shfl_xor(v, o));
    return v;
}
__device__ __forceinline__ void p0_transpose_item(const float* W, int ldw, int K, int nblk, bf16* WT, LAS float* scr, int item, int lane, const float* gk = nullptr, unsigned char* WT8 = nullptr, int nb8 = 0) {
    const int kb = item / nblk, nb = item % nblk, k0 = 64 * kb, n0 = 32 * nb;
#pragma unroll 8
    for (int i = 0; i < 32; ++i) { const int kk = 2 * i + (lane >> 5); scr[kk * 33 + (lane & 31)] = W[(size_t)(k0 + kk) * ldw + n0 + (lane & 31)]; }
    LDS_WAIT(); asm volatile("" ::: "memory");
    const int c = lane & 7;
    f32x4 g0 = (f32x4){1.f, 1.f, 1.f, 1.f}, g1 = g0;
    if (gk) { g0 = *(const f32x4*)(gk + k0 + 8 * c); g1 = *(const f32x4*)(gk + k0 + 8 * c + 4); }
    if (WT8 && nb >= nb8) {
#pragma unroll
        for (int j = 0; j < 4; ++j) { const int n = (lane >> 3) + 8 * j; const LAS float* s = scr + (8 * c) * 33 + n; const f32x4 h0 = g0 * 64.f, h1 = g1 * 64.f;
            v2u o; o.x = (unsigned)__builtin_amdgcn_cvt_pk_fp8_f32(s[2 * 33] * h0[2], s[3 * 33] * h0[3], __builtin_amdgcn_cvt_pk_fp8_f32(s[0 * 33] * h0[0], s[1 * 33] * h0[1], 0, false), true);
            o.y = (unsigned)__builtin_amdgcn_cvt_pk_fp8_f32(s[6 * 33] * h1[2], s[7 * 33] * h1[3], __builtin_amdgcn_cvt_pk_fp8_f32(s[4 * 33] * h1[0], s[5 * 33] * h1[1], 0, false), true);
            *(GAS v2u*)(WT8 + (size_t)(n0 - 32 * nb8 + n) * K + k0 + 8 * c) = o; }
    } else
#pragma unroll
    for (int j = 0; j < 4; ++j) { const int n = (lane >> 3) + 8 * j; const LAS float* s = scr + (8 * c) * 33 + n;
        v4u o; o.x = pk2(s[0 * 33] * g0[0], s[1 * 33] * g0[1]); o.y = pk2(s[2 * 33] * g0[2], s[3 * 33] * g0[3]); o.z = pk2(s[4 * 33] * g1[0], s[5 * 33] * g1[1]); o.w = pk2(s[6 * 33] * g1[2], s[7 * 33] * g1[3]);
        *(GAS v4u*)(WT + (size_t)(n0 + n) * K + k0 + 8 * c) = o; }
    LDS_WAIT(); asm volatile("" ::: "memory");
}
__device__ __forceinline__ void p0_prologue(Frame& F, const Args& args) {
    LAS float* scr = (LAS float*)(F.lds + RING_OFF + F.wave * 16384);
    const int gw = F.bx * NWAVES + F.wave, NGW = F.G * NWAVES;
    constexpr int I_INA = 32 * 224, I_INB = 32 * 288, I_P = 16 * 64, I_OUT = 32 * 64, I_UP = 32 * 352, I_DN = 88 * 64;
    constexpr int I_LAYER = I_INA + I_INB + 3 * I_P + I_OUT + I_UP + I_DN;
    for (int it = gw; it < DEPTH * I_LAYER; it += NGW) {
        const int l = it / I_LAYER; int r = it % I_LAYER;
        const float* win = args.in[I_WIN] + (size_t)l * DM * NIN; bf16* wint = WSP(bf16, WS_WIN) + (size_t)l * NZ * DM;
        if (r < I_INA) { p0_transpose_item(win, NIN, DM, 224, wint, scr, r, F.lane, args.in[I_NMIX] + l * DM, F.ws + ws_win8(l) + (size_t)3 * DM * DM, Z_MO / 32); continue; } r -= I_INA;
        if (r < I_INB) { p0_transpose_item(win + 7184, NIN, DM, 288, wint + (size_t)7168 * DM, scr, r, F.lane, args.in[I_NMIX] + l * DM, F.ws + ws_win8(l), 96); continue; } r -= I_INB;
        if (r < I_P) { p0_transpose_item(args.in[I_WPA] + (size_t)l * 1024 * DM, DM, 1024, 64, WSP(bf16, WS_WP) + ((size_t)l * 3 + 0) * DM * 1024, scr, r, F.lane); continue; } r -= I_P;
        if (r < I_P) { p0_transpose_item(args.in[I_WPB] + (size_t)l * 1024 * DM, DM, 1024, 64, WSP(bf16, WS_WP) + ((size_t)l * 3 + 1) * DM * 1024, scr, r, F.lane); continue; } r -= I_P;
        if (r < I_P) { p0_transpose_item(args.in[I_WPC] + (size_t)l * 1024 * DM, DM, 1024, 64, WSP(bf16, WS_WP) + ((size_t)l * 3 + 2) * DM * 1024, scr, r, F.lane); continue; } r -= I_P;
        if (r < I_OUT) { p0_transpose_item(args.in[I_WOUT] + (size_t)l * DM * DM, DM, DM, 64, WSP(bf16, WS_WOUT) + (size_t)l * DM * DM, scr, r, F.lane); continue; } r -= I_OUT;
        if (r < I_UP) {
            const int nb = r % 352, tile = nb >> 3, wi = nb & 7, src = (wi < 4) ? 128 * tile + 32 * wi : DFF + 128 * tile + 32 * (wi - 4);
            p0_transpose_item(args.in[I_WUP] + (size_t)l * DM * NUP + (src - 32 * nb), NUP, DM, 352, WSP(bf16, WS_WUP) + (size_t)l * NUP * DM, scr, r, F.lane, args.in[I_NFFN] + l * DM); continue; } r -= I_UP;
        p0_transpose_item(args.in[I_WDN] + (size_t)l * DFF * DM, DM, DFF, 64, WSP(bf16, WS_WDN) + (size_t)l * DM * DFF, scr, r, F.lane);
    }
    const int gt = F.bx * (NWAVES * 64) + F.tid, NGT = F.G * NWAVES * 64;
    for (int i = gt; i < DEPTH * 16 * DM; i += NGT) { const int l = i / (16 * DM), c = (i / DM) % 16, k = i % DM; WSP(bf16, WS_W16G)[i] = (bf16)f2bf(args.in[I_WIN][((size_t)l * DM + k) * NIN + W_GATE_COL + c] * args.in[I_NMIX][l * DM + k]); }
    for (int m = gw; m < M; m += NGW) { const f32x4* xr = (const f32x4*)(args.in[I_X] + (size_t)m * DM) + F.lane; v2u* o8 = (v2u*)(WSP(bf16, WS_XB) + (size_t)m * DM) + F.lane; float s = 0.f;
        unsigned* q8 = (unsigned*)(F.ws + WS_XB8 + (size_t)m * DM) + F.lane;
#pragma unroll
        for (int j = 0; j < 8; ++j) { const f32x4 v = xr[64 * j]; s += (v.x * v.x + v.y * v.y) + (v.z * v.z + v.w * v.w); v2u w; w.x = pk2(v.x, v.y); w.y = pk2(v.z, v.w); o8[64 * j] = w;
            q8[64 * j] = (unsigned)__builtin_amdgcn_cvt_pk_fp8_f32(v.z, v.w, __builtin_amdgcn_cvt_pk_fp8_f32(v.x, v.y, 0, false), true); }
        s = wave_sum(s); if (F.lane < 32) WSP(float, WS_RS)[(size_t)m * 32 + F.lane] = (F.lane == 0) ? s : 0.f; }
    for (int i = gt; i < 2 * SEQ * 64; i += NGT) { const int which = i / (SEQ * 64), pos = (i / 64) % SEQ, d = i % 64;
        const float ex = which == 0 ? (float)d / 63.0f : (float)(2 * d) / 128.0f;
        const float inv = 1.0f / powf(10000.0f, ex); const float ang = (float)pos * inv; float s, c; sincosf(ang, &s, &c); WSP(f32x2, WS_TAB)[i] = (f32x2){c, s}; }
}
__device__ __forceinline__ void prep_phase(Frame& F, const float* qn, const float* kn, const bf16* w16g, const float* rs, const float* big, const float* bfg) {
    const int gw = F.bx * NWAVES + F.wave, NGW = F.G * NWAVES, lane = F.lane, rsub = lane >> 2, dg = lane & 3;
    const f32x2* trope = WSP(f32x2, WS_TAB) + SEQ * 64;
    for (int u = gw; u < BATCH * 16 * NH; u += NGW) {
        const int kind = 1, hh = u & 7, hb = (u >> 3) & 15, b = u >> 7;
        const float* wn = kn;
        const float* rsb = rs + (size_t)(b * SEQ + hb * 128) * 32 + 8 * dg;
        float wl[16], wh[16], s1[16], s2[16];
#pragma unroll
        for (int e = 0; e < 16; ++e) { wl[e] = wn[16 * dg + e]; wh[e] = wn[64 + 16 * dg + e]; s1[e] = 0.f; s2[e] = 0.f; }
        bf16* zb = WSP(bf16, WS_Z) + (size_t)(b * SEQ + hb * 128) * NZ + (kind ? Z_AK : Z_AQ) + hh * 128 + 16 * dg;
#pragma unroll 2
        for (int st = 0; st < 8; ++st) {
            const int r = rsub + 16 * st, pos = hb * 128 + r; bf16* zr = zb + (size_t)r * NZ;
            const v4u l0 = *(const v4u*)(zr), l1 = *(const v4u*)(zr + 8), h0 = *(const v4u*)(zr + 64), h1 = *(const v4u*)(zr + 72);
            float a[16] = {bflo(l0.x), bfhi(l0.x), bflo(l0.y), bfhi(l0.y), bflo(l0.z), bfhi(l0.z), bflo(l0.w), bfhi(l0.w), bflo(l1.x), bfhi(l1.x), bflo(l1.y), bfhi(l1.y), bflo(l1.z), bfhi(l1.z), bflo(l1.w), bfhi(l1.w)};
            float c[16] = {bflo(h0.x), bfhi(h0.x), bflo(h0.y), bfhi(h0.y), bflo(h0.z), bfhi(h0.z), bflo(h0.w), bfhi(h0.w), bflo(h1.x), bfhi(h1.x), bflo(h1.y), bfhi(h1.y), bflo(h1.z), bfhi(h1.z), bflo(h1.w), bfhi(h1.w)};
            float ss = 0.f;
#pragma unroll
            for (int e = 0; e < 16; ++e) ss += a[e] * a[e] + c[e] * c[e];
            ss += __shfl_xor(ss, 1); ss += __shfl_xor(ss, 2);
            float rq; { const f32x4 s0 = *(const f32x4*)(rsb + (size_t)r * 32), s1 = *(const f32x4*)(rsb + (size_t)r * 32 + 4); rq = ((s0[0] + s0[1]) + (s0[2] + s0[3])) + ((s1[0] + s1[1]) + (s1[2] + s1[3])); }
            rq += __shfl_xor(rq, 1); rq += __shfl_xor(rq, 2);
            const float rr = rsqrtf(rq * (1.0f / 2048.0f) + 1e-6f);
            if (hh == 0 && dg == 0) WSP(float, WS_RSTD)[b * SEQ + hb * 128 + r] = rr;
            const float rstd = rr * rsqrtf(ss * rr * rr * (1.f / 128.f) + 1e-6f);
            const f32x2* tb = trope + pos * 64 + 16 * dg;
#pragma unroll
            for (int e = 0; e < 16; ++e) { const float x1 = a[e] * rstd * wl[e], x2 = c[e] * rstd * wh[e]; const f32x2 cs = tb[e]; a[e] = x1 * cs.x - x2 * cs.y; c[e] = x1 * cs.y + x2 * cs.x; s1[e] += a[e]; s2[e] += c[e]; }
            *(v4u*)(zr) = (v4u){pk2(a[0], a[1]), pk2(a[2], a[3]), pk2(a[4], a[5]), pk2(a[6], a[7])}; *(v4u*)(zr + 8) = (v4u){pk2(a[8], a[9]), pk2(a[10], a[11]), pk2(a[12], a[13]), pk2(a[14], a[15])};
            *(v4u*)(zr + 64) = (v4u){pk2(c[0], c[1]), pk2(c[2], c[3]), pk2(c[4], c[5]), pk2(c[6], c[7])}; *(v4u*)(zr + 72) = (v4u){pk2(c[8], c[9]), pk2(c[10], c[11]), pk2(c[12], c[13]), pk2(c[14], c[15])};
        }
        if (kind) {
            float* km = WSP(float, WS_KMEAN) + (size_t)((b * NH + hh) * 16 + hb) * 128 + 16 * dg;
#pragma unroll
            for (int e = 0; e < 16; ++e) { float x = s1[e], y = s2[e];
                x += __shfl_xor(x, 4); x += __shfl_xor(x, 8); x += __shfl_xor(x, 16); x += __shfl_xor(x, 32);
                y += __shfl_xor(y, 4); y += __shfl_xor(y, 8); y += __shfl_xor(y, 16); y += __shfl_xor(y, 32);
                if (rsub == 0) { km[e] = x * (1.f / 256.f); km[64 + e] = y * (1.f / 256.f); } }
        }
    }
    for (int it = NGW - 1 - gw; it < M / 16; it += NGW) {
        const int i16 = lane & 15, g = lane >> 4; const bf16* ar = WSP(bf16, WS_XB) + (size_t)(16 * it + i16) * DM + 8 * g; const bf16* br = w16g + (size_t)i16 * DM + 8 * g;
        typedef short bf16x8_t __attribute__((ext_vector_type(8)));
        f32x4 acc = (f32x4){0.f, 0.f, 0.f, 0.f};
#pragma unroll 1
        for (int s0 = 0; s0 < DM / 32; s0 += 16) { bf16x8_t av[16], bv[16];
#pragma unroll
            for (int s = 0; s < 16; ++s) { av[s] = *(const bf16x8_t*)(ar + 32 * (s0 + s)); bv[s] = *(const bf16x8_t*)(br + 32 * (s0 + s)); }
#pragma unroll
            for (int s = 0; s < 16; ++s) acc = __builtin_amdgcn_mfma_f32_16x16x32_bf16(av[s], bv[s], acc, 0, 0, 0); }
#pragma unroll
        for (int r = 0; r < 4; ++r) { const int row = 16 * it + 4 * g + r; float ssq = 0.f;
#pragma unroll
            for (int q = 0; q < 8; ++q) { const f32x4 a = *(const f32x4*)(rs + (size_t)row * 32 + 4 * q); ssq += (a[0] + a[1]) + (a[2] + a[3]); }
            const float sr = rsqrtf(ssq * (1.0f / 2048.0f) + 1e-6f);
            const float pre = acc[r] * sr + (i16 < 8 ? big[i16 & 7] : bfg[i16 & 7]); const float sc = 15.0f * tanhf(pre * (1.0f / 15.0f));
            float o = sc; if (i16 >= 8) o = sc > 0.f ? -log1pf(__expf(-sc)) : sc - log1pf(__expf(sc));
            WSP(float, WS_GIF)[(size_t)row * 16 + i16] = o; }
    }
}
__device__ __forceinline__ void glu_fix_phase(Frame& F, const float* cw, const float* cb) {
    const bf16* SB = WSP(bf16, WS_SB); bf16* ACT = WSP(bf16, WS_ACT);
    for (int gI = F.bx; gI < M / 128; gI += F.G) {
        const bool first = ((gI * 128) & (SEQ - 1)) == 0; const bf16* sb = SB + (size_t)gI * 4 * NUP;
        for (int it = F.tid; it < 2 * (DFF / 8); it += NWAVES * 64) {
            const int i = it / (DFF / 8), c8 = (it % (DFF / 8)) * 8;
            float r[2][8];
#pragma unroll
            for (int hf = 0; hf < 2; ++hf) { const int col = hf * DFF + c8;
                const f32x4 b0 = *(const f32x4*)(cb + col), b1 = *(const f32x4*)(cb + col + 4);
                float a[8] = {b0.x, b0.y, b0.z, b0.w, b1.x, b1.y, b1.z, b1.w};
#pragma unroll
                for (int j = 0; j < 3; ++j) { const int slot = i + j;
                    if (slot >= 2 || !first) { const v4u uw = *(const v4u*)(sb + (size_t)slot * NUP + col); const f32x4 w0 = *(const f32x4*)(cw + (size_t)j * NUP + col), w1 = *(const f32x4*)(cw + (size_t)j * NUP + col + 4);
                        a[0] += bflo(uw.x) * w0.x; a[1] += bfhi(uw.x) * w0.y; a[2] += bflo(uw.y) * w0.z; a[3] += bfhi(uw.y) * w0.w; a[4] += bflo(uw.z) * w1.x; a[5] += bfhi(uw.z) * w1.y; a[6] += bflo(uw.w) * w1.z; a[7] += bfhi(uw.w) * w1.w; } }
#pragma unroll
                for (int e = 0; e < 8; ++e) r[hf][e] = a[e]; }
            float o[8];
#pragma unroll
            for (int e = 0; e < 8; ++e) o[e] = r[0][e] * __builtin_amdgcn_rcpf(1.0f + __expf(-r[0][e])) * r[1][e];
            *(v4u*)(ACT + (size_t)(gI * 128 + i) * DFF + c8) = (v4u){pk2(o[0], o[1]), pk2(o[2], o[3]), pk2(o[4], o[5]), pk2(o[6], o[7])};
        }
    }
}
namespace mx {
typedef short bf16x8 __attribute__((ext_vector_type(8)));
typedef short s16x4 __attribute__((ext_vector_type(4)));
#define MFMA16(a, b, c) __builtin_amdgcn_mfma_f32_16x16x32_bf16((a), (b), (c), 0, 0, 0)
#define LDS_FENCE() asm volatile("s_waitcnt lgkmcnt(0)" ::: "memory")
#define SCHED_FENCE() __builtin_amdgcn_sched_barrier(0)
__device__ __forceinline__ bf16x8 frag_row(const LAS bf16* X, int ld, int r0, int c0, int lane) {
    return *(const LAS bf16x8*)(X + (r0 + (lane & 15)) * ld + c0 + 8 * (lane >> 4)); }
__device__ __forceinline__ bf16x8 frag_tr(const LAS bf16* X, int ld, int k0, int c0, int lane) {
    const int g = lane >> 4, q = (lane & 15) >> 2, p = lane & 3;
    const LAS bf16* a = X + (k0 + 8 * g + q) * ld + c0 + 4 * p;
    const s16x4 lo = __builtin_amdgcn_ds_read_tr16_b64_v4i16((LAS s16x4*)a);
    const s16x4 hi = __builtin_amdgcn_ds_read_tr16_b64_v4i16((LAS s16x4*)(a + 4 * ld));
    return __builtin_shufflevector(lo, hi, 0, 1, 2, 3, 4, 5, 6, 7);
}
__device__ __forceinline__ int trs_off(int row, int chunk) { return row * 128 + ((chunk ^ (((row & 3) << 1) | (((row >> 3) & 1) << 3))) << 3); }
__device__ __forceinline__ bf16x8 frag_trs(const LAS bf16* X, int k0, int c0, int lane) {
    const int g = lane >> 4, q = (lane & 15) >> 2, p = lane & 3;
    const LAS bf16* a = X + trs_off(k0 + 8 * g + q, (c0 >> 3) + (p >> 1)) + 4 * (p & 1);
    const s16x4 lo = __builtin_amdgcn_ds_read_tr16_b64_v4i16((LAS s16x4*)a);
    const s16x4 hi = __builtin_amdgcn_ds_read_tr16_b64_v4i16((LAS s16x4*)(a + 4 * 128));
    return __builtin_shufflevector(lo, hi, 0, 1, 2, 3, 4, 5, 6, 7);
}
template <int CTRL> __device__ __forceinline__ float dppf(float v) { return __builtin_bit_cast(float, __builtin_amdgcn_update_dpp(0, __builtin_bit_cast(int, v), CTRL, 0xf, 0xf, true)); }
__device__ __forceinline__ float r16max(float v) { v = fmaxf(v, dppf<0xB1>(v)); v = fmaxf(v, dppf<0x4E>(v)); v = fmaxf(v, dppf<0x141>(v)); v = fmaxf(v, dppf<0x140>(v)); return v; }
__device__ __forceinline__ float r16sum(float v) { v += dppf<0xB1>(v); v += dppf<0x4E>(v); v += dppf<0x141>(v); v += dppf<0x140>(v); return v; }
__device__ __forceinline__ float red16_sum(float v) { return r16sum(v); }
__device__ __forceinline__ float red16_max(float v) { return r16max(v); }
__device__ __forceinline__ void rot8(const v4u lo, const v4u hi, const f32x2* tb, float sc, v4u& olo, v4u& ohi) {
    float a[8] = {bflo(lo.x), bfhi(lo.x), bflo(lo.y), bfhi(lo.y), bflo(lo.z), bfhi(lo.z), bflo(lo.w), bfhi(lo.w)};
    float c[8] = {bflo(hi.x), bfhi(hi.x), bflo(hi.y), bfhi(hi.y), bflo(hi.z), bfhi(hi.z), bflo(hi.w), bfhi(hi.w)};
    float o1[8], o2[8];
#pragma unroll
    for (int e = 0; e < 8; ++e) { const f32x2 cs = tb[e]; o1[e] = (a[e] * cs.x - c[e] * cs.y) * sc; o2[e] = (a[e] * cs.y + c[e] * cs.x) * sc; }
    olo = (v4u){pk2(o1[0], o1[1]), pk2(o1[2], o1[3]), pk2(o1[4], o1[5]), pk2(o1[6], o1[7])};
    ohi = (v4u){pk2(o2[0], o2[1]), pk2(o2[2], o2[3]), pk2(o2[4], o2[5]), pk2(o2[6], o2[7])};
}
constexpr int LQ = 144;
__device__ __forceinline__ void ret_unit(Frame& F, const float* gn, int b, int h) {
    LAS bf16* Qs = (LAS bf16*)(F.lds); LAS bf16* Ks = Qs + 128 * LQ; LAS bf16* Vs = Ks + 128 * LQ; LAS bf16* Ts = Vs + 128 * LQ;
    const int tid = F.tid, lane = F.lane, w = tid >> 6, i16 = lane & 15, g = lane >> 4;
    const float gamma = 1.0f - exp2f(-5.0f - (float)h), lg = log2f(gamma);
    const float gC = exp2f(lg * 128.0f);
    f32x4 accT[8];
#pragma unroll
    for (int n = 0; n < 8; ++n) accT[n] = (f32x4){0.f, 0.f, 0.f, 0.f};
    for (int i = tid; i < 128 * LQ / 8; i += NWAVES * 64) ((LAS v4u*)Ts)[i] = (v4u){0u, 0u, 0u, 0u};
    const bf16* zb = WSP(bf16, WS_Z) + (size_t)(b * SEQ) * NZ + h * 128;
    const f32x2* tret = WSP(f32x2, WS_TAB);
    bf16* yb = WSP(bf16, WS_Y) + (size_t)(b * SEQ) * 1024 + h * 128;
    const int lr = tid >> 2, dg = tid & 3;
    v4u pq[4], pk[4], pv[4]; float prr;
    const float* rstd1 = WSP(float, WS_RSTD) + (size_t)(b * SEQ);
#define RET_FETCH(t0_) do { const bf16* zr_ = zb + (size_t)((t0_) + lr) * NZ; \
        pq[0] = *(const v4u*)(zr_ + Z_RQ + 16 * dg); pq[1] = *(const v4u*)(zr_ + Z_RQ + 64 + 16 * dg); pq[2] = *(const v4u*)(zr_ + Z_RQ + 16 * dg + 8); pq[3] = *(const v4u*)(zr_ + Z_RQ + 64 + 16 * dg + 8); \
        pk[0] = *(const v4u*)(zr_ + Z_RK + 16 * dg); pk[1] = *(const v4u*)(zr_ + Z_RK + 64 + 16 * dg); pk[2] = *(const v4u*)(zr_ + Z_RK + 16 * dg + 8); pk[3] = *(const v4u*)(zr_ + Z_RK + 64 + 16 * dg + 8); \
        _Pragma("unroll") for (int q_ = 0; q_ < 4; ++q_) pv[q_] = *(const v4u*)(zr_ + Z_RV + 32 * dg + 8 * q_); prr = rstd1[(t0_) + lr]; } while (0)
    RET_FETCH(0);
    const float sq = exp2f(lg * (float)lr), sk = exp2f(-lg * (float)lr) * 0.08838834764831845f;
    float gnv[8];
#pragma unroll
    for (int n = 0; n < 8; ++n) gnv[n] = gn[h * 128 + 16 * n + i16];
    for (int c = 0; c < SEQ / 128; ++c) {
        const int t0 = c * 128;
        {
            const f32x2* tb = tret + (t0 + lr) * 64 + 16 * dg;
#pragma unroll
            for (int hh = 0; hh < 2; ++hh) {
                v4u o1, o2; rot8(pq[2 * hh], pq[2 * hh + 1], tb + 8 * hh, sq * prr, o1, o2);
                *(LAS v4u*)(Qs + lr * LQ + 16 * dg + 8 * hh) = o1; *(LAS v4u*)(Qs + lr * LQ + 64 + 16 * dg + 8 * hh) = o2;
                rot8(pk[2 * hh], pk[2 * hh + 1], tb + 8 * hh, sk * prr * prr, o1, o2);
                *(LAS v4u*)(Ks + lr * LQ + 16 * dg + 8 * hh) = o1; *(LAS v4u*)(Ks + lr * LQ + 64 + 16 * dg + 8 * hh) = o2;
            }
#pragma unroll
            for (int q = 0; q < 4; ++q) *(LAS v4u*)(Vs + lr * LQ + 32 * dg + 8 * q) = pv[q];
            if (c + 1 < SEQ / 128) RET_FETCH(t0 + 128);
        }
        __syncthreads();
        bf16x8 aq[4];
#pragma unroll
        for (int s = 0; s < 4; ++s) aq[s] = frag_row(Qs, LQ, 16 * w, 32 * s, lane);
        f32x4 acco[8];
#pragma unroll
        for (int n = 0; n < 8; ++n) acco[n] = (f32x4){0.f, 0.f, 0.f, 0.f};
#pragma unroll
        for (int s = 0; s < 4; ++s) { bf16x8 bb[8];
#pragma unroll
            for (int n = 0; n < 8; ++n) bb[n] = frag_tr(Ts, LQ, 32 * s, 16 * n, lane);
            SCHED_FENCE();
#pragma unroll
            for (int n = 0; n < 8; ++n) acco[n] = MFMA16(aq[s], bb[n], acco[n]); }
        LDS_FENCE();
#pragma unroll
        for (int n = 0; n < 8; ++n) {
            if (n <= w) { f32x4 sa = (f32x4){0.f, 0.f, 0.f, 0.f}; bf16x8 bb[4];
#pragma unroll
                for (int s = 0; s < 4; ++s) bb[s] = frag_row(Ks, LQ, 16 * n, 32 * s, lane);
                SCHED_FENCE();
#pragma unroll
                for (int s = 0; s < 4; ++s) sa = MFMA16(aq[s], bb[s], sa);
#pragma unroll
                for (int r = 0; r < 4; ++r) { const int i = 16 * w + 4 * g + r, j = 16 * n + i16; Qs[i * LQ + j] = (bf16)f2bf(j <= i ? sa[r] : 0.f); } }
            else if (n == w + 1) {
#pragma unroll
                for (int r = 0; r < 4; ++r) Qs[(16 * w + 4 * g + r) * LQ + 16 * n + i16] = (bf16)0; }
        }
        LDS_FENCE();
#pragma unroll
        for (int n = 0; n < 8; ++n) accT[n] = accT[n] * gC;
#pragma unroll
        for (int s = 0; s < 4; ++s) { const bf16x8 ak = frag_tr(Ks, LQ, 32 * s, 16 * w, lane); const bool doi = (s <= (w >> 1)); bf16x8 as = ak; bf16x8 bb[8];
            if (doi) as = frag_row(Qs, LQ, 16 * w, 32 * s, lane);
#pragma unroll
            for (int n = 0; n < 8; ++n) bb[n] = frag_tr(Vs, LQ, 32 * s, 16 * n, lane);
            SCHED_FENCE();
            if (doi) {
#pragma unroll
                for (int n = 0; n < 8; ++n) acco[n] = MFMA16(as, bb[n], acco[n]); }
#pragma unroll
            for (int n = 0; n < 8; ++n) accT[n] = MFMA16(ak, bb[n], accT[n]); }
        bf16 gvr[4][8]; float rrv[4];
#pragma unroll
        for (int r = 0; r < 4; ++r) { const int pos = t0 + 16 * w + 4 * g + r; const bf16* gr = zb + (size_t)pos * NZ + Z_RG + i16; rrv[r] = rstd1[pos];
#pragma unroll
            for (int n = 0; n < 8; ++n) gvr[r][n] = gr[16 * n]; }
        LDS_FENCE();
        __syncthreads();
#pragma unroll
        for (int n = 0; n < 8; ++n)
#pragma unroll
            for (int r = 0; r < 4; ++r) Ts[(16 * w + 4 * g + r) * LQ + 16 * n + i16] = (bf16)f2bf(gC * accT[n][r]);
#pragma unroll
        for (int r = 0; r < 4; ++r) {
            float s = 0.f;
#pragma unroll
            for (int n = 0; n < 8; ++n) s += acco[n][r];
            const float mean = red16_sum(s) * (1.f / 128.f); float q = 0.f;
#pragma unroll
            for (int n = 0; n < 8; ++n) { const float d = acco[n][r] - mean; q += d * d; }
            const float rstd = rsqrtf(red16_sum(q) * (1.f / 128.f) + 1e-5f);
            const int pos = t0 + 16 * w + 4 * g + r; bf16* yr = yb + (size_t)pos * 1024; const float rri = rrv[r];
#pragma unroll
            for (int n = 0; n < 8; ++n) { const int e = 16 * n + i16; const float gv = bf1(gvr[r][n]) * rri; yr[e] = (bf16)f2bf((acco[n][r] - mean) * rstd * gnv[n] * gv * sigm(gv)); }
        }
    }
    __syncthreads();
#undef RET_FETCH
}
constexpr int LK = 72, LV = 168;
__device__ __forceinline__ float scan64_sum(float x, int lane) {
#pragma unroll
    for (int o = 1; o < 64; o <<= 1) { const float y = __shfl_up(x, o); if (lane >= o) x += y; }
    return x; }
__device__ __forceinline__ float scan64_max(float x, int lane) {
#pragma unroll
    for (int o = 1; o < 64; o <<= 1) { const float y = __shfl_up(x, o); if (lane >= o) x = fmaxf(x, y); }
    return x; }
__device__ __forceinline__ void mlstm_unit(Frame& F, const float* nw, int b, int h) {
    LAS bf16* Qm = (LAS bf16*)(F.lds); LAS bf16* Km = Qm + 128 * LK; LAS bf16* Kw = Km + 128 * LK; LAS bf16* Vm = Kw + 128 * LK; LAS bf16* Pm = Vm + 128 * LV; LAS bf16* Cm = Pm + 128 * LQ;
    const int tid = F.tid, lane = F.lane, w = F.wave, i16 = lane & 15, g = lane >> 4;
    const int dt = w & 3, eh = w >> 2;
    f32x4 accC[5];
#pragma unroll
    for (int k = 0; k < 5; ++k) accC[k] = (f32x4){0.f, 0.f, 0.f, 0.f};
    for (int i = tid; i < 64 * LV / 8; i += NWAVES * 64) ((LAS v4u*)Cm)[i] = (v4u){0u, 0u, 0u, 0u};
    float m_prev = 0.f;
    const bf16* zb = WSP(bf16, WS_Z) + (size_t)(b * SEQ) * NZ;
    const float* gif = WSP(float, WS_GIF) + (size_t)(b * SEQ) * 16;
    bf16* yb = WSP(bf16, WS_Y) + (size_t)M * 1024 + (size_t)(b * SEQ) * 1024 + h * 128;
    const int lr = tid >> 2, dg = tid & 3;
    v4u pq[2], pk[2]; float fl0, fl1, il0, il1, prr;
    const float* rstd1 = WSP(float, WS_RSTD) + (size_t)(b * SEQ);
#define ML_FETCH(t0_) do { const bf16* zr_ = zb + (size_t)((t0_) + lr) * NZ; \
        pq[0] = *(const v4u*)(zr_ + Z_MQ + h * 64 + 16 * dg); pq[1] = *(const v4u*)(zr_ + Z_MQ + h * 64 + 16 * dg + 8); pk[0] = *(const v4u*)(zr_ + Z_MK + h * 64 + 16 * dg); pk[1] = *(const v4u*)(zr_ + Z_MK + h * 64 + 16 * dg + 8); \
        fl0 = gif[(size_t)((t0_) + lane) * 16 + 8 + h]; fl1 = gif[(size_t)((t0_) + 64 + lane) * 16 + 8 + h]; il0 = gif[(size_t)((t0_) + lane) * 16 + h]; il1 = gif[(size_t)((t0_) + 64 + lane) * 16 + h]; prr = rstd1[(t0_) + lr]; } while (0)
    ML_FETCH(0);
    float nwv[8];
#pragma unroll
    for (int n = 0; n < 8; ++n) nwv[n] = nw[h * 128 + 16 * n + i16];
    for (int c = 0; c < SEQ / 128; ++c) {
        const int t0 = c * 128;
        const float a0 = scan64_sum(fl0, lane); const float a1 = scan64_sum(fl1, lane) + __shfl(a0, 63);
        const float b0 = il0 - a0, b1 = il1 - a1;
        const float pm0 = scan64_max(b0, lane); const float pm1 = fmaxf(scan64_max(b1, lane), __shfl(pm0, 63));
        const float a_last = __shfl(a1, 63), bmax = __shfl(pm1, 63);
        const float g_n = a_last + bmax, m_new = fmaxf(a_last + m_prev, g_n), s_old = __expf(a_last + m_prev - m_new), s_new = __expf(g_n - m_new);
        {
            const int r = lr;
            const float br = (r < 64) ? __shfl(b0, r & 63) : __shfl(b1, r & 63);
            const float rk = prr * 0.125f, wk = __expf(br - bmax) * rk * s_new;
#pragma unroll
            for (int hh = 0; hh < 2; ++hh) {
                *(LAS v4u*)(Qm + r * LK + 16 * dg + 8 * hh) = pq[hh];
                const v4u kk = pk[hh];
                float kf[8] = {bflo(kk.x), bfhi(kk.x), bflo(kk.y), bfhi(kk.y), bflo(kk.z), bfhi(kk.z), bflo(kk.w), bfhi(kk.w)};
                *(LAS v4u*)(Km + r * LK + 16 * dg + 8 * hh) = (v4u){pk2(kf[0] * rk, kf[1] * rk), pk2(kf[2] * rk, kf[3] * rk), pk2(kf[4] * rk, kf[5] * rk), pk2(kf[6] * rk, kf[7] * rk)};
                *(LAS v4u*)(Kw + r * LK + 16 * dg + 8 * hh) = (v4u){pk2(kf[0] * wk, kf[1] * wk), pk2(kf[2] * wk, kf[3] * wk), pk2(kf[4] * wk, kf[5] * wk), pk2(kf[6] * wk, kf[7] * wk)};
            }
#pragma unroll
            for (int q = 0; q < 4; ++q) { const v4u x = *(const v4u*)(zb + (size_t)(t0 + r) * NZ + Z_MV + h * 128 + 32 * dg + 8 * q); const float rv = prr;
                *(LAS v4u*)(Vm + r * LV + 32 * dg + 8 * q) = (v4u){pk2(bflo(x.x) * rv, bfhi(x.x) * rv), pk2(bflo(x.y) * rv, bfhi(x.y) * rv), pk2(bflo(x.z) * rv, bfhi(x.z) * rv), pk2(bflo(x.w) * rv, bfhi(x.w) * rv)}; }
            *(LAS v4u*)(Vm + r * LV + 128 + 8 * dg) = (v4u){dg == 0 ? 0x00003f80u : 0u, 0u, 0u, 0u};
            if (c + 1 < SEQ / 128) ML_FETCH(t0 + 128);
        }
        __syncthreads();
        float Mi[4], ai[4], rri[4];
#pragma unroll
        for (int r = 0; r < 4; ++r) { const int i = 16 * w + 4 * g + r; rri[r] = rstd1[t0 + i]; const float pmi = (w < 4) ? __shfl(pm0, i & 63) : __shfl(pm1, i & 63); ai[r] = (w < 4) ? __shfl(a0, i & 63) : __shfl(a1, i & 63); Mi[r] = fmaxf(pmi, m_prev); }
        bf16x8 aq[2];
#pragma unroll
        for (int s = 0; s < 2; ++s) aq[s] = frag_row(Qm, LK, 16 * w, 32 * s, lane);
        f32x4 acco[9];
#pragma unroll
        for (int n = 0; n < 9; ++n) acco[n] = (f32x4){0.f, 0.f, 0.f, 0.f};
#pragma unroll
        for (int s = 0; s < 2; ++s) {
#pragma unroll
          for (int hf = 0; hf < 2; ++hf) { bf16x8 bb[5];
#pragma unroll
            for (int n = 0; n < 5 - hf; ++n) bb[n] = frag_tr(Cm, LV, 32 * s, 16 * (5 * hf + n), lane);
            SCHED_FENCE();
#pragma unroll
            for (int n = 0; n < 5 - hf; ++n) acco[5 * hf + n] = MFMA16(aq[s], bb[n], acco[5 * hf + n]); } }
        { float si[4];
#pragma unroll
          for (int r = 0; r < 4; ++r) si[r] = __expf(m_prev - Mi[r]) * rri[r];
#pragma unroll
          for (int n = 0; n < 9; ++n)
#pragma unroll
            for (int r = 0; r < 4; ++r) acco[n][r] *= si[r]; }
        LDS_FENCE();
#pragma unroll
        for (int n = 0; n < 8; ++n) {
            if (n <= w) { f32x4 sa = (f32x4){0.f, 0.f, 0.f, 0.f}; bf16x8 bb[2];
#pragma unroll
                for (int s = 0; s < 2; ++s) bb[s] = frag_row(Km, LK, 16 * n, 32 * s, lane);
                SCHED_FENCE();
#pragma unroll
                for (int s = 0; s < 2; ++s) sa = MFMA16(aq[s], bb[s], sa);
                const int j = 16 * n + i16; const float bj = (n < 4) ? __shfl(b0, j & 63) : __shfl(b1, j & 63);
#pragma unroll
                for (int r = 0; r < 4; ++r) { const int i = 16 * w + 4 * g + r; Pm[i * LQ + j] = (bf16)f2bf(j <= i ? sa[r] * rri[r] * __expf(bj - Mi[r]) : 0.f); } }
            else if (n == w + 1) {
#pragma unroll
                for (int r = 0; r < 4; ++r) Pm[(16 * w + 4 * g + r) * LQ + 16 * n + i16] = (bf16)0; }
        }
        LDS_FENCE();
#pragma unroll
        for (int k = 0; k < 5; ++k) accC[k] = accC[k] * s_old;
#pragma unroll
        for (int s = 0; s < 4; ++s) { const bf16x8 ak = frag_tr(Kw, LK, 32 * s, 16 * dt, lane); const bool doi = (s <= (w >> 1)); bf16x8 ap = ak;
            if (doi) ap = frag_row(Pm, LQ, 16 * w, 32 * s, lane);
#pragma unroll
          for (int hf = 0; hf < 2; ++hf) { const bool dos = (hf == eh);
            if (doi || dos) { bf16x8 bb[5];
#pragma unroll
              for (int n = 0; n < 5; ++n) bb[n] = frag_tr(Vm, LV, 32 * s, 16 * (5 * hf + n), lane);
              SCHED_FENCE();
              if (doi) {
#pragma unroll
                for (int n = 0; n < 5 - hf; ++n) acco[5 * hf + n] = MFMA16(ap, bb[n], acco[5 * hf + n]); }
              if (dos) {
#pragma unroll
                for (int k = 0; k < 5; ++k) accC[k] = MFMA16(ak, bb[k], accC[k]); } } } }
        bf16 gvr[4][8];
#pragma unroll
        for (int r = 0; r < 4; ++r) { const bf16* gr = zb + (size_t)(t0 + 16 * w + 4 * g + r) * NZ + Z_MO + h * 128 + i16;
#pragma unroll
            for (int n = 0; n < 8; ++n) gvr[r][n] = gr[16 * n]; }
        LDS_FENCE();
        __syncthreads();
#pragma unroll
        for (int k = 0; k < 5; ++k)
#pragma unroll
            for (int r = 0; r < 4; ++r) Cm[(16 * dt + 4 * g + r) * LV + 16 * (5 * eh + k) + i16] = (bf16)f2bf(accC[k][r]);
#pragma unroll
        for (int r = 0; r < 4; ++r) {
            const float den = __shfl(acco[8][r], lane & 48);
            const float dd = 1.0f / fmaxf(fabsf(den), __expf(-(ai[r] + Mi[r])));
            float q = 0.f;
#pragma unroll
            for (int n = 0; n < 8; ++n) { acco[n][r] *= dd; q += acco[n][r] * acco[n][r]; }
            const float rstd = rsqrtf(red16_sum(q) * (1.f / 128.f) + 1e-6f);
            const int pos = t0 + 16 * w + 4 * g + r; bf16* yr = yb + (size_t)pos * 1024;
#pragma unroll
            for (int n = 0; n < 8; ++n) { const int e = 16 * n + i16; yr[e] = (bf16)f2bf(acco[n][r] * rstd * nwv[n] * sigm(bf1(gvr[r][n]) * rri[r])); }
        }
        m_prev = m_new;
    }
    __syncthreads();
#undef ML_FETCH
}
__device__ __forceinline__ int vt_off(int row, int chunk) { return row * 128 + ((chunk ^ ((row & 7) << 1)) << 3); }
__device__ __forceinline__ bf16x8 frag_trp(const LAS bf16* X, int k0, int c0, int lane) {
    const int g = lane >> 4, q = (lane & 15) >> 2, p = lane & 3;
    const LAS bf16* a = X + vt_off(k0 + 4 * g + q, (c0 >> 3) + (p >> 1)) + 4 * (p & 1);
    const s16x4 lo = __builtin_amdgcn_ds_read_tr16_b64_v4i16((LAS s16x4*)a);
    const s16x4 hi = __builtin_amdgcn_ds_read_tr16_b64_v4i16((LAS s16x4*)(a + 16 * 128));
    return __builtin_shufflevector(lo, hi, 0, 1, 2, 3, 4, 5, 6, 7);
}
__device__ __forceinline__ void moba_unit(Frame& F, const float* qn, int b, int h, int qi) {
    constexpr int KT_E = 128 * LQ, VT_E = 128 * 128;
    LAS bf16* Kt0 = (LAS bf16*)(F.lds); LAS bf16* Vt0 = Kt0 + 2 * KT_E; LAS float* RR = (LAS float*)(Vt0 + 2 * VT_E);
    const int tid = F.tid, lane = F.lane, w = tid >> 6, i16 = lane & 15, g = lane >> 4;
    const int blk = qi >> 1, qt = qi & 1, q0 = qi * 128;
    const bf16* zb = WSP(bf16, WS_Z) + (size_t)(b * SEQ) * NZ + h * 128;
    bf16x8 aq[4];
    { const bf16* qr = zb + (size_t)(q0 + 16 * w + i16) * NZ + Z_AQ + 8 * g;
#pragma unroll
      for (int s = 0; s < 4; ++s) aq[s] = *(const bf16x8*)(qr + 32 * s); }
    const int lr = tid >> 2, dg = tid & 3;
    v4u pk[4], pv[4]; float prr;
    const float* rstdb = WSP(float, WS_RSTD) + (size_t)(b * SEQ);
#define MB_FETCH(k0_) do { const bf16* zr_ = zb + (size_t)((k0_) + lr) * NZ + 32 * dg; \
        _Pragma("unroll") for (int q_ = 0; q_ < 4; ++q_) { pk[q_] = *(const v4u*)(zr_ + Z_AK + 8 * q_); pv[q_] = *(const v4u*)(zr_ + Z_AV + 8 * q_); } prr = rstdb[(k0_) + lr]; } while (0)
#define MB_STAGE(buf_) do { LAS bf16* kd_ = Kt0 + (buf_) * KT_E + lr * LQ + 32 * dg; LAS bf16* vd_ = Vt0 + (buf_) * VT_E; \
        _Pragma("unroll") for (int q_ = 0; q_ < 4; ++q_) { *(LAS v4u*)(kd_ + 8 * q_) = pk[q_]; *(LAS v4u*)(vd_ + vt_off(lr, 4 * dg + q_)) = pv[q_]; } if (dg == 0) RR[(buf_) * 128 + lr] = prr; } while (0)
    MB_FETCH(0);
    { float ss = 0.f; float qf[4][8];
#pragma unroll
      for (int s = 0; s < 4; ++s) { const v4u x = __builtin_bit_cast(v4u, aq[s]); qf[s][0] = bflo(x.x); qf[s][1] = bfhi(x.x); qf[s][2] = bflo(x.y); qf[s][3] = bfhi(x.y); qf[s][4] = bflo(x.z); qf[s][5] = bfhi(x.z); qf[s][6] = bflo(x.w); qf[s][7] = bfhi(x.w);
#pragma unroll
          for (int j = 0; j < 8; ++j) ss += qf[s][j] * qf[s][j]; }
      ss += __shfl_xor(ss, 16); ss += __shfl_xor(ss, 32);
      const int pos = q0 + 16 * w + i16; const float rr = rstdb[pos]; const float f = rr * rsqrtf(ss * rr * rr * (1.f / 128.f) + 1e-6f);
      const f32x2* tb = WSP(f32x2, WS_TAB) + SEQ * 64 + pos * 64 + 8 * g;
#pragma unroll
      for (int s = 0; s < 2; ++s) {
#pragma unroll
          for (int j = 0; j < 8; ++j) { const float x1 = qf[s][j] * f * qn[32 * s + 8 * g + j], x2 = qf[s + 2][j] * f * qn[64 + 32 * s + 8 * g + j]; const f32x2 cs = tb[32 * s + j];
              qf[s][j] = x1 * cs.x - x2 * cs.y; qf[s + 2][j] = x1 * cs.y + x2 * cs.x; } }
#pragma unroll
      for (int s = 0; s < 4; ++s) { const v4u o = (v4u){pk2(qf[s][0], qf[s][1]), pk2(qf[s][2], qf[s][3]), pk2(qf[s][4], qf[s][5]), pk2(qf[s][6], qf[s][7])}; aq[s] = __builtin_bit_cast(bf16x8, o); } }
    unsigned sel = 0u;
    {
        f32x4 gacc = (f32x4){0.f, 0.f, 0.f, 0.f};
        const float* km = WSP(float, WS_KMEAN) + (size_t)((b * NH + h) * 16) * 128 + (size_t)(i16 & 7) * 256 + 8 * g;
        const bool live = i16 < blk;
#pragma unroll
        for (int s = 0; s < 4; ++s) { f32x4 k0 = (f32x4){0.f, 0.f, 0.f, 0.f}, k1 = k0;
            if (live) { k0 = *(const f32x4*)(km + 32 * s) + *(const f32x4*)(km + 128 + 32 * s); k1 = *(const f32x4*)(km + 32 * s + 4) + *(const f32x4*)(km + 128 + 32 * s + 4); }
            const v4u hi = (v4u){pk2(k0.x, k0.y), pk2(k0.z, k0.w), pk2(k1.x, k1.y), pk2(k1.z, k1.w)};
            const v4u lo = (v4u){pk2(k0.x - bflo(hi.x), k0.y - bfhi(hi.x)), pk2(k0.z - bflo(hi.y), k0.w - bfhi(hi.y)), pk2(k1.x - bflo(hi.z), k1.y - bfhi(hi.z)), pk2(k1.z - bflo(hi.w), k1.w - bfhi(hi.w))};
            gacc = MFMA16(__builtin_bit_cast(bf16x8, hi), aq[s], gacc); gacc = MFMA16(__builtin_bit_cast(bf16x8, lo), aq[s], gacc); }
        float gate[8];
#pragma unroll
        for (int n = 0; n < 8; ++n) { const float gv = __shfl(gacc[n & 3], i16 + 16 * (n >> 2)); gate[n] = (n < blk) ? gv : -INFINITY; }
#pragma unroll
        for (int s = 0; s < 3; ++s) { float bv = -INFINITY; int best = -1;
#pragma unroll
            for (int n = 0; n < 8; ++n) { const bool c = !((sel >> n) & 1u) && gate[n] > bv; bv = c ? gate[n] : bv; best = c ? n : best; }
            if (best >= 0) sel |= 1u << best; }
    }
#pragma unroll
    for (int s = 0; s < 4; ++s) { const v4u u = __builtin_bit_cast(v4u, aq[s]); const float c2 = 0.08838834764831845f * 1.4426950408889634f;
        const v4u o = (v4u){pk2(bflo(u.x) * c2, bfhi(u.x) * c2), pk2(bflo(u.y) * c2, bfhi(u.y) * c2), pk2(bflo(u.z) * c2, bfhi(u.z) * c2), pk2(bflo(u.w) * c2, bfhi(u.w) * c2)}; aq[s] = __builtin_bit_cast(bf16x8, o); }
    f32x4 acco[8];
#pragma unroll
    for (int n = 0; n < 8; ++n) acco[n] = (f32x4){0.f, 0.f, 0.f, 0.f};
    float mq = -1e30f, lq = 0.f;
    const int ntiles = 2 * blk + qt + 1;
    const int qrel = 16 * w + i16 - 4 * g;
    __syncthreads();
    MB_STAGE(0);
    if (ntiles > 1) MB_FETCH(128);
    __syncthreads();
    for (int kt = 0; kt < ntiles; ++kt) {
        const int kb = kt >> 1; const bool own = (kb == blk), diag = (kt == 2 * blk + qt);
        const LAS bf16* Kt = Kt0 + (kt & 1) * KT_E; const LAS bf16* Vt = Vt0 + (kt & 1) * VT_E;
        f32x4 sc[8];
#pragma unroll
        for (int n = 0; n < 8; ++n) sc[n] = (f32x4){0.f, 0.f, 0.f, 0.f};
#pragma unroll
        for (int s = 0; s < 4; ++s) { bf16x8 bb[8];
#pragma unroll
            for (int n = 0; n < 8; ++n) bb[n] = frag_row(Kt, LQ, 16 * n, 32 * s, lane);
            SCHED_FENCE();
#pragma unroll
            for (int n = 0; n < 8; ++n) sc[n] = MFMA16(bb[n], aq[s], sc[n]); }
        if (diag) {
#pragma unroll
            for (int n = 0; n < 8; ++n)
#pragma unroll
                for (int r = 0; r < 4; ++r) sc[n][r] = (16 * n + r <= qrel) ? sc[n][r] : -1e30f; }
        const bool rowok = own || ((sel >> kb) & 1u);
        float mx = -1e30f;
#pragma unroll
        for (int n = 0; n < 8; ++n) mx = fmaxf(mx, fmaxf(fmaxf(sc[n][0], sc[n][1]), fmaxf(sc[n][2], sc[n][3])));
        mx = fmaxf(mx, __shfl_xor(mx, 16)); mx = fmaxf(mx, __shfl_xor(mx, 32));
        const float mnew = rowok ? fmaxf(mq, mx) : mq;
        const float alpha = __builtin_amdgcn_exp2f(mq - mnew); mq = mnew;
        const float msub = rowok ? mnew : 1e30f;
        float ps = 0.f;
#pragma unroll
        for (int n = 0; n < 8; ++n)
#pragma unroll
            for (int r = 0; r < 4; ++r) { sc[n][r] = __builtin_amdgcn_exp2f(sc[n][r] - msub); ps += sc[n][r]; }
        lq = lq * alpha + ps;
        { const LAS float* rrt = RR + (kt & 1) * 128 + 4 * g;
#pragma unroll
          for (int n = 0; n < 8; ++n) sc[n] = sc[n] * *(const LAS f32x4*)(rrt + 16 * n); }
        if (!__all(alpha == 1.0f)) {
#pragma unroll
            for (int n = 0; n < 8; ++n) acco[n] = acco[n] * alpha; }
#pragma unroll
        for (int t = 0; t < 4; ++t) {
            const v4u pw = (v4u){pk2(sc[2 * t][0], sc[2 * t][1]), pk2(sc[2 * t][2], sc[2 * t][3]), pk2(sc[2 * t + 1][0], sc[2 * t + 1][1]), pk2(sc[2 * t + 1][2], sc[2 * t + 1][3])};
            const bf16x8 pf = __builtin_bit_cast(bf16x8, pw); bf16x8 bb[8];
#pragma unroll
            for (int n = 0; n < 8; ++n) bb[n] = frag_trp(Vt, 32 * t, 16 * n, lane);
            SCHED_FENCE();
#pragma unroll
            for (int n = 0; n < 8; ++n) acco[n] = MFMA16(bb[n], pf, acco[n]); }
        if (kt + 1 < ntiles) { MB_STAGE((kt + 1) & 1); if (kt + 2 < ntiles) MB_FETCH((kt + 2) * 128); }
        __syncthreads();
    }
    lq += __shfl_xor(lq, 16); lq += __shfl_xor(lq, 32);
    const float inv = 1.0f / lq;
    bf16* yr = WSP(bf16, WS_Y) + (size_t)2 * M * 1024 + (size_t)(b * SEQ + q0 + 16 * w + i16) * 1024 + h * 128 + 4 * g;
#pragma unroll
    for (int n = 0; n < 8; ++n) *(v2u*)(yr + 16 * n) = (v2u){pk2(acco[n][0] * inv, acco[n][1] * inv), pk2(acco[n][2] * inv, acco[n][3] * inv)};
#undef MB_FETCH
#undef MB_STAGE
}
__device__ __forceinline__ void mix_phase(Frame& F, const float* rgn, const float* mln, const float* qn, unsigned* head) {
    volatile LAS unsigned* slot = F.MISC;
    for (;;) {
        if (F.tid == 0) slot[0] = __hip_atomic_fetch_add(head, 1u, __ATOMIC_RELAXED, __HIP_MEMORY_SCOPE_AGENT);
        __syncthreads();
        const unsigned it = slot[0];
        __syncthreads();
        if (it >= 128u + 1024u) break;
        { int t_ = threadIdx.x; asm volatile("" : "+v"(t_)); F.tid = t_; F.lane = t_ & 63; }
        if (it < 64u) ret_unit(F, rgn, (int)(it >> 3), (int)(it & 7u));
        else if (it < 128u) mlstm_unit(F, mln, (int)((it - 64u) >> 3), (int)(it & 7u));
        else { const unsigned rank = it - 128u; moba_unit(F, qn, (int)((rank & 63u) >> 3), (int)(rank & 7u), 15 - (int)(rank >> 6)); }
    }
}
}
constexpr int N_PHASES = 1 + 8 * DEPTH;
__global__ void __launch_bounds__(NWAVES * 64, 2) fwd(Args args) {
    extern __shared__ __attribute__((aligned(16))) unsigned char lds[];
    Frame F;
    F.lds = (LAS unsigned char*)lds;
    F.MISC = (volatile LAS unsigned*)(F.lds + MISC_OFF);
    F.tid = threadIdx.x; F.lane = F.tid & 63; F.wave = __builtin_amdgcn_readfirstlane(F.tid >> 6); F.G = gridDim.x; F.bx = blockIdx.x;
    F.ws = args.ws;
    for (int u = F.tid; u < (LDS_BYTES - LDSCTL_OFF) / 4; u += NWAVES * 64) ((LAS unsigned*)(F.lds + LDSCTL_OFF))[u] = 0u;
    __syncthreads();
    XcdBarrier bar = xcd_barrier_post((unsigned*)(F.ws + WS_CTL) + CW_BAR + args.li * XCD_BAR_WORDS, F.MISC + 8);
    const int lo = args.ph_lo, hi = args.ph_hi;
#define RUN(p) (lo <= (p) && (p) < hi)
#define SEAM(p) do { if ((p) + 1 < hi) xcd_barrier(bar); } while (0)
    if (RUN(0)) { p0_prologue(F, args); SEAM(0); }
    for (int l = 0; l < DEPTH; ++l) {
        const int p0 = 1 + 8 * l;
        { int t_ = threadIdx.x; asm volatile("" : "+v"(t_)); F.tid = t_; F.lane = t_ & 63; F.wave = __builtin_amdgcn_readfirstlane(t_ >> 6); int b_ = blockIdx.x; asm volatile("" : "+s"(b_)); F.bx = b_; }
        float* rs = WSP(float, WS_RS) + (size_t)(2 * l) * M * 32;
        if (RUN(p0 + 0)) {
            { const int kf = (((F.bx >> 3) & 7) >> 2);
#define IN_F8_CALL(I0, NN) { pg8::Gemm g8{WSP(bf16, WS_XB8), (const bf16*)(F.ws + ws_win8(l)), M, N8, DM / 2}; pg8::RangeOrder<pg8::StaticOrder> S8; S8.b.init(M, N8, F.G, F.bx); S8.i0 = (I0); S8.n = (NN); \
                pg8::EpiGate8 E8{F.ws + WS_ZG, 3 * DM, 1.0f / 64.0f, WSP(bf16, WS_Z), NZ, 3 * DM / 256, Z_MO}; \
                pg8::gemm_phase<pg8::EpiGate8, pg8::RangeOrder<pg8::StaticOrder>, false, true, true>(F.lds + RING_OFF, g8, S8, E8); }
              IN_F8_CALL(0, kf)
              { pg8::Gemm g{WSP(bf16, WS_XB), WSP(bf16, WS_WIN) + (size_t)l * NZ * DM, M, Z_GA - 1024, DM}; pg8::SkipOrder S; S.init(M, Z_GA - 1024, F.G, F.bx); S.skip0 = Z_MO / 256; S.nskip = 4;
                pg8::EpiBf16 E{WSP(bf16, WS_Z), NZ, nullptr, -1, 0};
                pg8::gemm_phase<pg8::EpiBf16, pg8::SkipOrder, false, true>(F.lds + RING_OFF, g, S, E); }
              { int kf2 = (((F.bx >> 3) & 7) >> 2); asm volatile("" : "+s"(kf2));
                IN_F8_CALL(kf2, 1 << 20) }
#undef IN_F8_CALL
            }
            SEAM(p0 + 0); }
        if (RUN(p0 + 1)) { prep_phase(F, args.in[I_QN] + l * 128, args.in[I_KN] + l * 128, WSP(bf16, WS_W16G) + (size_t)l * 16 * DM, rs, args.in[I_BIG] + l * 8, args.in[I_BFG] + l * 8); SEAM(p0 + 1); }
        if (RUN(p0 + 2)) { mx::mix_phase(F, args.in[I_RGN] + l * 1024, args.in[I_MLN] + l * 1024, args.in[I_QN] + l * 128, (unsigned*)(F.ws + WS_CTL) + CW_QUEUE + 64 * l); SEAM(p0 + 2); }
        if (RUN(p0 + 3)) {
            pg8::StaticOrder3 S; S.init(M, DM, F.G, F.bx);
            pg8::Gemm g{WSP(bf16, WS_Y), WSP(bf16, WS_WP) + (size_t)l * 3 * DM * 1024, M, DM, 1024, (size_t)M * 1024, (size_t)DM * 1024}; pg8::EpiGateAcc E{WSP(bf16, WS_MG), DM, F.ws + WS_ZG, 3 * DM, WSP(float, WS_RSTD)};
            pg8::gemm_phase<pg8::EpiGateAcc, pg8::StaticOrder3, true, true>(F.lds + RING_OFF, g, S, E);
            SEAM(p0 + 3); }
        if (RUN(p0 + 4)) {
            pg8::Gemm g{WSP(bf16, WS_MG), WSP(bf16, WS_WOUT) + (size_t)l * DM * DM, M, DM, DM}; pg8::StaticOrder S; S.init(M, DM, F.G, F.bx);
            pg8::EpiRes<false> E{WSP(bf16, WS_XB), rs + (size_t)32 * M, nullptr, DM};
            pg8::gemm_phase<pg8::EpiRes<false>, pg8::StaticOrder, true, true>(F.lds + RING_OFF, g, S, E);
            SEAM(p0 + 4); }
        if (RUN(p0 + 5)) {
            pg8::Gemm g{WSP(bf16, WS_XB), WSP(bf16, WS_WUP) + (size_t)l * NUP * DM, M, NUP, DM}; pg8::StaticOrder S; S.init(M, NUP, F.G, F.bx);
            pg8::EpiGLU E{WSP(bf16, WS_ACT), args.in[I_CW] + (size_t)l * 3 * NUP, args.in[I_CB] + (size_t)l * NUP, rs + (size_t)32 * M, WSP(bf16, WS_SB)};
            pg8::gemm_phase<pg8::EpiGLU, pg8::StaticOrder, false, true>(F.lds + RING_OFF, g, S, E);
            SEAM(p0 + 5); }
        if (RUN(p0 + 6)) { glu_fix_phase(F, args.in[I_CW] + (size_t)l * 3 * NUP, args.in[I_CB] + (size_t)l * NUP); SEAM(p0 + 6); }
        if (RUN(p0 + 7)) {
            pg8::Gemm g{WSP(bf16, WS_ACT), WSP(bf16, WS_WDN) + (size_t)l * DM * DFF, M, DM, DFF}; pg8::StaticOrder S; S.init(M, DM, F.G, F.bx);
            if (l + 1 < DEPTH) { pg8::EpiRes<false, true> E{WSP(bf16, WS_XB), rs + (size_t)64 * M, nullptr, DM, F.ws + WS_XB8};
                pg8::gemm_phase<pg8::EpiRes<false, true>, pg8::StaticOrder, true, true>(F.lds + RING_OFF, g, S, E); }
            else { pg8::EpiRes<true> E{WSP(bf16, WS_XB), nullptr, args.out, DM};
                pg8::gemm_phase<pg8::EpiRes<true>, pg8::StaticOrder, true, true>(F.lds + RING_OFF, g, S, E); }
            SEAM(p0 + 7); }
    }
#undef RUN
#undef SEAM
}

#ifndef MK_N_LAUNCHES
#define MK_N_LAUNCHES 1
#endif
extern "C" void kernel_launch(void* const* d_in, const int* in_sizes, int n_in, void* d_out, int out_size, void* d_ws, size_t ws_size, hipStream_t stream) {
    static int grid = 0;
    if (grid == 0) {
        if (n_in != 18 || in_sizes[0] != M * DM || out_size != M * DM || ws_size < WS_END) { fprintf(stderr, "kernel_launch: unexpected shapes (n_in %d, in0 %d, out %d, ws %zu)\n", n_in, n_in > 0 ? in_sizes[0] : -1, out_size, ws_size); grid = -1; return; }
        int dev = 0, cus = 0, per_cu = 0;
        if (hipGetDevice(&dev) != hipSuccess || hipDeviceGetAttribute(&cus, hipDeviceAttributeMultiprocessorCount, dev) != hipSuccess) { grid = -1; return; }
        if (hipFuncSetAttribute((const void*)fwd, hipFuncAttributeMaxDynamicSharedMemorySize, LDS_BYTES) != hipSuccess) { fprintf(stderr, "kernel_launch: hipFuncSetAttribute failed\n"); grid = -1; return; }
        if (hipOccupancyMaxActiveBlocksPerMultiprocessor(&per_cu, (const void*)fwd, NWAVES * 64, LDS_BYTES) != hipSuccess || per_cu < 1) fprintf(stderr, "kernel_launch: occupancy query reports %d\n", per_cu);
        (void)hipGetLastError();
        grid = cus;
    }
    if (grid < 0) return;
    if (hipMemsetAsync((char*)d_ws + WS_CTL, 0, CTL_ZERO_BYTES, stream) != hipSuccess) return;
    Args a{};
    for (int i = 0; i < 18; ++i) a.in[i] = (const float*)d_in[i];
    a.out = (float*)d_out; a.ws = (unsigned char*)d_ws; a.pad = 0;
    constexpr int NL = MK_N_LAUNCHES;
    for (int li = 0; li < NL; ++li) {
        a.ph_lo = (NL == 1) ? 0 : li; a.ph_hi = (NL == 1) ? N_PHASES : li + 1; a.li = (NL == 1) ? 0 : 0;
        hipLaunchKernelGGL(fwd, dim3(grid), dim3(NWAVES * 64), LDS_BYTES, stream, a);
    }
}
```

```cpp
#include <hip/hip_runtime.h>
#include <cstdio>
#include <cstdint>
namespace pg8 {
#define PG8_LAS __attribute__((address_space(3)))
typedef unsigned short bf16_t;
typedef short bf16x8 __attribute__((ext_vector_type(8)));
typedef float f32x4 __attribute__((ext_vector_type(4)));
typedef unsigned u32x4 __attribute__((ext_vector_type(4)));
constexpr int BM = 256, BK = 64, HALF = 128, HTB = HALF * BK * 2  , STAGE_BYTES = 8 * HTB, NXCD = 8, WGM = 8;

__host__ __device__ __forceinline__ int lds_byte(int r, int c) { const int st = (r >> 4) * 2 + (c >> 5), rr = r & 15, cc = c & 31, ob = rr * 64 + cc * 2; return st * 1024 + (ob ^ (((ob >> 9) & 1) << 5)); }
__host__ __device__ __forceinline__ void stage_rc(int b, int& R, int& C) { const int st = b / 1024, sb = b % 1024, swz = sb ^ (((sb >> 9) & 1) << 5); R = (st >> 1) * 16 + swz / 64; C = (st & 1) * 32 + (swz % 64) / 2; }
__host__ __device__ __forceinline__ int perm32(int rho) { const int n = rho >> 4, i = rho & 15; return 8 * (i >> 2) + 4 * n + (i & 3); }

struct Unit { int pm, pn, z; };
struct Gemm { const bf16_t* A; const bf16_t* Bt; int M, N, K; size_t zA, zB; };

struct StaticOrder {
    int nM, nN, nwg, G, c;
    __host__ __device__ void init(int M, int N, int G_, int c_) { nM = M / BM; nN = N / BM; nwg = nM * nN; G = G_; c = c_; }
    __host__ __device__ bool next(int i, Unit& u) const {
        const long L = (long)i * G + c; if (L >= nwg) return false;
        int wgid = (int)L; { const int q = nwg / NXCD, r = nwg % NXCD, xcd = wgid % NXCD, off = wgid / NXCD; wgid = (xcd < r ? xcd * (q + 1) : r * (q + 1) + (xcd - r) * q) + off; }
        const int nig = WGM * nN, gid = wgid / nig, fm = gid * WGM, gsz = (nM - fm) < WGM ? (nM - fm) : WGM;
        u.pm = fm + ((wgid % nig) % gsz); u.pn = (wgid % nig) / gsz; u.z = 0; return true;
    }
    __device__ __forceinline__ void a_ready(const Unit&) const {}
    __device__ __forceinline__ void done(const Unit&) const {}
};

struct SkipOrder : StaticOrder {
    int skip0, nskip;
    __host__ __device__ bool next(int i, Unit& u) const { if (!StaticOrder::next(i, u)) return false; if (u.pn >= skip0) u.pn += nskip; return true; }
};
template <class Base> struct RangeOrder {
    Base b; int i0, n;
    __host__ __device__ bool next(int i, Unit& u) const { return i < n && b.next(i0 + i, u); }
    __device__ __forceinline__ void a_ready(const Unit&) const {}
    __device__ __forceinline__ void done(const Unit&) const {}
};
struct StaticOrder3 : StaticOrder {
    __host__ __device__ bool next(int i, Unit& u) const { if (!StaticOrder::next(i / 3, u)) return false; u.z = i % 3; return true; }
};
__device__ __forceinline__ unsigned cvt_pk_bf16(float lo, float hi) { unsigned r; asm volatile("v_cvt_pk_bf16_f32 %0, %1, %2" : "=v"(r) : "v"(lo), "v"(hi)); return r; }
typedef unsigned u32x2 __attribute__((ext_vector_type(2)));
__device__ __forceinline__ u32x4 qgather(const u32x4 w, int lane) { const int src = 4 * (16 * (lane & 3) + (lane >> 2)); u32x4 o;
#pragma unroll
    for (int k = 0; k < 4; ++k) o[k] = (unsigned)__builtin_amdgcn_ds_bpermute(src, (int)w[k]); return o; }
__device__ __forceinline__ u32x4 qscatter(const u32x4 w, int lane) { const int src = 4 * (4 * (lane & 15) + (lane >> 4)); u32x4 o;
#pragma unroll
    for (int k = 0; k < 4; ++k) o[k] = (unsigned)__builtin_amdgcn_ds_bpermute(src, (int)w[k]); return o; }
struct EpiBf16 {
    static constexpr bool PERM = true, AFTER_DRAIN = false, KEEP = false, APERM = false;
    bf16_t* O; int ldc; unsigned char* G8; int g8_pn0, g8_ld;
    __device__ __forceinline__ void operator()(const f32x4 (&acc)[2][2][4][2], const Unit& u, int wr, int wc, int fr, int fq) const {
        const int lane = 16 * fq + fr; const int row0 = u.pm * BM + wr * 64 + (lane >> 2); const int col0 = u.pn * BM + wc * 32 + 8 * (lane & 3);
#pragma unroll
        for (int ai = 0; ai < 2; ++ai)
#pragma unroll
            for (int m = 0; m < 4; ++m) { bf16_t* rowp = O + (size_t)(row0 + ai * HALF + m * 16) * ldc + col0;
#pragma unroll
                for (int bj = 0; bj < 2; ++bj) { const f32x4 v0 = acc[ai][bj][m][0], v1 = acc[ai][bj][m][1];
                    u32x4 w; w.x = cvt_pk_bf16(v0[0], v0[1]); w.y = cvt_pk_bf16(v0[2], v0[3]); w.z = cvt_pk_bf16(v1[0], v1[1]); w.w = cvt_pk_bf16(v1[2], v1[3]);
                    *(u32x4*)(rowp + bj * HALF) = qgather(w, lane); } }
    }
};
struct EpiGate8 {
    static constexpr bool PERM = true, AFTER_DRAIN = false, KEEP = false, APERM = false;
    unsigned char* G8; int g8_ld; float sc; bf16_t* O; int ldc, o_pn0, o_col0;
    __device__ __forceinline__ void operator()(const f32x4 (&acc)[2][2][4][2], const Unit& u, int wr, int wc, int fr, int fq) const {
        const int lane = 16 * fq + fr; const int row0 = u.pm * BM + wr * 64 + (lane >> 2); const int pc = wc * 32 + 8 * (lane & 3);
        if (u.pn >= o_pn0) { const int col0 = o_col0 + (u.pn - o_pn0) * BM + pc;
#pragma unroll
            for (int ai = 0; ai < 2; ++ai)
#pragma unroll
                for (int m = 0; m < 4; ++m) { bf16_t* rowp = O + (size_t)(row0 + ai * HALF + m * 16) * ldc + col0;
#pragma unroll
                    for (int bj = 0; bj < 2; ++bj) { const f32x4 v0 = acc[ai][bj][m][0] * sc, v1 = acc[ai][bj][m][1] * sc;
                        u32x4 w; w.x = cvt_pk_bf16(v0[0], v0[1]); w.y = cvt_pk_bf16(v0[2], v0[3]); w.z = cvt_pk_bf16(v1[0], v1[1]); w.w = cvt_pk_bf16(v1[2], v1[3]);
                        *(u32x4*)(rowp + bj * HALF) = qgather(w, lane); } }
            return; }
        const int gc0 = u.pn * BM + pc; const int src = 4 * (16 * (lane & 3) + (lane >> 2));
#pragma unroll
        for (int ai = 0; ai < 2; ++ai)
#pragma unroll
            for (int m = 0; m < 4; ++m) { unsigned char* rowp = G8 + (size_t)(row0 + ai * HALF + m * 16) * g8_ld + gc0;
#pragma unroll
                for (int bj = 0; bj < 2; ++bj) { const f32x4 v0 = acc[ai][bj][m][0] * sc, v1 = acc[ai][bj][m][1] * sc; u32x2 w;
                    w.x = (unsigned)__builtin_amdgcn_cvt_pk_fp8_f32(v0[2], v0[3], __builtin_amdgcn_cvt_pk_fp8_f32(v0[0], v0[1], 0, false), true);
                    w.y = (unsigned)__builtin_amdgcn_cvt_pk_fp8_f32(v1[2], v1[3], __builtin_amdgcn_cvt_pk_fp8_f32(v1[0], v1[1], 0, false), true);
                    w.x = (unsigned)__builtin_amdgcn_ds_bpermute(src, (int)w.x); w.y = (unsigned)__builtin_amdgcn_ds_bpermute(src, (int)w.y);
                    *(u32x2*)(rowp + bj * HALF) = w; } }
    }
};
__device__ __forceinline__ float bf_lo(unsigned w) { return __uint_as_float(w << 16); }
__device__ __forceinline__ float bf_hi(unsigned w) { return __uint_as_float(w & 0xffff0000u); }
__device__ __forceinline__ float sigmoid_f(float x) { return __builtin_amdgcn_rcpf(1.0f + __expf(-x)); }
struct EpiGateAcc {
    static constexpr bool PERM = true, AFTER_DRAIN = false, KEEP = true, APERM = false;
    bf16_t* O; int ldc; const unsigned char* G8; int g8_ld; const float* rstd;
    template <int E> static __device__ __forceinline__ float g8f(const u32x2 w) { return __builtin_amdgcn_cvt_f32_fp8((int)(E < 4 ? w.x : w.y), E & 3); }
    static __device__ __forceinline__ float em(float g, float rr) { return __expf(-fminf(fmaxf(g * rr, -40.f), 40.f)); }
    __device__ __forceinline__ void operator()(f32x4 (&acc)[2][2][4][2], const Unit& u, int wr, int wc, int fr, int fq) const {
        const int row0 = u.pm * BM + wr * 64 + fr; const int col0 = u.pn * BM + wc * 32 + 8 * fq; const bool last = (u.z == 2); const float dmask = last ? 0.0f : 1.0f;
        const unsigned char* Gn = G8 + (size_t)u.z * ldc; const unsigned char* Gd = G8 + (size_t)(last ? u.z : u.z + 1) * ldc;
#pragma unroll
        for (int ai = 0; ai < 2; ++ai)
#pragma unroll
            for (int m = 0; m < 4; ++m) { const size_t row = (size_t)(row0 + ai * HALF + m * 16); const float rr = rstd[row];
#pragma unroll
                for (int bj = 0; bj < 2; ++bj) {
                    const u32x2 gn = *(const u32x2*)(Gn + row * g8_ld + col0 + bj * HALF), gd = *(const u32x2*)(Gd + row * g8_ld + col0 + bj * HALF);
                    f32x4 v0 = acc[ai][bj][m][0], v1 = acc[ai][bj][m][1];
#define GA_MUL(E) ((1.0f + dmask * em(g8f<E>(gd), rr)) * __builtin_amdgcn_rcpf(1.0f + em(g8f<E>(gn), rr)))
                    v0[0] *= GA_MUL(0); v0[1] *= GA_MUL(1); v0[2] *= GA_MUL(2); v0[3] *= GA_MUL(3); v1[0] *= GA_MUL(4); v1[1] *= GA_MUL(5); v1[2] *= GA_MUL(6); v1[3] *= GA_MUL(7);
#undef GA_MUL
                    acc[ai][bj][m][0] = v0; acc[ai][bj][m][1] = v1;
                    if (last) { u32x4 w; w.x = cvt_pk_bf16(v0[0], v0[1]); w.y = cvt_pk_bf16(v0[2], v0[3]); w.z = cvt_pk_bf16(v1[0], v1[1]); w.w = cvt_pk_bf16(v1[2], v1[3]); *(u32x4*)(O + row * ldc + col0 + bj * HALF) = w; } } }
    }
};
template <bool LAST, bool F8 = false> struct EpiRes {
    static constexpr bool PERM = true, AFTER_DRAIN = false, KEEP = false, APERM = false;
    bf16_t* xb; float* rs; float* out; int ldc; unsigned char* x8;
    __device__ __forceinline__ void operator()(const f32x4 (&acc)[2][2][4][2], const Unit& u, int wr, int wc, int fr, int fq) const {
        const int row0 = u.pm * BM + wr * 64 + fr; const int col0 = u.pn * BM + wc * 32 + 8 * fq;
#pragma unroll
        for (int ai = 0; ai < 2; ++ai)
#pragma unroll
            for (int m = 0; m < 4; ++m) { const int row = row0 + ai * HALF + m * 16; const size_t off = (size_t)row * ldc + col0; float sq = 0.f;
#pragma unroll
                for (int bj = 0; bj < 2; ++bj) { const u32x4 p = *(const u32x4*)(xb + off + bj * HALF); const f32x4 v0 = acc[ai][bj][m][0], v1 = acc[ai][bj][m][1];
                    const float o0 = bf_lo(p.x) + v0[0], o1 = bf_hi(p.x) + v0[1], o2 = bf_lo(p.y) + v0[2], o3 = bf_hi(p.y) + v0[3], o4 = bf_lo(p.z) + v1[0], o5 = bf_hi(p.z) + v1[1], o6 = bf_lo(p.w) + v1[2], o7 = bf_hi(p.w) + v1[3];
                    if (LAST) { *(f32x4*)(out + off + bj * HALF) = (f32x4){o0, o1, o2, o3}; *(f32x4*)(out + off + bj * HALF + 4) = (f32x4){o4, o5, o6, o7}; }
                    else { sq += ((o0 * o0 + o1 * o1) + (o2 * o2 + o3 * o3)) + ((o4 * o4 + o5 * o5) + (o6 * o6 + o7 * o7));
                        u32x4 w; w.x = cvt_pk_bf16(o0, o1); w.y = cvt_pk_bf16(o2, o3); w.z = cvt_pk_bf16(o4, o5); w.w = cvt_pk_bf16(o6, o7); *(u32x4*)(xb + off + bj * HALF) = w;
                        if (F8) { u32x2 q; q.x = (unsigned)__builtin_amdgcn_cvt_pk_fp8_f32(o2, o3, __builtin_amdgcn_cvt_pk_fp8_f32(o0, o1, 0, false), true); q.y = (unsigned)__builtin_amdgcn_cvt_pk_fp8_f32(o6, o7, __builtin_amdgcn_cvt_pk_fp8_f32(o4, o5, 0, false), true);
                            *(u32x2*)(x8 + off + bj * HALF) = q; } } }
                if (!LAST) { sq += __shfl_xor(sq, 16); sq += __shfl_xor(sq, 32); if (fq == 0) rs[(size_t)row * 32 + u.pn * 4 + wc] = sq; } }
    }
};

struct EpiGLU {
    static constexpr bool PERM = true, AFTER_DRAIN = false, KEEP = false, APERM = true;
    bf16_t* ACT; const float* cw; const float* cb; const float* rs; bf16_t* SB;
    static __device__ __forceinline__ f32x4 prev_lane(const f32x4 v, int src) { f32x4 o;
#pragma unroll
        for (int k = 0; k < 4; ++k) o[k] = __shfl(v[k], src); return o; }
    static __device__ __forceinline__ f32x4 silu4(const f32x4 a) { f32x4 o;
#pragma unroll
        for (int k = 0; k < 4; ++k) o[k] = a[k] * __builtin_amdgcn_rcpf(1.0f + __expf(-a[k])); return o; }
    __device__ __forceinline__ void operator()(const f32x4 (&acc)[2][2][4][2], const Unit& u, int wr, int wc, int fr, int fq) const {
        constexpr int DFF_ = 5632, NUP_ = 2 * DFF_;
        const int T0 = u.pm * BM + 8 * (16 * wr + fr), jq = u.pn * HALF + wc * 32 + 8 * fq, grp = 2 * u.pm + wr;
        const int lane = 16 * fq + fr, qsrc = 4 * (16 * (lane & 3) + (lane >> 2)), Tq = u.pm * BM + 8 * (16 * wr + (lane >> 2)), jqq = u.pn * HALF + wc * 32 + 8 * (lane & 3);
        float rr[8];
        { const f32x4 ra = *(const f32x4*)(rs + T0), rb = *(const f32x4*)(rs + T0 + 4); rr[0] = ra[0]; rr[1] = ra[1]; rr[2] = ra[2]; rr[3] = ra[3]; rr[4] = rb[0]; rr[5] = rb[1]; rr[6] = rb[2]; rr[7] = rb[3]; }
#pragma unroll
        for (int n = 0; n < 2; ++n) { const int j = jq + 4 * n;
            const f32x4 ca = *(const f32x4*)(cb + j), cbv = *(const f32x4*)(cb + DFF_ + j);
            const f32x4 a0 = *(const f32x4*)(cw + j), a1 = *(const f32x4*)(cw + NUP_ + j), a2 = *(const f32x4*)(cw + 2 * NUP_ + j);
            const f32x4 b0 = *(const f32x4*)(cw + DFF_ + j), b1 = *(const f32x4*)(cw + NUP_ + DFF_ + j), b2 = *(const f32x4*)(cw + 2 * NUP_ + DFF_ + j);
            f32x4 va[8], vb[8];
#pragma unroll
            for (int i = 0; i < 8; ++i) { va[i] = acc[i >> 2][0][i & 3][n] * rr[i]; vb[i] = acc[i >> 2][1][i & 3][n] * rr[i]; }
            const int psrc = fq * 16 + ((fr + 15) & 15); const f32x4 pa6 = prev_lane(va[6], psrc), pa7 = prev_lane(va[7], psrc), pb6 = prev_lane(vb[6], psrc), pb7 = prev_lane(vb[7], psrc);
#pragma unroll
            for (int i = 0; i < 8; ++i) {
                const f32x4 xa1 = i >= 1 ? va[i - 1] : pa7, xa2 = i >= 2 ? va[i - 2] : (i == 1 ? pa7 : pa6), xb1 = i >= 1 ? vb[i - 1] : pb7, xb2 = i >= 2 ? vb[i - 2] : (i == 1 ? pb7 : pb6);
                const f32x4 ua = ca + a0 * xa2 + a1 * xa1 + a2 * va[i], ub = cbv + b0 * xb2 + b1 * xb1 + b2 * vb[i];
                const f32x4 o = silu4(ua) * ub;
                { u32x2 w; w.x = cvt_pk_bf16(o[0], o[1]); w.y = cvt_pk_bf16(o[2], o[3]);
                  w.x = (unsigned)__builtin_amdgcn_ds_bpermute(qsrc, (int)w.x); w.y = (unsigned)__builtin_amdgcn_ds_bpermute(qsrc, (int)w.y);
                  if (i >= 2 || (lane >> 2) != 0) *(u32x2*)(ACT + (size_t)(Tq + i) * DFF_ + jqq + 4 * n) = w; } }
            if (fr == 0) {
#pragma unroll
                for (int i = 0; i < 2; ++i) { u32x2 w; w.x = cvt_pk_bf16(va[i][0], va[i][1]); w.y = cvt_pk_bf16(va[i][2], va[i][3]); *(u32x2*)(SB + ((size_t)grp * 4 + 2 + i) * NUP_ + j) = w;
                    w.x = cvt_pk_bf16(vb[i][0], vb[i][1]); w.y = cvt_pk_bf16(vb[i][2], vb[i][3]); *(u32x2*)(SB + ((size_t)grp * 4 + 2 + i) * NUP_ + DFF_ + j) = w; } }
            if (fr == 15) {
#pragma unroll
                for (int i = 0; i < 2; ++i) { u32x2 w; w.x = cvt_pk_bf16(va[6 + i][0], va[6 + i][1]); w.y = cvt_pk_bf16(va[6 + i][2], va[6 + i][3]); *(u32x2*)(SB + ((size_t)(grp + 1) * 4 + i) * NUP_ + j) = w;
                    w.x = cvt_pk_bf16(vb[6 + i][0], vb[6 + i][1]); w.y = cvt_pk_bf16(vb[6 + i][2], vb[6 + i][3]); *(u32x2*)(SB + ((size_t)(grp + 1) * 4 + i) * NUP_ + DFF_ + j) = w; } }
        }
    }
};

template <class E, class = void> struct EpiB64 { static constexpr bool v = false; };
template <class E> struct EpiB64<E, decltype((void)E::B64)> { static constexpr bool v = E::B64; };
typedef int i32x4_t __attribute__((ext_vector_type(4)));
typedef int i32x8_t __attribute__((ext_vector_type(8)));
__device__ __forceinline__ i32x8_t cat8(const bf16x8 a, const bf16x8 b) { return __builtin_shufflevector((i32x4_t)a, (i32x4_t)b, 0, 1, 2, 3, 4, 5, 6, 7); }
template <class Epi, class Sched, bool ALIGN_EPI = false, bool SP2 = false, bool F8 = false>
__device__ __forceinline__ void gemm_phase(PG8_LAS unsigned char* lds, const Gemm g, const Sched& S, const Epi& E) {
    int tid_ = threadIdx.x; asm volatile("" : "+v"(tid_));
    const int tid = tid_, wid = __builtin_amdgcn_readfirstlane(tid >> 6), lane = tid & 63, wr = wid >> 2, wc = wid & 3, fr = lane & 15, fq = lane >> 4;
    const int K = g.K, nt = K / BK;
    unsigned voffA[2], voffB[2];
#pragma unroll
    for (int i = 0; i < 2; ++i) { int R, C; stage_rc(tid * 16 + i * 8192, R, C); const int Rb = EpiB64<Epi>::v ? (2 * (R & ~31) + perm32(R & 31)) : Epi::PERM ? ((R & ~31) + perm32(R & 31)) : R;
        const int Ra = Epi::APERM ? (8 * (16 * (R >> 6) + (R & 15)) + ((R >> 4) & 3)) : R;
        voffA[i] = (unsigned)(Ra * K + C) * 2u; voffB[i] = (unsigned)(Rb * K + C) * 2u; }
    const size_t kstep = (size_t)(BK * 2);
    const size_t hstep = (size_t)HALF * K * 2;
    const size_t hstepA = Epi::APERM ? (size_t)4 * K * 2 : hstep;
    const size_t hstepB = EpiB64<Epi>::v ? (size_t)32 * K * 2 : hstep;
    const size_t tstep = 2 * hstep;
    const unsigned ldsw = (unsigned)wid * 1024u;
    const int aoff = lds_byte(wr * 64 + fr, fq * 8), boff = lds_byte(wc * 32 + fr, fq * 8);
#define PG8_SA(b, h) (((b) * 2 + (h)) * HTB)
#define PG8_SB(b, h) ((4 + (b) * 2 + (h)) * HTB)
#define PG8_STAGE(bufoff, gbase, voff) do { _Pragma("unroll") for (int _i = 0; _i < 2; ++_i) \
        __builtin_amdgcn_global_load_lds((const unsigned*)((const char*)(gbase) + (voff)[_i]), (PG8_LAS unsigned*)(lds + (bufoff) + ldsw + _i * 8192), 16, 0, 0); } while (0)
#define PG8_LDA(dst, b, h) do { _Pragma("unroll") for (int m = 0; m < 4; ++m) _Pragma("unroll") for (int k = 0; k < 2; ++k) dst[m][k] = *(const PG8_LAS bf16x8*)(lds + PG8_SA(b, h) + aoff + m * 2048 + k * 1024); } while (0)
#define PG8_LDB(dst, b, h) do { _Pragma("unroll") for (int n = 0; n < 2; ++n) _Pragma("unroll") for (int k = 0; k < 2; ++k) dst[n][k] = *(const PG8_LAS bf16x8*)(lds + PG8_SB(b, h) + boff + n * 2048 + k * 1024); } while (0)
#define PG8_MMA(ai, bj, At, Bt) do { __builtin_amdgcn_s_setprio(1); if constexpr (F8) { _Pragma("unroll") for (int m = 0; m < 4; ++m) _Pragma("unroll") for (int n = 0; n < 2; ++n) \
        asm volatile("v_mfma_f32_16x16x128_f8f6f4 %0, %1, %2, %0" : "+v"(acc[ai][bj][m][n]) : "v"(cat8(Bt[n][0], Bt[n][1])), "v"(cat8(At[m][0], At[m][1]))); } else { \
        _Pragma("unroll") for (int m = 0; m < 4; ++m) _Pragma("unroll") for (int n = 0; n < 2; ++n) _Pragma("unroll") for (int k = 0; k < 2; ++k) \
        acc[ai][bj][m][n] = __builtin_amdgcn_mfma_f32_16x16x32_bf16(Bt[n][k], At[m][k], acc[ai][bj][m][n], 0, 0, 0); } __builtin_amdgcn_s_setprio(0); } while (0)
#define PG8_WAIT_V(n) asm volatile("s_waitcnt vmcnt(" #n ")" ::: "memory")
#define PG8_WAIT_L(n) asm volatile("s_waitcnt lgkmcnt(" #n ")" ::: "memory")
#define PG8_BAR __builtin_amdgcn_s_barrier()
#define PG8_SCHED __builtin_amdgcn_sched_barrier(0)
    Unit cur, nxt; int ui = 0;
    if (!S.next(0, cur)) return;
    f32x4 acc[2][2][4][2];
#pragma unroll
    for (int a = 0; a < 2; ++a)
#pragma unroll
        for (int b = 0; b < 2; ++b)
#pragma unroll
            for (int m = 0; m < 4; ++m)
#pragma unroll
                for (int n = 0; n < 2; ++n) acc[a][b][m][n] = (f32x4){0.f, 0.f, 0.f, 0.f};
    bf16x8 At[4][2], B0[2][2], B1[2][2];
    const char* cA = (const char*)(g.A + (size_t)cur.z * g.zA) + (size_t)cur.pm * tstep; const char* cB = (const char*)(g.Bt + (size_t)cur.z * g.zB) + (size_t)cur.pn * tstep;
    S.a_ready(cur);
    if constexpr (SP2) {
        PG8_STAGE(PG8_SB(0, 0), cB, voffB); PG8_STAGE(PG8_SB(0, 1), cB + hstepB, voffB); PG8_STAGE(PG8_SA(0, 0), cA, voffA); PG8_STAGE(PG8_SA(0, 1), cA + hstepA, voffA);
        if (wr == 1) PG8_BAR;
        PG8_WAIT_V(2); PG8_BAR;
        PG8_STAGE(PG8_SB(1, 0), cB + kstep, voffB); PG8_STAGE(PG8_SA(1, 0), cA + kstep, voffA); PG8_STAGE(PG8_SB(1, 1), cB + hstepB + kstep, voffB);
        PG8_WAIT_V(6); PG8_BAR;
    } else {
        PG8_STAGE(PG8_SB(0, 0), cB, voffB); PG8_STAGE(PG8_SA(0, 0), cA, voffA); PG8_STAGE(PG8_SB(0, 1), cB + hstepB, voffB); PG8_STAGE(PG8_SA(0, 1), cA + hstepA, voffA);
        if (wr == 1) PG8_BAR;
        PG8_WAIT_V(4); PG8_BAR;
        PG8_STAGE(PG8_SB(1, 0), cB + kstep, voffB); PG8_STAGE(PG8_SA(1, 0), cA + kstep, voffA); PG8_STAGE(PG8_SB(1, 1), cB + hstepB + kstep, voffB);
        PG8_WAIT_V(6); PG8_BAR;
    }
    for (;;) {
        const bool has_next = S.next(ui + 1, nxt);
        const char* nA = has_next ? (const char*)(g.A + (size_t)nxt.z * g.zA) + (size_t)nxt.pm * tstep : cA; const char* nB = has_next ? (const char*)(g.Bt + (size_t)nxt.z * g.zB) + (size_t)nxt.pn * tstep : cB;
        for (int t = 0; t < nt; t += 2) {
            const bool last = (t == nt - 2);
            const char* a1 = cA + (size_t)(t + 1) * kstep;
            const char* a2 = last ? nA : cA + (size_t)(t + 2) * kstep; const char* b2 = last ? nB : cB + (size_t)(t + 2) * kstep;
            const char* a3 = a2 + kstep; const char* b3 = b2 + kstep;
            if (last && has_next) S.a_ready(nxt);
            if constexpr (SP2) {
            PG8_LDB(B0, 0, 0); PG8_LDB(B1, 0, 1); PG8_SCHED; PG8_LDA(At, 0, 0); PG8_STAGE(PG8_SA(1, 1), a1 + hstepA, voffA);
            PG8_WAIT_V(8); PG8_WAIT_L(0); PG8_BAR; PG8_MMA(0, 0, At, B0); PG8_MMA(0, 1, At, B1); PG8_BAR; PG8_SCHED;
            PG8_LDA(At, 0, 1); PG8_STAGE(PG8_SB(0, 0), b2, voffB); PG8_STAGE(PG8_SB(0, 1), b2 + hstepB, voffB); PG8_STAGE(PG8_SA(0, 0), a2, voffA);
            PG8_WAIT_V(8); PG8_WAIT_L(0); PG8_BAR; PG8_MMA(1, 0, At, B0); PG8_MMA(1, 1, At, B1); PG8_BAR; PG8_SCHED;
            PG8_LDB(B0, 1, 0); PG8_LDB(B1, 1, 1); PG8_SCHED; PG8_LDA(At, 1, 0); PG8_STAGE(PG8_SA(0, 1), a2 + hstepA, voffA);
            PG8_WAIT_V(8); PG8_WAIT_L(0); PG8_BAR; PG8_MMA(0, 0, At, B0); PG8_MMA(0, 1, At, B1); PG8_BAR; PG8_SCHED;
            PG8_LDA(At, 1, 1); PG8_STAGE(PG8_SB(1, 0), b3, voffB); PG8_STAGE(PG8_SB(1, 1), b3 + hstepB, voffB); PG8_STAGE(PG8_SA(1, 0), a3, voffA);
            PG8_WAIT_V(8); PG8_WAIT_L(0); PG8_BAR; PG8_MMA(1, 0, At, B0); PG8_MMA(1, 1, At, B1); PG8_BAR; PG8_SCHED;
            } else {
            PG8_LDB(B0, 0, 0); PG8_SCHED; PG8_LDA(At, 0, 0); PG8_STAGE(PG8_SA(1, 1), a1 + hstepA, voffA);
            PG8_WAIT_L(8); PG8_BAR; PG8_WAIT_L(0); PG8_MMA(0, 0, At, B0); PG8_BAR; PG8_SCHED;
            PG8_LDB(B1, 0, 1); PG8_STAGE(PG8_SB(0, 0), b2, voffB);
            PG8_BAR; PG8_WAIT_L(0); PG8_MMA(0, 1, At, B1); PG8_BAR;
            PG8_LDA(At, 0, 1); PG8_STAGE(PG8_SA(0, 0), a2, voffA);
            PG8_BAR; PG8_WAIT_L(0); PG8_MMA(1, 0, At, B0); PG8_BAR; PG8_SCHED;
            PG8_STAGE(PG8_SB(0, 1), b2 + hstepB, voffB);
            PG8_WAIT_V(6); PG8_BAR; PG8_MMA(1, 1, At, B1); PG8_BAR;
            PG8_LDB(B0, 1, 0); PG8_SCHED; PG8_LDA(At, 1, 0); PG8_STAGE(PG8_SA(0, 1), a2 + hstepA, voffA);
            PG8_WAIT_L(8); PG8_BAR; PG8_WAIT_L(0); PG8_MMA(0, 0, At, B0); PG8_BAR; PG8_SCHED;
            PG8_LDB(B1, 1, 1); PG8_STAGE(PG8_SB(1, 0), b3, voffB);
            PG8_BAR; PG8_WAIT_L(0); PG8_MMA(0, 1, At, B1); PG8_BAR;
            PG8_LDA(At, 1, 1); PG8_STAGE(PG8_SA(1, 0), a3, voffA);
            PG8_BAR; PG8_WAIT_L(0); PG8_MMA(1, 0, At, B0); PG8_BAR; PG8_SCHED;
            PG8_STAGE(PG8_SB(1, 1), b3 + hstepB, voffB);
            PG8_WAIT_V(6); PG8_BAR; PG8_MMA(1, 1, At, B1); PG8_BAR;
            }
        }
        if constexpr (F8) asm volatile("s_nop 15\n\ts_nop 15\n\ts_nop 15\n\ts_nop 15" ::: "memory");
        if constexpr (ALIGN_EPI) { if (wr == 0) PG8_BAR; }
        if constexpr (!Epi::AFTER_DRAIN) { E(acc, cur, wr, wc, fr, fq); S.done(cur); }
        if (!has_next) break;
        if (!(Epi::KEEP && nxt.z != 0)) {
#pragma unroll
        for (int a = 0; a < 2; ++a)
#pragma unroll
            for (int b = 0; b < 2; ++b)
#pragma unroll
                for (int m = 0; m < 4; ++m)
#pragma unroll
                    for (int n = 0; n < 2; ++n) acc[a][b][m][n] = (f32x4){0.f, 0.f, 0.f, 0.f};
        }
        cur = nxt; cA = nA; cB = nB; ++ui;
        if constexpr (ALIGN_EPI) { if (wr == 1) PG8_BAR; }
    }
    PG8_WAIT_V(0);
    if constexpr (!ALIGN_EPI) { if (wr == 0) PG8_BAR; }
    PG8_BAR;
    if constexpr (Epi::AFTER_DRAIN) { E.fused(acc, cur, wr, wc, fr, fq, lds, wid, lane); S.done(cur); }
#undef PG8_SA
#undef PG8_SB
#undef PG8_STAGE
#undef PG8_LDA
#undef PG8_LDB
#undef PG8_MMA
#undef PG8_WAIT_V
#undef PG8_WAIT_L
#undef PG8_BAR
#undef PG8_SCHED
}
}

constexpr int NWAVES = 8;
constexpr int BATCH = 8, SEQ = 2048, DM = 2048, DEPTH = 4, M = BATCH * SEQ, NH = 8;
constexpr int NIN = 16400, NZ = 16384, DFF = 5632, NUP = 2 * DFF, NY = 3072;
constexpr int Z_RQ = 0, Z_RK = 1024, Z_RV = 2048, Z_RG = 3072, Z_MQ = 4096, Z_MK = 4608, Z_MV = 5120, Z_MO = 6144, Z_AQ = 7168, Z_AK = 8192, Z_AV = 9216, Z_GA = 10240, Z_GB = 12288, Z_GC = 14336;
constexpr int W_GATE_COL = 7168;
constexpr size_t MiB = 1u << 20;
constexpr size_t WS_CTL = 0, CTL_ZERO_BYTES = 1 * MiB;
constexpr size_t WS_RS = 1520 * MiB;
constexpr size_t WS_TAB = 2 * MiB + 512 * 1024;
constexpr size_t WS_RSTD = 7 * MiB + 512 * 1024;
constexpr size_t WS_RSTD2 = 7 * MiB + 768 * 1024;
constexpr size_t WS_W16G = 7 * MiB;
constexpr size_t WS_KMEAN = 5 * MiB;
constexpr size_t WS_GIF = 6 * MiB;
constexpr size_t WS_WIN = 8 * MiB;
constexpr size_t WS_WP = 264 * MiB;
constexpr size_t WS_WOUT = 312 * MiB;
constexpr size_t WS_WUP = 344 * MiB;
constexpr size_t WS_WDN = 520 * MiB;
constexpr size_t WS_XB = 608 * MiB;
constexpr size_t WS_Z = 672 * MiB;
constexpr size_t WS_Y = 1184 * MiB;
constexpr size_t WS_MG = 1280 * MiB;
constexpr size_t WS_ACT = 1344 * MiB;
constexpr size_t WS_ZG = 1536 * MiB;
constexpr size_t WS_SB = 1632 * MiB;
constexpr size_t WS_XB8 = 1648 * MiB;
constexpr size_t WS_END = 1680 * MiB;
constexpr int N8 = 3 * DM + 1024;
__host__ __device__ constexpr size_t ws_win8(int l) { return WS_WIN + ((size_t)l * NZ + Z_GA) * DM * 2; }
constexpr int CW_TMO = 0, CW_CODE = 1;
constexpr int CW_BAR = 4096;
constexpr int CW_QUEUE = 8192;
constexpr int RING_OFF = 0, RING_BYTES = 131072;
constexpr int LDS_BYTES = 163840;
constexpr int LDSCTL_OFF = LDS_BYTES - 512, MISC_OFF = LDSCTL_OFF + 320;
static_assert(MISC_OFF + 128 <= LDS_BYTES, "LDS map");

#define GAS __attribute__((address_space(1)))
#define LAS __attribute__((address_space(3)))
typedef unsigned short bf16;
typedef unsigned v4u __attribute__((ext_vector_type(4)));
typedef unsigned v2u __attribute__((ext_vector_type(2)));
typedef float f32x4 __attribute__((ext_vector_type(4)));
typedef float f32x2 __attribute__((ext_vector_type(2)));
typedef GAS unsigned gu32;
#define RLX_AGENT __ATOMIC_RELAXED, __HIP_MEMORY_SCOPE_AGENT
#define LDS_WAIT() asm volatile("s_waitcnt lgkmcnt(0)" ::: "memory")
#define VM_WAIT() asm volatile("s_waitcnt vmcnt(0)" ::: "memory")
typedef __bf16 bf16x2_t __attribute__((ext_vector_type(2)));
__device__ __forceinline__ unsigned pk2(float lo, float hi) { const f32x2 v = {lo, hi}; const bf16x2_t b = __builtin_convertvector(v, bf16x2_t); return __builtin_bit_cast(unsigned, b); }
__device__ __forceinline__ unsigned f2bf(float f) { return pk2(f, f); }
__device__ __forceinline__ float bflo(unsigned w) { return __uint_as_float(w << 16); }
__device__ __forceinline__ float bfhi(unsigned w) { return __uint_as_float(w & 0xffff0000u); }
__device__ __forceinline__ float bf1(bf16 v) { return __uint_as_float((unsigned)v << 16); }
__device__ __forceinline__ float sigm(float x) { return 1.0f / (1.0f + __expf(-x)); }

#define XB_TMO      128
#define XB_XCNT(j)  (256  + 64 * (j))
#define XB_XSUB(j)  (1280 + 64 * (j))
#define XB_XGEN(j)  (2304 + 64 * (j))
#define XB_TOP      3328
#define XB_TOPGEN   3392
#define XCD_BAR_WORDS 3456
#define XB_SPIN_CAP (1u << 18)

__device__ __forceinline__ unsigned xb_ld(unsigned* p)              { return __hip_atomic_load(p, __ATOMIC_RELAXED, __HIP_MEMORY_SCOPE_AGENT); }
__device__ __forceinline__ unsigned xb_add(unsigned* p, unsigned v) { return __hip_atomic_fetch_add(p, v, __ATOMIC_RELAXED, __HIP_MEMORY_SCOPE_AGENT); }
__device__ __forceinline__ unsigned xb_xcc_id() { return (unsigned)__builtin_amdgcn_s_getreg((3 << 11) | 20) & 0xFu; }
#define XB_SPIN(cond, bar) do { unsigned _sp = 0; while (cond) { __builtin_amdgcn_s_sleep(1); \
    if ((++_sp & 255u) == 0u) { if (xb_ld(&(bar)[XB_TMO])) break; if (_sp > XB_SPIN_CAP) { atomicAdd(&(bar)[XB_TMO], 1u); break; } } } } while (0)

struct XcdBarrier {
    unsigned* bar; unsigned x;
    volatile LAS unsigned* st;
};

__device__ __forceinline__ XcdBarrier xcd_barrier_post(unsigned* bar, volatile LAS unsigned* st) {
    XcdBarrier b; b.bar = bar; b.x = xb_xcc_id(); b.st = st;
    if (threadIdx.x == 0) (void)xb_add(&bar[XB_XCNT(b.x)], 1u);
    return b;
}
__device__ __forceinline__ void xcd_barrier_complete(unsigned* bar, unsigned x, unsigned& nloc, unsigned& nx) {
    const unsigned G = gridDim.x * gridDim.y * gridDim.z;
    unsigned sum, cnt, mine, sp = 0u;
    for (;;) {
        sum = 0u; cnt = 0u; mine = 0u;
#pragma unroll
        for (unsigned j = 0; j < 16; ++j) { const unsigned c = xb_ld(&bar[XB_XCNT(j)]); sum += c; cnt += (c > 0u) ? 1u : 0u; mine = (j == x) ? c : mine; }
        if (sum == G) break;
        __builtin_amdgcn_s_sleep(1);
        if ((++sp & 255u) == 0u) { if (xb_ld(&bar[XB_TMO])) break; if (sp > XB_SPIN_CAP) { atomicAdd(&bar[XB_TMO], 1u); break; } }
    }
    nloc = mine > 0u ? mine : 1u; nx = cnt > 0u ? cnt : 1u;
}

__device__ __forceinline__ void xcd_barrier(const XcdBarrier& b) {
    asm volatile("s_waitcnt vmcnt(0)" ::: "memory");
    __syncthreads();
    if (threadIdx.x == 0) {
        unsigned* bar = b.bar;
        __builtin_amdgcn_s_waitcnt(0);
        unsigned nloc = b.st[0], nx = b.st[1];
        if (nloc == 0u) { xcd_barrier_complete(bar, b.x, nloc, nx); b.st[0] = nloc; b.st[1] = nx; }
        const unsigned old = xb_add(&bar[XB_XSUB(b.x)], 1u);
        const unsigned gen = old / nloc;
        if (old + 1u == (gen + 1u) * nloc) {
            __builtin_amdgcn_fence(__ATOMIC_RELEASE, "agent");
            asm volatile("s_waitcnt vmcnt(0)" ::: "memory");
            const unsigned og = xb_add(&bar[XB_TOP], 1u);
            const unsigned tg = og / nx;
            if (og + 1u == (tg + 1u) * nx) xb_add(&bar[XB_TOPGEN], 1u);
            else XB_SPIN(xb_ld(&bar[XB_TOPGEN]) == tg, bar);
            __builtin_amdgcn_fence(__ATOMIC_ACQUIRE, "agent");
            xb_add(&bar[XB_XGEN(b.x)], 1u);
            asm volatile("s_waitcnt vmcnt(0)" ::: "memory");
        } else {
            XB_SPIN(xb_ld(&bar[XB_XGEN(b.x)]) == gen, bar);
            __builtin_amdgcn_fence(__ATOMIC_ACQUIRE, "agent");
            asm volatile("s_waitcnt vmcnt(0)" ::: "memory");
        }
    }
    __syncthreads();
}

struct Args { const float* in[18]; float* out; unsigned char* ws; int ph_lo, ph_hi, li, pad; };
enum { I_X = 0, I_WIN, I_BIG, I_BFG, I_NMIX, I_RGN, I_MLN, I_QN, I_KN, I_WPA, I_WPB, I_WPC, I_WOUT, I_NFFN, I_WUP, I_CW, I_CB, I_WDN };
struct Frame {
    LAS unsigned char* lds;
    volatile LAS unsigned* MISC;
    unsigned char* ws;
    int tid, lane, wave, G, bx;
};
#define WSP(T, off) ((T*)(F.ws + (off)))
__device__ __forceinline__ float wave_sum(float v) {
#pragma unroll
    for (int o = 1; o < 64; o <<= 1) v += __shfl_xor(v, o);
    return v;
}
__device__ __forceinline__ float wave_max(float v) {
#pragma unroll
    for (int o = 1; o < 64; o <<= 1) v = fmaxf(v, __shfl_xor(v, o));
    return v;
}
__device__ __forceinline__ void p0_transpose_item(const float* W, int ldw, int K, int nblk, bf16* WT, LAS float* scr, int item, int lane, const float* gk = nullptr, unsigned char* WT8 = nullptr, int nb8 = 0) {
    const int kb = item / nblk, nb = item % nblk, k0 = 64 * kb, n0 = 32 * nb;
#pragma unroll 8
    for (int i = 0; i < 32; ++i) { const int kk = 2 * i + (lane >> 5); scr[kk * 33 + (lane & 31)] = W[(size_t)(k0 + kk) * ldw + n0 + (lane & 31)]; }
    LDS_WAIT(); asm volatile("" ::: "memory");
    const int c = lane & 7;
    f32x4 g0 = (f32x4){1.f, 1.f, 1.f, 1.f}, g1 = g0;
    if (gk) { g0 = *(const f32x4*)(gk + k0 + 8 * c); g1 = *(const f32x4*)(gk + k0 + 8 * c + 4); }
    if (WT8 && nb >= nb8) {
#pragma unroll
        for (int j = 0; j < 4; ++j) { const int n = (lane >> 3) + 8 * j; const LAS float* s = scr + (8 * c) * 33 + n; const f32x4 h0 = g0 * 64.f, h1 = g1 * 64.f;
            v2u o; o.x = (unsigned)__builtin_amdgcn_cvt_pk_fp8_f32(s[2 * 33] * h0[2], s[3 * 33] * h0[3], __builtin_amdgcn_cvt_pk_fp8_f32(s[0 * 33] * h0[0], s[1 * 33] * h0[1], 0, false), true);
            o.y = (unsigned)__builtin_amdgcn_cvt_pk_fp8_f32(s[6 * 33] * h1[2], s[7 * 33] * h1[3], __builtin_amdgcn_cvt_pk_fp8_f32(s[4 * 33] * h1[0], s[5 * 33] * h1[1], 0, false), true);
            *(GAS v2u*)(WT8 + (size_t)(n0 - 32 * nb8 + n) * K + k0 + 8 * c) = o; }
    } else
#pragma unroll
    for (int j = 0; j < 4; ++j) { const int n = (lane >> 3) + 8 * j; const LAS float* s = scr + (8 * c) * 33 + n;
        v4u o; o.x = pk2(s[0 * 33] * g0[0], s[1 * 33] * g0[1]); o.y = pk2(s[2 * 33] * g0[2], s[3 * 33] * g0[3]); o.z = pk2(s[4 * 33] * g1[0], s[5 * 33] * g1[1]); o.w = pk2(s[6 * 33] * g1[2], s[7 * 33] * g1[3]);
        *(GAS v4u*)(WT + (size_t)(n0 + n) * K + k0 + 8 * c) = o; }
    LDS_WAIT(); asm volatile("" ::: "memory");
}
__device__ __forceinline__ void p0_prologue(Frame& F, const Args& args) {
    LAS float* scr = (LAS float*)(F.lds + RING_OFF + F.wave * 16384);
    const int gw = F.bx * NWAVES + F.wave, NGW = F.G * NWAVES;
    constexpr int I_INA = 32 * 224, I_INB = 32 * 288, I_P = 16 * 64, I_OUT = 32 * 64, I_UP = 32 * 352, I_DN = 88 * 64;
    constexpr int I_LAYER = I_INA + I_INB + 3 * I_P + I_OUT + I_UP + I_DN;
    for (int it = gw; it < DEPTH * I_LAYER; it += NGW) {
        const int l = it / I_LAYER; int r = it % I_LAYER;
        const float* win = args.in[I_WIN] + (size_t)l * DM * NIN; bf16* wint = WSP(bf16, WS_WIN) + (size_t)l * NZ * DM;
        if (r < I_INA) { p0_transpose_item(win, NIN, DM, 224, wint, scr, r, F.lane, args.in[I_NMIX] + l * DM, F.ws + ws_win8(l) + (size_t)3 * DM * DM, Z_MO / 32); continue; } r -= I_INA;
        if (r < I_INB) { p0_transpose_item(win + 7184, NIN, DM, 288, wint + (size_t)7168 * DM, scr, r, F.lane, args.in[I_NMIX] + l * DM, F.ws + ws_win8(l), 96); continue; } r -= I_INB;
        if (r < I_P) { p0_transpose_item(args.in[I_WPA] + (size_t)l * 1024 * DM, DM, 1024, 64, WSP(bf16, WS_WP) + ((size_t)l * 3 + 0) * DM * 1024, scr, r, F.lane); continue; } r -= I_P;
        if (r < I_P) { p0_transpose_item(args.in[I_WPB] + (size_t)l * 1024 * DM, DM, 1024, 64, WSP(bf16, WS_WP) + ((size_t)l * 3 + 1) * DM * 1024, scr, r, F.lane); continue; } r -= I_P;
        if (r < I_P) { p0_transpose_item(args.in[I_WPC] + (size_t)l * 1024 * DM, DM, 1024, 64, WSP(bf16, WS_WP) + ((size_t)l * 3 + 2) * DM * 1024, scr, r, F.lane); continue; } r -= I_P;
        if (r < I_OUT) { p0_transpose_item(args.in[I_WOUT] + (size_t)l * DM * DM, DM, DM, 64, WSP(bf16, WS_WOUT) + (size_t)l * DM * DM, scr, r, F.lane); continue; } r -= I_OUT;
        if (r < I_UP) {
            const int nb = r % 352, tile = nb >> 3, wi = nb & 7, src = (wi < 4) ? 128 * tile + 32 * wi : DFF + 128 * tile + 32 * (wi - 4);
            p0_transpose_item(args.in[I_WUP] + (size_t)l * DM * NUP + (src - 32 * nb), NUP, DM, 352, WSP(bf16, WS_WUP) + (size_t)l * NUP * DM, scr, r, F.lane, args.in[I_NFFN] + l * DM); continue; } r -= I_UP;
        p0_transpose_item(args.in[I_WDN] + (size_t)l * DFF * DM, DM, DFF, 64, WSP(bf16, WS_WDN) + (size_t)l * DM * DFF, scr, r, F.lane);
    }
    const int gt = F.bx * (NWAVES * 64) + F.tid, NGT = F.G * NWAVES * 64;
    for (int i = gt; i < DEPTH * 16 * DM; i += NGT) { const int l = i / (16 * DM), c = (i / DM) % 16, k = i % DM; WSP(bf16, WS_W16G)[i] = (bf16)f2bf(args.in[I_WIN][((size_t)l * DM + k) * NIN + W_GATE_COL + c] * args.in[I_NMIX][l * DM + k]); }
    for (int m = gw; m < M; m += NGW) { const f32x4* xr = (const f32x4*)(args.in[I_X] + (size_t)m * DM) + F.lane; v2u* o8 = (v2u*)(WSP(bf16, WS_XB) + (size_t)m * DM) + F.lane; float s = 0.f;
        unsigned* q8 = (unsigned*)(F.ws + WS_XB8 + (size_t)m * DM) + F.lane;
#pragma unroll
        for (int j = 0; j < 8; ++j) { const f32x4 v = xr[64 * j]; s += (v.x * v.x + v.y * v.y) + (v.z * v.z + v.w * v.w); v2u w; w.x = pk2(v.x, v.y); w.y = pk2(v.z, v.w); o8[64 * j] = w;
            q8[64 * j] = (unsigned)__builtin_amdgcn_cvt_pk_fp8_f32(v.z, v.w, __builtin_amdgcn_cvt_pk_fp8_f32(v.x, v.y, 0, false), true); }
        s = wave_sum(s); if (F.lane < 32) WSP(float, WS_RS)[(size_t)m * 32 + F.lane] = (F.lane == 0) ? s : 0.f; }
    for (int i = gt; i < 2 * SEQ * 64; i += NGT) { const int which = i / (SEQ * 64), pos = (i / 64) % SEQ, d = i % 64;
        const float ex = which == 0 ? (float)d / 63.0f : (float)(2 * d) / 128.0f;
        const float inv = 1.0f / powf(10000.0f, ex); const float ang = (float)pos * inv; float s, c; sincosf(ang, &s, &c); WSP(f32x2, WS_TAB)[i] = (f32x2){c, s}; }
}
__device__ __forceinline__ void prep_phase(Frame& F, const float* qn, const float* kn, const bf16* w16g, const float* rs, const float* big, const float* bfg) {
    const int gw = F.bx * NWAVES + F.wave, NGW = F.G * NWAVES, lane = F.lane, rsub = lane >> 2, dg = lane & 3;
    const f32x2* trope = WSP(f32x2, WS_TAB) + SEQ * 64;
    for (int u = gw; u < BATCH * 16 * NH; u += NGW) {
        const int kind = 1, hh = u & 7, hb = (u >> 3) & 15, b = u >> 7;
        const float* wn = kn;
        const float* rsb = rs + (size_t)(b * SEQ + hb * 128) * 32 + 8 * dg;
        float wl[16], wh[16], s1[16], s2[16];
#pragma unroll
        for (int e = 0; e < 16; ++e) { wl[e] = wn[16 * dg + e]; wh[e] = wn[64 + 16 * dg + e]; s1[e] = 0.f; s2[e] = 0.f; }
        bf16* zb = WSP(bf16, WS_Z) + (size_t)(b * SEQ + hb * 128) * NZ + (kind ? Z_AK : Z_AQ) + hh * 128 + 16 * dg;
#pragma unroll 2
        for (int st = 0; st < 8; ++st) {
            const int r = rsub + 16 * st, pos = hb * 128 + r; bf16* zr = zb + (size_t)r * NZ;
            const v4u l0 = *(const v4u*)(zr), l1 = *(const v4u*)(zr + 8), h0 = *(const v4u*)(zr + 64), h1 = *(const v4u*)(zr + 72);
            float a[16] = {bflo(l0.x), bfhi(l0.x), bflo(l0.y), bfhi(l0.y), bflo(l0.z), bfhi(l0.z), bflo(l0.w), bfhi(l0.w), bflo(l1.x), bfhi(l1.x), bflo(l1.y), bfhi(l1.y), bflo(l1.z), bfhi(l1.z), bflo(l1.w), bfhi(l1.w)};
            float c[16] = {bflo(h0.x), bfhi(h0.x), bflo(h0.y), bfhi(h0.y), bflo(h0.z), bfhi(h0.z), bflo(h0.w), bfhi(h0.w), bflo(h1.x), bfhi(h1.x), bflo(h1.y), bfhi(h1.y), bflo(h1.z), bfhi(h1.z), bflo(h1.w), bfhi(h1.w)};
            float ss = 0.f;
#pragma unroll
            for (int e = 0; e < 16; ++e) ss += a[e] * a[e] + c[e] * c[e];
            ss += __shfl_xor(ss, 1); ss += __shfl_xor(ss, 2);
            float rq; { const f32x4 s0 = *(const f32x4*)(rsb + (size_t)r * 32), s1 = *(const f32x4*)(rsb + (size_t)r * 32 + 4); rq = ((s0[0] + s0[1]) + (s0[2] + s0[3])) + ((s1[0] + s1[1]) + (s1[2] + s1[3])); }
            rq += __shfl_xor(rq, 1); rq += __shfl_xor(rq, 2);
            const float rr = rsqrtf(rq * (1.0f / 2048.0f) + 1e-6f);
            if (hh == 0 && dg == 0) WSP(float, WS_RSTD)[b * SEQ + hb * 128 + r] = rr;
            const float rstd = rr * rsqrtf(ss * rr * rr * (1.f / 128.f) + 1e-6f);
            const f32x2* tb = trope + pos * 64 + 16 * dg;
#pragma unroll
            for (int e = 0; e < 16; ++e) { const float x1 = a[e] * rstd * wl[e], x2 = c[e] * rstd * wh[e]; const f32x2 cs = tb[e]; a[e] = x1 * cs.x - x2 * cs.y; c[e] = x1 * cs.y + x2 * cs.x; s1[e] += a[e]; s2[e] += c[e]; }
            *(v4u*)(zr) = (v4u){pk2(a[0], a[1]), pk2(a[2], a[3]), pk2(a[4], a[5]), pk2(a[6], a[7])}; *(v4u*)(zr + 8) = (v4u){pk2(a[8], a[9]), pk2(a[10], a[11]), pk2(a[12], a[13]), pk2(a[14], a[15])};
            *(v4u*)(zr + 64) = (v4u){pk2(c[0], c[1]), pk2(c[2], c[3]), pk2(c[4], c[5]), pk2(c[6], c[7])}; *(v4u*)(zr + 72) = (v4u){pk2(c[8], c[9]), pk2(c[10], c[11]), pk2(c[12], c[13]), pk2(c[14], c[15])};
        }
        if (kind) {
            float* km = WSP(float, WS_KMEAN) + (size_t)((b * NH + hh) * 16 + hb) * 128 + 16 * dg;
#pragma unroll
            for (int e = 0; e < 16; ++e) { float x = s1[e], y = s2[e];
                x += __shfl_xor(x, 4); x += __shfl_xor(x, 8); x += __shfl_xor(x, 16); x += __shfl_xor(x, 32);
                y += __shfl_xor(y, 4); y += __shfl_xor(y, 8); y += __shfl_xor(y, 16); y += __shfl_xor(y, 32);
                if (rsub == 0) { km[e] = x * (1.f / 256.f); km[64 + e] = y * (1.f / 256.f); } }
        }
    }
    for (int it = NGW - 1 - gw; it < M / 16; it += NGW) {
        const int i16 = lane & 15, g = lane >> 4; const bf16* ar = WSP(bf16, WS_XB) + (size_t)(16 * it + i16) * DM + 8 * g; const bf16* br = w16g + (size_t)i16 * DM + 8 * g;
        typedef short bf16x8_t __attribute__((ext_vector_type(8)));
        f32x4 acc = (f32x4){0.f, 0.f, 0.f, 0.f};
#pragma unroll 1
        for (int s0 = 0; s0 < DM / 32; s0 += 16) { bf16x8_t av[16], bv[16];
#pragma unroll
            for (int s = 0; s < 16; ++s) { av[s] = *(const bf16x8_t*)(ar + 32 * (s0 + s)); bv[s] = *(const bf16x8_t*)(br + 32 * (s0 + s)); }
#pragma unroll
            for (int s = 0; s < 16; ++s) acc = __builtin_amdgcn_mfma_f32_16x16x32_bf16(av[s], bv[s], acc, 0, 0, 0); }
#pragma unroll
        for (int r = 0; r < 4; ++r) { const int row = 16 * it + 4 * g + r; float ssq = 0.f;
#pragma unroll
            for (int q = 0; q < 8; ++q) { const f32x4 a = *(const f32x4*)(rs + (size_t)row * 32 + 4 * q); ssq += (a[0] + a[1]) + (a[2] + a[3]); }
            const float sr = rsqrtf(ssq * (1.0f / 2048.0f) + 1e-6f);
            const float pre = acc[r] * sr + (i16 < 8 ? big[i16 & 7] : bfg[i16 & 7]); const float sc = 15.0f * tanhf(pre * (1.0f / 15.0f));
            float o = sc; if (i16 >= 8) o = sc > 0.f ? -log1pf(__expf(-sc)) : sc - log1pf(__expf(sc));
            WSP(float, WS_GIF)[(size_t)row * 16 + i16] = o; }
    }
}
__device__ __forceinline__ void glu_fix_phase(Frame& F, const float* cw, const float* cb) {
    const bf16* SB = WSP(bf16, WS_SB); bf16* ACT = WSP(bf16, WS_ACT);
    for (int gI = F.bx; gI < M / 128; gI += F.G) {
        const bool first = ((gI * 128) & (SEQ - 1)) == 0; const bf16* sb = SB + (size_t)gI * 4 * NUP;
        for (int it = F.tid; it < 2 * (DFF / 8); it += NWAVES * 64) {
            const int i = it / (DFF / 8), c8 = (it % (DFF / 8)) * 8;
            float r[2][8];
#pragma unroll
            for (int hf = 0; hf < 2; ++hf) { const int col = hf * DFF + c8;
                const f32x4 b0 = *(const f32x4*)(cb + col), b1 = *(const f32x4*)(cb + col + 4);
                float a[8] = {b0.x, b0.y, b0.z, b0.w, b1.x, b1.y, b1.z, b1.w};
#pragma unroll
                for (int j = 0; j < 3; ++j) { const int slot = i + j;
                    if (slot >= 2 || !first) { const v4u uw = *(const v4u*)(sb + (size_t)slot * NUP + col); const f32x4 w0 = *(const f32x4*)(cw + (size_t)j * NUP + col), w1 = *(const f32x4*)(cw + (size_t)j * NUP + col + 4);
                        a[0] += bflo(uw.x) * w0.x; a[1] += bfhi(uw.x) * w0.y; a[2] += bflo(uw.y) * w0.z; a[3] += bfhi(uw.y) * w0.w; a[4] += bflo(uw.z) * w1.x; a[5] += bfhi(uw.z) * w1.y; a[6] += bflo(uw.w) * w1.z; a[7] += bfhi(uw.w) * w1.w; } }
#pragma unroll
                for (int e = 0; e < 8; ++e) r[hf][e] = a[e]; }
            float o[8];
#pragma unroll
            for (int e = 0; e < 8; ++e) o[e] = r[0][e] * __builtin_amdgcn_rcpf(1.0f + __expf(-r[0][e])) * r[1][e];
            *(v4u*)(ACT + (size_t)(gI * 128 + i) * DFF + c8) = (v4u){pk2(o[0], o[1]), pk2(o[2], o[3]), pk2(o[4], o[5]), pk2(o[6], o[7])};
        }
    }
}
namespace mx {
typedef short bf16x8 __attribute__((ext_vector_type(8)));
typedef short s16x4 __attribute__((ext_vector_type(4)));
#define MFMA16(a, b, c) __builtin_amdgcn_mfma_f32_16x16x32_bf16((a), (b), (c), 0, 0, 0)
#define LDS_FENCE() asm volatile("s_waitcnt lgkmcnt(0)" ::: "memory")
#define SCHED_FENCE() __builtin_amdgcn_sched_barrier(0)
__device__ __forceinline__ bf16x8 frag_row(const LAS bf16* X, int ld, int r0, int c0, int lane) {
    return *(const LAS bf16x8*)(X + (r0 + (lane & 15)) * ld + c0 + 8 * (lane >> 4)); }
__device__ __forceinline__ bf16x8 frag_tr(const LAS bf16* X, int ld, int k0, int c0, int lane) {
    const int g = lane >> 4, q = (lane & 15) >> 2, p = lane & 3;
    const LAS bf16* a = X + (k0 + 8 * g + q) * ld + c0 + 4 * p;
    const s16x4 lo = __builtin_amdgcn_ds_read_tr16_b64_v4i16((LAS s16x4*)a);
    const s16x4 hi = __builtin_amdgcn_ds_read_tr16_b64_v4i16((LAS s16x4*)(a + 4 * ld));
    return __builtin_shufflevector(lo, hi, 0, 1, 2, 3, 4, 5, 6, 7);
}
__device__ __forceinline__ int trs_off(int row, int chunk) { return row * 128 + ((chunk ^ (((row & 3) << 1) | (((row >> 3) & 1) << 3))) << 3); }
__device__ __forceinline__ bf16x8 frag_trs(const LAS bf16* X, int k0, int c0, int lane) {
    const int g = lane >> 4, q = (lane & 15) >> 2, p = lane & 3;
    const LAS bf16* a = X + trs_off(k0 + 8 * g + q, (c0 >> 3) + (p >> 1)) + 4 * (p & 1);
    const s16x4 lo = __builtin_amdgcn_ds_read_tr16_b64_v4i16((LAS s16x4*)a);
    const s16x4 hi = __builtin_amdgcn_ds_read_tr16_b64_v4i16((LAS s16x4*)(a + 4 * 128));
    return __builtin_shufflevector(lo, hi, 0, 1, 2, 3, 4, 5, 6, 7);
}
template <int CTRL> __device__ __forceinline__ float dppf(float v) { return __builtin_bit_cast(float, __builtin_amdgcn_update_dpp(0, __builtin_bit_cast(int, v), CTRL, 0xf, 0xf, true)); }
__device__ __forceinline__ float r16max(float v) { v = fmaxf(v, dppf<0xB1>(v)); v = fmaxf(v, dppf<0x4E>(v)); v = fmaxf(v, dppf<0x141>(v)); v = fmaxf(v, dppf<0x140>(v)); return v; }
__device__ __forceinline__ float r16sum(float v) { v += dppf<0xB1>(v); v += dppf<0x4E>(v); v += dppf<0x141>(v); v += dppf<0x140>(v); return v; }
__device__ __forceinline__ float red16_sum(float v) { return r16sum(v); }
__device__ __forceinline__ float red16_max(float v) { return r16max(v); }
__device__ __forceinline__ void rot8(const v4u lo, const v4u hi, const f32x2* tb, float sc, v4u& olo, v4u& ohi) {
    float a[8] = {bflo(lo.x), bfhi(lo.x), bflo(lo.y), bfhi(lo.y), bflo(lo.z), bfhi(lo.z), bflo(lo.w), bfhi(lo.w)};
    float c[8] = {bflo(hi.x), bfhi(hi.x), bflo(hi.y), bfhi(hi.y), bflo(hi.z), bfhi(hi.z), bflo(hi.w), bfhi(hi.w)};
    float o1[8], o2[8];
#pragma unroll
    for (int e = 0; e < 8; ++e) { const f32x2 cs = tb[e]; o1[e] = (a[e] * cs.x - c[e] * cs.y) * sc; o2[e] = (a[e] * cs.y + c[e] * cs.x) * sc; }
    olo = (v4u){pk2(o1[0], o1[1]), pk2(o1[2], o1[3]), pk2(o1[4], o1[5]), pk2(o1[6], o1[7])};
    ohi = (v4u){pk2(o2[0], o2[1]), pk2(o2[2], o2[3]), pk2(o2[4], o2[5]), pk2(o2[6], o2[7])};
}
constexpr int LQ = 144;
__device__ __forceinline__ void ret_unit(Frame& F, const float* gn, int b, int h) {
    LAS bf16* Qs = (LAS bf16*)(F.lds); LAS bf16* Ks = Qs + 128 * LQ; LAS bf16* Vs = Ks + 128 * LQ; LAS bf16* Ts = Vs + 128 * LQ;
    const int tid = F.tid, lane = F.lane, w = tid >> 6, i16 = lane & 15, g = lane >> 4;
    const float gamma = 1.0f - exp2f(-5.0f - (float)h), lg = log2f(gamma);
    const float gC = exp2f(lg * 128.0f);
    f32x4 accT[8];
#pragma unroll
    for (int n = 0; n < 8; ++n) accT[n] = (f32x4){0.f, 0.f, 0.f, 0.f};
    for (int i = tid; i < 128 * LQ / 8; i += NWAVES * 64) ((LAS v4u*)Ts)[i] = (v4u){0u, 0u, 0u, 0u};
    const bf16* zb = WSP(bf16, WS_Z) + (size_t)(b * SEQ) * NZ + h * 128;
    const f32x2* tret = WSP(f32x2, WS_TAB);
    bf16* yb = WSP(bf16, WS_Y) + (size_t)(b * SEQ) * 1024 + h * 128;
    const int lr = tid >> 2, dg = tid & 3;
    v4u pq[4], pk[4], pv[4]; float prr;
    const float* rstd1 = WSP(float, WS_RSTD) + (size_t)(b * SEQ);
#define RET_FETCH(t0_) do { const bf16* zr_ = zb + (size_t)((t0_) + lr) * NZ; \
        pq[0] = *(const v4u*)(zr_ + Z_RQ + 16 * dg); pq[1] = *(const v4u*)(zr_ + Z_RQ + 64 + 16 * dg); pq[2] = *(const v4u*)(zr_ + Z_RQ + 16 * dg + 8); pq[3] = *(const v4u*)(zr_ + Z_RQ + 64 + 16 * dg + 8); \
        pk[0] = *(const v4u*)(zr_ + Z_RK + 16 * dg); pk[1] = *(const v4u*)(zr_ + Z_RK + 64 + 16 * dg); pk[2] = *(const v4u*)(zr_ + Z_RK + 16 * dg + 8); pk[3] = *(const v4u*)(zr_ + Z_RK + 64 + 16 * dg + 8); \
        _Pragma("unroll") for (int q_ = 0; q_ < 4; ++q_) pv[q_] = *(const v4u*)(zr_ + Z_RV + 32 * dg + 8 * q_); prr = rstd1[(t0_) + lr]; } while (0)
    RET_FETCH(0);
    const float sq = exp2f(lg * (float)lr), sk = exp2f(-lg * (float)lr) * 0.08838834764831845f;
    float gnv[8];
#pragma unroll
    for (int n = 0; n < 8; ++n) gnv[n] = gn[h * 128 + 16 * n + i16];
    for (int c = 0; c < SEQ / 128; ++c) {
        const int t0 = c * 128;
        {
            const f32x2* tb = tret + (t0 + lr) * 64 + 16 * dg;
#pragma unroll
            for (int hh = 0; hh < 2; ++hh) {
                v4u o1, o2; rot8(pq[2 * hh], pq[2 * hh + 1], tb + 8 * hh, sq * prr, o1, o2);
                *(LAS v4u*)(Qs + lr * LQ + 16 * dg + 8 * hh) = o1; *(LAS v4u*)(Qs + lr * LQ + 64 + 16 * dg + 8 * hh) = o2;
                rot8(pk[2 * hh], pk[2 * hh + 1], tb + 8 * hh, sk * prr * prr, o1, o2);
                *(LAS v4u*)(Ks + lr * LQ + 16 * dg + 8 * hh) = o1; *(LAS v4u*)(Ks + lr * LQ + 64 + 16 * dg + 8 * hh) = o2;
            }
#pragma unroll
            for (int q = 0; q < 4; ++q) *(LAS v4u*)(Vs + lr * LQ + 32 * dg + 8 * q) = pv[q];
            if (c + 1 < SEQ / 128) RET_FETCH(t0 + 128);
        }
        __syncthreads();
        bf16x8 aq[4];
#pragma unroll
        for (int s = 0; s < 4; ++s) aq[s] = frag_row(Qs, LQ, 16 * w, 32 * s, lane);
        f32x4 acco[8];
#pragma unroll
        for (int n = 0; n < 8; ++n) acco[n] = (f32x4){0.f, 0.f, 0.f, 0.f};
#pragma unroll
        for (int s = 0; s < 4; ++s) { bf16x8 bb[8];
#pragma unroll
            for (int n = 0; n < 8; ++n) bb[n] = frag_tr(Ts, LQ, 32 * s, 16 * n, lane);
            SCHED_FENCE();
#pragma unroll
            for (int n = 0; n < 8; ++n) acco[n] = MFMA16(aq[s], bb[n], acco[n]); }
        LDS_FENCE();
#pragma unroll
        for (int n = 0; n < 8; ++n) {
            if (n <= w) { f32x4 sa = (f32x4){0.f, 0.f, 0.f, 0.f}; bf16x8 bb[4];
#pragma unroll
                for (int s = 0; s < 4; ++s) bb[s] = frag_row(Ks, LQ, 16 * n, 32 * s, lane);
                SCHED_FENCE();
#pragma unroll
                for (int s = 0; s < 4; ++s) sa = MFMA16(aq[s], bb[s], sa);
#pragma unroll
                for (int r = 0; r < 4; ++r) { const int i = 16 * w + 4 * g + r, j = 16 * n + i16; Qs[i * LQ + j] = (bf16)f2bf(j <= i ? sa[r] : 0.f); } }
            else if (n == w + 1) {
#pragma unroll
                for (int r = 0; r < 4; ++r) Qs[(16 * w + 4 * g + r) * LQ + 16 * n + i16] = (bf16)0; }
        }
        LDS_FENCE();
#pragma unroll
        for (int n = 0; n < 8; ++n) accT[n] = accT[n] * gC;
#pragma unroll
        for (int s = 0; s < 4; ++s) { const bf16x8 ak = frag_tr(Ks, LQ, 32 * s, 16 * w, lane); const bool doi = (s <= (w >> 1)); bf16x8 as = ak; bf16x8 bb[8];
            if (doi) as = frag_row(Qs, LQ, 16 * w, 32 * s, lane);
#pragma unroll
            for (int n = 0; n < 8; ++n) bb[n] = frag_tr(Vs, LQ, 32 * s, 16 * n, lane);
            SCHED_FENCE();
            if (doi) {
#pragma unroll
                for (int n = 0; n < 8; ++n) acco[n] = MFMA16(as, bb[n], acco[n]); }
#pragma unroll
            for (int n = 0; n < 8; ++n) accT[n] = MFMA16(ak, bb[n], accT[n]); }
        bf16 gvr[4][8]; float rrv[4];
#pragma unroll
        for (int r = 0; r < 4; ++r) { const int pos = t0 + 16 * w + 4 * g + r; const bf16* gr = zb + (size_t)pos * NZ + Z_RG + i16; rrv[r] = rstd1[pos];
#pragma unroll
            for (int n = 0; n < 8; ++n) gvr[r][n] = gr[16 * n]; }
        LDS_FENCE();
        __syncthreads();
#pragma unroll
        for (int n = 0; n < 8; ++n)
#pragma unroll
            for (int r = 0; r < 4; ++r) Ts[(16 * w + 4 * g + r) * LQ + 16 * n + i16] = (bf16)f2bf(gC * accT[n][r]);
#pragma unroll
        for (int r = 0; r < 4; ++r) {
            float s = 0.f;
#pragma unroll
            for (int n = 0; n < 8; ++n) s += acco[n][r];
            const float mean = red16_sum(s) * (1.f / 128.f); float q = 0.f;
#pragma unroll
            for (int n = 0; n < 8; ++n) { const float d = acco[n][r] - mean; q += d * d; }
            const float rstd = rsqrtf(red16_sum(q) * (1.f / 128.f) + 1e-5f);
            const int pos = t0 + 16 * w + 4 * g + r; bf16* yr = yb + (size_t)pos * 1024; const float rri = rrv[r];
#pragma unroll
            for (int n = 0; n < 8; ++n) { const int e = 16 * n + i16; const float gv = bf1(gvr[r][n]) * rri; yr[e] = (bf16)f2bf((acco[n][r] - mean) * rstd * gnv[n] * gv * sigm(gv)); }
        }
    }
    __syncthreads();
#undef RET_FETCH
}
constexpr int LK = 72, LV = 168;
__device__ __forceinline__ float scan64_sum(float x, int lane) {
#pragma unroll
    for (int o = 1; o < 64; o <<= 1) { const float y = __shfl_up(x, o); if (lane >= o) x += y; }
    return x; }
__device__ __forceinline__ float scan64_max(float x, int lane) {
#pragma unroll
    for (int o = 1; o < 64; o <<= 1) { const float y = __shfl_up(x, o); if (lane >= o) x = fmaxf(x, y); }
    return x; }
__device__ __forceinline__ void mlstm_unit(Frame& F, const float* nw, int b, int h) {
    LAS bf16* Qm = (LAS bf16*)(F.lds); LAS bf16* Km = Qm + 128 * LK; LAS bf16* Kw = Km + 128 * LK; LAS bf16* Vm = Kw + 128 * LK; LAS bf16* Pm = Vm + 128 * LV; LAS bf16* Cm = Pm + 128 * LQ;
    const int tid = F.tid, lane = F.lane, w = F.wave, i16 = lane & 15, g = lane >> 4;
    const int dt = w & 3, eh = w >> 2;
    f32x4 accC[5];
#pragma unroll
    for (int k = 0; k < 5; ++k) accC[k] = (f32x4){0.f, 0.f, 0.f, 0.f};
    for (int i = tid; i < 64 * LV / 8; i += NWAVES * 64) ((LAS v4u*)Cm)[i] = (v4u){0u, 0u, 0u, 0u};
    float m_prev = 0.f;
    const bf16* zb = WSP(bf16, WS_Z) + (size_t)(b * SEQ) * NZ;
    const float* gif = WSP(float, WS_GIF) + (size_t)(b * SEQ) * 16;
    bf16* yb = WSP(bf16, WS_Y) + (size_t)M * 1024 + (size_t)(b * SEQ) * 1024 + h * 128;
    const int lr = tid >> 2, dg = tid & 3;
    v4u pq[2], pk[2]; float fl0, fl1, il0, il1, prr;
    const float* rstd1 = WSP(float, WS_RSTD) + (size_t)(b * SEQ);
#define ML_FETCH(t0_) do { const bf16* zr_ = zb + (size_t)((t0_) + lr) * NZ; \
        pq[0] = *(const v4u*)(zr_ + Z_MQ + h * 64 + 16 * dg); pq[1] = *(const v4u*)(zr_ + Z_MQ + h * 64 + 16 * dg + 8); pk[0] = *(const v4u*)(zr_ + Z_MK + h * 64 + 16 * dg); pk[1] = *(const v4u*)(zr_ + Z_MK + h * 64 + 16 * dg + 8); \
        fl0 = gif[(size_t)((t0_) + lane) * 16 + 8 + h]; fl1 = gif[(size_t)((t0_) + 64 + lane) * 16 + 8 + h]; il0 = gif[(size_t)((t0_) + lane) * 16 + h]; il1 = gif[(size_t)((t0_) + 64 + lane) * 16 + h]; prr = rstd1[(t0_) + lr]; } while (0)
    ML_FETCH(0);
    float nwv[8];
#pragma unroll
    for (int n = 0; n < 8; ++n) nwv[n] = nw[h * 128 + 16 * n + i16];
    for (int c = 0; c < SEQ / 128; ++c) {
        const int t0 = c * 128;
        const float a0 = scan64_sum(fl0, lane); const float a1 = scan64_sum(fl1, lane) + __shfl(a0, 63);
        const float b0 = il0 - a0, b1 = il1 - a1;
        const float pm0 = scan64_max(b0, lane); const float pm1 = fmaxf(scan64_max(b1, lane), __shfl(pm0, 63));
        const float a_last = __shfl(a1, 63), bmax = __shfl(pm1, 63);
        const float g_n = a_last + bmax, m_new = fmaxf(a_last + m_prev, g_n), s_old = __expf(a_last + m_prev - m_new), s_new = __expf(g_n - m_new);
        {
            const int r = lr;
            const float br = (r < 64) ? __shfl(b0, r & 63) : __shfl(b1, r & 63);
            const float rk = prr * 0.125f, wk = __expf(br - bmax) * rk * s_new;
#pragma unroll
            for (int hh = 0; hh < 2; ++hh) {
                *(LAS v4u*)(Qm + r * LK + 16 * dg + 8 * hh) = pq[hh];
                const v4u kk = pk[hh];
                float kf[8] = {bflo(kk.x), bfhi(kk.x), bflo(kk.y), bfhi(kk.y), bflo(kk.z), bfhi(kk.z), bflo(kk.w), bfhi(kk.w)};
                *(LAS v4u*)(Km + r * LK + 16 * dg + 8 * hh) = (v4u){pk2(kf[0] * rk, kf[1] * rk), pk2(kf[2] * rk, kf[3] * rk), pk2(kf[4] * rk, kf[5] * rk), pk2(kf[6] * rk, kf[7] * rk)};
                *(LAS v4u*)(Kw + r * LK + 16 * dg + 8 * hh) = (v4u){pk2(kf[0] * wk, kf[1] * wk), pk2(kf[2] * wk, kf[3] * wk), pk2(kf[4] * wk, kf[5] * wk), pk2(kf[6] * wk, kf[7] * wk)};
            }
#pragma unroll
            for (int q = 0; q < 4; ++q) { const v4u x = *(const v4u*)(zb + (size_t)(t0 + r) * NZ + Z_MV + h * 128 + 32 * dg + 8 * q); const float rv = prr;
                *(LAS v4u*)(Vm + r * LV + 32 * dg + 8 * q) = (v4u){pk2(bflo(x.x) * rv, bfhi(x.x) * rv), pk2(bflo(x.y) * rv, bfhi(x.y) * rv), pk2(bflo(x.z) * rv, bfhi(x.z) * rv), pk2(bflo(x.w) * rv, bfhi(x.w) * rv)}; }
            *(LAS v4u*)(Vm + r * LV + 128 + 8 * dg) = (v4u){dg == 0 ? 0x00003f80u : 0u, 0u, 0u, 0u};
            if (c + 1 < SEQ / 128) ML_FETCH(t0 + 128);
        }
        __syncthreads();
        float Mi[4], ai[4], rri[4];
#pragma unroll
        for (int r = 0; r < 4; ++r) { const int i = 16 * w + 4 * g + r; rri[r] = rstd1[t0 + i]; const float pmi = (w < 4) ? __shfl(pm0, i & 63) : __shfl(pm1, i & 63); ai[r] = (w < 4) ? __shfl(a0, i & 63) : __shfl(a1, i & 63); Mi[r] = fmaxf(pmi, m_prev); }
        bf16x8 aq[2];
#pragma unroll
        for (int s = 0; s < 2; ++s) aq[s] = frag_row(Qm, LK, 16 * w, 32 * s, lane);
        f32x4 acco[9];
#pragma unroll
        for (int n = 0; n < 9; ++n) acco[n] = (f32x4){0.f, 0.f, 0.f, 0.f};
#pragma unroll
        for (int s = 0; s < 2; ++s) {
#pragma unroll
          for (int hf = 0; hf < 2; ++hf) { bf16x8 bb[5];
#pragma unroll
            for (int n = 0; n < 5 - hf; ++n) bb[n] = frag_tr(Cm, LV, 32 * s, 16 * (5 * hf + n), lane);
            SCHED_FENCE();
#pragma unroll
            for (int n = 0; n < 5 - hf; ++n) acco[5 * hf + n] = MFMA16(aq[s], bb[n], acco[5 * hf + n]); } }
        { float si[4];
#pragma unroll
          for (int r = 0; r < 4; ++r) si[r] = __expf(m_prev - Mi[r]) * rri[r];
#pragma unroll
          for (int n = 0; n < 9; ++n)
#pragma unroll
            for (int r = 0; r < 4; ++r) acco[n][r] *= si[r]; }
        LDS_FENCE();
#pragma unroll
        for (int n = 0; n < 8; ++n) {
            if (n <= w) { f32x4 sa = (f32x4){0.f, 0.f, 0.f, 0.f}; bf16x8 bb[2];
#pragma unroll
                for (int s = 0; s < 2; ++s) bb[s] = frag_row(Km, LK, 16 * n, 32 * s, lane);
                SCHED_FENCE();
#pragma unroll
                for (int s = 0; s < 2; ++s) sa = MFMA16(aq[s], bb[s], sa);
                const int j = 16 * n + i16; const float bj = (n < 4) ? __shfl(b0, j & 63) : __shfl(b1, j & 63);
#pragma unroll
                for (int r = 0; r < 4; ++r) { const int i = 16 * w + 4 * g + r; Pm[i * LQ + j] = (bf16)f2bf(j <= i ? sa[r] * rri[r] * __expf(bj - Mi[r]) : 0.f); } }
            else if (n == w + 1) {
#pragma unroll
                for (int r = 0; r < 4; ++r) Pm[(16 * w + 4 * g + r) * LQ + 16 * n + i16] = (bf16)0; }
        }
        LDS_FENCE();
#pragma unroll
        for (int k = 0; k < 5; ++k) accC[k] = accC[k] * s_old;
#pragma unroll
        for (int s = 0; s < 4; ++s) { const bf16x8 ak = frag_tr(Kw, LK, 32 * s, 16 * dt, lane); const bool doi = (s <= (w >> 1)); bf16x8 ap = ak;
            if (doi) ap = frag_row(Pm, LQ, 16 * w, 32 * s, lane);
#pragma unroll
          for (int hf = 0; hf < 2; ++hf) { const bool dos = (hf == eh);
            if (doi || dos) { bf16x8 bb[5];
#pragma unroll
              for (int n = 0; n < 5; ++n) bb[n] = frag_tr(Vm, LV, 32 * s, 16 * (5 * hf + n), lane);
              SCHED_FENCE();
              if (doi) {
#pragma unroll
                for (int n = 0; n < 5 - hf; ++n) acco[5 * hf + n] = MFMA16(ap, bb[n], acco[5 * hf + n]); }
              if (dos) {
#pragma unroll
                for (int k = 0; k < 5; ++k) accC[k] = MFMA16(ak, bb[k], accC[k]); } } } }
        bf16 gvr[4][8];
#pragma unroll
        for (int r = 0; r < 4; ++r) { const bf16* gr = zb + (size_t)(t0 + 16 * w + 4 * g + r) * NZ + Z_MO + h * 128 + i16;
#pragma unroll
            for (int n = 0; n < 8; ++n) gvr[r][n] = gr[16 * n]; }
        LDS_FENCE();
        __syncthreads();
#pragma unroll
        for (int k = 0; k < 5; ++k)
#pragma unroll
            for (int r = 0; r < 4; ++r) Cm[(16 * dt + 4 * g + r) * LV + 16 * (5 * eh + k) + i16] = (bf16)f2bf(accC[k][r]);
#pragma unroll
        for (int r = 0; r < 4; ++r) {
            const float den = __shfl(acco[8][r], lane & 48);
            const float dd = 1.0f / fmaxf(fabsf(den), __expf(-(ai[r] + Mi[r])));
            float q = 0.f;
#pragma unroll
            for (int n = 0; n < 8; ++n) { acco[n][r] *= dd; q += acco[n][r] * acco[n][r]; }
            const float rstd = rsqrtf(red16_sum(q) * (1.f / 128.f) + 1e-6f);
            const int pos = t0 + 16 * w + 4 * g + r; bf16* yr = yb + (size_t)pos * 1024;
#pragma unroll
            for (int n = 0; n < 8; ++n) { const int e = 16 * n + i16; yr[e] = (bf16)f2bf(acco[n][r] * rstd * nwv[n] * sigm(bf1(gvr[r][n]) * rri[r])); }
        }
        m_prev = m_new;
    }
    __syncthreads();
#undef ML_FETCH
}
__device__ __forceinline__ int vt_off(int row, int chunk) { return row * 128 + ((chunk ^ ((row & 7) << 1)) << 3); }
__device__ __forceinline__ bf16x8 frag_trp(const LAS bf16* X, int k0, int c0, int lane) {
    const int g = lane >> 4, q = (lane & 15) >> 2, p = lane & 3;
    const LAS bf16* a = X + vt_off(k0 + 4 * g + q, (c0 >> 3) + (p >> 1)) + 4 * (p & 1);
    const s16x4 lo = __builtin_amdgcn_ds_read_tr16_b64_v4i16((LAS s16x4*)a);
    const s16x4 hi = __builtin_amdgcn_ds_read_tr16_b64_v4i16((LAS s16x4*)(a + 16 * 128));
    return __builtin_shufflevector(lo, hi, 0, 1, 2, 3, 4, 5, 6, 7);
}
__device__ __forceinline__ void moba_unit(Frame& F, const float* qn, int b, int h, int qi) {
    constexpr int KT_E = 128 * LQ, VT_E = 128 * 128;
    LAS bf16* Kt0 = (LAS bf16*)(F.lds); LAS bf16* Vt0 = Kt0 + 2 * KT_E; LAS float* RR = (LAS float*)(Vt0 + 2 * VT_E);
    const int tid = F.tid, lane = F.lane, w = tid >> 6, i16 = lane & 15, g = lane >> 4;
    const int blk = qi >> 1, qt = qi & 1, q0 = qi * 128;
    const bf16* zb = WSP(bf16, WS_Z) + (size_t)(b * SEQ) * NZ + h * 128;
    bf16x8 aq[4];
    { const bf16* qr = zb + (size_t)(q0 + 16 * w + i16) * NZ + Z_AQ + 8 * g;
#pragma unroll
      for (int s = 0; s < 4; ++s) aq[s] = *(const bf16x8*)(qr + 32 * s); }
    const int lr = tid >> 2, dg = tid & 3;
    v4u pk[4], pv[4]; float prr;
    const float* rstdb = WSP(float, WS_RSTD) + (size_t)(b * SEQ);
#define MB_FETCH(k0_) do { const bf16* zr_ = zb + (size_t)((k0_) + lr) * NZ + 32 * dg; \
        _Pragma("unroll") for (int q_ = 0; q_ < 4; ++q_) { pk[q_] = *(const v4u*)(zr_ + Z_AK + 8 * q_); pv[q_] = *(const v4u*)(zr_ + Z_AV + 8 * q_); } prr = rstdb[(k0_) + lr]; } while (0)
#define MB_STAGE(buf_) do { LAS bf16* kd_ = Kt0 + (buf_) * KT_E + lr * LQ + 32 * dg; LAS bf16* vd_ = Vt0 + (buf_) * VT_E; \
        _Pragma("unroll") for (int q_ = 0; q_ < 4; ++q_) { *(LAS v4u*)(kd_ + 8 * q_) = pk[q_]; *(LAS v4u*)(vd_ + vt_off(lr, 4 * dg + q_)) = pv[q_]; } if (dg == 0) RR[(buf_) * 128 + lr] = prr; } while (0)
    MB_FETCH(0);
    { float ss = 0.f; float qf[4][8];
#pragma unroll
      for (int s = 0; s < 4; ++s) { const v4u x = __builtin_bit_cast(v4u, aq[s]); qf[s][0] = bflo(x.x); qf[s][1] = bfhi(x.x); qf[s][2] = bflo(x.y); qf[s][3] = bfhi(x.y); qf[s][4] = bflo(x.z); qf[s][5] = bfhi(x.z); qf[s][6] = bflo(x.w); qf[s][7] = bfhi(x.w);
#pragma unroll
          for (int j = 0; j < 8; ++j) ss += qf[s][j] * qf[s][j]; }
      ss += __shfl_xor(ss, 16); ss += __shfl_xor(ss, 32);
      const int pos = q0 + 16 * w + i16; const float rr = rstdb[pos]; const float f = rr * rsqrtf(ss * rr * rr * (1.f / 128.f) + 1e-6f);
      const f32x2* tb = WSP(f32x2, WS_TAB) + SEQ * 64 + pos * 64 + 8 * g;
#pragma unroll
      for (int s = 0; s < 2; ++s) {
#pragma unroll
          for (int j = 0; j < 8; ++j) { const float x1 = qf[s][j] * f * qn[32 * s + 8 * g + j], x2 = qf[s + 2][j] * f * qn[64 + 32 * s + 8 * g + j]; const f32x2 cs = tb[32 * s + j];
              qf[s][j] = x1 * cs.x - x2 * cs.y; qf[s + 2][j] = x1 * cs.y + x2 * cs.x; } }
#pragma unroll
      for (int s = 0; s < 4; ++s) { const v4u o = (v4u){pk2(qf[s][0], qf[s][1]), pk2(qf[s][2], qf[s][3]), pk2(qf[s][4], qf[s][5]), pk2(qf[s][6], qf[s][7])}; aq[s] = __builtin_bit_cast(bf16x8, o); } }
    unsigned sel = 0u;
    {
        f32x4 gacc = (f32x4){0.f, 0.f, 0.f, 0.f};
        const float* km = WSP(float, WS_KMEAN) + (size_t)((b * NH + h) * 16) * 128 + (size_t)(i16 & 7) * 256 + 8 * g;
        const bool live = i16 < blk;
#pragma unroll
        for (int s = 0; s < 4; ++s) { f32x4 k0 = (f32x4){0.f, 0.f, 0.f, 0.f}, k1 = k0;
            if (live) { k0 = *(const f32x4*)(km + 32 * s) + *(const f32x4*)(km + 128 + 32 * s); k1 = *(const f32x4*)(km + 32 * s + 4) + *(const f32x4*)(km + 128 + 32 * s + 4); }
            const v4u hi = (v4u){pk2(k0.x, k0.y), pk2(k0.z, k0.w), pk2(k1.x, k1.y), pk2(k1.z, k1.w)};
            const v4u lo = (v4u){pk2(k0.x - bflo(hi.x), k0.y - bfhi(hi.x)), pk2(k0.z - bflo(hi.y), k0.w - bfhi(hi.y)), pk2(k1.x - bflo(hi.z), k1.y - bfhi(hi.z)), pk2(k1.z - bflo(hi.w), k1.w - bfhi(hi.w))};
            gacc = MFMA16(__builtin_bit_cast(bf16x8, hi), aq[s], gacc); gacc = MFMA16(__builtin_bit_cast(bf16x8, lo), aq[s], gacc); }
        float gate[8];
#pragma unroll
        for (int n = 0; n < 8; ++n) { const float gv = __shfl(gacc[n & 3], i16 + 16 * (n >> 2)); gate[n] = (n < blk) ? gv : -INFINITY; }
#pragma unroll
        for (int s = 0; s < 3; ++s) { float bv = -INFINITY; int best = -1;
#pragma unroll
            for (int n = 0; n < 8; ++n) { const bool c = !((sel >> n) & 1u) && gate[n] > bv; bv = c ? gate[n] : bv; best = c ? n : best; }
            if (best >= 0) sel |= 1u << best; }
    }
#pragma unroll
    for (int s = 0; s < 4; ++s) { const v4u u = __builtin_bit_cast(v4u, aq[s]); const float c2 = 0.08838834764831845f * 1.4426950408889634f;
        const v4u o = (v4u){pk2(bflo(u.x) * c2, bfhi(u.x) * c2), pk2(bflo(u.y) * c2, bfhi(u.y) * c2), pk2(bflo(u.z) * c2, bfhi(u.z) * c2), pk2(bflo(u.w) * c2, bfhi(u.w) * c2)}; aq[s] = __builtin_bit_cast(bf16x8, o); }
    f32x4 acco[8];
#pragma unroll
    for (int n = 0; n < 8; ++n) acco[n] = (f32x4){0.f, 0.f, 0.f, 0.f};
    float mq = -1e30f, lq = 0.f;
    const int ntiles = 2 * blk + qt + 1;
    const int qrel = 16 * w + i16 - 4 * g;
    __syncthreads();
    MB_STAGE(0);
    if (ntiles > 1) MB_FETCH(128);
    __syncthreads();
    for (int kt = 0; kt < ntiles; ++kt) {
        const int kb = kt >> 1; const bool own = (kb == blk), diag = (kt == 2 * blk + qt);
        const LAS bf16* Kt = Kt0 + (kt & 1) * KT_E; const LAS bf16* Vt = Vt0 + (kt & 1) * VT_E;
        f32x4 sc[8];
#pragma unroll
        for (int n = 0; n < 8; ++n) sc[n] = (f32x4){0.f, 0.f, 0.f, 0.f};
#pragma unroll
        for (int s = 0; s < 4; ++s) { bf16x8 bb[8];
#pragma unroll
            for (int n = 0; n < 8; ++n) bb[n] = frag_row(Kt, LQ, 16 * n, 32 * s, lane);
            SCHED_FENCE();
#pragma unroll
            for (int n = 0; n < 8; ++n) sc[n] = MFMA16(bb[n], aq[s], sc[n]); }
        if (diag) {
#pragma unroll
            for (int n = 0; n < 8; ++n)
#pragma unroll
                for (int r = 0; r < 4; ++r) sc[n][r] = (16 * n + r <= qrel) ? sc[n][r] : -1e30f; }
        const bool rowok = own || ((sel >> kb) & 1u);
        float mx = -1e30f;
#pragma unroll
        for (int n = 0; n < 8; ++n) mx = fmaxf(mx, fmaxf(fmaxf(sc[n][0], sc[n][1]), fmaxf(sc[n][2], sc[n][3])));
        mx = fmaxf(mx, __shfl_xor(mx, 16)); mx = fmaxf(mx, __shfl_xor(mx, 32));
        const float mnew = rowok ? fmaxf(mq, mx) : mq;
        const float alpha = __builtin_amdgcn_exp2f(mq - mnew); mq = mnew;
        const float msub = rowok ? mnew : 1e30f;
        float ps = 0.f;
#pragma unroll
        for (int n = 0; n < 8; ++n)
#pragma unroll
            for (int r = 0; r < 4; ++r) { sc[n][r] = __builtin_amdgcn_exp2f(sc[n][r] - msub); ps += sc[n][r]; }
        lq = lq * alpha + ps;
        { const LAS float* rrt = RR + (kt & 1) * 128 + 4 * g;
#pragma unroll
          for (int n = 0; n < 8; ++n) sc[n] = sc[n] * *(const LAS f32x4*)(rrt + 16 * n); }
        if (!__all(alpha == 1.0f)) {
#pragma unroll
            for (int n = 0; n < 8; ++n) acco[n] = acco[n] * alpha; }
#pragma unroll
        for (int t = 0; t < 4; ++t) {
            const v4u pw = (v4u){pk2(sc[2 * t][0], sc[2 * t][1]), pk2(sc[2 * t][2], sc[2 * t][3]), pk2(sc[2 * t + 1][0], sc[2 * t + 1][1]), pk2(sc[2 * t + 1][2], sc[2 * t + 1][3])};
            const bf16x8 pf = __builtin_bit_cast(bf16x8, pw); bf16x8 bb[8];
#pragma unroll
            for (int n = 0; n < 8; ++n) bb[n] = frag_trp(Vt, 32 * t, 16 * n, lane);
            SCHED_FENCE();
#pragma unroll
            for (int n = 0; n < 8; ++n) acco[n] = MFMA16(bb[n], pf, acco[n]); }
        if (kt + 1 < ntiles) { MB_STAGE((kt + 1) & 1); if (kt + 2 < ntiles) MB_FETCH((kt + 2) * 128); }
        __syncthreads();
    }
    lq += __shfl_xor(lq, 16); lq += __shfl_xor(lq, 32);
    const float inv = 1.0f / lq;
    bf16* yr = WSP(bf16, WS_Y) + (size_t)2 * M * 1024 + (size_t)(b * SEQ + q0 + 16 * w + i16) * 1024 + h * 128 + 4 * g;
#pragma unroll
    for (int n = 0; n < 8; ++n) *(v2u*)(yr + 16 * n) = (v2u){pk2(acco[n][0] * inv, acco[n][1] * inv), pk2(acco[n][2] * inv, acco[n][3] * inv)};
#undef MB_FETCH
#undef MB_STAGE
}
__device__ __forceinline__ void mix_phase(Frame& F, const float* rgn, const float* mln, const float* qn, unsigned* head) {
    volatile LAS unsigned* slot = F.MISC;
    for (;;) {
        if (F.tid == 0) slot[0] = __hip_atomic_fetch_add(head, 1u, __ATOMIC_RELAXED, __HIP_MEMORY_SCOPE_AGENT);
        __syncthreads();
        const unsigned it = slot[0];
        __syncthreads();
        if (it >= 128u + 1024u) break;
        { int t_ = threadIdx.x; asm volatile("" : "+v"(t_)); F.tid = t_; F.lane = t_ & 63; }
        if (it < 64u) ret_unit(F, rgn, (int)(it >> 3), (int)(it & 7u));
        else if (it < 128u) mlstm_unit(F, mln, (int)((it - 64u) >> 3), (int)(it & 7u));
        else { const unsigned rank = it - 128u; moba_unit(F, qn, (int)((rank & 63u) >> 3), (int)(rank & 7u), 15 - (int)(rank >> 6)); }
    }
}
}
constexpr int N_PHASES = 1 + 8 * DEPTH;
__global__ void __launch_bounds__(NWAVES * 64, 2) fwd(Args args) {
    extern __shared__ __attribute__((aligned(16))) unsigned char lds[];
    Frame F;
    F.lds = (LAS unsigned char*)lds;
    F.MISC = (volatile LAS unsigned*)(F.lds + MISC_OFF);
    F.tid = threadIdx.x; F.lane = F.tid & 63; F.wave = __builtin_amdgcn_readfirstlane(F.tid >> 6); F.G = gridDim.x; F.bx = blockIdx.x;
    F.ws = args.ws;
    for (int u = F.tid; u < (LDS_BYTES - LDSCTL_OFF) / 4; u += NWAVES * 64) ((LAS unsigned*)(F.lds + LDSCTL_OFF))[u] = 0u;
    __syncthreads();
    XcdBarrier bar = xcd_barrier_post((unsigned*)(F.ws + WS_CTL) + CW_BAR + args.li * XCD_BAR_WORDS, F.MISC + 8);
    const int lo = args.ph_lo, hi = args.ph_hi;
#define RUN(p) (lo <= (p) && (p) < hi)
#define SEAM(p) do { if ((p) + 1 < hi) xcd_barrier(bar); } while (0)
    if (RUN(0)) { p0_prologue(F, args); SEAM(0); }
    for (int l = 0; l < DEPTH; ++l) {
        const int p0 = 1 + 8 * l;
        { int t_ = threadIdx.x; asm volatile("" : "+v"(t_)); F.tid = t_; F.lane = t_ & 63; F.wave = __builtin_amdgcn_readfirstlane(t_ >> 6); int b_ = blockIdx.x; asm volatile("" : "+s"(b_)); F.bx = b_; }
        float* rs = WSP(float, WS_RS) + (size_t)(2 * l) * M * 32;
        if (RUN(p0 + 0)) {
            { const int kf = (((F.bx >> 3) & 7) >> 2);
#define IN_F8_CALL(I0, NN) { pg8::Gemm g8{WSP(bf16, WS_XB8), (const bf16*)(F.ws + ws_win8(l)), M, N8, DM / 2}; pg8::RangeOrder<pg8::StaticOrder> S8; S8.b.init(M, N8, F.G, F.bx); S8.i0 = (I0); S8.n = (NN); \
                pg8::EpiGate8 E8{F.ws + WS_ZG, 3 * DM, 1.0f / 64.0f, WSP(bf16, WS_Z), NZ, 3 * DM / 256, Z_MO}; \
                pg8::gemm_phase<pg8::EpiGate8, pg8::RangeOrder<pg8::StaticOrder>, false, true, true>(F.lds + RING_OFF, g8, S8, E8); }
              IN_F8_CALL(0, kf)
              { pg8::Gemm g{WSP(bf16, WS_XB), WSP(bf16, WS_WIN) + (size_t)l * NZ * DM, M, Z_GA - 1024, DM}; pg8::SkipOrder S; S.init(M, Z_GA - 1024, F.G, F.bx); S.skip0 = Z_MO / 256; S.nskip = 4;
                pg8::EpiBf16 E{WSP(bf16, WS_Z), NZ, nullptr, -1, 0};
                pg8::gemm_phase<pg8::EpiBf16, pg8::SkipOrder, false, true>(F.lds + RING_OFF, g, S, E); }
              { int kf2 = (((F.bx >> 3) & 7) >> 2); asm volatile("" : "+s"(kf2));
                IN_F8_CALL(kf2, 1 << 20) }
#undef IN_F8_CALL
            }
            SEAM(p0 + 0); }
        if (RUN(p0 + 1)) { prep_phase(F, args.in[I_QN] + l * 128, args.in[I_KN] + l * 128, WSP(bf16, WS_W16G) + (size_t)l * 16 * DM, rs, args.in[I_BIG] + l * 8, args.in[I_BFG] + l * 8); SEAM(p0 + 1); }
        if (RUN(p0 + 2)) { mx::mix_phase(F, args.in[I_RGN] + l * 1024, args.in[I_MLN] + l * 1024, args.in[I_QN] + l * 128, (unsigned*)(F.ws + WS_CTL) + CW_QUEUE + 64 * l); SEAM(p0 + 2); }
        if (RUN(p0 + 3)) {
            pg8::StaticOrder3 S; S.init(M, DM, F.G, F.bx);
            pg8::Gemm g{WSP(bf16, WS_Y), WSP(bf16, WS_WP) + (size_t)l * 3 * DM * 1024, M, DM, 1024, (size_t)M * 1024, (size_t)DM * 1024}; pg8::EpiGateAcc E{WSP(bf16, WS_MG), DM, F.ws + WS_ZG, 3 * DM, WSP(float, WS_RSTD)};
            pg8::gemm_phase<pg8::EpiGateAcc, pg8::StaticOrder3, true, true>(F.lds + RING_OFF, g, S, E);
            SEAM(p0 + 3); }
        if (RUN(p0 + 4)) {
            pg8::Gemm g{WSP(bf16, WS_MG), WSP(bf16, WS_WOUT) + (size_t)l * DM * DM, M, DM, DM}; pg8::StaticOrder S; S.init(M, DM, F.G, F.bx);
            pg8::EpiRes<false> E{WSP(bf16, WS_XB), rs + (size_t)32 * M, nullptr, DM};
            pg8::gemm_phase<pg8::EpiRes<false>, pg8::StaticOrder, true, true>(F.lds + RING_OFF, g, S, E);
            SEAM(p0 + 4); }
        if (RUN(p0 + 5)) {
            pg8::Gemm g{WSP(bf16, WS_XB), WSP(bf16, WS_WUP) + (size_t)l * NUP * DM, M, NUP, DM}; pg8::StaticOrder S; S.init(M, NUP, F.G, F.bx);
            { pg8::Unit uu; int lastpm = -1; const float* rs2 = rs + (size_t)32 * M; int tq = threadIdx.x; asm volatile("" : "+v"(tq)); float* r2o = (float*)(F.ws + WS_RSTD2); asm volatile("" : "+s"(r2o));
              for (int i = 0; S.next(i, uu); ++i) if (uu.pm != lastpm) { lastpm = uu.pm;
                  const int r = uu.pm * 256 + (tq >> 1); const f32x4* p = (const f32x4*)(rs2 + (size_t)r * 32 + 16 * (tq & 1));
                  const f32x4 a = p[0], b = p[1], c = p[2], dd = p[3]; float s = (((a[0] + a[1]) + (a[2] + a[3])) + ((b[0] + b[1]) + (b[2] + b[3]))) + (((c[0] + c[1]) + (c[2] + c[3])) + ((dd[0] + dd[1]) + (dd[2] + dd[3])));
                  s += __shfl_xor(s, 1); if (!(tq & 1)) r2o[r] = __builtin_amdgcn_rsqf(s * (1.0f / DM) + 1e-6f); }
              VM_WAIT(); __syncthreads(); }
            const float* r2p = (const float*)(F.ws + WS_RSTD2); asm volatile("" : "+s"(r2p));
            pg8::EpiGLU E{WSP(bf16, WS_ACT), args.in[I_CW] + (size_t)l * 3 * NUP, args.in[I_CB] + (size_t)l * NUP, r2p, WSP(bf16, WS_SB)};
            pg8::gemm_phase<pg8::EpiGLU, pg8::StaticOrder, false, true>(F.lds + RING_OFF, g, S, E);
            SEAM(p0 + 5); }
        if (RUN(p0 + 6)) { glu_fix_phase(F, args.in[I_CW] + (size_t)l * 3 * NUP, args.in[I_CB] + (size_t)l * NUP); SEAM(p0 + 6); }
        if (RUN(p0 + 7)) {
            pg8::Gemm g{WSP(bf16, WS_ACT), WSP(bf16, WS_WDN) + (size_t)l * DM * DFF, M, DM, DFF}; pg8::StaticOrder S; S.init(M, DM, F.G, F.bx);
            if (l + 1 < DEPTH) { pg8::EpiRes<false, true> E{WSP(bf16, WS_XB), rs + (size_t)64 * M, nullptr, DM, F.ws + WS_XB8};
                pg8::gemm_phase<pg8::EpiRes<false, true>, pg8::StaticOrder, true, true>(F.lds + RING_OFF, g, S, E); }
            else { pg8::EpiRes<true> E{WSP(bf16, WS_XB), nullptr, args.out, DM};
                pg8::gemm_phase<pg8::EpiRes<true>, pg8::StaticOrder, true, true>(F.lds + RING_OFF, g, S, E); }
            SEAM(p0 + 7); }
    }
#undef RUN
#undef SEAM
}

#ifndef MK_N_LAUNCHES
#define MK_N_LAUNCHES 1
#endif
extern "C" void kernel_launch(void* const* d_in, const int* in_sizes, int n_in, void* d_out, int out_size, void* d_ws, size_t ws_size, hipStream_t stream) {
    static int grid = 0;
    if (grid == 0) {
        if (n_in != 18 || in_sizes[0] != M * DM || out_size != M * DM || ws_size < WS_END) { fprintf(stderr, "kernel_launch: unexpected shapes (n_in %d, in0 %d, out %d, ws %zu)\n", n_in, n_in > 0 ? in_sizes[0] : -1, out_size, ws_size); grid = -1; return; }
        int dev = 0, cus = 0, per_cu = 0;
        if (hipGetDevice(&dev) != hipSuccess || hipDeviceGetAttribute(&cus, hipDeviceAttributeMultiprocessorCount, dev) != hipSuccess) { grid = -1; return; }
        if (hipFuncSetAttribute((const void*)fwd, hipFuncAttributeMaxDynamicSharedMemorySize, LDS_BYTES) != hipSuccess) { fprintf(stderr, "kernel_launch: hipFuncSetAttribute failed\n"); grid = -1; return; }
        if (hipOccupancyMaxActiveBlocksPerMultiprocessor(&per_cu, (const void*)fwd, NWAVES * 64, LDS_BYTES) != hipSuccess || per_cu < 1) fprintf(stderr, "kernel_launch: occupancy query reports %d\n", per_cu);
        (void)hipGetLastError();
        grid = cus;
    }
    if (grid < 0) return;
    if (hipMemsetAsync((char*)d_ws + WS_CTL, 0, CTL_ZERO_BYTES, stream) != hipSuccess) return;
    Args a{};
    for (int i = 0; i < 18; ++i) a.in[i] = (const float*)d_in[i];
    a.out = (float*)d_out; a.ws = (unsigned char*)d_ws; a.pad = 0;
    constexpr int NL = MK_N_LAUNCHES;
    for (int li = 0; li < NL; ++li) {
        a.ph_lo = (NL == 1) ? 0 : li; a.ph_hi = (NL == 1) ? N_PHASES : li + 1; a.li = (NL == 1) ? 0 : 0;
        hipLaunchKernelGGL(fwd, dim3(grid), dim3(NWAVES * 64), LDS_BYTES, stream, a);
    }
}
```

```cpp
#include <hip/hip_runtime.h>
#include <cstdio>
#include <cstdint>
namespace pg8 {
#define PG8_LAS __attribute__((address_space(3)))
typedef unsigned short bf16_t;
typedef short bf16x8 __attribute__((ext_vector_type(8)));
typedef float f32x4 __attribute__((ext_vector_type(4)));
typedef unsigned u32x4 __attribute__((ext_vector_type(4)));
constexpr int BM = 256, BK = 64, HALF = 128, HTB = HALF * BK * 2  , STAGE_BYTES = 8 * HTB, NXCD = 8, WGM = 8;

__host__ __device__ __forceinline__ int lds_byte(int r, int c) { const int st = (r >> 4) * 2 + (c >> 5), rr = r & 15, cc = c & 31, ob = rr * 64 + cc * 2; return st * 1024 + (ob ^ (((ob >> 9) & 1) << 5)); }
__host__ __device__ __forceinline__ void stage_rc(int b, int& R, int& C) { const int st = b / 1024, sb = b % 1024, swz = sb ^ (((sb >> 9) & 1) << 5); R = (st >> 1) * 16 + swz / 64; C = (st & 1) * 32 + (swz % 64) / 2; }
__host__ __device__ __forceinline__ int perm32(int rho) { const int n = rho >> 4, i = rho & 15; return 8 * (i >> 2) + 4 * n + (i & 3); }

struct Unit { int pm, pn, z; };
struct Gemm { const bf16_t* A; const bf16_t* Bt; int M, N, K; size_t zA, zB; };

struct StaticOrder {
    int nM, nN, nwg, G, c;
    __host__ __device__ void init(int M, int N, int G_, int c_) { nM = M / BM; nN = N / BM; nwg = nM * nN; G = G_; c = c_; }
    __host__ __device__ bool next(int i, Unit& u) const {
        const long L = (long)i * G + c; if (L >= nwg) return false;
        int wgid = (int)L; { const int q = nwg / NXCD, r = nwg % NXCD, xcd = wgid % NXCD, off = wgid / NXCD; wgid = (xcd < r ? xcd * (q + 1) : r * (q + 1) + (xcd - r) * q) + off; }
        const int nig = WGM * nN, gid = wgid / nig, fm = gid * WGM, gsz = (nM - fm) < WGM ? (nM - fm) : WGM;
        u.pm = fm + ((wgid % nig) % gsz); u.pn = (wgid % nig) / gsz; u.z = 0; return true;
    }
    __device__ __forceinline__ void a_ready(const Unit&) const {}
    __device__ __forceinline__ void done(const Unit&) const {}
};

struct SkipOrder : StaticOrder {
    int skip0, nskip;
    __host__ __device__ bool next(int i, Unit& u) const { if (!StaticOrder::next(i, u)) return false; if (u.pn >= skip0) u.pn += nskip; return true; }
};
template <class Base> struct RangeOrder {
    Base b; int i0, n;
    __host__ __device__ bool next(int i, Unit& u) const { return i < n && b.next(i0 + i, u); }
    __device__ __forceinline__ void a_ready(const Unit&) const {}
    __device__ __forceinline__ void done(const Unit&) const {}
};
struct StaticOrder3 : StaticOrder {
    __host__ __device__ bool next(int i, Unit& u) const { if (!StaticOrder::next(i / 3, u)) return false; u.z = i % 3; return true; }
};
__device__ __forceinline__ unsigned cvt_pk_bf16(float lo, float hi) { unsigned r; asm volatile("v_cvt_pk_bf16_f32 %0, %1, %2" : "=v"(r) : "v"(lo), "v"(hi)); return r; }
typedef unsigned u32x2 __attribute__((ext_vector_type(2)));
__device__ __forceinline__ u32x4 qgather(const u32x4 w, int lane) { const int src = 4 * (16 * (lane & 3) + (lane >> 2)); u32x4 o;
#pragma unroll
    for (int k = 0; k < 4; ++k) o[k] = (unsigned)__builtin_amdgcn_ds_bpermute(src, (int)w[k]); return o; }
__device__ __forceinline__ u32x4 qscatter(const u32x4 w, int lane) { const int src = 4 * (4 * (lane & 15) + (lane >> 4)); u32x4 o;
#pragma unroll
    for (int k = 0; k < 4; ++k) o[k] = (unsigned)__builtin_amdgcn_ds_bpermute(src, (int)w[k]); return o; }
struct EpiBf16 {
    static constexpr bool PERM = true, AFTER_DRAIN = false, KEEP = false, APERM = false;
    bf16_t* O; int ldc; unsigned char* G8; int g8_pn0, g8_ld;
    __device__ __forceinline__ void operator()(const f32x4 (&acc)[2][2][4][2], const Unit& u, int wr, int wc, int fr, int fq) const {
        const int lane = 16 * fq + fr; const int row0 = u.pm * BM + wr * 64 + (lane >> 2); const int col0 = u.pn * BM + wc * 32 + 8 * (lane & 3);
#pragma unroll
        for (int ai = 0; ai < 2; ++ai)
#pragma unroll
            for (int m = 0; m < 4; ++m) { bf16_t* rowp = O + (size_t)(row0 + ai * HALF + m * 16) * ldc + col0;
#pragma unroll
                for (int bj = 0; bj < 2; ++bj) { const f32x4 v0 = acc[ai][bj][m][0], v1 = acc[ai][bj][m][1];
                    u32x4 w; w.x = cvt_pk_bf16(v0[0], v0[1]); w.y = cvt_pk_bf16(v0[2], v0[3]); w.z = cvt_pk_bf16(v1[0], v1[1]); w.w = cvt_pk_bf16(v1[2], v1[3]);
                    *(u32x4*)(rowp + bj * HALF) = qgather(w, lane); } }
    }
};
struct EpiGate8 {
    static constexpr bool PERM = true, AFTER_DRAIN = false, KEEP = false, APERM = false;
    unsigned char* G8; int g8_ld; float sc; bf16_t* O; int ldc, o_pn0, o_col0;
    __device__ __forceinline__ void operator()(const f32x4 (&acc)[2][2][4][2], const Unit& u, int wr, int wc, int fr, int fq) const {
        const int lane = 16 * fq + fr; const int row0 = u.pm * BM + wr * 64 + (lane >> 2); const int pc = wc * 32 + 8 * (lane & 3);
        if (u.pn >= o_pn0) { const int col0 = o_col0 + (u.pn - o_pn0) * BM + pc;
#pragma unroll
            for (int ai = 0; ai < 2; ++ai)
#pragma unroll
                for (int m = 0; m < 4; ++m) { bf16_t* rowp = O + (size_t)(row0 + ai * HALF + m * 16) * ldc + col0;
#pragma unroll
                    for (int bj = 0; bj < 2; ++bj) { const f32x4 v0 = acc[ai][bj][m][0] * sc, v1 = acc[ai][bj][m][1] * sc;
                        u32x4 w; w.x = cvt_pk_bf16(v0[0], v0[1]); w.y = cvt_pk_bf16(v0[2], v0[3]); w.z = cvt_pk_bf16(v1[0], v1[1]); w.w = cvt_pk_bf16(v1[2], v1[3]);
                        *(u32x4*)(rowp + bj * HALF) = qgather(w, lane); } }
            return; }
        const int gc0 = u.pn * BM + pc; const int src = 4 * (16 * (lane & 3) + (lane >> 2));
#pragma unroll
        for (int ai = 0; ai < 2; ++ai)
#pragma unroll
            for (int m = 0; m < 4; ++m) { unsigned char* rowp = G8 + (size_t)(row0 + ai * HALF + m * 16) * g8_ld + gc0;
#pragma unroll
                for (int bj = 0; bj < 2; ++bj) { const f32x4 v0 = acc[ai][bj][m][0] * sc, v1 = acc[ai][bj][m][1] * sc; u32x2 w;
                    w.x = (unsigned)__builtin_amdgcn_cvt_pk_fp8_f32(v0[2], v0[3], __builtin_amdgcn_cvt_pk_fp8_f32(v0[0], v0[1], 0, false), true);
                    w.y = (unsigned)__builtin_amdgcn_cvt_pk_fp8_f32(v1[2], v1[3], __builtin_amdgcn_cvt_pk_fp8_f32(v1[0], v1[1], 0, false), true);
                    w.x = (unsigned)__builtin_amdgcn_ds_bpermute(src, (int)w.x); w.y = (unsigned)__builtin_amdgcn_ds_bpermute(src, (int)w.y);
                    *(u32x2*)(rowp + bj * HALF) = w; } }
    }
};
__device__ __forceinline__ float bf_lo(unsigned w) { return __uint_as_float(w << 16); }
__device__ __forceinline__ float bf_hi(unsigned w) { return __uint_as_float(w & 0xffff0000u); }
__device__ __forceinline__ float sigmoid_f(float x) { return __builtin_amdgcn_rcpf(1.0f + __expf(-x)); }
struct EpiGateAcc {
    static constexpr bool PERM = true, AFTER_DRAIN = false, KEEP = true, APERM = false;
    bf16_t* O; int ldc; const unsigned char* G8; int g8_ld; const float* rstd;
    template <int E> static __device__ __forceinline__ float g8f(const u32x2 w) { return __builtin_amdgcn_cvt_f32_fp8((int)(E < 4 ? w.x : w.y), E & 3); }
    static __device__ __forceinline__ float em(float g, float rr) { return __expf(-fminf(fmaxf(g * rr, -40.f), 40.f)); }
    __device__ __forceinline__ void operator()(f32x4 (&acc)[2][2][4][2], const Unit& u, int wr, int wc, int fr, int fq) const {
        const int row0 = u.pm * BM + wr * 64 + fr; const int col0 = u.pn * BM + wc * 32 + 8 * fq; const bool last = (u.z == 2); const float dmask = last ? 0.0f : 1.0f;
        const unsigned char* Gn = G8 + (size_t)u.z * ldc; const unsigned char* Gd = G8 + (size_t)(last ? u.z : u.z + 1) * ldc;
#pragma unroll
        for (int ai = 0; ai < 2; ++ai)
#pragma unroll
            for (int m = 0; m < 4; ++m) { const size_t row = (size_t)(row0 + ai * HALF + m * 16); const float rr = rstd[row];
#pragma unroll
                for (int bj = 0; bj < 2; ++bj) {
                    const u32x2 gn = *(const u32x2*)(Gn + row * g8_ld + col0 + bj * HALF), gd = *(const u32x2*)(Gd + row * g8_ld + col0 + bj * HALF);
                    f32x4 v0 = acc[ai][bj][m][0], v1 = acc[ai][bj][m][1];
#define GA_MUL(E) ((1.0f + dmask * em(g8f<E>(gd), rr)) * __builtin_amdgcn_rcpf(1.0f + em(g8f<E>(gn), rr)))
                    v0[0] *= GA_MUL(0); v0[1] *= GA_MUL(1); v0[2] *= GA_MUL(2); v0[3] *= GA_MUL(3); v1[0] *= GA_MUL(4); v1[1] *= GA_MUL(5); v1[2] *= GA_MUL(6); v1[3] *= GA_MUL(7);
#undef GA_MUL
                    acc[ai][bj][m][0] = v0; acc[ai][bj][m][1] = v1;
                    if (last) { u32x4 w; w.x = cvt_pk_bf16(v0[0], v0[1]); w.y = cvt_pk_bf16(v0[2], v0[3]); w.z = cvt_pk_bf16(v1[0], v1[1]); w.w = cvt_pk_bf16(v1[2], v1[3]); *(u32x4*)(O + row * ldc + col0 + bj * HALF) = w; } } }
    }
};
template <bool LAST, bool F8 = false> struct EpiRes {
    static constexpr bool PERM = true, AFTER_DRAIN = false, KEEP = false, APERM = false;
    bf16_t* xb; float* rs; float* out; int ldc; unsigned char* x8;
    __device__ __forceinline__ void operator()(const f32x4 (&acc)[2][2][4][2], const Unit& u, int wr, int wc, int fr, int fq) const {
        const int row0 = u.pm * BM + wr * 64 + fr; const int col0 = u.pn * BM + wc * 32 + 8 * fq;
#pragma unroll
        for (int ai = 0; ai < 2; ++ai) {
            u32x4 pv[4][2];
#pragma unroll
            for (int m = 0; m < 4; ++m)
#pragma unroll
                for (int bj = 0; bj < 2; ++bj) pv[m][bj] = *(const u32x4*)(xb + (size_t)(row0 + ai * HALF + m * 16) * ldc + col0 + bj * HALF);
#pragma unroll
            for (int m = 0; m < 4; ++m) { const int row = row0 + ai * HALF + m * 16; const size_t off = (size_t)row * ldc + col0; float sq = 0.f;
#pragma unroll
                for (int bj = 0; bj < 2; ++bj) { const u32x4 p = pv[m][bj]; const f32x4 v0 = acc[ai][bj][m][0], v1 = acc[ai][bj][m][1];
                    const float o0 = bf_lo(p.x) + v0[0], o1 = bf_hi(p.x) + v0[1], o2 = bf_lo(p.y) + v0[2], o3 = bf_hi(p.y) + v0[3], o4 = bf_lo(p.z) + v1[0], o5 = bf_hi(p.z) + v1[1], o6 = bf_lo(p.w) + v1[2], o7 = bf_hi(p.w) + v1[3];
                    if (LAST) { *(f32x4*)(out + off + bj * HALF) = (f32x4){o0, o1, o2, o3}; *(f32x4*)(out + off + bj * HALF + 4) = (f32x4){o4, o5, o6, o7}; }
                    else { sq += ((o0 * o0 + o1 * o1) + (o2 * o2 + o3 * o3)) + ((o4 * o4 + o5 * o5) + (o6 * o6 + o7 * o7));
                        u32x4 w; w.x = cvt_pk_bf16(o0, o1); w.y = cvt_pk_bf16(o2, o3); w.z = cvt_pk_bf16(o4, o5); w.w = cvt_pk_bf16(o6, o7); *(u32x4*)(xb + off + bj * HALF) = w;
                        if (F8) { u32x2 q; q.x = (unsigned)__builtin_amdgcn_cvt_pk_fp8_f32(o2, o3, __builtin_amdgcn_cvt_pk_fp8_f32(o0, o1, 0, false), true); q.y = (unsigned)__builtin_amdgcn_cvt_pk_fp8_f32(o6, o7, __builtin_amdgcn_cvt_pk_fp8_f32(o4, o5, 0, false), true);
                            *(u32x2*)(x8 + off + bj * HALF) = q; } } }
                if (!LAST) { sq += __shfl_xor(sq, 16); sq += __shfl_xor(sq, 32); if (fq == 0) rs[(size_t)row * 32 + u.pn * 4 + wc] = sq; } } }
    }
};

struct EpiGLU {
    static constexpr bool PERM = true, AFTER_DRAIN = false, KEEP = false, APERM = true;
    bf16_t* ACT; const float* cw; const float* cb; const float* rs; bf16_t* SB;
    static __device__ __forceinline__ f32x4 prev_lane(const f32x4 v, int src) { f32x4 o;
#pragma unroll
        for (int k = 0; k < 4; ++k) o[k] = __shfl(v[k], src); return o; }
    static __device__ __forceinline__ f32x4 silu4(const f32x4 a) { f32x4 o;
#pragma unroll
        for (int k = 0; k < 4; ++k) o[k] = a[k] * __builtin_amdgcn_rcpf(1.0f + __expf(-a[k])); return o; }
    __device__ __forceinline__ void operator()(const f32x4 (&acc)[2][2][4][2], const Unit& u, int wr, int wc, int fr, int fq) const {
        constexpr int DFF_ = 5632, NUP_ = 2 * DFF_;
        const int T0 = u.pm * BM + 8 * (16 * wr + fr), jq = u.pn * HALF + wc * 32 + 8 * fq, grp = 2 * u.pm + wr;
        const int lane = 16 * fq + fr, qsrc = 4 * (16 * (lane & 3) + (lane >> 2)), Tq = u.pm * BM + 8 * (16 * wr + (lane >> 2)), jqq = u.pn * HALF + wc * 32 + 8 * (lane & 3);
        float rr[8];
        { const f32x4 ra = *(const f32x4*)(rs + T0), rb = *(const f32x4*)(rs + T0 + 4); rr[0] = ra[0]; rr[1] = ra[1]; rr[2] = ra[2]; rr[3] = ra[3]; rr[4] = rb[0]; rr[5] = rb[1]; rr[6] = rb[2]; rr[7] = rb[3]; }
#pragma unroll
        for (int n = 0; n < 2; ++n) { const int j = jq + 4 * n;
            const f32x4 ca = *(const f32x4*)(cb + j), cbv = *(const f32x4*)(cb + DFF_ + j);
            const f32x4 a0 = *(const f32x4*)(cw + j), a1 = *(const f32x4*)(cw + NUP_ + j), a2 = *(const f32x4*)(cw + 2 * NUP_ + j);
            const f32x4 b0 = *(const f32x4*)(cw + DFF_ + j), b1 = *(const f32x4*)(cw + NUP_ + DFF_ + j), b2 = *(const f32x4*)(cw + 2 * NUP_ + DFF_ + j);
            f32x4 va[8], vb[8];
#pragma unroll
            for (int i = 0; i < 8; ++i) { va[i] = acc[i >> 2][0][i & 3][n] * rr[i]; vb[i] = acc[i >> 2][1][i & 3][n] * rr[i]; }
            const int psrc = fq * 16 + ((fr + 15) & 15); const f32x4 pa6 = prev_lane(va[6], psrc), pa7 = prev_lane(va[7], psrc), pb6 = prev_lane(vb[6], psrc), pb7 = prev_lane(vb[7], psrc);
#pragma unroll
            for (int i = 0; i < 8; ++i) {
                const f32x4 xa1 = i >= 1 ? va[i - 1] : pa7, xa2 = i >= 2 ? va[i - 2] : (i == 1 ? pa7 : pa6), xb1 = i >= 1 ? vb[i - 1] : pb7, xb2 = i >= 2 ? vb[i - 2] : (i == 1 ? pb7 : pb6);
                const f32x4 ua = ca + a0 * xa2 + a1 * xa1 + a2 * va[i], ub = cbv + b0 * xb2 + b1 * xb1 + b2 * vb[i];
                const f32x4 o = silu4(ua) * ub;
                { u32x2 w; w.x = cvt_pk_bf16(o[0], o[1]); w.y = cvt_pk_bf16(o[2], o[3]);
                  w.x = (unsigned)__builtin_amdgcn_ds_bpermute(qsrc, (int)w.x); w.y = (unsigned)__builtin_amdgcn_ds_bpermute(qsrc, (int)w.y);
                  if (i >= 2 || (lane >> 2) != 0) *(u32x2*)(ACT + (size_t)(Tq + i) * DFF_ + jqq + 4 * n) = w; } }
            if (fr == 0) {
#pragma unroll
                for (int i = 0; i < 2; ++i) { u32x2 w; w.x = cvt_pk_bf16(va[i][0], va[i][1]); w.y = cvt_pk_bf16(va[i][2], va[i][3]); *(u32x2*)(SB + ((size_t)grp * 4 + 2 + i) * NUP_ + j) = w;
                    w.x = cvt_pk_bf16(vb[i][0], vb[i][1]); w.y = cvt_pk_bf16(vb[i][2], vb[i][3]); *(u32x2*)(SB + ((size_t)grp * 4 + 2 + i) * NUP_ + DFF_ + j) = w; } }
            if (fr == 15) {
#pragma unroll
                for (int i = 0; i < 2; ++i) { u32x2 w; w.x = cvt_pk_bf16(va[6 + i][0], va[6 + i][1]); w.y = cvt_pk_bf16(va[6 + i][2], va[6 + i][3]); *(u32x2*)(SB + ((size_t)(grp + 1) * 4 + i) * NUP_ + j) = w;
                    w.x = cvt_pk_bf16(vb[6 + i][0], vb[6 + i][1]); w.y = cvt_pk_bf16(vb[6 + i][2], vb[6 + i][3]); *(u32x2*)(SB + ((size_t)(grp + 1) * 4 + i) * NUP_ + DFF_ + j) = w; } }
        }
    }
};

template <class E, class = void> struct EpiB64 { static constexpr bool v = false; };
template <class E> struct EpiB64<E, decltype((void)E::B64)> { static constexpr bool v = E::B64; };
typedef int i32x4_t __attribute__((ext_vector_type(4)));
typedef int i32x8_t __attribute__((ext_vector_type(8)));
__device__ __forceinline__ i32x8_t cat8(const bf16x8 a, const bf16x8 b) { return __builtin_shufflevector((i32x4_t)a, (i32x4_t)b, 0, 1, 2, 3, 4, 5, 6, 7); }
template <class Epi, class Sched, bool ALIGN_EPI = false, bool SP2 = false, bool F8 = false>
__device__ __forceinline__ void gemm_phase(PG8_LAS unsigned char* lds, const Gemm g, const Sched& S, const Epi& E) {
    int tid_ = threadIdx.x; asm volatile("" : "+v"(tid_));
    const int tid = tid_, wid = __builtin_amdgcn_readfirstlane(tid >> 6), lane = tid & 63, wr = wid >> 2, wc = wid & 3, fr = lane & 15, fq = lane >> 4;
    const int K = g.K, nt = K / BK;
    unsigned voffA[2], voffB[2];
#pragma unroll
    for (int i = 0; i < 2; ++i) { int R, C; stage_rc(tid * 16 + i * 8192, R, C); const int Rb = EpiB64<Epi>::v ? (2 * (R & ~31) + perm32(R & 31)) : Epi::PERM ? ((R & ~31) + perm32(R & 31)) : R;
        const int Ra = Epi::APERM ? (8 * (16 * (R >> 6) + (R & 15)) + ((R >> 4) & 3)) : R;
        voffA[i] = (unsigned)(Ra * K + C) * 2u; voffB[i] = (unsigned)(Rb * K + C) * 2u; }
    const size_t kstep = (size_t)(BK * 2);
    const size_t hstep = (size_t)HALF * K * 2;
    const size_t hstepA = Epi::APERM ? (size_t)4 * K * 2 : hstep;
    const size_t hstepB = EpiB64<Epi>::v ? (size_t)32 * K * 2 : hstep;
    const size_t tstep = 2 * hstep;
    const unsigned ldsw = (unsigned)wid * 1024u;
    const int aoff = lds_byte(wr * 64 + fr, fq * 8), boff = lds_byte(wc * 32 + fr, fq * 8);
#define PG8_SA(b, h) (((b) * 2 + (h)) * HTB)
#define PG8_SB(b, h) ((4 + (b) * 2 + (h)) * HTB)
#define PG8_STAGE(bufoff, gbase, voff) do { _Pragma("unroll") for (int _i = 0; _i < 2; ++_i) \
        __builtin_amdgcn_global_load_lds((const unsigned*)((const char*)(gbase) + (voff)[_i]), (PG8_LAS unsigned*)(lds + (bufoff) + ldsw + _i * 8192), 16, 0, 0); } while (0)
#define PG8_LDA(dst, b, h) do { _Pragma("unroll") for (int m = 0; m < 4; ++m) _Pragma("unroll") for (int k = 0; k < 2; ++k) dst[m][k] = *(const PG8_LAS bf16x8*)(lds + PG8_SA(b, h) + aoff + m * 2048 + k * 1024); } while (0)
#define PG8_LDB(dst, b, h) do { _Pragma("unroll") for (int n = 0; n < 2; ++n) _Pragma("unroll") for (int k = 0; k < 2; ++k) dst[n][k] = *(const PG8_LAS bf16x8*)(lds + PG8_SB(b, h) + boff + n * 2048 + k * 1024); } while (0)
#define PG8_MMA(ai, bj, At, Bt) do { __builtin_amdgcn_s_setprio(1); if constexpr (F8) { _Pragma("unroll") for (int m = 0; m < 4; ++m) _Pragma("unroll") for (int n = 0; n < 2; ++n) \
        asm volatile("v_mfma_f32_16x16x128_f8f6f4 %0, %1, %2, %0" : "+v"(acc[ai][bj][m][n]) : "v"(cat8(Bt[n][0], Bt[n][1])), "v"(cat8(At[m][0], At[m][1]))); } else { \
        _Pragma("unroll") for (int m = 0; m < 4; ++m) _Pragma("unroll") for (int n = 0; n < 2; ++n) _Pragma("unroll") for (int k = 0; k < 2; ++k) \
        acc[ai][bj][m][n] = __builtin_amdgcn_mfma_f32_16x16x32_bf16(Bt[n][k], At[m][k], acc[ai][bj][m][n], 0, 0, 0); } __builtin_amdgcn_s_setprio(0); } while (0)
#define PG8_WAIT_V(n) asm volatile("s_waitcnt vmcnt(" #n ")" ::: "memory")
#define PG8_WAIT_L(n) asm volatile("s_waitcnt lgkmcnt(" #n ")" ::: "memory")
#define PG8_BAR __builtin_amdgcn_s_barrier()
#define PG8_SCHED __builtin_amdgcn_sched_barrier(0)
    Unit cur, nxt; int ui = 0;
    if (!S.next(0, cur)) return;
    f32x4 acc[2][2][4][2];
#pragma unroll
    for (int a = 0; a < 2; ++a)
#pragma unroll
        for (int b = 0; b < 2; ++b)
#pragma unroll
            for (int m = 0; m < 4; ++m)
#pragma unroll
                for (int n = 0; n < 2; ++n) acc[a][b][m][n] = (f32x4){0.f, 0.f, 0.f, 0.f};
    bf16x8 At[4][2], B0[2][2], B1[2][2];
    const char* cA = (const char*)(g.A + (size_t)cur.z * g.zA) + (size_t)cur.pm * tstep; const char* cB = (const char*)(g.Bt + (size_t)cur.z * g.zB) + (size_t)cur.pn * tstep;
    S.a_ready(cur);
    if constexpr (SP2) {
        PG8_STAGE(PG8_SB(0, 0), cB, voffB); PG8_STAGE(PG8_SB(0, 1), cB + hstepB, voffB); PG8_STAGE(PG8_SA(0, 0), cA, voffA); PG8_STAGE(PG8_SA(0, 1), cA + hstepA, voffA);
        if (wr == 1) PG8_BAR;
        PG8_WAIT_V(2); PG8_BAR;
        PG8_STAGE(PG8_SB(1, 0), cB + kstep, voffB); PG8_STAGE(PG8_SA(1, 0), cA + kstep, voffA); PG8_STAGE(PG8_SB(1, 1), cB + hstepB + kstep, voffB);
        PG8_WAIT_V(6); PG8_BAR;
    } else {
        PG8_STAGE(PG8_SB(0, 0), cB, voffB); PG8_STAGE(PG8_SA(0, 0), cA, voffA); PG8_STAGE(PG8_SB(0, 1), cB + hstepB, voffB); PG8_STAGE(PG8_SA(0, 1), cA + hstepA, voffA);
        if (wr == 1) PG8_BAR;
        PG8_WAIT_V(4); PG8_BAR;
        PG8_STAGE(PG8_SB(1, 0), cB + kstep, voffB); PG8_STAGE(PG8_SA(1, 0), cA + kstep, voffA); PG8_STAGE(PG8_SB(1, 1), cB + hstepB + kstep, voffB);
        PG8_WAIT_V(6); PG8_BAR;
    }
    for (;;) {
        const bool has_next = S.next(ui + 1, nxt);
        const char* nA = has_next ? (const char*)(g.A + (size_t)nxt.z * g.zA) + (size_t)nxt.pm * tstep : cA; const char* nB = has_next ? (const char*)(g.Bt + (size_t)nxt.z * g.zB) + (size_t)nxt.pn * tstep : cB;
        for (int t = 0; t < nt; t += 2) {
            const bool last = (t == nt - 2);
            const char* a1 = cA + (size_t)(t + 1) * kstep;
            const char* a2 = last ? nA : cA + (size_t)(t + 2) * kstep; const char* b2 = last ? nB : cB + (size_t)(t + 2) * kstep;
            const char* a3 = a2 + kstep; const char* b3 = b2 + kstep;
            if (last && has_next) S.a_ready(nxt);
            if constexpr (SP2) {
            PG8_LDB(B0, 0, 0); PG8_LDB(B1, 0, 1); PG8_SCHED; PG8_LDA(At, 0, 0); PG8_STAGE(PG8_SA(1, 1), a1 + hstepA, voffA);
            PG8_WAIT_V(8); PG8_WAIT_L(0); PG8_BAR; PG8_MMA(0, 0, At, B0); PG8_MMA(0, 1, At, B1); PG8_BAR; PG8_SCHED;
            PG8_LDA(At, 0, 1); PG8_STAGE(PG8_SB(0, 0), b2, voffB); PG8_STAGE(PG8_SB(0, 1), b2 + hstepB, voffB); PG8_STAGE(PG8_SA(0, 0), a2, voffA);
            PG8_WAIT_V(8); PG8_WAIT_L(0); PG8_BAR; PG8_MMA(1, 0, At, B0); PG8_MMA(1, 1, At, B1); PG8_BAR; PG8_SCHED;
            PG8_LDB(B0, 1, 0); PG8_LDB(B1, 1, 1); PG8_SCHED; PG8_LDA(At, 1, 0); PG8_STAGE(PG8_SA(0, 1), a2 + hstepA, voffA);
            PG8_WAIT_V(8); PG8_WAIT_L(0); PG8_BAR; PG8_MMA(0, 0, At, B0); PG8_MMA(0, 1, At, B1); PG8_BAR; PG8_SCHED;
            PG8_LDA(At, 1, 1); PG8_STAGE(PG8_SB(1, 0), b3, voffB); PG8_STAGE(PG8_SB(1, 1), b3 + hstepB, voffB); PG8_STAGE(PG8_SA(1, 0), a3, voffA);
            PG8_WAIT_V(8); PG8_WAIT_L(0); PG8_BAR; PG8_MMA(1, 0, At, B0); PG8_MMA(1, 1, At, B1); PG8_BAR; PG8_SCHED;
            } else {
            PG8_LDB(B0, 0, 0); PG8_SCHED; PG8_LDA(At, 0, 0); PG8_STAGE(PG8_SA(1, 1), a1 + hstepA, voffA);
            PG8_WAIT_L(8); PG8_BAR; PG8_WAIT_L(0); PG8_MMA(0, 0, At, B0); PG8_BAR; PG8_SCHED;
            PG8_LDB(B1, 0, 1); PG8_STAGE(PG8_SB(0, 0), b2, voffB);
            PG8_BAR; PG8_WAIT_L(0); PG8_MMA(0, 1, At, B1); PG8_BAR;
            PG8_LDA(At, 0, 1); PG8_STAGE(PG8_SA(0, 0), a2, voffA);
            PG8_BAR; PG8_WAIT_L(0); PG8_MMA(1, 0, At, B0); PG8_BAR; PG8_SCHED;
            PG8_STAGE(PG8_SB(0, 1), b2 + hstepB, voffB);
            PG8_WAIT_V(6); PG8_BAR; PG8_MMA(1, 1, At, B1); PG8_BAR;
            PG8_LDB(B0, 1, 0); PG8_SCHED; PG8_LDA(At, 1, 0); PG8_STAGE(PG8_SA(0, 1), a2 + hstepA, voffA);
            PG8_WAIT_L(8); PG8_BAR; PG8_WAIT_L(0); PG8_MMA(0, 0, At, B0); PG8_BAR; PG8_SCHED;
            PG8_LDB(B1, 1, 1); PG8_STAGE(PG8_SB(1, 0), b3, voffB);
            PG8_BAR; PG8_WAIT_L(0); PG8_MMA(0, 1, At, B1); PG8_BAR;
            PG8_LDA(At, 1, 1); PG8_STAGE(PG8_SA(1, 0), a3, voffA);
            PG8_BAR; PG8_WAIT_L(0); PG8_MMA(1, 0, At, B0); PG8_BAR; PG8_SCHED;
            PG8_STAGE(PG8_SB(1, 1), b3 + hstepB, voffB);
            PG8_WAIT_V(6); PG8_BAR; PG8_MMA(1, 1, At, B1); PG8_BAR;
            }
        }
        if constexpr (F8) asm volatile("s_nop 15\n\ts_nop 15\n\ts_nop 15\n\ts_nop 15" ::: "memory");
        if constexpr (ALIGN_EPI) { if (wr == 0) PG8_BAR; }
        if constexpr (!Epi::AFTER_DRAIN) { E(acc, cur, wr, wc, fr, fq); S.done(cur); }
        if (!has_next) break;
        if (!(Epi::KEEP && nxt.z != 0)) {
#pragma unroll
        for (int a = 0; a < 2; ++a)
#pragma unroll
            for (int b = 0; b < 2; ++b)
#pragma unroll
                for (int m = 0; m < 4; ++m)
#pragma unroll
                    for (int n = 0; n < 2; ++n) acc[a][b][m][n] = (f32x4){0.f, 0.f, 0.f, 0.f};
        }
        cur = nxt; cA = nA; cB = nB; ++ui;
        if constexpr (ALIGN_EPI) { if (wr == 1) PG8_BAR; }
    }
    PG8_WAIT_V(0);
    if constexpr (!ALIGN_EPI) { if (wr == 0) PG8_BAR; }
    PG8_BAR;
    if constexpr (Epi::AFTER_DRAIN) { E.fused(acc, cur, wr, wc, fr, fq, lds, wid, lane); S.done(cur); }
#undef PG8_SA
#undef PG8_SB
#undef PG8_STAGE
#undef PG8_LDA
#undef PG8_LDB
#undef PG8_MMA
#undef PG8_WAIT_V
#undef PG8_WAIT_L
#undef PG8_BAR
#undef PG8_SCHED
}
}

constexpr int NWAVES = 8;
constexpr int BATCH = 8, SEQ = 2048, DM = 2048, DEPTH = 4, M = BATCH * SEQ, NH = 8;
constexpr int NIN = 16400, NZ = 16384, DFF = 5632, NUP = 2 * DFF, NY = 3072;
constexpr int Z_RQ = 0, Z_RK = 1024, Z_RV = 2048, Z_RG = 3072, Z_MQ = 4096, Z_MK = 4608, Z_MV = 5120, Z_MO = 6144, Z_AQ = 7168, Z_AK = 8192, Z_AV = 9216, Z_GA = 10240, Z_GB = 12288, Z_GC = 14336;
constexpr int W_GATE_COL = 7168;
constexpr size_t MiB = 1u << 20;
constexpr size_t WS_CTL = 0, CTL_ZERO_BYTES = 1 * MiB;
constexpr size_t WS_RS = 1520 * MiB;
constexpr size_t WS_TAB = 2 * MiB + 512 * 1024;
constexpr size_t WS_RSTD = 7 * MiB + 512 * 1024;
constexpr size_t WS_RSTD2 = 7 * MiB + 768 * 1024;
constexpr size_t WS_W16G = 7 * MiB;
constexpr size_t WS_KMEAN = 5 * MiB;
constexpr size_t WS_GIF = 6 * MiB;
constexpr size_t WS_WIN = 8 * MiB;
constexpr size_t WS_WP = 264 * MiB;
constexpr size_t WS_WOUT = 312 * MiB;
constexpr size_t WS_WUP = 344 * MiB;
constexpr size_t WS_WDN = 520 * MiB;
constexpr size_t WS_XB = 608 * MiB;
constexpr size_t WS_Z = 672 * MiB;
constexpr size_t WS_Y = 1184 * MiB;
constexpr size_t WS_MG = 1280 * MiB;
constexpr size_t WS_ACT = 1344 * MiB;
constexpr size_t WS_ZG = 1536 * MiB;
constexpr size_t WS_SB = 1632 * MiB;
constexpr size_t WS_XB8 = 1648 * MiB;
constexpr size_t WS_END = 1680 * MiB;
constexpr int N8 = 3 * DM + 1024;
__host__ __device__ constexpr size_t ws_win8(int l) { return WS_WIN + ((size_t)l * NZ + Z_GA) * DM * 2; }
constexpr int CW_TMO = 0, CW_CODE = 1;
constexpr int CW_BAR = 4096;
constexpr int CW_QUEUE = 8192;
constexpr int RING_OFF = 0, RING_BYTES = 131072;
constexpr int LDS_BYTES = 163840;
constexpr int LDSCTL_OFF = LDS_BYTES - 512, MISC_OFF = LDSCTL_OFF + 320;
static_assert(MISC_OFF + 128 <= LDS_BYTES, "LDS map");

#define GAS __attribute__((address_space(1)))
#define LAS __attribute__((address_space(3)))
typedef unsigned short bf16;
typedef unsigned v4u __attribute__((ext_vector_type(4)));
typedef unsigned v2u __attribute__((ext_vector_type(2)));
typedef float f32x4 __attribute__((ext_vector_type(4)));
typedef float f32x2 __attribute__((ext_vector_type(2)));
typedef GAS unsigned gu32;
#define RLX_AGENT __ATOMIC_RELAXED, __HIP_MEMORY_SCOPE_AGENT
#define LDS_WAIT() asm volatile("s_waitcnt lgkmcnt(0)" ::: "memory")
#define VM_WAIT() asm volatile("s_waitcnt vmcnt(0)" ::: "memory")
typedef __bf16 bf16x2_t __attribute__((ext_vector_type(2)));
__device__ __forceinline__ unsigned pk2(float lo, float hi) { const f32x2 v = {lo, hi}; const bf16x2_t b = __builtin_convertvector(v, bf16x2_t); return __builtin_bit_cast(unsigned, b); }
__device__ __forceinline__ unsigned f2bf(float f) { return pk2(f, f); }
__device__ __forceinline__ float bflo(unsigned w) { return __uint_as_float(w << 16); }
__device__ __forceinline__ float bfhi(unsigned w) { return __uint_as_float(w & 0xffff0000u); }
__device__ __forceinline__ float bf1(bf16 v) { return __uint_as_float((unsigned)v << 16); }
__device__ __forceinline__ float sigm(float x) { return 1.0f / (1.0f + __expf(-x)); }

#define XB_TMO      128
#define XB_XCNT(j)  (256  + 64 * (j))
#define XB_XSUB(j)  (1280 + 64 * (j))
#define XB_XGEN(j)  (2304 + 64 * (j))
#define XB_TOP      3328
#define XB_TOPGEN   3392
#define XCD_BAR_WORDS 3456
#define XB_SPIN_CAP (1u << 18)

__device__ __forceinline__ unsigned xb_ld(unsigned* p)              { return __hip_atomic_load(p, __ATOMIC_RELAXED, __HIP_MEMORY_SCOPE_AGENT); }
__device__ __forceinline__ unsigned xb_add(unsigned* p, unsigned v) { return __hip_atomic_fetch_add(p, v, __ATOMIC_RELAXED, __HIP_MEMORY_SCOPE_AGENT); }
__device__ __forceinline__ unsigned xb_xcc_id() { return (unsigned)__builtin_amdgcn_s_getreg((3 << 11) | 20) & 0xFu; }
#define XB_SPIN(cond, bar) do { unsigned _sp = 0; while (cond) { __builtin_amdgcn_s_sleep(1); \
    if ((++_sp & 255u) == 0u) { if (xb_ld(&(bar)[XB_TMO])) break; if (_sp > XB_SPIN_CAP) { atomicAdd(&(bar)[XB_TMO], 1u); break; } } } } while (0)

struct XcdBarrier {
    unsigned* bar; unsigned x;
    volatile LAS unsigned* st;
};

__device__ __forceinline__ XcdBarrier xcd_barrier_post(unsigned* bar, volatile LAS unsigned* st) {
    XcdBarrier b; b.bar = bar; b.x = xb_xcc_id(); b.st = st;
    if (threadIdx.x == 0) (void)xb_add(&bar[XB_XCNT(b.x)], 1u);
    return b;
}
__device__ __forceinline__ void xcd_barrier_complete(unsigned* bar, unsigned x, unsigned& nloc, unsigned& nx) {
    const unsigned G = gridDim.x * gridDim.y * gridDim.z;
    unsigned sum, cnt, mine, sp = 0u;
    for (;;) {
        sum = 0u; cnt = 0u; mine = 0u;
#pragma unroll
        for (unsigned j = 0; j < 16; ++j) { const unsigned c = xb_ld(&bar[XB_XCNT(j)]); sum += c; cnt += (c > 0u) ? 1u : 0u; mine = (j == x) ? c : mine; }
        if (sum == G) break;
        __builtin_amdgcn_s_sleep(1);
        if ((++sp & 255u) == 0u) { if (xb_ld(&bar[XB_TMO])) break; if (sp > XB_SPIN_CAP) { atomicAdd(&bar[XB_TMO], 1u); break; } }
    }
    nloc = mine > 0u ? mine : 1u; nx = cnt > 0u ? cnt : 1u;
}

__device__ __forceinline__ void xcd_barrier(const XcdBarrier& b) {
    asm volatile("s_waitcnt vmcnt(0)" ::: "memory");
    __syncthreads();
    if (threadIdx.x == 0) {
        unsigned* bar = b.bar;
        __builtin_amdgcn_s_waitcnt(0);
        unsigned nloc = b.st[0], nx = b.st[1];
        if (nloc == 0u) { xcd_barrier_complete(bar, b.x, nloc, nx); b.st[0] = nloc; b.st[1] = nx; }
        const unsigned old = xb_add(&bar[XB_XSUB(b.x)], 1u);
        const unsigned gen = old / nloc;
        if (old + 1u == (gen + 1u) * nloc) {
            __builtin_amdgcn_fence(__ATOMIC_RELEASE, "agent");
            asm volatile("s_waitcnt vmcnt(0)" ::: "memory");
            const unsigned og = xb_add(&bar[XB_TOP], 1u);
            const unsigned tg = og / nx;
            if (og + 1u == (tg + 1u) * nx) xb_add(&bar[XB_TOPGEN], 1u);
            else XB_SPIN(xb_ld(&bar[XB_TOPGEN]) == tg, bar);
            __builtin_amdgcn_fence(__ATOMIC_ACQUIRE, "agent");
            xb_add(&bar[XB_XGEN(b.x)], 1u);
            asm volatile("s_waitcnt vmcnt(0)" ::: "memory");
        } else {
            XB_SPIN(xb_ld(&bar[XB_XGEN(b.x)]) == gen, bar);
            __builtin_amdgcn_fence(__ATOMIC_ACQUIRE, "agent");
            asm volatile("s_waitcnt vmcnt(0)" ::: "memory");
        }
    }
    __syncthreads();
}

struct Args { const float* in[18]; float* out; unsigned char* ws; int ph_lo, ph_hi, li, pad; };
enum { I_X = 0, I_WIN, I_BIG, I_BFG, I_NMIX, I_RGN, I_MLN, I_QN, I_KN, I_WPA, I_WPB, I_WPC, I_WOUT, I_NFFN, I_WUP, I_CW, I_CB, I_WDN };
struct Frame {
    LAS unsigned char* lds;
    volatile LAS unsigned* MISC;
    unsigned char* ws;
    int tid, lane, wave, G, bx;
};
#define WSP(T, off) ((T*)(F.ws + (off)))
__device__ __forceinline__ float wave_sum(float v) {
#pragma unroll
    for (int o = 1; o < 64; o <<= 1) v += __shfl_xor(v, o);
    return v;
}
__device__ __forceinline__ float wave_max(float v) {
#pragma unroll
    for (int o = 1; o < 64; o <<= 1) v = fmaxf(v, __shfl_xor(v, o));
    return v;
}
__device__ __forceinline__ void p0_transpose_item(const float* W, int ldw, int K, int nblk, bf16* WT, LAS float* scr, int item, int lane, const float* gk = nullptr, unsigned char* WT8 = nullptr, int nb8 = 0) {
    const int kb = item / nblk, nb = item % nblk, k0 = 64 * kb, n0 = 32 * nb;
#pragma unroll 8
    for (int i = 0; i < 32; ++i) { const int kk = 2 * i + (lane >> 5); scr[kk * 33 + (lane & 31)] = W[(size_t)(k0 + kk) * ldw + n0 + (lane & 31)]; }
    LDS_WAIT(); asm volatile("" ::: "memory");
    const int c = lane & 7;
    f32x4 g0 = (f32x4){1.f, 1.f, 1.f, 1.f}, g1 = g0;
    if (gk) { g0 = *(const f32x4*)(gk + k0 + 8 * c); g1 = *(const f32x4*)(gk + k0 + 8 * c + 4); }
    if (WT8 && nb >= nb8) {
#pragma unroll
        for (int j = 0; j < 4; ++j) { const int n = (lane >> 3) + 8 * j; const LAS float* s = scr + (8 * c) * 33 + n; const f32x4 h0 = g0 * 64.f, h1 = g1 * 64.f;
            v2u o; o.x = (unsigned)__builtin_amdgcn_cvt_pk_fp8_f32(s[2 * 33] * h0[2], s[3 * 33] * h0[3], __builtin_amdgcn_cvt_pk_fp8_f32(s[0 * 33] * h0[0], s[1 * 33] * h0[1], 0, false), true);
            o.y = (unsigned)__builtin_amdgcn_cvt_pk_fp8_f32(s[6 * 33] * h1[2], s[7 * 33] * h1[3], __builtin_amdgcn_cvt_pk_fp8_f32(s[4 * 33] * h1[0], s[5 * 33] * h1[1], 0, false), true);
            *(GAS v2u*)(WT8 + (size_t)(n0 - 32 * nb8 + n) * K + k0 + 8 * c) = o; }
    } else
#pragma unroll
    for (int j = 0; j < 4; ++j) { const int n = (lane >> 3) + 8 * j; const LAS float* s = scr + (8 * c) * 33 + n;
        v4u o; o.x = pk2(s[0 * 33] * g0[0], s[1 * 33] * g0[1]); o.y = pk2(s[2 * 33] * g0[2], s[3 * 33] * g0[3]); o.z = pk2(s[4 * 33] * g1[0], s[5 * 33] * g1[1]); o.w = pk2(s[6 * 33] * g1[2], s[7 * 33] * g1[3]);
        *(GAS v4u*)(WT + (size_t)(n0 + n) * K + k0 + 8 * c) = o; }
    LDS_WAIT(); asm volatile("" ::: "memory");
}
__device__ __forceinline__ void p0_prologue(Frame& F, const Args& args) {
    LAS float* scr = (LAS float*)(F.lds + RING_OFF + F.wave * 16384);
    const int gw = F.bx * NWAVES + F.wave, NGW = F.G * NWAVES;
    constexpr int I_INA = 32 * 224, I_INB = 32 * 288, I_P = 16 * 64, I_OUT = 32 * 64, I_UP = 32 * 352, I_DN = 88 * 64;
    constexpr int I_LAYER = I_INA + I_INB + 3 * I_P + I_OUT + I_UP + I_DN;
    for (int it = gw; it < DEPTH * I_LAYER; it += NGW) {
        const int l = it / I_LAYER; int r = it % I_LAYER;
        const float* win = args.in[I_WIN] + (size_t)l * DM * NIN; bf16* wint = WSP(bf16, WS_WIN) + (size_t)l * NZ * DM;
        if (r < I_INA) { p0_transpose_item(win, NIN, DM, 224, wint, scr, r, F.lane, args.in[I_NMIX] + l * DM, F.ws + ws_win8(l) + (size_t)3 * DM * DM, Z_MO / 32); continue; } r -= I_INA;
        if (r < I_INB) { p0_transpose_item(win + 7184, NIN, DM, 288, wint + (size_t)7168 * DM, scr, r, F.lane, args.in[I_NMIX] + l * DM, F.ws + ws_win8(l), 96); continue; } r -= I_INB;
        if (r < I_P) { p0_transpose_item(args.in[I_WPA] + (size_t)l * 1024 * DM, DM, 1024, 64, WSP(bf16, WS_WP) + ((size_t)l * 3 + 0) * DM * 1024, scr, r, F.lane); continue; } r -= I_P;
        if (r < I_P) { p0_transpose_item(args.in[I_WPB] + (size_t)l * 1024 * DM, DM, 1024, 64, WSP(bf16, WS_WP) + ((size_t)l * 3 + 1) * DM * 1024, scr, r, F.lane); continue; } r -= I_P;
        if (r < I_P) { p0_transpose_item(args.in[I_WPC] + (size_t)l * 1024 * DM, DM, 1024, 64, WSP(bf16, WS_WP) + ((size_t)l * 3 + 2) * DM * 1024, scr, r, F.lane); continue; } r -= I_P;
        if (r < I_OUT) { p0_transpose_item(args.in[I_WOUT] + (size_t)l * DM * DM, DM, DM, 64, WSP(bf16, WS_WOUT) + (size_t)l * DM * DM, scr, r, F.lane); continue; } r -= I_OUT;
        if (r < I_UP) {
            const int nb = r % 352, tile = nb >> 3, wi = nb & 7, src = (wi < 4) ? 128 * tile + 32 * wi : DFF + 128 * tile + 32 * (wi - 4);
            p0_transpose_item(args.in[I_WUP] + (size_t)l * DM * NUP + (src - 32 * nb), NUP, DM, 352, WSP(bf16, WS_WUP) + (size_t)l * NUP * DM, scr, r, F.lane, args.in[I_NFFN] + l * DM); continue; } r -= I_UP;
        p0_transpose_item(args.in[I_WDN] + (size_t)l * DFF * DM, DM, DFF, 64, WSP(bf16, WS_WDN) + (size_t)l * DM * DFF, scr, r, F.lane);
    }
    const int gt = F.bx * (NWAVES * 64) + F.tid, NGT = F.G * NWAVES * 64;
    for (int i = gt; i < DEPTH * 16 * DM; i += NGT) { const int l = i / (16 * DM), c = (i / DM) % 16, k = i % DM; WSP(bf16, WS_W16G)[i] = (bf16)f2bf(args.in[I_WIN][((size_t)l * DM + k) * NIN + W_GATE_COL + c] * args.in[I_NMIX][l * DM + k]); }
    for (int m = gw; m < M; m += NGW) { const f32x4* xr = (const f32x4*)(args.in[I_X] + (size_t)m * DM) + F.lane; v2u* o8 = (v2u*)(WSP(bf16, WS_XB) + (size_t)m * DM) + F.lane; float s = 0.f;
        unsigned* q8 = (unsigned*)(F.ws + WS_XB8 + (size_t)m * DM) + F.lane;
#pragma unroll
        for (int j = 0; j < 8; ++j) { const f32x4 v = xr[64 * j]; s += (v.x * v.x + v.y * v.y) + (v.z * v.z + v.w * v.w); v2u w; w.x = pk2(v.x, v.y); w.y = pk2(v.z, v.w); o8[64 * j] = w;
            q8[64 * j] = (unsigned)__builtin_amdgcn_cvt_pk_fp8_f32(v.z, v.w, __builtin_amdgcn_cvt_pk_fp8_f32(v.x, v.y, 0, false), true); }
        s = wave_sum(s); if (F.lane < 32) WSP(float, WS_RS)[(size_t)m * 32 + F.lane] = (F.lane == 0) ? s : 0.f; }
    for (int i = gt; i < 2 * SEQ * 64; i += NGT) { const int which = i / (SEQ * 64), pos = (i / 64) % SEQ, d = i % 64;
        const float ex = which == 0 ? (float)d / 63.0f : (float)(2 * d) / 128.0f;
        const float inv = 1.0f / powf(10000.0f, ex); const float ang = (float)pos * inv; float s, c; sincosf(ang, &s, &c); WSP(f32x2, WS_TAB)[i] = (f32x2){c, s}; }
}
__device__ __forceinline__ void prep_phase(Frame& F, const float* qn, const float* kn, const bf16* w16g, const float* rs, const float* big, const float* bfg) {
    const int gw = F.bx * NWAVES + F.wave, NGW = F.G * NWAVES, lane = F.lane, rsub = lane >> 2, dg = lane & 3;
    const f32x2* trope = WSP(f32x2, WS_TAB) + SEQ * 64;
    for (int u = gw; u < BATCH * 16 * NH; u += NGW) {
        const int kind = 1, hh = u & 7, hb = (u >> 3) & 15, b = u >> 7;
        const float* wn = kn;
        const float* rsb = rs + (size_t)(b * SEQ + hb * 128) * 32 + 8 * dg;
        float wl[16], wh[16], s1[16], s2[16];
#pragma unroll
        for (int e = 0; e < 16; ++e) { wl[e] = wn[16 * dg + e]; wh[e] = wn[64 + 16 * dg + e]; s1[e] = 0.f; s2[e] = 0.f; }
        bf16* zb = WSP(bf16, WS_Z) + (size_t)(b * SEQ + hb * 128) * NZ + (kind ? Z_AK : Z_AQ) + hh * 128 + 16 * dg;
#pragma unroll 2
        for (int st = 0; st < 8; ++st) {
            const int r = rsub + 16 * st, pos = hb * 128 + r; bf16* zr = zb + (size_t)r * NZ;
            const v4u l0 = *(const v4u*)(zr), l1 = *(const v4u*)(zr + 8), h0 = *(const v4u*)(zr + 64), h1 = *(const v4u*)(zr + 72);
            float a[16] = {bflo(l0.x), bfhi(l0.x), bflo(l0.y), bfhi(l0.y), bflo(l0.z), bfhi(l0.z), bflo(l0.w), bfhi(l0.w), bflo(l1.x), bfhi(l1.x), bflo(l1.y), bfhi(l1.y), bflo(l1.z), bfhi(l1.z), bflo(l1.w), bfhi(l1.w)};
            float c[16] = {bflo(h0.x), bfhi(h0.x), bflo(h0.y), bfhi(h0.y), bflo(h0.z), bfhi(h0.z), bflo(h0.w), bfhi(h0.w), bflo(h1.x), bfhi(h1.x), bflo(h1.y), bfhi(h1.y), bflo(h1.z), bfhi(h1.z), bflo(h1.w), bfhi(h1.w)};
            float ss = 0.f;
#pragma unroll
            for (int e = 0; e < 16; ++e) ss += a[e] * a[e] + c[e] * c[e];
            ss += __shfl_xor(ss, 1); ss += __shfl_xor(ss, 2);
            float rq; { const f32x4 s0 = *(const f32x4*)(rsb + (size_t)r * 32), s1 = *(const f32x4*)(rsb + (size_t)r * 32 + 4); rq = ((s0[0] + s0[1]) + (s0[2] + s0[3])) + ((s1[0] + s1[1]) + (s1[2] + s1[3])); }
            rq += __shfl_xor(rq, 1); rq += __shfl_xor(rq, 2);
            const float rr = rsqrtf(rq * (1.0f / 2048.0f) + 1e-6f);
            if (hh == 0 && dg == 0) WSP(float, WS_RSTD)[b * SEQ + hb * 128 + r] = rr;
            const float rstd = rr * rsqrtf(ss * rr * rr * (1.f / 128.f) + 1e-6f);
            const f32x2* tb = trope + pos * 64 + 16 * dg;
#pragma unroll
            for (int e = 0; e < 16; ++e) { const float x1 = a[e] * rstd * wl[e], x2 = c[e] * rstd * wh[e]; const f32x2 cs = tb[e]; a[e] = x1 * cs.x - x2 * cs.y; c[e] = x1 * cs.y + x2 * cs.x; s1[e] += a[e]; s2[e] += c[e]; }
            *(v4u*)(zr) = (v4u){pk2(a[0], a[1]), pk2(a[2], a[3]), pk2(a[4], a[5]), pk2(a[6], a[7])}; *(v4u*)(zr + 8) = (v4u){pk2(a[8], a[9]), pk2(a[10], a[11]), pk2(a[12], a[13]), pk2(a[14], a[15])};
            *(v4u*)(zr + 64) = (v4u){pk2(c[0], c[1]), pk2(c[2], c[3]), pk2(c[4], c[5]), pk2(c[6], c[7])}; *(v4u*)(zr + 72) = (v4u){pk2(c[8], c[9]), pk2(c[10], c[11]), pk2(c[12], c[13]), pk2(c[14], c[15])};
        }
        if (kind) {
            float* km = WSP(float, WS_KMEAN) + (size_t)((b * NH + hh) * 16 + hb) * 128 + 16 * dg;
#pragma unroll
            for (int e = 0; e < 16; ++e) { float x = s1[e], y = s2[e];
                x += __shfl_xor(x, 4); x += __shfl_xor(x, 8); x += __shfl_xor(x, 16); x += __shfl_xor(x, 32);
                y += __shfl_xor(y, 4); y += __shfl_xor(y, 8); y += __shfl_xor(y, 16); y += __shfl_xor(y, 32);
                if (rsub == 0) { km[e] = x * (1.f / 256.f); km[64 + e] = y * (1.f / 256.f); } }
        }
    }
    for (int it = NGW - 1 - gw; it < M / 16; it += NGW) {
        const int i16 = lane & 15, g = lane >> 4; const bf16* ar = WSP(bf16, WS_XB) + (size_t)(16 * it + i16) * DM + 8 * g; const bf16* br = w16g + (size_t)i16 * DM + 8 * g;
        typedef short bf16x8_t __attribute__((ext_vector_type(8)));
        f32x4 acc = (f32x4){0.f, 0.f, 0.f, 0.f};
#pragma unroll 1
        for (int s0 = 0; s0 < DM / 32; s0 += 16) { bf16x8_t av[16], bv[16];
#pragma unroll
            for (int s = 0; s < 16; ++s) { av[s] = *(const bf16x8_t*)(ar + 32 * (s0 + s)); bv[s] = *(const bf16x8_t*)(br + 32 * (s0 + s)); }
#pragma unroll
            for (int s = 0; s < 16; ++s) acc = __builtin_amdgcn_mfma_f32_16x16x32_bf16(av[s], bv[s], acc, 0, 0, 0); }
#pragma unroll
        for (int r = 0; r < 4; ++r) { const int row = 16 * it + 4 * g + r; float ssq = 0.f;
#pragma unroll
            for (int q = 0; q < 8; ++q) { const f32x4 a = *(const f32x4*)(rs + (size_t)row * 32 + 4 * q); ssq += (a[0] + a[1]) + (a[2] + a[3]); }
            const float sr = rsqrtf(ssq * (1.0f / 2048.0f) + 1e-6f);
            const float pre = acc[r] * sr + (i16 < 8 ? big[i16 & 7] : bfg[i16 & 7]); const float sc = 15.0f * tanhf(pre * (1.0f / 15.0f));
            float o = sc; if (i16 >= 8) o = sc > 0.f ? -log1pf(__expf(-sc)) : sc - log1pf(__expf(sc));
            WSP(float, WS_GIF)[(size_t)row * 16 + i16] = o; }
    }
}
__device__ __forceinline__ void glu_fix_phase(Frame& F, const float* cw, const float* cb) {
    const bf16* SB = WSP(bf16, WS_SB); bf16* ACT = WSP(bf16, WS_ACT);
    for (int gI = F.bx; gI < M / 128; gI += F.G) {
        const bool first = ((gI * 128) & (SEQ - 1)) == 0; const bf16* sb = SB + (size_t)gI * 4 * NUP;
        for (int it = F.tid; it < 2 * (DFF / 8); it += NWAVES * 64) {
            const int i = it / (DFF / 8), c8 = (it % (DFF / 8)) * 8;
            float r[2][8];
#pragma unroll
            for (int hf = 0; hf < 2; ++hf) { const int col = hf * DFF + c8;
                const f32x4 b0 = *(const f32x4*)(cb + col), b1 = *(const f32x4*)(cb + col + 4);
                float a[8] = {b0.x, b0.y, b0.z, b0.w, b1.x, b1.y, b1.z, b1.w};
#pragma unroll
                for (int j = 0; j < 3; ++j) { const int slot = i + j;
                    if (slot >= 2 || !first) { const v4u uw = *(const v4u*)(sb + (size_t)slot * NUP + col); const f32x4 w0 = *(const f32x4*)(cw + (size_t)j * NUP + col), w1 = *(const f32x4*)(cw + (size_t)j * NUP + col + 4);
                        a[0] += bflo(uw.x) * w0.x; a[1] += bfhi(uw.x) * w0.y; a[2] += bflo(uw.y) * w0.z; a[3] += bfhi(uw.y) * w0.w; a[4] += bflo(uw.z) * w1.x; a[5] += bfhi(uw.z) * w1.y; a[6] += bflo(uw.w) * w1.z; a[7] += bfhi(uw.w) * w1.w; } }
#pragma unroll
                for (int e = 0; e < 8; ++e) r[hf][e] = a[e]; }
            float o[8];
#pragma unroll
            for (int e = 0; e < 8; ++e) o[e] = r[0][e] * __builtin_amdgcn_rcpf(1.0f + __expf(-r[0][e])) * r[1][e];
            *(v4u*)(ACT + (size_t)(gI * 128 + i) * DFF + c8) = (v4u){pk2(o[0], o[1]), pk2(o[2], o[3]), pk2(o[4], o[5]), pk2(o[6], o[7])};
        }
    }
}
namespace mx {
typedef short bf16x8 __attribute__((ext_vector_type(8)));
typedef short s16x4 __attribute__((ext_vector_type(4)));
#define MFMA16(a, b, c) __builtin_amdgcn_mfma_f32_16x16x32_bf16((a), (b), (c), 0, 0, 0)
#define LDS_FENCE() asm volatile("s_waitcnt lgkmcnt(0)" ::: "memory")
#define SCHED_FENCE() __builtin_amdgcn_sched_barrier(0)
__device__ __forceinline__ bf16x8 frag_row(const LAS bf16* X, int ld, int r0, int c0, int lane) {
    return *(const LAS bf16x8*)(X + (r0 + (lane & 15)) * ld + c0 + 8 * (lane >> 4)); }
__device__ __forceinline__ bf16x8 frag_tr(const LAS bf16* X, int ld, int k0, int c0, int lane) {
    const int g = lane >> 4, q = (lane & 15) >> 2, p = lane & 3;
    const LAS bf16* a = X + (k0 + 8 * g + q) * ld + c0 + 4 * p;
    const s16x4 lo = __builtin_amdgcn_ds_read_tr16_b64_v4i16((LAS s16x4*)a);
    const s16x4 hi = __builtin_amdgcn_ds_read_tr16_b64_v4i16((LAS s16x4*)(a + 4 * ld));
    return __builtin_shufflevector(lo, hi, 0, 1, 2, 3, 4, 5, 6, 7);
}
__device__ __forceinline__ int trs_off(int row, int chunk) { return row * 128 + ((chunk ^ (((row & 3) << 1) | (((row >> 3) & 1) << 3))) << 3); }
__device__ __forceinline__ bf16x8 frag_trs(const LAS bf16* X, int k0, int c0, int lane) {
    const int g = lane >> 4, q = (lane & 15) >> 2, p = lane & 3;
    const LAS bf16* a = X + trs_off(k0 + 8 * g + q, (c0 >> 3) + (p >> 1)) + 4 * (p & 1);
    const s16x4 lo = __builtin_amdgcn_ds_read_tr16_b64_v4i16((LAS s16x4*)a);
    const s16x4 hi = __builtin_amdgcn_ds_read_tr16_b64_v4i16((LAS s16x4*)(a + 4 * 128));
    return __builtin_shufflevector(lo, hi, 0, 1, 2, 3, 4, 5, 6, 7);
}
template <int CTRL> __device__ __forceinline__ float dppf(float v) { return __builtin_bit_cast(float, __builtin_amdgcn_update_dpp(0, __builtin_bit_cast(int, v), CTRL, 0xf, 0xf, true)); }
__device__ __forceinline__ float r16max(float v) { v = fmaxf(v, dppf<0xB1>(v)); v = fmaxf(v, dppf<0x4E>(v)); v = fmaxf(v, dppf<0x141>(v)); v = fmaxf(v, dppf<0x140>(v)); return v; }
__device__ __forceinline__ float r16sum(float v) { v += dppf<0xB1>(v); v += dppf<0x4E>(v); v += dppf<0x141>(v); v += dppf<0x140>(v); return v; }
__device__ __forceinline__ float red16_sum(float v) { return r16sum(v); }
__device__ __forceinline__ float red16_max(float v) { return r16max(v); }
__device__ __forceinline__ void rot8(const v4u lo, const v4u hi, const f32x2* tb, float sc, v4u& olo, v4u& ohi) {
    float a[8] = {bflo(lo.x), bfhi(lo.x), bflo(lo.y), bfhi(lo.y), bflo(lo.z), bfhi(lo.z), bflo(lo.w), bfhi(lo.w)};
    float c[8] = {bflo(hi.x), bfhi(hi.x), bflo(hi.y), bfhi(hi.y), bflo(hi.z), bfhi(hi.z), bflo(hi.w), bfhi(hi.w)};
    float o1[8], o2[8];
#pragma unroll
    for (int e = 0; e < 8; ++e) { const f32x2 cs = tb[e]; o1[e] = (a[e] * cs.x - c[e] * cs.y) * sc; o2[e] = (a[e] * cs.y + c[e] * cs.x) * sc; }
    olo = (v4u){pk2(o1[0], o1[1]), pk2(o1[2], o1[3]), pk2(o1[4], o1[5]), pk2(o1[6], o1[7])};
    ohi = (v4u){pk2(o2[0], o2[1]), pk2(o2[2], o2[3]), pk2(o2[4], o2[5]), pk2(o2[6], o2[7])};
}
constexpr int LQ = 144;
__device__ __forceinline__ void ret_unit(Frame& F, const float* gn, int b, int h) {
    LAS bf16* Qs = (LAS bf16*)(F.lds); LAS bf16* Ks = Qs + 128 * LQ; LAS bf16* Vs = Ks + 128 * LQ; LAS bf16* Ts = Vs + 128 * LQ;
    const int tid = F.tid, lane = F.lane, w = tid >> 6, i16 = lane & 15, g = lane >> 4;
    const float gamma = 1.0f - exp2f(-5.0f - (float)h), lg = log2f(gamma);
    const float gC = exp2f(lg * 128.0f);
    f32x4 accT[8];
#pragma unroll
    for (int n = 0; n < 8; ++n) accT[n] = (f32x4){0.f, 0.f, 0.f, 0.f};
    for (int i = tid; i < 128 * LQ / 8; i += NWAVES * 64) ((LAS v4u*)Ts)[i] = (v4u){0u, 0u, 0u, 0u};
    const bf16* zb = WSP(bf16, WS_Z) + (size_t)(b * SEQ) * NZ + h * 128;
    const f32x2* tret = WSP(f32x2, WS_TAB);
    bf16* yb = WSP(bf16, WS_Y) + (size_t)(b * SEQ) * 1024 + h * 128;
    const int lr = tid >> 2, dg = tid & 3;
    v4u pq[4], pk[4], pv[4]; float prr;
    const float* rstd1 = WSP(float, WS_RSTD) + (size_t)(b * SEQ);
#define RET_FETCH(t0_) do { const bf16* zr_ = zb + (size_t)((t0_) + lr) * NZ; \
        pq[0] = *(const v4u*)(zr_ + Z_RQ + 16 * dg); pq[1] = *(const v4u*)(zr_ + Z_RQ + 64 + 16 * dg); pq[2] = *(const v4u*)(zr_ + Z_RQ + 16 * dg + 8); pq[3] = *(const v4u*)(zr_ + Z_RQ + 64 + 16 * dg + 8); \
        pk[0] = *(const v4u*)(zr_ + Z_RK + 16 * dg); pk[1] = *(const v4u*)(zr_ + Z_RK + 64 + 16 * dg); pk[2] = *(const v4u*)(zr_ + Z_RK + 16 * dg + 8); pk[3] = *(const v4u*)(zr_ + Z_RK + 64 + 16 * dg + 8); \
        _Pragma("unroll") for (int q_ = 0; q_ < 4; ++q_) pv[q_] = *(const v4u*)(zr_ + Z_RV + 32 * dg + 8 * q_); prr = rstd1[(t0_) + lr]; } while (0)
    RET_FETCH(0);
    const float sq = exp2f(lg * (float)lr), sk = exp2f(-lg * (float)lr) * 0.08838834764831845f;
    float gnv[8];
#pragma unroll
    for (int n = 0; n < 8; ++n) gnv[n] = gn[h * 128 + 16 * n + i16];
    for (int c = 0; c < SEQ / 128; ++c) {
        const int t0 = c * 128;
        {
            const f32x2* tb = tret + (t0 + lr) * 64 + 16 * dg;
#pragma unroll
            for (int hh = 0; hh < 2; ++hh) {
                v4u o1, o2; rot8(pq[2 * hh], pq[2 * hh + 1], tb + 8 * hh, sq * prr, o1, o2);
                *(LAS v4u*)(Qs + lr * LQ + 16 * dg + 8 * hh) = o1; *(LAS v4u*)(Qs + lr * LQ + 64 + 16 * dg + 8 * hh) = o2;
                rot8(pk[2 * hh], pk[2 * hh + 1], tb + 8 * hh, sk * prr * prr, o1, o2);
                *(LAS v4u*)(Ks + lr * LQ + 16 * dg + 8 * hh) = o1; *(LAS v4u*)(Ks + lr * LQ + 64 + 16 * dg + 8 * hh) = o2;
            }
#pragma unroll
            for (int q = 0; q < 4; ++q) *(LAS v4u*)(Vs + lr * LQ + 32 * dg + 8 * q) = pv[q];
            if (c + 1 < SEQ / 128) RET_FETCH(t0 + 128);
        }
        __syncthreads();
        bf16x8 aq[4];
#pragma unroll
        for (int s = 0; s < 4; ++s) aq[s] = frag_row(Qs, LQ, 16 * w, 32 * s, lane);
        f32x4 acco[8];
#pragma unroll
        for (int n = 0; n < 8; ++n) acco[n] = (f32x4){0.f, 0.f, 0.f, 0.f};
#pragma unroll
        for (int s = 0; s < 4; ++s) { bf16x8 bb[8];
#pragma unroll
            for (int n = 0; n < 8; ++n) bb[n] = frag_tr(Ts, LQ, 32 * s, 16 * n, lane);
            SCHED_FENCE();
#pragma unroll
            for (int n = 0; n < 8; ++n) acco[n] = MFMA16(aq[s], bb[n], acco[n]); }
        LDS_FENCE();
#pragma unroll
        for (int n = 0; n < 8; ++n) {
            if (n <= w) { f32x4 sa = (f32x4){0.f, 0.f, 0.f, 0.f}; bf16x8 bb[4];
#pragma unroll
                for (int s = 0; s < 4; ++s) bb[s] = frag_row(Ks, LQ, 16 * n, 32 * s, lane);
                SCHED_FENCE();
#pragma unroll
                for (int s = 0; s < 4; ++s) sa = MFMA16(aq[s], bb[s], sa);
#pragma unroll
                for (int r = 0; r < 4; ++r) { const int i = 16 * w + 4 * g + r, j = 16 * n + i16; Qs[i * LQ + j] = (bf16)f2bf(j <= i ? sa[r] : 0.f); } }
            else if (n == w + 1) {
#pragma unroll
                for (int r = 0; r < 4; ++r) Qs[(16 * w + 4 * g + r) * LQ + 16 * n + i16] = (bf16)0; }
        }
        LDS_FENCE();
#pragma unroll
        for (int n = 0; n < 8; ++n) accT[n] = accT[n] * gC;
#pragma unroll
        for (int s = 0; s < 4; ++s) { const bf16x8 ak = frag_tr(Ks, LQ, 32 * s, 16 * w, lane); const bool doi = (s <= (w >> 1)); bf16x8 as = ak; bf16x8 bb[8];
            if (doi) as = frag_row(Qs, LQ, 16 * w, 32 * s, lane);
#pragma unroll
            for (int n = 0; n < 8; ++n) bb[n] = frag_tr(Vs, LQ, 32 * s, 16 * n, lane);
            SCHED_FENCE();
            if (doi) {
#pragma unroll
                for (int n = 0; n < 8; ++n) acco[n] = MFMA16(as, bb[n], acco[n]); }
#pragma unroll
            for (int n = 0; n < 8; ++n) accT[n] = MFMA16(ak, bb[n], accT[n]); }
        bf16 gvr[4][8]; float rrv[4];
#pragma unroll
        for (int r = 0; r < 4; ++r) { const int pos = t0 + 16 * w + 4 * g + r; const bf16* gr = zb + (size_t)pos * NZ + Z_RG + i16; rrv[r] = rstd1[pos];
#pragma unroll
            for (int n = 0; n < 8; ++n) gvr[r][n] = gr[16 * n]; }
        LDS_FENCE();
        __syncthreads();
#pragma unroll
        for (int n = 0; n < 8; ++n)
#pragma unroll
            for (int r = 0; r < 4; ++r) Ts[(16 * w + 4 * g + r) * LQ + 16 * n + i16] = (bf16)f2bf(gC * accT[n][r]);
#pragma unroll
        for (int r = 0; r < 4; ++r) {
            float s = 0.f;
#pragma unroll
            for (int n = 0; n < 8; ++n) s += acco[n][r];
            const float mean = red16_sum(s) * (1.f / 128.f); float q = 0.f;
#pragma unroll
            for (int n = 0; n < 8; ++n) { const float d = acco[n][r] - mean; q += d * d; }
            const float rstd = rsqrtf(red16_sum(q) * (1.f / 128.f) + 1e-5f);
            const int pos = t0 + 16 * w + 4 * g + r; bf16* yr = yb + (size_t)pos * 1024; const float rri = rrv[r];
#pragma unroll
            for (int n = 0; n < 8; ++n) { const int e = 16 * n + i16; const float gv = bf1(gvr[r][n]) * rri; yr[e] = (bf16)f2bf((acco[n][r] - mean) * rstd * gnv[n] * gv * sigm(gv)); }
        }
    }
    __syncthreads();
#undef RET_FETCH
}
constexpr int LK = 72, LV = 168;
__device__ __forceinline__ float scan64_sum(float x, int lane) {
#pragma unroll
    for (int o = 1; o < 64; o <<= 1) { const float y = __shfl_up(x, o); if (lane >= o) x += y; }
    return x; }
__device__ __forceinline__ float scan64_max(float x, int lane) {
#pragma unroll
    for (int o = 1; o < 64; o <<= 1) { const float y = __shfl_up(x, o); if (lane >= o) x = fmaxf(x, y); }
    return x; }
__device__ __forceinline__ void mlstm_unit(Frame& F, const float* nw, int b, int h) {
    LAS bf16* Qm = (LAS bf16*)(F.lds); LAS bf16* Km = Qm + 128 * LK; LAS bf16* Kw = Km + 128 * LK; LAS bf16* Vm = Kw + 128 * LK; LAS bf16* Pm = Vm + 128 * LV; LAS bf16* Cm = Pm + 128 * LQ;
    const int tid = F.tid, lane = F.lane, w = F.wave, i16 = lane & 15, g = lane >> 4;
    const int dt = w & 3, eh = w >> 2;
    f32x4 accC[5];
#pragma unroll
    for (int k = 0; k < 5; ++k) accC[k] = (f32x4){0.f, 0.f, 0.f, 0.f};
    for (int i = tid; i < 64 * LV / 8; i += NWAVES * 64) ((LAS v4u*)Cm)[i] = (v4u){0u, 0u, 0u, 0u};
    float m_prev = 0.f;
    const bf16* zb = WSP(bf16, WS_Z) + (size_t)(b * SEQ) * NZ;
    const float* gif = WSP(float, WS_GIF) + (size_t)(b * SEQ) * 16;
    bf16* yb = WSP(bf16, WS_Y) + (size_t)M * 1024 + (size_t)(b * SEQ) * 1024 + h * 128;
    const int lr = tid >> 2, dg = tid & 3;
    v4u pq[2], pk[2]; float fl0, fl1, il0, il1, prr;
    const float* rstd1 = WSP(float, WS_RSTD) + (size_t)(b * SEQ);
#define ML_FETCH(t0_) do { const bf16* zr_ = zb + (size_t)((t0_) + lr) * NZ; \
        pq[0] = *(const v4u*)(zr_ + Z_MQ + h * 64 + 16 * dg); pq[1] = *(const v4u*)(zr_ + Z_MQ + h * 64 + 16 * dg + 8); pk[0] = *(const v4u*)(zr_ + Z_MK + h * 64 + 16 * dg); pk[1] = *(const v4u*)(zr_ + Z_MK + h * 64 + 16 * dg + 8); \
        fl0 = gif[(size_t)((t0_) + lane) * 16 + 8 + h]; fl1 = gif[(size_t)((t0_) + 64 + lane) * 16 + 8 + h]; il0 = gif[(size_t)((t0_) + lane) * 16 + h]; il1 = gif[(size_t)((t0_) + 64 + lane) * 16 + h]; prr = rstd1[(t0_) + lr]; } while (0)
    ML_FETCH(0);
    float nwv[8];
#pragma unroll
    for (int n = 0; n < 8; ++n) nwv[n] = nw[h * 128 + 16 * n + i16];
    for (int c = 0; c < SEQ / 128; ++c) {
        const int t0 = c * 128;
        const float a0 = scan64_sum(fl0, lane); const float a1 = scan64_sum(fl1, lane) + __shfl(a0, 63);
        const float b0 = il0 - a0, b1 = il1 - a1;
        const float pm0 = scan64_max(b0, lane); const float pm1 = fmaxf(scan64_max(b1, lane), __shfl(pm0, 63));
        const float a_last = __shfl(a1, 63), bmax = __shfl(pm1, 63);
        const float g_n = a_last + bmax, m_new = fmaxf(a_last + m_prev, g_n), s_old = __expf(a_last + m_prev - m_new), s_new = __expf(g_n - m_new);
        {
            const int r = lr;
            const float br = (r < 64) ? __shfl(b0, r & 63) : __shfl(b1, r & 63);
            const float rk = prr * 0.125f, wk = __expf(br - bmax) * rk * s_new;
#pragma unroll
            for (int hh = 0; hh < 2; ++hh) {
                *(LAS v4u*)(Qm + r * LK + 16 * dg + 8 * hh) = pq[hh];
                const v4u kk = pk[hh];
                float kf[8] = {bflo(kk.x), bfhi(kk.x), bflo(kk.y), bfhi(kk.y), bflo(kk.z), bfhi(kk.z), bflo(kk.w), bfhi(kk.w)};
                *(LAS v4u*)(Km + r * LK + 16 * dg + 8 * hh) = (v4u){pk2(kf[0] * rk, kf[1] * rk), pk2(kf[2] * rk, kf[3] * rk), pk2(kf[4] * rk, kf[5] * rk), pk2(kf[6] * rk, kf[7] * rk)};
                *(LAS v4u*)(Kw + r * LK + 16 * dg + 8 * hh) = (v4u){pk2(kf[0] * wk, kf[1] * wk), pk2(kf[2] * wk, kf[3] * wk), pk2(kf[4] * wk, kf[5] * wk), pk2(kf[6] * wk, kf[7] * wk)};
            }
#pragma unroll
            for (int q = 0; q < 4; ++q) { const v4u x = *(const v4u*)(zb + (size_t)(t0 + r) * NZ + Z_MV + h * 128 + 32 * dg + 8 * q); const float rv = prr;
                *(LAS v4u*)(Vm + r * LV + 32 * dg + 8 * q) = (v4u){pk2(bflo(x.x) * rv, bfhi(x.x) * rv), pk2(bflo(x.y) * rv, bfhi(x.y) * rv), pk2(bflo(x.z) * rv, bfhi(x.z) * rv), pk2(bflo(x.w) * rv, bfhi(x.w) * rv)}; }
            *(LAS v4u*)(Vm + r * LV + 128 + 8 * dg) = (v4u){dg == 0 ? 0x00003f80u : 0u, 0u, 0u, 0u};
            if (c + 1 < SEQ / 128) ML_FETCH(t0 + 128);
        }
        __syncthreads();
        float Mi[4], ai[4], rri[4];
#pragma unroll
        for (int r = 0; r < 4; ++r) { const int i = 16 * w + 4 * g + r; rri[r] = rstd1[t0 + i]; const float pmi = (w < 4) ? __shfl(pm0, i & 63) : __shfl(pm1, i & 63); ai[r] = (w < 4) ? __shfl(a0, i & 63) : __shfl(a1, i & 63); Mi[r] = fmaxf(pmi, m_prev); }
        bf16x8 aq[2];
#pragma unroll
        for (int s = 0; s < 2; ++s) aq[s] = frag_row(Qm, LK, 16 * w, 32 * s, lane);
        f32x4 acco[9];
#pragma unroll
        for (int n = 0; n < 9; ++n) acco[n] = (f32x4){0.f, 0.f, 0.f, 0.f};
#pragma unroll
        for (int s = 0; s < 2; ++s) {
#pragma unroll
          for (int hf = 0; hf < 2; ++hf) { bf16x8 bb[5];
#pragma unroll
            for (int n = 0; n < 5 - hf; ++n) bb[n] = frag_tr(Cm, LV, 32 * s, 16 * (5 * hf + n), lane);
            SCHED_FENCE();
#pragma unroll
            for (int n = 0; n < 5 - hf; ++n) acco[5 * hf + n] = MFMA16(aq[s], bb[n], acco[5 * hf + n]); } }
        { float si[4];
#pragma unroll
          for (int r = 0; r < 4; ++r) si[r] = __expf(m_prev - Mi[r]) * rri[r];
#pragma unroll
          for (int n = 0; n < 9; ++n)
#pragma unroll
            for (int r = 0; r < 4; ++r) acco[n][r] *= si[r]; }
        LDS_FENCE();
#pragma unroll
        for (int n = 0; n < 8; ++n) {
            if (n <= w) { f32x4 sa = (f32x4){0.f, 0.f, 0.f, 0.f}; bf16x8 bb[2];
#pragma unroll
                for (int s = 0; s < 2; ++s) bb[s] = frag_row(Km, LK, 16 * n, 32 * s, lane);
                SCHED_FENCE();
#pragma unroll
                for (int s = 0; s < 2; ++s) sa = MFMA16(aq[s], bb[s], sa);
                const int j = 16 * n + i16; const float bj = (n < 4) ? __shfl(b0, j & 63) : __shfl(b1, j & 63);
#pragma unroll
                for (int r = 0; r < 4; ++r) { const int i = 16 * w + 4 * g + r; Pm[i * LQ + j] = (bf16)f2bf(j <= i ? sa[r] * rri[r] * __expf(bj - Mi[r]) : 0.f); } }
            else if (n == w + 1) {
#pragma unroll
                for (int r = 0; r < 4; ++r) Pm[(16 * w + 4 * g + r) * LQ + 16 * n + i16] = (bf16)0; }
        }
        LDS_FENCE();
#pragma unroll
        for (int k = 0; k < 5; ++k) accC[k] = accC[k] * s_old;
#pragma unroll
        for (int s = 0; s < 4; ++s) { const bf16x8 ak = frag_tr(Kw, LK, 32 * s, 16 * dt, lane); const bool doi = (s <= (w >> 1)); bf16x8 ap = ak;
            if (doi) ap = frag_row(Pm, LQ, 16 * w, 32 * s, lane);
#pragma unroll
          for (int hf = 0; hf < 2; ++hf) { const bool dos = (hf == eh);
            if (doi || dos) { bf16x8 bb[5];
#pragma unroll
              for (int n = 0; n < 5; ++n) bb[n] = frag_tr(Vm, LV, 32 * s, 16 * (5 * hf + n), lane);
              SCHED_FENCE();
              if (doi) {
#pragma unroll
                for (int n = 0; n < 5 - hf; ++n) acco[5 * hf + n] = MFMA16(ap, bb[n], acco[5 * hf + n]); }
              if (dos) {
#pragma unroll
                for (int k = 0; k < 5; ++k) accC[k] = MFMA16(ak, bb[k], accC[k]); } } } }
        bf16 gvr[4][8];
#pragma unroll
        for (int r = 0; r < 4; ++r) { const bf16* gr = zb + (size_t)(t0 + 16 * w + 4 * g + r) * NZ + Z_MO + h * 128 + i16;
#pragma unroll
            for (int n = 0; n < 8; ++n) gvr[r][n] = gr[16 * n]; }
        LDS_FENCE();
        __syncthreads();
#pragma unroll
        for (int k = 0; k < 5; ++k)
#pragma unroll
            for (int r = 0; r < 4; ++r) Cm[(16 * dt + 4 * g + r) * LV + 16 * (5 * eh + k) + i16] = (bf16)f2bf(accC[k][r]);
#pragma unroll
        for (int r = 0; r < 4; ++r) {
            const float den = __shfl(acco[8][r], lane & 48);
            const float dd = 1.0f / fmaxf(fabsf(den), __expf(-(ai[r] + Mi[r])));
            float q = 0.f;
#pragma unroll
            for (int n = 0; n < 8; ++n) { acco[n][r] *= dd; q += acco[n][r] * acco[n][r]; }
            const float rstd = rsqrtf(red16_sum(q) * (1.f / 128.f) + 1e-6f);
            const int pos = t0 + 16 * w + 4 * g + r; bf16* yr = yb + (size_t)pos * 1024;
#pragma unroll
            for (int n = 0; n < 8; ++n) { const int e = 16 * n + i16; yr[e] = (bf16)f2bf(acco[n][r] * rstd * nwv[n] * sigm(bf1(gvr[r][n]) * rri[r])); }
        }
        m_prev = m_new;
    }
    __syncthreads();
#undef ML_FETCH
}
__device__ __forceinline__ int vt_off(int row, int chunk) { return row * 128 + ((chunk ^ ((row & 7) << 1)) << 3); }
__device__ __forceinline__ bf16x8 frag_trp(const LAS bf16* X, int k0, int c0, int lane) {
    const int g = lane >> 4, q = (lane & 15) >> 2, p = lane & 3;
    const LAS bf16* a = X + vt_off(k0 + 4 * g + q, (c0 >> 3) + (p >> 1)) + 4 * (p & 1);
    const s16x4 lo = __builtin_amdgcn_ds_read_tr16_b64_v4i16((LAS s16x4*)a);
    const s16x4 hi = __builtin_amdgcn_ds_read_tr16_b64_v4i16((LAS s16x4*)(a + 16 * 128));
    return __builtin_shufflevector(lo, hi, 0, 1, 2, 3, 4, 5, 6, 7);
}
__device__ __forceinline__ void moba_unit(Frame& F, const float* qn, int b, int h, int qi) {
    constexpr int KT_E = 128 * LQ, VT_E = 128 * 128;
    LAS bf16* Kt0 = (LAS bf16*)(F.lds); LAS bf16* Vt0 = Kt0 + 2 * KT_E; LAS float* RR = (LAS float*)(Vt0 + 2 * VT_E);
    const int tid = F.tid, lane = F.lane, w = tid >> 6, i16 = lane & 15, g = lane >> 4;
    const int blk = qi >> 1, qt = qi & 1, q0 = qi * 128;
    const bf16* zb = WSP(bf16, WS_Z) + (size_t)(b * SEQ) * NZ + h * 128;
    bf16x8 aq[4];
    { const bf16* qr = zb + (size_t)(q0 + 16 * w + i16) * NZ + Z_AQ + 8 * g;
#pragma unroll
      for (int s = 0; s < 4; ++s) aq[s] = *(const bf16x8*)(qr + 32 * s); }
    const int lr = tid >> 2, dg = tid & 3;
    v4u pk[4], pv[4]; float prr;
    const float* rstdb = WSP(float, WS_RSTD) + (size_t)(b * SEQ);
#define MB_FETCH(k0_) do { const bf16* zr_ = zb + (size_t)((k0_) + lr) * NZ + 32 * dg; \
        _Pragma("unroll") for (int q_ = 0; q_ < 4; ++q_) { pk[q_] = *(const v4u*)(zr_ + Z_AK + 8 * q_); pv[q_] = *(const v4u*)(zr_ + Z_AV + 8 * q_); } prr = rstdb[(k0_) + lr]; } while (0)
#define MB_STAGE(buf_) do { LAS bf16* kd_ = Kt0 + (buf_) * KT_E + lr * LQ + 32 * dg; LAS bf16* vd_ = Vt0 + (buf_) * VT_E; \
        _Pragma("unroll") for (int q_ = 0; q_ < 4; ++q_) { *(LAS v4u*)(kd_ + 8 * q_) = pk[q_]; *(LAS v4u*)(vd_ + vt_off(lr, 4 * dg + q_)) = pv[q_]; } if (dg == 0) RR[(buf_) * 128 + lr] = prr; } while (0)
    MB_FETCH(0);
    { float ss = 0.f; float qf[4][8];
#pragma unroll
      for (int s = 0; s < 4; ++s) { const v4u x = __builtin_bit_cast(v4u, aq[s]); qf[s][0] = bflo(x.x); qf[s][1] = bfhi(x.x); qf[s][2] = bflo(x.y); qf[s][3] = bfhi(x.y); qf[s][4] = bflo(x.z); qf[s][5] = bfhi(x.z); qf[s][6] = bflo(x.w); qf[s][7] = bfhi(x.w);
#pragma unroll
          for (int j = 0; j < 8; ++j) ss += qf[s][j] * qf[s][j]; }
      ss += __shfl_xor(ss, 16); ss += __shfl_xor(ss, 32);
      const int pos = q0 + 16 * w + i16; const float rr = rstdb[pos]; const float f = rr * rsqrtf(ss * rr * rr * (1.f / 128.f) + 1e-6f);
      const f32x2* tb = WSP(f32x2, WS_TAB) + SEQ * 64 + pos * 64 + 8 * g;
#pragma unroll
      for (int s = 0; s < 2; ++s) {
#pragma unroll
          for (int j = 0; j < 8; ++j) { const float x1 = qf[s][j] * f * qn[32 * s + 8 * g + j], x2 = qf[s + 2][j] * f * qn[64 + 32 * s + 8 * g + j]; const f32x2 cs = tb[32 * s + j];
              qf[s][j] = x1 * cs.x - x2 * cs.y; qf[s + 2][j] = x1 * cs.y + x2 * cs.x; } }
#pragma unroll
      for (int s = 0; s < 4; ++s) { const v4u o = (v4u){pk2(qf[s][0], qf[s][1]), pk2(qf[s][2], qf[s][3]), pk2(qf[s][4], qf[s][5]), pk2(qf[s][6], qf[s][7])}; aq[s] = __builtin_bit_cast(bf16x8, o); } }
    unsigned sel = 0u;
    {
        f32x4 gacc = (f32x4){0.f, 0.f, 0.f, 0.f};
        const float* km = WSP(float, WS_KMEAN) + (size_t)((b * NH + h) * 16) * 128 + (size_t)(i16 & 7) * 256 + 8 * g;
        const bool live = i16 < blk;
#pragma unroll
        for (int s = 0; s < 4; ++s) { f32x4 k0 = (f32x4){0.f, 0.f, 0.f, 0.f}, k1 = k0;
            if (live) { k0 = *(const f32x4*)(km + 32 * s) + *(const f32x4*)(km + 128 + 32 * s); k1 = *(const f32x4*)(km + 32 * s + 4) + *(const f32x4*)(km + 128 + 32 * s + 4); }
            const v4u hi = (v4u){pk2(k0.x, k0.y), pk2(k0.z, k0.w), pk2(k1.x, k1.y), pk2(k1.z, k1.w)};
            const v4u lo = (v4u){pk2(k0.x - bflo(hi.x), k0.y - bfhi(hi.x)), pk2(k0.z - bflo(hi.y), k0.w - bfhi(hi.y)), pk2(k1.x - bflo(hi.z), k1.y - bfhi(hi.z)), pk2(k1.z - bflo(hi.w), k1.w - bfhi(hi.w))};
            gacc = MFMA16(__builtin_bit_cast(bf16x8, hi), aq[s], gacc); gacc = MFMA16(__builtin_bit_cast(bf16x8, lo), aq[s], gacc); }
        float gate[8];
#pragma unroll
        for (int n = 0; n < 8; ++n) { const float gv = __shfl(gacc[n & 3], i16 + 16 * (n >> 2)); gate[n] = (n < blk) ? gv : -INFINITY; }
#pragma unroll
        for (int s = 0; s < 3; ++s) { float bv = -INFINITY; int best = -1;
#pragma unroll
            for (int n = 0; n < 8; ++n) { const bool c = !((sel >> n) & 1u) && gate[n] > bv; bv = c ? gate[n] : bv; best = c ? n : best; }
            if (best >= 0) sel |= 1u << best; }
    }
#pragma unroll
    for (int s = 0; s < 4; ++s) { const v4u u = __builtin_bit_cast(v4u, aq[s]); const float c2 = 0.08838834764831845f * 1.4426950408889634f;
        const v4u o = (v4u){pk2(bflo(u.x) * c2, bfhi(u.x) * c2), pk2(bflo(u.y) * c2, bfhi(u.y) * c2), pk2(bflo(u.z) * c2, bfhi(u.z) * c2), pk2(bflo(u.w) * c2, bfhi(u.w) * c2)}; aq[s] = __builtin_bit_cast(bf16x8, o); }
    f32x4 acco[8];
#pragma unroll
    for (int n = 0; n < 8; ++n) acco[n] = (f32x4){0.f, 0.f, 0.f, 0.f};
    float mq = -1e30f, lq = 0.f;
    const int ntiles = 2 * blk + qt + 1;
    const int qrel = 16 * w + i16 - 4 * g;
    __syncthreads();
    MB_STAGE(0);
    if (ntiles > 1) MB_FETCH(128);
    __syncthreads();
    for (int kt = 0; kt < ntiles; ++kt) {
        const int kb = kt >> 1; const bool own = (kb == blk), diag = (kt == 2 * blk + qt);
        const LAS bf16* Kt = Kt0 + (kt & 1) * KT_E; const LAS bf16* Vt = Vt0 + (kt & 1) * VT_E;
        f32x4 sc[8];
#pragma unroll
        for (int n = 0; n < 8; ++n) sc[n] = (f32x4){0.f, 0.f, 0.f, 0.f};
#pragma unroll
        for (int s = 0; s < 4; ++s) { bf16x8 bb[8];
#pragma unroll
            for (int n = 0; n < 8; ++n) bb[n] = frag_row(Kt, LQ, 16 * n, 32 * s, lane);
            SCHED_FENCE();
#pragma unroll
            for (int n = 0; n < 8; ++n) sc[n] = MFMA16(bb[n], aq[s], sc[n]); }
        if (diag) {
#pragma unroll
            for (int n = 0; n < 8; ++n)
#pragma unroll
                for (int r = 0; r < 4; ++r) sc[n][r] = (16 * n + r <= qrel) ? sc[n][r] : -1e30f; }
        const bool rowok = own || ((sel >> kb) & 1u);
        float mx = -1e30f;
#pragma unroll
        for (int n = 0; n < 8; ++n) mx = fmaxf(mx, fmaxf(fmaxf(sc[n][0], sc[n][1]), fmaxf(sc[n][2], sc[n][3])));
        mx = fmaxf(mx, __shfl_xor(mx, 16)); mx = fmaxf(mx, __shfl_xor(mx, 32));
        const float mnew = rowok ? fmaxf(mq, mx) : mq;
        const float alpha = __builtin_amdgcn_exp2f(mq - mnew); mq = mnew;
        const float msub = rowok ? mnew : 1e30f;
        float ps = 0.f;
#pragma unroll
        for (int n = 0; n < 8; ++n)
#pragma unroll
            for (int r = 0; r < 4; ++r) { sc[n][r] = __builtin_amdgcn_exp2f(sc[n][r] - msub); ps += sc[n][r]; }
        lq = lq * alpha + ps;
        { const LAS float* rrt = RR + (kt & 1) * 128 + 4 * g;
#pragma unroll
          for (int n = 0; n < 8; ++n) sc[n] = sc[n] * *(const LAS f32x4*)(rrt + 16 * n); }
        if (!__all(alpha == 1.0f)) {
#pragma unroll
            for (int n = 0; n < 8; ++n) acco[n] = acco[n] * alpha; }
#pragma unroll
        for (int t = 0; t < 4; ++t) {
            const v4u pw = (v4u){pk2(sc[2 * t][0], sc[2 * t][1]), pk2(sc[2 * t][2], sc[2 * t][3]), pk2(sc[2 * t + 1][0], sc[2 * t + 1][1]), pk2(sc[2 * t + 1][2], sc[2 * t + 1][3])};
            const bf16x8 pf = __builtin_bit_cast(bf16x8, pw); bf16x8 bb[8];
#pragma unroll
            for (int n = 0; n < 8; ++n) bb[n] = frag_trp(Vt, 32 * t, 16 * n, lane);
            SCHED_FENCE();
#pragma unroll
            for (int n = 0; n < 8; ++n) acco[n] = MFMA16(bb[n], pf, acco[n]); }
        if (kt + 1 < ntiles) { MB_STAGE((kt + 1) & 1); if (kt + 2 < ntiles) MB_FETCH((kt + 2) * 128); }
        __syncthreads();
    }
    lq += __shfl_xor(lq, 16); lq += __shfl_xor(lq, 32);
    const float inv = 1.0f / lq;
    bf16* yr = WSP(bf16, WS_Y) + (size_t)2 * M * 1024 + (size_t)(b * SEQ + q0 + 16 * w + i16) * 1024 + h * 128 + 4 * g;
#pragma unroll
    for (int n = 0; n < 8; ++n) *(v2u*)(yr + 16 * n) = (v2u){pk2(acco[n][0] * inv, acco[n][1] * inv), pk2(acco[n][2] * inv, acco[n][3] * inv)};
#undef MB_FETCH
#undef MB_STAGE
}
__device__ __forceinline__ void mix_phase(Frame& F, const float* rgn, const float* mln, const float* qn, unsigned* head) {
    volatile LAS unsigned* slot = F.MISC;
    for (;;) {
        if (F.tid == 0) slot[0] = __hip_atomic_fetch_add(head, 1u, __ATOMIC_RELAXED, __HIP_MEMORY_SCOPE_AGENT);
        __syncthreads();
        const unsigned it = slot[0];
        __syncthreads();
        if (it >= 128u + 1024u) break;
        { int t_ = threadIdx.x; asm volatile("" : "+v"(t_)); F.tid = t_; F.lane = t_ & 63; }
        if (it < 64u) ret_unit(F, rgn, (int)(it >> 3), (int)(it & 7u));
        else if (it < 128u) mlstm_unit(F, mln, (int)((it - 64u) >> 3), (int)(it & 7u));
        else { const unsigned rank = it - 128u; moba_unit(F, qn, (int)((rank & 63u) >> 3), (int)(rank & 7u), 15 - (int)(rank >> 6)); }
    }
}
}
constexpr int N_PHASES = 1 + 8 * DEPTH;
__global__ void __launch_bounds__(NWAVES * 64, 2) fwd(Args args) {
    extern __shared__ __attribute__((aligned(16))) unsigned char lds[];
    Frame F;
    F.lds = (LAS unsigned char*)lds;
    F.MISC = (volatile LAS unsigned*)(F.lds + MISC_OFF);
    F.tid = threadIdx.x; F.lane = F.tid & 63; F.wave = __builtin_amdgcn_readfirstlane(F.tid >> 6); F.G = gridDim.x; F.bx = blockIdx.x;
    F.ws = args.ws;
    for (int u = F.tid; u < (LDS_BYTES - LDSCTL_OFF) / 4; u += NWAVES * 64) ((LAS unsigned*)(F.lds + LDSCTL_OFF))[u] = 0u;
    __syncthreads();
    XcdBarrier bar = xcd_barrier_post((unsigned*)(F.ws + WS_CTL) + CW_BAR + args.li * XCD_BAR_WORDS, F.MISC + 8);
    const int lo = args.ph_lo, hi = args.ph_hi;
#define RUN(p) (lo <= (p) && (p) < hi)
#define SEAM(p) do { if ((p) + 1 < hi) xcd_barrier(bar); } while (0)
    if (RUN(0)) { p0_prologue(F, args); SEAM(0); }
    for (int l = 0; l < DEPTH; ++l) {
        const int p0 = 1 + 8 * l;
        { int t_ = threadIdx.x; asm volatile("" : "+v"(t_)); F.tid = t_; F.lane = t_ & 63; F.wave = __builtin_amdgcn_readfirstlane(t_ >> 6); int b_ = blockIdx.x; asm volatile("" : "+s"(b_)); F.bx = b_; }
        float* rs = WSP(float, WS_RS) + (size_t)(2 * l) * M * 32;
        if (RUN(p0 + 0)) {
            { const int kf = (((F.bx >> 3) & 7) >> 2);
#define IN_F8_CALL(I0, NN) { pg8::Gemm g8{WSP(bf16, WS_XB8), (const bf16*)(F.ws + ws_win8(l)), M, N8, DM / 2}; pg8::RangeOrder<pg8::StaticOrder> S8; S8.b.init(M, N8, F.G, F.bx); S8.i0 = (I0); S8.n = (NN); \
                pg8::EpiGate8 E8{F.ws + WS_ZG, 3 * DM, 1.0f / 64.0f, WSP(bf16, WS_Z), NZ, 3 * DM / 256, Z_MO}; \
                pg8::gemm_phase<pg8::EpiGate8, pg8::RangeOrder<pg8::StaticOrder>, false, true, true>(F.lds + RING_OFF, g8, S8, E8); }
              IN_F8_CALL(0, kf)
              { pg8::Gemm g{WSP(bf16, WS_XB), WSP(bf16, WS_WIN) + (size_t)l * NZ * DM, M, Z_GA - 1024, DM}; pg8::SkipOrder S; S.init(M, Z_GA - 1024, F.G, F.bx); S.skip0 = Z_MO / 256; S.nskip = 4;
                pg8::EpiBf16 E{WSP(bf16, WS_Z), NZ, nullptr, -1, 0};
                pg8::gemm_phase<pg8::EpiBf16, pg8::SkipOrder, false, true>(F.lds + RING_OFF, g, S, E); }
              { int kf2 = (((F.bx >> 3) & 7) >> 2); asm volatile("" : "+s"(kf2));
                IN_F8_CALL(kf2, 1 << 20) }
#undef IN_F8_CALL
            }
            SEAM(p0 + 0); }
        if (RUN(p0 + 1)) { prep_phase(F, args.in[I_QN] + l * 128, args.in[I_KN] + l * 128, WSP(bf16, WS_W16G) + (size_t)l * 16 * DM, rs, args.in[I_BIG] + l * 8, args.in[I_BFG] + l * 8); SEAM(p0 + 1); }
        if (RUN(p0 + 2)) { mx::mix_phase(F, args.in[I_RGN] + l * 1024, args.in[I_MLN] + l * 1024, args.in[I_QN] + l * 128, (unsigned*)(F.ws + WS_CTL) + CW_QUEUE + 64 * l); SEAM(p0 + 2); }
        if (RUN(p0 + 3)) {
            pg8::StaticOrder3 S; S.init(M, DM, F.G, F.bx);
            pg8::Gemm g{WSP(bf16, WS_Y), WSP(bf16, WS_WP) + (size_t)l * 3 * DM * 1024, M, DM, 1024, (size_t)M * 1024, (size_t)DM * 1024}; pg8::EpiGateAcc E{WSP(bf16, WS_MG), DM, F.ws + WS_ZG, 3 * DM, WSP(float, WS_RSTD)};
            pg8::gemm_phase<pg8::EpiGateAcc, pg8::StaticOrder3, true, true>(F.lds + RING_OFF, g, S, E);
            SEAM(p0 + 3); }
        if (RUN(p0 + 4)) {
            pg8::Gemm g{WSP(bf16, WS_MG), WSP(bf16, WS_WOUT) + (size_t)l * DM * DM, M, DM, DM}; pg8::StaticOrder S; S.init(M, DM, F.G, F.bx);
            pg8::EpiRes<false> E{WSP(bf16, WS_XB), rs + (size_t)32 * M, nullptr, DM};
            pg8::gemm_phase<pg8::EpiRes<false>, pg8::StaticOrder, true, true>(F.lds + RING_OFF, g, S, E);
            SEAM(p0 + 4); }
        if (RUN(p0 + 5)) {
            pg8::Gemm g{WSP(bf16, WS_XB), WSP(bf16, WS_WUP) + (size_t)l * NUP * DM, M, NUP, DM}; pg8::StaticOrder S; S.init(M, NUP, F.G, F.bx);
            { pg8::Unit uu; int lastpm = -1; const float* rs2 = rs + (size_t)32 * M; int tq = threadIdx.x; asm volatile("" : "+v"(tq)); float* r2o = (float*)(F.ws + WS_RSTD2); asm volatile("" : "+s"(r2o));
              for (int i = 0; S.next(i, uu); ++i) if (uu.pm != lastpm) { lastpm = uu.pm;
                  const int r = uu.pm * 256 + (tq >> 1); const f32x4* p = (const f32x4*)(rs2 + (size_t)r * 32 + 16 * (tq & 1));
                  const f32x4 a = p[0], b = p[1], c = p[2], dd = p[3]; float s = (((a[0] + a[1]) + (a[2] + a[3])) + ((b[0] + b[1]) + (b[2] + b[3]))) + (((c[0] + c[1]) + (c[2] + c[3])) + ((dd[0] + dd[1]) + (dd[2] + dd[3])));
                  s += __shfl_xor(s, 1); if (!(tq & 1)) r2o[r] = __builtin_amdgcn_rsqf(s * (1.0f / DM) + 1e-6f); }
              VM_WAIT(); __syncthreads(); }
            const float* r2p = (const float*)(F.ws + WS_RSTD2); asm volatile("" : "+s"(r2p));
            pg8::EpiGLU E{WSP(bf16, WS_ACT), args.in[I_CW] + (size_t)l * 3 * NUP, args.in[I_CB] + (size_t)l * NUP, r2p, WSP(bf16, WS_SB)};
            pg8::gemm_phase<pg8::EpiGLU, pg8::StaticOrder, false, true>(F.lds + RING_OFF, g, S, E);
            SEAM(p0 + 5); }
        if (RUN(p0 + 6)) { glu_fix_phase(F, args.in[I_CW] + (size_t)l * 3 * NUP, args.in[I_CB] + (size_t)l * NUP); SEAM(p0 + 6); }
        if (RUN(p0 + 7)) {
            pg8::Gemm g{WSP(bf16, WS_ACT), WSP(bf16, WS_WDN) + (size_t)l * DM * DFF, M, DM, DFF}; pg8::StaticOrder S; S.init(M, DM, F.G, F.bx);
            if (l + 1 < DEPTH) { pg8::EpiRes<false, true> E{WSP(bf16, WS_XB), rs + (size_t)64 * M, nullptr, DM, F.ws + WS_XB8};
                pg8::gemm_phase<pg8::EpiRes<false, true>, pg8::StaticOrder, true, true>(F.lds + RING_OFF, g, S, E); }
            else { pg8::EpiRes<true> E{WSP(bf16, WS_XB), nullptr, args.out, DM};
                pg8::gemm_phase<pg8::EpiRes<true>, pg8::StaticOrder, true, true>(F.lds + RING_OFF, g, S, E); }
            SEAM(p0 + 7); }
    }
#undef RUN
#undef SEAM
}

#ifndef MK_N_LAUNCHES
#define MK_N_LAUNCHES 1
#endif
extern "C" void kernel_launch(void* const* d_in, const int* in_sizes, int n_in, void* d_out, int out_size, void* d_ws, size_t ws_size, hipStream_t stream) {
    static int grid = 0;
    if (grid == 0) {
        if (n_in != 18 || in_sizes[0] != M * DM || out_size != M * DM || ws_size < WS_END) { fprintf(stderr, "kernel_launch: unexpected shapes (n_in %d, in0 %d, out %d, ws %zu)\n", n_in, n_in > 0 ? in_sizes[0] : -1, out_size, ws_size); grid = -1; return; }
        int dev = 0, cus = 0, per_cu = 0;
        if (hipGetDevice(&dev) != hipSuccess || hipDeviceGetAttribute(&cus, hipDeviceAttributeMultiprocessorCount, dev) != hipSuccess) { grid = -1; return; }
        if (hipFuncSetAttribute((const void*)fwd, hipFuncAttributeMaxDynamicSharedMemorySize, LDS_BYTES) != hipSuccess) { fprintf(stderr, "kernel_launch: hipFuncSetAttribute failed\n"); grid = -1; return; }
        if (hipOccupancyMaxActiveBlocksPerMultiprocessor(&per_cu, (const void*)fwd, NWAVES * 64, LDS_BYTES) != hipSuccess || per_cu < 1) fprintf(stderr, "kernel_launch: occupancy query reports %d\n", per_cu);
        (void)hipGetLastError();
        grid = cus;
    }
    if (grid < 0) return;
    if (hipMemsetAsync((char*)d_ws + WS_CTL, 0, CTL_ZERO_BYTES, stream) != hipSuccess) return;
    Args a{};
    for (int i = 0; i < 18; ++i) a.in[i] = (const float*)d_in[i];
    a.out = (float*)d_out; a.ws = (unsigned char*)d_ws; a.pad = 0;
    constexpr int NL = MK_N_LAUNCHES;
    for (int li = 0; li < NL; ++li) {
        a.ph_lo = (NL == 1) ? 0 : li; a.ph_hi = (NL == 1) ? N_PHASES : li + 1; a.li = (NL == 1) ? 0 : 0;
        hipLaunchKernelGGL(fwd, dim3(grid), dim3(NWAVES * 64), LDS_BYTES, stream, a);
    }
}
```

```cpp
#include <hip/hip_runtime.h>
#include <cstdio>
#include <cstdint>
namespace pg8 {
#define PG8_LAS __attribute__((address_space(3)))
typedef unsigned short bf16_t;
typedef short bf16x8 __attribute__((ext_vector_type(8)));
typedef float f32x4 __attribute__((ext_vector_type(4)));
typedef unsigned u32x4 __attribute__((ext_vector_type(4)));
constexpr int BM = 256, BK = 64, HALF = 128, HTB = HALF * BK * 2  , STAGE_BYTES = 8 * HTB, NXCD = 8, WGM = 8;

__host__ __device__ __forceinline__ int lds_byte(int r, int c) { const int st = (r >> 4) * 2 + (c >> 5), rr = r & 15, cc = c & 31, ob = rr * 64 + cc * 2; return st * 1024 + (ob ^ (((ob >> 9) & 1) << 5)); }
__host__ __device__ __forceinline__ void stage_rc(int b, int& R, int& C) { const int st = b / 1024, sb = b % 1024, swz = sb ^ (((sb >> 9) & 1) << 5); R = (st >> 1) * 16 + swz / 64; C = (st & 1) * 32 + (swz % 64) / 2; }
__host__ __device__ __forceinline__ int perm32(int rho) { const int n = rho >> 4, i = rho & 15; return 8 * (i >> 2) + 4 * n + (i & 3); }

struct Unit { int pm, pn, z; };
struct Gemm { const bf16_t* A; const bf16_t* Bt; int M, N, K; size_t zA, zB; };

struct StaticOrder {
    int nM, nN, nwg, G, c;
    __host__ __device__ void init(int M, int N, int G_, int c_) { nM = M / BM; nN = N / BM; nwg = nM * nN; G = G_; c = c_; }
    __host__ __device__ bool next(int i, Unit& u) const {
        const long L = (long)i * G + c; if (L >= nwg) return false;
        int wgid = (int)L; { const int q = nwg / NXCD, r = nwg % NXCD, xcd = wgid % NXCD, off = wgid / NXCD; wgid = (xcd < r ? xcd * (q + 1) : r * (q + 1) + (xcd - r) * q) + off; }
        const int nig = WGM * nN, gid = wgid / nig, fm = gid * WGM, gsz = (nM - fm) < WGM ? (nM - fm) : WGM;
        u.pm = fm + ((wgid % nig) % gsz); u.pn = (wgid % nig) / gsz; u.z = 0; return true;
    }
    __device__ __forceinline__ void a_ready(const Unit&) const {}
    __device__ __forceinline__ void done(const Unit&) const {}
};

struct SkipOrder : StaticOrder {
    int skip0, nskip;
    __host__ __device__ bool next(int i, Unit& u) const { if (!StaticOrder::next(i, u)) return false; if (u.pn >= skip0) u.pn += nskip; return true; }
};
template <class Base> struct RangeOrder {
    Base b; int i0, n;
    __host__ __device__ bool next(int i, Unit& u) const { return i < n && b.next(i0 + i, u); }
    __device__ __forceinline__ void a_ready(const Unit&) const {}
    __device__ __forceinline__ void done(const Unit&) const {}
};
struct StaticOrder3 : StaticOrder {
    __host__ __device__ bool next(int i, Unit& u) const { if (!StaticOrder::next(i / 3, u)) return false; u.z = i % 3; return true; }
};
__device__ __forceinline__ unsigned cvt_pk_bf16(float lo, float hi) { unsigned r; asm volatile("v_cvt_pk_bf16_f32 %0, %1, %2" : "=v"(r) : "v"(lo), "v"(hi)); return r; }
typedef unsigned u32x2 __attribute__((ext_vector_type(2)));
__device__ __forceinline__ u32x4 qgather(const u32x4 w, int lane) { const int src = 4 * (16 * (lane & 3) + (lane >> 2)); u32x4 o;
#pragma unroll
    for (int k = 0; k < 4; ++k) o[k] = (unsigned)__builtin_amdgcn_ds_bpermute(src, (int)w[k]); return o; }
__device__ __forceinline__ u32x4 qscatter(const u32x4 w, int lane) { const int src = 4 * (4 * (lane & 15) + (lane >> 4)); u32x4 o;
#pragma unroll
    for (int k = 0; k < 4; ++k) o[k] = (unsigned)__builtin_amdgcn_ds_bpermute(src, (int)w[k]); return o; }
struct EpiBf16 {
    static constexpr bool PERM = true, AFTER_DRAIN = false, KEEP = false, APERM = false;
    bf16_t* O; int ldc; unsigned char* G8; int g8_pn0, g8_ld;
    __device__ __forceinline__ void operator()(const f32x4 (&acc)[2][2][4][2], const Unit& u, int wr, int wc, int fr, int fq) const {
        const int lane = 16 * fq + fr; const int row0 = u.pm * BM + wr * 64 + (lane >> 2); const int col0 = u.pn * BM + wc * 32 + 8 * (lane & 3);
#pragma unroll
        for (int ai = 0; ai < 2; ++ai)
#pragma unroll
            for (int m = 0; m < 4; ++m) { bf16_t* rowp = O + (size_t)(row0 + ai * HALF + m * 16) * ldc + col0;
#pragma unroll
                for (int bj = 0; bj < 2; ++bj) { const f32x4 v0 = acc[ai][bj][m][0], v1 = acc[ai][bj][m][1];
                    u32x4 w; w.x = cvt_pk_bf16(v0[0], v0[1]); w.y = cvt_pk_bf16(v0[2], v0[3]); w.z = cvt_pk_bf16(v1[0], v1[1]); w.w = cvt_pk_bf16(v1[2], v1[3]);
                    *(u32x4*)(rowp + bj * HALF) = qgather(w, lane); } }
    }
};
struct EpiGate8 {
    static constexpr bool PERM = true, AFTER_DRAIN = false, KEEP = false, APERM = false;
    unsigned char* G8; int g8_ld; float sc; bf16_t* O; int ldc, o_pn0, o_col0;
    __device__ __forceinline__ void operator()(const f32x4 (&acc)[2][2][4][2], const Unit& u, int wr, int wc, int fr, int fq) const {
        const int lane = 16 * fq + fr; const int row0 = u.pm * BM + wr * 64 + (lane >> 2); const int pc = wc * 32 + 8 * (lane & 3);
        if (u.pn >= o_pn0) { const int col0 = o_col0 + (u.pn - o_pn0) * BM + pc;
#pragma unroll
            for (int ai = 0; ai < 2; ++ai)
#pragma unroll
                for (int m = 0; m < 4; ++m) { bf16_t* rowp = O + (size_t)(row0 + ai * HALF + m * 16) * ldc + col0;
#pragma unroll
                    for (int bj = 0; bj < 2; ++bj) { const f32x4 v0 = acc[ai][bj][m][0] * sc, v1 = acc[ai][bj][m][1] * sc;
                        u32x4 w; w.x = cvt_pk_bf16(v0[0], v0[1]); w.y = cvt_pk_bf16(v0[2], v0[3]); w.z = cvt_pk_bf16(v1[0], v1[1]); w.w = cvt_pk_bf16(v1[2], v1[3]);
                        *(u32x4*)(rowp + bj * HALF) = qgather(w, lane); } }
            return; }
        const int gc0 = u.pn * BM + pc; const int src = 4 * (16 * (lane & 3) + (lane >> 2));
#pragma unroll
        for (int ai = 0; ai < 2; ++ai)
#pragma unroll
            for (int m = 0; m < 4; ++m) { unsigned char* rowp = G8 + (size_t)(row0 + ai * HALF + m * 16) * g8_ld + gc0;
#pragma unroll
                for (int bj = 0; bj < 2; ++bj) { const f32x4 v0 = acc[ai][bj][m][0] * sc, v1 = acc[ai][bj][m][1] * sc; u32x2 w;
                    w.x = (unsigned)__builtin_amdgcn_cvt_pk_fp8_f32(v0[2], v0[3], __builtin_amdgcn_cvt_pk_fp8_f32(v0[0], v0[1], 0, false), true);
                    w.y = (unsigned)__builtin_amdgcn_cvt_pk_fp8_f32(v1[2], v1[3], __builtin_amdgcn_cvt_pk_fp8_f32(v1[0], v1[1], 0, false), true);
                    w.x = (unsigned)__builtin_amdgcn_ds_bpermute(src, (int)w.x); w.y = (unsigned)__builtin_amdgcn_ds_bpermute(src, (int)w.y);
                    *(u32x2*)(rowp + bj * HALF) = w; } }
    }
};
__device__ __forceinline__ float bf_lo(unsigned w) { return __uint_as_float(w << 16); }
__device__ __forceinline__ float bf_hi(unsigned w) { return __uint_as_float(w & 0xffff0000u); }
__device__ __forceinline__ float sigmoid_f(float x) { return __builtin_amdgcn_rcpf(1.0f + __expf(-x)); }
struct EpiGateAcc {
    static constexpr bool PERM = true, AFTER_DRAIN = false, KEEP = true, APERM = false;
    bf16_t* O; int ldc; const unsigned char* G8; int g8_ld; const float* rstd;
    template <int E> static __device__ __forceinline__ float g8f(const u32x2 w) { return __builtin_amdgcn_cvt_f32_fp8((int)(E < 4 ? w.x : w.y), E & 3); }
    static __device__ __forceinline__ float em(float g, float rr) { return __expf(-fminf(fmaxf(g * rr, -40.f), 40.f)); }
    __device__ __forceinline__ void operator()(f32x4 (&acc)[2][2][4][2], const Unit& u, int wr, int wc, int fr, int fq) const {
        const int row0 = u.pm * BM + wr * 64 + fr; const int col0 = u.pn * BM + wc * 32 + 8 * fq; const bool last = (u.z == 2); const float dmask = last ? 0.0f : 1.0f;
        const unsigned char* Gn = G8 + (size_t)u.z * ldc; const unsigned char* Gd = G8 + (size_t)(last ? u.z : u.z + 1) * ldc;
#pragma unroll
        for (int ai = 0; ai < 2; ++ai)
#pragma unroll
            for (int m = 0; m < 4; ++m) { const size_t row = (size_t)(row0 + ai * HALF + m * 16); const float rr = rstd[row];
#pragma unroll
                for (int bj = 0; bj < 2; ++bj) {
                    const u32x2 gn = *(const u32x2*)(Gn + row * g8_ld + col0 + bj * HALF), gd = *(const u32x2*)(Gd + row * g8_ld + col0 + bj * HALF);
                    f32x4 v0 = acc[ai][bj][m][0], v1 = acc[ai][bj][m][1];
#define GA_MUL(E) ((1.0f + dmask * em(g8f<E>(gd), rr)) * __builtin_amdgcn_rcpf(1.0f + em(g8f<E>(gn), rr)))
                    v0[0] *= GA_MUL(0); v0[1] *= GA_MUL(1); v0[2] *= GA_MUL(2); v0[3] *= GA_MUL(3); v1[0] *= GA_MUL(4); v1[1] *= GA_MUL(5); v1[2] *= GA_MUL(6); v1[3] *= GA_MUL(7);
#undef GA_MUL
                    acc[ai][bj][m][0] = v0; acc[ai][bj][m][1] = v1;
                    if (last) { u32x4 w; w.x = cvt_pk_bf16(v0[0], v0[1]); w.y = cvt_pk_bf16(v0[2], v0[3]); w.z = cvt_pk_bf16(v1[0], v1[1]); w.w = cvt_pk_bf16(v1[2], v1[3]); *(u32x4*)(O + row * ldc + col0 + bj * HALF) = w; } } }
    }
};
template <bool LAST, bool F8 = false> struct EpiRes {
    static constexpr bool PERM = true, AFTER_DRAIN = false, KEEP = false, APERM = false;
    bf16_t* xb; float* rs; float* out; int ldc; unsigned char* x8;
    __device__ __forceinline__ void operator()(const f32x4 (&acc)[2][2][4][2], const Unit& u, int wr, int wc, int fr, int fq) const {
        const int row0 = u.pm * BM + wr * 64 + fr; const int col0 = u.pn * BM + wc * 32 + 8 * fq;
        const int lane = 16 * fq + fr, qsrc = 4 * (16 * (lane & 3) + (lane >> 2)); const size_t qoff = (size_t)(u.pm * BM + wr * 64 + (lane >> 2)) * ldc + u.pn * BM + wc * 32 + 8 * (lane & 3);
#pragma unroll
        for (int ai = 0; ai < 2; ++ai) {
            u32x4 pv[4][2];
#pragma unroll
            for (int m = 0; m < 4; ++m)
#pragma unroll
                for (int bj = 0; bj < 2; ++bj) pv[m][bj] = *(const u32x4*)(xb + qoff + (size_t)(ai * HALF + m * 16) * ldc + bj * HALF);
#pragma unroll
            for (int m = 0; m < 4; ++m) { const int row = row0 + ai * HALF + m * 16; const size_t off = (size_t)row * ldc + col0; float sq = 0.f;
#pragma unroll
                for (int bj = 0; bj < 2; ++bj) { const u32x4 p = qscatter(pv[m][bj], lane); const f32x4 v0 = acc[ai][bj][m][0], v1 = acc[ai][bj][m][1];
                    const float o0 = bf_lo(p.x) + v0[0], o1 = bf_hi(p.x) + v0[1], o2 = bf_lo(p.y) + v0[2], o3 = bf_hi(p.y) + v0[3], o4 = bf_lo(p.z) + v1[0], o5 = bf_hi(p.z) + v1[1], o6 = bf_lo(p.w) + v1[2], o7 = bf_hi(p.w) + v1[3];
                    if (LAST) { *(f32x4*)(out + off + bj * HALF) = (f32x4){o0, o1, o2, o3}; *(f32x4*)(out + off + bj * HALF + 4) = (f32x4){o4, o5, o6, o7}; }
                    else { sq += ((o0 * o0 + o1 * o1) + (o2 * o2 + o3 * o3)) + ((o4 * o4 + o5 * o5) + (o6 * o6 + o7 * o7));
                        u32x4 w; w.x = cvt_pk_bf16(o0, o1); w.y = cvt_pk_bf16(o2, o3); w.z = cvt_pk_bf16(o4, o5); w.w = cvt_pk_bf16(o6, o7); *(u32x4*)(xb + qoff + (size_t)(ai * HALF + m * 16) * ldc + bj * HALF) = qgather(w, lane);
                        if (F8) { u32x2 q; q.x = (unsigned)__builtin_amdgcn_cvt_pk_fp8_f32(o2, o3, __builtin_amdgcn_cvt_pk_fp8_f32(o0, o1, 0, false), true); q.y = (unsigned)__builtin_amdgcn_cvt_pk_fp8_f32(o6, o7, __builtin_amdgcn_cvt_pk_fp8_f32(o4, o5, 0, false), true);
                            q.x = (unsigned)__builtin_amdgcn_ds_bpermute(qsrc, (int)q.x); q.y = (unsigned)__builtin_amdgcn_ds_bpermute(qsrc, (int)q.y); *(u32x2*)(x8 + qoff + (size_t)(ai * HALF + m * 16) * ldc + bj * HALF) = q; } } }
                if (!LAST) { sq += __shfl_xor(sq, 16); sq += __shfl_xor(sq, 32); if (fq == 0) rs[(size_t)row * 32 + u.pn * 4 + wc] = sq; } } }
    }
};

struct EpiGLU {
    static constexpr bool PERM = true, AFTER_DRAIN = false, KEEP = false, APERM = true;
    bf16_t* ACT; const float* cw; const float* cb; const float* rs; bf16_t* SB;
    static __device__ __forceinline__ f32x4 prev_lane(const f32x4 v, int src) { f32x4 o;
#pragma unroll
        for (int k = 0; k < 4; ++k) o[k] = __shfl(v[k], src); return o; }
    static __device__ __forceinline__ f32x4 silu4(const f32x4 a) { f32x4 o;
#pragma unroll
        for (int k = 0; k < 4; ++k) o[k] = a[k] * __builtin_amdgcn_rcpf(1.0f + __expf(-a[k])); return o; }
    __device__ __forceinline__ void operator()(const f32x4 (&acc)[2][2][4][2], const Unit& u, int wr, int wc, int fr, int fq) const {
        constexpr int DFF_ = 5632, NUP_ = 2 * DFF_;
        const int T0 = u.pm * BM + 8 * (16 * wr + fr), jq = u.pn * HALF + wc * 32 + 8 * fq, grp = 2 * u.pm + wr;
        const int lane = 16 * fq + fr, qsrc = 4 * (16 * (lane & 3) + (lane >> 2)), Tq = u.pm * BM + 8 * (16 * wr + (lane >> 2)), jqq = u.pn * HALF + wc * 32 + 8 * (lane & 3);
        float rr[8];
        { const f32x4 ra = *(const f32x4*)(rs + T0), rb = *(const f32x4*)(rs + T0 + 4); rr[0] = ra[0]; rr[1] = ra[1]; rr[2] = ra[2]; rr[3] = ra[3]; rr[4] = rb[0]; rr[5] = rb[1]; rr[6] = rb[2]; rr[7] = rb[3]; }
#pragma unroll
        for (int n = 0; n < 2; ++n) { const int j = jq + 4 * n;
            const f32x4 ca = *(const f32x4*)(cb + j), cbv = *(const f32x4*)(cb + DFF_ + j);
            const f32x4 a0 = *(const f32x4*)(cw + j), a1 = *(const f32x4*)(cw + NUP_ + j), a2 = *(const f32x4*)(cw + 2 * NUP_ + j);
            const f32x4 b0 = *(const f32x4*)(cw + DFF_ + j), b1 = *(const f32x4*)(cw + NUP_ + DFF_ + j), b2 = *(const f32x4*)(cw + 2 * NUP_ + DFF_ + j);
            f32x4 va[8], vb[8];
#pragma unroll
            for (int i = 0; i < 8; ++i) { va[i] = acc[i >> 2][0][i & 3][n] * rr[i]; vb[i] = acc[i >> 2][1][i & 3][n] * rr[i]; }
            const int psrc = fq * 16 + ((fr + 15) & 15); const f32x4 pa6 = prev_lane(va[6], psrc), pa7 = prev_lane(va[7], psrc), pb6 = prev_lane(vb[6], psrc), pb7 = prev_lane(vb[7], psrc);
#pragma unroll
            for (int i = 0; i < 8; ++i) {
                const f32x4 xa1 = i >= 1 ? va[i - 1] : pa7, xa2 = i >= 2 ? va[i - 2] : (i == 1 ? pa7 : pa6), xb1 = i >= 1 ? vb[i - 1] : pb7, xb2 = i >= 2 ? vb[i - 2] : (i == 1 ? pb7 : pb6);
                const f32x4 ua = ca + a0 * xa2 + a1 * xa1 + a2 * va[i], ub = cbv + b0 * xb2 + b1 * xb1 + b2 * vb[i];
                const f32x4 o = silu4(ua) * ub;
                { u32x2 w; w.x = cvt_pk_bf16(o[0], o[1]); w.y = cvt_pk_bf16(o[2], o[3]);
                  w.x = (unsigned)__builtin_amdgcn_ds_bpermute(qsrc, (int)w.x); w.y = (unsigned)__builtin_amdgcn_ds_bpermute(qsrc, (int)w.y);
                  if (i >= 2 || (lane >> 2) != 0) *(u32x2*)(ACT + (size_t)(Tq + i) * DFF_ + jqq + 4 * n) = w; } }
            if (fr == 0) {
#pragma unroll
                for (int i = 0; i < 2; ++i) { u32x2 w; w.x = cvt_pk_bf16(va[i][0], va[i][1]); w.y = cvt_pk_bf16(va[i][2], va[i][3]); *(u32x2*)(SB + ((size_t)grp * 4 + 2 + i) * NUP_ + j) = w;
                    w.x = cvt_pk_bf16(vb[i][0], vb[i][1]); w.y = cvt_pk_bf16(vb[i][2], vb[i][3]); *(u32x2*)(SB + ((size_t)grp * 4 + 2 + i) * NUP_ + DFF_ + j) = w; } }
            if (fr == 15) {
#pragma unroll
                for (int i = 0; i < 2; ++i) { u32x2 w; w.x = cvt_pk_bf16(va[6 + i][0], va[6 + i][1]); w.y = cvt_pk_bf16(va[6 + i][2], va[6 + i][3]); *(u32x2*)(SB + ((size_t)(grp + 1) * 4 + i) * NUP_ + j) = w;
                    w.x = cvt_pk_bf16(vb[6 + i][0], vb[6 + i][1]); w.y = cvt_pk_bf16(vb[6 + i][2], vb[6 + i][3]); *(u32x2*)(SB + ((size_t)(grp + 1) * 4 + i) * NUP_ + DFF_ + j) = w; } }
        }
    }
};

template <class E, class = void> struct EpiB64 { static constexpr bool v = false; };
template <class E> struct EpiB64<E, decltype((void)E::B64)> { static constexpr bool v = E::B64; };
typedef int i32x4_t __attribute__((ext_vector_type(4)));
typedef int i32x8_t __attribute__((ext_vector_type(8)));
__device__ __forceinline__ i32x8_t cat8(const bf16x8 a, const bf16x8 b) { return __builtin_shufflevector((i32x4_t)a, (i32x4_t)b, 0, 1, 2, 3, 4, 5, 6, 7); }
template <class Epi, class Sched, bool ALIGN_EPI = false, bool SP2 = false, bool F8 = false>
__device__ __forceinline__ void gemm_phase(PG8_LAS unsigned char* lds, const Gemm g, const Sched& S, const Epi& E) {
    int tid_ = threadIdx.x; asm volatile("" : "+v"(tid_));
    const int tid = tid_, wid = __builtin_amdgcn_readfirstlane(tid >> 6), lane = tid & 63, wr = wid >> 2, wc = wid & 3, fr = lane & 15, fq = lane >> 4;
    const int K = g.K, nt = K / BK;
    unsigned voffA[2], voffB[2];
#pragma unroll
    for (int i = 0; i < 2; ++i) { int R, C; stage_rc(tid * 16 + i * 8192, R, C); const int Rb = EpiB64<Epi>::v ? (2 * (R & ~31) + perm32(R & 31)) : Epi::PERM ? ((R & ~31) + perm32(R & 31)) : R;
        const int Ra = Epi::APERM ? (8 * (16 * (R >> 6) + (R & 15)) + ((R >> 4) & 3)) : R;
        voffA[i] = (unsigned)(Ra * K + C) * 2u; voffB[i] = (unsigned)(Rb * K + C) * 2u; }
    const size_t kstep = (size_t)(BK * 2);
    const size_t hstep = (size_t)HALF * K * 2;
    const size_t hstepA = Epi::APERM ? (size_t)4 * K * 2 : hstep;
    const size_t hstepB = EpiB64<Epi>::v ? (size_t)32 * K * 2 : hstep;
    const size_t tstep = 2 * hstep;
    const unsigned ldsw = (unsigned)wid * 1024u;
    const int aoff = lds_byte(wr * 64 + fr, fq * 8), boff = lds_byte(wc * 32 + fr, fq * 8);
#define PG8_SA(b, h) (((b) * 2 + (h)) * HTB)
#define PG8_SB(b, h) ((4 + (b) * 2 + (h)) * HTB)
#define PG8_STAGE(bufoff, gbase, voff) do { _Pragma("unroll") for (int _i = 0; _i < 2; ++_i) \
        __builtin_amdgcn_global_load_lds((const unsigned*)((const char*)(gbase) + (voff)[_i]), (PG8_LAS unsigned*)(lds + (bufoff) + ldsw + _i * 8192), 16, 0, 0); } while (0)
#define PG8_LDA(dst, b, h) do { _Pragma("unroll") for (int m = 0; m < 4; ++m) _Pragma("unroll") for (int k = 0; k < 2; ++k) dst[m][k] = *(const PG8_LAS bf16x8*)(lds + PG8_SA(b, h) + aoff + m * 2048 + k * 1024); } while (0)
#define PG8_LDB(dst, b, h) do { _Pragma("unroll") for (int n = 0; n < 2; ++n) _Pragma("unroll") for (int k = 0; k < 2; ++k) dst[n][k] = *(const PG8_LAS bf16x8*)(lds + PG8_SB(b, h) + boff + n * 2048 + k * 1024); } while (0)
#define PG8_MMA(ai, bj, At, Bt) do { __builtin_amdgcn_s_setprio(1); if constexpr (F8) { _Pragma("unroll") for (int m = 0; m < 4; ++m) _Pragma("unroll") for (int n = 0; n < 2; ++n) \
        asm volatile("v_mfma_f32_16x16x128_f8f6f4 %0, %1, %2, %0" : "+v"(acc[ai][bj][m][n]) : "v"(cat8(Bt[n][0], Bt[n][1])), "v"(cat8(At[m][0], At[m][1]))); } else { \
        _Pragma("unroll") for (int m = 0; m < 4; ++m) _Pragma("unroll") for (int n = 0; n < 2; ++n) _Pragma("unroll") for (int k = 0; k < 2; ++k) \
        acc[ai][bj][m][n] = __builtin_amdgcn_mfma_f32_16x16x32_bf16(Bt[n][k], At[m][k], acc[ai][bj][m][n], 0, 0, 0); } __builtin_amdgcn_s_setprio(0); } while (0)
#define PG8_WAIT_V(n) asm volatile("s_waitcnt vmcnt(" #n ")" ::: "memory")
#define PG8_WAIT_L(n) asm volatile("s_waitcnt lgkmcnt(" #n ")" ::: "memory")
#define PG8_BAR __builtin_amdgcn_s_barrier()
#define PG8_SCHED __builtin_amdgcn_sched_barrier(0)
    Unit cur, nxt; int ui = 0;
    if (!S.next(0, cur)) return;
    f32x4 acc[2][2][4][2];
#pragma unroll
    for (int a = 0; a < 2; ++a)
#pragma unroll
        for (int b = 0; b < 2; ++b)
#pragma unroll
            for (int m = 0; m < 4; ++m)
#pragma unroll
                for (int n = 0; n < 2; ++n) acc[a][b][m][n] = (f32x4){0.f, 0.f, 0.f, 0.f};
    bf16x8 At[4][2], B0[2][2], B1[2][2];
    const char* cA = (const char*)(g.A + (size_t)cur.z * g.zA) + (size_t)cur.pm * tstep; const char* cB = (const char*)(g.Bt + (size_t)cur.z * g.zB) + (size_t)cur.pn * tstep;
    S.a_ready(cur);
    if constexpr (SP2) {
        PG8_STAGE(PG8_SB(0, 0), cB, voffB); PG8_STAGE(PG8_SB(0, 1), cB + hstepB, voffB); PG8_STAGE(PG8_SA(0, 0), cA, voffA); PG8_STAGE(PG8_SA(0, 1), cA + hstepA, voffA);
        if (wr == 1) PG8_BAR;
        PG8_WAIT_V(2); PG8_BAR;
        PG8_STAGE(PG8_SB(1, 0), cB + kstep, voffB); PG8_STAGE(PG8_SA(1, 0), cA + kstep, voffA); PG8_STAGE(PG8_SB(1, 1), cB + hstepB + kstep, voffB);
        PG8_WAIT_V(6); PG8_BAR;
    } else {
        PG8_STAGE(PG8_SB(0, 0), cB, voffB); PG8_STAGE(PG8_SA(0, 0), cA, voffA); PG8_STAGE(PG8_SB(0, 1), cB + hstepB, voffB); PG8_STAGE(PG8_SA(0, 1), cA + hstepA, voffA);
        if (wr == 1) PG8_BAR;
        PG8_WAIT_V(4); PG8_BAR;
        PG8_STAGE(PG8_SB(1, 0), cB + kstep, voffB); PG8_STAGE(PG8_SA(1, 0), cA + kstep, voffA); PG8_STAGE(PG8_SB(1, 1), cB + hstepB + kstep, voffB);
        PG8_WAIT_V(6); PG8_BAR;
    }
    for (;;) {
        const bool has_next = S.next(ui + 1, nxt);
        const char* nA = has_next ? (const char*)(g.A + (size_t)nxt.z * g.zA) + (size_t)nxt.pm * tstep : cA; const char* nB = has_next ? (const char*)(g.Bt + (size_t)nxt.z * g.zB) + (size_t)nxt.pn * tstep : cB;
        for (int t = 0; t < nt; t += 2) {
            const bool last = (t == nt - 2);
            const char* a1 = cA + (size_t)(t + 1) * kstep;
            const char* a2 = last ? nA : cA + (size_t)(t + 2) * kstep; const char* b2 = last ? nB : cB + (size_t)(t + 2) * kstep;
            const char* a3 = a2 + kstep; const char* b3 = b2 + kstep;
            if (last && has_next) S.a_ready(nxt);
            if constexpr (SP2) {
            PG8_LDB(B0, 0, 0); PG8_LDB(B1, 0, 1); PG8_SCHED; PG8_LDA(At, 0, 0); PG8_STAGE(PG8_SA(1, 1), a1 + hstepA, voffA);
            PG8_WAIT_V(8); PG8_WAIT_L(0); PG8_BAR; PG8_MMA(0, 0, At, B0); PG8_MMA(0, 1, At, B1); PG8_BAR; PG8_SCHED;
            PG8_LDA(At, 0, 1); PG8_STAGE(PG8_SB(0, 0), b2, voffB); PG8_STAGE(PG8_SB(0, 1), b2 + hstepB, voffB); PG8_STAGE(PG8_SA(0, 0), a2, voffA);
            PG8_WAIT_V(8); PG8_WAIT_L(0); PG8_BAR; PG8_MMA(1, 0, At, B0); PG8_MMA(1, 1, At, B1); PG8_BAR; PG8_SCHED;
            PG8_LDB(B0, 1, 0); PG8_LDB(B1, 1, 1); PG8_SCHED; PG8_LDA(At, 1, 0); PG8_STAGE(PG8_SA(0, 1), a2 + hstepA, voffA);
            PG8_WAIT_V(8); PG8_WAIT_L(0); PG8_BAR; PG8_MMA(0, 0, At, B0); PG8_MMA(0, 1, At, B1); PG8_BAR; PG8_SCHED;
            PG8_LDA(At, 1, 1); PG8_STAGE(PG8_SB(1, 0), b3, voffB); PG8_STAGE(PG8_SB(1, 1), b3 + hstepB, voffB); PG8_STAGE(PG8_SA(1, 0), a3, voffA);
            PG8_WAIT_V(8); PG8_WAIT_L(0); PG8_BAR; PG8_MMA(1, 0, At, B0); PG8_MMA(1, 1, At, B1); PG8_BAR; PG8_SCHED;
            } else {
            PG8_LDB(B0, 0, 0); PG8_SCHED; PG8_LDA(At, 0, 0); PG8_STAGE(PG8_SA(1, 1), a1 + hstepA, voffA);
            PG8_WAIT_L(8); PG8_BAR; PG8_WAIT_L(0); PG8_MMA(0, 0, At, B0); PG8_BAR; PG8_SCHED;
            PG8_LDB(B1, 0, 1); PG8_STAGE(PG8_SB(0, 0), b2, voffB);
            PG8_BAR; PG8_WAIT_L(0); PG8_MMA(0, 1, At, B1); PG8_BAR;
            PG8_LDA(At, 0, 1); PG8_STAGE(PG8_SA(0, 0), a2, voffA);
            PG8_BAR; PG8_WAIT_L(0); PG8_MMA(1, 0, At, B0); PG8_BAR; PG8_SCHED;
            PG8_STAGE(PG8_SB(0, 1), b2 + hstepB, voffB);
            PG8_WAIT_V(6); PG8_BAR; PG8_MMA(1, 1, At, B1); PG8_BAR;
            PG8_LDB(B0, 1, 0); PG8_SCHED; PG8_LDA(At, 1, 0); PG8_STAGE(PG8_SA(0, 1), a2 + hstepA, voffA);
            PG8_WAIT_L(8); PG8_BAR; PG8_WAIT_L(0); PG8_MMA(0, 0, At, B0); PG8_BAR; PG8_SCHED;
            PG8_LDB(B1, 1, 1); PG8_STAGE(PG8_SB(1, 0), b3, voffB);
            PG8_BAR; PG8_WAIT_L(0); PG8_MMA(0, 1, At, B1); PG8_BAR;
            PG8_LDA(At, 1, 1); PG8_STAGE(PG8_SA(1, 0), a3, voffA);
            PG8_BAR; PG8_WAIT_L(0); PG8_MMA(1, 0, At, B0); PG8_BAR; PG8_SCHED;
            PG8_STAGE(PG8_SB(1, 1), b3 + hstepB, voffB);
            PG8_WAIT_V(6); PG8_BAR; PG8_MMA(1, 1, At, B1); PG8_BAR;
            }
        }
        if constexpr (F8) asm volatile("s_nop 15\n\ts_nop 15\n\ts_nop 15\n\ts_nop 15" ::: "memory");
        if constexpr (ALIGN_EPI) { if (wr == 0) PG8_BAR; }
        if constexpr (!Epi::AFTER_DRAIN) { E(acc, cur, wr, wc, fr, fq); S.done(cur); }
        if (!has_next) break;
        if (!(Epi::KEEP && nxt.z != 0)) {
#pragma unroll
        for (int a = 0; a < 2; ++a)
#pragma unroll
            for (int b = 0; b < 2; ++b)
#pragma unroll
                for (int m = 0; m < 4; ++m)
#pragma unroll
                    for (int n = 0; n < 2; ++n) acc[a][b][m][n] = (f32x4){0.f, 0.f, 0.f, 0.f};
        }
        cur = nxt; cA = nA; cB = nB; ++ui;
        if constexpr (ALIGN_EPI) { if (wr == 1) PG8_BAR; }
    }
    PG8_WAIT_V(0);
    if constexpr (!ALIGN_EPI) { if (wr == 0) PG8_BAR; }
    PG8_BAR;
    if constexpr (Epi::AFTER_DRAIN) { E.fused(acc, cur, wr, wc, fr, fq, lds, wid, lane); S.done(cur); }
#undef PG8_SA
#undef PG8_SB
#undef PG8_STAGE
#undef PG8_LDA
#undef PG8_LDB
#undef PG8_MMA
#undef PG8_WAIT_V
#undef PG8_WAIT_L
#undef PG8_BAR
#undef PG8_SCHED
}
}

constexpr int NWAVES = 8;
constexpr int BATCH = 8, SEQ = 2048, DM = 2048, DEPTH = 4, M = BATCH * SEQ, NH = 8;
constexpr int NIN = 16400, NZ = 16384, DFF = 5632, NUP = 2 * DFF, NY = 3072;
constexpr int Z_RQ = 0, Z_RK = 1024, Z_RV = 2048, Z_RG = 3072, Z_MQ = 4096, Z_MK = 4608, Z_MV = 5120, Z_MO = 6144, Z_AQ = 7168, Z_AK = 8192, Z_AV = 9216, Z_GA = 10240, Z_GB = 12288, Z_GC = 14336;
constexpr int W_GATE_COL = 7168;
constexpr size_t MiB = 1u << 20;
constexpr size_t WS_CTL = 0, CTL_ZERO_BYTES = 1 * MiB;
constexpr size_t WS_RS = 1520 * MiB;
constexpr size_t WS_TAB = 2 * MiB + 512 * 1024;
constexpr size_t WS_RSTD = 7 * MiB + 512 * 1024;
constexpr size_t WS_RSTD2 = 7 * MiB + 768 * 1024;
constexpr size_t WS_W16G = 7 * MiB;
constexpr size_t WS_KMEAN = 5 * MiB;
constexpr size_t WS_GIF = 6 * MiB;
constexpr size_t WS_WIN = 8 * MiB;
constexpr size_t WS_WP = 264 * MiB;
constexpr size_t WS_WOUT = 312 * MiB;
constexpr size_t WS_WUP = 344 * MiB;
constexpr size_t WS_WDN = 520 * MiB;
constexpr size_t WS_XB = 608 * MiB;
constexpr size_t WS_Z = 672 * MiB;
constexpr size_t WS_Y = 1184 * MiB;
constexpr size_t WS_MG = 1280 * MiB;
constexpr size_t WS_ACT = 1344 * MiB;
constexpr size_t WS_ZG = 1536 * MiB;
constexpr size_t WS_SB = 1632 * MiB;
constexpr size_t WS_XB8 = 1648 * MiB;
constexpr size_t WS_END = 1680 * MiB;
constexpr int N8 = 3 * DM + 1024;
__host__ __device__ constexpr size_t ws_win8(int l) { return WS_WIN + ((size_t)l * NZ + Z_GA) * DM * 2; }
constexpr int CW_TMO = 0, CW_CODE = 1;
constexpr int CW_BAR = 4096;
constexpr int CW_QUEUE = 8192;
constexpr int RING_OFF = 0, RING_BYTES = 131072;
constexpr int LDS_BYTES = 163840;
constexpr int LDSCTL_OFF = LDS_BYTES - 512, MISC_OFF = LDSCTL_OFF + 320;
static_assert(MISC_OFF + 128 <= LDS_BYTES, "LDS map");

#define GAS __attribute__((address_space(1)))
#define LAS __attribute__((address_space(3)))
typedef unsigned short bf16;
typedef unsigned v4u __attribute__((ext_vector_type(4)));
typedef unsigned v2u __attribute__((ext_vector_type(2)));
typedef float f32x4 __attribute__((ext_vector_type(4)));
typedef float f32x2 __attribute__((ext_vector_type(2)));
typedef GAS unsigned gu32;
#define RLX_AGENT __ATOMIC_RELAXED, __HIP_MEMORY_SCOPE_AGENT
#define LDS_WAIT() asm volatile("s_waitcnt lgkmcnt(0)" ::: "memory")
#define VM_WAIT() asm volatile("s_waitcnt vmcnt(0)" ::: "memory")
typedef __bf16 bf16x2_t __attribute__((ext_vector_type(2)));
__device__ __forceinline__ unsigned pk2(float lo, float hi) { const f32x2 v = {lo, hi}; const bf16x2_t b = __builtin_convertvector(v, bf16x2_t); return __builtin_bit_cast(unsigned, b); }
__device__ __forceinline__ unsigned f2bf(float f) { return pk2(f, f); }
__device__ __forceinline__ float bflo(unsigned w) { return __uint_as_float(w << 16); }
__device__ __forceinline__ float bfhi(unsigned w) { return __uint_as_float(w & 0xffff0000u); }
__device__ __forceinline__ float bf1(bf16 v) { return __uint_as_float((unsigned)v << 16); }
__device__ __forceinline__ float sigm(float x) { return 1.0f / (1.0f + __expf(-x)); }

#define XB_TMO      128
#define XB_XCNT(j)  (256  + 64 * (j))
#define XB_XSUB(j)  (1280 + 64 * (j))
#define XB_XGEN(j)  (2304 + 64 * (j))
#define XB_TOP      3328
#define XB_TOPGEN   3392
#define XCD_BAR_WORDS 3456
#define XB_SPIN_CAP (1u << 18)

__device__ __forceinline__ unsigned xb_ld(unsigned* p)              { return __hip_atomic_load(p, __ATOMIC_RELAXED, __HIP_MEMORY_SCOPE_AGENT); }
__device__ __forceinline__ unsigned xb_add(unsigned* p, unsigned v) { return __hip_atomic_fetch_add(p, v, __ATOMIC_RELAXED, __HIP_MEMORY_SCOPE_AGENT); }
__device__ __forceinline__ unsigned xb_xcc_id() { return (unsigned)__builtin_amdgcn_s_getreg((3 << 11) | 20) & 0xFu; }
#define XB_SPIN(cond, bar) do { unsigned _sp = 0; while (cond) { __builtin_amdgcn_s_sleep(1); \
    if ((++_sp & 255u) == 0u) { if (xb_ld(&(bar)[XB_TMO])) break; if (_sp > XB_SPIN_CAP) { atomicAdd(&(bar)[XB_TMO], 1u); break; } } } } while (0)

struct XcdBarrier {
    unsigned* bar; unsigned x;
    volatile LAS unsigned* st;
};

__device__ __forceinline__ XcdBarrier xcd_barrier_post(unsigned* bar, volatile LAS unsigned* st) {
    XcdBarrier b; b.bar = bar; b.x = xb_xcc_id(); b.st = st;
    if (threadIdx.x == 0) (void)xb_add(&bar[XB_XCNT(b.x)], 1u);
    return b;
}
__device__ __forceinline__ void xcd_barrier_complete(unsigned* bar, unsigned x, unsigned& nloc, unsigned& nx) {
    const unsigned G = gridDim.x * gridDim.y * gridDim.z;
    unsigned sum, cnt, mine, sp = 0u;
    for (;;) {
        sum = 0u; cnt = 0u; mine = 0u;
#pragma unroll
        for (unsigned j = 0; j < 16; ++j) { const unsigned c = xb_ld(&bar[XB_XCNT(j)]); sum += c; cnt += (c > 0u) ? 1u : 0u; mine = (j == x) ? c : mine; }
        if (sum == G) break;
        __builtin_amdgcn_s_sleep(1);
        if ((++sp & 255u) == 0u) { if (xb_ld(&bar[XB_TMO])) break; if (sp > XB_SPIN_CAP) { atomicAdd(&bar[XB_TMO], 1u); break; } }
    }
    nloc = mine > 0u ? mine : 1u; nx = cnt > 0u ? cnt : 1u;
}

__device__ __forceinline__ void xcd_barrier(const XcdBarrier& b) {
    asm volatile("s_waitcnt vmcnt(0)" ::: "memory");
    __syncthreads();
    if (threadIdx.x == 0) {
        unsigned* bar = b.bar;
        __builtin_amdgcn_s_waitcnt(0);
        unsigned nloc = b.st[0], nx = b.st[1];
        if (nloc == 0u) { xcd_barrier_complete(bar, b.x, nloc, nx); b.st[0] = nloc; b.st[1] = nx; }
        const unsigned old = xb_add(&bar[XB_XSUB(b.x)], 1u);
        const unsigned gen = old / nloc;
        if (old + 1u == (gen + 1u) * nloc) {
            __builtin_amdgcn_fence(__ATOMIC_RELEASE, "agent");
            asm volatile("s_waitcnt vmcnt(0)" ::: "memory");
            const unsigned og = xb_add(&bar[XB_TOP], 1u);
            const unsigned tg = og / nx;
            if (og + 1u == (tg + 1u) * nx) xb_add(&bar[XB_TOPGEN], 1u);
            else XB_SPIN(xb_ld(&bar[XB_TOPGEN]) == tg, bar);
            __builtin_amdgcn_fence(__ATOMIC_ACQUIRE, "agent");
            xb_add(&bar[XB_XGEN(b.x)], 1u);
            asm volatile("s_waitcnt vmcnt(0)" ::: "memory");
        } else {
            XB_SPIN(xb_ld(&bar[XB_XGEN(b.x)]) == gen, bar);
            __builtin_amdgcn_fence(__ATOMIC_ACQUIRE, "agent");
            asm volatile("s_waitcnt vmcnt(0)" ::: "memory");
        }
    }
    __syncthreads();
}

struct Args { const float* in[18]; float* out; unsigned char* ws; int ph_lo, ph_hi, li, pad; };
enum { I_X = 0, I_WIN, I_BIG, I_BFG, I_NMIX, I_RGN, I_MLN, I_QN, I_KN, I_WPA, I_WPB, I_WPC, I_WOUT, I_NFFN, I_WUP, I_CW, I_CB, I_WDN };
struct Frame {
    LAS unsigned char* lds;
    volatile LAS unsigned* MISC;
    unsigned char* ws;
    int tid, lane, wave, G, bx;
};
#define WSP(T, off) ((T*)(F.ws + (off)))
__device__ __forceinline__ float wave_sum(float v) {
#pragma unroll
    for (int o = 1; o < 64; o <<= 1) v += __shfl_xor(v, o);
    return v;
}
__device__ __forceinline__ float wave_max(float v) {
#pragma unroll
    for (int o = 1; o < 64; o <<= 1) v = fmaxf(v, __shfl_xor(v, o));
    return v;
}
struct TJob { const float* W; int ldw, K, nblk; bf16* WT; const float* gk; unsigned char* WT8; int nb8, item; };
__device__ __forceinline__ void p0_job_load(const TJob& j, int lane, float (&wv)[32]) {
    const int kb = j.item / j.nblk, nb = j.item % j.nblk, k0 = 64 * kb, n0 = 32 * nb;
    const float* wp = j.W + (size_t)(k0 + (lane >> 5)) * j.ldw + n0 + (lane & 31);
#pragma unroll
    for (int i = 0; i < 32; ++i) wv[i] = wp[(size_t)(2 * i) * j.ldw];
}
__device__ __forceinline__ void p0_job_finish(const TJob& j, int lane, const float (&wv)[32], LAS float* scr) {
    const int kb = j.item / j.nblk, nb = j.item % j.nblk, k0 = 64 * kb, n0 = 32 * nb, K = j.K;
#pragma unroll
    for (int i = 0; i < 32; ++i) scr[(2 * i + (lane >> 5)) * 33 + (lane & 31)] = wv[i];
    LDS_WAIT(); asm volatile("" ::: "memory");
    const int c = lane & 7;
    f32x4 g0 = (f32x4){1.f, 1.f, 1.f, 1.f}, g1 = g0;
    if (j.gk) { g0 = *(const f32x4*)(j.gk + k0 + 8 * c); g1 = *(const f32x4*)(j.gk + k0 + 8 * c + 4); }
    if (j.WT8 && nb >= j.nb8) {
#pragma unroll
        for (int q = 0; q < 4; ++q) { const int n = (lane >> 3) + 8 * q; const LAS float* s = scr + (8 * c) * 33 + n; const f32x4 h0 = g0 * 64.f, h1 = g1 * 64.f;
            v2u o; o.x = (unsigned)__builtin_amdgcn_cvt_pk_fp8_f32(s[2 * 33] * h0[2], s[3 * 33] * h0[3], __builtin_amdgcn_cvt_pk_fp8_f32(s[0 * 33] * h0[0], s[1 * 33] * h0[1], 0, false), true);
            o.y = (unsigned)__builtin_amdgcn_cvt_pk_fp8_f32(s[6 * 33] * h1[2], s[7 * 33] * h1[3], __builtin_amdgcn_cvt_pk_fp8_f32(s[4 * 33] * h1[0], s[5 * 33] * h1[1], 0, false), true);
            *(GAS v2u*)(j.WT8 + (size_t)(n0 - 32 * j.nb8 + n) * K + k0 + 8 * c) = o; }
    } else
#pragma unroll
    for (int q = 0; q < 4; ++q) { const int n = (lane >> 3) + 8 * q; const LAS float* s = scr + (8 * c) * 33 + n;
        v4u o; o.x = pk2(s[0 * 33] * g0[0], s[1 * 33] * g0[1]); o.y = pk2(s[2 * 33] * g0[2], s[3 * 33] * g0[3]); o.z = pk2(s[4 * 33] * g1[0], s[5 * 33] * g1[1]); o.w = pk2(s[6 * 33] * g1[2], s[7 * 33] * g1[3]);
        *(GAS v4u*)(j.WT + (size_t)(n0 + n) * K + k0 + 8 * c) = o; }
    LDS_WAIT(); asm volatile("" ::: "memory");
}
constexpr int P0_INA = 32 * 224, P0_INB = 32 * 288, P0_P = 16 * 64, P0_OUT = 32 * 64, P0_UP = 32 * 352, P0_DN = 88 * 64;
constexpr int P0_LAYER = P0_INA + P0_INB + 3 * P0_P + P0_OUT + P0_UP + P0_DN;
__device__ __forceinline__ TJob p0_job(Frame& F, const Args& args, int it) {
    const int l = it / P0_LAYER; int r = it % P0_LAYER;
    const float* win = args.in[I_WIN] + (size_t)l * DM * NIN; bf16* wint = WSP(bf16, WS_WIN) + (size_t)l * NZ * DM;
    if (r < P0_INA) return TJob{win, NIN, DM, 224, wint, args.in[I_NMIX] + l * DM, F.ws + ws_win8(l) + (size_t)3 * DM * DM, Z_MO / 32, r}; r -= P0_INA;
    if (r < P0_INB) return TJob{win + 7184, NIN, DM, 288, wint + (size_t)7168 * DM, args.in[I_NMIX] + l * DM, F.ws + ws_win8(l), 96, r}; r -= P0_INB;
    if (r < P0_P) return TJob{args.in[I_WPA] + (size_t)l * 1024 * DM, DM, 1024, 64, WSP(bf16, WS_WP) + ((size_t)l * 3 + 0) * DM * 1024, nullptr, nullptr, 0, r}; r -= P0_P;
    if (r < P0_P) return TJob{args.in[I_WPB] + (size_t)l * 1024 * DM, DM, 1024, 64, WSP(bf16, WS_WP) + ((size_t)l * 3 + 1) * DM * 1024, nullptr, nullptr, 0, r}; r -= P0_P;
    if (r < P0_P) return TJob{args.in[I_WPC] + (size_t)l * 1024 * DM, DM, 1024, 64, WSP(bf16, WS_WP) + ((size_t)l * 3 + 2) * DM * 1024, nullptr, nullptr, 0, r}; r -= P0_P;
    if (r < P0_OUT) return TJob{args.in[I_WOUT] + (size_t)l * DM * DM, DM, DM, 64, WSP(bf16, WS_WOUT) + (size_t)l * DM * DM, nullptr, nullptr, 0, r}; r -= P0_OUT;
    if (r < P0_UP) {
        const int nb = r % 352, tile = nb >> 3, wi = nb & 7, src = (wi < 4) ? 128 * tile + 32 * wi : DFF + 128 * tile + 32 * (wi - 4);
        return TJob{args.in[I_WUP] + (size_t)l * DM * NUP + (src - 32 * nb), NUP, DM, 352, WSP(bf16, WS_WUP) + (size_t)l * NUP * DM, args.in[I_NFFN] + l * DM, nullptr, 0, r}; } r -= P0_UP;
    return TJob{args.in[I_WDN] + (size_t)l * DFF * DM, DM, DFF, 64, WSP(bf16, WS_WDN) + (size_t)l * DM * DFF, nullptr, nullptr, 0, r};
}
__device__ __forceinline__ void p0_prologue(Frame& F, const Args& args) {
    LAS float* scr = (LAS float*)(F.lds + RING_OFF + F.wave * 16384);
    const int gw = F.bx * NWAVES + F.wave, NGW = F.G * NWAVES;
    if (gw < DEPTH * P0_LAYER) {
        TJob cur = p0_job(F, args, gw); float va[32]; p0_job_load(cur, F.lane, va);
#pragma unroll 1
        for (int it = gw + NGW; ; it += NGW) {
            const bool has = it < DEPTH * P0_LAYER; TJob nx = cur; float vb[32];
            if (has) { nx = p0_job(F, args, it); p0_job_load(nx, F.lane, vb); }
            p0_job_finish(cur, F.lane, va, scr);
            if (!has) break;
            cur = nx;
#pragma unroll
            for (int i = 0; i < 32; ++i) va[i] = vb[i]; }
    }
    const int gt = F.bx * (NWAVES * 64) + F.tid, NGT = F.G * NWAVES * 64;
    for (int i = gt; i < DEPTH * 16 * DM; i += NGT) { const int l = i / (16 * DM), c = (i / DM) % 16, k = i % DM; WSP(bf16, WS_W16G)[i] = (bf16)f2bf(args.in[I_WIN][((size_t)l * DM + k) * NIN + W_GATE_COL + c] * args.in[I_NMIX][l * DM + k]); }
    for (int m = gw; m < M; m += NGW) { const f32x4* xr = (const f32x4*)(args.in[I_X] + (size_t)m * DM) + F.lane; v2u* o8 = (v2u*)(WSP(bf16, WS_XB) + (size_t)m * DM) + F.lane; float s = 0.f;
        unsigned* q8 = (unsigned*)(F.ws + WS_XB8 + (size_t)m * DM) + F.lane;
#pragma unroll
        for (int j = 0; j < 8; ++j) { const f32x4 v = xr[64 * j]; s += (v.x * v.x + v.y * v.y) + (v.z * v.z + v.w * v.w); v2u w; w.x = pk2(v.x, v.y); w.y = pk2(v.z, v.w); o8[64 * j] = w;
            q8[64 * j] = (unsigned)__builtin_amdgcn_cvt_pk_fp8_f32(v.z, v.w, __builtin_amdgcn_cvt_pk_fp8_f32(v.x, v.y, 0, false), true); }
        s = wave_sum(s); if (F.lane < 32) WSP(float, WS_RS)[(size_t)m * 32 + F.lane] = (F.lane == 0) ? s : 0.f; }
    for (int i = gt; i < 2 * SEQ * 64; i += NGT) { const int which = i / (SEQ * 64), pos = (i / 64) % SEQ, d = i % 64;
        const float ex = which == 0 ? (float)d / 63.0f : (float)(2 * d) / 128.0f;
        const float inv = 1.0f / powf(10000.0f, ex); const float ang = (float)pos * inv; float s, c; sincosf(ang, &s, &c); WSP(f32x2, WS_TAB)[i] = (f32x2){c, s}; }
}
__device__ __forceinline__ void prep_phase(Frame& F, const float* qn, const float* kn, const bf16* w16g, const float* rs, const float* big, const float* bfg) {
    const int gw = F.bx * NWAVES + F.wave, NGW = F.G * NWAVES, lane = F.lane, rsub = lane >> 2, dg = lane & 3;
    const f32x2* trope = WSP(f32x2, WS_TAB) + SEQ * 64;
    for (int u = gw; u < BATCH * 16 * NH; u += NGW) {
        const int kind = 1, hh = u & 7, hb = (u >> 3) & 15, b = u >> 7;
        const float* wn = kn;
        const float* rsb = rs + (size_t)(b * SEQ + hb * 128) * 32 + 8 * dg;
        float wl[16], wh[16], s1[16], s2[16];
#pragma unroll
        for (int e = 0; e < 16; ++e) { wl[e] = wn[16 * dg + e]; wh[e] = wn[64 + 16 * dg + e]; s1[e] = 0.f; s2[e] = 0.f; }
        bf16* zb = WSP(bf16, WS_Z) + (size_t)(b * SEQ + hb * 128) * NZ + (kind ? Z_AK : Z_AQ) + hh * 128 + 16 * dg;
#pragma unroll 2
        for (int st = 0; st < 8; ++st) {
            const int r = rsub + 16 * st, pos = hb * 128 + r; bf16* zr = zb + (size_t)r * NZ;
            const v4u l0 = *(const v4u*)(zr), l1 = *(const v4u*)(zr + 8), h0 = *(const v4u*)(zr + 64), h1 = *(const v4u*)(zr + 72);
            float a[16] = {bflo(l0.x), bfhi(l0.x), bflo(l0.y), bfhi(l0.y), bflo(l0.z), bfhi(l0.z), bflo(l0.w), bfhi(l0.w), bflo(l1.x), bfhi(l1.x), bflo(l1.y), bfhi(l1.y), bflo(l1.z), bfhi(l1.z), bflo(l1.w), bfhi(l1.w)};
            float c[16] = {bflo(h0.x), bfhi(h0.x), bflo(h0.y), bfhi(h0.y), bflo(h0.z), bfhi(h0.z), bflo(h0.w), bfhi(h0.w), bflo(h1.x), bfhi(h1.x), bflo(h1.y), bfhi(h1.y), bflo(h1.z), bfhi(h1.z), bflo(h1.w), bfhi(h1.w)};
            float ss = 0.f;
#pragma unroll
            for (int e = 0; e < 16; ++e) ss += a[e] * a[e] + c[e] * c[e];
            ss += __shfl_xor(ss, 1); ss += __shfl_xor(ss, 2);
            float rq; { const f32x4 s0 = *(const f32x4*)(rsb + (size_t)r * 32), s1 = *(const f32x4*)(rsb + (size_t)r * 32 + 4); rq = ((s0[0] + s0[1]) + (s0[2] + s0[3])) + ((s1[0] + s1[1]) + (s1[2] + s1[3])); }
            rq += __shfl_xor(rq, 1); rq += __shfl_xor(rq, 2);
            const float rr = rsqrtf(rq * (1.0f / 2048.0f) + 1e-6f);
            if (hh == 0 && dg == 0) WSP(float, WS_RSTD)[b * SEQ + hb * 128 + r] = rr;
            const float rstd = rr * rsqrtf(ss * rr * rr * (1.f / 128.f) + 1e-6f);
            const f32x2* tb = trope + pos * 64 + 16 * dg;
#pragma unroll
            for (int e = 0; e < 16; ++e) { const float x1 = a[e] * rstd * wl[e], x2 = c[e] * rstd * wh[e]; const f32x2 cs = tb[e]; a[e] = x1 * cs.x - x2 * cs.y; c[e] = x1 * cs.y + x2 * cs.x; s1[e] += a[e]; s2[e] += c[e]; }
            *(v4u*)(zr) = (v4u){pk2(a[0], a[1]), pk2(a[2], a[3]), pk2(a[4], a[5]), pk2(a[6], a[7])}; *(v4u*)(zr + 8) = (v4u){pk2(a[8], a[9]), pk2(a[10], a[11]), pk2(a[12], a[13]), pk2(a[14], a[15])};
            *(v4u*)(zr + 64) = (v4u){pk2(c[0], c[1]), pk2(c[2], c[3]), pk2(c[4], c[5]), pk2(c[6], c[7])}; *(v4u*)(zr + 72) = (v4u){pk2(c[8], c[9]), pk2(c[10], c[11]), pk2(c[12], c[13]), pk2(c[14], c[15])};
        }
        if (kind) {
            float* km = WSP(float, WS_KMEAN) + (size_t)((b * NH + hh) * 16 + hb) * 128 + 16 * dg;
#pragma unroll
            for (int e = 0; e < 16; ++e) { float x = s1[e], y = s2[e];
                x += __shfl_xor(x, 4); x += __shfl_xor(x, 8); x += __shfl_xor(x, 16); x += __shfl_xor(x, 32);
                y += __shfl_xor(y, 4); y += __shfl_xor(y, 8); y += __shfl_xor(y, 16); y += __shfl_xor(y, 32);
                if (rsub == 0) { km[e] = x * (1.f / 256.f); km[64 + e] = y * (1.f / 256.f); } }
        }
    }
    for (int it = NGW - 1 - gw; it < M / 16; it += NGW) {
        const int i16 = lane & 15, g = lane >> 4; const bf16* ar = WSP(bf16, WS_XB) + (size_t)(16 * it + i16) * DM + 8 * g; const bf16* br = w16g + (size_t)i16 * DM + 8 * g;
        typedef short bf16x8_t __attribute__((ext_vector_type(8)));
        f32x4 acc = (f32x4){0.f, 0.f, 0.f, 0.f};
#pragma unroll 1
        for (int s0 = 0; s0 < DM / 32; s0 += 16) { bf16x8_t av[16], bv[16];
#pragma unroll
            for (int s = 0; s < 16; ++s) { av[s] = *(const bf16x8_t*)(ar + 32 * (s0 + s)); bv[s] = *(const bf16x8_t*)(br + 32 * (s0 + s)); }
#pragma unroll
            for (int s = 0; s < 16; ++s) acc = __builtin_amdgcn_mfma_f32_16x16x32_bf16(av[s], bv[s], acc, 0, 0, 0); }
#pragma unroll
        for (int r = 0; r < 4; ++r) { const int row = 16 * it + 4 * g + r; float ssq = 0.f;
#pragma unroll
            for (int q = 0; q < 8; ++q) { const f32x4 a = *(const f32x4*)(rs + (size_t)row * 32 + 4 * q); ssq += (a[0] + a[1]) + (a[2] + a[3]); }
            const float sr = rsqrtf(ssq * (1.0f / 2048.0f) + 1e-6f);
            const float pre = acc[r] * sr + (i16 < 8 ? big[i16 & 7] : bfg[i16 & 7]); const float sc = 15.0f * tanhf(pre * (1.0f / 15.0f));
            float o = sc; if (i16 >= 8) o = sc > 0.f ? -log1pf(__expf(-sc)) : sc - log1pf(__expf(sc));
            WSP(float, WS_GIF)[(size_t)row * 16 + i16] = o; }
    }
}
__device__ __forceinline__ void glu_fix_phase(Frame& F, const float* cw, const float* cb) {
    const bf16* SB = WSP(bf16, WS_SB); bf16* ACT = WSP(bf16, WS_ACT);
    for (int gI = F.bx; gI < M / 128; gI += F.G) {
        const bool first = ((gI * 128) & (SEQ - 1)) == 0; const bf16* sb = SB + (size_t)gI * 4 * NUP;
        for (int it = F.tid; it < 2 * (DFF / 8); it += NWAVES * 64) {
            const int i = it / (DFF / 8), c8 = (it % (DFF / 8)) * 8;
            float r[2][8];
#pragma unroll
            for (int hf = 0; hf < 2; ++hf) { const int col = hf * DFF + c8;
                const f32x4 b0 = *(const f32x4*)(cb + col), b1 = *(const f32x4*)(cb + col + 4);
                float a[8] = {b0.x, b0.y, b0.z, b0.w, b1.x, b1.y, b1.z, b1.w};
#pragma unroll
                for (int j = 0; j < 3; ++j) { const int slot = i + j;
                    if (slot >= 2 || !first) { const v4u uw = *(const v4u*)(sb + (size_t)slot * NUP + col); const f32x4 w0 = *(const f32x4*)(cw + (size_t)j * NUP + col), w1 = *(const f32x4*)(cw + (size_t)j * NUP + col + 4);
                        a[0] += bflo(uw.x) * w0.x; a[1] += bfhi(uw.x) * w0.y; a[2] += bflo(uw.y) * w0.z; a[3] += bfhi(uw.y) * w0.w; a[4] += bflo(uw.z) * w1.x; a[5] += bfhi(uw.z) * w1.y; a[6] += bflo(uw.w) * w1.z; a[7] += bfhi(uw.w) * w1.w; } }
#pragma unroll
                for (int e = 0; e < 8; ++e) r[hf][e] = a[e]; }
            float o[8];
#pragma unroll
            for (int e = 0; e < 8; ++e) o[e] = r[0][e] * __builtin_amdgcn_rcpf(1.0f + __expf(-r[0][e])) * r[1][e];
            *(v4u*)(ACT + (size_t)(gI * 128 + i) * DFF + c8) = (v4u){pk2(o[0], o[1]), pk2(o[2], o[3]), pk2(o[4], o[5]), pk2(o[6], o[7])};
        }
    }
}
namespace mx {
typedef short bf16x8 __attribute__((ext_vector_type(8)));
typedef short s16x4 __attribute__((ext_vector_type(4)));
#define MFMA16(a, b, c) __builtin_amdgcn_mfma_f32_16x16x32_bf16((a), (b), (c), 0, 0, 0)
#define LDS_FENCE() asm volatile("s_waitcnt lgkmcnt(0)" ::: "memory")
#define SCHED_FENCE() __builtin_amdgcn_sched_barrier(0)
__device__ __forceinline__ bf16x8 frag_row(const LAS bf16* X, int ld, int r0, int c0, int lane) {
    return *(const LAS bf16x8*)(X + (r0 + (lane & 15)) * ld + c0 + 8 * (lane >> 4)); }
__device__ __forceinline__ bf16x8 frag_tr(const LAS bf16* X, int ld, int k0, int c0, int lane) {
    const int g = lane >> 4, q = (lane & 15) >> 2, p = lane & 3;
    const LAS bf16* a = X + (k0 + 8 * g + q) * ld + c0 + 4 * p;
    const s16x4 lo = __builtin_amdgcn_ds_read_tr16_b64_v4i16((LAS s16x4*)a);
    const s16x4 hi = __builtin_amdgcn_ds_read_tr16_b64_v4i16((LAS s16x4*)(a + 4 * ld));
    return __builtin_shufflevector(lo, hi, 0, 1, 2, 3, 4, 5, 6, 7);
}
__device__ __forceinline__ int trs_off(int row, int chunk) { return row * 128 + ((chunk ^ (((row & 3) << 1) | (((row >> 3) & 1) << 3))) << 3); }
__device__ __forceinline__ bf16x8 frag_trs(const LAS bf16* X, int k0, int c0, int lane) {
    const int g = lane >> 4, q = (lane & 15) >> 2, p = lane & 3;
    const LAS bf16* a = X + trs_off(k0 + 8 * g + q, (c0 >> 3) + (p >> 1)) + 4 * (p & 1);
    const s16x4 lo = __builtin_amdgcn_ds_read_tr16_b64_v4i16((LAS s16x4*)a);
    const s16x4 hi = __builtin_amdgcn_ds_read_tr16_b64_v4i16((LAS s16x4*)(a + 4 * 128));
    return __builtin_shufflevector(lo, hi, 0, 1, 2, 3, 4, 5, 6, 7);
}
template <int CTRL> __device__ __forceinline__ float dppf(float v) { return __builtin_bit_cast(float, __builtin_amdgcn_update_dpp(0, __builtin_bit_cast(int, v), CTRL, 0xf, 0xf, true)); }
__device__ __forceinline__ float r16max(float v) { v = fmaxf(v, dppf<0xB1>(v)); v = fmaxf(v, dppf<0x4E>(v)); v = fmaxf(v, dppf<0x141>(v)); v = fmaxf(v, dppf<0x140>(v)); return v; }
__device__ __forceinline__ float r16sum(float v) { v += dppf<0xB1>(v); v += dppf<0x4E>(v); v += dppf<0x141>(v); v += dppf<0x140>(v); return v; }
__device__ __forceinline__ float red16_sum(float v) { return r16sum(v); }
__device__ __forceinline__ float red16_max(float v) { return r16max(v); }
__device__ __forceinline__ void rot8(const v4u lo, const v4u hi, const f32x2* tb, float sc, v4u& olo, v4u& ohi) {
    float a[8] = {bflo(lo.x), bfhi(lo.x), bflo(lo.y), bfhi(lo.y), bflo(lo.z), bfhi(lo.z), bflo(lo.w), bfhi(lo.w)};
    float c[8] = {bflo(hi.x), bfhi(hi.x), bflo(hi.y), bfhi(hi.y), bflo(hi.z), bfhi(hi.z), bflo(hi.w), bfhi(hi.w)};
    float o1[8], o2[8];
#pragma unroll
    for (int e = 0; e < 8; ++e) { const f32x2 cs = tb[e]; o1[e] = (a[e] * cs.x - c[e] * cs.y) * sc; o2[e] = (a[e] * cs.y + c[e] * cs.x) * sc; }
    olo = (v4u){pk2(o1[0], o1[1]), pk2(o1[2], o1[3]), pk2(o1[4], o1[5]), pk2(o1[6], o1[7])};
    ohi = (v4u){pk2(o2[0], o2[1]), pk2(o2[2], o2[3]), pk2(o2[4], o2[5]), pk2(o2[6], o2[7])};
}
constexpr int LQ = 144;
__device__ __forceinline__ void ret_unit(Frame& F, const float* gn, int b, int h) {
    LAS bf16* Qs = (LAS bf16*)(F.lds); LAS bf16* Ks = Qs + 128 * LQ; LAS bf16* Vs = Ks + 128 * LQ; LAS bf16* Ts = Vs + 128 * LQ;
    const int tid = F.tid, lane = F.lane, w = tid >> 6, i16 = lane & 15, g = lane >> 4;
    const float gamma = 1.0f - exp2f(-5.0f - (float)h), lg = log2f(gamma);
    const float gC = exp2f(lg * 128.0f);
    f32x4 accT[8];
#pragma unroll
    for (int n = 0; n < 8; ++n) accT[n] = (f32x4){0.f, 0.f, 0.f, 0.f};
    for (int i = tid; i < 128 * LQ / 8; i += NWAVES * 64) ((LAS v4u*)Ts)[i] = (v4u){0u, 0u, 0u, 0u};
    const bf16* zb = WSP(bf16, WS_Z) + (size_t)(b * SEQ) * NZ + h * 128;
    const f32x2* tret = WSP(f32x2, WS_TAB);
    bf16* yb = WSP(bf16, WS_Y) + (size_t)(b * SEQ) * 1024 + h * 128;
    const int lr = tid >> 2, dg = tid & 3;
    v4u pq[4], pk[4], pv[4]; float prr;
    const float* rstd1 = WSP(float, WS_RSTD) + (size_t)(b * SEQ);
#define RET_FETCH(t0_) do { const bf16* zr_ = zb + (size_t)((t0_) + lr) * NZ; \
        pq[0] = *(const v4u*)(zr_ + Z_RQ + 16 * dg); pq[1] = *(const v4u*)(zr_ + Z_RQ + 64 + 16 * dg); pq[2] = *(const v4u*)(zr_ + Z_RQ + 16 * dg + 8); pq[3] = *(const v4u*)(zr_ + Z_RQ + 64 + 16 * dg + 8); \
        pk[0] = *(const v4u*)(zr_ + Z_RK + 16 * dg); pk[1] = *(const v4u*)(zr_ + Z_RK + 64 + 16 * dg); pk[2] = *(const v4u*)(zr_ + Z_RK + 16 * dg + 8); pk[3] = *(const v4u*)(zr_ + Z_RK + 64 + 16 * dg + 8); \
        _Pragma("unroll") for (int q_ = 0; q_ < 4; ++q_) pv[q_] = *(const v4u*)(zr_ + Z_RV + 32 * dg + 8 * q_); prr = rstd1[(t0_) + lr]; } while (0)
    RET_FETCH(0);
    const float sq = exp2f(lg * (float)lr), sk = exp2f(-lg * (float)lr) * 0.08838834764831845f;
    float gnv[8];
#pragma unroll
    for (int n = 0; n < 8; ++n) gnv[n] = gn[h * 128 + 16 * n + i16];
    for (int c = 0; c < SEQ / 128; ++c) {
        const int t0 = c * 128;
        {
            const f32x2* tb = tret + (t0 + lr) * 64 + 16 * dg;
#pragma unroll
            for (int hh = 0; hh < 2; ++hh) {
                v4u o1, o2; rot8(pq[2 * hh], pq[2 * hh + 1], tb + 8 * hh, sq * prr, o1, o2);
                *(LAS v4u*)(Qs + lr * LQ + 16 * dg + 8 * hh) = o1; *(LAS v4u*)(Qs + lr * LQ + 64 + 16 * dg + 8 * hh) = o2;
                rot8(pk[2 * hh], pk[2 * hh + 1], tb + 8 * hh, sk * prr * prr, o1, o2);
                *(LAS v4u*)(Ks + lr * LQ + 16 * dg + 8 * hh) = o1; *(LAS v4u*)(Ks + lr * LQ + 64 + 16 * dg + 8 * hh) = o2;
            }
#pragma unroll
            for (int q = 0; q < 4; ++q) *(LAS v4u*)(Vs + lr * LQ + 32 * dg + 8 * q) = pv[q];
            if (c + 1 < SEQ / 128) RET_FETCH(t0 + 128);
        }
        __syncthreads();
        bf16x8 aq[4];
#pragma unroll
        for (int s = 0; s < 4; ++s) aq[s] = frag_row(Qs, LQ, 16 * w, 32 * s, lane);
        f32x4 acco[8];
#pragma unroll
        for (int n = 0; n < 8; ++n) acco[n] = (f32x4){0.f, 0.f, 0.f, 0.f};
#pragma unroll
        for (int s = 0; s < 4; ++s) { bf16x8 bb[8];
#pragma unroll
            for (int n = 0; n < 8; ++n) bb[n] = frag_tr(Ts, LQ, 32 * s, 16 * n, lane);
            SCHED_FENCE();
#pragma unroll
            for (int n = 0; n < 8; ++n) acco[n] = MFMA16(aq[s], bb[n], acco[n]); }
        LDS_FENCE();
#pragma unroll
        for (int n = 0; n < 8; ++n) {
            if (n <= w) { f32x4 sa = (f32x4){0.f, 0.f, 0.f, 0.f}; bf16x8 bb[4];
#pragma unroll
                for (int s = 0; s < 4; ++s) bb[s] = frag_row(Ks, LQ, 16 * n, 32 * s, lane);
                SCHED_FENCE();
#pragma unroll
                for (int s = 0; s < 4; ++s) sa = MFMA16(aq[s], bb[s], sa);
#pragma unroll
                for (int r = 0; r < 4; ++r) { const int i = 16 * w + 4 * g + r, j = 16 * n + i16; Qs[i * LQ + j] = (bf16)f2bf(j <= i ? sa[r] : 0.f); } }
            else if (n == w + 1) {
#pragma unroll
                for (int r = 0; r < 4; ++r) Qs[(16 * w + 4 * g + r) * LQ + 16 * n + i16] = (bf16)0; }
        }
        LDS_FENCE();
#pragma unroll
        for (int n = 0; n < 8; ++n) accT[n] = accT[n] * gC;
#pragma unroll
        for (int s = 0; s < 4; ++s) { const bf16x8 ak = frag_tr(Ks, LQ, 32 * s, 16 * w, lane); const bool doi = (s <= (w >> 1)); bf16x8 as = ak; bf16x8 bb[8];
            if (doi) as = frag_row(Qs, LQ, 16 * w, 32 * s, lane);
#pragma unroll
            for (int n = 0; n < 8; ++n) bb[n] = frag_tr(Vs, LQ, 32 * s, 16 * n, lane);
            SCHED_FENCE();
            if (doi) {
#pragma unroll
                for (int n = 0; n < 8; ++n) acco[n] = MFMA16(as, bb[n], acco[n]); }
#pragma unroll
            for (int n = 0; n < 8; ++n) accT[n] = MFMA16(ak, bb[n], accT[n]); }
        bf16 gvr[4][8]; float rrv[4];
#pragma unroll
        for (int r = 0; r < 4; ++r) { const int pos = t0 + 16 * w + 4 * g + r; const bf16* gr = zb + (size_t)pos * NZ + Z_RG + i16; rrv[r] = rstd1[pos];
#pragma unroll
            for (int n = 0; n < 8; ++n) gvr[r][n] = gr[16 * n]; }
        LDS_FENCE();
        __syncthreads();
#pragma unroll
        for (int n = 0; n < 8; ++n)
#pragma unroll
            for (int r = 0; r < 4; ++r) Ts[(16 * w + 4 * g + r) * LQ + 16 * n + i16] = (bf16)f2bf(gC * accT[n][r]);
#pragma unroll
        for (int r = 0; r < 4; ++r) {
            float s = 0.f;
#pragma unroll
            for (int n = 0; n < 8; ++n) s += acco[n][r];
            const float mean = red16_sum(s) * (1.f / 128.f); float q = 0.f;
#pragma unroll
            for (int n = 0; n < 8; ++n) { const float d = acco[n][r] - mean; q += d * d; }
            const float rstd = rsqrtf(red16_sum(q) * (1.f / 128.f) + 1e-5f);
            const int pos = t0 + 16 * w + 4 * g + r; bf16* yr = yb + (size_t)pos * 1024; const float rri = rrv[r];
#pragma unroll
            for (int n = 0; n < 8; ++n) { const int e = 16 * n + i16; const float gv = bf1(gvr[r][n]) * rri; yr[e] = (bf16)f2bf((acco[n][r] - mean) * rstd * gnv[n] * gv * sigm(gv)); }
        }
    }
    __syncthreads();
#undef RET_FETCH
}
constexpr int LK = 72, LV = 168;
__device__ __forceinline__ float scan64_sum(float x, int lane) {
#pragma unroll
    for (int o = 1; o < 64; o <<= 1) { const float y = __shfl_up(x, o); if (lane >= o) x += y; }
    return x; }
__device__ __forceinline__ float scan64_max(float x, int lane) {
#pragma unroll
    for (int o = 1; o < 64; o <<= 1) { const float y = __shfl_up(x, o); if (lane >= o) x = fmaxf(x, y); }
    return x; }
__device__ __forceinline__ void mlstm_unit(Frame& F, const float* nw, int b, int h) {
    LAS bf16* Qm = (LAS bf16*)(F.lds); LAS bf16* Km = Qm + 128 * LK; LAS bf16* Kw = Km + 128 * LK; LAS bf16* Vm = Kw + 128 * LK; LAS bf16* Pm = Vm + 128 * LV; LAS bf16* Cm = Pm + 128 * LQ;
    const int tid = F.tid, lane = F.lane, w = F.wave, i16 = lane & 15, g = lane >> 4;
    const int dt = w & 3, eh = w >> 2;
    f32x4 accC[5];
#pragma unroll
    for (int k = 0; k < 5; ++k) accC[k] = (f32x4){0.f, 0.f, 0.f, 0.f};
    for (int i = tid; i < 64 * LV / 8; i += NWAVES * 64) ((LAS v4u*)Cm)[i] = (v4u){0u, 0u, 0u, 0u};
    float m_prev = 0.f;
    const bf16* zb = WSP(bf16, WS_Z) + (size_t)(b * SEQ) * NZ;
    const float* gif = WSP(float, WS_GIF) + (size_t)(b * SEQ) * 16;
    bf16* yb = WSP(bf16, WS_Y) + (size_t)M * 1024 + (size_t)(b * SEQ) * 1024 + h * 128;
    const int lr = tid >> 2, dg = tid & 3;
    v4u pq[2], pk[2]; float fl0, fl1, il0, il1, prr;
    const float* rstd1 = WSP(float, WS_RSTD) + (size_t)(b * SEQ);
#define ML_FETCH(t0_) do { const bf16* zr_ = zb + (size_t)((t0_) + lr) * NZ; \
        pq[0] = *(const v4u*)(zr_ + Z_MQ + h * 64 + 16 * dg); pq[1] = *(const v4u*)(zr_ + Z_MQ + h * 64 + 16 * dg + 8); pk[0] = *(const v4u*)(zr_ + Z_MK + h * 64 + 16 * dg); pk[1] = *(const v4u*)(zr_ + Z_MK + h * 64 + 16 * dg + 8); \
        fl0 = gif[(size_t)((t0_) + lane) * 16 + 8 + h]; fl1 = gif[(size_t)((t0_) + 64 + lane) * 16 + 8 + h]; il0 = gif[(size_t)((t0_) + lane) * 16 + h]; il1 = gif[(size_t)((t0_) + 64 + lane) * 16 + h]; prr = rstd1[(t0_) + lr]; } while (0)
    ML_FETCH(0);
    float nwv[8];
#pragma unroll
    for (int n = 0; n < 8; ++n) nwv[n] = nw[h * 128 + 16 * n + i16];
    for (int c = 0; c < SEQ / 128; ++c) {
        const int t0 = c * 128;
        const float a0 = scan64_sum(fl0, lane); const float a1 = scan64_sum(fl1, lane) + __shfl(a0, 63);
        const float b0 = il0 - a0, b1 = il1 - a1;
        const float pm0 = scan64_max(b0, lane); const float pm1 = fmaxf(scan64_max(b1, lane), __shfl(pm0, 63));
        const float a_last = __shfl(a1, 63), bmax = __shfl(pm1, 63);
        const float g_n = a_last + bmax, m_new = fmaxf(a_last + m_prev, g_n), s_old = __expf(a_last + m_prev - m_new), s_new = __expf(g_n - m_new);
        {
            const int r = lr;
            const float br = (r < 64) ? __shfl(b0, r & 63) : __shfl(b1, r & 63);
            const float rk = prr * 0.125f, wk = __expf(br - bmax) * rk * s_new;
#pragma unroll
            for (int hh = 0; hh < 2; ++hh) {
                *(LAS v4u*)(Qm + r * LK + 16 * dg + 8 * hh) = pq[hh];
                const v4u kk = pk[hh];
                float kf[8] = {bflo(kk.x), bfhi(kk.x), bflo(kk.y), bfhi(kk.y), bflo(kk.z), bfhi(kk.z), bflo(kk.w), bfhi(kk.w)};
                *(LAS v4u*)(Km + r * LK + 16 * dg + 8 * hh) = (v4u){pk2(kf[0] * rk, kf[1] * rk), pk2(kf[2] * rk, kf[3] * rk), pk2(kf[4] * rk, kf[5] * rk), pk2(kf[6] * rk, kf[7] * rk)};
                *(LAS v4u*)(Kw + r * LK + 16 * dg + 8 * hh) = (v4u){pk2(kf[0] * wk, kf[1] * wk), pk2(kf[2] * wk, kf[3] * wk), pk2(kf[4] * wk, kf[5] * wk), pk2(kf[6] * wk, kf[7] * wk)};
            }
#pragma unroll
            for (int q = 0; q < 4; ++q) { const v4u x = *(const v4u*)(zb + (size_t)(t0 + r) * NZ + Z_MV + h * 128 + 32 * dg + 8 * q); const float rv = prr;
                *(LAS v4u*)(Vm + r * LV + 32 * dg + 8 * q) = (v4u){pk2(bflo(x.x) * rv, bfhi(x.x) * rv), pk2(bflo(x.y) * rv, bfhi(x.y) * rv), pk2(bflo(x.z) * rv, bfhi(x.z) * rv), pk2(bflo(x.w) * rv, bfhi(x.w) * rv)}; }
            *(LAS v4u*)(Vm + r * LV + 128 + 8 * dg) = (v4u){dg == 0 ? 0x00003f80u : 0u, 0u, 0u, 0u};
            if (c + 1 < SEQ / 128) ML_FETCH(t0 + 128);
        }
        __syncthreads();
        float Mi[4], ai[4], rri[4];
#pragma unroll
        for (int r = 0; r < 4; ++r) { const int i = 16 * w + 4 * g + r; rri[r] = rstd1[t0 + i]; const float pmi = (w < 4) ? __shfl(pm0, i & 63) : __shfl(pm1, i & 63); ai[r] = (w < 4) ? __shfl(a0, i & 63) : __shfl(a1, i & 63); Mi[r] = fmaxf(pmi, m_prev); }
        bf16x8 aq[2];
#pragma unroll
        for (int s = 0; s < 2; ++s) aq[s] = frag_row(Qm, LK, 16 * w, 32 * s, lane);
        f32x4 acco[9];
#pragma unroll
        for (int n = 0; n < 9; ++n) acco[n] = (f32x4){0.f, 0.f, 0.f, 0.f};
#pragma unroll
        for (int s = 0; s < 2; ++s) {
#pragma unroll
          for (int hf = 0; hf < 2; ++hf) { bf16x8 bb[5];
#pragma unroll
            for (int n = 0; n < 5 - hf; ++n) bb[n] = frag_tr(Cm, LV, 32 * s, 16 * (5 * hf + n), lane);
            SCHED_FENCE();
#pragma unroll
            for (int n = 0; n < 5 - hf; ++n) acco[5 * hf + n] = MFMA16(aq[s], bb[n], acco[5 * hf + n]); } }
        { float si[4];
#pragma unroll
          for (int r = 0; r < 4; ++r) si[r] = __expf(m_prev - Mi[r]) * rri[r];
#pragma unroll
          for (int n = 0; n < 9; ++n)
#pragma unroll
            for (int r = 0; r < 4; ++r) acco[n][r] *= si[r]; }
        LDS_FENCE();
#pragma unroll
        for (int n = 0; n < 8; ++n) {
            if (n <= w) { f32x4 sa = (f32x4){0.f, 0.f, 0.f, 0.f}; bf16x8 bb[2];
#pragma unroll
                for (int s = 0; s < 2; ++s) bb[s] = frag_row(Km, LK, 16 * n, 32 * s, lane);
                SCHED_FENCE();
#pragma unroll
                for (int s = 0; s < 2; ++s) sa = MFMA16(aq[s], bb[s], sa);
                const int j = 16 * n + i16; const float bj = (n < 4) ? __shfl(b0, j & 63) : __shfl(b1, j & 63);
#pragma unroll
                for (int r = 0; r < 4; ++r) { const int i = 16 * w + 4 * g + r; Pm[i * LQ + j] = (bf16)f2bf(j <= i ? sa[r] * rri[r] * __expf(bj - Mi[r]) : 0.f); } }
            else if (n == w + 1) {
#pragma unroll
                for (int r = 0; r < 4; ++r) Pm[(16 * w + 4 * g + r) * LQ + 16 * n + i16] = (bf16)0; }
        }
        LDS_FENCE();
#pragma unroll
        for (int k = 0; k < 5; ++k) accC[k] = accC[k] * s_old;
#pragma unroll
        for (int s = 0; s < 4; ++s) { const bf16x8 ak = frag_tr(Kw, LK, 32 * s, 16 * dt, lane); const bool doi = (s <= (w >> 1)); bf16x8 ap = ak;
            if (doi) ap = frag_row(Pm, LQ, 16 * w, 32 * s, lane);
#pragma unroll
          for (int hf = 0; hf < 2; ++hf) { const bool dos = (hf == eh);
            if (doi || dos) { bf16x8 bb[5];
#pragma unroll
              for (int n = 0; n < 5; ++n) bb[n] = frag_tr(Vm, LV, 32 * s, 16 * (5 * hf + n), lane);
              SCHED_FENCE();
              if (doi) {
#pragma unroll
                for (int n = 0; n < 5 - hf; ++n) acco[5 * hf + n] = MFMA16(ap, bb[n], acco[5 * hf + n]); }
              if (dos) {
#pragma unroll
                for (int k = 0; k < 5; ++k) accC[k] = MFMA16(ak, bb[k], accC[k]); } } } }
        bf16 gvr[4][8];
#pragma unroll
        for (int r = 0; r < 4; ++r) { const bf16* gr = zb + (size_t)(t0 + 16 * w + 4 * g + r) * NZ + Z_MO + h * 128 + i16;
#pragma unroll
            for (int n = 0; n < 8; ++n) gvr[r][n] = gr[16 * n]; }
        LDS_FENCE();
        __syncthreads();
#pragma unroll
        for (int k = 0; k < 5; ++k)
#pragma unroll
            for (int r = 0; r < 4; ++r) Cm[(16 * dt + 4 * g + r) * LV + 16 * (5 * eh + k) + i16] = (bf16)f2bf(accC[k][r]);
#pragma unroll
        for (int r = 0; r < 4; ++r) {
            const float den = __shfl(acco[8][r], lane & 48);
            const float dd = 1.0f / fmaxf(fabsf(den), __expf(-(ai[r] + Mi[r])));
            float q = 0.f;
#pragma unroll
            for (int n = 0; n < 8; ++n) { acco[n][r] *= dd; q += acco[n][r] * acco[n][r]; }
            const float rstd = rsqrtf(red16_sum(q) * (1.f / 128.f) + 1e-6f);
            const int pos = t0 + 16 * w + 4 * g + r; bf16* yr = yb + (size_t)pos * 1024;
#pragma unroll
            for (int n = 0; n < 8; ++n) { const int e = 16 * n + i16; yr[e] = (bf16)f2bf(acco[n][r] * rstd * nwv[n] * sigm(bf1(gvr[r][n]) * rri[r])); }
        }
        m_prev = m_new;
    }
    __syncthreads();
#undef ML_FETCH
}
__device__ __forceinline__ int vt_off(int row, int chunk) { return row * 128 + ((chunk ^ ((row & 7) << 1)) << 3); }
__device__ __forceinline__ bf16x8 frag_trp(const LAS bf16* X, int k0, int c0, int lane) {
    const int g = lane >> 4, q = (lane & 15) >> 2, p = lane & 3;
    const LAS bf16* a = X + vt_off(k0 + 4 * g + q, (c0 >> 3) + (p >> 1)) + 4 * (p & 1);
    const s16x4 lo = __builtin_amdgcn_ds_read_tr16_b64_v4i16((LAS s16x4*)a);
    const s16x4 hi = __builtin_amdgcn_ds_read_tr16_b64_v4i16((LAS s16x4*)(a + 16 * 128));
    return __builtin_shufflevector(lo, hi, 0, 1, 2, 3, 4, 5, 6, 7);
}
__device__ __forceinline__ void moba_unit(Frame& F, const float* qn, int b, int h, int qi) {
    constexpr int KT_E = 128 * LQ, VT_E = 128 * 128;
    LAS bf16* Kt0 = (LAS bf16*)(F.lds); LAS bf16* Vt0 = Kt0 + 2 * KT_E; LAS float* RR = (LAS float*)(Vt0 + 2 * VT_E);
    const int tid = F.tid, lane = F.lane, w = tid >> 6, i16 = lane & 15, g = lane >> 4;
    const int blk = qi >> 1, qt = qi & 1, q0 = qi * 128;
    const bf16* zb = WSP(bf16, WS_Z) + (size_t)(b * SEQ) * NZ + h * 128;
    bf16x8 aq[4];
    { const bf16* qr = zb + (size_t)(q0 + 16 * w + i16) * NZ + Z_AQ + 8 * g;
#pragma unroll
      for (int s = 0; s < 4; ++s) aq[s] = *(const bf16x8*)(qr + 32 * s); }
    const int lr = tid >> 2, dg = tid & 3;
    v4u pk[4], pv[4]; float prr;
    const float* rstdb = WSP(float, WS_RSTD) + (size_t)(b * SEQ);
#define MB_FETCH(k0_) do { const bf16* zr_ = zb + (size_t)((k0_) + lr) * NZ + 32 * dg; \
        _Pragma("unroll") for (int q_ = 0; q_ < 4; ++q_) { pk[q_] = *(const v4u*)(zr_ + Z_AK + 8 * q_); pv[q_] = *(const v4u*)(zr_ + Z_AV + 8 * q_); } prr = rstdb[(k0_) + lr]; } while (0)
#define MB_STAGE(buf_) do { LAS bf16* kd_ = Kt0 + (buf_) * KT_E + lr * LQ + 32 * dg; LAS bf16* vd_ = Vt0 + (buf_) * VT_E; \
        _Pragma("unroll") for (int q_ = 0; q_ < 4; ++q_) { *(LAS v4u*)(kd_ + 8 * q_) = pk[q_]; *(LAS v4u*)(vd_ + vt_off(lr, 4 * dg + q_)) = pv[q_]; } if (dg == 0) RR[(buf_) * 128 + lr] = prr; } while (0)
    MB_FETCH(0);
    { float ss = 0.f; float qf[4][8];
#pragma unroll
      for (int s = 0; s < 4; ++s) { const v4u x = __builtin_bit_cast(v4u, aq[s]); qf[s][0] = bflo(x.x); qf[s][1] = bfhi(x.x); qf[s][2] = bflo(x.y); qf[s][3] = bfhi(x.y); qf[s][4] = bflo(x.z); qf[s][5] = bfhi(x.z); qf[s][6] = bflo(x.w); qf[s][7] = bfhi(x.w);
#pragma unroll
          for (int j = 0; j < 8; ++j) ss += qf[s][j] * qf[s][j]; }
      ss += __shfl_xor(ss, 16); ss += __shfl_xor(ss, 32);
      const int pos = q0 + 16 * w + i16; const float rr = rstdb[pos]; const float f = rr * rsqrtf(ss * rr * rr * (1.f / 128.f) + 1e-6f);
      const f32x2* tb = WSP(f32x2, WS_TAB) + SEQ * 64 + pos * 64 + 8 * g;
#pragma unroll
      for (int s = 0; s < 2; ++s) {
#pragma unroll
          for (int j = 0; j < 8; ++j) { const float x1 = qf[s][j] * f * qn[32 * s + 8 * g + j], x2 = qf[s + 2][j] * f * qn[64 + 32 * s + 8 * g + j]; const f32x2 cs = tb[32 * s + j];
              qf[s][j] = x1 * cs.x - x2 * cs.y; qf[s + 2][j] = x1 * cs.y + x2 * cs.x; } }
#pragma unroll
      for (int s = 0; s < 4; ++s) { const v4u o = (v4u){pk2(qf[s][0], qf[s][1]), pk2(qf[s][2], qf[s][3]), pk2(qf[s][4], qf[s][5]), pk2(qf[s][6], qf[s][7])}; aq[s] = __builtin_bit_cast(bf16x8, o); } }
    unsigned sel = 0u;
    {
        f32x4 gacc = (f32x4){0.f, 0.f, 0.f, 0.f};
        const float* km = WSP(float, WS_KMEAN) + (size_t)((b * NH + h) * 16) * 128 + (size_t)(i16 & 7) * 256 + 8 * g;
        const bool live = i16 < blk;
#pragma unroll
        for (int s = 0; s < 4; ++s) { f32x4 k0 = (f32x4){0.f, 0.f, 0.f, 0.f}, k1 = k0;
            if (live) { k0 = *(const f32x4*)(km + 32 * s) + *(const f32x4*)(km + 128 + 32 * s); k1 = *(const f32x4*)(km + 32 * s + 4) + *(const f32x4*)(km + 128 + 32 * s + 4); }
            const v4u hi = (v4u){pk2(k0.x, k0.y), pk2(k0.z, k0.w), pk2(k1.x, k1.y), pk2(k1.z, k1.w)};
            const v4u lo = (v4u){pk2(k0.x - bflo(hi.x), k0.y - bfhi(hi.x)), pk2(k0.z - bflo(hi.y), k0.w - bfhi(hi.y)), pk2(k1.x - bflo(hi.z), k1.y - bfhi(hi.z)), pk2(k1.z - bflo(hi.w), k1.w - bfhi(hi.w))};
            gacc = MFMA16(__builtin_bit_cast(bf16x8, hi), aq[s], gacc); gacc = MFMA16(__builtin_bit_cast(bf16x8, lo), aq[s], gacc); }
        float gate[8];
#pragma unroll
        for (int n = 0; n < 8; ++n) { const float gv = __shfl(gacc[n & 3], i16 + 16 * (n >> 2)); gate[n] = (n < blk) ? gv : -INFINITY; }
#pragma unroll
        for (int s = 0; s < 3; ++s) { float bv = -INFINITY; int best = -1;
#pragma unroll
            for (int n = 0; n < 8; ++n) { const bool c = !((sel >> n) & 1u) && gate[n] > bv; bv = c ? gate[n] : bv; best = c ? n : best; }
            if (best >= 0) sel |= 1u << best; }
    }
#pragma unroll
    for (int s = 0; s < 4; ++s) { const v4u u = __builtin_bit_cast(v4u, aq[s]); const float c2 = 0.08838834764831845f * 1.4426950408889634f;
        const v4u o = (v4u){pk2(bflo(u.x) * c2, bfhi(u.x) * c2), pk2(bflo(u.y) * c2, bfhi(u.y) * c2), pk2(bflo(u.z) * c2, bfhi(u.z) * c2), pk2(bflo(u.w) * c2, bfhi(u.w) * c2)}; aq[s] = __builtin_bit_cast(bf16x8, o); }
    f32x4 acco[8];
#pragma unroll
    for (int n = 0; n < 8; ++n) acco[n] = (f32x4){0.f, 0.f, 0.f, 0.f};
    float mq = -1e30f, lq = 0.f;
    const int ntiles = 2 * blk + qt + 1;
    const int qrel = 16 * w + i16 - 4 * g;
    __syncthreads();
    MB_STAGE(0);
    if (ntiles > 1) MB_FETCH(128);
    __syncthreads();
    for (int kt = 0; kt < ntiles; ++kt) {
        const int kb = kt >> 1; const bool own = (kb == blk), diag = (kt == 2 * blk + qt);
        const LAS bf16* Kt = Kt0 + (kt & 1) * KT_E; const LAS bf16* Vt = Vt0 + (kt & 1) * VT_E;
        f32x4 sc[8];
#pragma unroll
        for (int n = 0; n < 8; ++n) sc[n] = (f32x4){0.f, 0.f, 0.f, 0.f};
#pragma unroll
        for (int s = 0; s < 4; ++s) { bf16x8 bb[8];
#pragma unroll
            for (int n = 0; n < 8; ++n) bb[n] = frag_row(Kt, LQ, 16 * n, 32 * s, lane);
            SCHED_FENCE();
#pragma unroll
            for (int n = 0; n < 8; ++n) sc[n] = MFMA16(bb[n], aq[s], sc[n]); }
        if (diag) {
#pragma unroll
            for (int n = 0; n < 8; ++n)
#pragma unroll
                for (int r = 0; r < 4; ++r) sc[n][r] = (16 * n + r <= qrel) ? sc[n][r] : -1e30f; }
        const bool rowok = own || ((sel >> kb) & 1u);
        float mx = -1e30f;
#pragma unroll
        for (int n = 0; n < 8; ++n) mx = fmaxf(mx, fmaxf(fmaxf(sc[n][0], sc[n][1]), fmaxf(sc[n][2], sc[n][3])));
        mx = fmaxf(mx, __shfl_xor(mx, 16)); mx = fmaxf(mx, __shfl_xor(mx, 32));
        const float mnew = rowok ? fmaxf(mq, mx) : mq;
        const float alpha = __builtin_amdgcn_exp2f(mq - mnew); mq = mnew;
        const float msub = rowok ? mnew : 1e30f;
        float ps = 0.f;
#pragma unroll
        for (int n = 0; n < 8; ++n)
#pragma unroll
            for (int r = 0; r < 4; ++r) { sc[n][r] = __builtin_amdgcn_exp2f(sc[n][r] - msub); ps += sc[n][r]; }
        lq = lq * alpha + ps;
        { const LAS float* rrt = RR + (kt & 1) * 128 + 4 * g;
#pragma unroll
          for (int n = 0; n < 8; ++n) sc[n] = sc[n] * *(const LAS f32x4*)(rrt + 16 * n); }
        if (!__all(alpha == 1.0f)) {
#pragma unroll
            for (int n = 0; n < 8; ++n) acco[n] = acco[n] * alpha; }
#pragma unroll
        for (int t = 0; t < 4; ++t) {
            const v4u pw = (v4u){pk2(sc[2 * t][0], sc[2 * t][1]), pk2(sc[2 * t][2], sc[2 * t][3]), pk2(sc[2 * t + 1][0], sc[2 * t + 1][1]), pk2(sc[2 * t + 1][2], sc[2 * t + 1][3])};
            const bf16x8 pf = __builtin_bit_cast(bf16x8, pw); bf16x8 bb[8];
#pragma unroll
            for (int n = 0; n < 8; ++n) bb[n] = frag_trp(Vt, 32 * t, 16 * n, lane);
            SCHED_FENCE();
#pragma unroll
            for (int n = 0; n < 8; ++n) acco[n] = MFMA16(bb[n], pf, acco[n]); }
        if (kt + 1 < ntiles) { MB_STAGE((kt + 1) & 1); if (kt + 2 < ntiles) MB_FETCH((kt + 2) * 128); }
        __syncthreads();
    }
    lq += __shfl_xor(lq, 16); lq += __shfl_xor(lq, 32);
    const float inv = 1.0f / lq;
    bf16* yr = WSP(bf16, WS_Y) + (size_t)2 * M * 1024 + (size_t)(b * SEQ + q0 + 16 * w + i16) * 1024 + h * 128 + 4 * g;
#pragma unroll
    for (int n = 0; n < 8; ++n) *(v2u*)(yr + 16 * n) = (v2u){pk2(acco[n][0] * inv, acco[n][1] * inv), pk2(acco[n][2] * inv, acco[n][3] * inv)};
#undef MB_FETCH
#undef MB_STAGE
}
__device__ __forceinline__ void mix_phase(Frame& F, const float* rgn, const float* mln, const float* qn, unsigned* head) {
    volatile LAS unsigned* slot = F.MISC; unsigned par = 0u;
    for (;;) {
        if (F.tid == 0) slot[par] = __hip_atomic_fetch_add(head, 1u, __ATOMIC_RELAXED, __HIP_MEMORY_SCOPE_AGENT);
        __syncthreads();
        const unsigned it = slot[par]; par ^= 1u;
        if (it >= 128u + 1024u) break;
        { int t_ = threadIdx.x; asm volatile("" : "+v"(t_)); F.tid = t_; F.lane = t_ & 63; }
        if (it < 64u) ret_unit(F, rgn, (int)(it >> 3), (int)(it & 7u));
        else if (it < 128u) mlstm_unit(F, mln, (int)((it - 64u) >> 3), (int)(it & 7u));
        else { const unsigned rank = it - 128u; moba_unit(F, qn, (int)((rank & 63u) >> 3), (int)(rank & 7u), 15 - (int)(rank >> 6)); }
    }
}
}
constexpr int N_PHASES = 1 + 8 * DEPTH;
__global__ void __launch_bounds__(NWAVES * 64, 2) fwd(Args args) {
    extern __shared__ __attribute__((aligned(16))) unsigned char lds[];
    Frame F;
    F.lds = (LAS unsigned char*)lds;
    F.MISC = (volatile LAS unsigned*)(F.lds + MISC_OFF);
    F.tid = threadIdx.x; F.lane = F.tid & 63; F.wave = __builtin_amdgcn_readfirstlane(F.tid >> 6); F.G = gridDim.x; F.bx = blockIdx.x;
    F.ws = args.ws;
    for (int u = F.tid; u < (LDS_BYTES - LDSCTL_OFF) / 4; u += NWAVES * 64) ((LAS unsigned*)(F.lds + LDSCTL_OFF))[u] = 0u;
    __syncthreads();
    XcdBarrier bar = xcd_barrier_post((unsigned*)(F.ws + WS_CTL) + CW_BAR + args.li * XCD_BAR_WORDS, F.MISC + 8);
    const int lo = args.ph_lo, hi = args.ph_hi;
#define RUN(p) (lo <= (p) && (p) < hi)
#define SEAM(p) do { if ((p) + 1 < hi) xcd_barrier(bar); } while (0)
    if (RUN(0)) { p0_prologue(F, args); SEAM(0); }
    for (int l = 0; l < DEPTH; ++l) {
        const int p0 = 1 + 8 * l;
        { int t_ = threadIdx.x; asm volatile("" : "+v"(t_)); F.tid = t_; F.lane = t_ & 63; F.wave = __builtin_amdgcn_readfirstlane(t_ >> 6); int b_ = blockIdx.x; asm volatile("" : "+s"(b_)); F.bx = b_; }
        float* rs = WSP(float, WS_RS) + (size_t)(2 * l) * M * 32;
        if (RUN(p0 + 0)) {
            { const int kf = (((F.bx >> 3) & 7) >> 2);
#define IN_F8_CALL(I0, NN) { pg8::Gemm g8{WSP(bf16, WS_XB8), (const bf16*)(F.ws + ws_win8(l)), M, N8, DM / 2}; pg8::RangeOrder<pg8::StaticOrder> S8; S8.b.init(M, N8, F.G, F.bx); S8.i0 = (I0); S8.n = (NN); \
                pg8::EpiGate8 E8{F.ws + WS_ZG, 3 * DM, 1.0f / 64.0f, WSP(bf16, WS_Z), NZ, 3 * DM / 256, Z_MO}; \
                pg8::gemm_phase<pg8::EpiGate8, pg8::RangeOrder<pg8::StaticOrder>, false, true, true>(F.lds + RING_OFF, g8, S8, E8); }
              IN_F8_CALL(0, kf)
              { pg8::Gemm g{WSP(bf16, WS_XB), WSP(bf16, WS_WIN) + (size_t)l * NZ * DM, M, Z_GA - 1024, DM}; pg8::SkipOrder S; S.init(M, Z_GA - 1024, F.G, F.bx); S.skip0 = Z_MO / 256; S.nskip = 4;
                pg8::EpiBf16 E{WSP(bf16, WS_Z), NZ, nullptr, -1, 0};
                pg8::gemm_phase<pg8::EpiBf16, pg8::SkipOrder, false, true>(F.lds + RING_OFF, g, S, E); }
              { int kf2 = (((F.bx >> 3) & 7) >> 2); asm volatile("" : "+s"(kf2));
                IN_F8_CALL(kf2, 1 << 20) }
#undef IN_F8_CALL
            }
            SEAM(p0 + 0); }
        if (RUN(p0 + 1)) { prep_phase(F, args.in[I_QN] + l * 128, args.in[I_KN] + l * 128, WSP(bf16, WS_W16G) + (size_t)l * 16 * DM, rs, args.in[I_BIG] + l * 8, args.in[I_BFG] + l * 8); SEAM(p0 + 1); }
        if (RUN(p0 + 2)) { mx::mix_phase(F, args.in[I_RGN] + l * 1024, args.in[I_MLN] + l * 1024, args.in[I_QN] + l * 128, (unsigned*)(F.ws + WS_CTL) + CW_QUEUE + 64 * l); SEAM(p0 + 2); }
        if (RUN(p0 + 3)) {
            pg8::StaticOrder3 S; S.init(M, DM, F.G, F.bx);
            pg8::Gemm g{WSP(bf16, WS_Y), WSP(bf16, WS_WP) + (size_t)l * 3 * DM * 1024, M, DM, 1024, (size_t)M * 1024, (size_t)DM * 1024}; pg8::EpiGateAcc E{WSP(bf16, WS_MG), DM, F.ws + WS_ZG, 3 * DM, WSP(float, WS_RSTD)};
            pg8::gemm_phase<pg8::EpiGateAcc, pg8::StaticOrder3, true, true>(F.lds + RING_OFF, g, S, E);
            SEAM(p0 + 3); }
        if (RUN(p0 + 4)) {
            pg8::Gemm g{WSP(bf16, WS_MG), WSP(bf16, WS_WOUT) + (size_t)l * DM * DM, M, DM, DM}; pg8::StaticOrder S; S.init(M, DM, F.G, F.bx);
            pg8::EpiRes<false> E{WSP(bf16, WS_XB), rs + (size_t)32 * M, nullptr, DM};
            pg8::gemm_phase<pg8::EpiRes<false>, pg8::StaticOrder, true, true>(F.lds + RING_OFF, g, S, E);
            SEAM(p0 + 4); }
        if (RUN(p0 + 5)) {
            pg8::Gemm g{WSP(bf16, WS_XB), WSP(bf16, WS_WUP) + (size_t)l * NUP * DM, M, NUP, DM}; pg8::StaticOrder S; S.init(M, NUP, F.G, F.bx);
            { pg8::Unit uu; int lastpm = -1; const float* rs2 = rs + (size_t)32 * M; int tq = threadIdx.x; asm volatile("" : "+v"(tq)); float* r2o = (float*)(F.ws + WS_RSTD2); asm volatile("" : "+s"(r2o));
              for (int i = 0; S.next(i, uu); ++i) if (uu.pm != lastpm) { lastpm = uu.pm;
                  const int r = uu.pm * 256 + (tq >> 1); const f32x4* p = (const f32x4*)(rs2 + (size_t)r * 32 + 16 * (tq & 1));
                  const f32x4 a = p[0], b = p[1], c = p[2], dd = p[3]; float s = (((a[0] + a[1]) + (a[2] + a[3])) + ((b[0] + b[1]) + (b[2] + b[3]))) + (((c[0] + c[1]) + (c[2] + c[3])) + ((dd[0] + dd[1]) + (dd[2] + dd[3])));
                  s += __shfl_xor(s, 1); if (!(tq & 1)) r2o[r] = __builtin_amdgcn_rsqf(s * (1.0f / DM) + 1e-6f); }
              VM_WAIT(); __syncthreads(); }
            const float* r2p = (const float*)(F.ws + WS_RSTD2); asm volatile("" : "+s"(r2p));
            pg8::EpiGLU E{WSP(bf16, WS_ACT), args.in[I_CW] + (size_t)l * 3 * NUP, args.in[I_CB] + (size_t)l * NUP, r2p, WSP(bf16, WS_SB)};
            pg8::gemm_phase<pg8::EpiGLU, pg8::StaticOrder, true, true>(F.lds + RING_OFF, g, S, E);
            SEAM(p0 + 5); }
        if (RUN(p0 + 6)) { glu_fix_phase(F, args.in[I_CW] + (size_t)l * 3 * NUP, args.in[I_CB] + (size_t)l * NUP); SEAM(p0 + 6); }
        if (RUN(p0 + 7)) {
            pg8::Gemm g{WSP(bf16, WS_ACT), WSP(bf16, WS_WDN) + (size_t)l * DM * DFF, M, DM, DFF}; pg8::StaticOrder S; S.init(M, DM, F.G, F.bx);
            if (l + 1 < DEPTH) { pg8::EpiRes<false, true> E{WSP(bf16, WS_XB), rs + (size_t)64 * M, nullptr, DM, F.ws + WS_XB8};
                pg8::gemm_phase<pg8::EpiRes<false, true>, pg8::StaticOrder, true, true>(F.lds + RING_OFF, g, S, E); }
            else { pg8::EpiRes<true> E{WSP(bf16, WS_XB), nullptr, args.out, DM};
                pg8::gemm_phase<pg8::EpiRes<true>, pg8::StaticOrder, true, true>(F.lds + RING_OFF, g, S, E); }
            SEAM(p0 + 7); }
    }
#undef RUN
#undef SEAM
}

#ifndef MK_N_LAUNCHES
#define MK_N_LAUNCHES 1
#endif
extern "C" void kernel_launch(void* const* d_in, const int* in_sizes, int n_in, void* d_out, int out_size, void* d_ws, size_t ws_size, hipStream_t stream) {
    static int grid = 0;
    if (grid == 0) {
        if (n_in != 18 || in_sizes[0] != M * DM || out_size != M * DM || ws_size < WS_END) { fprintf(stderr, "kernel_launch: unexpected shapes (n_in %d, in0 %d, out %d, ws %zu)\n", n_in, n_in > 0 ? in_sizes[0] : -1, out_size, ws_size); grid = -1; return; }
        int dev = 0, cus = 0, per_cu = 0;
        if (hipGetDevice(&dev) != hipSuccess || hipDeviceGetAttribute(&cus, hipDeviceAttributeMultiprocessorCount, dev) != hipSuccess) { grid = -1; return; }
        if (hipFuncSetAttribute((const void*)fwd, hipFuncAttributeMaxDynamicSharedMemorySize, LDS_BYTES) != hipSuccess) { fprintf(stderr, "kernel_launch: hipFuncSetAttribute failed\n"); grid = -1; return; }
        if (hipOccupancyMaxActiveBlocksPerMultiprocessor(&per_cu, (const void*)fwd, NWAVES * 64, LDS_BYTES) != hipSuccess || per_cu < 1) fprintf(stderr, "kernel_launch: occupancy query reports %d\n", per_cu);
        (void)hipGetLastError();
        grid = cus;
    }
    if (grid < 0) return;
    if (hipMemsetAsync((char*)d_ws + WS_CTL, 0, CTL_ZERO_BYTES, stream) != hipSuccess) return;
    Args a{};
    for (int i = 0; i < 18; ++i) a.in[i] = (const float*)d_in[i];
    a.out = (float*)d_out; a.ws = (unsigned char*)d_ws; a.pad = 0;
    constexpr int NL = MK_N_LAUNCHES;
    for (int li = 0; li < NL; ++li) {
        a.ph_lo = (NL == 1) ? 0 : li; a.ph_hi = (NL == 1) ? N_PHASES : li + 1; a.li = (NL == 1) ? 0 : 0;
        hipLaunchKernelGGL(fwd, dim3(grid), dim3(NWAVES * 64), LDS_BYTES, stream, a);
    }
}
```
